# Optimizing an MI355X kernel written in HIP

```python
import math
import jax
import jax.numpy as jnp
from jax import lax
import numpy as np

D_MODEL = 1024
BATCH = 8
SEQ = 2048
DEPTH = 2

MEM_LEN = 256
EPS = 1e-6
MIX_WIDTH = D_MODEL
GROUP_WIDTH = MIX_WIDTH // 4

GLA_HEADS = 4
GLA_DV = GROUP_WIDTH // GLA_HEADS
GLA_DK = GLA_DV // 2
GLA_RANK = 16
GLA_TAU = 16.0
GLA_CHUNK = 64

POOL_WINDOWS = (2, 4, 8, 16)
POOL_GROUPS = len(POOL_WINDOWS)
POOL_CG = GROUP_WIDTH // POOL_GROUPS

DSA_HEADS = 4
DSA_DH = GROUP_WIDTH // DSA_HEADS
IDX_HEADS = 8
IDX_DIM = 32
DSA_TOPK_MAX = 256
DSA_QBLOCK = 128

SGU_GROUPS = 4
SGU_CHUNK = 128
SGU_CG = GROUP_WIDTH // SGU_GROUPS

REL_BUCKETS = 32
REL_MAX_DIST = 128

XA_HEADS = 4
XA_DH = 64

D_FF = 2816
N_EXPERTS = 8
TOP_K = 2
D_FF_EXPERT = 3584

IN_SPLITS = (
    GLA_HEADS * GLA_DK, GLA_HEADS * GLA_DK, GROUP_WIDTH, GROUP_WIDTH, GLA_RANK,
    GROUP_WIDTH,
    GROUP_WIDTH, GROUP_WIDTH, GROUP_WIDTH, IDX_HEADS * IDX_DIM, IDX_DIM, IDX_HEADS,
    2 * GROUP_WIDTH,
)
IN_WIDTH = sum(IN_SPLITS)

kernel_name = 'hybrid_parallel_group_block'

F32 = jnp.float32


def rmsnorm(x, g):
    xf = x.astype(F32)
    y = xf * lax.rsqrt(jnp.mean(xf * xf, axis=-1, keepdims=True) + EPS)
    return (y * g.astype(F32)).astype(x.dtype)


def split_cols(z, sizes):
    outs, off = [], 0
    for s in sizes:
        outs.append(z[..., off:off + s])
        off += s
    return outs


def rel_bucket(dist):
    n = jnp.maximum(dist, 0)
    max_exact = REL_BUCKETS // 2
    nf = jnp.maximum(n, 1).astype(F32)
    large = max_exact + (jnp.log(nf / max_exact) / math.log(REL_MAX_DIST / max_exact)
                         * (REL_BUCKETS - max_exact)).astype(jnp.int32)
    large = jnp.minimum(large, REL_BUCKETS - 1)
    return jnp.where(n < max_exact, n, large)


def gla_mixer(q, k, v, g_out, a_low, wa2, ba, norm_g):
    B, T, _ = q.shape
    C = GLA_CHUNK
    N = T // C
    logit = (a_low @ wa2 + ba).astype(F32)
    log_a = jax.nn.log_sigmoid(logit) / GLA_TAU

    def heads(t, d):
        return t.reshape(B, N, C, GLA_HEADS, d).transpose(0, 3, 1, 2, 4).astype(F32)

    qh = heads(q, GLA_DK) * (GLA_DK ** -0.5)
    kh = heads(k, GLA_DK)
    vh = heads(v, GLA_DV)
    b = jnp.cumsum(heads(log_a, GLA_DK), axis=3)
    q_t = qh * jnp.exp(b)
    k_t = kh * jnp.exp(-b)
    causal = jnp.tril(jnp.ones((C, C), dtype=bool))
    att = jnp.where(causal, jnp.einsum('bhnik,bhnjk->bhnij', q_t, k_t), 0.0)
    o_intra = jnp.einsum('bhnij,bhnjv->bhniv', att, vh)
    b_last = b[:, :, :, -1:, :]
    chunk_kv = jnp.einsum('bhnck,bhncv->bhnkv', kh * jnp.exp(b_last - b), vh)
    decay = jnp.exp(b_last[:, :, :, 0, :])

    def step(S, inp):
        dec_n, kv_n = inp
        return S * dec_n[..., None] + kv_n, S

    S0 = jnp.zeros((B, GLA_HEADS, GLA_DK, GLA_DV), F32)
    _, S_start = lax.scan(step, S0, (jnp.moveaxis(decay, 2, 0), jnp.moveaxis(chunk_kv, 2, 0)))
    S_start = jnp.moveaxis(S_start, 0, 2)
    o = o_intra + jnp.einsum('bhnck,bhnkv->bhncv', q_t, S_start)
    o = o * lax.rsqrt(jnp.mean(o * o, axis=-1, keepdims=True) + EPS)
    o = o.transpose(0, 2, 3, 1, 4).reshape(B, T, GLA_HEADS * GLA_DV) * norm_g.astype(F32)
    return (o * jax.nn.silu(g_out.astype(F32))).astype(q.dtype)


def pool_mixer(u, w, b, scale):
    B, T, _ = u.shape
    uf = u.astype(F32)
    csum = jnp.concatenate([jnp.zeros((B, 1, GROUP_WIDTH), F32), jnp.cumsum(uf, axis=1)], axis=1)
    tpos = jnp.arange(T)
    outs = []
    for gi, win in enumerate(POOL_WINDOWS):
        c = csum[:, :, gi * POOL_CG:(gi + 1) * POOL_CG]
        hi = c[:, 1:]
        lo = jnp.pad(c[:, :T + 1 - win], ((0, 0), (win - 1, 0), (0, 0)))
        cnt = jnp.minimum(tpos + 1, win).astype(F32)[None, :, None]
        outs.append((hi - lo) / cnt - uf[:, :, gi * POOL_CG:(gi + 1) * POOL_CG])
    p = jnp.stack(outs, axis=2)
    y = jnp.einsum('btgc,gcd->btgd', p, w.astype(F32)) + b.astype(F32)
    return (y.reshape(B, T, GROUP_WIDTH) * scale.astype(F32)).astype(u.dtype)


def dsa_mixer(q, k, v, qi, ki, wi, rel_bias):
    B, T, _ = q.shape
    topk = min(DSA_TOPK_MAX, T // 4)
    n_blk = T // DSA_QBLOCK
    qh = q.reshape(B, T, DSA_HEADS, DSA_DH)
    kh = k.reshape(B, T, DSA_HEADS, DSA_DH)
    vh = v.reshape(B, T, DSA_HEADS, DSA_DH)
    qih = qi.reshape(B, T, IDX_HEADS, IDX_DIM)
    kif = ki.astype(F32)
    w_idx = wi.astype(F32) * (IDX_HEADS ** -0.5)
    spos = jnp.arange(T)
    gather = jax.vmap(lambda arr, idx: arr[idx])

    def block(blk):
        t0 = blk * DSA_QBLOCK
        tpos = t0 + jnp.arange(DSA_QBLOCK)
        q_b = lax.dynamic_slice_in_dim(qh, t0, DSA_QBLOCK, axis=1).astype(F32)
        qi_b = lax.dynamic_slice_in_dim(qih, t0, DSA_QBLOCK, axis=1).astype(F32)
        w_b = lax.dynamic_slice_in_dim(w_idx, t0, DSA_QBLOCK, axis=1)
        dots = jnp.einsum('bqhd,bsd->bqsh', qi_b, kif) * (IDX_DIM ** -0.5)
        score = jnp.einsum('bqsh,bqh->bqs', jax.nn.relu(dots), w_b)
        visible = spos[None, :] <= tpos[:, None]
        score = jnp.where(visible[None], score, -jnp.inf)
        _, sel = lax.top_k(score, topk)
        k_sel = gather(kh, sel).astype(F32)
        v_sel = gather(vh, sel).astype(F32)
        dist = tpos[None, :, None] - sel
        bias = rel_bias[rel_bucket(dist)].astype(F32)
        logits = jnp.einsum('bqhd,bqkhd->bqkh', q_b, k_sel) * (DSA_DH ** -0.5) + bias
        logits = jnp.where((dist >= 0)[..., None], logits, -jnp.inf)
        p = jax.nn.softmax(logits, axis=2)
        return jnp.einsum('bqkh,bqkhd->bqhd', p, v_sel).astype(q.dtype)

    out = lax.map(block, jnp.arange(n_blk))
    return out.transpose(1, 0, 2, 3, 4).reshape(B, T, DSA_HEADS * DSA_DH)


def sgu_mixer(zuv, ln_g, ln_b, w_s, b_s):
    B, T, _ = zuv.shape
    z = jax.nn.gelu(zuv.astype(F32))
    u, v = z[..., :GROUP_WIDTH], z[..., GROUP_WIDTH:]
    mu = jnp.mean(v, axis=-1, keepdims=True)
    var = jnp.mean(jnp.square(v - mu), axis=-1, keepdims=True)
    vn = (v - mu) * lax.rsqrt(var + EPS) * ln_g.astype(F32) + ln_b.astype(F32)
    vn = vn.reshape(B, T // SGU_CHUNK, SGU_CHUNK, SGU_GROUPS, SGU_CG)
    ws = w_s.astype(F32) * jnp.tril(jnp.ones((SGU_CHUNK, SGU_CHUNK), F32))
    mixed = jnp.einsum('gts,bnsgc->bntgc', ws, vn) + b_s.astype(F32).T[None, None, :, :, None]
    return (u * mixed.reshape(B, T, GROUP_WIDTH)).astype(zuv.dtype)


def hybrid_mixer(hn, w_in, gla_wa2, gla_ba, gla_norm, pool_w, pool_b, pool_scale,
                 sgu_ln_g, sgu_ln_b, sgu_w, sgu_b, w_out, rel_bias):
    z = hn @ w_in
    (a_q, a_k, a_v, a_g, a_lr, b_u, c_q, c_k, c_v, c_qi, c_ki, c_wi, d_uv) = split_cols(z, IN_SPLITS)
    o_a = gla_mixer(a_q, a_k, a_v, a_g, a_lr, gla_wa2, gla_ba, gla_norm)
    o_b = pool_mixer(b_u, pool_w, pool_b, pool_scale)
    o_c = dsa_mixer(c_q, c_k, c_v, c_qi, c_ki, c_wi, rel_bias)
    o_d = sgu_mixer(d_uv, sgu_ln_g, sgu_ln_b, sgu_w, sgu_b)
    return jnp.concatenate([o_a, o_b, o_c, o_d], axis=-1) @ w_out


def cross_attn(hn, mem, norm_mem, wq, wkv, wo):
    B, T, _ = hn.shape
    q = (hn @ wq).reshape(B, T, XA_HEADS, XA_DH).astype(F32)
    kv = rmsnorm(mem, norm_mem) @ wkv
    M = mem.shape[1]
    k = kv[..., :XA_HEADS * XA_DH].reshape(B, M, XA_HEADS, XA_DH).astype(F32)
    v = kv[..., XA_HEADS * XA_DH:].reshape(B, M, XA_HEADS, XA_DH).astype(F32)
    p = jax.nn.softmax(jnp.einsum('bthd,bmhd->bhtm', q, k) * (XA_DH ** -0.5), axis=-1)
    o = jnp.einsum('bhtm,bmhd->bthd', p, v).reshape(B, T, XA_HEADS * XA_DH).astype(hn.dtype)
    return o @ wo


def swiglu(h, w1, w3, w2):
    return (jax.nn.silu(h @ w1) * (h @ w3)) @ w2


def moe_swiglu(h, router, w1, w3, w2):
    logits = (h @ router).astype(F32)
    top_v, top_i = lax.top_k(logits, TOP_K)
    gates = jax.nn.softmax(top_v, axis=-1)
    dense_gate = jnp.sum(jax.nn.one_hot(top_i, N_EXPERTS, dtype=F32) * gates[..., None], axis=-2)
    y = jnp.zeros(h.shape, F32)
    for e in range(N_EXPERTS):
        y = y + swiglu(h, w1[e], w3[e], w2[e]).astype(F32) * dense_gate[..., e:e + 1]
    return y.astype(h.dtype)


def setup_inputs(seed: int = 0) -> dict:
    key = jax.random.key(seed)
    ks = jax.random.split(key, 30)
    n_dense = (DEPTH + 1) // 2
    n_moe = DEPTH // 2

    def nrm(k, shape, fan_in):
        return jax.random.normal(k, shape, F32) * (fan_in ** -0.5)

    def gain(k, shape):
        return 1.0 + 0.05 * jax.random.normal(k, shape, F32)

    def small(k, shape):
        return 0.02 * jax.random.normal(k, shape, F32)

    return {
        'x': jax.random.normal(ks[0], (BATCH, SEQ, D_MODEL), F32),
        'mem': jax.random.normal(ks[1], (BATCH, MEM_LEN, D_MODEL), F32),
        'rel_bias': 0.5 * jax.random.normal(ks[2], (REL_BUCKETS, DSA_HEADS), F32),
        'final_norm': gain(ks[3], (D_MODEL,)),
        'norm_mix': gain(ks[4], (DEPTH, D_MODEL)),
        'w_in': nrm(ks[5], (DEPTH, D_MODEL, IN_WIDTH), D_MODEL),
        'gla_wa2': nrm(ks[6], (DEPTH, GLA_RANK, GLA_HEADS * GLA_DK), GLA_RANK),
        'gla_ba': small(ks[7], (DEPTH, GLA_HEADS * GLA_DK)),
        'gla_norm': gain(ks[8], (DEPTH, GROUP_WIDTH)),
        'pool_w': nrm(ks[9], (DEPTH, POOL_GROUPS, POOL_CG, POOL_CG), POOL_CG),
        'pool_b': small(ks[10], (DEPTH, POOL_GROUPS, POOL_CG)),
        'pool_scale': gain(ks[11], (DEPTH, GROUP_WIDTH)),
        'sgu_ln_g': gain(ks[12], (DEPTH, GROUP_WIDTH)),
        'sgu_ln_b': small(ks[13], (DEPTH, GROUP_WIDTH)),
        'sgu_w': nrm(ks[14], (DEPTH, SGU_GROUPS, SGU_CHUNK, SGU_CHUNK), SGU_CHUNK),
        'sgu_b': gain(ks[15], (DEPTH, SGU_GROUPS, SGU_CHUNK)),
        'w_out': nrm(ks[16], (DEPTH, MIX_WIDTH, D_MODEL), MIX_WIDTH),
        'norm_xa': gain(ks[17], (DEPTH, D_MODEL)),
        'norm_mem': gain(ks[18], (DEPTH, D_MODEL)),
        'xa_wq': nrm(ks[19], (DEPTH, D_MODEL, XA_HEADS * XA_DH), D_MODEL),
        'xa_wkv': nrm(ks[20], (DEPTH, D_MODEL, 2 * XA_HEADS * XA_DH), D_MODEL),
        'xa_wo': nrm(ks[21], (DEPTH, XA_HEADS * XA_DH, D_MODEL), XA_HEADS * XA_DH),
        'norm_ffn': gain(ks[22], (DEPTH, D_MODEL)),
        'ffn_w1': nrm(ks[23], (n_dense, D_MODEL, D_FF), D_MODEL),
        'ffn_w3': nrm(ks[24], (n_dense, D_MODEL, D_FF), D_MODEL),
        'ffn_w2': nrm(ks[25], (n_dense, D_FF, D_MODEL), D_FF),
        'router': nrm(ks[26], (n_moe, D_MODEL, N_EXPERTS), D_MODEL),
        'moe_w1': nrm(ks[27], (n_moe, N_EXPERTS, D_MODEL, D_FF_EXPERT), D_MODEL),
        'moe_w3': nrm(ks[28], (n_moe, N_EXPERTS, D_MODEL, D_FF_EXPERT), D_MODEL),
        'moe_w2': nrm(ks[29], (n_moe, N_EXPERTS, D_FF_EXPERT, D_MODEL), D_FF_EXPERT),
    }


def reference(x, mem, rel_bias, final_norm, norm_mix, w_in, gla_wa2, gla_ba, gla_norm,
              pool_w, pool_b, pool_scale, sgu_ln_g, sgu_ln_b, sgu_w, sgu_b, w_out,
              norm_xa, norm_mem, xa_wq, xa_wkv, xa_wo, norm_ffn,
              ffn_w1, ffn_w3, ffn_w2, router, moe_w1, moe_w3, moe_w2):
    h = x
    for i in range(DEPTH):
        h = h + hybrid_mixer(rmsnorm(h, norm_mix[i]), w_in[i], gla_wa2[i], gla_ba[i], gla_norm[i],
                             pool_w[i], pool_b[i], pool_scale[i], sgu_ln_g[i], sgu_ln_b[i],
                             sgu_w[i], sgu_b[i], w_out[i], rel_bias)
        h = h + cross_attn(rmsnorm(h, norm_xa[i]), mem, norm_mem[i], xa_wq[i], xa_wkv[i], xa_wo[i])
        hn = rmsnorm(h, norm_ffn[i])
        j = i // 2
        if i % 2 == 0:
            h = h + swiglu(hn, ffn_w1[j], ffn_w3[j], ffn_w2[j])
        else:
            h = h + moe_swiglu(hn, router[j], moe_w1[j], moe_w3[j], moe_w2[j])
    return rmsnorm(h, final_norm)
```

```cpp
#include <hip/hip_runtime.h>
#include <cstdio>
#include <cstdint>
#include <cmath>

#ifndef N_LAUNCH_MODE
#define N_LAUNCH_MODE 0
#endif

namespace pg8 {
#define PG8_LAS __attribute__((address_space(3)))
typedef unsigned short bf16_t;
typedef short bf16x8 __attribute__((ext_vector_type(8)));
typedef float f32x4 __attribute__((ext_vector_type(4)));
typedef unsigned u32x4 __attribute__((ext_vector_type(4)));
constexpr int BM = 256, BK = 64, HALF = 128, HTB = HALF * BK * 2  , STAGE_BYTES = 8 * HTB, NXCD = 8, WGM = 8;

__host__ __device__ __forceinline__ int lds_byte(int r, int c) { const int st = (r >> 4) * 2 + (c >> 5), rr = r & 15, cc = c & 31, ob = rr * 64 + cc * 2; return st * 1024 + (ob ^ (((ob >> 9) & 1) << 5)); }
__host__ __device__ __forceinline__ void stage_rc(int b, int& R, int& C) { const int st = b / 1024, sb = b % 1024, swz = sb ^ (((sb >> 9) & 1) << 5); R = (st >> 1) * 16 + swz / 64; C = (st & 1) * 32 + (swz % 64) / 2; }
__host__ __device__ __forceinline__ int perm32(int rho) { const int n = rho >> 4, i = rho & 15; return 8 * (i >> 2) + 4 * n + (i & 3); }

struct Unit { int pm, pn, po, e; };
struct Gemm { const bf16_t* A; const bf16_t* Bt; int M, N, K; };

struct StaticOrder {
    int nM, nN, nwg, G, c;
    __host__ __device__ void init(int M, int N, int G_, int c_) { nM = M / BM; nN = N / BM; nwg = nM * nN; G = G_; c = c_; }
    __host__ __device__ bool next(int i, Unit& u) const {
        const long L = (long)i * G + c; if (L >= nwg) return false;
        int wgid = (int)L; { const int q = nwg / NXCD, r = nwg % NXCD, xcd = wgid % NXCD, off = wgid / NXCD; wgid = (xcd < r ? xcd * (q + 1) : r * (q + 1) + (xcd - r) * q) + off; }
        const int nig = WGM * nN, gid = wgid / nig, fm = gid * WGM, gsz = (nM - fm) < WGM ? (nM - fm) : WGM;
        u.pm = fm + ((wgid % nig) % gsz); u.pn = (wgid % nig) / gsz; u.po = u.pm; u.e = u.pn; return true;
    }
    __device__ __forceinline__ void a_ready(const Unit&) const {}
    __device__ __forceinline__ void done(const Unit&) const {}
};
struct MoeOrder {
    int t0, nt, nNe, G, c, a_local; const int* tile_e;
    __device__ bool next(int i, Unit& u) const {
        const long L = (long)i * G + c; if (L >= (long)nt * nNe) return false;
        const int tl = (int)(L % nt), pn = (int)(L / nt), tile = t0 + tl, e = tile_e[tile];
        u.pm = a_local ? tl : tile; u.po = a_local ? tile : tl; u.pn = e * nNe + pn; u.e = pn; return true;
    }
    __device__ __forceinline__ void a_ready(const Unit&) const {}
    __device__ __forceinline__ void done(const Unit&) const {}
};
__device__ __forceinline__ unsigned cvt_pk_bf16(float lo, float hi) { unsigned r; asm volatile("v_cvt_pk_bf16_f32 %0, %1, %2" : "=v"(r) : "v"(lo), "v"(hi)); return r; }
template <class Epi, class Sched, bool ALIGN_EPI = false, bool SP2 = false>
__device__ __forceinline__ void gemm_phase(PG8_LAS unsigned char* lds, const Gemm g, const Sched& S, const Epi& E) {
    int tid_ = threadIdx.x; asm volatile("" : "+v"(tid_)); const int tid = tid_, wid = __builtin_amdgcn_readfirstlane(tid >> 6), lane = tid & 63, wr = wid >> 2, wc = wid & 3, fr = lane & 15, fq = lane >> 4;
    const int K = g.K, nt = K / BK;
    unsigned voffA[2], voffB[2];
#pragma unroll
    for (int i = 0; i < 2; ++i) { int R, C; stage_rc(tid * 16 + i * 8192, R, C); const int Rb = Epi::PERM ? ((R & ~31) + perm32(R & 31)) : R;
        voffA[i] = (unsigned)(R * K + C) * 2u; voffB[i] = (unsigned)(Rb * K + C) * 2u; }
    const size_t kstep = (size_t)(BK * 2);
    const size_t hstep = (size_t)HALF * K * 2;
    const size_t tstep = 2 * hstep;
    const unsigned ldsw = (unsigned)wid * 1024u;
    const int aoff = lds_byte(wr * 64 + fr, fq * 8), boff = lds_byte(wc * 32 + fr, fq * 8);
#define PG8_SA(b, h) (((b) * 2 + (h)) * HTB)
#define PG8_SB(b, h) ((4 + (b) * 2 + (h)) * HTB)
#define PG8_STAGE(bufoff, gbase, voff) do { _Pragma("unroll") for (int _i = 0; _i < 2; ++_i) \
        __builtin_amdgcn_global_load_lds((const unsigned*)((const char*)(gbase) + (voff)[_i]), (PG8_LAS unsigned*)(lds + (bufoff) + ldsw + _i * 8192), 16, 0, 0); } while (0)
#define PG8_LDA(dst, b, h) do { _Pragma("unroll") for (int m = 0; m < 4; ++m) _Pragma("unroll") for (int k = 0; k < 2; ++k) dst[m][k] = *(const PG8_LAS bf16x8*)(lds + PG8_SA(b, h) + aoff + m * 2048 + k * 1024); } while (0)
#define PG8_LDB(dst, b, h) do { _Pragma("unroll") for (int n = 0; n < 2; ++n) _Pragma("unroll") for (int k = 0; k < 2; ++k) dst[n][k] = *(const PG8_LAS bf16x8*)(lds + PG8_SB(b, h) + boff + n * 2048 + k * 1024); } while (0)
#define PG8_MMA(ai, bj, At, Bt) do { __builtin_amdgcn_s_setprio(1); _Pragma("unroll") for (int m = 0; m < 4; ++m) _Pragma("unroll") for (int n = 0; n < 2; ++n) _Pragma("unroll") for (int k = 0; k < 2; ++k) \
        acc[ai][bj][m][n] = __builtin_amdgcn_mfma_f32_16x16x32_bf16(Bt[n][k], At[m][k], acc[ai][bj][m][n], 0, 0, 0); __builtin_amdgcn_s_setprio(0); } while (0)
#define PG8_WAIT_V(n) asm volatile("s_waitcnt vmcnt(" #n ")" ::: "memory")
#define PG8_WAIT_L(n) asm volatile("s_waitcnt lgkmcnt(" #n ")" ::: "memory")
#define PG8_BAR __builtin_amdgcn_s_barrier()
#define PG8_SCHED __builtin_amdgcn_sched_barrier(0)
    Unit cur, nxt; int ui = 0;
    if (!S.next(0, cur)) return;
    f32x4 acc[2][2][4][2];
#pragma unroll
    for (int a = 0; a < 2; ++a)
#pragma unroll
        for (int b = 0; b < 2; ++b)
#pragma unroll
            for (int m = 0; m < 4; ++m)
#pragma unroll
                for (int n = 0; n < 2; ++n) acc[a][b][m][n] = (f32x4){0.f, 0.f, 0.f, 0.f};
    bf16x8 At[4][2], B0[2][2], B1[2][2];
    const char* cA = (const char*)g.A + (size_t)cur.pm * tstep; const char* cB = (const char*)g.Bt + (size_t)cur.pn * tstep;
    S.a_ready(cur);
    if constexpr (SP2) {
        PG8_STAGE(PG8_SB(0, 0), cB, voffB); PG8_STAGE(PG8_SB(0, 1), cB + hstep, voffB); PG8_STAGE(PG8_SA(0, 0), cA, voffA); PG8_STAGE(PG8_SA(0, 1), cA + hstep, voffA);
        if (wr == 1) PG8_BAR;
        PG8_WAIT_V(2); PG8_BAR;
        PG8_STAGE(PG8_SB(1, 0), cB + kstep, voffB); PG8_STAGE(PG8_SA(1, 0), cA + kstep, voffA); PG8_STAGE(PG8_SB(1, 1), cB + hstep + kstep, voffB);
        PG8_WAIT_V(6); PG8_BAR;
    } else {
        PG8_STAGE(PG8_SB(0, 0), cB, voffB); PG8_STAGE(PG8_SA(0, 0), cA, voffA); PG8_STAGE(PG8_SB(0, 1), cB + hstep, voffB); PG8_STAGE(PG8_SA(0, 1), cA + hstep, voffA);
        if (wr == 1) PG8_BAR;
        PG8_WAIT_V(4); PG8_BAR;
        PG8_STAGE(PG8_SB(1, 0), cB + kstep, voffB); PG8_STAGE(PG8_SA(1, 0), cA + kstep, voffA); PG8_STAGE(PG8_SB(1, 1), cB + hstep + kstep, voffB);
        PG8_WAIT_V(6); PG8_BAR;
    }
    for (;;) {
        const bool has_next = S.next(ui + 1, nxt);
        const char* nA = has_next ? (const char*)g.A + (size_t)nxt.pm * tstep : cA; const char* nB = has_next ? (const char*)g.Bt + (size_t)nxt.pn * tstep : cB;
        for (int t = 0; t < nt; t += 2) {
            const bool last = (t == nt - 2);
            const char* a1 = cA + (size_t)(t + 1) * kstep;
            const char* a2 = last ? nA : cA + (size_t)(t + 2) * kstep; const char* b2 = last ? nB : cB + (size_t)(t + 2) * kstep;
            const char* a3 = a2 + kstep; const char* b3 = b2 + kstep;
            if (last && has_next) S.a_ready(nxt);
            if constexpr (SP2) {
            PG8_LDB(B0, 0, 0); PG8_LDB(B1, 0, 1); PG8_SCHED; PG8_LDA(At, 0, 0); PG8_STAGE(PG8_SA(1, 1), a1 + hstep, voffA);
            PG8_WAIT_V(8); PG8_WAIT_L(0); PG8_BAR; PG8_MMA(0, 0, At, B0); PG8_MMA(0, 1, At, B1); PG8_BAR; PG8_SCHED;
            PG8_LDA(At, 0, 1); PG8_STAGE(PG8_SB(0, 0), b2, voffB); PG8_STAGE(PG8_SB(0, 1), b2 + hstep, voffB); PG8_STAGE(PG8_SA(0, 0), a2, voffA);
            PG8_WAIT_V(8); PG8_WAIT_L(0); PG8_BAR; PG8_MMA(1, 0, At, B0); PG8_MMA(1, 1, At, B1); PG8_BAR; PG8_SCHED;
            PG8_LDB(B0, 1, 0); PG8_LDB(B1, 1, 1); PG8_SCHED; PG8_LDA(At, 1, 0); PG8_STAGE(PG8_SA(0, 1), a2 + hstep, voffA);
            PG8_WAIT_V(8); PG8_WAIT_L(0); PG8_BAR; PG8_MMA(0, 0, At, B0); PG8_MMA(0, 1, At, B1); PG8_BAR; PG8_SCHED;
            PG8_LDA(At, 1, 1); PG8_STAGE(PG8_SB(1, 0), b3, voffB); PG8_STAGE(PG8_SB(1, 1), b3 + hstep, voffB); PG8_STAGE(PG8_SA(1, 0), a3, voffA);
            PG8_WAIT_V(8); PG8_WAIT_L(0); PG8_BAR; PG8_MMA(1, 0, At, B0); PG8_MMA(1, 1, At, B1); PG8_BAR; PG8_SCHED;
            } else {
            PG8_LDB(B0, 0, 0); PG8_SCHED; PG8_LDA(At, 0, 0); PG8_STAGE(PG8_SA(1, 1), a1 + hstep, voffA);
            PG8_WAIT_L(8); PG8_BAR; PG8_WAIT_L(0); PG8_MMA(0, 0, At, B0); PG8_BAR; PG8_SCHED;
            PG8_LDB(B1, 0, 1); PG8_STAGE(PG8_SB(0, 0), b2, voffB);
            PG8_BAR; PG8_WAIT_L(0); PG8_MMA(0, 1, At, B1); PG8_BAR;
            PG8_LDA(At, 0, 1); PG8_STAGE(PG8_SA(0, 0), a2, voffA);
            PG8_BAR; PG8_WAIT_L(0); PG8_MMA(1, 0, At, B0); PG8_BAR; PG8_SCHED;
            PG8_STAGE(PG8_SB(0, 1), b2 + hstep, voffB);
            PG8_WAIT_V(6); PG8_BAR; PG8_MMA(1, 1, At, B1); PG8_BAR;
            PG8_LDB(B0, 1, 0); PG8_SCHED; PG8_LDA(At, 1, 0); PG8_STAGE(PG8_SA(0, 1), a2 + hstep, voffA);
            PG8_WAIT_L(8); PG8_BAR; PG8_WAIT_L(0); PG8_MMA(0, 0, At, B0); PG8_BAR; PG8_SCHED;
            PG8_LDB(B1, 1, 1); PG8_STAGE(PG8_SB(1, 0), b3, voffB);
            PG8_BAR; PG8_WAIT_L(0); PG8_MMA(0, 1, At, B1); PG8_BAR;
            PG8_LDA(At, 1, 1); PG8_STAGE(PG8_SA(1, 0), a3, voffA);
            PG8_BAR; PG8_WAIT_L(0); PG8_MMA(1, 0, At, B0); PG8_BAR; PG8_SCHED;
            PG8_STAGE(PG8_SB(1, 1), b3 + hstep, voffB);
            PG8_WAIT_V(6); PG8_BAR; PG8_MMA(1, 1, At, B1); PG8_BAR;
            }
        }
        if constexpr (ALIGN_EPI) { if (wr == 0) PG8_BAR; }
        if constexpr (!Epi::AFTER_DRAIN) { E(acc, cur, wr, wc, fr, fq); S.done(cur); }
        if (!has_next) break;
#pragma unroll
        for (int a = 0; a < 2; ++a)
#pragma unroll
            for (int b = 0; b < 2; ++b)
#pragma unroll
                for (int m = 0; m < 4; ++m)
#pragma unroll
                    for (int n = 0; n < 2; ++n) acc[a][b][m][n] = (f32x4){0.f, 0.f, 0.f, 0.f};
        cur = nxt; cA = nA; cB = nB; ++ui;
        if constexpr (ALIGN_EPI) { if (wr == 1) PG8_BAR; }
    }
    PG8_WAIT_V(0);
    if constexpr (!ALIGN_EPI) { if (wr == 0) PG8_BAR; }
    PG8_BAR;
    if constexpr (Epi::AFTER_DRAIN) { E.fused(acc, cur, wr, wc, fr, fq, lds, wid, lane); S.done(cur); }
#undef PG8_SA
#undef PG8_SB
#undef PG8_STAGE
#undef PG8_LDA
#undef PG8_LDB
#undef PG8_MMA
#undef PG8_WAIT_V
#undef PG8_WAIT_L
#undef PG8_BAR
#undef PG8_SCHED
}
}

constexpr int BATCH = 8, T = 2048, D = 1024, M = BATCH * T, MEMLEN = 256, MM = BATCH * MEMLEN;
constexpr int INW = 2616, ZW = 2816;
constexpr int DFF = 2816, NEXP = 8, DFE = 3584;
constexpr float EPS = 1e-6f;
constexpr int Z_AQ = 0, Z_AK = 128, Z_AV = 256, Z_AG = 512, Z_ALR = 768, Z_BU = 784, Z_CQ = 1040, Z_CK = 1296, Z_CV = 1552, Z_CQI = 1808, Z_CKI = 2064, Z_CWI = 2096, Z_DUV = 2104;
constexpr int NWAVES = 8, NTHR = 512;
constexpr int MOE_TP = 34, MOE_NPASS = 4, MOE_MAXT = MOE_TP * MOE_NPASS;
constexpr int MAXSLOT = MOE_MAXT * 256;

constexpr size_t MiB = 1u << 20;
constexpr size_t al(size_t x) { return (x + 4095) & ~(size_t)4095; }
constexpr size_t WS_CTL = 0, CTL_ZERO_BYTES = 1 * MiB;
constexpr size_t WS_SS = 1 * MiB;
constexpr size_t WS_SSM = WS_SS + al((size_t)M * 16 * 4);
constexpr size_t WS_TOKE = WS_SSM + al((size_t)MM * 16 * 4);
constexpr size_t WS_TOKG = WS_TOKE + al((size_t)M * 8);
constexpr size_t WS_TOKR = WS_TOKG + al((size_t)M * 8);
constexpr size_t WS_TOKS = WS_TOKR + al((size_t)M * 4);
constexpr size_t WS_CNT = WS_TOKS + al((size_t)M * 8);
constexpr size_t WS_TILEE = WS_CNT + al(256 * 8 * 4);
constexpr size_t WS_SLOTR = WS_TILEE + al(160 * 4);
constexpr size_t WS_SLOTG = WS_SLOTR + al((size_t)MAXSLOT * 4);
constexpr size_t WS_WIN = al(WS_SLOTG + (size_t)MAXSLOT * 4 + MiB);
constexpr size_t SZ_WIN = (size_t)ZW * D * 2, SZ_WOUT = (size_t)D * D * 2, SZ_WQ = (size_t)256 * D * 2, SZ_WKV = (size_t)512 * D * 2, SZ_WO = (size_t)D * 256 * 2;
constexpr size_t WS_WOUT = WS_WIN + 2 * SZ_WIN, WS_WQ = WS_WOUT + 2 * SZ_WOUT, WS_WKV = WS_WQ + 2 * SZ_WQ, WS_WO = WS_WKV + 2 * SZ_WKV;
constexpr size_t WS_W13 = WS_WO + 2 * SZ_WO, WS_W2 = WS_W13 + (size_t)2 * DFF * D * 2, WS_MW13 = WS_W2 + (size_t)D * DFF * 2;
constexpr size_t WS_MW2 = WS_MW13 + (size_t)NEXP * 2 * DFE * D * 2, WS_KVM = WS_MW2 + (size_t)NEXP * D * DFE * 2;
constexpr size_t SZ_KVM = (size_t)MM * 512 * 2;
constexpr size_t WS_MEMB = WS_KVM + 2 * SZ_KVM;
constexpr size_t WS_ACT = al(WS_MEMB + (size_t)MM * D * 2);
constexpr size_t WS_HB = WS_ACT, WS_Z = WS_HB + (size_t)M * D * 2, WS_MIX = WS_Z + (size_t)M * ZW * 2, WS_QX = WS_MIX + (size_t)M * D * 2, WS_OX = WS_QX + (size_t)M * 256 * 2;
constexpr size_t WS_GOI = WS_OX + (size_t)M * 256 * 2, WS_GQT = WS_GOI + (size_t)M * 256 * 4, WS_GKV = WS_GQT + (size_t)M * 128 * 4, WS_GDEC = WS_GKV + (size_t)1024 * 2048 * 4;
constexpr size_t WS_ACT_END = WS_GDEC + (size_t)1024 * 32 * 4;
constexpr size_t WS_FACT = WS_Z;
constexpr size_t WS_MACT = WS_ACT, SZ_MACT = (size_t)MOE_TP * 256 * DFE * 2;
constexpr size_t WS_AG = WS_MACT + SZ_MACT, WS_YS = WS_AG + (size_t)MAXSLOT * D * 2, WS_MOE_END = WS_YS + (size_t)MAXSLOT * D * 2;
static_assert(WS_AG >= WS_HB + (size_t)M * D * 2, "AG must not overlay HB");
static_assert(WS_MOE_END <= WS_ACT_END, "MoE overlays fit");
constexpr size_t WS_END = WS_ACT_END;
constexpr int CW_BAR = 4096;

constexpr int LDS_BYTES = 147456;
constexpr int MISC_OFF = 147456 - 128;
constexpr int SCR_BYTES = MISC_OFF;

#define GAS __attribute__((address_space(1)))
#define LAS __attribute__((address_space(3)))
typedef unsigned short bf16;
typedef unsigned v4u __attribute__((ext_vector_type(4)));
typedef unsigned v2u __attribute__((ext_vector_type(2)));
typedef float f32x4 __attribute__((ext_vector_type(4)));
typedef GAS unsigned gu32;
#define RLX_AGENT __ATOMIC_RELAXED, __HIP_MEMORY_SCOPE_AGENT
#define LDS_WAIT() asm volatile("s_waitcnt lgkmcnt(0)" ::: "memory")
#define LDS_ADD(p, v) (void)__hip_atomic_fetch_add((p), (v), __ATOMIC_RELAXED, __HIP_MEMORY_SCOPE_WORKGROUP)
__device__ __forceinline__ unsigned f2bf(float f) { unsigned u = __builtin_bit_cast(unsigned, f); return (u + 0x7fffu + ((u >> 16) & 1u)) >> 16; }
__device__ __forceinline__ unsigned pk2(float lo, float hi) { return f2bf(lo) | (f2bf(hi) << 16); }
__device__ __forceinline__ float bflo(unsigned w) { return __builtin_bit_cast(float, w << 16); }
__device__ __forceinline__ float bfhi(unsigned w) { return __builtin_bit_cast(float, w & 0xffff0000u); }
__device__ __forceinline__ float bf1(bf16 b) { return __builtin_bit_cast(float, ((unsigned)b) << 16); }
__device__ __forceinline__ float wave_sum(float v) {
#pragma unroll
    for (int o = 1; o < 64; o <<= 1) v += __shfl_xor(v, o);
    return v;
}
__device__ __forceinline__ float wave_max(float v) {
#pragma unroll
    for (int o = 1; o < 64; o <<= 1) v = fmaxf(v, __shfl_xor(v, o));
    return v;
}
#define XB_TMO      128
#define XB_XCNT(j)  (256  + 64 * (j))
#define XB_XSUB(j)  (1280 + 64 * (j))
#define XB_XGEN(j)  (2304 + 64 * (j))
#define XB_TOP      3328
#define XB_TOPGEN   3392
#define XCD_BAR_WORDS 3456
#define XB_SPIN_CAP (1u << 18)

__device__ __forceinline__ unsigned xb_ld(unsigned* p)              { return __hip_atomic_load(p, __ATOMIC_RELAXED, __HIP_MEMORY_SCOPE_AGENT); }
__device__ __forceinline__ unsigned xb_add(unsigned* p, unsigned v) { return __hip_atomic_fetch_add(p, v, __ATOMIC_RELAXED, __HIP_MEMORY_SCOPE_AGENT); }
__device__ __forceinline__ unsigned xb_xcc_id() { return (unsigned)__builtin_amdgcn_s_getreg((3 << 11) | 20) & 0xFu; }
#define XB_SPIN(cond, bar) do { unsigned _sp = 0; while (cond) { __builtin_amdgcn_s_sleep(1); \
    if ((++_sp & 255u) == 0u) { if (xb_ld(&(bar)[XB_TMO])) break; if (_sp > XB_SPIN_CAP) { atomicAdd(&(bar)[XB_TMO], 1u); break; } } } } while (0)

struct XcdBarrier {
    unsigned* bar; unsigned x;
    volatile LAS unsigned* st;
};

__device__ __forceinline__ XcdBarrier xcd_barrier_post(unsigned* bar, volatile LAS unsigned* st) {
    XcdBarrier b; b.bar = bar; b.x = xb_xcc_id(); b.st = st;
    if (threadIdx.x == 0) (void)xb_add(&bar[XB_XCNT(b.x)], 1u);
    return b;
}
__device__ __forceinline__ void xcd_barrier_complete(unsigned* bar, unsigned x, unsigned& nloc, unsigned& nx) {
    const unsigned G = gridDim.x * gridDim.y * gridDim.z;
    unsigned sum, cnt, mine, sp = 0u;
    for (;;) {
        sum = 0u; cnt = 0u; mine = 0u;
#pragma unroll
        for (unsigned j = 0; j < 16; ++j) { const unsigned c = xb_ld(&bar[XB_XCNT(j)]); sum += c; cnt += (c > 0u) ? 1u : 0u; mine = (j == x) ? c : mine; }
        if (sum == G) break;
        __builtin_amdgcn_s_sleep(1);
        if ((++sp & 255u) == 0u) { if (xb_ld(&bar[XB_TMO])) break; if (sp > XB_SPIN_CAP) { atomicAdd(&bar[XB_TMO], 1u); break; } }
    }
    nloc = mine > 0u ? mine : 1u; nx = cnt > 0u ? cnt : 1u;
}

__device__ __forceinline__ void xcd_barrier(const XcdBarrier& b) {
    asm volatile("s_waitcnt vmcnt(0)" ::: "memory");
    __syncthreads();
    if (threadIdx.x == 0) {
        unsigned* bar = b.bar;
        __builtin_amdgcn_s_waitcnt(0);
        unsigned nloc = b.st[0], nx = b.st[1];
        if (nloc == 0u) { xcd_barrier_complete(bar, b.x, nloc, nx); b.st[0] = nloc; b.st[1] = nx; }
        const unsigned old = xb_add(&bar[XB_XSUB(b.x)], 1u);
        const unsigned gen = old / nloc;
        if (old + 1u == (gen + 1u) * nloc) {
            __builtin_amdgcn_fence(__ATOMIC_RELEASE, "agent");
            asm volatile("s_waitcnt vmcnt(0)" ::: "memory");
            const unsigned og = xb_add(&bar[XB_TOP], 1u);
            const unsigned tg = og / nx;
            if (og + 1u == (tg + 1u) * nx) xb_add(&bar[XB_TOPGEN], 1u);
            else XB_SPIN(xb_ld(&bar[XB_TOPGEN]) == tg, bar);
            __builtin_amdgcn_fence(__ATOMIC_ACQUIRE, "agent");
            xb_add(&bar[XB_XGEN(b.x)], 1u);
            asm volatile("s_waitcnt vmcnt(0)" ::: "memory");
        } else {
            XB_SPIN(xb_ld(&bar[XB_XGEN(b.x)]) == gen, bar);
            __builtin_amdgcn_fence(__ATOMIC_ACQUIRE, "agent");
            asm volatile("s_waitcnt vmcnt(0)" ::: "memory");
        }
    }
    __syncthreads();
}

enum { IN_X = 0, IN_MEM, IN_RELB, IN_FNORM, IN_NMIX, IN_WIN, IN_WA2, IN_BA, IN_GNORM, IN_PW, IN_PB, IN_PS, IN_LNG, IN_LNB, IN_SW, IN_SB, IN_WOUT,
       IN_NXA, IN_NMEM, IN_WQ, IN_WKV, IN_WO, IN_NFFN, IN_F1, IN_F3, IN_F2, IN_ROUTER, IN_M1, IN_M3, IN_M2, N_IN };
struct Args { const float* in[N_IN]; float* out; unsigned char* ws; int ph_lo, ph_hi; };

__device__ __forceinline__ float rstd16(const float* ss, int row) {
    const f32x4* p = (const f32x4*)(ss + (size_t)row * 16);
    const f32x4 a = p[0], b = p[1], c = p[2], d = p[3];
    const float s = (((a.x + a.y) + (a.z + a.w)) + ((b.x + b.y) + (b.z + b.w))) + (((c.x + c.y) + (c.z + c.w)) + ((d.x + d.y) + (d.z + d.w)));
    return rsqrtf(s * (1.0f / 1024.0f) + EPS);
}
__device__ __forceinline__ v4u pack8(const f32x4 a, const f32x4 b) { v4u w; w.x = pg8::cvt_pk_bf16(a.x, a.y); w.y = pg8::cvt_pk_bf16(a.z, a.w); w.z = pg8::cvt_pk_bf16(b.x, b.y); w.w = pg8::cvt_pk_bf16(b.z, b.w); return w; }

struct EpiScale {
    static constexpr bool PERM = true, AFTER_DRAIN = false;
    bf16* O; int ldc; const float* ss; float scale;
    __device__ __forceinline__ void operator()(const pg8::f32x4 (&acc)[2][2][4][2], const pg8::Unit& u, int wr, int wc, int fr, int fq) const {
        const int row0 = u.po * 256 + wr * 64 + fr, col0 = u.e * 256 + wc * 32 + 8 * fq;
#pragma unroll
        for (int ai = 0; ai < 2; ++ai)
#pragma unroll
            for (int m = 0; m < 4; ++m) { const int row = row0 + ai * 128 + m * 16; const float r = rstd16(ss, row) * scale; bf16* rowp = O + (size_t)row * ldc + col0;
#pragma unroll
                for (int bj = 0; bj < 2; ++bj) *(v4u*)(rowp + bj * 128) = pack8(acc[ai][bj][m][0] * r, acc[ai][bj][m][1] * r); }
    }
};
struct EpiResid {
    static constexpr bool PERM = true, AFTER_DRAIN = false;
    const float* res; float* H; bf16* HB; float* SS;
    __device__ __forceinline__ void operator()(const pg8::f32x4 (&acc)[2][2][4][2], const pg8::Unit& u, int wr, int wc, int fr, int fq) const {
        const int row0 = u.po * 256 + wr * 64 + fr, col0 = u.e * 256 + wc * 32 + 8 * fq;
#pragma unroll
        for (int ai = 0; ai < 2; ++ai)
#pragma unroll
            for (int m = 0; m < 4; ++m) { const int row = row0 + ai * 128 + m * 16; const size_t off = (size_t)row * D + col0; float q = 0.f;
#pragma unroll
                for (int bj = 0; bj < 2; ++bj) {
                    const f32x4 r0 = *(const f32x4*)(res + off + bj * 128), r1 = *(const f32x4*)(res + off + bj * 128 + 4);
                    const f32x4 v0 = acc[ai][bj][m][0] + r0, v1 = acc[ai][bj][m][1] + r1;
                    *(f32x4*)(H + off + bj * 128) = v0; *(f32x4*)(H + off + bj * 128 + 4) = v1;
                    *(v4u*)(HB + off + bj * 128) = pack8(v0, v1);
                    q += ((v0.x * v0.x + v0.y * v0.y) + (v0.z * v0.z + v0.w * v0.w)) + ((v1.x * v1.x + v1.y * v1.y) + (v1.z * v1.z + v1.w * v1.w)); }
                q += __shfl_xor(q, 16); q += __shfl_xor(q, 32);
                if (fq == 0) SS[(size_t)row * 16 + u.e * 4 + wc] = q; }
    }
};
__device__ __forceinline__ float silu_f(float x) { return x * __builtin_amdgcn_rcpf(1.0f + __expf(-x)); }
template <bool MOE> struct EpiSwiglu {
    static constexpr bool PERM = true, AFTER_DRAIN = false;
    bf16* O; int ldc; const float* ss; const float* slot_r; const float* slot_g;
    __device__ __forceinline__ void operator()(const pg8::f32x4 (&acc)[2][2][4][2], const pg8::Unit& u, int wr, int wc, int fr, int fq) const {
        const int rin0 = u.pm * 256 + wr * 64 + fr, rout0 = u.po * 256 + wr * 64 + fr, col0 = u.e * 128 + wc * 32 + 8 * fq;
#pragma unroll
        for (int ai = 0; ai < 2; ++ai)
#pragma unroll
            for (int m = 0; m < 4; ++m) { const int rin = rin0 + ai * 128 + m * 16, rout = rout0 + ai * 128 + m * 16;
                float r, gt; if (MOE) { r = slot_r[rin]; gt = slot_g[rin]; } else { r = rstd16(ss, rin); gt = 1.0f; }
                f32x4 o0, o1;
#pragma unroll
                for (int j = 0; j < 4; ++j) { o0[j] = silu_f(acc[ai][0][m][0][j] * r) * (acc[ai][1][m][0][j] * r) * gt; o1[j] = silu_f(acc[ai][0][m][1][j] * r) * (acc[ai][1][m][1][j] * r) * gt; }
                *(v4u*)(O + (size_t)rout * ldc + col0) = pack8(o0, o1); }
    }
};
struct EpiPlain {
    static constexpr bool PERM = true, AFTER_DRAIN = false;
    bf16* O; int ldc;
    __device__ __forceinline__ void operator()(const pg8::f32x4 (&acc)[2][2][4][2], const pg8::Unit& u, int wr, int wc, int fr, int fq) const {
        const int row0 = u.po * 256 + wr * 64 + fr, col0 = u.e * 256 + wc * 32 + 8 * fq;
#pragma unroll
        for (int ai = 0; ai < 2; ++ai)
#pragma unroll
            for (int m = 0; m < 4; ++m) { bf16* rowp = O + (size_t)(row0 + ai * 128 + m * 16) * ldc + col0;
#pragma unroll
                for (int bj = 0; bj < 2; ++bj) *(v4u*)(rowp + bj * 128) = pack8(acc[ai][bj][m][0], acc[ai][bj][m][1]); }
    }
};

__device__ __forceinline__ void tr_item(const float* W, int N, int K, int k0, int n0, const float* gain, bf16* WT, long dst_row0, LAS float* scr, int lane) {
    const int nn = n0 + (lane & 31);
#pragma unroll 8
    for (int i = 0; i < 32; ++i) { const int kk = 2 * i + (lane >> 5); float v = (nn < N) ? W[(size_t)(k0 + kk) * N + nn] : 0.f; if (gain) v *= gain[k0 + kk]; scr[kk * 33 + (lane & 31)] = v; }
    LDS_WAIT(); asm volatile("" ::: "memory");
    const int c = lane & 7;
#pragma unroll
    for (int j = 0; j < 4; ++j) { const int n = (lane >> 3) + 8 * j; const LAS float* s = scr + (8 * c) * 33 + n;
        v4u o; o.x = pk2(s[0 * 33], s[1 * 33]); o.y = pk2(s[2 * 33], s[3 * 33]); o.z = pk2(s[4 * 33], s[5 * 33]); o.w = pk2(s[6 * 33], s[7 * 33]);
        if (n0 + n < N) *(v4u*)(WT + (size_t)(dst_row0 + n) * K + k0 + 8 * c) = o; }
    LDS_WAIT(); asm volatile("" ::: "memory");
}
__device__ __forceinline__ void conv_job(const float* W, int K, int N, const float* gain, bf16* WT, int mode, LAS float* scr, int gw, int NGW, int lane, long& base) {
    const int nblk = (N + 31) / 32, nitems = (K / 64) * nblk;
    const int first = (int)(((long)gw - (base % NGW) + NGW) % NGW);
    for (int it = first; it < nitems; it += NGW) {
        const int kb = it / nblk, nb = it % nblk, k0 = 64 * kb, n0 = 32 * nb;
        const long dr = (mode == 0) ? (long)n0 : (long)(n0 >> 7) * 256 + (n0 & 127) + (mode == 2 ? 128 : 0);
        tr_item(W, N, K, k0, n0, gain, WT, dr, scr, lane);
    }
    base += nitems;
}
__device__ __forceinline__ void row_cvt(const float* xrow, bf16* orow, float* ssrow, int lane) {
    const f32x4* xr = (const f32x4*)xrow + lane; f32x4 v[4]; float s = 0.f;
#pragma unroll
    for (int j = 0; j < 4; ++j) { v[j] = xr[64 * j]; s += (v[j].x * v[j].x + v[j].y * v[j].y) + (v[j].z * v[j].z + v[j].w * v[j].w); }
    s = wave_sum(s);
    v2u* o8 = (v2u*)orow + lane;
#pragma unroll
    for (int j = 0; j < 4; ++j) { v2u w; w.x = pk2(v[j].x, v[j].y); w.y = pk2(v[j].z, v[j].w); o8[64 * j] = w; }
    if (lane < 16) ssrow[lane] = lane == 0 ? s : 0.f;
}
__device__ __forceinline__ void p0_prologue(const Args& a, LAS unsigned char* lds, int tid, int G) {
    const int lane = tid & 63, wave = tid >> 6, gw = blockIdx.x * NWAVES + wave, NGW = G * NWAVES;
    LAS float* scr = (LAS float*)(lds + wave * 16384);
    unsigned char* ws = a.ws; long base = 0;
    for (int l = 0; l < 2; ++l) {
        conv_job(a.in[IN_WIN] + (size_t)l * D * INW, D, INW, a.in[IN_NMIX] + l * D, (bf16*)(ws + WS_WIN + l * SZ_WIN), 0, scr, gw, NGW, lane, base);
        conv_job(a.in[IN_WOUT] + (size_t)l * D * D, D, D, nullptr, (bf16*)(ws + WS_WOUT + l * SZ_WOUT), 0, scr, gw, NGW, lane, base);
        conv_job(a.in[IN_WQ] + (size_t)l * D * 256, D, 256, a.in[IN_NXA] + l * D, (bf16*)(ws + WS_WQ + l * SZ_WQ), 0, scr, gw, NGW, lane, base);
        conv_job(a.in[IN_WKV] + (size_t)l * D * 512, D, 512, a.in[IN_NMEM] + l * D, (bf16*)(ws + WS_WKV + l * SZ_WKV), 0, scr, gw, NGW, lane, base);
        conv_job(a.in[IN_WO] + (size_t)l * 256 * D, 256, D, nullptr, (bf16*)(ws + WS_WO + l * SZ_WO), 0, scr, gw, NGW, lane, base);
        { v4u* zp = (v4u*)(ws + WS_WIN + l * SZ_WIN + (size_t)INW * D * 2); const int n16 = (ZW - INW) * D * 2 / 16;
          for (int i = blockIdx.x * NTHR + tid; i < n16; i += G * NTHR) zp[i] = (v4u){0u, 0u, 0u, 0u}; }
    }
    conv_job(a.in[IN_F1], D, DFF, a.in[IN_NFFN], (bf16*)(ws + WS_W13), 1, scr, gw, NGW, lane, base);
    conv_job(a.in[IN_F3], D, DFF, a.in[IN_NFFN], (bf16*)(ws + WS_W13), 2, scr, gw, NGW, lane, base);
    conv_job(a.in[IN_F2], DFF, D, nullptr, (bf16*)(ws + WS_W2), 0, scr, gw, NGW, lane, base);
    for (int e = 0; e < NEXP; ++e) {
        conv_job(a.in[IN_M1] + (size_t)e * D * DFE, D, DFE, a.in[IN_NFFN] + D, (bf16*)(ws + WS_MW13) + (size_t)e * 2 * DFE * D, 1, scr, gw, NGW, lane, base);
        conv_job(a.in[IN_M3] + (size_t)e * D * DFE, D, DFE, a.in[IN_NFFN] + D, (bf16*)(ws + WS_MW13) + (size_t)e * 2 * DFE * D, 2, scr, gw, NGW, lane, base);
        conv_job(a.in[IN_M2] + (size_t)e * DFE * D, DFE, D, nullptr, (bf16*)(ws + WS_MW2) + (size_t)e * D * DFE, 0, scr, gw, NGW, lane, base);
    }
    for (int m = gw; m < M; m += NGW) row_cvt(a.in[IN_X] + (size_t)m * D, (bf16*)(ws + WS_HB) + (size_t)m * D, (float*)(ws + WS_SS) + (size_t)m * 16, lane);
    for (int m = gw; m < MM; m += NGW) row_cvt(a.in[IN_MEM] + (size_t)m * D, (bf16*)(ws + WS_MEMB) + (size_t)m * D, (float*)(ws + WS_SSM) + (size_t)m * 16, lane);
}

__device__ __forceinline__ float gelu_tanh(float x) { return 0.5f * x * (1.0f + tanhf(0.7978845608028654f * (x + 0.044715f * x * x * x))); }

__device__ __forceinline__ void gla_a_item(const Args& a, int l, int item, LAS unsigned char* lds, int tid) {
    const int n = item & 31, h = (item >> 5) & 3, b = item >> 7, tok0 = b * T + n * 64;
    LAS float* alr = (LAS float*)lds;
    LAS float* wa = alr + 64 * 16;
    LAS float* bb = wa + 16 * 32;
    LAS float* qt = bb + 64 * 33;
    LAS float* kt = qt + 64 * 33;
    LAS float* kd = kt + 64 * 33;
    LAS float* vv = kd + 64 * 33;
    LAS float* att = vv + 64 * 64;
    LAS float* bav = att + 64 * 65;
    const bf16* z = (const bf16*)(a.ws + WS_Z);
    float* OI = (float*)(a.ws + WS_GOI); float* QT = (float*)(a.ws + WS_GQT); float* KV = (float*)(a.ws + WS_GKV); float* DEC = (float*)(a.ws + WS_GDEC);
    for (int i = tid; i < 1024; i += NTHR) alr[i] = bf1(z[(size_t)(tok0 + (i >> 4)) * ZW + Z_ALR + (i & 15)]);
    { const int r = tid >> 5, k = tid & 31; wa[tid] = a.in[IN_WA2][(size_t)l * 16 * 128 + r * 128 + h * 32 + k]; }
    if (tid < 32) bav[tid] = a.in[IN_BA][l * 128 + h * 32 + tid];
    for (int i = tid; i < 4096; i += NTHR) vv[i] = bf1(z[(size_t)(tok0 + (i >> 6)) * ZW + Z_AV + h * 64 + (i & 63)]);
    __syncthreads();
    for (int i = tid; i < 2048; i += NTHR) { const int c = i >> 5, k = i & 31; float x = bav[k];
#pragma unroll
        for (int r = 0; r < 16; ++r) x += alr[c * 16 + r] * wa[r * 32 + k];
        const float ls = fminf(x, 0.f) - log1pf(expf(-fabsf(x)));
        bb[c * 33 + k] = ls * (1.0f / 16.0f); }
    __syncthreads();
    if (tid < 32) { float run = 0.f; for (int c = 0; c < 64; ++c) { run += bb[c * 33 + tid]; bb[c * 33 + tid] = run; } }
    __syncthreads();
    for (int i = tid; i < 2048; i += NTHR) { const int c = i >> 5, k = i & 31; const float bv = bb[c * 33 + k], bl = bb[63 * 33 + k];
        const float q = bf1(z[(size_t)(tok0 + c) * ZW + Z_AQ + h * 32 + k]), kk = bf1(z[(size_t)(tok0 + c) * ZW + Z_AK + h * 32 + k]);
        const float qv = q * 0.17677669529663687f * expf(bv);
        qt[c * 33 + k] = qv; kt[c * 33 + k] = kk * expf(-bv); kd[c * 33 + k] = kk * expf(bl - bv);
        QT[(size_t)(tok0 + c) * 128 + h * 32 + k] = qv; }
    if (tid < 32) DEC[(size_t)item * 32 + tid] = expf(bb[63 * 33 + tid]);
    __syncthreads();
    for (int idx = tid; idx < 4096; idx += NTHR) { const int i = idx >> 6, j = idx & 63; float s = 0.f;
        if (j <= i) {
#pragma unroll 8
            for (int k = 0; k < 32; ++k) s += qt[i * 33 + k] * kt[j * 33 + k]; }
        att[i * 65 + j] = s; }
    __syncthreads();
    for (int idx = tid; idx < 4096; idx += NTHR) { const int i = idx >> 6, v = idx & 63; float s = 0.f;
#pragma unroll 8
        for (int j = 0; j < 64; ++j) s += att[i * 65 + j] * vv[j * 64 + v];
        OI[(size_t)(tok0 + i) * 256 + h * 64 + v] = s; }
    for (int idx = tid; idx < 2048; idx += NTHR) { const int k = idx >> 6, v = idx & 63; float s = 0.f;
#pragma unroll 8
        for (int c = 0; c < 64; ++c) s += kd[c * 33 + k] * vv[c * 64 + v];
        KV[(size_t)item * 2048 + idx] = s; }
    __syncthreads();
}
__device__ __forceinline__ void gla_c_item(const Args& a, int l, int item, LAS unsigned char* lds, int tid) {
    const int n = item & 31, h = (item >> 5) & 3, b = item >> 7, tok0 = b * T + n * 64, lane = tid & 63, w = tid >> 6;
    LAS float* S = (LAS float*)lds;
    LAS float* ql = S + 2048;
    const bf16* z = (const bf16*)(a.ws + WS_Z); bf16* mix = (bf16*)(a.ws + WS_MIX);
    const float* OI = (const float*)(a.ws + WS_GOI); const float* QT = (const float*)(a.ws + WS_GQT); const float* KV = (const float*)(a.ws + WS_GKV); const float* DEC = (const float*)(a.ws + WS_GDEC);
    for (int e = tid; e < 2048; e += NTHR) { const int k = e >> 6; float s = 0.f;
        for (int m = 0; m < n; ++m) { const size_t it = (size_t)(item - n + m); s = s * DEC[it * 32 + k] + KV[it * 2048 + e]; }
        S[e] = s; }
    for (int i = tid; i < 2048; i += NTHR) ql[(i >> 5) * 33 + (i & 31)] = QT[(size_t)(tok0 + (i >> 5)) * 128 + h * 32 + (i & 31)];
    __syncthreads();
    for (int j = 0; j < 8; ++j) { const int i = w + 8 * j; float o = OI[(size_t)(tok0 + i) * 256 + h * 64 + lane];
#pragma unroll 8
        for (int k = 0; k < 32; ++k) o += ql[i * 33 + k] * S[k * 64 + lane];
        const float ms = wave_sum(o * o) * (1.0f / 64.0f);
        float y = o * rsqrtf(ms + EPS) * a.in[IN_GNORM][l * 256 + h * 64 + lane];
        const float g = bf1(z[(size_t)(tok0 + i) * ZW + Z_AG + h * 64 + lane]);
        y *= g / (1.0f + expf(-g));
        mix[(size_t)(tok0 + i) * D + h * 64 + lane] = (bf16)f2bf(y); }
    __syncthreads();
}
__device__ __forceinline__ void pool_item(const Args& a, int l, int item, LAS unsigned char* lds, int tid) {
    const int g = item & 3, tt = (item >> 2) & 31, b = item >> 7, t0 = tt * 64;
    LAS float* u = (LAS float*)lds;
    LAS float* w = u + 79 * 64;
    LAS float* p = w + 4096;
    const bf16* z = (const bf16*)(a.ws + WS_Z); bf16* mix = (bf16*)(a.ws + WS_MIX);
    for (int i = tid; i < 79 * 64; i += NTHR) { const int t = t0 - 15 + (i >> 6); u[i] = t >= 0 ? bf1(z[(size_t)(b * T + t) * ZW + Z_BU + g * 64 + (i & 63)]) : 0.f; }
    for (int i = tid; i < 4096; i += NTHR) w[i] = a.in[IN_PW][(size_t)(l * 4 + g) * 4096 + i];
    __syncthreads();
    const int win = 2 << g;
    for (int i = tid; i < 4096; i += NTHR) { const int tl = i >> 6, c = i & 63, t = t0 + tl, cnt = (t + 1 < win) ? t + 1 : win; float s = 0.f;
        for (int j = 0; j < cnt; ++j) s += u[(tl + 15 - j) * 64 + c];
        p[tl * 65 + c] = s / (float)cnt - u[(tl + 15) * 64 + c]; }
    __syncthreads();
    for (int i = tid; i < 4096; i += NTHR) { const int tl = i >> 6, d = i & 63; float s = a.in[IN_PB][(l * 4 + g) * 64 + d];
#pragma unroll 8
        for (int c = 0; c < 64; ++c) s += p[tl * 65 + c] * w[c * 64 + d];
        s *= a.in[IN_PS][l * 256 + g * 64 + d];
        mix[(size_t)(b * T + t0 + tl) * D + 256 + g * 64 + d] = (bf16)f2bf(s); }
    __syncthreads();
}
__device__ __forceinline__ void sgu_item(const Args& a, int l, int item, LAS unsigned char* lds, int tid) {
    const int g = item & 3, nc = (item >> 2) & 15, b = item >> 6, tok0 = b * T + nc * 128, lane = tid & 63, w = tid >> 6;
    LAS float* vn = (LAS float*)lds;
    const bf16* z = (const bf16*)(a.ws + WS_Z); bf16* mix = (bf16*)(a.ws + WS_MIX);
    for (int j = 0; j < 16; ++j) { const int s = w + 8 * j;
        const v2u raw = *(const v2u*)(z + (size_t)(tok0 + s) * ZW + Z_DUV + 256 + 4 * lane);
        float x[4] = {gelu_tanh(bflo(raw.x)), gelu_tanh(bfhi(raw.x)), gelu_tanh(bflo(raw.y)), gelu_tanh(bfhi(raw.y))};
        const float mu = wave_sum((x[0] + x[1]) + (x[2] + x[3])) * (1.0f / 256.0f);
        float q = 0.f;
#pragma unroll
        for (int i = 0; i < 4; ++i) { x[i] -= mu; q += x[i] * x[i]; }
        const float rstd = rsqrtf(wave_sum(q) * (1.0f / 256.0f) + EPS);
        if ((lane >> 4) == g) {
#pragma unroll
            for (int i = 0; i < 4; ++i) { const int cl = 4 * (lane & 15) + i; vn[s * 64 + cl] = x[i] * rstd * a.in[IN_LNG][l * 256 + g * 64 + cl] + a.in[IN_LNB][l * 256 + g * 64 + cl]; } } }
    __syncthreads();
    const float* sw = a.in[IN_SW] + (size_t)(l * 4 + g) * 128 * 128;
    for (int j = 0; j < 16; ++j) { const int t = w + 8 * j; float acc = a.in[IN_SB][(l * 4 + g) * 128 + t];
        const float* swr = sw + t * 128;
        for (int s = 0; s <= t; ++s) acc += swr[s] * vn[s * 64 + lane];
        const float uu = gelu_tanh(bf1(z[(size_t)(tok0 + t) * ZW + Z_DUV + g * 64 + lane]));
        mix[(size_t)(tok0 + t) * D + 768 + g * 64 + lane] = (bf16)f2bf(uu * acc); }
    __syncthreads();
}
__device__ __forceinline__ void xattn_item(const Args& a, int l, int item, LAS unsigned char* lds, int tid) {
    const int qtile = item & 31, h = (item >> 5) & 3, b = item >> 7, lane = tid & 63, w = tid >> 6;
    LAS float* Ks = (LAS float*)lds;
    LAS float* Vs = Ks + 256 * 65;
    LAS float* qs = Vs + 256 * 64;
    LAS float* pw = qs + 512;
    const bf16* kvm = (const bf16*)(a.ws + WS_KVM + (size_t)l * SZ_KVM); const bf16* qx = (const bf16*)(a.ws + WS_QX); bf16* ox = (bf16*)(a.ws + WS_OX);
    for (int i = tid; i < 16384; i += NTHR) { const int key = i >> 6, d = i & 63; const size_t o = (size_t)(b * MEMLEN + key) * 512 + h * 64 + d;
        Ks[key * 65 + d] = bf1(kvm[o]); Vs[key * 64 + d] = bf1(kvm[o + 256]); }
    __syncthreads();
    for (int qq = 0; qq < 8; ++qq) { const int row = b * T + qtile * 64 + w * 8 + qq;
        qs[w * 64 + lane] = bf1(qx[(size_t)row * 256 + h * 64 + lane]);
        LDS_WAIT(); asm volatile("" ::: "memory");
        float s[4] = {0.f, 0.f, 0.f, 0.f};
        for (int d = 0; d < 64; ++d) { const float qd = qs[w * 64 + d];
#pragma unroll
            for (int j = 0; j < 4; ++j) s[j] += qd * Ks[(lane + 64 * j) * 65 + d]; }
        const float mx = wave_max(fmaxf(fmaxf(s[0], s[1]), fmaxf(s[2], s[3])));
        float e[4], sum = 0.f;
#pragma unroll
        for (int j = 0; j < 4; ++j) { e[j] = expf(s[j] - mx); sum += e[j]; }
        const float inv = 1.0f / wave_sum(sum);
#pragma unroll
        for (int j = 0; j < 4; ++j) pw[w * 256 + lane + 64 * j] = e[j] * inv;
        LDS_WAIT(); asm volatile("" ::: "memory");
        float o = 0.f;
        for (int key = 0; key < 256; ++key) o += pw[w * 256 + key] * Vs[key * 64 + lane];
        ox[(size_t)row * 256 + h * 64 + lane] = (bf16)f2bf(o);
        LDS_WAIT(); asm volatile("" ::: "memory"); }
    __syncthreads();
}

__device__ __forceinline__ unsigned ord_u(float f) { const unsigned u = __builtin_bit_cast(unsigned, f); return (u & 0x80000000u) ? ~u : (u | 0x80000000u); }
__device__ __forceinline__ int rel_bucket(int n) {
    if (n < 16) return n;
    int large = 16 + (int)(logf((float)n / 16.0f) / logf(8.0f) * 16.0f);
    return large < 31 ? large : 31;
}
__device__ __forceinline__ void dsa_setup(const Args& a, LAS unsigned char* lds, int tid) {
    LAS float* biasd = (LAS float*)(lds + 48 * 1024);
    for (int i = tid; i < 129 * 4; i += NTHR) { const int d = i >> 2, h = i & 3; biasd[i] = a.in[IN_RELB][rel_bucket(d) * 4 + h]; }
    __syncthreads();
}
__device__ __forceinline__ void dsa_item(const Args& a, int item, LAS unsigned char* lds, int tid) {
    const int b = item / T, t = item % T, nk = t + 1, lane = tid & 63, w = tid >> 6;
    LAS unsigned* su = (LAS unsigned*)lds;
    LAS float* lg = (LAS float*)(lds + 8192);
    LAS float* qi = (LAS float*)(lds + 8192 + 32768);
    LAS float* qv = qi + 256;
    LAS float* wi = qv + 256;
    LAS unsigned* cnt = (LAS unsigned*)(wi + 8);
    LAS float* red = (LAS float*)(cnt + 40);
    LAS float* red2 = red + 64;
    LAS float* biasd = (LAS float*)(lds + 48 * 1024);
    const bf16* z = (const bf16*)(a.ws + WS_Z); bf16* mix = (bf16*)(a.ws + WS_MIX);
    const size_t row = (size_t)b * T + t;
    if (tid < 256) { qi[tid] = bf1(z[row * ZW + Z_CQI + tid]) * 0.17677669529663687f; qv[tid] = bf1(z[row * ZW + Z_CQ + tid]) * 0.125f; }
    if (tid < 8) wi[tid] = bf1(z[row * ZW + Z_CWI + tid]) * 0.35355339059327373f;
    if (tid < 40) cnt[tid] = 0u;
    __syncthreads();
    unsigned myu[4];
#pragma unroll
    for (int j = 0; j < 4; ++j) { const int key = tid + NTHR * j; myu[j] = 0u;
        if (key < nk) { const v4u* kp = (const v4u*)(z + ((size_t)b * T + key) * ZW + Z_CKI); float kf[32];
#pragma unroll
            for (int i = 0; i < 4; ++i) { const v4u r = kp[i]; kf[8 * i + 0] = bflo(r.x); kf[8 * i + 1] = bfhi(r.x); kf[8 * i + 2] = bflo(r.y); kf[8 * i + 3] = bfhi(r.y); kf[8 * i + 4] = bflo(r.z); kf[8 * i + 5] = bfhi(r.z); kf[8 * i + 6] = bflo(r.w); kf[8 * i + 7] = bfhi(r.w); }
            float sc = 0.f;
            for (int hh = 0; hh < 8; ++hh) { float dot = 0.f;
#pragma unroll
                for (int d = 0; d < 32; ++d) dot += qi[hh * 32 + d] * kf[d];
                sc += fmaxf(dot, 0.f) * wi[hh]; }
            sc += 0.0f;
            myu[j] = ord_u(sc); su[key] = myu[j]; } }
    __syncthreads();
    bool sel[4];
#pragma unroll
    for (int j = 0; j < 4; ++j) sel[j] = (tid + NTHR * j) < nk;
    if (nk > 256) {
        unsigned Tt = 0u;
        for (int bit = 31; bit >= 0; --bit) { const unsigned cand = Tt | (1u << bit); int c = 0;
#pragma unroll
            for (int j = 0; j < 4; ++j) c += (myu[j] >= cand) ? 1 : 0;
            c = (int)wave_sum((float)c);
            if (lane == 0 && c) LDS_ADD(&cnt[bit], (unsigned)c);
            __syncthreads();
            if (cnt[bit] >= 256u) Tt = cand; }
        { int c = 0;
#pragma unroll
            for (int j = 0; j < 4; ++j) c += (myu[j] > Tt) ? 1 : 0;
            c = (int)wave_sum((float)c);
            if (lane == 0 && c) LDS_ADD(&cnt[32], (unsigned)c);
            __syncthreads(); }
        const int r = 256 - (int)cnt[32];
#pragma unroll
        for (int j = 0; j < 4; ++j) { const int key = tid + NTHR * j;
            if (myu[j] > Tt) sel[j] = true;
            else if (myu[j] == Tt && key < nk) { int rank = 0; for (int s = 0; s < key; ++s) rank += (su[s] == Tt) ? 1 : 0; sel[j] = rank < r; }
            else sel[j] = false; }
    }
    float lmax[4] = {-INFINITY, -INFINITY, -INFINITY, -INFINITY};
#pragma unroll
    for (int j = 0; j < 4; ++j) { const int key = tid + NTHR * j;
        if (key < nk) {
            float lv[4] = {-INFINITY, -INFINITY, -INFINITY, -INFINITY};
            if (sel[j]) { const v4u* kp = (const v4u*)(z + ((size_t)b * T + key) * ZW + Z_CK); const int dd = (t - key) < 128 ? (t - key) : 128;
#pragma unroll
                for (int hh = 0; hh < 4; ++hh) { float dot = 0.f;
#pragma unroll
                    for (int i = 0; i < 8; ++i) { const v4u r = kp[hh * 8 + i]; const LAS float* qq = qv + hh * 64 + 8 * i;
                        dot += qq[0] * bflo(r.x) + qq[1] * bfhi(r.x) + qq[2] * bflo(r.y) + qq[3] * bfhi(r.y) + qq[4] * bflo(r.z) + qq[5] * bfhi(r.z) + qq[6] * bflo(r.w) + qq[7] * bfhi(r.w); }
                    lv[hh] = dot + biasd[dd * 4 + hh]; lmax[hh] = fmaxf(lmax[hh], lv[hh]); } }
#pragma unroll
            for (int hh = 0; hh < 4; ++hh) lg[hh * 2048 + key] = lv[hh]; } }
#pragma unroll
    for (int hh = 0; hh < 4; ++hh) { const float m = wave_max(lmax[hh]); if (lane == 0) red[w * 4 + hh] = m; }
    __syncthreads();
    float mx[4], lsum[4] = {0.f, 0.f, 0.f, 0.f};
#pragma unroll
    for (int hh = 0; hh < 4; ++hh) { float m = red[hh]; for (int ww = 1; ww < 8; ++ww) m = fmaxf(m, red[ww * 4 + hh]); mx[hh] = m; }
#pragma unroll
    for (int j = 0; j < 4; ++j) { const int key = tid + NTHR * j;
        if (key < nk) {
#pragma unroll
            for (int hh = 0; hh < 4; ++hh) { const float lv = lg[hh * 2048 + key]; const float p = (lv == -INFINITY) ? 0.f : expf(lv - mx[hh]); lg[hh * 2048 + key] = p; lsum[hh] += p; } } }
#pragma unroll
    for (int hh = 0; hh < 4; ++hh) { const float s = wave_sum(lsum[hh]); if (lane == 0) red[32 + w * 4 + hh] = s; }
    __syncthreads();
    { const int half = tid >> 8, hd = tid & 255, hh = hd >> 6; float acc = 0.f;
      const bf16* vp = z + (size_t)b * T * ZW + Z_CV + hd;
      for (int key = half; key < nk; key += 2) { const float p = lg[hh * 2048 + key]; if (p != 0.f) acc += p * bf1(vp[(size_t)key * ZW]); }
      red2[tid] = acc; }
    __syncthreads();
    if (tid < 256) { const int hh = tid >> 6; float s = 0.f; for (int ww = 0; ww < 8; ++ww) s += red[32 + ww * 4 + hh];
        mix[row * D + 512 + tid] = (bf16)f2bf((red2[tid] + red2[tid + 256]) / s); }
    __syncthreads();
}

__device__ __forceinline__ void moe_route(const Args& a, LAS unsigned char* lds, int tid, int G) {
    const int lane = tid & 63, w = tid >> 6;
    LAS float* rt = (LAS float*)lds;
    LAS unsigned* cnt = (LAS unsigned*)(lds + 32768);
    const float* h = a.out; unsigned char* ws = a.ws;
    for (int i = tid; i < 8192; i += NTHR) rt[(i & 7) * 1024 + (i >> 3)] = a.in[IN_ROUTER][i] * a.in[IN_NFFN][D + (i >> 3)];
    __syncthreads();
    for (int chunk = blockIdx.x; chunk < 256; chunk += G) {
        if (tid < 8) cnt[tid] = 0u;
        __syncthreads();
        for (int q = 0; q < 8; ++q) { const int tk = chunk * 64 + w * 8 + q;
            const f32x4* hr = (const f32x4*)(h + (size_t)tk * D) + lane; float lg[8] = {0.f, 0.f, 0.f, 0.f, 0.f, 0.f, 0.f, 0.f}; float ss = 0.f;
#pragma unroll
            for (int j = 0; j < 4; ++j) { const f32x4 v = hr[64 * j]; const int c0 = 4 * (lane + 64 * j);
                ss += (v.x * v.x + v.y * v.y) + (v.z * v.z + v.w * v.w);
#pragma unroll
                for (int e = 0; e < 8; ++e) { const f32x4 r = *(const LAS f32x4*)(rt + e * 1024 + c0); lg[e] += (v.x * r.x + v.y * r.y) + (v.z * r.z + v.w * r.w); } }
            ss = wave_sum(ss); const float rstd = rsqrtf(ss * (1.0f / 1024.0f) + EPS);
#pragma unroll
            for (int e = 0; e < 8; ++e) lg[e] = wave_sum(lg[e]) * rstd;
            int e0 = 0; float v0 = lg[0];
#pragma unroll
            for (int e = 1; e < 8; ++e) if (lg[e] > v0) { v0 = lg[e]; e0 = e; }
            int e1 = -1; float v1 = -INFINITY;
#pragma unroll
            for (int e = 0; e < 8; ++e) if (e != e0 && lg[e] > v1) { v1 = lg[e]; e1 = e; }
            const float g0 = 1.0f / (1.0f + expf(v1 - v0)), g1 = 1.0f - g0;
            if (lane == 0) { ((int*)(ws + WS_TOKE))[2 * tk] = e0; ((int*)(ws + WS_TOKE))[2 * tk + 1] = e1; ((float*)(ws + WS_TOKG))[2 * tk] = g0; ((float*)(ws + WS_TOKG))[2 * tk + 1] = g1;
                ((float*)(ws + WS_TOKR))[tk] = rstd; LDS_ADD(&cnt[e0], 1u); LDS_ADD(&cnt[e1], 1u); } }
        __syncthreads();
        if (tid < 8) ((int*)(ws + WS_CNT))[chunk * 8 + tid] = (int)cnt[tid];
        __syncthreads();
    }
}
__device__ __forceinline__ void moe_assign(const Args& a, LAS unsigned char* lds, int tid, int G) {
    const int lane = tid & 63, w = tid >> 6;
    LAS int* cn = (LAS int*)lds;
    LAS int* tot = cn + 2048;
    LAS int* basee = tot + 8;
    LAS int* sl = basee + 8;
    LAS int* pref = sl + 128;
    unsigned char* ws = a.ws;
    const int* CNT = (const int*)(ws + WS_CNT); int* TILEE = (int*)(ws + WS_TILEE);
    const int* TOKE = (const int*)(ws + WS_TOKE); const float* TOKG = (const float*)(ws + WS_TOKG); const float* TOKR = (const float*)(ws + WS_TOKR); int* TOKS = (int*)(ws + WS_TOKS);
    float* SLOTR = (float*)(ws + WS_SLOTR); float* SLOTG = (float*)(ws + WS_SLOTG);
    const bf16* HB = (const bf16*)(ws + WS_HB); bf16* AG = (bf16*)(ws + WS_AG);
    for (int i = tid; i < 2048; i += NTHR) cn[i] = CNT[i];
    __syncthreads();
    if (tid < 8) { int s = 0; for (int c = 0; c < 256; ++c) s += cn[c * 8 + tid]; tot[tid] = s; }
    __syncthreads();
    if (tid == 0) { int tile = 0; for (int e = 0; e < 8; ++e) { basee[e] = tile * 256; const int nt = (tot[e] + 255) >> 8;
            if (blockIdx.x == 0) for (int q = 0; q < nt; ++q) TILEE[tile + q] = e;
            tile += nt; }
        if (blockIdx.x == 0) { for (int q = tile; q < 159; ++q) TILEE[q] = 0; TILEE[159] = tile; } }
    __syncthreads();
    for (int e = blockIdx.x; e < 8; e += G) { const int s0 = basee[e] + tot[e], s1 = basee[e] + (((tot[e] + 255) >> 8) << 8);
        for (int s = s0 + w; s < s1; s += NWAVES) { v4u* rp = (v4u*)(AG + (size_t)s * D) + lane; rp[0] = (v4u){0u, 0u, 0u, 0u}; rp[64] = (v4u){0u, 0u, 0u, 0u}; if (lane == 0) { SLOTR[s] = 0.f; SLOTG[s] = 0.f; } } }
    for (int chunk = blockIdx.x; chunk < 256; chunk += G) {
        if (tid < 8) { int s = 0; for (int c = 0; c < chunk; ++c) s += cn[c * 8 + tid]; int pos = basee[tid] + s;
            for (int i = 0; i < 128; ++i) { const int tk = chunk * 64 + (i >> 1); if (TOKE[2 * tk + (i & 1)] == tid) { sl[i] = pos; SLOTR[pos] = TOKR[tk]; SLOTG[pos] = TOKG[2 * tk + (i & 1)]; TOKS[2 * tk + (i & 1)] = pos; ++pos; } } }
        __syncthreads();
        for (int q = 0; q < 16; ++q) { const int i = w * 16 + q, tk = chunk * 64 + (i >> 1), s = sl[i];
            const v4u* src = (const v4u*)(HB + (size_t)tk * D) + lane; v4u* dst = (v4u*)(AG + (size_t)s * D) + lane; dst[0] = src[0]; dst[64] = src[64]; }
        __syncthreads();
    }
}
__device__ __forceinline__ void final_phase(const Args& a, int tid, int G) {
    const int lane = tid & 63, gw = blockIdx.x * NWAVES + (tid >> 6), NGW = G * NWAVES;
    const int* TOKS = (const int*)(a.ws + WS_TOKS); const bf16* YS = (const bf16*)(a.ws + WS_YS);
    for (int tk = gw; tk < M; tk += NGW) { const int s0 = TOKS[2 * tk], s1 = TOKS[2 * tk + 1];
        f32x4* hr = (f32x4*)(a.out + (size_t)tk * D) + lane; const v2u* y0 = (const v2u*)(YS + (size_t)s0 * D) + lane; const v2u* y1 = (const v2u*)(YS + (size_t)s1 * D) + lane;
        f32x4 v[4]; float ss = 0.f;
#pragma unroll
        for (int j = 0; j < 4; ++j) { v[j] = hr[64 * j]; const v2u p = y0[64 * j], q = y1[64 * j];
            v[j].x += bflo(p.x) + bflo(q.x); v[j].y += bfhi(p.x) + bfhi(q.x); v[j].z += bflo(p.y) + bflo(q.y); v[j].w += bfhi(p.y) + bfhi(q.y);
            ss += (v[j].x * v[j].x + v[j].y * v[j].y) + (v[j].z * v[j].z + v[j].w * v[j].w); }
        const float rstd = rsqrtf(wave_sum(ss) * (1.0f / 1024.0f) + EPS);
#pragma unroll
        for (int j = 0; j < 4; ++j) { const f32x4 g = ((const f32x4*)a.in[IN_FNORM])[lane + 64 * j]; hr[64 * j] = v[j] * rstd * g; } }
}

constexpr int NPHASE = 28;
#define OTID() int tid = threadIdx.x; asm volatile("" : "+v"(tid))
__global__ void __launch_bounds__(NTHR, 2) fwd_kernel(Args a) {
    extern __shared__ __attribute__((aligned(16))) unsigned char lds_raw[];
    LAS unsigned char* lds = (LAS unsigned char*)lds_raw;
    const int G = gridDim.x, bid = blockIdx.x;
    volatile LAS unsigned* MISC = (volatile LAS unsigned*)(lds + MISC_OFF);
    if (threadIdx.x < 32) MISC[threadIdx.x] = 0u;
    __syncthreads();
    unsigned char* ws = a.ws;
    XcdBarrier bar; bar.bar = (unsigned*)(ws + WS_CTL) + CW_BAR; bar.x = 0; bar.st = nullptr;
    if (N_LAUNCH_MODE == 1) bar = xcd_barrier_post((unsigned*)(ws + WS_CTL) + CW_BAR, MISC + 8);
    const int lo = a.ph_lo, hi = a.ph_hi;
#define RUN(k) (lo <= (k) && (k) < hi)
#define SEAM() do { if (N_LAUNCH_MODE == 1) xcd_barrier(bar); } while (0)
#define WB(off) ((bf16*)(ws + (off)))
#define WF(off) ((float*)(ws + (off)))
    if (RUN(0)) { OTID(); p0_prologue(a, lds, tid, G); SEAM(); }

    for (int l = 0; l < 2; ++l) {
        const int pb = l ? 10 : 1;
        if (RUN(pb + 0)) {
            { pg8::Gemm g{WB(WS_HB), WB(WS_WIN + l * SZ_WIN), M, ZW, D}; pg8::StaticOrder S; S.init(M, ZW, G, bid);
              EpiScale E{WB(WS_Z), ZW, WF(WS_SS), 1.0f}; pg8::gemm_phase<EpiScale, pg8::StaticOrder, true, true>(lds, g, S, E); }
            if (l == 0) {
                for (int l2 = 0; l2 < 2; ++l2) {
                    pg8::Gemm g{WB(WS_MEMB), WB(WS_WKV + l2 * SZ_WKV), MM, 512, D}; pg8::StaticOrder S; S.init(MM, 512, G, (G - 1 - bid - 16 * l2 + 2 * G) % G);
                    EpiScale E{WB(WS_KVM + l2 * SZ_KVM), 512, WF(WS_SSM), 1.0f}; pg8::gemm_phase<EpiScale, pg8::StaticOrder, true, true>(lds, g, S, E); }
            }
            SEAM();
        }
        if (RUN(pb + 1)) {
            { OTID(); for (int it = bid; it < 1024; it += G) gla_a_item(a, l, it, lds, tid); }
            { OTID(); for (int it = bid; it < 1024; it += G) pool_item(a, l, it, lds, tid); }
            { OTID(); for (int it = bid; it < 512; it += G) sgu_item(a, l, it, lds, tid); }
            { OTID(); dsa_setup(a, lds, tid); for (int it = M - 1 - bid; it >= 0; it -= G) dsa_item(a, it, lds, tid); }
            SEAM();
        }
        if (RUN(pb + 2)) { OTID(); for (int it = bid; it < 1024; it += G) gla_c_item(a, l, it, lds, tid); SEAM(); }
        if (RUN(pb + 3)) {
            pg8::Gemm g{WB(WS_MIX), WB(WS_WOUT + l * SZ_WOUT), M, D, D}; pg8::StaticOrder S; S.init(M, D, G, bid);
            EpiResid E{l == 0 ? a.in[IN_X] : (const float*)a.out, a.out, WB(WS_HB), WF(WS_SS)}; pg8::gemm_phase<EpiResid, pg8::StaticOrder, true, true>(lds, g, S, E); SEAM();
        }
        if (RUN(pb + 4)) {
            pg8::Gemm g{WB(WS_HB), WB(WS_WQ + l * SZ_WQ), M, 256, D}; pg8::StaticOrder S; S.init(M, 256, G, bid);
            EpiScale E{WB(WS_QX), 256, WF(WS_SS), 0.125f}; pg8::gemm_phase<EpiScale, pg8::StaticOrder, true, true>(lds, g, S, E); SEAM();
        }
        if (RUN(pb + 5)) { OTID(); for (int it = bid; it < 1024; it += G) xattn_item(a, l, it, lds, tid); SEAM(); }
        if (RUN(pb + 6)) {
            pg8::Gemm g{WB(WS_OX), WB(WS_WO + l * SZ_WO), M, D, 256}; pg8::StaticOrder S; S.init(M, D, G, bid);
            EpiResid E{a.out, a.out, WB(WS_HB), WF(WS_SS)}; pg8::gemm_phase<EpiResid, pg8::StaticOrder, true, true>(lds, g, S, E); SEAM();
        }
        if (l == 0) {
            if (RUN(8)) {
                pg8::Gemm g{WB(WS_HB), WB(WS_W13), M, 2 * DFF, D}; pg8::StaticOrder S; S.init(M, 2 * DFF, G, bid);
                EpiSwiglu<false> E{WB(WS_FACT), DFF, WF(WS_SS), nullptr, nullptr}; pg8::gemm_phase<EpiSwiglu<false>, pg8::StaticOrder, true, true>(lds, g, S, E); SEAM();
            }
            if (RUN(9)) {
                pg8::Gemm g{WB(WS_FACT), WB(WS_W2), M, D, DFF}; pg8::StaticOrder S; S.init(M, D, G, bid);
                EpiResid E{a.out, a.out, WB(WS_HB), WF(WS_SS)}; pg8::gemm_phase<EpiResid, pg8::StaticOrder, true, true>(lds, g, S, E); SEAM();
            }
        } else {
            if (RUN(17)) { OTID(); moe_route(a, lds, tid, G); SEAM(); }
            if (RUN(18)) { OTID(); moe_assign(a, lds, tid, G); SEAM(); }
            for (int p = 0; p < MOE_NPASS; ++p) {
                const int* TILEE = (const int*)(ws + WS_TILEE);
                if (RUN(19 + 2 * p)) {
                    const int NT = TILEE[159]; int nt = NT - p * MOE_TP; nt = nt < 0 ? 0 : (nt > MOE_TP ? MOE_TP : nt);
                    pg8::Gemm g{WB(WS_AG), WB(WS_MW13), MAXSLOT, NEXP * 2 * DFE, D}; pg8::MoeOrder S{p * MOE_TP, nt, 2 * DFE / 256, G, bid, 0, TILEE};
                    EpiSwiglu<true> E{WB(WS_MACT), DFE, nullptr, WF(WS_SLOTR), WF(WS_SLOTG)};
                    pg8::gemm_phase<EpiSwiglu<true>, pg8::MoeOrder, true, true>(lds, g, S, E); SEAM();
                }
                if (RUN(20 + 2 * p)) {
                    const int NT = TILEE[159]; int nt = NT - p * MOE_TP; nt = nt < 0 ? 0 : (nt > MOE_TP ? MOE_TP : nt);
                    pg8::Gemm g{WB(WS_MACT), WB(WS_MW2), MOE_TP * 256, NEXP * D, DFE}; pg8::MoeOrder S{p * MOE_TP, nt, D / 256, G, bid, 1, TILEE};
                    EpiPlain E{WB(WS_YS), D};
                    pg8::gemm_phase<EpiPlain, pg8::MoeOrder, true, true>(lds, g, S, E); SEAM();
                }
            }
            if (RUN(27)) { OTID(); final_phase(a, tid, G); }
        }
    }
#undef RUN
#undef SEAM
}

extern "C" void kernel_launch(void* const* d_in, const int* in_sizes, int n_in, void* d_out, int out_size, void* d_ws, size_t ws_size, hipStream_t stream) {
    static int grid = 0;
    if (grid == 0) {
        if (n_in != N_IN || out_size != M * D || ws_size < WS_END) { fprintf(stderr, "kernel_launch: unexpected problem (n_in %d, out %d, ws %zu < %zu)\n", n_in, out_size, ws_size, (size_t)WS_END); grid = -1; return; }
        int dev = 0, cus = 0, per_cu = 0;
        if (hipGetDevice(&dev) != hipSuccess || hipDeviceGetAttribute(&cus, hipDeviceAttributeMultiprocessorCount, dev) != hipSuccess) { grid = -1; return; }
        if (hipFuncSetAttribute((const void*)fwd_kernel, hipFuncAttributeMaxDynamicSharedMemorySize, LDS_BYTES) != hipSuccess) { fprintf(stderr, "kernel_launch: hipFuncSetAttribute failed\n"); grid = -1; return; }
        if (hipOccupancyMaxActiveBlocksPerMultiprocessor(&per_cu, (const void*)fwd_kernel, NTHR, LDS_BYTES) != hipSuccess || per_cu < 1) { fprintf(stderr, "kernel_launch: occupancy query says %d\n", per_cu); }
        (void)hipGetLastError();
        grid = cus > 0 ? cus : 256;
    }
    if (grid < 0) return;
    (void)hipMemsetAsync((char*)d_ws + WS_CTL, 0, CTL_ZERO_BYTES, stream);
    Args a{};
    for (int i = 0; i < N_IN; ++i) a.in[i] = (const float*)d_in[i];
    a.out = (float*)d_out; a.ws = (unsigned char*)d_ws;
#if N_LAUNCH_MODE == 1
    a.ph_lo = 0; a.ph_hi = NPHASE;
    hipLaunchKernelGGL(fwd_kernel, dim3(grid), dim3(NTHR), LDS_BYTES, stream, a);
#else
    for (int p = 0; p < NPHASE; ++p) { a.ph_lo = p; a.ph_hi = p + 1; hipLaunchKernelGGL(fwd_kernel, dim3(grid), dim3(NTHR), LDS_BYTES, stream, a); }
#endif
}
```

```cpp
#include <hip/hip_runtime.h>
#include <cstdio>
#include <cstdint>
#include <cmath>

#ifndef N_LAUNCH_MODE
#define N_LAUNCH_MODE 1
#endif

namespace pg8 {
#define PG8_LAS __attribute__((address_space(3)))
typedef unsigned short bf16_t;
typedef short bf16x8 __attribute__((ext_vector_type(8)));
typedef float f32x4 __attribute__((ext_vector_type(4)));
typedef unsigned u32x4 __attribute__((ext_vector_type(4)));
constexpr int BM = 256, BK = 64, HALF = 128, HTB = HALF * BK * 2  , STAGE_BYTES = 8 * HTB, NXCD = 8, WGM = 8;

__host__ __device__ __forceinline__ int lds_byte(int r, int c) { const int st = (r >> 4) * 2 + (c >> 5), rr = r & 15, cc = c & 31, ob = rr * 64 + cc * 2; return st * 1024 + (ob ^ (((ob >> 9) & 1) << 5)); }
__host__ __device__ __forceinline__ void stage_rc(int b, int& R, int& C) { const int st = b / 1024, sb = b % 1024, swz = sb ^ (((sb >> 9) & 1) << 5); R = (st >> 1) * 16 + swz / 64; C = (st & 1) * 32 + (swz % 64) / 2; }
__host__ __device__ __forceinline__ int perm32(int rho) { const int n = rho >> 4, i = rho & 15; return 8 * (i >> 2) + 4 * n + (i & 3); }

struct Unit { int pm, pn, po, e; };
struct Gemm { const bf16_t* A; const bf16_t* Bt; int M, N, K; };

struct StaticOrder {
    int nM, nN, nwg, G, c;
    __host__ __device__ void init(int M, int N, int G_, int c_) { nM = M / BM; nN = N / BM; nwg = nM * nN; G = G_; c = c_; }
    __host__ __device__ bool next(int i, Unit& u) const {
        const long L = (long)i * G + c; if (L >= nwg) return false;
        int wgid = (int)L; { const int q = nwg / NXCD, r = nwg % NXCD, xcd = wgid % NXCD, off = wgid / NXCD; wgid = (xcd < r ? xcd * (q + 1) : r * (q + 1) + (xcd - r) * q) + off; }
        const int nig = WGM * nN, gid = wgid / nig, fm = gid * WGM, gsz = (nM - fm) < WGM ? (nM - fm) : WGM;
        u.pm = fm + ((wgid % nig) % gsz); u.pn = (wgid % nig) / gsz; u.po = u.pm; u.e = u.pn; return true;
    }
    __device__ __forceinline__ void a_ready(const Unit&) const {}
    __device__ __forceinline__ void done(const Unit&) const {}
};
struct MoeOrder {
    int t0, nt, nNe, G, c, a_local; const int* tile_e;
    __device__ bool next(int i, Unit& u) const {
        const long L = (long)i * G + c; if (L >= (long)nt * nNe) return false;
        const int tl = (int)(L % nt), pn = (int)(L / nt), tile = t0 + tl, e = tile_e[tile];
        u.pm = a_local ? tl : tile; u.po = a_local ? tile : tl; u.pn = e * nNe + pn; u.e = pn; return true;
    }
    __device__ __forceinline__ void a_ready(const Unit&) const {}
    __device__ __forceinline__ void done(const Unit&) const {}
};
__device__ __forceinline__ unsigned cvt_pk_bf16(float lo, float hi) { unsigned r; asm volatile("v_cvt_pk_bf16_f32 %0, %1, %2" : "=v"(r) : "v"(lo), "v"(hi)); return r; }
template <class Epi, class Sched, bool ALIGN_EPI = false, bool SP2 = false>
__device__ __forceinline__ void gemm_phase(PG8_LAS unsigned char* lds, const Gemm g, const Sched& S, const Epi& E) {
    int tid_ = threadIdx.x; asm volatile("" : "+v"(tid_)); const int tid = tid_, wid = __builtin_amdgcn_readfirstlane(tid >> 6), lane = tid & 63, wr = wid >> 2, wc = wid & 3, fr = lane & 15, fq = lane >> 4;
    const int K = g.K, nt = K / BK;
    unsigned voffA[2], voffB[2];
#pragma unroll
    for (int i = 0; i < 2; ++i) { int R, C; stage_rc(tid * 16 + i * 8192, R, C); const int Rb = Epi::PERM ? ((R & ~31) + perm32(R & 31)) : R;
        voffA[i] = (unsigned)(R * K + C) * 2u; voffB[i] = (unsigned)(Rb * K + C) * 2u; }
    const size_t kstep = (size_t)(BK * 2);
    const size_t hstep = (size_t)HALF * K * 2;
    const size_t tstep = 2 * hstep;
    const unsigned ldsw = (unsigned)wid * 1024u;
    const int aoff = lds_byte(wr * 64 + fr, fq * 8), boff = lds_byte(wc * 32 + fr, fq * 8);
#define PG8_SA(b, h) (((b) * 2 + (h)) * HTB)
#define PG8_SB(b, h) ((4 + (b) * 2 + (h)) * HTB)
#define PG8_STAGE(bufoff, gbase, voff) do { _Pragma("unroll") for (int _i = 0; _i < 2; ++_i) \
        __builtin_amdgcn_global_load_lds((const unsigned*)((const char*)(gbase) + (voff)[_i]), (PG8_LAS unsigned*)(lds + (bufoff) + ldsw + _i * 8192), 16, 0, 0); } while (0)
#define PG8_LDA(dst, b, h) do { _Pragma("unroll") for (int m = 0; m < 4; ++m) _Pragma("unroll") for (int k = 0; k < 2; ++k) dst[m][k] = *(const PG8_LAS bf16x8*)(lds + PG8_SA(b, h) + aoff + m * 2048 + k * 1024); } while (0)
#define PG8_LDB(dst, b, h) do { _Pragma("unroll") for (int n = 0; n < 2; ++n) _Pragma("unroll") for (int k = 0; k < 2; ++k) dst[n][k] = *(const PG8_LAS bf16x8*)(lds + PG8_SB(b, h) + boff + n * 2048 + k * 1024); } while (0)
#define PG8_MMA(ai, bj, At, Bt) do { __builtin_amdgcn_s_setprio(1); _Pragma("unroll") for (int m = 0; m < 4; ++m) _Pragma("unroll") for (int n = 0; n < 2; ++n) _Pragma("unroll") for (int k = 0; k < 2; ++k) \
        acc[ai][bj][m][n] = __builtin_amdgcn_mfma_f32_16x16x32_bf16(Bt[n][k], At[m][k], acc[ai][bj][m][n], 0, 0, 0); __builtin_amdgcn_s_setprio(0); } while (0)
#define PG8_WAIT_V(n) asm volatile("s_waitcnt vmcnt(" #n ")" ::: "memory")
#define PG8_WAIT_L(n) asm volatile("s_waitcnt lgkmcnt(" #n ")" ::: "memory")
#define PG8_BAR __builtin_amdgcn_s_barrier()
#define PG8_SCHED __builtin_amdgcn_sched_barrier(0)
    Unit cur, nxt; int ui = 0;
    if (!S.next(0, cur)) return;
    f32x4 acc[2][2][4][2];
#pragma unroll
    for (int a = 0; a < 2; ++a)
#pragma unroll
        for (int b = 0; b < 2; ++b)
#pragma unroll
            for (int m = 0; m < 4; ++m)
#pragma unroll
                for (int n = 0; n < 2; ++n) acc[a][b][m][n] = (f32x4){0.f, 0.f, 0.f, 0.f};
    bf16x8 At[4][2], B0[2][2], B1[2][2];
    const char* cA = (const char*)g.A + (size_t)cur.pm * tstep; const char* cB = (const char*)g.Bt + (size_t)cur.pn * tstep;
    S.a_ready(cur);
    if constexpr (SP2) {
        PG8_STAGE(PG8_SB(0, 0), cB, voffB); PG8_STAGE(PG8_SB(0, 1), cB + hstep, voffB); PG8_STAGE(PG8_SA(0, 0), cA, voffA); PG8_STAGE(PG8_SA(0, 1), cA + hstep, voffA);
        if (wr == 1) PG8_BAR;
        PG8_WAIT_V(2); PG8_BAR;
        PG8_STAGE(PG8_SB(1, 0), cB + kstep, voffB); PG8_STAGE(PG8_SA(1, 0), cA + kstep, voffA); PG8_STAGE(PG8_SB(1, 1), cB + hstep + kstep, voffB);
        PG8_WAIT_V(6); PG8_BAR;
    } else {
        PG8_STAGE(PG8_SB(0, 0), cB, voffB); PG8_STAGE(PG8_SA(0, 0), cA, voffA); PG8_STAGE(PG8_SB(0, 1), cB + hstep, voffB); PG8_STAGE(PG8_SA(0, 1), cA + hstep, voffA);
        if (wr == 1) PG8_BAR;
        PG8_WAIT_V(4); PG8_BAR;
        PG8_STAGE(PG8_SB(1, 0), cB + kstep, voffB); PG8_STAGE(PG8_SA(1, 0), cA + kstep, voffA); PG8_STAGE(PG8_SB(1, 1), cB + hstep + kstep, voffB);
        PG8_WAIT_V(6); PG8_BAR;
    }
    for (;;) {
        const bool has_next = S.next(ui + 1, nxt);
        const char* nA = has_next ? (const char*)g.A + (size_t)nxt.pm * tstep : cA; const char* nB = has_next ? (const char*)g.Bt + (size_t)nxt.pn * tstep : cB;
        for (int t = 0; t < nt; t += 2) {
            const bool last = (t == nt - 2);
            const char* a1 = cA + (size_t)(t + 1) * kstep;
            const char* a2 = last ? nA : cA + (size_t)(t + 2) * kstep; const char* b2 = last ? nB : cB + (size_t)(t + 2) * kstep;
            const char* a3 = a2 + kstep; const char* b3 = b2 + kstep;
            if (last && has_next) S.a_ready(nxt);
            if constexpr (SP2) {
            PG8_LDB(B0, 0, 0); PG8_LDB(B1, 0, 1); PG8_SCHED; PG8_LDA(At, 0, 0); PG8_STAGE(PG8_SA(1, 1), a1 + hstep, voffA);
            PG8_WAIT_V(8); PG8_WAIT_L(0); PG8_BAR; PG8_MMA(0, 0, At, B0); PG8_MMA(0, 1, At, B1); PG8_BAR; PG8_SCHED;
            PG8_LDA(At, 0, 1); PG8_STAGE(PG8_SB(0, 0), b2, voffB); PG8_STAGE(PG8_SB(0, 1), b2 + hstep, voffB); PG8_STAGE(PG8_SA(0, 0), a2, voffA);
            PG8_WAIT_V(8); PG8_WAIT_L(0); PG8_BAR; PG8_MMA(1, 0, At, B0); PG8_MMA(1, 1, At, B1); PG8_BAR; PG8_SCHED;
            PG8_LDB(B0, 1, 0); PG8_LDB(B1, 1, 1); PG8_SCHED; PG8_LDA(At, 1, 0); PG8_STAGE(PG8_SA(0, 1), a2 + hstep, voffA);
            PG8_WAIT_V(8); PG8_WAIT_L(0); PG8_BAR; PG8_MMA(0, 0, At, B0); PG8_MMA(0, 1, At, B1); PG8_BAR; PG8_SCHED;
            PG8_LDA(At, 1, 1); PG8_STAGE(PG8_SB(1, 0), b3, voffB); PG8_STAGE(PG8_SB(1, 1), b3 + hstep, voffB); PG8_STAGE(PG8_SA(1, 0), a3, voffA);
            PG8_WAIT_V(8); PG8_WAIT_L(0); PG8_BAR; PG8_MMA(1, 0, At, B0); PG8_MMA(1, 1, At, B1); PG8_BAR; PG8_SCHED;
            } else {
            PG8_LDB(B0, 0, 0); PG8_SCHED; PG8_LDA(At, 0, 0); PG8_STAGE(PG8_SA(1, 1), a1 + hstep, voffA);
            PG8_WAIT_L(8); PG8_BAR; PG8_WAIT_L(0); PG8_MMA(0, 0, At, B0); PG8_BAR; PG8_SCHED;
            PG8_LDB(B1, 0, 1); PG8_STAGE(PG8_SB(0, 0), b2, voffB);
            PG8_BAR; PG8_WAIT_L(0); PG8_MMA(0, 1, At, B1); PG8_BAR;
            PG8_LDA(At, 0, 1); PG8_STAGE(PG8_SA(0, 0), a2, voffA);
            PG8_BAR; PG8_WAIT_L(0); PG8_MMA(1, 0, At, B0); PG8_BAR; PG8_SCHED;
            PG8_STAGE(PG8_SB(0, 1), b2 + hstep, voffB);
            PG8_WAIT_V(6); PG8_BAR; PG8_MMA(1, 1, At, B1); PG8_BAR;
            PG8_LDB(B0, 1, 0); PG8_SCHED; PG8_LDA(At, 1, 0); PG8_STAGE(PG8_SA(0, 1), a2 + hstep, voffA);
            PG8_WAIT_L(8); PG8_BAR; PG8_WAIT_L(0); PG8_MMA(0, 0, At, B0); PG8_BAR; PG8_SCHED;
            PG8_LDB(B1, 1, 1); PG8_STAGE(PG8_SB(1, 0), b3, voffB);
            PG8_BAR; PG8_WAIT_L(0); PG8_MMA(0, 1, At, B1); PG8_BAR;
            PG8_LDA(At, 1, 1); PG8_STAGE(PG8_SA(1, 0), a3, voffA);
            PG8_BAR; PG8_WAIT_L(0); PG8_MMA(1, 0, At, B0); PG8_BAR; PG8_SCHED;
            PG8_STAGE(PG8_SB(1, 1), b3 + hstep, voffB);
            PG8_WAIT_V(6); PG8_BAR; PG8_MMA(1, 1, At, B1); PG8_BAR;
            }
        }
        if constexpr (ALIGN_EPI) { if (wr == 0) PG8_BAR; }
        if constexpr (!Epi::AFTER_DRAIN) { E(acc, cur, wr, wc, fr, fq); S.done(cur); }
        if (!has_next) break;
#pragma unroll
        for (int a = 0; a < 2; ++a)
#pragma unroll
            for (int b = 0; b < 2; ++b)
#pragma unroll
                for (int m = 0; m < 4; ++m)
#pragma unroll
                    for (int n = 0; n < 2; ++n) acc[a][b][m][n] = (f32x4){0.f, 0.f, 0.f, 0.f};
        cur = nxt; cA = nA; cB = nB; ++ui;
        if constexpr (ALIGN_EPI) { if (wr == 1) PG8_BAR; }
    }
    PG8_WAIT_V(0);
    if constexpr (!ALIGN_EPI) { if (wr == 0) PG8_BAR; }
    PG8_BAR;
    if constexpr (Epi::AFTER_DRAIN) { E.fused(acc, cur, wr, wc, fr, fq, lds, wid, lane); S.done(cur); }
#undef PG8_SA
#undef PG8_SB
#undef PG8_STAGE
#undef PG8_LDA
#undef PG8_LDB
#undef PG8_MMA
#undef PG8_WAIT_V
#undef PG8_WAIT_L
#undef PG8_BAR
#undef PG8_SCHED
}
}

constexpr int BATCH = 8, T = 2048, D = 1024, M = BATCH * T, MEMLEN = 256, MM = BATCH * MEMLEN;
constexpr int INW = 2616, ZW = 2816;
constexpr int DFF = 2816, NEXP = 8, DFE = 3584;
constexpr float EPS = 1e-6f;
constexpr int Z_AQ = 0, Z_AK = 128, Z_AV = 256, Z_AG = 512, Z_ALR = 768, Z_BU = 784, Z_CQ = 1040, Z_CK = 1296, Z_CV = 1552, Z_CQI = 1808, Z_CKI = 2064, Z_CWI = 2096, Z_DUV = 2104;
constexpr int NWAVES = 8, NTHR = 512;
constexpr int MOE_TP = 34, MOE_NPASS = 4, MOE_MAXT = MOE_TP * MOE_NPASS;
constexpr int MAXSLOT = MOE_MAXT * 256;

constexpr size_t MiB = 1u << 20;
constexpr size_t al(size_t x) { return (x + 4095) & ~(size_t)4095; }
constexpr size_t WS_CTL = 0, CTL_ZERO_BYTES = 1 * MiB;
constexpr size_t WS_SS = 1 * MiB;
constexpr size_t WS_SSM = WS_SS + al((size_t)M * 16 * 4);
constexpr size_t WS_TOKE = WS_SSM + al((size_t)MM * 16 * 4);
constexpr size_t WS_TOKG = WS_TOKE + al((size_t)M * 8);
constexpr size_t WS_TOKR = WS_TOKG + al((size_t)M * 8);
constexpr size_t WS_TOKS = WS_TOKR + al((size_t)M * 4);
constexpr size_t WS_CNT = WS_TOKS + al((size_t)M * 8);
constexpr size_t WS_TILEE = WS_CNT + al(256 * 8 * 4);
constexpr size_t WS_SLOTR = WS_TILEE + al(160 * 4);
constexpr size_t WS_SLOTG = WS_SLOTR + al((size_t)MAXSLOT * 4);
constexpr size_t WS_WIN = al(WS_SLOTG + (size_t)MAXSLOT * 4 + MiB);
constexpr size_t SZ_WIN = (size_t)ZW * D * 2, SZ_WOUT = (size_t)D * D * 2, SZ_WQ = (size_t)256 * D * 2, SZ_WKV = (size_t)512 * D * 2, SZ_WO = (size_t)D * 256 * 2;
constexpr size_t WS_WOUT = WS_WIN + 2 * SZ_WIN, WS_WQ = WS_WOUT + 2 * SZ_WOUT, WS_WKV = WS_WQ + 2 * SZ_WQ, WS_WO = WS_WKV + 2 * SZ_WKV;
constexpr size_t WS_W13 = WS_WO + 2 * SZ_WO, WS_W2 = WS_W13 + (size_t)2 * DFF * D * 2, WS_MW13 = WS_W2 + (size_t)D * DFF * 2;
constexpr size_t WS_MW2 = WS_MW13 + (size_t)NEXP * 2 * DFE * D * 2, WS_KVM = WS_MW2 + (size_t)NEXP * D * DFE * 2;
constexpr size_t SZ_KVM = (size_t)MM * 512 * 2;
constexpr size_t WS_MEMB = WS_KVM + 2 * SZ_KVM;
constexpr size_t WS_ACT = al(WS_MEMB + (size_t)MM * D * 2);
constexpr size_t WS_HB = WS_ACT, WS_Z = WS_HB + (size_t)M * D * 2, WS_MIX = WS_Z + (size_t)M * ZW * 2, WS_QX = WS_MIX + (size_t)M * D * 2, WS_OX = WS_QX + (size_t)M * 256 * 2;
constexpr size_t WS_GOI = WS_OX + (size_t)M * 256 * 2, WS_GQT = WS_GOI + (size_t)M * 256 * 4, WS_GKV = WS_GQT + (size_t)M * 128 * 4, WS_GDEC = WS_GKV + (size_t)1024 * 2048 * 4;
constexpr size_t WS_ACT_END = WS_GDEC + (size_t)1024 * 32 * 4;
constexpr size_t WS_FACT = WS_Z;
constexpr size_t WS_MACT = WS_ACT, SZ_MACT = (size_t)MOE_TP * 256 * DFE * 2;
constexpr size_t WS_AG = WS_MACT + SZ_MACT, WS_YS = WS_AG + (size_t)MAXSLOT * D * 2, WS_MOE_END = WS_YS + (size_t)MAXSLOT * D * 2;
static_assert(WS_AG >= WS_HB + (size_t)M * D * 2, "AG must not overlay HB");
static_assert(WS_MOE_END <= WS_ACT_END, "MoE overlays fit");
constexpr size_t WS_END = WS_ACT_END;
constexpr int CW_BAR = 4096;

constexpr int LDS_BYTES = 147456;
constexpr int MISC_OFF = 147456 - 128;
constexpr int SCR_BYTES = MISC_OFF;

#define GAS __attribute__((address_space(1)))
#define LAS __attribute__((address_space(3)))
typedef unsigned short bf16;
typedef unsigned v4u __attribute__((ext_vector_type(4)));
typedef unsigned v2u __attribute__((ext_vector_type(2)));
typedef float f32x4 __attribute__((ext_vector_type(4)));
typedef GAS unsigned gu32;
#define RLX_AGENT __ATOMIC_RELAXED, __HIP_MEMORY_SCOPE_AGENT
#define LDS_WAIT() asm volatile("s_waitcnt lgkmcnt(0)" ::: "memory")
#define LDS_ADD(p, v) (void)__hip_atomic_fetch_add((p), (v), __ATOMIC_RELAXED, __HIP_MEMORY_SCOPE_WORKGROUP)
__device__ __forceinline__ unsigned f2bf(float f) { unsigned u = __builtin_bit_cast(unsigned, f); return (u + 0x7fffu + ((u >> 16) & 1u)) >> 16; }
__device__ __forceinline__ unsigned pk2(float lo, float hi) { return f2bf(lo) | (f2bf(hi) << 16); }
__device__ __forceinline__ float bflo(unsigned w) { return __builtin_bit_cast(float, w << 16); }
__device__ __forceinline__ float bfhi(unsigned w) { return __builtin_bit_cast(float, w & 0xffff0000u); }
__device__ __forceinline__ float bf1(bf16 b) { return __builtin_bit_cast(float, ((unsigned)b) << 16); }
__device__ __forceinline__ float wave_sum(float v) {
#pragma unroll
    for (int o = 1; o < 64; o <<= 1) v += __shfl_xor(v, o);
    return v;
}
__device__ __forceinline__ float wave_max(float v) {
#pragma unroll
    for (int o = 1; o < 64; o <<= 1) v = fmaxf(v, __shfl_xor(v, o));
    return v;
}
#define XB_TMO      128
#define XB_XCNT(j)  (256  + 64 * (j))
#define XB_XSUB(j)  (1280 + 64 * (j))
#define XB_XGEN(j)  (2304 + 64 * (j))
#define XB_TOP      3328
#define XB_TOPGEN   3392
#define XCD_BAR_WORDS 3456
#define XB_SPIN_CAP (1u << 18)

__device__ __forceinline__ unsigned xb_ld(unsigned* p)              { return __hip_atomic_load(p, __ATOMIC_RELAXED, __HIP_MEMORY_SCOPE_AGENT); }
__device__ __forceinline__ unsigned xb_add(unsigned* p, unsigned v) { return __hip_atomic_fetch_add(p, v, __ATOMIC_RELAXED, __HIP_MEMORY_SCOPE_AGENT); }
__device__ __forceinline__ unsigned xb_xcc_id() { return (unsigned)__builtin_amdgcn_s_getreg((3 << 11) | 20) & 0xFu; }
#define XB_SPIN(cond, bar) do { unsigned _sp = 0; while (cond) { __builtin_amdgcn_s_sleep(1); \
    if ((++_sp & 255u) == 0u) { if (xb_ld(&(bar)[XB_TMO])) break; if (_sp > XB_SPIN_CAP) { atomicAdd(&(bar)[XB_TMO], 1u); break; } } } } while (0)

struct XcdBarrier {
    unsigned* bar; unsigned x;
    volatile LAS unsigned* st;
};

__device__ __forceinline__ XcdBarrier xcd_barrier_post(unsigned* bar, volatile LAS unsigned* st) {
    XcdBarrier b; b.bar = bar; b.x = xb_xcc_id(); b.st = st;
    if (threadIdx.x == 0) (void)xb_add(&bar[XB_XCNT(b.x)], 1u);
    return b;
}
__device__ __forceinline__ void xcd_barrier_complete(unsigned* bar, unsigned x, unsigned& nloc, unsigned& nx) {
    const unsigned G = gridDim.x * gridDim.y * gridDim.z;
    unsigned sum, cnt, mine, sp = 0u;
    for (;;) {
        sum = 0u; cnt = 0u; mine = 0u;
#pragma unroll
        for (unsigned j = 0; j < 16; ++j) { const unsigned c = xb_ld(&bar[XB_XCNT(j)]); sum += c; cnt += (c > 0u) ? 1u : 0u; mine = (j == x) ? c : mine; }
        if (sum == G) break;
        __builtin_amdgcn_s_sleep(1);
        if ((++sp & 255u) == 0u) { if (xb_ld(&bar[XB_TMO])) break; if (sp > XB_SPIN_CAP) { atomicAdd(&bar[XB_TMO], 1u); break; } }
    }
    nloc = mine > 0u ? mine : 1u; nx = cnt > 0u ? cnt : 1u;
}

__device__ __forceinline__ void xcd_barrier(const XcdBarrier& b) {
    asm volatile("s_waitcnt vmcnt(0)" ::: "memory");
    __syncthreads();
    if (threadIdx.x == 0) {
        unsigned* bar = b.bar;
        __builtin_amdgcn_s_waitcnt(0);
        unsigned nloc = b.st[0], nx = b.st[1];
        if (nloc == 0u) { xcd_barrier_complete(bar, b.x, nloc, nx); b.st[0] = nloc; b.st[1] = nx; }
        const unsigned old = xb_add(&bar[XB_XSUB(b.x)], 1u);
        const unsigned gen = old / nloc;
        if (old + 1u == (gen + 1u) * nloc) {
            __builtin_amdgcn_fence(__ATOMIC_RELEASE, "agent");
            asm volatile("s_waitcnt vmcnt(0)" ::: "memory");
            const unsigned og = xb_add(&bar[XB_TOP], 1u);
            const unsigned tg = og / nx;
            if (og + 1u == (tg + 1u) * nx) xb_add(&bar[XB_TOPGEN], 1u);
            else XB_SPIN(xb_ld(&bar[XB_TOPGEN]) == tg, bar);
            __builtin_amdgcn_fence(__ATOMIC_ACQUIRE, "agent");
            xb_add(&bar[XB_XGEN(b.x)], 1u);
            asm volatile("s_waitcnt vmcnt(0)" ::: "memory");
        } else {
            XB_SPIN(xb_ld(&bar[XB_XGEN(b.x)]) == gen, bar);
            __builtin_amdgcn_fence(__ATOMIC_ACQUIRE, "agent");
            asm volatile("s_waitcnt vmcnt(0)" ::: "memory");
        }
    }
    __syncthreads();
}

enum { IN_X = 0, IN_MEM, IN_RELB, IN_FNORM, IN_NMIX, IN_WIN, IN_WA2, IN_BA, IN_GNORM, IN_PW, IN_PB, IN_PS, IN_LNG, IN_LNB, IN_SW, IN_SB, IN_WOUT,
       IN_NXA, IN_NMEM, IN_WQ, IN_WKV, IN_WO, IN_NFFN, IN_F1, IN_F3, IN_F2, IN_ROUTER, IN_M1, IN_M3, IN_M2, N_IN };
struct Args { const float* in[N_IN]; float* out; unsigned char* ws; int ph_lo, ph_hi; };

__device__ __forceinline__ float rstd16(const float* ss, int row) {
    const f32x4* p = (const f32x4*)(ss + (size_t)row * 16);
    const f32x4 a = p[0], b = p[1], c = p[2], d = p[3];
    const float s = (((a.x + a.y) + (a.z + a.w)) + ((b.x + b.y) + (b.z + b.w))) + (((c.x + c.y) + (c.z + c.w)) + ((d.x + d.y) + (d.z + d.w)));
    return rsqrtf(s * (1.0f / 1024.0f) + EPS);
}
__device__ __forceinline__ v4u pack8(const f32x4 a, const f32x4 b) { v4u w; w.x = pg8::cvt_pk_bf16(a.x, a.y); w.y = pg8::cvt_pk_bf16(a.z, a.w); w.z = pg8::cvt_pk_bf16(b.x, b.y); w.w = pg8::cvt_pk_bf16(b.z, b.w); return w; }

struct EpiScale {
    static constexpr bool PERM = true, AFTER_DRAIN = false;
    bf16* O; int ldc; const float* ss; float scale;
    __device__ __forceinline__ void operator()(const pg8::f32x4 (&acc)[2][2][4][2], const pg8::Unit& u, int wr, int wc, int fr, int fq) const {
        const int row0 = u.po * 256 + wr * 64 + fr, col0 = u.e * 256 + wc * 32 + 8 * fq;
#pragma unroll
        for (int ai = 0; ai < 2; ++ai)
#pragma unroll
            for (int m = 0; m < 4; ++m) { const int row = row0 + ai * 128 + m * 16; const float r = rstd16(ss, row) * scale; bf16* rowp = O + (size_t)row * ldc + col0;
#pragma unroll
                for (int bj = 0; bj < 2; ++bj) *(v4u*)(rowp + bj * 128) = pack8(acc[ai][bj][m][0] * r, acc[ai][bj][m][1] * r); }
    }
};
struct EpiResid {
    static constexpr bool PERM = true, AFTER_DRAIN = false;
    const float* res; float* H; bf16* HB; float* SS;
    __device__ __forceinline__ void operator()(const pg8::f32x4 (&acc)[2][2][4][2], const pg8::Unit& u, int wr, int wc, int fr, int fq) const {
        const int row0 = u.po * 256 + wr * 64 + fr, col0 = u.e * 256 + wc * 32 + 8 * fq;
#pragma unroll
        for (int ai = 0; ai < 2; ++ai)
#pragma unroll
            for (int m = 0; m < 4; ++m) { const int row = row0 + ai * 128 + m * 16; const size_t off = (size_t)row * D + col0; float q = 0.f;
#pragma unroll
                for (int bj = 0; bj < 2; ++bj) {
                    const f32x4 r0 = *(const f32x4*)(res + off + bj * 128), r1 = *(const f32x4*)(res + off + bj * 128 + 4);
                    const f32x4 v0 = acc[ai][bj][m][0] + r0, v1 = acc[ai][bj][m][1] + r1;
                    *(f32x4*)(H + off + bj * 128) = v0; *(f32x4*)(H + off + bj * 128 + 4) = v1;
                    *(v4u*)(HB + off + bj * 128) = pack8(v0, v1);
                    q += ((v0.x * v0.x + v0.y * v0.y) + (v0.z * v0.z + v0.w * v0.w)) + ((v1.x * v1.x + v1.y * v1.y) + (v1.z * v1.z + v1.w * v1.w)); }
                q += __shfl_xor(q, 16); q += __shfl_xor(q, 32);
                if (fq == 0) SS[(size_t)row * 16 + u.e * 4 + wc] = q; }
    }
};
__device__ __forceinline__ float silu_f(float x) { return x * __builtin_amdgcn_rcpf(1.0f + __expf(-x)); }
template <bool MOE> struct EpiSwiglu {
    static constexpr bool PERM = true, AFTER_DRAIN = false;
    bf16* O; int ldc; const float* ss; const float* slot_r; const float* slot_g;
    __device__ __forceinline__ void operator()(const pg8::f32x4 (&acc)[2][2][4][2], const pg8::Unit& u, int wr, int wc, int fr, int fq) const {
        const int rin0 = u.pm * 256 + wr * 64 + fr, rout0 = u.po * 256 + wr * 64 + fr, col0 = u.e * 128 + wc * 32 + 8 * fq;
#pragma unroll
        for (int ai = 0; ai < 2; ++ai)
#pragma unroll
            for (int m = 0; m < 4; ++m) { const int rin = rin0 + ai * 128 + m * 16, rout = rout0 + ai * 128 + m * 16;
                float r, gt; if (MOE) { r = slot_r[rin]; gt = slot_g[rin]; } else { r = rstd16(ss, rin); gt = 1.0f; }
                f32x4 o0, o1;
#pragma unroll
                for (int j = 0; j < 4; ++j) { o0[j] = silu_f(acc[ai][0][m][0][j] * r) * (acc[ai][1][m][0][j] * r) * gt; o1[j] = silu_f(acc[ai][0][m][1][j] * r) * (acc[ai][1][m][1][j] * r) * gt; }
                *(v4u*)(O + (size_t)rout * ldc + col0) = pack8(o0, o1); }
    }
};
struct EpiPlain {
    static constexpr bool PERM = true, AFTER_DRAIN = false;
    bf16* O; int ldc;
    __device__ __forceinline__ void operator()(const pg8::f32x4 (&acc)[2][2][4][2], const pg8::Unit& u, int wr, int wc, int fr, int fq) const {
        const int row0 = u.po * 256 + wr * 64 + fr, col0 = u.e * 256 + wc * 32 + 8 * fq;
#pragma unroll
        for (int ai = 0; ai < 2; ++ai)
#pragma unroll
            for (int m = 0; m < 4; ++m) { bf16* rowp = O + (size_t)(row0 + ai * 128 + m * 16) * ldc + col0;
#pragma unroll
                for (int bj = 0; bj < 2; ++bj) *(v4u*)(rowp + bj * 128) = pack8(acc[ai][bj][m][0], acc[ai][bj][m][1]); }
    }
};

__device__ __forceinline__ void tr_item(const float* W, int N, int K, int k0, int n0, const float* gain, bf16* WT, long dst_row0, LAS float* scr, int lane) {
    const int nn = n0 + (lane & 31);
#pragma unroll 8
    for (int i = 0; i < 32; ++i) { const int kk = 2 * i + (lane >> 5); float v = (nn < N) ? W[(size_t)(k0 + kk) * N + nn] : 0.f; if (gain) v *= gain[k0 + kk]; scr[kk * 33 + (lane & 31)] = v; }
    LDS_WAIT(); asm volatile("" ::: "memory");
    const int c = lane & 7;
#pragma unroll
    for (int j = 0; j < 4; ++j) { const int n = (lane >> 3) + 8 * j; const LAS float* s = scr + (8 * c) * 33 + n;
        v4u o; o.x = pk2(s[0 * 33], s[1 * 33]); o.y = pk2(s[2 * 33], s[3 * 33]); o.z = pk2(s[4 * 33], s[5 * 33]); o.w = pk2(s[6 * 33], s[7 * 33]);
        if (n0 + n < N) *(v4u*)(WT + (size_t)(dst_row0 + n) * K + k0 + 8 * c) = o; }
    LDS_WAIT(); asm volatile("" ::: "memory");
}
__device__ __forceinline__ void conv_job(const float* W, int K, int N, const float* gain, bf16* WT, int mode, LAS float* scr, int gw, int NGW, int lane, long& base) {
    const int nblk = (N + 31) / 32, nitems = (K / 64) * nblk;
    const int first = (int)(((long)gw - (base % NGW) + NGW) % NGW);
    for (int it = first; it < nitems; it += NGW) {
        const int kb = it / nblk, nb = it % nblk, k0 = 64 * kb, n0 = 32 * nb;
        const long dr = (mode == 0) ? (long)n0 : (long)(n0 >> 7) * 256 + (n0 & 127) + (mode == 2 ? 128 : 0);
        tr_item(W, N, K, k0, n0, gain, WT, dr, scr, lane);
    }
    base += nitems;
}
__device__ __forceinline__ void row_cvt(const float* xrow, bf16* orow, float* ssrow, int lane) {
    const f32x4* xr = (const f32x4*)xrow + lane; f32x4 v[4]; float s = 0.f;
#pragma unroll
    for (int j = 0; j < 4; ++j) { v[j] = xr[64 * j]; s += (v[j].x * v[j].x + v[j].y * v[j].y) + (v[j].z * v[j].z + v[j].w * v[j].w); }
    s = wave_sum(s);
    v2u* o8 = (v2u*)orow + lane;
#pragma unroll
    for (int j = 0; j < 4; ++j) { v2u w; w.x = pk2(v[j].x, v[j].y); w.y = pk2(v[j].z, v[j].w); o8[64 * j] = w; }
    if (lane < 16) ssrow[lane] = lane == 0 ? s : 0.f;
}
__device__ __forceinline__ void p0_prologue(const Args& a, LAS unsigned char* lds, int tid, int G) {
    const int lane = tid & 63, wave = tid >> 6, gw = blockIdx.x * NWAVES + wave, NGW = G * NWAVES;
    LAS float* scr = (LAS float*)(lds + wave * 16384);
    unsigned char* ws = a.ws; long base = 0;
    for (int l = 0; l < 2; ++l) {
        conv_job(a.in[IN_WIN] + (size_t)l * D * INW, D, INW, a.in[IN_NMIX] + l * D, (bf16*)(ws + WS_WIN + l * SZ_WIN), 0, scr, gw, NGW, lane, base);
        conv_job(a.in[IN_WOUT] + (size_t)l * D * D, D, D, nullptr, (bf16*)(ws + WS_WOUT + l * SZ_WOUT), 0, scr, gw, NGW, lane, base);
        conv_job(a.in[IN_WQ] + (size_t)l * D * 256, D, 256, a.in[IN_NXA] + l * D, (bf16*)(ws + WS_WQ + l * SZ_WQ), 0, scr, gw, NGW, lane, base);
        conv_job(a.in[IN_WKV] + (size_t)l * D * 512, D, 512, a.in[IN_NMEM] + l * D, (bf16*)(ws + WS_WKV + l * SZ_WKV), 0, scr, gw, NGW, lane, base);
        conv_job(a.in[IN_WO] + (size_t)l * 256 * D, 256, D, nullptr, (bf16*)(ws + WS_WO + l * SZ_WO), 0, scr, gw, NGW, lane, base);
        { v4u* zp = (v4u*)(ws + WS_WIN + l * SZ_WIN + (size_t)INW * D * 2); const int n16 = (ZW - INW) * D * 2 / 16;
          for (int i = blockIdx.x * NTHR + tid; i < n16; i += G * NTHR) zp[i] = (v4u){0u, 0u, 0u, 0u}; }
    }
    conv_job(a.in[IN_F1], D, DFF, a.in[IN_NFFN], (bf16*)(ws + WS_W13), 1, scr, gw, NGW, lane, base);
    conv_job(a.in[IN_F3], D, DFF, a.in[IN_NFFN], (bf16*)(ws + WS_W13), 2, scr, gw, NGW, lane, base);
    conv_job(a.in[IN_F2], DFF, D, nullptr, (bf16*)(ws + WS_W2), 0, scr, gw, NGW, lane, base);
    for (int e = 0; e < NEXP; ++e) {
        conv_job(a.in[IN_M1] + (size_t)e * D * DFE, D, DFE, a.in[IN_NFFN] + D, (bf16*)(ws + WS_MW13) + (size_t)e * 2 * DFE * D, 1, scr, gw, NGW, lane, base);
        conv_job(a.in[IN_M3] + (size_t)e * D * DFE, D, DFE, a.in[IN_NFFN] + D, (bf16*)(ws + WS_MW13) + (size_t)e * 2 * DFE * D, 2, scr, gw, NGW, lane, base);
        conv_job(a.in[IN_M2] + (size_t)e * DFE * D, DFE, D, nullptr, (bf16*)(ws + WS_MW2) + (size_t)e * D * DFE, 0, scr, gw, NGW, lane, base);
    }
    for (int m = gw; m < M; m += NGW) row_cvt(a.in[IN_X] + (size_t)m * D, (bf16*)(ws + WS_HB) + (size_t)m * D, (float*)(ws + WS_SS) + (size_t)m * 16, lane);
    for (int m = gw; m < MM; m += NGW) row_cvt(a.in[IN_MEM] + (size_t)m * D, (bf16*)(ws + WS_MEMB) + (size_t)m * D, (float*)(ws + WS_SSM) + (size_t)m * 16, lane);
}

__device__ __forceinline__ float gelu_tanh(float x) { return 0.5f * x * (1.0f + tanhf(0.7978845608028654f * (x + 0.044715f * x * x * x))); }

__device__ __forceinline__ void gla_a_item(const Args& a, int l, int item, LAS unsigned char* lds, int tid) {
    const int n = item & 31, h = (item >> 5) & 3, b = item >> 7, tok0 = b * T + n * 64;
    LAS float* alr = (LAS float*)lds;
    LAS float* wa = alr + 64 * 16;
    LAS float* bb = wa + 16 * 32;
    LAS float* qt = bb + 64 * 33;
    LAS float* kt = qt + 64 * 33;
    LAS float* kd = kt + 64 * 33;
    LAS float* vv = kd + 64 * 33;
    LAS float* att = vv + 64 * 64;
    LAS float* bav = att + 64 * 65;
    const bf16* z = (const bf16*)(a.ws + WS_Z);
    float* OI = (float*)(a.ws + WS_GOI); float* QT = (float*)(a.ws + WS_GQT); float* KV = (float*)(a.ws + WS_GKV); float* DEC = (float*)(a.ws + WS_GDEC);
    for (int i = tid; i < 1024; i += NTHR) alr[i] = bf1(z[(size_t)(tok0 + (i >> 4)) * ZW + Z_ALR + (i & 15)]);
    { const int r = tid >> 5, k = tid & 31; wa[tid] = a.in[IN_WA2][(size_t)l * 16 * 128 + r * 128 + h * 32 + k]; }
    if (tid < 32) bav[tid] = a.in[IN_BA][l * 128 + h * 32 + tid];
    for (int i = tid; i < 4096; i += NTHR) vv[i] = bf1(z[(size_t)(tok0 + (i >> 6)) * ZW + Z_AV + h * 64 + (i & 63)]);
    __syncthreads();
    for (int i = tid; i < 2048; i += NTHR) { const int c = i >> 5, k = i & 31; float x = bav[k];
#pragma unroll
        for (int r = 0; r < 16; ++r) x += alr[c * 16 + r] * wa[r * 32 + k];
        const float ls = fminf(x, 0.f) - log1pf(expf(-fabsf(x)));
        bb[c * 33 + k] = ls * (1.0f / 16.0f); }
    __syncthreads();
    if (tid < 32) { float run = 0.f; for (int c = 0; c < 64; ++c) { run += bb[c * 33 + tid]; bb[c * 33 + tid] = run; } }
    __syncthreads();
    for (int i = tid; i < 2048; i += NTHR) { const int c = i >> 5, k = i & 31; const float bv = bb[c * 33 + k], bl = bb[63 * 33 + k];
        const float q = bf1(z[(size_t)(tok0 + c) * ZW + Z_AQ + h * 32 + k]), kk = bf1(z[(size_t)(tok0 + c) * ZW + Z_AK + h * 32 + k]);
        const float qv = q * 0.17677669529663687f * expf(bv);
        qt[c * 33 + k] = qv; kt[c * 33 + k] = kk * expf(-bv); kd[c * 33 + k] = kk * expf(bl - bv);
        QT[(size_t)(tok0 + c) * 128 + h * 32 + k] = qv; }
    if (tid < 32) DEC[(size_t)item * 32 + tid] = expf(bb[63 * 33 + tid]);
    __syncthreads();
    for (int idx = tid; idx < 4096; idx += NTHR) { const int i = idx >> 6, j = idx & 63; float s = 0.f;
        if (j <= i) {
#pragma unroll 8
            for (int k = 0; k < 32; ++k) s += qt[i * 33 + k] * kt[j * 33 + k]; }
        att[i * 65 + j] = s; }
    __syncthreads();
    for (int idx = tid; idx < 4096; idx += NTHR) { const int i = idx >> 6, v = idx & 63; float s = 0.f;
#pragma unroll 8
        for (int j = 0; j < 64; ++j) s += att[i * 65 + j] * vv[j * 64 + v];
        OI[(size_t)(tok0 + i) * 256 + h * 64 + v] = s; }
    for (int idx = tid; idx < 2048; idx += NTHR) { const int k = idx >> 6, v = idx & 63; float s = 0.f;
#pragma unroll 8
        for (int c = 0; c < 64; ++c) s += kd[c * 33 + k] * vv[c * 64 + v];
        KV[(size_t)item * 2048 + idx] = s; }
    __syncthreads();
}
__device__ __forceinline__ void gla_c_item(const Args& a, int l, int item, LAS unsigned char* lds, int tid) {
    const int n = item & 31, h = (item >> 5) & 3, b = item >> 7, tok0 = b * T + n * 64, lane = tid & 63, w = tid >> 6;
    LAS float* S = (LAS float*)lds;
    LAS float* ql = S + 2048;
    const bf16* z = (const bf16*)(a.ws + WS_Z); bf16* mix = (bf16*)(a.ws + WS_MIX);
    const float* OI = (const float*)(a.ws + WS_GOI); const float* QT = (const float*)(a.ws + WS_GQT); const float* KV = (const float*)(a.ws + WS_GKV); const float* DEC = (const float*)(a.ws + WS_GDEC);
    for (int e = tid; e < 2048; e += NTHR) { const int k = e >> 6; float s = 0.f;
        for (int m = 0; m < n; ++m) { const size_t it = (size_t)(item - n + m); s = s * DEC[it * 32 + k] + KV[it * 2048 + e]; }
        S[e] = s; }
    for (int i = tid; i < 2048; i += NTHR) ql[(i >> 5) * 33 + (i & 31)] = QT[(size_t)(tok0 + (i >> 5)) * 128 + h * 32 + (i & 31)];
    __syncthreads();
    for (int j = 0; j < 8; ++j) { const int i = w + 8 * j; float o = OI[(size_t)(tok0 + i) * 256 + h * 64 + lane];
#pragma unroll 8
        for (int k = 0; k < 32; ++k) o += ql[i * 33 + k] * S[k * 64 + lane];
        const float ms = wave_sum(o * o) * (1.0f / 64.0f);
        float y = o * rsqrtf(ms + EPS) * a.in[IN_GNORM][l * 256 + h * 64 + lane];
        const float g = bf1(z[(size_t)(tok0 + i) * ZW + Z_AG + h * 64 + lane]);
        y *= g / (1.0f + expf(-g));
        mix[(size_t)(tok0 + i) * D + h * 64 + lane] = (bf16)f2bf(y); }
    __syncthreads();
}
__device__ __forceinline__ void pool_item(const Args& a, int l, int item, LAS unsigned char* lds, int tid) {
    const int g = item & 3, tt = (item >> 2) & 31, b = item >> 7, t0 = tt * 64;
    LAS float* u = (LAS float*)lds;
    LAS float* w = u + 79 * 64;
    LAS float* p = w + 4096;
    const bf16* z = (const bf16*)(a.ws + WS_Z); bf16* mix = (bf16*)(a.ws + WS_MIX);
    for (int i = tid; i < 79 * 64; i += NTHR) { const int t = t0 - 15 + (i >> 6); u[i] = t >= 0 ? bf1(z[(size_t)(b * T + t) * ZW + Z_BU + g * 64 + (i & 63)]) : 0.f; }
    for (int i = tid; i < 4096; i += NTHR) w[i] = a.in[IN_PW][(size_t)(l * 4 + g) * 4096 + i];
    __syncthreads();
    const int win = 2 << g;
    for (int i = tid; i < 4096; i += NTHR) { const int tl = i >> 6, c = i & 63, t = t0 + tl, cnt = (t + 1 < win) ? t + 1 : win; float s = 0.f;
        for (int j = 0; j < cnt; ++j) s += u[(tl + 15 - j) * 64 + c];
        p[tl * 65 + c] = s / (float)cnt - u[(tl + 15) * 64 + c]; }
    __syncthreads();
    for (int i = tid; i < 4096; i += NTHR) { const int tl = i >> 6, d = i & 63; float s = a.in[IN_PB][(l * 4 + g) * 64 + d];
#pragma unroll 8
        for (int c = 0; c < 64; ++c) s += p[tl * 65 + c] * w[c * 64 + d];
        s *= a.in[IN_PS][l * 256 + g * 64 + d];
        mix[(size_t)(b * T + t0 + tl) * D + 256 + g * 64 + d] = (bf16)f2bf(s); }
    __syncthreads();
}
__device__ __forceinline__ void sgu_item(const Args& a, int l, int item, LAS unsigned char* lds, int tid) {
    const int g = item & 3, nc = (item >> 2) & 15, b = item >> 6, tok0 = b * T + nc * 128, lane = tid & 63, w = tid >> 6;
    LAS float* vn = (LAS float*)lds;
    const bf16* z = (const bf16*)(a.ws + WS_Z); bf16* mix = (bf16*)(a.ws + WS_MIX);
    for (int j = 0; j < 16; ++j) { const int s = w + 8 * j;
        const v2u raw = *(const v2u*)(z + (size_t)(tok0 + s) * ZW + Z_DUV + 256 + 4 * lane);
        float x[4] = {gelu_tanh(bflo(raw.x)), gelu_tanh(bfhi(raw.x)), gelu_tanh(bflo(raw.y)), gelu_tanh(bfhi(raw.y))};
        const float mu = wave_sum((x[0] + x[1]) + (x[2] + x[3])) * (1.0f / 256.0f);
        float q = 0.f;
#pragma unroll
        for (int i = 0; i < 4; ++i) { x[i] -= mu; q += x[i] * x[i]; }
        const float rstd = rsqrtf(wave_sum(q) * (1.0f / 256.0f) + EPS);
        if ((lane >> 4) == g) {
#pragma unroll
            for (int i = 0; i < 4; ++i) { const int cl = 4 * (lane & 15) + i; vn[s * 64 + cl] = x[i] * rstd * a.in[IN_LNG][l * 256 + g * 64 + cl] + a.in[IN_LNB][l * 256 + g * 64 + cl]; } } }
    __syncthreads();
    const float* sw = a.in[IN_SW] + (size_t)(l * 4 + g) * 128 * 128;
    for (int j = 0; j < 16; ++j) { const int t = w + 8 * j; float acc = a.in[IN_SB][(l * 4 + g) * 128 + t];
        const float* swr = sw + t * 128;
        for (int s = 0; s <= t; ++s) acc += swr[s] * vn[s * 64 + lane];
        const float uu = gelu_tanh(bf1(z[(size_t)(tok0 + t) * ZW + Z_DUV + g * 64 + lane]));
        mix[(size_t)(tok0 + t) * D + 768 + g * 64 + lane] = (bf16)f2bf(uu * acc); }
    __syncthreads();
}
__device__ __forceinline__ void xattn_item(const Args& a, int l, int item, LAS unsigned char* lds, int tid) {
    const int qtile = item & 31, h = (item >> 5) & 3, b = item >> 7, lane = tid & 63, w = tid >> 6;
    LAS float* Ks = (LAS float*)lds;
    LAS float* Vs = Ks + 256 * 65;
    LAS float* qs = Vs + 256 * 64;
    LAS float* pw = qs + 512;
    const bf16* kvm = (const bf16*)(a.ws + WS_KVM + (size_t)l * SZ_KVM); const bf16* qx = (const bf16*)(a.ws + WS_QX); bf16* ox = (bf16*)(a.ws + WS_OX);
    for (int i = tid; i < 16384; i += NTHR) { const int key = i >> 6, d = i & 63; const size_t o = (size_t)(b * MEMLEN + key) * 512 + h * 64 + d;
        Ks[key * 65 + d] = bf1(kvm[o]); Vs[key * 64 + d] = bf1(kvm[o + 256]); }
    __syncthreads();
    for (int qq = 0; qq < 8; ++qq) { const int row = b * T + qtile * 64 + w * 8 + qq;
        qs[w * 64 + lane] = bf1(qx[(size_t)row * 256 + h * 64 + lane]);
        LDS_WAIT(); asm volatile("" ::: "memory");
        float s[4] = {0.f, 0.f, 0.f, 0.f};
        for (int d = 0; d < 64; ++d) { const float qd = qs[w * 64 + d];
#pragma unroll
            for (int j = 0; j < 4; ++j) s[j] += qd * Ks[(lane + 64 * j) * 65 + d]; }
        const float mx = wave_max(fmaxf(fmaxf(s[0], s[1]), fmaxf(s[2], s[3])));
        float e[4], sum = 0.f;
#pragma unroll
        for (int j = 0; j < 4; ++j) { e[j] = expf(s[j] - mx); sum += e[j]; }
        const float inv = 1.0f / wave_sum(sum);
#pragma unroll
        for (int j = 0; j < 4; ++j) pw[w * 256 + lane + 64 * j] = e[j] * inv;
        LDS_WAIT(); asm volatile("" ::: "memory");
        float o = 0.f;
        for (int key = 0; key < 256; ++key) o += pw[w * 256 + key] * Vs[key * 64 + lane];
        ox[(size_t)row * 256 + h * 64 + lane] = (bf16)f2bf(o);
        LDS_WAIT(); asm volatile("" ::: "memory"); }
    __syncthreads();
}

__device__ __forceinline__ unsigned ord_u(float f) { const unsigned u = __builtin_bit_cast(unsigned, f); return (u & 0x80000000u) ? ~u : (u | 0x80000000u); }
__device__ __forceinline__ int rel_bucket(int n) {
    if (n < 16) return n;
    int large = 16 + (int)(logf((float)n / 16.0f) / logf(8.0f) * 16.0f);
    return large < 31 ? large : 31;
}
__device__ __forceinline__ void dsa_setup(const Args& a, LAS unsigned char* lds, int tid) {
    LAS float* biasd = (LAS float*)(lds + 48 * 1024);
    for (int i = tid; i < 129 * 4; i += NTHR) { const int d = i >> 2, h = i & 3; biasd[i] = a.in[IN_RELB][rel_bucket(d) * 4 + h]; }
    __syncthreads();
}
__device__ __forceinline__ void dsa_item(const Args& a, int item, LAS unsigned char* lds, int tid) {
    const int b = item / T, t = item % T, nk = t + 1, lane = tid & 63, w = tid >> 6;
    LAS unsigned* su = (LAS unsigned*)lds;
    LAS float* lg = (LAS float*)(lds + 8192);
    LAS float* qi = (LAS float*)(lds + 8192 + 32768);
    LAS float* qv = qi + 256;
    LAS float* wi = qv + 256;
    LAS unsigned* cnt = (LAS unsigned*)(wi + 8);
    LAS float* red = (LAS float*)(cnt + 40);
    LAS float* red2 = red + 64;
    LAS float* biasd = (LAS float*)(lds + 48 * 1024);
    const bf16* z = (const bf16*)(a.ws + WS_Z); bf16* mix = (bf16*)(a.ws + WS_MIX);
    const size_t row = (size_t)b * T + t;
    if (tid < 256) { qi[tid] = bf1(z[row * ZW + Z_CQI + tid]) * 0.17677669529663687f; qv[tid] = bf1(z[row * ZW + Z_CQ + tid]) * 0.125f; }
    if (tid < 8) wi[tid] = bf1(z[row * ZW + Z_CWI + tid]) * 0.35355339059327373f;
    if (tid < 40) cnt[tid] = 0u;
    __syncthreads();
    unsigned myu[4];
#pragma unroll
    for (int j = 0; j < 4; ++j) { const int key = tid + NTHR * j; myu[j] = 0u;
        if (key < nk) { const v4u* kp = (const v4u*)(z + ((size_t)b * T + key) * ZW + Z_CKI); float kf[32];
#pragma unroll
            for (int i = 0; i < 4; ++i) { const v4u r = kp[i]; kf[8 * i + 0] = bflo(r.x); kf[8 * i + 1] = bfhi(r.x); kf[8 * i + 2] = bflo(r.y); kf[8 * i + 3] = bfhi(r.y); kf[8 * i + 4] = bflo(r.z); kf[8 * i + 5] = bfhi(r.z); kf[8 * i + 6] = bflo(r.w); kf[8 * i + 7] = bfhi(r.w); }
            float sc = 0.f;
            for (int hh = 0; hh < 8; ++hh) { float dot = 0.f;
#pragma unroll
                for (int d = 0; d < 32; ++d) dot += qi[hh * 32 + d] * kf[d];
                sc += fmaxf(dot, 0.f) * wi[hh]; }
            sc += 0.0f;
            myu[j] = ord_u(sc); su[key] = myu[j]; } }
    __syncthreads();
    bool sel[4];
#pragma unroll
    for (int j = 0; j < 4; ++j) sel[j] = (tid + NTHR * j) < nk;
    if (nk > 256) {
        unsigned Tt = 0u;
        for (int bit = 31; bit >= 0; --bit) { const unsigned cand = Tt | (1u << bit); int c = 0;
#pragma unroll
            for (int j = 0; j < 4; ++j) c += (myu[j] >= cand) ? 1 : 0;
            c = (int)wave_sum((float)c);
            if (lane == 0 && c) LDS_ADD(&cnt[bit], (unsigned)c);
            __syncthreads();
            if (cnt[bit] >= 256u) Tt = cand; }
        { int c = 0;
#pragma unroll
            for (int j = 0; j < 4; ++j) c += (myu[j] > Tt) ? 1 : 0;
            c = (int)wave_sum((float)c);
            if (lane == 0 && c) LDS_ADD(&cnt[32], (unsigned)c);
            __syncthreads(); }
        const int r = 256 - (int)cnt[32];
#pragma unroll
        for (int j = 0; j < 4; ++j) { const int key = tid + NTHR * j;
            if (myu[j] > Tt) sel[j] = true;
            else if (myu[j] == Tt && key < nk) { int rank = 0; for (int s = 0; s < key; ++s) rank += (su[s] == Tt) ? 1 : 0; sel[j] = rank < r; }
            else sel[j] = false; }
    }
    float lmax[4] = {-INFINITY, -INFINITY, -INFINITY, -INFINITY};
#pragma unroll
    for (int j = 0; j < 4; ++j) { const int key = tid + NTHR * j;
        if (key < nk) {
            float lv[4] = {-INFINITY, -INFINITY, -INFINITY, -INFINITY};
            if (sel[j]) { const v4u* kp = (const v4u*)(z + ((size_t)b * T + key) * ZW + Z_CK); const int dd = (t - key) < 128 ? (t - key) : 128;
#pragma unroll
                for (int hh = 0; hh < 4; ++hh) { float dot = 0.f;
#pragma unroll
                    for (int i = 0; i < 8; ++i) { const v4u r = kp[hh * 8 + i]; const LAS float* qq = qv + hh * 64 + 8 * i;
                        dot += qq[0] * bflo(r.x) + qq[1] * bfhi(r.x) + qq[2] * bflo(r.y) + qq[3] * bfhi(r.y) + qq[4] * bflo(r.z) + qq[5] * bfhi(r.z) + qq[6] * bflo(r.w) + qq[7] * bfhi(r.w); }
                    lv[hh] = dot + biasd[dd * 4 + hh]; lmax[hh] = fmaxf(lmax[hh], lv[hh]); } }
#pragma unroll
            for (int hh = 0; hh < 4; ++hh) lg[hh * 2048 + key] = lv[hh]; } }
#pragma unroll
    for (int hh = 0; hh < 4; ++hh) { const float m = wave_max(lmax[hh]); if (lane == 0) red[w * 4 + hh] = m; }
    __syncthreads();
    float mx[4], lsum[4] = {0.f, 0.f, 0.f, 0.f};
#pragma unroll
    for (int hh = 0; hh < 4; ++hh) { float m = red[hh]; for (int ww = 1; ww < 8; ++ww) m = fmaxf(m, red[ww * 4 + hh]); mx[hh] = m; }
#pragma unroll
    for (int j = 0; j < 4; ++j) { const int key = tid + NTHR * j;
        if (key < nk) {
#pragma unroll
            for (int hh = 0; hh < 4; ++hh) { const float lv = lg[hh * 2048 + key]; const float p = (lv == -INFINITY) ? 0.f : expf(lv - mx[hh]); lg[hh * 2048 + key] = p; lsum[hh] += p; } } }
#pragma unroll
    for (int hh = 0; hh < 4; ++hh) { const float s = wave_sum(lsum[hh]); if (lane == 0) red[32 + w * 4 + hh] = s; }
    __syncthreads();
    { const int half = tid >> 8, hd = tid & 255, hh = hd >> 6; float acc = 0.f;
      const bf16* vp = z + (size_t)b * T * ZW + Z_CV + hd;
      for (int key = half; key < nk; key += 2) { const float p = lg[hh * 2048 + key]; if (p != 0.f) acc += p * bf1(vp[(size_t)key * ZW]); }
      red2[tid] = acc; }
    __syncthreads();
    if (tid < 256) { const int hh = tid >> 6; float s = 0.f; for (int ww = 0; ww < 8; ++ww) s += red[32 + ww * 4 + hh];
        mix[row * D + 512 + tid] = (bf16)f2bf((red2[tid] + red2[tid + 256]) / s); }
    __syncthreads();
}

__device__ __forceinline__ void moe_route(const Args& a, LAS unsigned char* lds, int tid, int G) {
    const int lane = tid & 63, w = tid >> 6;
    LAS float* rt = (LAS float*)lds;
    LAS unsigned* cnt = (LAS unsigned*)(lds + 32768);
    const float* h = a.out; unsigned char* ws = a.ws;
    for (int i = tid; i < 8192; i += NTHR) rt[(i & 7) * 1024 + (i >> 3)] = a.in[IN_ROUTER][i] * a.in[IN_NFFN][D + (i >> 3)];
    __syncthreads();
    for (int chunk = blockIdx.x; chunk < 256; chunk += G) {
        if (tid < 8) cnt[tid] = 0u;
        __syncthreads();
        for (int q = 0; q < 8; ++q) { const int tk = chunk * 64 + w * 8 + q;
            const f32x4* hr = (const f32x4*)(h + (size_t)tk * D) + lane; float lg[8] = {0.f, 0.f, 0.f, 0.f, 0.f, 0.f, 0.f, 0.f}; float ss = 0.f;
#pragma unroll
            for (int j = 0; j < 4; ++j) { const f32x4 v = hr[64 * j]; const int c0 = 4 * (lane + 64 * j);
                ss += (v.x * v.x + v.y * v.y) + (v.z * v.z + v.w * v.w);
#pragma unroll
                for (int e = 0; e < 8; ++e) { const f32x4 r = *(const LAS f32x4*)(rt + e * 1024 + c0); lg[e] += (v.x * r.x + v.y * r.y) + (v.z * r.z + v.w * r.w); } }
            ss = wave_sum(ss); const float rstd = rsqrtf(ss * (1.0f / 1024.0f) + EPS);
#pragma unroll
            for (int e = 0; e < 8; ++e) lg[e] = wave_sum(lg[e]) * rstd;
            int e0 = 0; float v0 = lg[0];
#pragma unroll
            for (int e = 1; e < 8; ++e) if (lg[e] > v0) { v0 = lg[e]; e0 = e; }
            int e1 = -1; float v1 = -INFINITY;
#pragma unroll
            for (int e = 0; e < 8; ++e) if (e != e0 && lg[e] > v1) { v1 = lg[e]; e1 = e; }
            const float g0 = 1.0f / (1.0f + expf(v1 - v0)), g1 = 1.0f - g0;
            if (lane == 0) { ((int*)(ws + WS_TOKE))[2 * tk] = e0; ((int*)(ws + WS_TOKE))[2 * tk + 1] = e1; ((float*)(ws + WS_TOKG))[2 * tk] = g0; ((float*)(ws + WS_TOKG))[2 * tk + 1] = g1;
                ((float*)(ws + WS_TOKR))[tk] = rstd; LDS_ADD(&cnt[e0], 1u); LDS_ADD(&cnt[e1], 1u); } }
        __syncthreads();
        if (tid < 8) ((int*)(ws + WS_CNT))[chunk * 8 + tid] = (int)cnt[tid];
        __syncthreads();
    }
}
__device__ __forceinline__ void moe_assign(const Args& a, LAS unsigned char* lds, int tid, int G) {
    const int lane = tid & 63, w = tid >> 6;
    LAS int* cn = (LAS int*)lds;
    LAS int* tot = cn + 2048;
    LAS int* basee = tot + 8;
    LAS int* sl = basee + 8;
    LAS int* pref = sl + 128;
    unsigned char* ws = a.ws;
    const int* CNT = (const int*)(ws + WS_CNT); int* TILEE = (int*)(ws + WS_TILEE);
    const int* TOKE = (const int*)(ws + WS_TOKE); const float* TOKG = (const float*)(ws + WS_TOKG); const float* TOKR = (const float*)(ws + WS_TOKR); int* TOKS = (int*)(ws + WS_TOKS);
    float* SLOTR = (float*)(ws + WS_SLOTR); float* SLOTG = (float*)(ws + WS_SLOTG);
    const bf16* HB = (const bf16*)(ws + WS_HB); bf16* AG = (bf16*)(ws + WS_AG);
    for (int i = tid; i < 2048; i += NTHR) cn[i] = CNT[i];
    __syncthreads();
    if (tid < 8) { int s = 0; for (int c = 0; c < 256; ++c) s += cn[c * 8 + tid]; tot[tid] = s; }
    __syncthreads();
    if (tid == 0) { int tile = 0; for (int e = 0; e < 8; ++e) { basee[e] = tile * 256; const int nt = (tot[e] + 255) >> 8;
            if (blockIdx.x == 0) for (int q = 0; q < nt; ++q) TILEE[tile + q] = e;
            tile += nt; }
        if (blockIdx.x == 0) { for (int q = tile; q < 159; ++q) TILEE[q] = 0; TILEE[159] = tile; } }
    __syncthreads();
    for (int e = blockIdx.x; e < 8; e += G) { const int s0 = basee[e] + tot[e], s1 = basee[e] + (((tot[e] + 255) >> 8) << 8);
        for (int s = s0 + w; s < s1; s += NWAVES) { v4u* rp = (v4u*)(AG + (size_t)s * D) + lane; rp[0] = (v4u){0u, 0u, 0u, 0u}; rp[64] = (v4u){0u, 0u, 0u, 0u}; if (lane == 0) { SLOTR[s] = 0.f; SLOTG[s] = 0.f; } } }
    for (int chunk = blockIdx.x; chunk < 256; chunk += G) {
        if (tid < 8) { int s = 0; for (int c = 0; c < chunk; ++c) s += cn[c * 8 + tid]; int pos = basee[tid] + s;
            for (int i = 0; i < 128; ++i) { const int tk = chunk * 64 + (i >> 1); if (TOKE[2 * tk + (i & 1)] == tid) { sl[i] = pos; SLOTR[pos] = TOKR[tk]; SLOTG[pos] = TOKG[2 * tk + (i & 1)]; TOKS[2 * tk + (i & 1)] = pos; ++pos; } } }
        __syncthreads();
        for (int q = 0; q < 16; ++q) { const int i = w * 16 + q, tk = chunk * 64 + (i >> 1), s = sl[i];
            const v4u* src = (const v4u*)(HB + (size_t)tk * D) + lane; v4u* dst = (v4u*)(AG + (size_t)s * D) + lane; dst[0] = src[0]; dst[64] = src[64]; }
        __syncthreads();
    }
}
__device__ __forceinline__ void final_phase(const Args& a, int tid, int G) {
    const int lane = tid & 63, gw = blockIdx.x * NWAVES + (tid >> 6), NGW = G * NWAVES;
    const int* TOKS = (const int*)(a.ws + WS_TOKS); const bf16* YS = (const bf16*)(a.ws + WS_YS);
    for (int tk = gw; tk < M; tk += NGW) { const int s0 = TOKS[2 * tk], s1 = TOKS[2 * tk + 1];
        f32x4* hr = (f32x4*)(a.out + (size_t)tk * D) + lane; const v2u* y0 = (const v2u*)(YS + (size_t)s0 * D) + lane; const v2u* y1 = (const v2u*)(YS + (size_t)s1 * D) + lane;
        f32x4 v[4]; float ss = 0.f;
#pragma unroll
        for (int j = 0; j < 4; ++j) { v[j] = hr[64 * j]; const v2u p = y0[64 * j], q = y1[64 * j];
            v[j].x += bflo(p.x) + bflo(q.x); v[j].y += bfhi(p.x) + bfhi(q.x); v[j].z += bflo(p.y) + bflo(q.y); v[j].w += bfhi(p.y) + bfhi(q.y);
            ss += (v[j].x * v[j].x + v[j].y * v[j].y) + (v[j].z * v[j].z + v[j].w * v[j].w); }
        const float rstd = rsqrtf(wave_sum(ss) * (1.0f / 1024.0f) + EPS);
#pragma unroll
        for (int j = 0; j < 4; ++j) { const f32x4 g = ((const f32x4*)a.in[IN_FNORM])[lane + 64 * j]; hr[64 * j] = v[j] * rstd * g; } }
}

constexpr int NPHASE = 28;
#define OTID() int tid = threadIdx.x; asm volatile("" : "+v"(tid))
__global__ void __launch_bounds__(NTHR, 2) fwd_kernel(Args a) {
    extern __shared__ __attribute__((aligned(16))) unsigned char lds_raw[];
    LAS unsigned char* lds = (LAS unsigned char*)lds_raw;
    const int G = gridDim.x, bid = blockIdx.x;
    volatile LAS unsigned* MISC = (volatile LAS unsigned*)(lds + MISC_OFF);
    if (threadIdx.x < 32) MISC[threadIdx.x] = 0u;
    __syncthreads();
    unsigned char* ws = a.ws;
    XcdBarrier bar; bar.bar = (unsigned*)(ws + WS_CTL) + CW_BAR; bar.x = 0; bar.st = nullptr;
    if (N_LAUNCH_MODE == 1) bar = xcd_barrier_post((unsigned*)(ws + WS_CTL) + CW_BAR, MISC + 8);
    const int lo = a.ph_lo, hi = a.ph_hi;
#define RUN(k) (lo <= (k) && (k) < hi)
#define SEAM() do { if (N_LAUNCH_MODE == 1) xcd_barrier(bar); } while (0)
#define WB(off) ((bf16*)(ws + (off)))
#define WF(off) ((float*)(ws + (off)))
    if (RUN(0)) { OTID(); p0_prologue(a, lds, tid, G); SEAM(); }

    for (int l = 0; l < 2; ++l) {
        const int pb = l ? 10 : 1;
        if (RUN(pb + 0)) {
            { pg8::Gemm g{WB(WS_HB), WB(WS_WIN + l * SZ_WIN), M, ZW, D}; pg8::StaticOrder S; S.init(M, ZW, G, bid);
              EpiScale E{WB(WS_Z), ZW, WF(WS_SS), 1.0f}; pg8::gemm_phase<EpiScale, pg8::StaticOrder, true, true>(lds, g, S, E); }
            if (l == 0) {
                for (int l2 = 0; l2 < 2; ++l2) {
                    pg8::Gemm g{WB(WS_MEMB), WB(WS_WKV + l2 * SZ_WKV), MM, 512, D}; pg8::StaticOrder S; S.init(MM, 512, G, (G - 1 - bid - 16 * l2 + 2 * G) % G);
                    EpiScale E{WB(WS_KVM + l2 * SZ_KVM), 512, WF(WS_SSM), 1.0f}; pg8::gemm_phase<EpiScale, pg8::StaticOrder, true, true>(lds, g, S, E); }
            }
            SEAM();
        }
        if (RUN(pb + 1)) {
            { OTID(); for (int it = bid; it < 1024; it += G) gla_a_item(a, l, it, lds, tid); }
            { OTID(); for (int it = bid; it < 1024; it += G) pool_item(a, l, it, lds, tid); }
            { OTID(); for (int it = bid; it < 512; it += G) sgu_item(a, l, it, lds, tid); }
            { OTID(); dsa_setup(a, lds, tid); for (int it = M - 1 - bid; it >= 0; it -= G) dsa_item(a, it, lds, tid); }
            SEAM();
        }
        if (RUN(pb + 2)) { OTID(); for (int it = bid; it < 1024; it += G) gla_c_item(a, l, it, lds, tid); SEAM(); }
        if (RUN(pb + 3)) {
            pg8::Gemm g{WB(WS_MIX), WB(WS_WOUT + l * SZ_WOUT), M, D, D}; pg8::StaticOrder S; S.init(M, D, G, bid);
            EpiResid E{l == 0 ? a.in[IN_X] : (const float*)a.out, a.out, WB(WS_HB), WF(WS_SS)}; pg8::gemm_phase<EpiResid, pg8::StaticOrder, true, true>(lds, g, S, E); SEAM();
        }
        if (RUN(pb + 4)) {
            pg8::Gemm g{WB(WS_HB), WB(WS_WQ + l * SZ_WQ), M, 256, D}; pg8::StaticOrder S; S.init(M, 256, G, bid);
            EpiScale E{WB(WS_QX), 256, WF(WS_SS), 0.125f}; pg8::gemm_phase<EpiScale, pg8::StaticOrder, true, true>(lds, g, S, E); SEAM();
        }
        if (RUN(pb + 5)) { OTID(); for (int it = bid; it < 1024; it += G) xattn_item(a, l, it, lds, tid); SEAM(); }
        if (RUN(pb + 6)) {
            pg8::Gemm g{WB(WS_OX), WB(WS_WO + l * SZ_WO), M, D, 256}; pg8::StaticOrder S; S.init(M, D, G, bid);
            EpiResid E{a.out, a.out, WB(WS_HB), WF(WS_SS)}; pg8::gemm_phase<EpiResid, pg8::StaticOrder, true, true>(lds, g, S, E); SEAM();
        }
        if (l == 0) {
            if (RUN(8)) {
                pg8::Gemm g{WB(WS_HB), WB(WS_W13), M, 2 * DFF, D}; pg8::StaticOrder S; S.init(M, 2 * DFF, G, bid);
                EpiSwiglu<false> E{WB(WS_FACT), DFF, WF(WS_SS), nullptr, nullptr}; pg8::gemm_phase<EpiSwiglu<false>, pg8::StaticOrder, true, true>(lds, g, S, E); SEAM();
            }
            if (RUN(9)) {
                pg8::Gemm g{WB(WS_FACT), WB(WS_W2), M, D, DFF}; pg8::StaticOrder S; S.init(M, D, G, bid);
                EpiResid E{a.out, a.out, WB(WS_HB), WF(WS_SS)}; pg8::gemm_phase<EpiResid, pg8::StaticOrder, true, true>(lds, g, S, E); SEAM();
            }
        } else {
            if (RUN(17)) { OTID(); moe_route(a, lds, tid, G); SEAM(); }
            if (RUN(18)) { OTID(); moe_assign(a, lds, tid, G); SEAM(); }
            for (int p = 0; p < MOE_NPASS; ++p) {
                const int* TILEE = (const int*)(ws + WS_TILEE);
                if (RUN(19 + 2 * p)) {
                    const int NT = TILEE[159]; int nt = NT - p * MOE_TP; nt = nt < 0 ? 0 : (nt > MOE_TP ? MOE_TP : nt);
                    pg8::Gemm g{WB(WS_AG), WB(WS_MW13), MAXSLOT, NEXP * 2 * DFE, D}; pg8::MoeOrder S{p * MOE_TP, nt, 2 * DFE / 256, G, bid, 0, TILEE};
                    EpiSwiglu<true> E{WB(WS_MACT), DFE, nullptr, WF(WS_SLOTR), WF(WS_SLOTG)};
                    pg8::gemm_phase<EpiSwiglu<true>, pg8::MoeOrder, true, true>(lds, g, S, E); SEAM();
                }
                if (RUN(20 + 2 * p)) {
                    const int NT = TILEE[159]; int nt = NT - p * MOE_TP; nt = nt < 0 ? 0 : (nt > MOE_TP ? MOE_TP : nt);
                    pg8::Gemm g{WB(WS_MACT), WB(WS_MW2), MOE_TP * 256, NEXP * D, DFE}; pg8::MoeOrder S{p * MOE_TP, nt, D / 256, G, bid, 1, TILEE};
                    EpiPlain E{WB(WS_YS), D};
                    pg8::gemm_phase<EpiPlain, pg8::MoeOrder, true, true>(lds, g, S, E); SEAM();
                }
            }
            if (RUN(27)) { OTID(); final_phase(a, tid, G); }
        }
    }
#undef RUN
#undef SEAM
}

extern "C" void kernel_launch(void* const* d_in, const int* in_sizes, int n_in, void* d_out, int out_size, void* d_ws, size_t ws_size, hipStream_t stream) {
    static int grid = 0;
    if (grid == 0) {
        if (n_in != N_IN || out_size != M * D || ws_size < WS_END) { fprintf(stderr, "kernel_launch: unexpected problem (n_in %d, out %d, ws %zu < %zu)\n", n_in, out_size, ws_size, (size_t)WS_END); grid = -1; return; }
        int dev = 0, cus = 0, per_cu = 0;
        if (hipGetDevice(&dev) != hipSuccess || hipDeviceGetAttribute(&cus, hipDeviceAttributeMultiprocessorCount, dev) != hipSuccess) { grid = -1; return; }
        if (hipFuncSetAttribute((const void*)fwd_kernel, hipFuncAttributeMaxDynamicSharedMemorySize, LDS_BYTES) != hipSuccess) { fprintf(stderr, "kernel_launch: hipFuncSetAttribute failed\n"); grid = -1; return; }
        if (hipOccupancyMaxActiveBlocksPerMultiprocessor(&per_cu, (const void*)fwd_kernel, NTHR, LDS_BYTES) != hipSuccess || per_cu < 1) { fprintf(stderr, "kernel_launch: occupancy query says %d\n", per_cu); }
        (void)hipGetLastError();
        grid = cus > 0 ? cus : 256;
    }
    if (grid < 0) return;
    (void)hipMemsetAsync((char*)d_ws + WS_CTL, 0, CTL_ZERO_BYTES, stream);
    Args a{};
    for (int i = 0; i < N_IN; ++i) a.in[i] = (const float*)d_in[i];
    a.out = (float*)d_out; a.ws = (unsigned char*)d_ws;
#if N_LAUNCH_MODE == 1
    a.ph_lo = 0; a.ph_hi = NPHASE;
    hipLaunchKernelGGL(fwd_kernel, dim3(grid), dim3(NTHR), LDS_BYTES, stream, a);
#else
    for (int p = 0; p < NPHASE; ++p) { a.ph_lo = p; a.ph_hi = p + 1; hipLaunchKernelGGL(fwd_kernel, dim3(grid), dim3(NTHR), LDS_BYTES, stream, a); }
#endif
}
```

```cpp
#include <hip/hip_runtime.h>
#include <cstdio>
#include <cstdint>
#include <cmath>

#ifndef N_LAUNCH_MODE
#define N_LAUNCH_MODE 1
#endif

namespace pg8 {
#define PG8_LAS __attribute__((address_space(3)))
typedef unsigned short bf16_t;
typedef short bf16x8 __attribute__((ext_vector_type(8)));
typedef float f32x4 __attribute__((ext_vector_type(4)));
typedef unsigned u32x4 __attribute__((ext_vector_type(4)));
constexpr int BM = 256, BK = 64, HALF = 128, HTB = HALF * BK * 2  , STAGE_BYTES = 8 * HTB, NXCD = 8, WGM = 8;

__host__ __device__ __forceinline__ int lds_byte(int r, int c) { const int st = (r >> 4) * 2 + (c >> 5), rr = r & 15, cc = c & 31, ob = rr * 64 + cc * 2; return st * 1024 + (ob ^ (((ob >> 9) & 1) << 5)); }
__host__ __device__ __forceinline__ void stage_rc(int b, int& R, int& C) { const int st = b / 1024, sb = b % 1024, swz = sb ^ (((sb >> 9) & 1) << 5); R = (st >> 1) * 16 + swz / 64; C = (st & 1) * 32 + (swz % 64) / 2; }
__host__ __device__ __forceinline__ int perm32(int rho) { const int n = rho >> 4, i = rho & 15; return 8 * (i >> 2) + 4 * n + (i & 3); }

struct Unit { int pm, pn, po, e; };
struct Gemm { const bf16_t* A; const bf16_t* Bt; int M, N, K; };

struct StaticOrder {
    int nM, nN, nwg, G, c;
    __host__ __device__ void init(int M, int N, int G_, int c_) { nM = M / BM; nN = N / BM; nwg = nM * nN; G = G_; c = c_; }
    __host__ __device__ bool next(int i, Unit& u) const {
        const long L = (long)i * G + c; if (L >= nwg) return false;
        int wgid = (int)L; { const int q = nwg / NXCD, r = nwg % NXCD, xcd = wgid % NXCD, off = wgid / NXCD; wgid = (xcd < r ? xcd * (q + 1) : r * (q + 1) + (xcd - r) * q) + off; }
        const int nig = WGM * nN, gid = wgid / nig, fm = gid * WGM, gsz = (nM - fm) < WGM ? (nM - fm) : WGM;
        u.pm = fm + ((wgid % nig) % gsz); u.pn = (wgid % nig) / gsz; u.po = u.pm; u.e = u.pn; return true;
    }
    __device__ __forceinline__ void a_ready(const Unit&) const {}
    __device__ __forceinline__ void done(const Unit&) const {}
};
struct MoeOrder {
    int t0, nt, nNe, G, c, a_local; const int* tile_e;
    __device__ bool next(int i, Unit& u) const {
        const long L = (long)i * G + c; if (L >= (long)nt * nNe) return false;
        const int tl = (int)(L % nt), pn = (int)(L / nt), tile = t0 + tl, e = tile_e[tile];
        u.pm = a_local ? tl : tile; u.po = a_local ? tile : tl; u.pn = e * nNe + pn; u.e = pn; return true;
    }
    __device__ __forceinline__ void a_ready(const Unit&) const {}
    __device__ __forceinline__ void done(const Unit&) const {}
};
__device__ __forceinline__ unsigned cvt_pk_bf16(float lo, float hi) { unsigned r; asm volatile("v_cvt_pk_bf16_f32 %0, %1, %2" : "=v"(r) : "v"(lo), "v"(hi)); return r; }
template <class Epi, class Sched, bool ALIGN_EPI = false, bool SP2 = false>
__device__ __forceinline__ void gemm_phase(PG8_LAS unsigned char* lds, const Gemm g, const Sched& S, const Epi& E) {
    int tid_ = threadIdx.x; asm volatile("" : "+v"(tid_)); const int tid = tid_, wid = __builtin_amdgcn_readfirstlane(tid >> 6), lane = tid & 63, wr = wid >> 2, wc = wid & 3, fr = lane & 15, fq = lane >> 4;
    const int K = g.K, nt = K / BK;
    unsigned voffA[2], voffB[2];
#pragma unroll
    for (int i = 0; i < 2; ++i) { int R, C; stage_rc(tid * 16 + i * 8192, R, C); const int Rb = Epi::PERM ? ((R & ~31) + perm32(R & 31)) : R;
        voffA[i] = (unsigned)(R * K + C) * 2u; voffB[i] = (unsigned)(Rb * K + C) * 2u; }
    const size_t kstep = (size_t)(BK * 2);
    const size_t hstep = (size_t)HALF * K * 2;
    const size_t tstep = 2 * hstep;
    const unsigned ldsw = (unsigned)wid * 1024u;
    const int aoff = lds_byte(wr * 64 + fr, fq * 8), boff = lds_byte(wc * 32 + fr, fq * 8);
#define PG8_SA(b, h) (((b) * 2 + (h)) * HTB)
#define PG8_SB(b, h) ((4 + (b) * 2 + (h)) * HTB)
#define PG8_STAGE(bufoff, gbase, voff) do { _Pragma("unroll") for (int _i = 0; _i < 2; ++_i) \
        __builtin_amdgcn_global_load_lds((const unsigned*)((const char*)(gbase) + (voff)[_i]), (PG8_LAS unsigned*)(lds + (bufoff) + ldsw + _i * 8192), 16, 0, 0); } while (0)
#define PG8_LDA(dst, b, h) do { _Pragma("unroll") for (int m = 0; m < 4; ++m) _Pragma("unroll") for (int k = 0; k < 2; ++k) dst[m][k] = *(const PG8_LAS bf16x8*)(lds + PG8_SA(b, h) + aoff + m * 2048 + k * 1024); } while (0)
#define PG8_LDB(dst, b, h) do { _Pragma("unroll") for (int n = 0; n < 2; ++n) _Pragma("unroll") for (int k = 0; k < 2; ++k) dst[n][k] = *(const PG8_LAS bf16x8*)(lds + PG8_SB(b, h) + boff + n * 2048 + k * 1024); } while (0)
#define PG8_MMA(ai, bj, At, Bt) do { __builtin_amdgcn_s_setprio(1); _Pragma("unroll") for (int m = 0; m < 4; ++m) _Pragma("unroll") for (int n = 0; n < 2; ++n) _Pragma("unroll") for (int k = 0; k < 2; ++k) \
        acc[ai][bj][m][n] = __builtin_amdgcn_mfma_f32_16x16x32_bf16(Bt[n][k], At[m][k], acc[ai][bj][m][n], 0, 0, 0); __builtin_amdgcn_s_setprio(0); } while (0)
#define PG8_WAIT_V(n) asm volatile("s_waitcnt vmcnt(" #n ")" ::: "memory")
#define PG8_WAIT_L(n) asm volatile("s_waitcnt lgkmcnt(" #n ")" ::: "memory")
#define PG8_BAR __builtin_amdgcn_s_barrier()
#define PG8_SCHED __builtin_amdgcn_sched_barrier(0)
    Unit cur, nxt; int ui = 0;
    if (!S.next(0, cur)) return;
    f32x4 acc[2][2][4][2];
#pragma unroll
    for (int a = 0; a < 2; ++a)
#pragma unroll
        for (int b = 0; b < 2; ++b)
#pragma unroll
            for (int m = 0; m < 4; ++m)
#pragma unroll
                for (int n = 0; n < 2; ++n) acc[a][b][m][n] = (f32x4){0.f, 0.f, 0.f, 0.f};
    bf16x8 At[4][2], B0[2][2], B1[2][2];
    const char* cA = (const char*)g.A + (size_t)cur.pm * tstep; const char* cB = (const char*)g.Bt + (size_t)cur.pn * tstep;
    S.a_ready(cur);
    if constexpr (SP2) {
        PG8_STAGE(PG8_SB(0, 0), cB, voffB); PG8_STAGE(PG8_SB(0, 1), cB + hstep, voffB); PG8_STAGE(PG8_SA(0, 0), cA, voffA); PG8_STAGE(PG8_SA(0, 1), cA + hstep, voffA);
        if (wr == 1) PG8_BAR;
        PG8_WAIT_V(2); PG8_BAR;
        PG8_STAGE(PG8_SB(1, 0), cB + kstep, voffB); PG8_STAGE(PG8_SA(1, 0), cA + kstep, voffA); PG8_STAGE(PG8_SB(1, 1), cB + hstep + kstep, voffB);
        PG8_WAIT_V(6); PG8_BAR;
    } else {
        PG8_STAGE(PG8_SB(0, 0), cB, voffB); PG8_STAGE(PG8_SA(0, 0), cA, voffA); PG8_STAGE(PG8_SB(0, 1), cB + hstep, voffB); PG8_STAGE(PG8_SA(0, 1), cA + hstep, voffA);
        if (wr == 1) PG8_BAR;
        PG8_WAIT_V(4); PG8_BAR;
        PG8_STAGE(PG8_SB(1, 0), cB + kstep, voffB); PG8_STAGE(PG8_SA(1, 0), cA + kstep, voffA); PG8_STAGE(PG8_SB(1, 1), cB + hstep + kstep, voffB);
        PG8_WAIT_V(6); PG8_BAR;
    }
    for (;;) {
        const bool has_next = S.next(ui + 1, nxt);
        const char* nA = has_next ? (const char*)g.A + (size_t)nxt.pm * tstep : cA; const char* nB = has_next ? (const char*)g.Bt + (size_t)nxt.pn * tstep : cB;
        for (int t = 0; t < nt; t += 2) {
            const bool last = (t == nt - 2);
            const char* a1 = cA + (size_t)(t + 1) * kstep;
            const char* a2 = last ? nA : cA + (size_t)(t + 2) * kstep; const char* b2 = last ? nB : cB + (size_t)(t + 2) * kstep;
            const char* a3 = a2 + kstep; const char* b3 = b2 + kstep;
            if (last && has_next) S.a_ready(nxt);
            if constexpr (SP2) {
            PG8_LDB(B0, 0, 0); PG8_LDB(B1, 0, 1); PG8_SCHED; PG8_LDA(At, 0, 0); PG8_STAGE(PG8_SA(1, 1), a1 + hstep, voffA);
            PG8_WAIT_V(8); PG8_WAIT_L(0); PG8_BAR; PG8_MMA(0, 0, At, B0); PG8_MMA(0, 1, At, B1); PG8_BAR; PG8_SCHED;
            PG8_LDA(At, 0, 1); PG8_STAGE(PG8_SB(0, 0), b2, voffB); PG8_STAGE(PG8_SB(0, 1), b2 + hstep, voffB); PG8_STAGE(PG8_SA(0, 0), a2, voffA);
            PG8_WAIT_V(8); PG8_WAIT_L(0); PG8_BAR; PG8_MMA(1, 0, At, B0); PG8_MMA(1, 1, At, B1); PG8_BAR; PG8_SCHED;
            PG8_LDB(B0, 1, 0); PG8_LDB(B1, 1, 1); PG8_SCHED; PG8_LDA(At, 1, 0); PG8_STAGE(PG8_SA(0, 1), a2 + hstep, voffA);
            PG8_WAIT_V(8); PG8_WAIT_L(0); PG8_BAR; PG8_MMA(0, 0, At, B0); PG8_MMA(0, 1, At, B1); PG8_BAR; PG8_SCHED;
            PG8_LDA(At, 1, 1); PG8_STAGE(PG8_SB(1, 0), b3, voffB); PG8_STAGE(PG8_SB(1, 1), b3 + hstep, voffB); PG8_STAGE(PG8_SA(1, 0), a3, voffA);
            PG8_WAIT_V(8); PG8_WAIT_L(0); PG8_BAR; PG8_MMA(1, 0, At, B0); PG8_MMA(1, 1, At, B1); PG8_BAR; PG8_SCHED;
            } else {
            PG8_LDB(B0, 0, 0); PG8_SCHED; PG8_LDA(At, 0, 0); PG8_STAGE(PG8_SA(1, 1), a1 + hstep, voffA);
            PG8_WAIT_L(8); PG8_BAR; PG8_WAIT_L(0); PG8_MMA(0, 0, At, B0); PG8_BAR; PG8_SCHED;
            PG8_LDB(B1, 0, 1); PG8_STAGE(PG8_SB(0, 0), b2, voffB);
            PG8_BAR; PG8_WAIT_L(0); PG8_MMA(0, 1, At, B1); PG8_BAR;
            PG8_LDA(At, 0, 1); PG8_STAGE(PG8_SA(0, 0), a2, voffA);
            PG8_BAR; PG8_WAIT_L(0); PG8_MMA(1, 0, At, B0); PG8_BAR; PG8_SCHED;
            PG8_STAGE(PG8_SB(0, 1), b2 + hstep, voffB);
            PG8_WAIT_V(6); PG8_BAR; PG8_MMA(1, 1, At, B1); PG8_BAR;
            PG8_LDB(B0, 1, 0); PG8_SCHED; PG8_LDA(At, 1, 0); PG8_STAGE(PG8_SA(0, 1), a2 + hstep, voffA);
            PG8_WAIT_L(8); PG8_BAR; PG8_WAIT_L(0); PG8_MMA(0, 0, At, B0); PG8_BAR; PG8_SCHED;
            PG8_LDB(B1, 1, 1); PG8_STAGE(PG8_SB(1, 0), b3, voffB);
            PG8_BAR; PG8_WAIT_L(0); PG8_MMA(0, 1, At, B1); PG8_BAR;
            PG8_LDA(At, 1, 1); PG8_STAGE(PG8_SA(1, 0), a3, voffA);
            PG8_BAR; PG8_WAIT_L(0); PG8_MMA(1, 0, At, B0); PG8_BAR; PG8_SCHED;
            PG8_STAGE(PG8_SB(1, 1), b3 + hstep, voffB);
            PG8_WAIT_V(6); PG8_BAR; PG8_MMA(1, 1, At, B1); PG8_BAR;
            }
        }
        if constexpr (ALIGN_EPI) { if (wr == 0) PG8_BAR; }
        if constexpr (!Epi::AFTER_DRAIN) { E(acc, cur, wr, wc, fr, fq); S.done(cur); }
        if (!has_next) break;
#pragma unroll
        for (int a = 0; a < 2; ++a)
#pragma unroll
            for (int b = 0; b < 2; ++b)
#pragma unroll
                for (int m = 0; m < 4; ++m)
#pragma unroll
                    for (int n = 0; n < 2; ++n) acc[a][b][m][n] = (f32x4){0.f, 0.f, 0.f, 0.f};
        cur = nxt; cA = nA; cB = nB; ++ui;
        if constexpr (ALIGN_EPI) { if (wr == 1) PG8_BAR; }
    }
    PG8_WAIT_V(0);
    if constexpr (!ALIGN_EPI) { if (wr == 0) PG8_BAR; }
    PG8_BAR;
    if constexpr (Epi::AFTER_DRAIN) { E.fused(acc, cur, wr, wc, fr, fq, lds, wid, lane); S.done(cur); }
#undef PG8_SA
#undef PG8_SB
#undef PG8_STAGE
#undef PG8_LDA
#undef PG8_LDB
#undef PG8_MMA
#undef PG8_WAIT_V
#undef PG8_WAIT_L
#undef PG8_BAR
#undef PG8_SCHED
}
}

constexpr int BATCH = 8, T = 2048, D = 1024, M = BATCH * T, MEMLEN = 256, MM = BATCH * MEMLEN;
constexpr int INW = 2616, ZW = 2816;
constexpr int DFF = 2816, NEXP = 8, DFE = 3584;
constexpr float EPS = 1e-6f;
constexpr int Z_AQ = 0, Z_AK = 128, Z_AV = 256, Z_AG = 512, Z_ALR = 768, Z_BU = 784, Z_CQ = 1040, Z_CK = 1296, Z_CV = 1552, Z_CQI = 1808, Z_CKI = 2064, Z_CWI = 2096, Z_DUV = 2104;
constexpr int NWAVES = 8, NTHR = 512;
constexpr int MOE_TP = 34, MOE_NPASS = 4, MOE_MAXT = MOE_TP * MOE_NPASS;
constexpr int MAXSLOT = MOE_MAXT * 256;

constexpr size_t MiB = 1u << 20;
constexpr size_t al(size_t x) { return (x + 4095) & ~(size_t)4095; }
constexpr size_t WS_CTL = 0, CTL_ZERO_BYTES = 1 * MiB;
constexpr size_t WS_SS = 1 * MiB;
constexpr size_t WS_SSM = WS_SS + al((size_t)M * 16 * 4);
constexpr size_t WS_TOKE = WS_SSM + al((size_t)MM * 16 * 4);
constexpr size_t WS_TOKG = WS_TOKE + al((size_t)M * 8);
constexpr size_t WS_TOKR = WS_TOKG + al((size_t)M * 8);
constexpr size_t WS_TOKS = WS_TOKR + al((size_t)M * 4);
constexpr size_t WS_CNT = WS_TOKS + al((size_t)M * 8);
constexpr size_t WS_TILEE = WS_CNT + al(256 * 8 * 4);
constexpr size_t WS_SLOTR = WS_TILEE + al(160 * 4);
constexpr size_t WS_SLOTG = WS_SLOTR + al((size_t)MAXSLOT * 4);
constexpr size_t WS_WIN = al(WS_SLOTG + (size_t)MAXSLOT * 4 + MiB);
constexpr size_t SZ_WIN = (size_t)ZW * D * 2, SZ_WOUT = (size_t)D * D * 2, SZ_WQ = (size_t)256 * D * 2, SZ_WKV = (size_t)512 * D * 2, SZ_WO = (size_t)D * 256 * 2;
constexpr size_t WS_WOUT = WS_WIN + 2 * SZ_WIN, WS_WQ = WS_WOUT + 2 * SZ_WOUT, WS_WKV = WS_WQ + 2 * SZ_WQ, WS_WO = WS_WKV + 2 * SZ_WKV;
constexpr size_t WS_W13 = WS_WO + 2 * SZ_WO, WS_W2 = WS_W13 + (size_t)2 * DFF * D * 2, WS_MW13 = WS_W2 + (size_t)D * DFF * 2;
constexpr size_t WS_MW2 = WS_MW13 + (size_t)NEXP * 2 * DFE * D * 2, WS_KVM = WS_MW2 + (size_t)NEXP * D * DFE * 2;
constexpr size_t SZ_KVM = (size_t)MM * 512 * 2;
constexpr size_t WS_MEMB = WS_KVM + 2 * SZ_KVM;
constexpr size_t WS_ACT = al(WS_MEMB + (size_t)MM * D * 2);
constexpr size_t WS_HB = WS_ACT, WS_Z = WS_HB + (size_t)M * D * 2, WS_MIX = WS_Z + (size_t)M * ZW * 2, WS_QX = WS_MIX + (size_t)M * D * 2, WS_OX = WS_QX + (size_t)M * 256 * 2;
constexpr size_t WS_GOI = WS_OX + (size_t)M * 256 * 2, WS_GQT = WS_GOI + (size_t)M * 256 * 4, WS_GKV = WS_GQT + (size_t)M * 128 * 4, WS_GDEC = WS_GKV + (size_t)1024 * 2048 * 4;
constexpr size_t WS_ACT_END = WS_GDEC + (size_t)1024 * 32 * 4;
constexpr size_t WS_FACT = WS_Z;
constexpr size_t WS_MACT = WS_ACT, SZ_MACT = (size_t)MOE_TP * 256 * DFE * 2;
constexpr size_t WS_AG = WS_MACT + SZ_MACT, WS_YS = WS_AG + (size_t)MAXSLOT * D * 2, WS_MOE_END = WS_YS + (size_t)MAXSLOT * D * 2;
static_assert(WS_AG >= WS_HB + (size_t)M * D * 2, "AG must not overlay HB");
static_assert(WS_MOE_END <= WS_ACT_END, "MoE overlays fit");
constexpr size_t WS_END = WS_ACT_END;
constexpr int CW_BAR = 4096;

constexpr int LDS_BYTES = 147456;
constexpr int MISC_OFF = 147456 - 128;
constexpr int SCR_BYTES = MISC_OFF;

#define GAS __attribute__((address_space(1)))
#define LAS __attribute__((address_space(3)))
typedef unsigned short bf16;
typedef unsigned v4u __attribute__((ext_vector_type(4)));
typedef unsigned v2u __attribute__((ext_vector_type(2)));
typedef float f32x4 __attribute__((ext_vector_type(4)));
typedef GAS unsigned gu32;
#define RLX_AGENT __ATOMIC_RELAXED, __HIP_MEMORY_SCOPE_AGENT
#define LDS_WAIT() asm volatile("s_waitcnt lgkmcnt(0)" ::: "memory")
#define LDS_ADD(p, v) (void)__hip_atomic_fetch_add((p), (v), __ATOMIC_RELAXED, __HIP_MEMORY_SCOPE_WORKGROUP)
__device__ __forceinline__ unsigned f2bf(float f) { unsigned u = __builtin_bit_cast(unsigned, f); return (u + 0x7fffu + ((u >> 16) & 1u)) >> 16; }
__device__ __forceinline__ unsigned pk2(float lo, float hi) { return f2bf(lo) | (f2bf(hi) << 16); }
__device__ __forceinline__ float bflo(unsigned w) { return __builtin_bit_cast(float, w << 16); }
__device__ __forceinline__ float bfhi(unsigned w) { return __builtin_bit_cast(float, w & 0xffff0000u); }
__device__ __forceinline__ float bf1(bf16 b) { return __builtin_bit_cast(float, ((unsigned)b) << 16); }
__device__ __forceinline__ float wave_sum(float v) {
#pragma unroll
    for (int o = 1; o < 64; o <<= 1) v += __shfl_xor(v, o);
    return v;
}
__device__ __forceinline__ float wave_max(float v) {
#pragma unroll
    for (int o = 1; o < 64; o <<= 1) v = fmaxf(v, __shfl_xor(v, o));
    return v;
}
#define XB_TMO      128
#define XB_XCNT(j)  (256  + 64 * (j))
#define XB_XSUB(j)  (1280 + 64 * (j))
#define XB_XGEN(j)  (2304 + 64 * (j))
#define XB_TOP      3328
#define XB_TOPGEN   3392
#define XCD_BAR_WORDS 3456
#define XB_SPIN_CAP (1u << 18)

__device__ __forceinline__ unsigned xb_ld(unsigned* p)              { return __hip_atomic_load(p, __ATOMIC_RELAXED, __HIP_MEMORY_SCOPE_AGENT); }
__device__ __forceinline__ unsigned xb_add(unsigned* p, unsigned v) { return __hip_atomic_fetch_add(p, v, __ATOMIC_RELAXED, __HIP_MEMORY_SCOPE_AGENT); }
__device__ __forceinline__ unsigned xb_xcc_id() { return (unsigned)__builtin_amdgcn_s_getreg((3 << 11) | 20) & 0xFu; }
#define XB_SPIN(cond, bar) do { unsigned _sp = 0; while (cond) { __builtin_amdgcn_s_sleep(1); \
    if ((++_sp & 255u) == 0u) { if (xb_ld(&(bar)[XB_TMO])) break; if (_sp > XB_SPIN_CAP) { atomicAdd(&(bar)[XB_TMO], 1u); break; } } } } while (0)

struct XcdBarrier {
    unsigned* bar; unsigned x;
    volatile LAS unsigned* st;
};

__device__ __forceinline__ XcdBarrier xcd_barrier_post(unsigned* bar, volatile LAS unsigned* st) {
    XcdBarrier b; b.bar = bar; b.x = xb_xcc_id(); b.st = st;
    if (threadIdx.x == 0) (void)xb_add(&bar[XB_XCNT(b.x)], 1u);
    return b;
}
__device__ __forceinline__ void xcd_barrier_complete(unsigned* bar, unsigned x, unsigned& nloc, unsigned& nx) {
    const unsigned G = gridDim.x * gridDim.y * gridDim.z;
    unsigned sum, cnt, mine, sp = 0u;
    for (;;) {
        sum = 0u; cnt = 0u; mine = 0u;
#pragma unroll
        for (unsigned j = 0; j < 16; ++j) { const unsigned c = xb_ld(&bar[XB_XCNT(j)]); sum += c; cnt += (c > 0u) ? 1u : 0u; mine = (j == x) ? c : mine; }
        if (sum == G) break;
        __builtin_amdgcn_s_sleep(1);
        if ((++sp & 255u) == 0u) { if (xb_ld(&bar[XB_TMO])) break; if (sp > XB_SPIN_CAP) { atomicAdd(&bar[XB_TMO], 1u); break; } }
    }
    nloc = mine > 0u ? mine : 1u; nx = cnt > 0u ? cnt : 1u;
}

__device__ __forceinline__ void xcd_barrier(const XcdBarrier& b) {
    asm volatile("s_waitcnt vmcnt(0)" ::: "memory");
    __syncthreads();
    if (threadIdx.x == 0) {
        unsigned* bar = b.bar;
        __builtin_amdgcn_s_waitcnt(0);
        unsigned nloc = b.st[0], nx = b.st[1];
        if (nloc == 0u) { xcd_barrier_complete(bar, b.x, nloc, nx); b.st[0] = nloc; b.st[1] = nx; }
        const unsigned old = xb_add(&bar[XB_XSUB(b.x)], 1u);
        const unsigned gen = old / nloc;
        if (old + 1u == (gen + 1u) * nloc) {
            __builtin_amdgcn_fence(__ATOMIC_RELEASE, "agent");
            asm volatile("s_waitcnt vmcnt(0)" ::: "memory");
            const unsigned og = xb_add(&bar[XB_TOP], 1u);
            const unsigned tg = og / nx;
            if (og + 1u == (tg + 1u) * nx) xb_add(&bar[XB_TOPGEN], 1u);
            else XB_SPIN(xb_ld(&bar[XB_TOPGEN]) == tg, bar);
            __builtin_amdgcn_fence(__ATOMIC_ACQUIRE, "agent");
            xb_add(&bar[XB_XGEN(b.x)], 1u);
            asm volatile("s_waitcnt vmcnt(0)" ::: "memory");
        } else {
            XB_SPIN(xb_ld(&bar[XB_XGEN(b.x)]) == gen, bar);
            __builtin_amdgcn_fence(__ATOMIC_ACQUIRE, "agent");
            asm volatile("s_waitcnt vmcnt(0)" ::: "memory");
        }
    }
    __syncthreads();
}

enum { IN_X = 0, IN_MEM, IN_RELB, IN_FNORM, IN_NMIX, IN_WIN, IN_WA2, IN_BA, IN_GNORM, IN_PW, IN_PB, IN_PS, IN_LNG, IN_LNB, IN_SW, IN_SB, IN_WOUT,
       IN_NXA, IN_NMEM, IN_WQ, IN_WKV, IN_WO, IN_NFFN, IN_F1, IN_F3, IN_F2, IN_ROUTER, IN_M1, IN_M3, IN_M2, N_IN };
struct Args { const float* in[N_IN]; float* out; unsigned char* ws; int ph_lo, ph_hi; };

__device__ __forceinline__ float rstd16(const float* ss, int row) {
    const f32x4* p = (const f32x4*)(ss + (size_t)row * 16);
    const f32x4 a = p[0], b = p[1], c = p[2], d = p[3];
    const float s = (((a.x + a.y) + (a.z + a.w)) + ((b.x + b.y) + (b.z + b.w))) + (((c.x + c.y) + (c.z + c.w)) + ((d.x + d.y) + (d.z + d.w)));
    return rsqrtf(s * (1.0f / 1024.0f) + EPS);
}
__device__ __forceinline__ v4u pack8(const f32x4 a, const f32x4 b) { v4u w; w.x = pg8::cvt_pk_bf16(a.x, a.y); w.y = pg8::cvt_pk_bf16(a.z, a.w); w.z = pg8::cvt_pk_bf16(b.x, b.y); w.w = pg8::cvt_pk_bf16(b.z, b.w); return w; }

struct EpiScale {
    static constexpr bool PERM = true, AFTER_DRAIN = false;
    bf16* O; int ldc; const float* ss; float scale;
    __device__ __forceinline__ void operator()(const pg8::f32x4 (&acc)[2][2][4][2], const pg8::Unit& u, int wr, int wc, int fr, int fq) const {
        const int row0 = u.po * 256 + wr * 64 + fr, col0 = u.e * 256 + wc * 32 + 8 * fq;
#pragma unroll
        for (int ai = 0; ai < 2; ++ai)
#pragma unroll
            for (int m = 0; m < 4; ++m) { const int row = row0 + ai * 128 + m * 16; const float r = rstd16(ss, row) * scale; bf16* rowp = O + (size_t)row * ldc + col0;
#pragma unroll
                for (int bj = 0; bj < 2; ++bj) *(v4u*)(rowp + bj * 128) = pack8(acc[ai][bj][m][0] * r, acc[ai][bj][m][1] * r); }
    }
};
struct EpiResid {
    static constexpr bool PERM = true, AFTER_DRAIN = false;
    const float* res; float* H; bf16* HB; float* SS;
    __device__ __forceinline__ void operator()(const pg8::f32x4 (&acc)[2][2][4][2], const pg8::Unit& u, int wr, int wc, int fr, int fq) const {
        const int row0 = u.po * 256 + wr * 64 + fr, col0 = u.e * 256 + wc * 32 + 8 * fq;
#pragma unroll
        for (int ai = 0; ai < 2; ++ai)
#pragma unroll
            for (int m = 0; m < 4; ++m) { const int row = row0 + ai * 128 + m * 16; const size_t off = (size_t)row * D + col0; float q = 0.f;
#pragma unroll
                for (int bj = 0; bj < 2; ++bj) {
                    const f32x4 r0 = *(const f32x4*)(res + off + bj * 128), r1 = *(const f32x4*)(res + off + bj * 128 + 4);
                    const f32x4 v0 = acc[ai][bj][m][0] + r0, v1 = acc[ai][bj][m][1] + r1;
                    *(f32x4*)(H + off + bj * 128) = v0; *(f32x4*)(H + off + bj * 128 + 4) = v1;
                    *(v4u*)(HB + off + bj * 128) = pack8(v0, v1);
                    q += ((v0.x * v0.x + v0.y * v0.y) + (v0.z * v0.z + v0.w * v0.w)) + ((v1.x * v1.x + v1.y * v1.y) + (v1.z * v1.z + v1.w * v1.w)); }
                q += __shfl_xor(q, 16); q += __shfl_xor(q, 32);
                if (fq == 0) SS[(size_t)row * 16 + u.e * 4 + wc] = q; }
    }
};
__device__ __forceinline__ float silu_f(float x) { return x * __builtin_amdgcn_rcpf(1.0f + __expf(-x)); }
template <bool MOE> struct EpiSwiglu {
    static constexpr bool PERM = true, AFTER_DRAIN = false;
    bf16* O; int ldc; const float* ss; const float* slot_r; const float* slot_g;
    __device__ __forceinline__ void operator()(const pg8::f32x4 (&acc)[2][2][4][2], const pg8::Unit& u, int wr, int wc, int fr, int fq) const {
        const int rin0 = u.pm * 256 + wr * 64 + fr, rout0 = u.po * 256 + wr * 64 + fr, col0 = u.e * 128 + wc * 32 + 8 * fq;
#pragma unroll
        for (int ai = 0; ai < 2; ++ai)
#pragma unroll
            for (int m = 0; m < 4; ++m) { const int rin = rin0 + ai * 128 + m * 16, rout = rout0 + ai * 128 + m * 16;
                float r, gt; if (MOE) { r = slot_r[rin]; gt = slot_g[rin]; } else { r = rstd16(ss, rin); gt = 1.0f; }
                f32x4 o0, o1;
#pragma unroll
                for (int j = 0; j < 4; ++j) { o0[j] = silu_f(acc[ai][0][m][0][j] * r) * (acc[ai][1][m][0][j] * r) * gt; o1[j] = silu_f(acc[ai][0][m][1][j] * r) * (acc[ai][1][m][1][j] * r) * gt; }
                *(v4u*)(O + (size_t)rout * ldc + col0) = pack8(o0, o1); }
    }
};
struct EpiPlain {
    static constexpr bool PERM = true, AFTER_DRAIN = false;
    bf16* O; int ldc;
    __device__ __forceinline__ void operator()(const pg8::f32x4 (&acc)[2][2][4][2], const pg8::Unit& u, int wr, int wc, int fr, int fq) const {
        const int row0 = u.po * 256 + wr * 64 + fr, col0 = u.e * 256 + wc * 32 + 8 * fq;
#pragma unroll
        for (int ai = 0; ai < 2; ++ai)
#pragma unroll
            for (int m = 0; m < 4; ++m) { bf16* rowp = O + (size_t)(row0 + ai * 128 + m * 16) * ldc + col0;
#pragma unroll
                for (int bj = 0; bj < 2; ++bj) *(v4u*)(rowp + bj * 128) = pack8(acc[ai][bj][m][0], acc[ai][bj][m][1]); }
    }
};

__device__ __forceinline__ void tr_item(const float* W, int N, int K, int k0, int n0, const float* gain, bf16* WT, long dst_row0, LAS float* scr, int lane) {
    const int nn = n0 + (lane & 31);
#pragma unroll 8
    for (int i = 0; i < 32; ++i) { const int kk = 2 * i + (lane >> 5); float v = (nn < N) ? W[(size_t)(k0 + kk) * N + nn] : 0.f; if (gain) v *= gain[k0 + kk]; scr[kk * 33 + (lane & 31)] = v; }
    LDS_WAIT(); asm volatile("" ::: "memory");
    const int c = lane & 7;
#pragma unroll
    for (int j = 0; j < 4; ++j) { const int n = (lane >> 3) + 8 * j; const LAS float* s = scr + (8 * c) * 33 + n;
        v4u o; o.x = pk2(s[0 * 33], s[1 * 33]); o.y = pk2(s[2 * 33], s[3 * 33]); o.z = pk2(s[4 * 33], s[5 * 33]); o.w = pk2(s[6 * 33], s[7 * 33]);
        if (n0 + n < N) *(v4u*)(WT + (size_t)(dst_row0 + n) * K + k0 + 8 * c) = o; }
    LDS_WAIT(); asm volatile("" ::: "memory");
}
__device__ __forceinline__ void conv_job(const float* W, int K, int N, const float* gain, bf16* WT, int mode, LAS float* scr, int gw, int NGW, int lane, long& base) {
    const int nblk = (N + 31) / 32, nitems = (K / 64) * nblk;
    const int first = (int)(((long)gw - (base % NGW) + NGW) % NGW);
    for (int it = first; it < nitems; it += NGW) {
        const int kb = it / nblk, nb = it % nblk, k0 = 64 * kb, n0 = 32 * nb;
        const long dr = (mode == 0) ? (long)n0 : (long)(n0 >> 7) * 256 + (n0 & 127) + (mode == 2 ? 128 : 0);
        tr_item(W, N, K, k0, n0, gain, WT, dr, scr, lane);
    }
    base += nitems;
}
__device__ __forceinline__ void row_cvt(const float* xrow, bf16* orow, float* ssrow, int lane) {
    const f32x4* xr = (const f32x4*)xrow + lane; f32x4 v[4]; float s = 0.f;
#pragma unroll
    for (int j = 0; j < 4; ++j) { v[j] = xr[64 * j]; s += (v[j].x * v[j].x + v[j].y * v[j].y) + (v[j].z * v[j].z + v[j].w * v[j].w); }
    s = wave_sum(s);
    v2u* o8 = (v2u*)orow + lane;
#pragma unroll
    for (int j = 0; j < 4; ++j) { v2u w; w.x = pk2(v[j].x, v[j].y); w.y = pk2(v[j].z, v[j].w); o8[64 * j] = w; }
    if (lane < 16) ssrow[lane] = lane == 0 ? s : 0.f;
}
__device__ __forceinline__ void p0_prologue(const Args& a, LAS unsigned char* lds, int tid, int G) {
    const int lane = tid & 63, wave = tid >> 6, gw = blockIdx.x * NWAVES + wave, NGW = G * NWAVES;
    LAS float* scr = (LAS float*)(lds + wave * 16384);
    unsigned char* ws = a.ws; long base = 0;
    for (int l = 0; l < 2; ++l) {
        conv_job(a.in[IN_WIN] + (size_t)l * D * INW, D, INW, a.in[IN_NMIX] + l * D, (bf16*)(ws + WS_WIN + l * SZ_WIN), 0, scr, gw, NGW, lane, base);
        conv_job(a.in[IN_WOUT] + (size_t)l * D * D, D, D, nullptr, (bf16*)(ws + WS_WOUT + l * SZ_WOUT), 0, scr, gw, NGW, lane, base);
        conv_job(a.in[IN_WQ] + (size_t)l * D * 256, D, 256, a.in[IN_NXA] + l * D, (bf16*)(ws + WS_WQ + l * SZ_WQ), 0, scr, gw, NGW, lane, base);
        conv_job(a.in[IN_WKV] + (size_t)l * D * 512, D, 512, a.in[IN_NMEM] + l * D, (bf16*)(ws + WS_WKV + l * SZ_WKV), 0, scr, gw, NGW, lane, base);
        conv_job(a.in[IN_WO] + (size_t)l * 256 * D, 256, D, nullptr, (bf16*)(ws + WS_WO + l * SZ_WO), 0, scr, gw, NGW, lane, base);
        { v4u* zp = (v4u*)(ws + WS_WIN + l * SZ_WIN + (size_t)INW * D * 2); const int n16 = (ZW - INW) * D * 2 / 16;
          for (int i = blockIdx.x * NTHR + tid; i < n16; i += G * NTHR) zp[i] = (v4u){0u, 0u, 0u, 0u}; }
    }
    conv_job(a.in[IN_F1], D, DFF, a.in[IN_NFFN], (bf16*)(ws + WS_W13), 1, scr, gw, NGW, lane, base);
    conv_job(a.in[IN_F3], D, DFF, a.in[IN_NFFN], (bf16*)(ws + WS_W13), 2, scr, gw, NGW, lane, base);
    conv_job(a.in[IN_F2], DFF, D, nullptr, (bf16*)(ws + WS_W2), 0, scr, gw, NGW, lane, base);
    for (int e = 0; e < NEXP; ++e) {
        conv_job(a.in[IN_M1] + (size_t)e * D * DFE, D, DFE, a.in[IN_NFFN] + D, (bf16*)(ws + WS_MW13) + (size_t)e * 2 * DFE * D, 1, scr, gw, NGW, lane, base);
        conv_job(a.in[IN_M3] + (size_t)e * D * DFE, D, DFE, a.in[IN_NFFN] + D, (bf16*)(ws + WS_MW13) + (size_t)e * 2 * DFE * D, 2, scr, gw, NGW, lane, base);
        conv_job(a.in[IN_M2] + (size_t)e * DFE * D, DFE, D, nullptr, (bf16*)(ws + WS_MW2) + (size_t)e * D * DFE, 0, scr, gw, NGW, lane, base);
    }
    for (int m = gw; m < M; m += NGW) row_cvt(a.in[IN_X] + (size_t)m * D, (bf16*)(ws + WS_HB) + (size_t)m * D, (float*)(ws + WS_SS) + (size_t)m * 16, lane);
    for (int m = gw; m < MM; m += NGW) row_cvt(a.in[IN_MEM] + (size_t)m * D, (bf16*)(ws + WS_MEMB) + (size_t)m * D, (float*)(ws + WS_SSM) + (size_t)m * 16, lane);
}

__device__ __forceinline__ float gelu_tanh(float x) { return 0.5f * x * (1.0f + tanhf(0.7978845608028654f * (x + 0.044715f * x * x * x))); }

__device__ __forceinline__ void gla_a_item(const Args& a, int l, int item, LAS unsigned char* lds, int tid) {
    const int n = item & 31, h = (item >> 5) & 3, b = item >> 7, tok0 = b * T + n * 64;
    LAS float* alr = (LAS float*)lds;
    LAS float* wa = alr + 64 * 16;
    LAS float* bb = wa + 16 * 32;
    LAS float* qt = bb + 64 * 33;
    LAS float* kt = qt + 64 * 33;
    LAS float* kd = kt + 64 * 33;
    LAS float* vv = kd + 64 * 33;
    LAS float* att = vv + 64 * 64;
    LAS float* bav = att + 64 * 65;
    const bf16* z = (const bf16*)(a.ws + WS_Z);
    float* OI = (float*)(a.ws + WS_GOI); float* QT = (float*)(a.ws + WS_GQT); float* KV = (float*)(a.ws + WS_GKV); float* DEC = (float*)(a.ws + WS_GDEC);
    for (int i = tid; i < 1024; i += NTHR) alr[i] = bf1(z[(size_t)(tok0 + (i >> 4)) * ZW + Z_ALR + (i & 15)]);
    { const int r = tid >> 5, k = tid & 31; wa[tid] = a.in[IN_WA2][(size_t)l * 16 * 128 + r * 128 + h * 32 + k]; }
    if (tid < 32) bav[tid] = a.in[IN_BA][l * 128 + h * 32 + tid];
    for (int i = tid; i < 4096; i += NTHR) vv[i] = bf1(z[(size_t)(tok0 + (i >> 6)) * ZW + Z_AV + h * 64 + (i & 63)]);
    __syncthreads();
    for (int i = tid; i < 2048; i += NTHR) { const int c = i >> 5, k = i & 31; float x = bav[k];
#pragma unroll
        for (int r = 0; r < 16; ++r) x += alr[c * 16 + r] * wa[r * 32 + k];
        const float ls = fminf(x, 0.f) - log1pf(expf(-fabsf(x)));
        bb[c * 33 + k] = ls * (1.0f / 16.0f); }
    __syncthreads();
    if (tid < 32) { float run = 0.f; for (int c = 0; c < 64; ++c) { run += bb[c * 33 + tid]; bb[c * 33 + tid] = run; } }
    __syncthreads();
    for (int i = tid; i < 2048; i += NTHR) { const int c = i >> 5, k = i & 31; const float bv = bb[c * 33 + k], bl = bb[63 * 33 + k];
        const float q = bf1(z[(size_t)(tok0 + c) * ZW + Z_AQ + h * 32 + k]), kk = bf1(z[(size_t)(tok0 + c) * ZW + Z_AK + h * 32 + k]);
        const float qv = q * 0.17677669529663687f * expf(bv);
        qt[c * 33 + k] = qv; kt[c * 33 + k] = kk * expf(-bv); kd[c * 33 + k] = kk * expf(bl - bv);
        QT[(size_t)(tok0 + c) * 128 + h * 32 + k] = qv; }
    if (tid < 32) DEC[(size_t)item * 32 + tid] = expf(bb[63 * 33 + tid]);
    __syncthreads();
    for (int idx = tid; idx < 4096; idx += NTHR) { const int i = idx >> 6, j = idx & 63; float s = 0.f;
        if (j <= i) {
#pragma unroll 8
            for (int k = 0; k < 32; ++k) s += qt[i * 33 + k] * kt[j * 33 + k]; }
        att[i * 65 + j] = s; }
    __syncthreads();
    for (int idx = tid; idx < 4096; idx += NTHR) { const int i = idx >> 6, v = idx & 63; float s = 0.f;
#pragma unroll 8
        for (int j = 0; j < 64; ++j) s += att[i * 65 + j] * vv[j * 64 + v];
        OI[(size_t)(tok0 + i) * 256 + h * 64 + v] = s; }
    for (int idx = tid; idx < 2048; idx += NTHR) { const int k = idx >> 6, v = idx & 63; float s = 0.f;
#pragma unroll 8
        for (int c = 0; c < 64; ++c) s += kd[c * 33 + k] * vv[c * 64 + v];
        KV[(size_t)item * 2048 + idx] = s; }
    __syncthreads();
}
__device__ __forceinline__ void gla_c_item(const Args& a, int l, int item, LAS unsigned char* lds, int tid) {
    const int n = item & 31, h = (item >> 5) & 3, b = item >> 7, tok0 = b * T + n * 64, lane = tid & 63, w = tid >> 6;
    LAS float* S = (LAS float*)lds;
    LAS float* ql = S + 2048;
    const bf16* z = (const bf16*)(a.ws + WS_Z); bf16* mix = (bf16*)(a.ws + WS_MIX);
    const float* OI = (const float*)(a.ws + WS_GOI); const float* QT = (const float*)(a.ws + WS_GQT); const float* KV = (const float*)(a.ws + WS_GKV); const float* DEC = (const float*)(a.ws + WS_GDEC);
    for (int e = tid; e < 2048; e += NTHR) { const int k = e >> 6; float s = 0.f;
        for (int m = 0; m < n; ++m) { const size_t it = (size_t)(item - n + m); s = s * DEC[it * 32 + k] + KV[it * 2048 + e]; }
        S[e] = s; }
    for (int i = tid; i < 2048; i += NTHR) ql[(i >> 5) * 33 + (i & 31)] = QT[(size_t)(tok0 + (i >> 5)) * 128 + h * 32 + (i & 31)];
    __syncthreads();
    for (int j = 0; j < 8; ++j) { const int i = w + 8 * j; float o = OI[(size_t)(tok0 + i) * 256 + h * 64 + lane];
#pragma unroll 8
        for (int k = 0; k < 32; ++k) o += ql[i * 33 + k] * S[k * 64 + lane];
        const float ms = wave_sum(o * o) * (1.0f / 64.0f);
        float y = o * rsqrtf(ms + EPS) * a.in[IN_GNORM][l * 256 + h * 64 + lane];
        const float g = bf1(z[(size_t)(tok0 + i) * ZW + Z_AG + h * 64 + lane]);
        y *= g / (1.0f + expf(-g));
        mix[(size_t)(tok0 + i) * D + h * 64 + lane] = (bf16)f2bf(y); }
    __syncthreads();
}
__device__ __forceinline__ void pool_item(const Args& a, int l, int item, LAS unsigned char* lds, int tid) {
    const int g = item & 3, tt = (item >> 2) & 31, b = item >> 7, t0 = tt * 64;
    LAS float* u = (LAS float*)lds;
    LAS float* w = u + 79 * 64;
    LAS float* p = w + 4096;
    const bf16* z = (const bf16*)(a.ws + WS_Z); bf16* mix = (bf16*)(a.ws + WS_MIX);
    for (int i = tid; i < 79 * 64; i += NTHR) { const int t = t0 - 15 + (i >> 6); u[i] = t >= 0 ? bf1(z[(size_t)(b * T + t) * ZW + Z_BU + g * 64 + (i & 63)]) : 0.f; }
    for (int i = tid; i < 4096; i += NTHR) w[i] = a.in[IN_PW][(size_t)(l * 4 + g) * 4096 + i];
    __syncthreads();
    const int win = 2 << g;
    for (int i = tid; i < 4096; i += NTHR) { const int tl = i >> 6, c = i & 63, t = t0 + tl, cnt = (t + 1 < win) ? t + 1 : win; float s = 0.f;
        for (int j = 0; j < cnt; ++j) s += u[(tl + 15 - j) * 64 + c];
        p[tl * 65 + c] = s / (float)cnt - u[(tl + 15) * 64 + c]; }
    __syncthreads();
    for (int i = tid; i < 4096; i += NTHR) { const int tl = i >> 6, d = i & 63; float s = a.in[IN_PB][(l * 4 + g) * 64 + d];
#pragma unroll 8
        for (int c = 0; c < 64; ++c) s += p[tl * 65 + c] * w[c * 64 + d];
        s *= a.in[IN_PS][l * 256 + g * 64 + d];
        mix[(size_t)(b * T + t0 + tl) * D + 256 + g * 64 + d] = (bf16)f2bf(s); }
    __syncthreads();
}
__device__ __forceinline__ void sgu_item(const Args& a, int l, int item, LAS unsigned char* lds, int tid) {
    const int g = item & 3, nc = (item >> 2) & 15, b = item >> 6, tok0 = b * T + nc * 128, lane = tid & 63, w = tid >> 6;
    LAS float* vn = (LAS float*)lds;
    const bf16* z = (const bf16*)(a.ws + WS_Z); bf16* mix = (bf16*)(a.ws + WS_MIX);
    for (int j = 0; j < 16; ++j) { const int s = w + 8 * j;
        const v2u raw = *(const v2u*)(z + (size_t)(tok0 + s) * ZW + Z_DUV + 256 + 4 * lane);
        float x[4] = {gelu_tanh(bflo(raw.x)), gelu_tanh(bfhi(raw.x)), gelu_tanh(bflo(raw.y)), gelu_tanh(bfhi(raw.y))};
        const float mu = wave_sum((x[0] + x[1]) + (x[2] + x[3])) * (1.0f / 256.0f);
        float q = 0.f;
#pragma unroll
        for (int i = 0; i < 4; ++i) { x[i] -= mu; q += x[i] * x[i]; }
        const float rstd = rsqrtf(wave_sum(q) * (1.0f / 256.0f) + EPS);
        if ((lane >> 4) == g) {
#pragma unroll
            for (int i = 0; i < 4; ++i) { const int cl = 4 * (lane & 15) + i; vn[s * 64 + cl] = x[i] * rstd * a.in[IN_LNG][l * 256 + g * 64 + cl] + a.in[IN_LNB][l * 256 + g * 64 + cl]; } } }
    __syncthreads();
    const float* sw = a.in[IN_SW] + (size_t)(l * 4 + g) * 128 * 128;
    for (int j = 0; j < 16; ++j) { const int t = w + 8 * j; float acc = a.in[IN_SB][(l * 4 + g) * 128 + t];
        const float* swr = sw + t * 128;
        for (int s = 0; s <= t; ++s) acc += swr[s] * vn[s * 64 + lane];
        const float uu = gelu_tanh(bf1(z[(size_t)(tok0 + t) * ZW + Z_DUV + g * 64 + lane]));
        mix[(size_t)(tok0 + t) * D + 768 + g * 64 + lane] = (bf16)f2bf(uu * acc); }
    __syncthreads();
}
__device__ __forceinline__ void xattn_item(const Args& a, int l, int item, LAS unsigned char* lds, int tid) {
    const int qtile = item & 31, h = (item >> 5) & 3, b = item >> 7, lane = tid & 63, w = tid >> 6;
    LAS float* Ks = (LAS float*)lds;
    LAS float* Vs = Ks + 256 * 65;
    LAS float* qs = Vs + 256 * 64;
    LAS float* pw = qs + 512;
    const bf16* kvm = (const bf16*)(a.ws + WS_KVM + (size_t)l * SZ_KVM); const bf16* qx = (const bf16*)(a.ws + WS_QX); bf16* ox = (bf16*)(a.ws + WS_OX);
    for (int i = tid; i < 16384; i += NTHR) { const int key = i >> 6, d = i & 63; const size_t o = (size_t)(b * MEMLEN + key) * 512 + h * 64 + d;
        Ks[key * 65 + d] = bf1(kvm[o]); Vs[key * 64 + d] = bf1(kvm[o + 256]); }
    __syncthreads();
    for (int qq = 0; qq < 8; ++qq) { const int row = b * T + qtile * 64 + w * 8 + qq;
        qs[w * 64 + lane] = bf1(qx[(size_t)row * 256 + h * 64 + lane]);
        LDS_WAIT(); asm volatile("" ::: "memory");
        float s[4] = {0.f, 0.f, 0.f, 0.f};
        for (int d = 0; d < 64; ++d) { const float qd = qs[w * 64 + d];
#pragma unroll
            for (int j = 0; j < 4; ++j) s[j] += qd * Ks[(lane + 64 * j) * 65 + d]; }
        const float mx = wave_max(fmaxf(fmaxf(s[0], s[1]), fmaxf(s[2], s[3])));
        float e[4], sum = 0.f;
#pragma unroll
        for (int j = 0; j < 4; ++j) { e[j] = expf(s[j] - mx); sum += e[j]; }
        const float inv = 1.0f / wave_sum(sum);
#pragma unroll
        for (int j = 0; j < 4; ++j) pw[w * 256 + lane + 64 * j] = e[j] * inv;
        LDS_WAIT(); asm volatile("" ::: "memory");
        float o = 0.f;
        for (int key = 0; key < 256; ++key) o += pw[w * 256 + key] * Vs[key * 64 + lane];
        ox[(size_t)row * 256 + h * 64 + lane] = (bf16)f2bf(o);
        LDS_WAIT(); asm volatile("" ::: "memory"); }
    __syncthreads();
}

__device__ __forceinline__ unsigned ord_u(float f) { const unsigned u = __builtin_bit_cast(unsigned, f); return (u & 0x80000000u) ? ~u : (u | 0x80000000u); }
__device__ __forceinline__ int rel_bucket(int n) {
    if (n < 16) return n;
    int large = 16 + (int)(logf((float)n / 16.0f) / logf(8.0f) * 16.0f);
    return large < 31 ? large : 31;
}
__device__ __forceinline__ void dsa_setup(const Args& a, LAS unsigned char* lds, int tid) {
    LAS float* biasd = (LAS float*)(lds + 48 * 1024);
    for (int i = tid; i < 129 * 4; i += NTHR) { const int d = i >> 2, h = i & 3; biasd[i] = a.in[IN_RELB][rel_bucket(d) * 4 + h]; }
    __syncthreads();
}
__device__ __forceinline__ void dsa_item(const Args& a, int item, LAS unsigned char* lds, int tid) {
    const int b = item / T, t = item % T, nk = t + 1, lane = tid & 63, w = tid >> 6;
    LAS unsigned* su = (LAS unsigned*)lds;
    LAS float* lg = (LAS float*)(lds + 8192);
    LAS float* qi = (LAS float*)(lds + 8192 + 32768);
    LAS float* qv = qi + 256;
    LAS float* wi = qv + 256;
    LAS unsigned* cnt = (LAS unsigned*)(wi + 8);
    LAS float* red = (LAS float*)(cnt + 40);
    LAS float* red2 = red + 64;
    LAS float* biasd = (LAS float*)(lds + 48 * 1024);
    const bf16* z = (const bf16*)(a.ws + WS_Z); bf16* mix = (bf16*)(a.ws + WS_MIX);
    const size_t row = (size_t)b * T + t;
    if (tid < 256) { qi[tid] = bf1(z[row * ZW + Z_CQI + tid]) * 0.17677669529663687f; qv[tid] = bf1(z[row * ZW + Z_CQ + tid]) * 0.125f; }
    if (tid < 8) wi[tid] = bf1(z[row * ZW + Z_CWI + tid]) * 0.35355339059327373f;
    if (tid < 40) cnt[tid] = 0u;
    __syncthreads();
    unsigned myu[4];
#pragma unroll
    for (int j = 0; j < 4; ++j) { const int key = tid + NTHR * j; myu[j] = 0u;
        if (key < nk) { const v4u* kp = (const v4u*)(z + ((size_t)b * T + key) * ZW + Z_CKI); float kf[32];
#pragma unroll
            for (int i = 0; i < 4; ++i) { const v4u r = kp[i]; kf[8 * i + 0] = bflo(r.x); kf[8 * i + 1] = bfhi(r.x); kf[8 * i + 2] = bflo(r.y); kf[8 * i + 3] = bfhi(r.y); kf[8 * i + 4] = bflo(r.z); kf[8 * i + 5] = bfhi(r.z); kf[8 * i + 6] = bflo(r.w); kf[8 * i + 7] = bfhi(r.w); }
            float sc = 0.f;
            for (int hh = 0; hh < 8; ++hh) { float dot = 0.f;
#pragma unroll
                for (int d = 0; d < 32; ++d) dot += qi[hh * 32 + d] * kf[d];
                sc += fmaxf(dot, 0.f) * wi[hh]; }
            sc += 0.0f;
            myu[j] = ord_u(sc); su[key] = myu[j]; } }
    __syncthreads();
    bool sel[4];
#pragma unroll
    for (int j = 0; j < 4; ++j) sel[j] = (tid + NTHR * j) < nk;
    if (nk > 256) {
        unsigned Tt = 0u;
        for (int bit = 31; bit >= 0; --bit) { const unsigned cand = Tt | (1u << bit); int c = 0;
#pragma unroll
            for (int j = 0; j < 4; ++j) c += (myu[j] >= cand) ? 1 : 0;
            c = (int)wave_sum((float)c);
            if (lane == 0 && c) LDS_ADD(&cnt[bit], (unsigned)c);
            __syncthreads();
            if (cnt[bit] >= 256u) Tt = cand; }
        { int c = 0;
#pragma unroll
            for (int j = 0; j < 4; ++j) c += (myu[j] > Tt) ? 1 : 0;
            c = (int)wave_sum((float)c);
            if (lane == 0 && c) LDS_ADD(&cnt[32], (unsigned)c);
            __syncthreads(); }
        const int r = 256 - (int)cnt[32];
#pragma unroll
        for (int j = 0; j < 4; ++j) { const int key = tid + NTHR * j;
            if (myu[j] > Tt) sel[j] = true;
            else if (myu[j] == Tt && key < nk) { int rank = 0; for (int s = 0; s < key; ++s) rank += (su[s] == Tt) ? 1 : 0; sel[j] = rank < r; }
            else sel[j] = false; }
    }
    float lmax[4] = {-INFINITY, -INFINITY, -INFINITY, -INFINITY};
#pragma unroll
    for (int j = 0; j < 4; ++j) { const int key = tid + NTHR * j;
        if (key < nk) {
            float lv[4] = {-INFINITY, -INFINITY, -INFINITY, -INFINITY};
            if (sel[j]) { const v4u* kp = (const v4u*)(z + ((size_t)b * T + key) * ZW + Z_CK); const int dd = (t - key) < 128 ? (t - key) : 128;
#pragma unroll
                for (int hh = 0; hh < 4; ++hh) { float dot = 0.f;
#pragma unroll
                    for (int i = 0; i < 8; ++i) { const v4u r = kp[hh * 8 + i]; const LAS float* qq = qv + hh * 64 + 8 * i;
                        dot += qq[0] * bflo(r.x) + qq[1] * bfhi(r.x) + qq[2] * bflo(r.y) + qq[3] * bfhi(r.y) + qq[4] * bflo(r.z) + qq[5] * bfhi(r.z) + qq[6] * bflo(r.w) + qq[7] * bfhi(r.w); }
                    lv[hh] = dot + biasd[dd * 4 + hh]; lmax[hh] = fmaxf(lmax[hh], lv[hh]); } }
#pragma unroll
            for (int hh = 0; hh < 4; ++hh) lg[hh * 2048 + key] = lv[hh]; } }
#pragma unroll
    for (int hh = 0; hh < 4; ++hh) { const float m = wave_max(lmax[hh]); if (lane == 0) red[w * 4 + hh] = m; }
    __syncthreads();
    float mx[4], lsum[4] = {0.f, 0.f, 0.f, 0.f};
#pragma unroll
    for (int hh = 0; hh < 4; ++hh) { float m = red[hh]; for (int ww = 1; ww < 8; ++ww) m = fmaxf(m, red[ww * 4 + hh]); mx[hh] = m; }
#pragma unroll
    for (int j = 0; j < 4; ++j) { const int key = tid + NTHR * j;
        if (key < nk) {
#pragma unroll
            for (int hh = 0; hh < 4; ++hh) { const float lv = lg[hh * 2048 + key]; const float p = (lv == -INFINITY) ? 0.f : expf(lv - mx[hh]); lg[hh * 2048 + key] = p; lsum[hh] += p; } } }
#pragma unroll
    for (int hh = 0; hh < 4; ++hh) { const float s = wave_sum(lsum[hh]); if (lane == 0) red[32 + w * 4 + hh] = s; }
    __syncthreads();
    { const int half = tid >> 8, hd = tid & 255, hh = hd >> 6; float acc = 0.f;
      const bf16* vp = z + (size_t)b * T * ZW + Z_CV + hd;
      for (int key = half; key < nk; key += 2) { const float p = lg[hh * 2048 + key]; if (p != 0.f) acc += p * bf1(vp[(size_t)key * ZW]); }
      red2[tid] = acc; }
    __syncthreads();
    if (tid < 256) { const int hh = tid >> 6; float s = 0.f; for (int ww = 0; ww < 8; ++ww) s += red[32 + ww * 4 + hh];
        mix[row * D + 512 + tid] = (bf16)f2bf((red2[tid] + red2[tid + 256]) / s); }
    __syncthreads();
}

__device__ __forceinline__ void moe_route(const Args& a, LAS unsigned char* lds, int tid, int G) {
    const int lane = tid & 63, w = tid >> 6;
    LAS float* rt = (LAS float*)lds;
    LAS unsigned* cnt = (LAS unsigned*)(lds + 32768);
    const float* h = a.out; unsigned char* ws = a.ws;
    for (int i = tid; i < 8192; i += NTHR) rt[(i & 7) * 1024 + (i >> 3)] = a.in[IN_ROUTER][i] * a.in[IN_NFFN][D + (i >> 3)];
    __syncthreads();
    for (int chunk = blockIdx.x; chunk < 256; chunk += G) {
        if (tid < 8) cnt[tid] = 0u;
        __syncthreads();
        for (int q = 0; q < 8; ++q) { const int tk = chunk * 64 + w * 8 + q;
            const f32x4* hr = (const f32x4*)(h + (size_t)tk * D) + lane; float lg[8] = {0.f, 0.f, 0.f, 0.f, 0.f, 0.f, 0.f, 0.f}; float ss = 0.f;
#pragma unroll
            for (int j = 0; j < 4; ++j) { const f32x4 v = hr[64 * j]; const int c0 = 4 * (lane + 64 * j);
                ss += (v.x * v.x + v.y * v.y) + (v.z * v.z + v.w * v.w);
#pragma unroll
                for (int e = 0; e < 8; ++e) { const f32x4 r = *(const LAS f32x4*)(rt + e * 1024 + c0); lg[e] += (v.x * r.x + v.y * r.y) + (v.z * r.z + v.w * r.w); } }
            ss = wave_sum(ss); const float rstd = rsqrtf(ss * (1.0f / 1024.0f) + EPS);
#pragma unroll
            for (int e = 0; e < 8; ++e) lg[e] = wave_sum(lg[e]) * rstd;
            int e0 = 0; float v0 = lg[0];
#pragma unroll
            for (int e = 1; e < 8; ++e) if (lg[e] > v0) { v0 = lg[e]; e0 = e; }
            int e1 = -1; float v1 = -INFINITY;
#pragma unroll
            for (int e = 0; e < 8; ++e) if (e != e0 && lg[e] > v1) { v1 = lg[e]; e1 = e; }
            const float g0 = 1.0f / (1.0f + expf(v1 - v0)), g1 = 1.0f - g0;
            if (lane == 0) { ((int*)(ws + WS_TOKE))[2 * tk] = e0; ((int*)(ws + WS_TOKE))[2 * tk + 1] = e1; ((float*)(ws + WS_TOKG))[2 * tk] = g0; ((float*)(ws + WS_TOKG))[2 * tk + 1] = g1;
                ((float*)(ws + WS_TOKR))[tk] = rstd; LDS_ADD(&cnt[e0], 1u); LDS_ADD(&cnt[e1], 1u); } }
        __syncthreads();
        if (tid < 8) ((int*)(ws + WS_CNT))[chunk * 8 + tid] = (int)cnt[tid];
        __syncthreads();
    }
}
__device__ __forceinline__ void moe_assign(const Args& a, LAS unsigned char* lds, int tid, int G) {
    const int lane = tid & 63, w = tid >> 6;
    LAS int* cn = (LAS int*)lds;
    LAS int* tot = cn + 2048;
    LAS int* basee = tot + 8;
    LAS int* sl = basee + 8;
    LAS int* pref = sl + 128;
    unsigned char* ws = a.ws;
    const int* CNT = (const int*)(ws + WS_CNT); int* TILEE = (int*)(ws + WS_TILEE);
    const int* TOKE = (const int*)(ws + WS_TOKE); const float* TOKG = (const float*)(ws + WS_TOKG); const float* TOKR = (const float*)(ws + WS_TOKR); int* TOKS = (int*)(ws + WS_TOKS);
    float* SLOTR = (float*)(ws + WS_SLOTR); float* SLOTG = (float*)(ws + WS_SLOTG);
    const bf16* HB = (const bf16*)(ws + WS_HB); bf16* AG = (bf16*)(ws + WS_AG);
    for (int i = tid; i < 2048; i += NTHR) cn[i] = CNT[i];
    __syncthreads();
    if (tid < 8) { int s = 0; for (int c = 0; c < 256; ++c) s += cn[c * 8 + tid]; tot[tid] = s; }
    __syncthreads();
    if (tid == 0) { int tile = 0; for (int e = 0; e < 8; ++e) { basee[e] = tile * 256; const int nt = (tot[e] + 255) >> 8;
            if (blockIdx.x == 0) for (int q = 0; q < nt; ++q) TILEE[tile + q] = e;
            tile += nt; }
        if (blockIdx.x == 0) { for (int q = tile; q < 159; ++q) TILEE[q] = 0; TILEE[159] = tile; } }
    __syncthreads();
    for (int e = blockIdx.x; e < 8; e += G) { const int s0 = basee[e] + tot[e], s1 = basee[e] + (((tot[e] + 255) >> 8) << 8);
        for (int s = s0 + w; s < s1; s += NWAVES) { v4u* rp = (v4u*)(AG + (size_t)s * D) + lane; rp[0] = (v4u){0u, 0u, 0u, 0u}; rp[64] = (v4u){0u, 0u, 0u, 0u}; if (lane == 0) { SLOTR[s] = 0.f; SLOTG[s] = 0.f; } } }
    for (int chunk = blockIdx.x; chunk < 256; chunk += G) {
        if (tid < 8) { int s = 0; for (int c = 0; c < chunk; ++c) s += cn[c * 8 + tid]; int pos = basee[tid] + s;
            for (int i = 0; i < 128; ++i) { const int tk = chunk * 64 + (i >> 1); if (TOKE[2 * tk + (i & 1)] == tid) { sl[i] = pos; SLOTR[pos] = TOKR[tk]; SLOTG[pos] = TOKG[2 * tk + (i & 1)]; TOKS[2 * tk + (i & 1)] = pos; ++pos; } } }
        __syncthreads();
        for (int q = 0; q < 16; ++q) { const int i = w * 16 + q, tk = chunk * 64 + (i >> 1), s = sl[i];
            const v4u* src = (const v4u*)(HB + (size_t)tk * D) + lane; v4u* dst = (v4u*)(AG + (size_t)s * D) + lane; dst[0] = src[0]; dst[64] = src[64]; }
        __syncthreads();
    }
}
__device__ __forceinline__ void final_phase(const Args& a, int tid, int G) {
    const int lane = tid & 63, gw = blockIdx.x * NWAVES + (tid >> 6), NGW = G * NWAVES;
    const int* TOKS = (const int*)(a.ws + WS_TOKS); const bf16* YS = (const bf16*)(a.ws + WS_YS);
    for (int tk = gw; tk < M; tk += NGW) { const int s0 = TOKS[2 * tk], s1 = TOKS[2 * tk + 1];
        f32x4* hr = (f32x4*)(a.out + (size_t)tk * D) + lane; const v2u* y0 = (const v2u*)(YS + (size_t)s0 * D) + lane; const v2u* y1 = (const v2u*)(YS + (size_t)s1 * D) + lane;
        f32x4 v[4]; float ss = 0.f;
#pragma unroll
        for (int j = 0; j < 4; ++j) { v[j] = hr[64 * j]; const v2u p = y0[64 * j], q = y1[64 * j];
            v[j].x += bflo(p.x) + bflo(q.x); v[j].y += bfhi(p.x) + bfhi(q.x); v[j].z += bflo(p.y) + bflo(q.y); v[j].w += bfhi(p.y) + bfhi(q.y);
            ss += (v[j].x * v[j].x + v[j].y * v[j].y) + (v[j].z * v[j].z + v[j].w * v[j].w); }
        const float rstd = rsqrtf(wave_sum(ss) * (1.0f / 1024.0f) + EPS);
#pragma unroll
        for (int j = 0; j < 4; ++j) { const f32x4 g = ((const f32x4*)a.in[IN_FNORM])[lane + 64 * j]; hr[64 * j] = v[j] * rstd * g; } }
}

typedef short bf16x8 __attribute__((ext_vector_type(8)));
typedef short bf16x4 __attribute__((ext_vector_type(4)));
typedef float f32x16 __attribute__((ext_vector_type(16)));
#define MFMA32(a, b, c) __builtin_amdgcn_mfma_f32_32x32x16_bf16((a), (b), (c), 0, 0, 0)
constexpr int DS_HIST = 0;
constexpr int DS_BM = 33024;
constexpr int DS_P = DS_BM + 8192;
constexpr int DS_CU = DS_P + 512;
constexpr int DS_CK = DS_CU + 8192;
constexpr int DS_BIAS = DS_CK + 8192;
constexpr int DS_ST = DS_BIAS + 2112;
constexpr int DS_CMB = DS_ST + 8 * 4608;
constexpr int DS_END = DS_CMB + 4 * 8704;
constexpr int DSA_CAP = 64;
static_assert(DS_END <= MISC_OFF - 64, "DSA LDS map");
__device__ __forceinline__ void tr_read_tile(unsigned addr, bf16x4& t00, bf16x4& t01, bf16x4& t10, bf16x4& t11, bf16x4& u00, bf16x4& u01, bf16x4& u10, bf16x4& u11) {
    asm volatile("s_waitcnt lgkmcnt(0)\n\t"
                 "ds_read_b64_tr_b16 %0, %8 offset:0\n\t" "ds_read_b64_tr_b16 %1, %8 offset:512\n\t" "ds_read_b64_tr_b16 %2, %8 offset:1024\n\t" "ds_read_b64_tr_b16 %3, %8 offset:1536\n\t"
                 "ds_read_b64_tr_b16 %4, %8 offset:2048\n\t" "ds_read_b64_tr_b16 %5, %8 offset:2560\n\t" "ds_read_b64_tr_b16 %6, %8 offset:3072\n\t" "ds_read_b64_tr_b16 %7, %8 offset:3584\n\t"
                 "s_waitcnt lgkmcnt(0)"
                 : "=&v"(t00), "=&v"(t01), "=&v"(t10), "=&v"(t11), "=&v"(u00), "=&v"(u01), "=&v"(u10), "=&v"(u11) : "v"(addr) : "memory");
}

__device__ __forceinline__ void dsa2_setup(const Args& a, LAS unsigned char* lds, int tid) {
    LAS float* biasL = (LAS float*)(lds + DS_BIAS);
    for (int i = tid; i < 4 * 129; i += NTHR) { const int h = i / 129, d = i % 129; biasL[h * 132 + d] = a.in[IN_RELB][rel_bucket(d) * 4 + h] * 1.4426950408889634f; }
    __syncthreads();
}
__device__ __forceinline__ void idx_scores(const bf16x8 ka0, const bf16x8 ka1, const bf16x8 (&qf)[8][2], const float (&wv)[8], float (&sc)[16]) {
#pragma unroll
    for (int r = 0; r < 16; ++r) sc[r] = 0.f;
    float zero = 0.f;
#pragma unroll
    for (int hp = 0; hp < 4; ++hp) {
        f32x16 acc0, acc1;
#pragma unroll
        for (int r = 0; r < 16; ++r) { acc0[r] = zero; acc1[r] = zero; }
        acc0 = MFMA32(ka0, qf[2 * hp][0], acc0); acc1 = MFMA32(ka0, qf[2 * hp + 1][0], acc1);
        acc0 = MFMA32(ka1, qf[2 * hp][1], acc0); acc1 = MFMA32(ka1, qf[2 * hp + 1][1], acc1);
#pragma unroll
        for (int r = 0; r < 16; ++r) sc[r] = __builtin_fmaf(fmaxf(acc1[r], 0.f), wv[2 * hp + 1], __builtin_fmaf(fmaxf(acc0[r], 0.f), wv[2 * hp], sc[r]));
        asm volatile("" : "+v"(zero), "+v"(sc[0]), "+v"(sc[1]), "+v"(sc[2]), "+v"(sc[3]), "+v"(sc[4]), "+v"(sc[5]), "+v"(sc[6]), "+v"(sc[7]), "+v"(sc[8]), "+v"(sc[9]), "+v"(sc[10]), "+v"(sc[11]), "+v"(sc[12]), "+v"(sc[13]), "+v"(sc[14]), "+v"(sc[15]));
    }
}
__device__ __forceinline__ void dsa2_item(const Args& a, int item, LAS unsigned char* lds, int tid) {
    const int lane = tid & 63, w = __builtin_amdgcn_readfirstlane(tid >> 6), ql = lane & 31, hh = lane >> 5;
    const int b = item & 7, qi = 63 - (item >> 3), tq0 = qi * 32, ntl = qi + 1;
    const bool sel = qi >= 8;
    const bf16* z = (const bf16*)(a.ws + WS_Z); bf16* mix = (bf16*)(a.ws + WS_MIX);
    const bf16* zb = z + (size_t)b * T * ZW;
    const bf16* zq = zb + (size_t)(tq0 + ql) * ZW;
    LAS unsigned* hist = (LAS unsigned*)(lds + DS_HIST); LAS unsigned* bm = (LAS unsigned*)(lds + DS_BM);
    LAS unsigned* Pp = (LAS unsigned*)(lds + DS_P); LAS unsigned* need = Pp + 32; LAS unsigned* ccnt = Pp + 64; LAS unsigned* ccnt2 = Pp + 96;
    LAS unsigned* cu = (LAS unsigned*)(lds + DS_CU); LAS unsigned* ck = (LAS unsigned*)(lds + DS_CK);
    const LAS float* biasL = (const LAS float*)(lds + DS_BIAS);
    if (sel) {
        for (int i = tid; i < 2048; i += NTHR) bm[i] = 0u;
        if (tid < 32) { Pp[tid] = 0u; need[tid] = 256u; ccnt2[tid] = 0u; }
        bf16x8 qf[8][2]; float wv[8];
#pragma unroll
        for (int hx = 0; hx < 8; ++hx) { qf[hx][0] = *(const bf16x8*)(zq + Z_CQI + hx * 32 + 8 * hh); qf[hx][1] = *(const bf16x8*)(zq + Z_CQI + hx * 32 + 16 + 8 * hh); }
        { const v4u wr = *(const v4u*)(zq + Z_CWI);
          wv[0] = bflo(wr.x) * 0.0625f; wv[1] = bfhi(wr.x) * 0.0625f; wv[2] = bflo(wr.y) * 0.0625f; wv[3] = bfhi(wr.y) * 0.0625f;
          wv[4] = bflo(wr.z) * 0.0625f; wv[5] = bfhi(wr.z) * 0.0625f; wv[6] = bflo(wr.w) * 0.0625f; wv[7] = bfhi(wr.w) * 0.0625f; }
        int sh = 23, nb = 9;
#pragma unroll 1
        for (int level = 0; level < 4; ++level) {
            for (int i = tid; i < 32 * 257; i += NTHR) hist[i] = 0u;
            __syncthreads();
            const unsigned myP = Pp[ql];
#pragma unroll 1
            for (int kt = w; kt < ntl; kt += 8) {
                const bf16* zk = zb + (size_t)(kt * 32 + ql) * ZW + Z_CKI + 8 * hh;
                const bf16x8 ka0 = *(const bf16x8*)zk, ka1 = *(const bf16x8*)(zk + 16);
                float sc[16]; idx_scores(ka0, ka1, qf, wv, sc);
#pragma unroll
                for (int r = 0; r < 16; ++r) { const int kl = (r & 3) + 8 * (r >> 2) + 4 * hh; const unsigned u = ord_u(sc[r] + 0.0f);
                    const bool ok = (kt < qi || kl <= ql) && (level == 0 || (u >> (sh + nb)) == myP);
                    if (ok) { const unsigned digit = (u >> sh) & ((1u << nb) - 1u); LDS_ADD(&hist[ql * 257 + (digit >> 1)], 1u << (16 * (digit & 1))); } }
            }
            __syncthreads();
#pragma unroll 1
            for (int qq = 0; qq < 4; ++qq) { const int q = 4 * w + qq; const int bpl = (1 << nb) >> 6, wpl = bpl >> 1;
                unsigned c[8]; unsigned s = 0u;
#pragma unroll
                for (int i = 0; i < 4; ++i) { const unsigned wd = (i < wpl) ? hist[q * 257 + lane * wpl + i] : 0u; c[2 * i] = wd & 0xffffu; c[2 * i + 1] = wd >> 16; s += c[2 * i] + c[2 * i + 1]; }
                unsigned incl = s;
#pragma unroll
                for (int o = 1; o < 64; o <<= 1) { const unsigned t2 = __shfl_down(incl, o); if (lane + o < 64) incl += t2; }
                const unsigned excl = incl - s, nd = need[q];
                if (excl < nd && nd <= incl) { unsigned run = excl; int dsel = 0; unsigned above = 0u, cand = 0u; bool found = false;
#pragma unroll
                    for (int i = 7; i >= 0; --i) { if (i < bpl && !found) { if (run + c[i] >= nd) { dsel = i; above = run; cand = c[i]; found = true; } else run += c[i]; } }
                    Pp[q] = (Pp[q] << nb) | (unsigned)(lane * bpl + dsel); need[q] = nd - above; ccnt[q] = cand; }
            }
            __syncthreads();
            unsigned mc = ccnt[ql]; mc = (unsigned)wave_max((float)mc);
            if (mc <= (unsigned)DSA_CAP || level == 3) break;
            sh -= (level == 2) ? 7 : 8; nb = (level == 2) ? 7 : 8;
        }
        { const unsigned myP = Pp[ql];
#pragma unroll 1
          for (int kt = w; kt < ntl; kt += 8) {
            const bf16* zk = zb + (size_t)(kt * 32 + ql) * ZW + Z_CKI + 8 * hh;
            const bf16x8 ka0 = *(const bf16x8*)zk, ka1 = *(const bf16x8*)(zk + 16);
            float sc[16]; idx_scores(ka0, ka1, qf, wv, sc); unsigned bits = 0u;
#pragma unroll
            for (int r = 0; r < 16; ++r) { const int kl = (r & 3) + 8 * (r >> 2) + 4 * hh; const unsigned u = ord_u(sc[r] + 0.0f), pfx = u >> sh;
                if (kt < qi || kl <= ql) { if (pfx > myP) bits |= 1u << kl;
                    else if (pfx == myP) { const unsigned slot = __hip_atomic_fetch_add(&ccnt2[ql], 1u, __ATOMIC_RELAXED, __HIP_MEMORY_SCOPE_WORKGROUP);
                        if (slot < (unsigned)DSA_CAP) { cu[ql * DSA_CAP + slot] = u; ck[ql * DSA_CAP + slot] = (unsigned)(kt * 32 + kl); } } } }
            if (bits) (void)__hip_atomic_fetch_or(&bm[kt * 32 + ql], bits, __ATOMIC_RELAXED, __HIP_MEMORY_SCOPE_WORKGROUP);
          } }
        __syncthreads();
        for (int idx = tid; idx < 32 * DSA_CAP; idx += NTHR) { const int q = idx / DSA_CAP, i = idx % DSA_CAP; unsigned n = ccnt2[q]; n = n < (unsigned)DSA_CAP ? n : (unsigned)DSA_CAP;
            if ((unsigned)i < n) { const unsigned ui = cu[q * DSA_CAP + i], ki = ck[q * DSA_CAP + i]; unsigned rank = 0u;
                for (unsigned j = 0; j < n; ++j) { const unsigned uj = cu[q * DSA_CAP + j], kj = ck[q * DSA_CAP + j]; rank += (uj > ui || (uj == ui && kj < ki)) ? 1u : 0u; }
                if (rank < need[q]) (void)__hip_atomic_fetch_or(&bm[(ki >> 5) * 32 + q], 1u << (ki & 31u), __ATOMIC_RELAXED, __HIP_MEMORY_SCOPE_WORKGROUP); } }
        __syncthreads();
    }
    const int hd = w >> 1, half = w & 1;
    bf16x8 qa[4];
#pragma unroll
    for (int s = 0; s < 4; ++s) qa[s] = *(const bf16x8*)(zq + Z_CQ + hd * 64 + 16 * s + 8 * hh);
    f32x16 o0, o1;
#pragma unroll
    for (int r = 0; r < 16; ++r) { o0[r] = 0.f; o1[r] = 0.f; }
    float m = -1e30f, lsum = 0.f;
    const float c31 = biasL[hd * 132 + 128];
    LAS unsigned char* st = lds + DS_ST + w * 4608;
    const unsigned vaddr = (unsigned)(size_t)st + (unsigned)((4 * hh + ((lane >> 2) & 3)) * 64 + 32 * ((lane >> 4) & 1) + 8 * (lane & 3));
    constexpr float SC = 0.18033688011112042f;
#pragma unroll 1
    for (int kt = half; kt < ntl; kt += 2) {
        const int k0 = kt * 32;
        bf16x8 kf[4];
        { const bf16* zk = zb + (size_t)(k0 + ql) * ZW + Z_CK + hd * 64 + 8 * hh;
#pragma unroll
          for (int s = 0; s < 4; ++s) kf[s] = *(const bf16x8*)(zk + 16 * s); }
#pragma unroll
        for (int i = 0; i < 4; ++i) { const int key = (lane >> 3) + 8 * i, ch = lane & 7;
            const v4u v = *(const v4u*)(zb + (size_t)(k0 + key) * ZW + Z_CV + hd * 64 + ch * 8);
            *(LAS v4u*)(st + (ch >> 2) * 2048 + key * 64 + (ch & 3) * 16) = v; }
        f32x16 sacc;
#pragma unroll
        for (int r = 0; r < 16; ++r) sacc[r] = 0.f;
#pragma unroll
        for (int s = 0; s < 4; ++s) sacc = MFMA32(kf[s], qa[s], sacc);
        unsigned word = sel ? bm[kt * 32 + ql] : 0xffffffffu;
        if (kt == qi) word &= (ql == 31) ? 0xffffffffu : ((2u << ql) - 1u);
        const bool nearb = (tq0 - (k0 + 31)) < 128;
        float sv[16]; float tmax = -1e30f;
#pragma unroll
        for (int r = 0; r < 16; ++r) { const int kl = (r & 3) + 8 * (r >> 2) + 4 * hh; float bias = c31;
            if (nearb) { int dd = tq0 + ql - k0 - kl; dd = dd < 0 ? 0 : (dd > 128 ? 128 : dd); bias = biasL[hd * 132 + dd]; }
            const float v = sacc[r] * SC + bias; sv[r] = ((word >> kl) & 1u) ? v : -1e30f; tmax = fmaxf(tmax, sv[r]); }
        tmax = fmaxf(tmax, __shfl_xor(tmax, 32));
        const float mnew = fmaxf(m, tmax), alpha = __builtin_amdgcn_exp2f(m - mnew);
        float p[16]; float ps = 0.f;
#pragma unroll
        for (int r = 0; r < 16; ++r) { p[r] = (sv[r] > -1e29f) ? __builtin_amdgcn_exp2f(sv[r] - mnew) : 0.f; ps += p[r]; }
        ps += __shfl_xor(ps, 32);
        lsum = lsum * alpha + ps; m = mnew;
#pragma unroll
        for (int r = 0; r < 16; ++r) { o0[r] *= alpha; o1[r] *= alpha; }
        bf16x8 pb[2];
#pragma unroll
        for (int s = 0; s < 2; ++s) { v4u t4; t4.x = pg8::cvt_pk_bf16(p[8 * s + 0], p[8 * s + 1]); t4.y = pg8::cvt_pk_bf16(p[8 * s + 2], p[8 * s + 3]); t4.z = pg8::cvt_pk_bf16(p[8 * s + 4], p[8 * s + 5]); t4.w = pg8::cvt_pk_bf16(p[8 * s + 6], p[8 * s + 7]);
            pb[s] = __builtin_bit_cast(bf16x8, t4); }
        bf16x4 t00, t01, t10, t11, u00, u01, u10, u11;
        tr_read_tile(vaddr, t00, t01, t10, t11, u00, u01, u10, u11);
        const bf16x8 va00 = __builtin_shufflevector(t00, t01, 0, 1, 2, 3, 4, 5, 6, 7), va01 = __builtin_shufflevector(t10, t11, 0, 1, 2, 3, 4, 5, 6, 7);
        const bf16x8 va10 = __builtin_shufflevector(u00, u01, 0, 1, 2, 3, 4, 5, 6, 7), va11 = __builtin_shufflevector(u10, u11, 0, 1, 2, 3, 4, 5, 6, 7);
        o0 = MFMA32(va00, pb[0], o0); o0 = MFMA32(va01, pb[1], o0);
        o1 = MFMA32(va10, pb[0], o1); o1 = MFMA32(va11, pb[1], o1);
    }
    LAS float* cmb = (LAS float*)(lds + DS_CMB + hd * 8704);
    if (half == 1) {
#pragma unroll
        for (int r = 0; r < 16; ++r) { cmb[r * 64 + lane] = o0[r]; cmb[(16 + r) * 64 + lane] = o1[r]; }
        cmb[2048 + lane] = m; cmb[2048 + 64 + lane] = lsum;
    }
    __syncthreads();
    if (half == 0) {
        const float mb = cmb[2048 + lane], lb = cmb[2048 + 64 + lane];
        const float mt = fmaxf(m, mb), fa = __builtin_amdgcn_exp2f(m - mt), fb = __builtin_amdgcn_exp2f(mb - mt);
        const float inv = 1.0f / (lsum * fa + lb * fb), ga = fa * inv, gb = fb * inv;
        asm volatile("s_waitcnt lgkmcnt(0)" ::: "memory");
#pragma unroll
        for (int r = 0; r < 16; ++r) { o0[r] = o0[r] * ga + cmb[r * 64 + lane] * gb; o1[r] = o1[r] * ga + cmb[(16 + r) * 64 + lane] * gb; }
#pragma unroll
        for (int g = 0; g < 4; ++g) { v2u w0, w1; w0.x = pg8::cvt_pk_bf16(o0[4 * g], o0[4 * g + 1]); w0.y = pg8::cvt_pk_bf16(o0[4 * g + 2], o0[4 * g + 3]); w1.x = pg8::cvt_pk_bf16(o1[4 * g], o1[4 * g + 1]); w1.y = pg8::cvt_pk_bf16(o1[4 * g + 2], o1[4 * g + 3]);
            *(LAS v2u*)(st + ql * 136 + (8 * g + 4 * hh) * 2) = w0; *(LAS v2u*)(st + ql * 136 + (32 + 8 * g + 4 * hh) * 2) = w1; }
        asm volatile("s_waitcnt lgkmcnt(0)" ::: "memory");
#pragma unroll
        for (int i = 0; i < 4; ++i) { const int q = (lane >> 3) + 8 * i, ch = lane & 7;
            const v2u x0 = *(const LAS v2u*)(st + q * 136 + ch * 16), x1 = *(const LAS v2u*)(st + q * 136 + ch * 16 + 8);
            v4u o; o.x = x0.x; o.y = x0.y; o.z = x1.x; o.w = x1.y;
            *(v4u*)(mix + ((size_t)b * T + tq0 + q) * D + 512 + hd * 64 + ch * 8) = o; }
    }
    __syncthreads();
}

constexpr int CW_QUEUE = 8192;
__device__ __forceinline__ void mixers_phase(const Args& a, int l, LAS unsigned char* lds, int tid) {
    dsa2_setup(a, lds, tid);
    unsigned* qctr = (unsigned*)(a.ws + WS_CTL) + CW_QUEUE + 64 * l;
    volatile LAS int* qslot = (volatile LAS int*)(lds + MISC_OFF + 64);
    for (;;) {
        if (tid == 0) *qslot = (int)__hip_atomic_fetch_add(qctr, 1u, __ATOMIC_RELAXED, __HIP_MEMORY_SCOPE_AGENT);
        __syncthreads();
        const int it = *qslot;
        __syncthreads();
        if (it >= 3072) break;
        int t2 = tid; asm volatile("" : "+v"(t2));
        if (it < 512) dsa2_item(a, it, lds, t2);
        else if (it < 1536) gla_a_item(a, l, it - 512, lds, t2);
        else if (it < 2560) pool_item(a, l, it - 1536, lds, t2);
        else sgu_item(a, l, it - 2560, lds, t2);
    }
}

constexpr int NPHASE = 28;
#define OTID() int tid = threadIdx.x; asm volatile("" : "+v"(tid))
__global__ void __launch_bounds__(NTHR, 2) fwd_kernel(Args a) {
    extern __shared__ __attribute__((aligned(16))) unsigned char lds_raw[];
    LAS unsigned char* lds = (LAS unsigned char*)lds_raw;
    const int G = gridDim.x, bid = blockIdx.x;
    volatile LAS unsigned* MISC = (volatile LAS unsigned*)(lds + MISC_OFF);
    if (threadIdx.x < 32) MISC[threadIdx.x] = 0u;
    __syncthreads();
    unsigned char* ws = a.ws;
    XcdBarrier bar; bar.bar = (unsigned*)(ws + WS_CTL) + CW_BAR; bar.x = 0; bar.st = nullptr;
    if (N_LAUNCH_MODE == 1) bar = xcd_barrier_post((unsigned*)(ws + WS_CTL) + CW_BAR, MISC + 8);
    const int lo = a.ph_lo, hi = a.ph_hi;
#define RUN(k) (lo <= (k) && (k) < hi)
#define SEAM() do { if (N_LAUNCH_MODE == 1) xcd_barrier(bar); } while (0)
#define WB(off) ((bf16*)(ws + (off)))
#define WF(off) ((float*)(ws + (off)))
    if (RUN(0)) { OTID(); p0_prologue(a, lds, tid, G); SEAM(); }

    for (int l = 0; l < 2; ++l) {
        const int pb = l ? 10 : 1;
        if (RUN(pb + 0)) {
            { pg8::Gemm g{WB(WS_HB), WB(WS_WIN + l * SZ_WIN), M, ZW, D}; pg8::StaticOrder S; S.init(M, ZW, G, bid);
              EpiScale E{WB(WS_Z), ZW, WF(WS_SS), 1.0f}; pg8::gemm_phase<EpiScale, pg8::StaticOrder, true, true>(lds, g, S, E); }
            if (l == 0) {
                for (int l2 = 0; l2 < 2; ++l2) {
                    pg8::Gemm g{WB(WS_MEMB), WB(WS_WKV + l2 * SZ_WKV), MM, 512, D}; pg8::StaticOrder S; S.init(MM, 512, G, (G - 1 - bid - 16 * l2 + 2 * G) % G);
                    EpiScale E{WB(WS_KVM + l2 * SZ_KVM), 512, WF(WS_SSM), 1.0f}; pg8::gemm_phase<EpiScale, pg8::StaticOrder, true, true>(lds, g, S, E); }
            }
            SEAM();
        }
        if (RUN(pb + 1)) {
            { OTID(); mixers_phase(a, l, lds, tid); }
            SEAM();
        }
        if (RUN(pb + 2)) { OTID(); for (int it = bid; it < 1024; it += G) gla_c_item(a, l, it, lds, tid); SEAM(); }
        if (RUN(pb + 3)) {
            pg8::Gemm g{WB(WS_MIX), WB(WS_WOUT + l * SZ_WOUT), M, D, D}; pg8::StaticOrder S; S.init(M, D, G, bid);
            EpiResid E{l == 0 ? a.in[IN_X] : (const float*)a.out, a.out, WB(WS_HB), WF(WS_SS)}; pg8::gemm_phase<EpiResid, pg8::StaticOrder, true, true>(lds, g, S, E); SEAM();
        }
        if (RUN(pb + 4)) {
            pg8::Gemm g{WB(WS_HB), WB(WS_WQ + l * SZ_WQ), M, 256, D}; pg8::StaticOrder S; S.init(M, 256, G, bid);
            EpiScale E{WB(WS_QX), 256, WF(WS_SS), 0.125f}; pg8::gemm_phase<EpiScale, pg8::StaticOrder, true, true>(lds, g, S, E); SEAM();
        }
        if (RUN(pb + 5)) { OTID(); for (int it = bid; it < 1024; it += G) xattn_item(a, l, it, lds, tid); SEAM(); }
        if (RUN(pb + 6)) {
            pg8::Gemm g{WB(WS_OX), WB(WS_WO + l * SZ_WO), M, D, 256}; pg8::StaticOrder S; S.init(M, D, G, bid);
            EpiResid E{a.out, a.out, WB(WS_HB), WF(WS_SS)}; pg8::gemm_phase<EpiResid, pg8::StaticOrder, true, true>(lds, g, S, E); SEAM();
        }
        if (l == 0) {
            if (RUN(8)) {
                pg8::Gemm g{WB(WS_HB), WB(WS_W13), M, 2 * DFF, D}; pg8::StaticOrder S; S.init(M, 2 * DFF, G, bid);
                EpiSwiglu<false> E{WB(WS_FACT), DFF, WF(WS_SS), nullptr, nullptr}; pg8::gemm_phase<EpiSwiglu<false>, pg8::StaticOrder, true, true>(lds, g, S, E); SEAM();
            }
            if (RUN(9)) {
                pg8::Gemm g{WB(WS_FACT), WB(WS_W2), M, D, DFF}; pg8::StaticOrder S; S.init(M, D, G, bid);
                EpiResid E{a.out, a.out, WB(WS_HB), WF(WS_SS)}; pg8::gemm_phase<EpiResid, pg8::StaticOrder, true, true>(lds, g, S, E); SEAM();
            }
        } else {
            if (RUN(17)) { OTID(); moe_route(a, lds, tid, G); SEAM(); }
            if (RUN(18)) { OTID(); moe_assign(a, lds, tid, G); SEAM(); }
            for (int p = 0; p < MOE_NPASS; ++p) {
                const int* TILEE = (const int*)(ws + WS_TILEE);
                if (RUN(19 + 2 * p)) {
                    const int NT = TILEE[159]; int nt = NT - p * MOE_TP; nt = nt < 0 ? 0 : (nt > MOE_TP ? MOE_TP : nt);
                    pg8::Gemm g{WB(WS_AG), WB(WS_MW13), MAXSLOT, NEXP * 2 * DFE, D}; pg8::MoeOrder S{p * MOE_TP, nt, 2 * DFE / 256, G, bid, 0, TILEE};
                    EpiSwiglu<true> E{WB(WS_MACT), DFE, nullptr, WF(WS_SLOTR), WF(WS_SLOTG)};
                    pg8::gemm_phase<EpiSwiglu<true>, pg8::MoeOrder, true, true>(lds, g, S, E); SEAM();
                }
                if (RUN(20 + 2 * p)) {
                    const int NT = TILEE[159]; int nt = NT - p * MOE_TP; nt = nt < 0 ? 0 : (nt > MOE_TP ? MOE_TP : nt);
                    pg8::Gemm g{WB(WS_MACT), WB(WS_MW2), MOE_TP * 256, NEXP * D, DFE}; pg8::MoeOrder S{p * MOE_TP, nt, D / 256, G, bid, 1, TILEE};
                    EpiPlain E{WB(WS_YS), D};
                    pg8::gemm_phase<EpiPlain, pg8::MoeOrder, true, true>(lds, g, S, E); SEAM();
                }
            }
            if (RUN(27)) { OTID(); final_phase(a, tid, G); }
        }
    }
#undef RUN
#undef SEAM
}

extern "C" void kernel_launch(void* const* d_in, const int* in_sizes, int n_in, void* d_out, int out_size, void* d_ws, size_t ws_size, hipStream_t stream) {
    static int grid = 0;
    if (grid == 0) {
        if (n_in != N_IN || out_size != M * D || ws_size < WS_END) { fprintf(stderr, "kernel_launch: unexpected problem (n_in %d, out %d, ws %zu < %zu)\n", n_in, out_size, ws_size, (size_t)WS_END); grid = -1; return; }
        int dev = 0, cus = 0, per_cu = 0;
        if (hipGetDevice(&dev) != hipSuccess || hipDeviceGetAttribute(&cus, hipDeviceAttributeMultiprocessorCount, dev) != hipSuccess) { grid = -1; return; }
        if (hipFuncSetAttribute((const void*)fwd_kernel, hipFuncAttributeMaxDynamicSharedMemorySize, LDS_BYTES) != hipSuccess) { fprintf(stderr, "kernel_launch: hipFuncSetAttribute failed\n"); grid = -1; return; }
        if (hipOccupancyMaxActiveBlocksPerMultiprocessor(&per_cu, (const void*)fwd_kernel, NTHR, LDS_BYTES) != hipSuccess || per_cu < 1) { fprintf(stderr, "kernel_launch: occupancy query says %d\n", per_cu); }
        (void)hipGetLastError();
        grid = cus > 0 ? cus : 256;
    }
    if (grid < 0) return;
    (void)hipMemsetAsync((char*)d_ws + WS_CTL, 0, CTL_ZERO_BYTES, stream);
    Args a{};
    for (int i = 0; i < N_IN; ++i) a.in[i] = (const float*)d_in[i];
    a.out = (float*)d_out; a.ws = (unsigned char*)d_ws;
#if N_LAUNCH_MODE == 1
    a.ph_lo = 0; a.ph_hi = NPHASE;
    hipLaunchKernelGGL(fwd_kernel, dim3(grid), dim3(NTHR), LDS_BYTES, stream, a);
#else
    for (int p = 0; p < NPHASE; ++p) { a.ph_lo = p; a.ph_hi = p + 1; hipLaunchKernelGGL(fwd_kernel, dim3(grid), dim3(NTHR), LDS_BYTES, stream, a); }
#endif
}
```

```cpp
#include <hip/hip_runtime.h>
#include <cstdio>
#include <cstdint>
#include <cmath>

#ifndef N_LAUNCH_MODE
#define N_LAUNCH_MODE 1
#endif

namespace pg8 {
#define PG8_LAS __attribute__((address_space(3)))
typedef unsigned short bf16_t;
typedef short bf16x8 __attribute__((ext_vector_type(8)));
typedef float f32x4 __attribute__((ext_vector_type(4)));
typedef unsigned u32x4 __attribute__((ext_vector_type(4)));
constexpr int BM = 256, BK = 64, HALF = 128, HTB = HALF * BK * 2  , STAGE_BYTES = 8 * HTB, NXCD = 8, WGM = 8;

__host__ __device__ __forceinline__ int lds_byte(int r, int c) { const int st = (r >> 4) * 2 + (c >> 5), rr = r & 15, cc = c & 31, ob = rr * 64 + cc * 2; return st * 1024 + (ob ^ (((ob >> 9) & 1) << 5)); }
__host__ __device__ __forceinline__ void stage_rc(int b, int& R, int& C) { const int st = b / 1024, sb = b % 1024, swz = sb ^ (((sb >> 9) & 1) << 5); R = (st >> 1) * 16 + swz / 64; C = (st & 1) * 32 + (swz % 64) / 2; }
__host__ __device__ __forceinline__ int perm32(int rho) { const int n = rho >> 4, i = rho & 15; return 8 * (i >> 2) + 4 * n + (i & 3); }

struct Unit { int pm, pn, po, e; };
struct Gemm { const bf16_t* A; const bf16_t* Bt; int M, N, K; };

struct StaticOrder {
    int nM, nN, nwg, G, c;
    __host__ __device__ void init(int M, int N, int G_, int c_) { nM = M / BM; nN = N / BM; nwg = nM * nN; G = G_; c = c_; }
    __host__ __device__ bool next(int i, Unit& u) const {
        const long L = (long)i * G + c; if (L >= nwg) return false;
        int wgid = (int)L; { const int q = nwg / NXCD, r = nwg % NXCD, xcd = wgid % NXCD, off = wgid / NXCD; wgid = (xcd < r ? xcd * (q + 1) : r * (q + 1) + (xcd - r) * q) + off; }
        const int nig = WGM * nN, gid = wgid / nig, fm = gid * WGM, gsz = (nM - fm) < WGM ? (nM - fm) : WGM;
        u.pm = fm + ((wgid % nig) % gsz); u.pn = (wgid % nig) / gsz; u.po = u.pm; u.e = u.pn; return true;
    }
    __device__ __forceinline__ void a_ready(const Unit&) const {}
    __device__ __forceinline__ void done(const Unit&) const {}
};
struct MoeOrder {
    int t0, nt, nNe, G, c, a_local; const int* tile_e;
    __device__ bool next(int i, Unit& u) const {
        const long L = (long)i * G + c; if (L >= (long)nt * nNe) return false;
        const int tl = (int)(L % nt), pn = (int)(L / nt), tile = t0 + tl, e = tile_e[tile];
        u.pm = a_local ? tl : tile; u.po = a_local ? tile : tl; u.pn = e * nNe + pn; u.e = pn; return true;
    }
    __device__ __forceinline__ void a_ready(const Unit&) const {}
    __device__ __forceinline__ void done(const Unit&) const {}
};
__device__ __forceinline__ unsigned cvt_pk_bf16(float lo, float hi) { unsigned r; asm volatile("v_cvt_pk_bf16_f32 %0, %1, %2" : "=v"(r) : "v"(lo), "v"(hi)); return r; }
template <class Epi, class Sched, bool ALIGN_EPI = false, bool SP2 = false>
__device__ __forceinline__ void gemm_phase(PG8_LAS unsigned char* lds, const Gemm g, const Sched& S, const Epi& E) {
    int tid_ = threadIdx.x; asm volatile("" : "+v"(tid_)); const int tid = tid_, wid = __builtin_amdgcn_readfirstlane(tid >> 6), lane = tid & 63, wr = wid >> 2, wc = wid & 3, fr = lane & 15, fq = lane >> 4;
    const int K = g.K, nt = K / BK;
    unsigned voffA[2], voffB[2];
#pragma unroll
    for (int i = 0; i < 2; ++i) { int R, C; stage_rc(tid * 16 + i * 8192, R, C); const int Rb = Epi::PERM ? ((R & ~31) + perm32(R & 31)) : R;
        voffA[i] = (unsigned)(R * K + C) * 2u; voffB[i] = (unsigned)(Rb * K + C) * 2u; }
    const size_t kstep = (size_t)(BK * 2);
    const size_t hstep = (size_t)HALF * K * 2;
    const size_t tstep = 2 * hstep;
    const unsigned ldsw = (unsigned)wid * 1024u;
    const int aoff = lds_byte(wr * 64 + fr, fq * 8), boff = lds_byte(wc * 32 + fr, fq * 8);
#define PG8_SA(b, h) (((b) * 2 + (h)) * HTB)
#define PG8_SB(b, h) ((4 + (b) * 2 + (h)) * HTB)
#define PG8_STAGE(bufoff, gbase, voff) do { _Pragma("unroll") for (int _i = 0; _i < 2; ++_i) \
        __builtin_amdgcn_global_load_lds((const unsigned*)((const char*)(gbase) + (voff)[_i]), (PG8_LAS unsigned*)(lds + (bufoff) + ldsw + _i * 8192), 16, 0, 0); } while (0)
#define PG8_LDA(dst, b, h) do { _Pragma("unroll") for (int m = 0; m < 4; ++m) _Pragma("unroll") for (int k = 0; k < 2; ++k) dst[m][k] = *(const PG8_LAS bf16x8*)(lds + PG8_SA(b, h) + aoff + m * 2048 + k * 1024); } while (0)
#define PG8_LDB(dst, b, h) do { _Pragma("unroll") for (int n = 0; n < 2; ++n) _Pragma("unroll") for (int k = 0; k < 2; ++k) dst[n][k] = *(const PG8_LAS bf16x8*)(lds + PG8_SB(b, h) + boff + n * 2048 + k * 1024); } while (0)
#define PG8_MMA(ai, bj, At, Bt) do { __builtin_amdgcn_s_setprio(1); _Pragma("unroll") for (int m = 0; m < 4; ++m) _Pragma("unroll") for (int n = 0; n < 2; ++n) _Pragma("unroll") for (int k = 0; k < 2; ++k) \
        acc[ai][bj][m][n] = __builtin_amdgcn_mfma_f32_16x16x32_bf16(Bt[n][k], At[m][k], acc[ai][bj][m][n], 0, 0, 0); __builtin_amdgcn_s_setprio(0); } while (0)
#define PG8_WAIT_V(n) asm volatile("s_waitcnt vmcnt(" #n ")" ::: "memory")
#define PG8_WAIT_L(n) asm volatile("s_waitcnt lgkmcnt(" #n ")" ::: "memory")
#define PG8_BAR __builtin_amdgcn_s_barrier()
#define PG8_SCHED __builtin_amdgcn_sched_barrier(0)
    Unit cur, nxt; int ui = 0;
    if (!S.next(0, cur)) return;
    f32x4 acc[2][2][4][2];
#pragma unroll
    for (int a = 0; a < 2; ++a)
#pragma unroll
        for (int b = 0; b < 2; ++b)
#pragma unroll
            for (int m = 0; m < 4; ++m)
#pragma unroll
                for (int n = 0; n < 2; ++n) acc[a][b][m][n] = (f32x4){0.f, 0.f, 0.f, 0.f};
    bf16x8 At[4][2], B0[2][2], B1[2][2];
    const char* cA = (const char*)g.A + (size_t)cur.pm * tstep; const char* cB = (const char*)g.Bt + (size_t)cur.pn * tstep;
    S.a_ready(cur);
    if constexpr (SP2) {
        PG8_STAGE(PG8_SB(0, 0), cB, voffB); PG8_STAGE(PG8_SB(0, 1), cB + hstep, voffB); PG8_STAGE(PG8_SA(0, 0), cA, voffA); PG8_STAGE(PG8_SA(0, 1), cA + hstep, voffA);
        if (wr == 1) PG8_BAR;
        PG8_WAIT_V(2); PG8_BAR;
        PG8_STAGE(PG8_SB(1, 0), cB + kstep, voffB); PG8_STAGE(PG8_SA(1, 0), cA + kstep, voffA); PG8_STAGE(PG8_SB(1, 1), cB + hstep + kstep, voffB);
        PG8_WAIT_V(6); PG8_BAR;
    } else {
        PG8_STAGE(PG8_SB(0, 0), cB, voffB); PG8_STAGE(PG8_SA(0, 0), cA, voffA); PG8_STAGE(PG8_SB(0, 1), cB + hstep, voffB); PG8_STAGE(PG8_SA(0, 1), cA + hstep, voffA);
        if (wr == 1) PG8_BAR;
        PG8_WAIT_V(4); PG8_BAR;
        PG8_STAGE(PG8_SB(1, 0), cB + kstep, voffB); PG8_STAGE(PG8_SA(1, 0), cA + kstep, voffA); PG8_STAGE(PG8_SB(1, 1), cB + hstep + kstep, voffB);
        PG8_WAIT_V(6); PG8_BAR;
    }
    for (;;) {
        const bool has_next = S.next(ui + 1, nxt);
        const char* nA = has_next ? (const char*)g.A + (size_t)nxt.pm * tstep : cA; const char* nB = has_next ? (const char*)g.Bt + (size_t)nxt.pn * tstep : cB;
        for (int t = 0; t < nt; t += 2) {
            const bool last = (t == nt - 2);
            const char* a1 = cA + (size_t)(t + 1) * kstep;
            const char* a2 = last ? nA : cA + (size_t)(t + 2) * kstep; const char* b2 = last ? nB : cB + (size_t)(t + 2) * kstep;
            const char* a3 = a2 + kstep; const char* b3 = b2 + kstep;
            if (last && has_next) S.a_ready(nxt);
            if constexpr (SP2) {
            PG8_LDB(B0, 0, 0); PG8_LDB(B1, 0, 1); PG8_SCHED; PG8_LDA(At, 0, 0); PG8_STAGE(PG8_SA(1, 1), a1 + hstep, voffA);
            PG8_WAIT_V(8); PG8_WAIT_L(0); PG8_BAR; PG8_MMA(0, 0, At, B0); PG8_MMA(0, 1, At, B1); PG8_BAR; PG8_SCHED;
            PG8_LDA(At, 0, 1); PG8_STAGE(PG8_SB(0, 0), b2, voffB); PG8_STAGE(PG8_SB(0, 1), b2 + hstep, voffB); PG8_STAGE(PG8_SA(0, 0), a2, voffA);
            PG8_WAIT_V(8); PG8_WAIT_L(0); PG8_BAR; PG8_MMA(1, 0, At, B0); PG8_MMA(1, 1, At, B1); PG8_BAR; PG8_SCHED;
            PG8_LDB(B0, 1, 0); PG8_LDB(B1, 1, 1); PG8_SCHED; PG8_LDA(At, 1, 0); PG8_STAGE(PG8_SA(0, 1), a2 + hstep, voffA);
            PG8_WAIT_V(8); PG8_WAIT_L(0); PG8_BAR; PG8_MMA(0, 0, At, B0); PG8_MMA(0, 1, At, B1); PG8_BAR; PG8_SCHED;
            PG8_LDA(At, 1, 1); PG8_STAGE(PG8_SB(1, 0), b3, voffB); PG8_STAGE(PG8_SB(1, 1), b3 + hstep, voffB); PG8_STAGE(PG8_SA(1, 0), a3, voffA);
            PG8_WAIT_V(8); PG8_WAIT_L(0); PG8_BAR; PG8_MMA(1, 0, At, B0); PG8_MMA(1, 1, At, B1); PG8_BAR; PG8_SCHED;
            } else {
            PG8_LDB(B0, 0, 0); PG8_SCHED; PG8_LDA(At, 0, 0); PG8_STAGE(PG8_SA(1, 1), a1 + hstep, voffA);
            PG8_WAIT_L(8); PG8_BAR; PG8_WAIT_L(0); PG8_MMA(0, 0, At, B0); PG8_BAR; PG8_SCHED;
            PG8_LDB(B1, 0, 1); PG8_STAGE(PG8_SB(0, 0), b2, voffB);
            PG8_BAR; PG8_WAIT_L(0); PG8_MMA(0, 1, At, B1); PG8_BAR;
            PG8_LDA(At, 0, 1); PG8_STAGE(PG8_SA(0, 0), a2, voffA);
            PG8_BAR; PG8_WAIT_L(0); PG8_MMA(1, 0, At, B0); PG8_BAR; PG8_SCHED;
            PG8_STAGE(PG8_SB(0, 1), b2 + hstep, voffB);
            PG8_WAIT_V(6); PG8_BAR; PG8_MMA(1, 1, At, B1); PG8_BAR;
            PG8_LDB(B0, 1, 0); PG8_SCHED; PG8_LDA(At, 1, 0); PG8_STAGE(PG8_SA(0, 1), a2 + hstep, voffA);
            PG8_WAIT_L(8); PG8_BAR; PG8_WAIT_L(0); PG8_MMA(0, 0, At, B0); PG8_BAR; PG8_SCHED;
            PG8_LDB(B1, 1, 1); PG8_STAGE(PG8_SB(1, 0), b3, voffB);
            PG8_BAR; PG8_WAIT_L(0); PG8_MMA(0, 1, At, B1); PG8_BAR;
            PG8_LDA(At, 1, 1); PG8_STAGE(PG8_SA(1, 0), a3, voffA);
            PG8_BAR; PG8_WAIT_L(0); PG8_MMA(1, 0, At, B0); PG8_BAR; PG8_SCHED;
            PG8_STAGE(PG8_SB(1, 1), b3 + hstep, voffB);
            PG8_WAIT_V(6); PG8_BAR; PG8_MMA(1, 1, At, B1); PG8_BAR;
            }
        }
        if constexpr (ALIGN_EPI) { if (wr == 0) PG8_BAR; }
        if constexpr (!Epi::AFTER_DRAIN) { E(acc, cur, wr, wc, fr, fq); S.done(cur); }
        if (!has_next) break;
#pragma unroll
        for (int a = 0; a < 2; ++a)
#pragma unroll
            for (int b = 0; b < 2; ++b)
#pragma unroll
                for (int m = 0; m < 4; ++m)
#pragma unroll
                    for (int n = 0; n < 2; ++n) acc[a][b][m][n] = (f32x4){0.f, 0.f, 0.f, 0.f};
        cur = nxt; cA = nA; cB = nB; ++ui;
        if constexpr (ALIGN_EPI) { if (wr == 1) PG8_BAR; }
    }
    PG8_WAIT_V(0);
    if constexpr (!ALIGN_EPI) { if (wr == 0) PG8_BAR; }
    PG8_BAR;
    if constexpr (Epi::AFTER_DRAIN) { E.fused(acc, cur, wr, wc, fr, fq, lds, wid, lane); S.done(cur); }
#undef PG8_SA
#undef PG8_SB
#undef PG8_STAGE
#undef PG8_LDA
#undef PG8_LDB
#undef PG8_MMA
#undef PG8_WAIT_V
#undef PG8_WAIT_L
#undef PG8_BAR
#undef PG8_SCHED
}
}

constexpr int BATCH = 8, T = 2048, D = 1024, M = BATCH * T, MEMLEN = 256, MM = BATCH * MEMLEN;
constexpr int INW = 2616, ZW = 2816;
constexpr int DFF = 2816, NEXP = 8, DFE = 3584;
constexpr float EPS = 1e-6f;
constexpr int Z_AQ = 0, Z_AK = 128, Z_AV = 256, Z_AG = 512, Z_ALR = 768, Z_BU = 784, Z_CQ = 1040, Z_CK = 1296, Z_CV = 1552, Z_CQI = 1808, Z_CKI = 2064, Z_CWI = 2096, Z_DUV = 2104;
constexpr int NWAVES = 8, NTHR = 512;
constexpr int MOE_TP = 34, MOE_NPASS = 4, MOE_MAXT = MOE_TP * MOE_NPASS;
constexpr int MAXSLOT = MOE_MAXT * 256;

constexpr size_t MiB = 1u << 20;
constexpr size_t al(size_t x) { return (x + 4095) & ~(size_t)4095; }
constexpr size_t WS_CTL = 0, CTL_ZERO_BYTES = 1 * MiB;
constexpr size_t WS_SS = 1 * MiB;
constexpr size_t WS_SSM = WS_SS + al((size_t)M * 16 * 4);
constexpr size_t WS_TOKE = WS_SSM + al((size_t)MM * 16 * 4);
constexpr size_t WS_TOKG = WS_TOKE + al((size_t)M * 8);
constexpr size_t WS_TOKR = WS_TOKG + al((size_t)M * 8);
constexpr size_t WS_TOKS = WS_TOKR + al((size_t)M * 4);
constexpr size_t WS_CNT = WS_TOKS + al((size_t)M * 8);
constexpr size_t WS_TILEE = WS_CNT + al(256 * 8 * 4);
constexpr size_t WS_SLOTR = WS_TILEE + al(160 * 4);
constexpr size_t WS_SLOTG = WS_SLOTR + al((size_t)MAXSLOT * 4);
constexpr size_t WS_WIN = al(WS_SLOTG + (size_t)MAXSLOT * 4 + MiB);
constexpr size_t SZ_WIN = (size_t)ZW * D * 2, SZ_WOUT = (size_t)D * D * 2, SZ_WQ = (size_t)256 * D * 2, SZ_WKV = (size_t)512 * D * 2, SZ_WO = (size_t)D * 256 * 2;
constexpr size_t WS_WOUT = WS_WIN + 2 * SZ_WIN, WS_WQ = WS_WOUT + 2 * SZ_WOUT, WS_WKV = WS_WQ + 2 * SZ_WQ, WS_WO = WS_WKV + 2 * SZ_WKV;
constexpr size_t WS_W13 = WS_WO + 2 * SZ_WO, WS_W2 = WS_W13 + (size_t)2 * DFF * D * 2, WS_MW13 = WS_W2 + (size_t)D * DFF * 2;
constexpr size_t WS_MW2 = WS_MW13 + (size_t)NEXP * 2 * DFE * D * 2, WS_KVM = WS_MW2 + (size_t)NEXP * D * DFE * 2;
constexpr size_t SZ_KVM = (size_t)MM * 512 * 2;
constexpr size_t WS_MEMB = WS_KVM + 2 * SZ_KVM;
constexpr size_t WS_ACT = al(WS_MEMB + (size_t)MM * D * 2);
constexpr size_t WS_HB = WS_ACT, WS_Z = WS_HB + (size_t)M * D * 2, WS_MIX = WS_Z + (size_t)M * ZW * 2, WS_QX = WS_MIX + (size_t)M * D * 2, WS_OX = WS_QX + (size_t)M * 256 * 2;
constexpr size_t WS_GOI = WS_OX + (size_t)M * 256 * 2, WS_GQT = WS_GOI + (size_t)M * 256 * 4, WS_GKV = WS_GQT + (size_t)M * 128 * 4, WS_GDEC = WS_GKV + (size_t)1024 * 2048 * 4;
constexpr size_t WS_ACT_END = WS_GDEC + (size_t)1024 * 32 * 4;
constexpr size_t WS_FACT = WS_Z;
constexpr size_t WS_MACT = WS_ACT, SZ_MACT = (size_t)MOE_TP * 256 * DFE * 2;
constexpr size_t WS_AG = WS_MACT + SZ_MACT, WS_YS = WS_AG + (size_t)MAXSLOT * D * 2, WS_MOE_END = WS_YS + (size_t)MAXSLOT * D * 2;
static_assert(WS_AG >= WS_HB + (size_t)M * D * 2, "AG must not overlay HB");
static_assert(WS_MOE_END <= WS_ACT_END, "MoE overlays fit");
constexpr size_t WS_END = WS_ACT_END;
constexpr int CW_BAR = 4096;

constexpr int LDS_BYTES = 147456;
constexpr int MISC_OFF = 147456 - 128;
constexpr int SCR_BYTES = MISC_OFF;

#define GAS __attribute__((address_space(1)))
#define LAS __attribute__((address_space(3)))
typedef unsigned short bf16;
typedef unsigned v4u __attribute__((ext_vector_type(4)));
typedef unsigned v2u __attribute__((ext_vector_type(2)));
typedef float f32x4 __attribute__((ext_vector_type(4)));
typedef GAS unsigned gu32;
#define RLX_AGENT __ATOMIC_RELAXED, __HIP_MEMORY_SCOPE_AGENT
#define LDS_WAIT() asm volatile("s_waitcnt lgkmcnt(0)" ::: "memory")
#define LDS_ADD(p, v) (void)__hip_atomic_fetch_add((p), (v), __ATOMIC_RELAXED, __HIP_MEMORY_SCOPE_WORKGROUP)
__device__ __forceinline__ unsigned f2bf(float f) { unsigned u = __builtin_bit_cast(unsigned, f); return (u + 0x7fffu + ((u >> 16) & 1u)) >> 16; }
__device__ __forceinline__ unsigned pk2(float lo, float hi) { return f2bf(lo) | (f2bf(hi) << 16); }
__device__ __forceinline__ float bflo(unsigned w) { return __builtin_bit_cast(float, w << 16); }
__device__ __forceinline__ float bfhi(unsigned w) { return __builtin_bit_cast(float, w & 0xffff0000u); }
__device__ __forceinline__ float bf1(bf16 b) { return __builtin_bit_cast(float, ((unsigned)b) << 16); }
__device__ __forceinline__ float wave_sum(float v) {
#pragma unroll
    for (int o = 1; o < 64; o <<= 1) v += __shfl_xor(v, o);
    return v;
}
__device__ __forceinline__ float wave_max(float v) {
#pragma unroll
    for (int o = 1; o < 64; o <<= 1) v = fmaxf(v, __shfl_xor(v, o));
    return v;
}
#define XB_TMO      128
#define XB_XCNT(j)  (256  + 64 * (j))
#define XB_XSUB(j)  (1280 + 64 * (j))
#define XB_XGEN(j)  (2304 + 64 * (j))
#define XB_TOP      3328
#define XB_TOPGEN   3392
#define XCD_BAR_WORDS 3456
#define XB_SPIN_CAP (1u << 18)

__device__ __forceinline__ unsigned xb_ld(unsigned* p)              { return __hip_atomic_load(p, __ATOMIC_RELAXED, __HIP_MEMORY_SCOPE_AGENT); }
__device__ __forceinline__ unsigned xb_add(unsigned* p, unsigned v) { return __hip_atomic_fetch_add(p, v, __ATOMIC_RELAXED, __HIP_MEMORY_SCOPE_AGENT); }
__device__ __forceinline__ unsigned xb_xcc_id() { return (unsigned)__builtin_amdgcn_s_getreg((3 << 11) | 20) & 0xFu; }
#define XB_SPIN(cond, bar) do { unsigned _sp = 0; while (cond) { __builtin_amdgcn_s_sleep(1); \
    if ((++_sp & 255u) == 0u) { if (xb_ld(&(bar)[XB_TMO])) break; if (_sp > XB_SPIN_CAP) { atomicAdd(&(bar)[XB_TMO], 1u); break; } } } } while (0)

struct XcdBarrier {
    unsigned* bar; unsigned x;
    volatile LAS unsigned* st;
};

__device__ __forceinline__ XcdBarrier xcd_barrier_post(unsigned* bar, volatile LAS unsigned* st) {
    XcdBarrier b; b.bar = bar; b.x = xb_xcc_id(); b.st = st;
    if (threadIdx.x == 0) (void)xb_add(&bar[XB_XCNT(b.x)], 1u);
    return b;
}
__device__ __forceinline__ void xcd_barrier_complete(unsigned* bar, unsigned x, unsigned& nloc, unsigned& nx) {
    const unsigned G = gridDim.x * gridDim.y * gridDim.z;
    unsigned sum, cnt, mine, sp = 0u;
    for (;;) {
        sum = 0u; cnt = 0u; mine = 0u;
#pragma unroll
        for (unsigned j = 0; j < 16; ++j) { const unsigned c = xb_ld(&bar[XB_XCNT(j)]); sum += c; cnt += (c > 0u) ? 1u : 0u; mine = (j == x) ? c : mine; }
        if (sum == G) break;
        __builtin_amdgcn_s_sleep(1);
        if ((++sp & 255u) == 0u) { if (xb_ld(&bar[XB_TMO])) break; if (sp > XB_SPIN_CAP) { atomicAdd(&bar[XB_TMO], 1u); break; } }
    }
    nloc = mine > 0u ? mine : 1u; nx = cnt > 0u ? cnt : 1u;
}

__device__ __forceinline__ void xcd_barrier(const XcdBarrier& b) {
    asm volatile("s_waitcnt vmcnt(0)" ::: "memory");
    __syncthreads();
    if (threadIdx.x == 0) {
        unsigned* bar = b.bar;
        __builtin_amdgcn_s_waitcnt(0);
        unsigned nloc = b.st[0], nx = b.st[1];
        if (nloc == 0u) { xcd_barrier_complete(bar, b.x, nloc, nx); b.st[0] = nloc; b.st[1] = nx; }
        const unsigned old = xb_add(&bar[XB_XSUB(b.x)], 1u);
        const unsigned gen = old / nloc;
        if (old + 1u == (gen + 1u) * nloc) {
            __builtin_amdgcn_fence(__ATOMIC_RELEASE, "agent");
            asm volatile("s_waitcnt vmcnt(0)" ::: "memory");
            const unsigned og = xb_add(&bar[XB_TOP], 1u);
            const unsigned tg = og / nx;
            if (og + 1u == (tg + 1u) * nx) xb_add(&bar[XB_TOPGEN], 1u);
            else XB_SPIN(xb_ld(&bar[XB_TOPGEN]) == tg, bar);
            __builtin_amdgcn_fence(__ATOMIC_ACQUIRE, "agent");
            xb_add(&bar[XB_XGEN(b.x)], 1u);
            asm volatile("s_waitcnt vmcnt(0)" ::: "memory");
        } else {
            XB_SPIN(xb_ld(&bar[XB_XGEN(b.x)]) == gen, bar);
            __builtin_amdgcn_fence(__ATOMIC_ACQUIRE, "agent");
            asm volatile("s_waitcnt vmcnt(0)" ::: "memory");
        }
    }
    __syncthreads();
}

enum { IN_X = 0, IN_MEM, IN_RELB, IN_FNORM, IN_NMIX, IN_WIN, IN_WA2, IN_BA, IN_GNORM, IN_PW, IN_PB, IN_PS, IN_LNG, IN_LNB, IN_SW, IN_SB, IN_WOUT,
       IN_NXA, IN_NMEM, IN_WQ, IN_WKV, IN_WO, IN_NFFN, IN_F1, IN_F3, IN_F2, IN_ROUTER, IN_M1, IN_M3, IN_M2, N_IN };
struct Args { const float* in[N_IN]; float* out; unsigned char* ws; int ph_lo, ph_hi; };

__device__ __forceinline__ float rstd16(const float* ss, int row) {
    const f32x4* p = (const f32x4*)(ss + (size_t)row * 16);
    const f32x4 a = p[0], b = p[1], c = p[2], d = p[3];
    const float s = (((a.x + a.y) + (a.z + a.w)) + ((b.x + b.y) + (b.z + b.w))) + (((c.x + c.y) + (c.z + c.w)) + ((d.x + d.y) + (d.z + d.w)));
    return rsqrtf(s * (1.0f / 1024.0f) + EPS);
}
__device__ __forceinline__ v4u pack8(const f32x4 a, const f32x4 b) { v4u w; w.x = pg8::cvt_pk_bf16(a.x, a.y); w.y = pg8::cvt_pk_bf16(a.z, a.w); w.z = pg8::cvt_pk_bf16(b.x, b.y); w.w = pg8::cvt_pk_bf16(b.z, b.w); return w; }

struct EpiScale {
    static constexpr bool PERM = true, AFTER_DRAIN = false;
    bf16* O; int ldc; const float* ss; float scale;
    __device__ __forceinline__ void operator()(const pg8::f32x4 (&acc)[2][2][4][2], const pg8::Unit& u, int wr, int wc, int fr, int fq) const {
        const int row0 = u.po * 256 + wr * 64 + fr, col0 = u.e * 256 + wc * 32 + 8 * fq;
#pragma unroll
        for (int ai = 0; ai < 2; ++ai)
#pragma unroll
            for (int m = 0; m < 4; ++m) { const int row = row0 + ai * 128 + m * 16; const float r = rstd16(ss, row) * scale; bf16* rowp = O + (size_t)row * ldc + col0;
#pragma unroll
                for (int bj = 0; bj < 2; ++bj) *(v4u*)(rowp + bj * 128) = pack8(acc[ai][bj][m][0] * r, acc[ai][bj][m][1] * r); }
    }
};
struct EpiResid {
    static constexpr bool PERM = true, AFTER_DRAIN = false;
    const float* res; float* H; bf16* HB; float* SS;
    __device__ __forceinline__ void operator()(const pg8::f32x4 (&acc)[2][2][4][2], const pg8::Unit& u, int wr, int wc, int fr, int fq) const {
        const int row0 = u.po * 256 + wr * 64 + fr, col0 = u.e * 256 + wc * 32 + 8 * fq;
#pragma unroll
        for (int ai = 0; ai < 2; ++ai)
#pragma unroll
            for (int m = 0; m < 4; ++m) { const int row = row0 + ai * 128 + m * 16; const size_t off = (size_t)row * D + col0; float q = 0.f;
#pragma unroll
                for (int bj = 0; bj < 2; ++bj) {
                    const f32x4 r0 = *(const f32x4*)(res + off + bj * 128), r1 = *(const f32x4*)(res + off + bj * 128 + 4);
                    const f32x4 v0 = acc[ai][bj][m][0] + r0, v1 = acc[ai][bj][m][1] + r1;
                    *(f32x4*)(H + off + bj * 128) = v0; *(f32x4*)(H + off + bj * 128 + 4) = v1;
                    *(v4u*)(HB + off + bj * 128) = pack8(v0, v1);
                    q += ((v0.x * v0.x + v0.y * v0.y) + (v0.z * v0.z + v0.w * v0.w)) + ((v1.x * v1.x + v1.y * v1.y) + (v1.z * v1.z + v1.w * v1.w)); }
                q += __shfl_xor(q, 16); q += __shfl_xor(q, 32);
                if (fq == 0) SS[(size_t)row * 16 + u.e * 4 + wc] = q; }
    }
};
__device__ __forceinline__ float silu_f(float x) { return x * __builtin_amdgcn_rcpf(1.0f + __expf(-x)); }
template <bool MOE> struct EpiSwiglu {
    static constexpr bool PERM = true, AFTER_DRAIN = false;
    bf16* O; int ldc; const float* ss; const float* slot_r; const float* slot_g;
    __device__ __forceinline__ void operator()(const pg8::f32x4 (&acc)[2][2][4][2], const pg8::Unit& u, int wr, int wc, int fr, int fq) const {
        const int rin0 = u.pm * 256 + wr * 64 + fr, rout0 = u.po * 256 + wr * 64 + fr, col0 = u.e * 128 + wc * 32 + 8 * fq;
#pragma unroll
        for (int ai = 0; ai < 2; ++ai)
#pragma unroll
            for (int m = 0; m < 4; ++m) { const int rin = rin0 + ai * 128 + m * 16, rout = rout0 + ai * 128 + m * 16;
                float r, gt; if (MOE) { r = slot_r[rin]; gt = slot_g[rin]; } else { r = rstd16(ss, rin); gt = 1.0f; }
                f32x4 o0, o1;
#pragma unroll
                for (int j = 0; j < 4; ++j) { o0[j] = silu_f(acc[ai][0][m][0][j] * r) * (acc[ai][1][m][0][j] * r) * gt; o1[j] = silu_f(acc[ai][0][m][1][j] * r) * (acc[ai][1][m][1][j] * r) * gt; }
                *(v4u*)(O + (size_t)rout * ldc + col0) = pack8(o0, o1); }
    }
};
struct EpiPlain {
    static constexpr bool PERM = true, AFTER_DRAIN = false;
    bf16* O; int ldc;
    __device__ __forceinline__ void operator()(const pg8::f32x4 (&acc)[2][2][4][2], const pg8::Unit& u, int wr, int wc, int fr, int fq) const {
        const int row0 = u.po * 256 + wr * 64 + fr, col0 = u.e * 256 + wc * 32 + 8 * fq;
#pragma unroll
        for (int ai = 0; ai < 2; ++ai)
#pragma unroll
            for (int m = 0; m < 4; ++m) { bf16* rowp = O + (size_t)(row0 + ai * 128 + m * 16) * ldc + col0;
#pragma unroll
                for (int bj = 0; bj < 2; ++bj) *(v4u*)(rowp + bj * 128) = pack8(acc[ai][bj][m][0], acc[ai][bj][m][1]); }
    }
};

__device__ __forceinline__ void tr_item(const float* W, int N, int K, int k0, int n0, const float* gain, bf16* WT, long dst_row0, LAS float* scr, int lane) {
    const int nn = n0 + lane; const bool ok = nn < N; const float* wp = W + (size_t)k0 * N + (ok ? nn : 0);
    float v[64];
#pragma unroll
    for (int i = 0; i < 64; ++i) v[i] = wp[(size_t)i * N];
#pragma unroll
    for (int i = 0; i < 64; ++i) { float x = ok ? v[i] : 0.f; if (gain) x *= gain[k0 + i]; scr[i * 65 + lane] = x; }
    LDS_WAIT(); asm volatile("" ::: "memory");
    const int c = lane & 7;
#pragma unroll
    for (int j = 0; j < 8; ++j) { const int n = (lane >> 3) + 8 * j; const LAS float* s = scr + (8 * c) * 65 + n;
        v4u o; o.x = pk2(s[0 * 65], s[1 * 65]); o.y = pk2(s[2 * 65], s[3 * 65]); o.z = pk2(s[4 * 65], s[5 * 65]); o.w = pk2(s[6 * 65], s[7 * 65]);
        if (n0 + n < N) *(v4u*)(WT + (size_t)(dst_row0 + n) * K + k0 + 8 * c) = o; }
    LDS_WAIT(); asm volatile("" ::: "memory");
}
__device__ __forceinline__ void conv_job(const float* W, int K, int N, const float* gain, bf16* WT, int mode, LAS float* scr, int gw, int NGW, int lane, long& base) {
    const int nblk = (N + 63) / 64, nitems = (K / 64) * nblk;
    const int first = (int)(((long)gw - (base % NGW) + NGW) % NGW);
    for (int it = first; it < nitems; it += NGW) {
        const int kb = it / nblk, nb = it % nblk, k0 = 64 * kb, n0 = 64 * nb;
        const long dr = (mode == 0) ? (long)n0 : (long)(n0 >> 7) * 256 + (n0 & 127) + (mode == 2 ? 128 : 0);
        tr_item(W, N, K, k0, n0, gain, WT, dr, scr, lane);
    }
    base += nitems;
}
__device__ __forceinline__ void row_cvt(const float* xrow, bf16* orow, float* ssrow, int lane) {
    const f32x4* xr = (const f32x4*)xrow + lane; f32x4 v[4]; float s = 0.f;
#pragma unroll
    for (int j = 0; j < 4; ++j) { v[j] = xr[64 * j]; s += (v[j].x * v[j].x + v[j].y * v[j].y) + (v[j].z * v[j].z + v[j].w * v[j].w); }
    s = wave_sum(s);
    v2u* o8 = (v2u*)orow + lane;
#pragma unroll
    for (int j = 0; j < 4; ++j) { v2u w; w.x = pk2(v[j].x, v[j].y); w.y = pk2(v[j].z, v[j].w); o8[64 * j] = w; }
    if (lane < 16) ssrow[lane] = lane == 0 ? s : 0.f;
}
__device__ __forceinline__ void p0_prologue(const Args& a, LAS unsigned char* lds, int tid, int G) {
    const int lane = tid & 63, wave = tid >> 6, gw = blockIdx.x * NWAVES + wave, NGW = G * NWAVES;
    LAS float* scr = (LAS float*)(lds + wave * 16640);
    unsigned char* ws = a.ws; long base = 0;
    for (int l = 0; l < 2; ++l) {
        conv_job(a.in[IN_WIN] + (size_t)l * D * INW, D, INW, a.in[IN_NMIX] + l * D, (bf16*)(ws + WS_WIN + l * SZ_WIN), 0, scr, gw, NGW, lane, base);
        conv_job(a.in[IN_WOUT] + (size_t)l * D * D, D, D, nullptr, (bf16*)(ws + WS_WOUT + l * SZ_WOUT), 0, scr, gw, NGW, lane, base);
        conv_job(a.in[IN_WQ] + (size_t)l * D * 256, D, 256, a.in[IN_NXA] + l * D, (bf16*)(ws + WS_WQ + l * SZ_WQ), 0, scr, gw, NGW, lane, base);
        conv_job(a.in[IN_WKV] + (size_t)l * D * 512, D, 512, a.in[IN_NMEM] + l * D, (bf16*)(ws + WS_WKV + l * SZ_WKV), 0, scr, gw, NGW, lane, base);
        conv_job(a.in[IN_WO] + (size_t)l * 256 * D, 256, D, nullptr, (bf16*)(ws + WS_WO + l * SZ_WO), 0, scr, gw, NGW, lane, base);
        { v4u* zp = (v4u*)(ws + WS_WIN + l * SZ_WIN + (size_t)INW * D * 2); const int n16 = (ZW - INW) * D * 2 / 16;
          for (int i = blockIdx.x * NTHR + tid; i < n16; i += G * NTHR) zp[i] = (v4u){0u, 0u, 0u, 0u}; }
    }
    conv_job(a.in[IN_F1], D, DFF, a.in[IN_NFFN], (bf16*)(ws + WS_W13), 1, scr, gw, NGW, lane, base);
    conv_job(a.in[IN_F3], D, DFF, a.in[IN_NFFN], (bf16*)(ws + WS_W13), 2, scr, gw, NGW, lane, base);
    conv_job(a.in[IN_F2], DFF, D, nullptr, (bf16*)(ws + WS_W2), 0, scr, gw, NGW, lane, base);
    for (int e = 0; e < NEXP; ++e) {
        conv_job(a.in[IN_M1] + (size_t)e * D * DFE, D, DFE, a.in[IN_NFFN] + D, (bf16*)(ws + WS_MW13) + (size_t)e * 2 * DFE * D, 1, scr, gw, NGW, lane, base);
        conv_job(a.in[IN_M3] + (size_t)e * D * DFE, D, DFE, a.in[IN_NFFN] + D, (bf16*)(ws + WS_MW13) + (size_t)e * 2 * DFE * D, 2, scr, gw, NGW, lane, base);
        conv_job(a.in[IN_M2] + (size_t)e * DFE * D, DFE, D, nullptr, (bf16*)(ws + WS_MW2) + (size_t)e * D * DFE, 0, scr, gw, NGW, lane, base);
    }
    for (int m = gw; m < M; m += NGW) row_cvt(a.in[IN_X] + (size_t)m * D, (bf16*)(ws + WS_HB) + (size_t)m * D, (float*)(ws + WS_SS) + (size_t)m * 16, lane);
    for (int m = gw; m < MM; m += NGW) row_cvt(a.in[IN_MEM] + (size_t)m * D, (bf16*)(ws + WS_MEMB) + (size_t)m * D, (float*)(ws + WS_SSM) + (size_t)m * 16, lane);
}

__device__ __forceinline__ float gelu_tanh(float x) { return 0.5f * x * (1.0f + tanhf(0.7978845608028654f * (x + 0.044715f * x * x * x))); }

__device__ __forceinline__ void gla_a_item(const Args& a, int l, int item, LAS unsigned char* lds, int tid) {
    const int n = item & 31, h = (item >> 5) & 3, b = item >> 7, tok0 = b * T + n * 64;
    LAS float* alr = (LAS float*)lds;
    LAS float* wa = alr + 64 * 16;
    LAS float* bb = wa + 16 * 32;
    LAS float* qt = bb + 64 * 33;
    LAS float* kt = qt + 64 * 33;
    LAS float* kd = kt + 64 * 33;
    LAS float* vv = kd + 64 * 33;
    LAS float* att = vv + 64 * 64;
    LAS float* bav = att + 64 * 65;
    const bf16* z = (const bf16*)(a.ws + WS_Z);
    float* OI = (float*)(a.ws + WS_GOI); float* QT = (float*)(a.ws + WS_GQT); float* KV = (float*)(a.ws + WS_GKV); float* DEC = (float*)(a.ws + WS_GDEC);
    for (int i = tid; i < 1024; i += NTHR) alr[i] = bf1(z[(size_t)(tok0 + (i >> 4)) * ZW + Z_ALR + (i & 15)]);
    { const int r = tid >> 5, k = tid & 31; wa[tid] = a.in[IN_WA2][(size_t)l * 16 * 128 + r * 128 + h * 32 + k]; }
    if (tid < 32) bav[tid] = a.in[IN_BA][l * 128 + h * 32 + tid];
    for (int i = tid; i < 4096; i += NTHR) vv[i] = bf1(z[(size_t)(tok0 + (i >> 6)) * ZW + Z_AV + h * 64 + (i & 63)]);
    __syncthreads();
    for (int i = tid; i < 2048; i += NTHR) { const int c = i >> 5, k = i & 31; float x = bav[k];
#pragma unroll
        for (int r = 0; r < 16; ++r) x += alr[c * 16 + r] * wa[r * 32 + k];
        const float ls = fminf(x, 0.f) - log1pf(expf(-fabsf(x)));
        bb[c * 33 + k] = ls * (1.0f / 16.0f); }
    __syncthreads();
    if (tid < 32) { float run = 0.f; for (int c = 0; c < 64; ++c) { run += bb[c * 33 + tid]; bb[c * 33 + tid] = run; } }
    __syncthreads();
    for (int i = tid; i < 2048; i += NTHR) { const int c = i >> 5, k = i & 31; const float bv = bb[c * 33 + k], bl = bb[63 * 33 + k];
        const float q = bf1(z[(size_t)(tok0 + c) * ZW + Z_AQ + h * 32 + k]), kk = bf1(z[(size_t)(tok0 + c) * ZW + Z_AK + h * 32 + k]);
        const float qv = q * 0.17677669529663687f * expf(bv);
        qt[c * 33 + k] = qv; kt[c * 33 + k] = kk * expf(-bv); kd[c * 33 + k] = kk * expf(bl - bv);
        QT[(size_t)(tok0 + c) * 128 + h * 32 + k] = qv; }
    if (tid < 32) DEC[(size_t)item * 32 + tid] = expf(bb[63 * 33 + tid]);
    __syncthreads();
    for (int idx = tid; idx < 4096; idx += NTHR) { const int i = idx >> 6, j = idx & 63; float s = 0.f;
        if (j <= i) {
#pragma unroll 8
            for (int k = 0; k < 32; ++k) s += qt[i * 33 + k] * kt[j * 33 + k]; }
        att[i * 65 + j] = s; }
    __syncthreads();
    for (int idx = tid; idx < 4096; idx += NTHR) { const int i = idx >> 6, v = idx & 63; float s = 0.f;
#pragma unroll 8
        for (int j = 0; j < 64; ++j) s += att[i * 65 + j] * vv[j * 64 + v];
        OI[(size_t)(tok0 + i) * 256 + h * 64 + v] = s; }
    for (int idx = tid; idx < 2048; idx += NTHR) { const int k = idx >> 6, v = idx & 63; float s = 0.f;
#pragma unroll 8
        for (int c = 0; c < 64; ++c) s += kd[c * 33 + k] * vv[c * 64 + v];
        KV[(size_t)item * 2048 + idx] = s; }
    __syncthreads();
}
__device__ __forceinline__ void gla_c_item(const Args& a, int l, int item, LAS unsigned char* lds, int tid) {
    const int n = item & 31, h = (item >> 5) & 3, b = item >> 7, tok0 = b * T + n * 64, lane = tid & 63, w = tid >> 6;
    LAS float* S = (LAS float*)lds;
    LAS float* ql = S + 2048;
    const bf16* z = (const bf16*)(a.ws + WS_Z); bf16* mix = (bf16*)(a.ws + WS_MIX);
    const float* OI = (const float*)(a.ws + WS_GOI); const float* QT = (const float*)(a.ws + WS_GQT); const float* KV = (const float*)(a.ws + WS_GKV); const float* DEC = (const float*)(a.ws + WS_GDEC);
    for (int e = tid; e < 2048; e += NTHR) { const int k = e >> 6; float s = 0.f;
        for (int m = 0; m < n; ++m) { const size_t it = (size_t)(item - n + m); s = s * DEC[it * 32 + k] + KV[it * 2048 + e]; }
        S[e] = s; }
    for (int i = tid; i < 2048; i += NTHR) ql[(i >> 5) * 33 + (i & 31)] = QT[(size_t)(tok0 + (i >> 5)) * 128 + h * 32 + (i & 31)];
    __syncthreads();
    for (int j = 0; j < 8; ++j) { const int i = w + 8 * j; float o = OI[(size_t)(tok0 + i) * 256 + h * 64 + lane];
#pragma unroll 8
        for (int k = 0; k < 32; ++k) o += ql[i * 33 + k] * S[k * 64 + lane];
        const float ms = wave_sum(o * o) * (1.0f / 64.0f);
        float y = o * rsqrtf(ms + EPS) * a.in[IN_GNORM][l * 256 + h * 64 + lane];
        const float g = bf1(z[(size_t)(tok0 + i) * ZW + Z_AG + h * 64 + lane]);
        y *= g / (1.0f + expf(-g));
        mix[(size_t)(tok0 + i) * D + h * 64 + lane] = (bf16)f2bf(y); }
    __syncthreads();
}
__device__ __forceinline__ void pool_item(const Args& a, int l, int item, LAS unsigned char* lds, int tid) {
    const int g = item & 3, tt = (item >> 2) & 31, b = item >> 7, t0 = tt * 64;
    LAS float* u = (LAS float*)lds;
    LAS float* w = u + 79 * 64;
    LAS float* p = w + 4096;
    const bf16* z = (const bf16*)(a.ws + WS_Z); bf16* mix = (bf16*)(a.ws + WS_MIX);
    for (int i = tid; i < 79 * 64; i += NTHR) { const int t = t0 - 15 + (i >> 6); u[i] = t >= 0 ? bf1(z[(size_t)(b * T + t) * ZW + Z_BU + g * 64 + (i & 63)]) : 0.f; }
    for (int i = tid; i < 4096; i += NTHR) w[i] = a.in[IN_PW][(size_t)(l * 4 + g) * 4096 + i];
    __syncthreads();
    const int win = 2 << g;
    for (int i = tid; i < 4096; i += NTHR) { const int tl = i >> 6, c = i & 63, t = t0 + tl, cnt = (t + 1 < win) ? t + 1 : win; float s = 0.f;
        for (int j = 0; j < cnt; ++j) s += u[(tl + 15 - j) * 64 + c];
        p[tl * 65 + c] = s / (float)cnt - u[(tl + 15) * 64 + c]; }
    __syncthreads();
    for (int i = tid; i < 4096; i += NTHR) { const int tl = i >> 6, d = i & 63; float s = a.in[IN_PB][(l * 4 + g) * 64 + d];
#pragma unroll 8
        for (int c = 0; c < 64; ++c) s += p[tl * 65 + c] * w[c * 64 + d];
        s *= a.in[IN_PS][l * 256 + g * 64 + d];
        mix[(size_t)(b * T + t0 + tl) * D + 256 + g * 64 + d] = (bf16)f2bf(s); }
    __syncthreads();
}
__device__ __forceinline__ void sgu_item(const Args& a, int l, int item, LAS unsigned char* lds, int tid) {
    const int g = item & 3, nc = (item >> 2) & 15, b = item >> 6, tok0 = b * T + nc * 128, lane = tid & 63, w = tid >> 6;
    LAS float* vn = (LAS float*)lds;
    const bf16* z = (const bf16*)(a.ws + WS_Z); bf16* mix = (bf16*)(a.ws + WS_MIX);
    for (int j = 0; j < 16; ++j) { const int s = w + 8 * j;
        const v2u raw = *(const v2u*)(z + (size_t)(tok0 + s) * ZW + Z_DUV + 256 + 4 * lane);
        float x[4] = {gelu_tanh(bflo(raw.x)), gelu_tanh(bfhi(raw.x)), gelu_tanh(bflo(raw.y)), gelu_tanh(bfhi(raw.y))};
        const float mu = wave_sum((x[0] + x[1]) + (x[2] + x[3])) * (1.0f / 256.0f);
        float q = 0.f;
#pragma unroll
        for (int i = 0; i < 4; ++i) { x[i] -= mu; q += x[i] * x[i]; }
        const float rstd = rsqrtf(wave_sum(q) * (1.0f / 256.0f) + EPS);
        if ((lane >> 4) == g) {
#pragma unroll
            for (int i = 0; i < 4; ++i) { const int cl = 4 * (lane & 15) + i; vn[s * 64 + cl] = x[i] * rstd * a.in[IN_LNG][l * 256 + g * 64 + cl] + a.in[IN_LNB][l * 256 + g * 64 + cl]; } } }
    __syncthreads();
    const float* sw = a.in[IN_SW] + (size_t)(l * 4 + g) * 128 * 128;
    for (int j = 0; j < 16; ++j) { const int t = w + 8 * j; float acc = a.in[IN_SB][(l * 4 + g) * 128 + t];
        const float* swr = sw + t * 128;
        for (int s = 0; s <= t; ++s) acc += swr[s] * vn[s * 64 + lane];
        const float uu = gelu_tanh(bf1(z[(size_t)(tok0 + t) * ZW + Z_DUV + g * 64 + lane]));
        mix[(size_t)(tok0 + t) * D + 768 + g * 64 + lane] = (bf16)f2bf(uu * acc); }
    __syncthreads();
}
__device__ __forceinline__ void xattn_item(const Args& a, int l, int item, LAS unsigned char* lds, int tid) {
    const int qtile = item & 31, h = (item >> 5) & 3, b = item >> 7, lane = tid & 63, w = tid >> 6;
    LAS float* Ks = (LAS float*)lds;
    LAS float* Vs = Ks + 256 * 65;
    LAS float* qs = Vs + 256 * 64;
    LAS float* pw = qs + 512;
    const bf16* kvm = (const bf16*)(a.ws + WS_KVM + (size_t)l * SZ_KVM); const bf16* qx = (const bf16*)(a.ws + WS_QX); bf16* ox = (bf16*)(a.ws + WS_OX);
    for (int i = tid; i < 16384; i += NTHR) { const int key = i >> 6, d = i & 63; const size_t o = (size_t)(b * MEMLEN + key) * 512 + h * 64 + d;
        Ks[key * 65 + d] = bf1(kvm[o]); Vs[key * 64 + d] = bf1(kvm[o + 256]); }
    __syncthreads();
    for (int qq = 0; qq < 8; ++qq) { const int row = b * T + qtile * 64 + w * 8 + qq;
        qs[w * 64 + lane] = bf1(qx[(size_t)row * 256 + h * 64 + lane]);
        LDS_WAIT(); asm volatile("" ::: "memory");
        float s[4] = {0.f, 0.f, 0.f, 0.f};
        for (int d = 0; d < 64; ++d) { const float qd = qs[w * 64 + d];
#pragma unroll
            for (int j = 0; j < 4; ++j) s[j] += qd * Ks[(lane + 64 * j) * 65 + d]; }
        const float mx = wave_max(fmaxf(fmaxf(s[0], s[1]), fmaxf(s[2], s[3])));
        float e[4], sum = 0.f;
#pragma unroll
        for (int j = 0; j < 4; ++j) { e[j] = expf(s[j] - mx); sum += e[j]; }
        const float inv = 1.0f / wave_sum(sum);
#pragma unroll
        for (int j = 0; j < 4; ++j) pw[w * 256 + lane + 64 * j] = e[j] * inv;
        LDS_WAIT(); asm volatile("" ::: "memory");
        float o = 0.f;
        for (int key = 0; key < 256; ++key) o += pw[w * 256 + key] * Vs[key * 64 + lane];
        ox[(size_t)row * 256 + h * 64 + lane] = (bf16)f2bf(o);
        LDS_WAIT(); asm volatile("" ::: "memory"); }
    __syncthreads();
}

__device__ __forceinline__ unsigned ord_u(float f) { const unsigned u = __builtin_bit_cast(unsigned, f); return (u & 0x80000000u) ? ~u : (u | 0x80000000u); }
__device__ __forceinline__ int rel_bucket(int n) {
    if (n < 16) return n;
    int large = 16 + (int)(logf((float)n / 16.0f) / logf(8.0f) * 16.0f);
    return large < 31 ? large : 31;
}
__device__ __forceinline__ void dsa_setup(const Args& a, LAS unsigned char* lds, int tid) {
    LAS float* biasd = (LAS float*)(lds + 48 * 1024);
    for (int i = tid; i < 129 * 4; i += NTHR) { const int d = i >> 2, h = i & 3; biasd[i] = a.in[IN_RELB][rel_bucket(d) * 4 + h]; }
    __syncthreads();
}
__device__ __forceinline__ void dsa_item(const Args& a, int item, LAS unsigned char* lds, int tid, bf16* outp, int ostride) {
    const int b = item / T, t = item % T, nk = t + 1, lane = tid & 63, w = tid >> 6;
    LAS unsigned* su = (LAS unsigned*)lds;
    LAS float* lg = (LAS float*)(lds + 8192);
    LAS float* qi = (LAS float*)(lds + 8192 + 32768);
    LAS float* qv = qi + 256;
    LAS float* wi = qv + 256;
    LAS unsigned* cnt = (LAS unsigned*)(wi + 8);
    LAS float* red = (LAS float*)(cnt + 40);
    LAS float* red2 = red + 64;
    LAS float* biasd = (LAS float*)(lds + 48 * 1024);
    const bf16* z = (const bf16*)(a.ws + WS_Z);
    const size_t row = (size_t)b * T + t;
    if (tid < 256) { qi[tid] = bf1(z[row * ZW + Z_CQI + tid]) * 0.17677669529663687f; qv[tid] = bf1(z[row * ZW + Z_CQ + tid]) * 0.125f; }
    if (tid < 8) wi[tid] = bf1(z[row * ZW + Z_CWI + tid]) * 0.35355339059327373f;
    if (tid < 40) cnt[tid] = 0u;
    __syncthreads();
    unsigned myu[4];
#pragma unroll
    for (int j = 0; j < 4; ++j) { const int key = tid + NTHR * j; myu[j] = 0u;
        if (key < nk) { const v4u* kp = (const v4u*)(z + ((size_t)b * T + key) * ZW + Z_CKI); float kf[32];
#pragma unroll
            for (int i = 0; i < 4; ++i) { const v4u r = kp[i]; kf[8 * i + 0] = bflo(r.x); kf[8 * i + 1] = bfhi(r.x); kf[8 * i + 2] = bflo(r.y); kf[8 * i + 3] = bfhi(r.y); kf[8 * i + 4] = bflo(r.z); kf[8 * i + 5] = bfhi(r.z); kf[8 * i + 6] = bflo(r.w); kf[8 * i + 7] = bfhi(r.w); }
            float sc = 0.f;
            for (int hh = 0; hh < 8; ++hh) { float dot = 0.f;
#pragma unroll
                for (int d = 0; d < 32; ++d) dot += qi[hh * 32 + d] * kf[d];
                sc += fmaxf(dot, 0.f) * wi[hh]; }
            sc += 0.0f;
            myu[j] = ord_u(sc); su[key] = myu[j]; } }
    __syncthreads();
    bool sel[4];
#pragma unroll
    for (int j = 0; j < 4; ++j) sel[j] = (tid + NTHR * j) < nk;
    if (nk > 256) {
        unsigned Tt = 0u;
        for (int bit = 31; bit >= 0; --bit) { const unsigned cand = Tt | (1u << bit); int c = 0;
#pragma unroll
            for (int j = 0; j < 4; ++j) c += (myu[j] >= cand) ? 1 : 0;
            c = (int)wave_sum((float)c);
            if (lane == 0 && c) LDS_ADD(&cnt[bit], (unsigned)c);
            __syncthreads();
            if (cnt[bit] >= 256u) Tt = cand; }
        { int c = 0;
#pragma unroll
            for (int j = 0; j < 4; ++j) c += (myu[j] > Tt) ? 1 : 0;
            c = (int)wave_sum((float)c);
            if (lane == 0 && c) LDS_ADD(&cnt[32], (unsigned)c);
            __syncthreads(); }
        const int r = 256 - (int)cnt[32];
#pragma unroll
        for (int j = 0; j < 4; ++j) { const int key = tid + NTHR * j;
            if (myu[j] > Tt) sel[j] = true;
            else if (myu[j] == Tt && key < nk) { int rank = 0; for (int s = 0; s < key; ++s) rank += (su[s] == Tt) ? 1 : 0; sel[j] = rank < r; }
            else sel[j] = false; }
    }
    float lmax[4] = {-INFINITY, -INFINITY, -INFINITY, -INFINITY};
#pragma unroll
    for (int j = 0; j < 4; ++j) { const int key = tid + NTHR * j;
        if (key < nk) {
            float lv[4] = {-INFINITY, -INFINITY, -INFINITY, -INFINITY};
            if (sel[j]) { const v4u* kp = (const v4u*)(z + ((size_t)b * T + key) * ZW + Z_CK); const int dd = (t - key) < 128 ? (t - key) : 128;
#pragma unroll
                for (int hh = 0; hh < 4; ++hh) { float dot = 0.f;
#pragma unroll
                    for (int i = 0; i < 8; ++i) { const v4u r = kp[hh * 8 + i]; const LAS float* qq = qv + hh * 64 + 8 * i;
                        dot += qq[0] * bflo(r.x) + qq[1] * bfhi(r.x) + qq[2] * bflo(r.y) + qq[3] * bfhi(r.y) + qq[4] * bflo(r.z) + qq[5] * bfhi(r.z) + qq[6] * bflo(r.w) + qq[7] * bfhi(r.w); }
                    lv[hh] = dot + biasd[dd * 4 + hh]; lmax[hh] = fmaxf(lmax[hh], lv[hh]); } }
#pragma unroll
            for (int hh = 0; hh < 4; ++hh) lg[hh * 2048 + key] = lv[hh]; } }
#pragma unroll
    for (int hh = 0; hh < 4; ++hh) { const float m = wave_max(lmax[hh]); if (lane == 0) red[w * 4 + hh] = m; }
    __syncthreads();
    float mx[4], lsum[4] = {0.f, 0.f, 0.f, 0.f};
#pragma unroll
    for (int hh = 0; hh < 4; ++hh) { float m = red[hh]; for (int ww = 1; ww < 8; ++ww) m = fmaxf(m, red[ww * 4 + hh]); mx[hh] = m; }
#pragma unroll
    for (int j = 0; j < 4; ++j) { const int key = tid + NTHR * j;
        if (key < nk) {
#pragma unroll
            for (int hh = 0; hh < 4; ++hh) { const float lv = lg[hh * 2048 + key]; const float p = (lv == -INFINITY) ? 0.f : expf(lv - mx[hh]); lg[hh * 2048 + key] = p; lsum[hh] += p; } } }
#pragma unroll
    for (int hh = 0; hh < 4; ++hh) { const float s = wave_sum(lsum[hh]); if (lane == 0) red[32 + w * 4 + hh] = s; }
    __syncthreads();
    { const int half = tid >> 8, hd = tid & 255, hh = hd >> 6; float acc = 0.f;
      const bf16* vp = z + (size_t)b * T * ZW + Z_CV + hd;
      for (int key = half; key < nk; key += 2) { const float p = lg[hh * 2048 + key]; if (p != 0.f) acc += p * bf1(vp[(size_t)key * ZW]); }
      red2[tid] = acc; }
    __syncthreads();
    if (tid < 256) { const int hh = tid >> 6; float s = 0.f; for (int ww = 0; ww < 8; ++ww) s += red[32 + ww * 4 + hh];
        outp[row * ostride + tid] = (bf16)f2bf((red2[tid] + red2[tid + 256]) / s); }
    __syncthreads();
}

__device__ __forceinline__ void moe_route(const Args& a, LAS unsigned char* lds, int tid, int G) {
    const int lane = tid & 63, w = tid >> 6;
    LAS float* rt = (LAS float*)lds;
    LAS unsigned* cnt = (LAS unsigned*)(lds + 32768);
    const float* h = a.out; unsigned char* ws = a.ws;
    for (int i = tid; i < 8192; i += NTHR) rt[(i & 7) * 1024 + (i >> 3)] = a.in[IN_ROUTER][i] * a.in[IN_NFFN][D + (i >> 3)];
    __syncthreads();
    for (int chunk = blockIdx.x; chunk < 256; chunk += G) {
        if (tid < 8) cnt[tid] = 0u;
        __syncthreads();
        for (int q = 0; q < 8; ++q) { const int tk = chunk * 64 + w * 8 + q;
            const f32x4* hr = (const f32x4*)(h + (size_t)tk * D) + lane; float lg[8] = {0.f, 0.f, 0.f, 0.f, 0.f, 0.f, 0.f, 0.f}; float ss = 0.f;
#pragma unroll
            for (int j = 0; j < 4; ++j) { const f32x4 v = hr[64 * j]; const int c0 = 4 * (lane + 64 * j);
                ss += (v.x * v.x + v.y * v.y) + (v.z * v.z + v.w * v.w);
#pragma unroll
                for (int e = 0; e < 8; ++e) { const f32x4 r = *(const LAS f32x4*)(rt + e * 1024 + c0); lg[e] += (v.x * r.x + v.y * r.y) + (v.z * r.z + v.w * r.w); } }
            ss = wave_sum(ss); const float rstd = rsqrtf(ss * (1.0f / 1024.0f) + EPS);
#pragma unroll
            for (int e = 0; e < 8; ++e) lg[e] = wave_sum(lg[e]) * rstd;
            int e0 = 0; float v0 = lg[0];
#pragma unroll
            for (int e = 1; e < 8; ++e) if (lg[e] > v0) { v0 = lg[e]; e0 = e; }
            int e1 = -1; float v1 = -INFINITY;
#pragma unroll
            for (int e = 0; e < 8; ++e) if (e != e0 && lg[e] > v1) { v1 = lg[e]; e1 = e; }
            const float g0 = 1.0f / (1.0f + expf(v1 - v0)), g1 = 1.0f - g0;
            if (lane == 0) { ((int*)(ws + WS_TOKE))[2 * tk] = e0; ((int*)(ws + WS_TOKE))[2 * tk + 1] = e1; ((float*)(ws + WS_TOKG))[2 * tk] = g0; ((float*)(ws + WS_TOKG))[2 * tk + 1] = g1;
                ((float*)(ws + WS_TOKR))[tk] = rstd; LDS_ADD(&cnt[e0], 1u); LDS_ADD(&cnt[e1], 1u); } }
        __syncthreads();
        if (tid < 8) ((int*)(ws + WS_CNT))[chunk * 8 + tid] = (int)cnt[tid];
        __syncthreads();
    }
}
__device__ __forceinline__ void moe_assign(const Args& a, LAS unsigned char* lds, int tid, int G) {
    const int lane = tid & 63, w = tid >> 6;
    LAS int* cn = (LAS int*)lds;
    LAS int* tot = cn + 2048;
    LAS int* basee = tot + 8;
    LAS int* sl = basee + 8;
    LAS int* pref = sl + 128;
    unsigned char* ws = a.ws;
    const int* CNT = (const int*)(ws + WS_CNT); int* TILEE = (int*)(ws + WS_TILEE);
    const int* TOKE = (const int*)(ws + WS_TOKE); const float* TOKG = (const float*)(ws + WS_TOKG); const float* TOKR = (const float*)(ws + WS_TOKR); int* TOKS = (int*)(ws + WS_TOKS);
    float* SLOTR = (float*)(ws + WS_SLOTR); float* SLOTG = (float*)(ws + WS_SLOTG);
    const bf16* HB = (const bf16*)(ws + WS_HB); bf16* AG = (bf16*)(ws + WS_AG);
    for (int i = tid; i < 2048; i += NTHR) cn[i] = CNT[i];
    __syncthreads();
    if (tid < 8) { int s = 0; for (int c = 0; c < 256; ++c) s += cn[c * 8 + tid]; tot[tid] = s; }
    __syncthreads();
    if (tid == 0) { int tile = 0; for (int e = 0; e < 8; ++e) { basee[e] = tile * 256; const int nt = (tot[e] + 255) >> 8;
            if (blockIdx.x == 0) for (int q = 0; q < nt; ++q) TILEE[tile + q] = e;
            tile += nt; }
        if (blockIdx.x == 0) { for (int q = tile; q < 159; ++q) TILEE[q] = 0; TILEE[159] = tile; } }
    __syncthreads();
    for (int e = blockIdx.x; e < 8; e += G) { const int s0 = basee[e] + tot[e], s1 = basee[e] + (((tot[e] + 255) >> 8) << 8);
        for (int s = s0 + w; s < s1; s += NWAVES) { v4u* rp = (v4u*)(AG + (size_t)s * D) + lane; rp[0] = (v4u){0u, 0u, 0u, 0u}; rp[64] = (v4u){0u, 0u, 0u, 0u}; if (lane == 0) { SLOTR[s] = 0.f; SLOTG[s] = 0.f; } } }
    for (int chunk = blockIdx.x; chunk < 256; chunk += G) {
        if (tid < 8) { int s = 0; for (int c = 0; c < chunk; ++c) s += cn[c * 8 + tid]; int pos = basee[tid] + s;
            for (int i = 0; i < 128; ++i) { const int tk = chunk * 64 + (i >> 1); if (TOKE[2 * tk + (i & 1)] == tid) { sl[i] = pos; SLOTR[pos] = TOKR[tk]; SLOTG[pos] = TOKG[2 * tk + (i & 1)]; TOKS[2 * tk + (i & 1)] = pos; ++pos; } } }
        __syncthreads();
        for (int q = 0; q < 16; ++q) { const int i = w * 16 + q, tk = chunk * 64 + (i >> 1), s = sl[i];
            const v4u* src = (const v4u*)(HB + (size_t)tk * D) + lane; v4u* dst = (v4u*)(AG + (size_t)s * D) + lane; dst[0] = src[0]; dst[64] = src[64]; }
        __syncthreads();
    }
}
__device__ __forceinline__ void final_phase(const Args& a, int tid, int G) {
    const int lane = tid & 63, gw = blockIdx.x * NWAVES + (tid >> 6), NGW = G * NWAVES;
    const int* TOKS = (const int*)(a.ws + WS_TOKS); const bf16* YS = (const bf16*)(a.ws + WS_YS);
    for (int tk = gw; tk < M; tk += NGW) { const int s0 = TOKS[2 * tk], s1 = TOKS[2 * tk + 1];
        f32x4* hr = (f32x4*)(a.out + (size_t)tk * D) + lane; const v2u* y0 = (const v2u*)(YS + (size_t)s0 * D) + lane; const v2u* y1 = (const v2u*)(YS + (size_t)s1 * D) + lane;
        f32x4 v[4]; float ss = 0.f;
#pragma unroll
        for (int j = 0; j < 4; ++j) { v[j] = hr[64 * j]; const v2u p = y0[64 * j], q = y1[64 * j];
            v[j].x += bflo(p.x) + bflo(q.x); v[j].y += bfhi(p.x) + bfhi(q.x); v[j].z += bflo(p.y) + bflo(q.y); v[j].w += bfhi(p.y) + bfhi(q.y);
            ss += (v[j].x * v[j].x + v[j].y * v[j].y) + (v[j].z * v[j].z + v[j].w * v[j].w); }
        const float rstd = rsqrtf(wave_sum(ss) * (1.0f / 1024.0f) + EPS);
#ifdef PROBE_DSA
        const float* pr = (const float*)(a.ws + WS_CTL) + 12288; const float padd = PROBE_C * sqrtf(pr[0] / fmaxf(pr[1], 1e-30f));
#else
        const float padd = 0.f;
#endif
#pragma unroll
        for (int j = 0; j < 4; ++j) { const f32x4 g = ((const f32x4*)a.in[IN_FNORM])[lane + 64 * j]; hr[64 * j] = v[j] * rstd * g + padd; } }
}

typedef short bf16x8 __attribute__((ext_vector_type(8)));
typedef short bf16x4 __attribute__((ext_vector_type(4)));
typedef float f32x16 __attribute__((ext_vector_type(16)));
#define MFMA32(a, b, c) __builtin_amdgcn_mfma_f32_32x32x16_bf16((a), (b), (c), 0, 0, 0)
constexpr int DS_HIST = 0;
constexpr int DS_BM = 33024;
constexpr int DS_P = DS_BM + 8192;
constexpr int DS_CU = DS_P + 512;
constexpr int DS_CK = DS_CU + 8192;
constexpr int DS_BIAS = DS_CK + 8192;
constexpr int DS_ST = DS_BIAS + 2112;
constexpr int DS_CMB = DS_ST + 8 * 4608;
constexpr int DS_END = DS_CMB + 4 * 8704;
constexpr int DSA_CAP = 64;
static_assert(DS_END <= MISC_OFF - 64, "DSA LDS map");
__device__ __forceinline__ void tr_read_tile(unsigned addr, bf16x4& t00, bf16x4& t01, bf16x4& t10, bf16x4& t11, bf16x4& u00, bf16x4& u01, bf16x4& u10, bf16x4& u11) {
    asm volatile("s_waitcnt lgkmcnt(0)\n\t"
                 "ds_read_b64_tr_b16 %0, %8 offset:0\n\t" "ds_read_b64_tr_b16 %1, %8 offset:512\n\t" "ds_read_b64_tr_b16 %2, %8 offset:1024\n\t" "ds_read_b64_tr_b16 %3, %8 offset:1536\n\t"
                 "ds_read_b64_tr_b16 %4, %8 offset:2048\n\t" "ds_read_b64_tr_b16 %5, %8 offset:2560\n\t" "ds_read_b64_tr_b16 %6, %8 offset:3072\n\t" "ds_read_b64_tr_b16 %7, %8 offset:3584\n\t"
                 "s_waitcnt lgkmcnt(0)"
                 : "=&v"(t00), "=&v"(t01), "=&v"(t10), "=&v"(t11), "=&v"(u00), "=&v"(u01), "=&v"(u10), "=&v"(u11) : "v"(addr) : "memory");
}

__device__ __forceinline__ void dsa2_setup(const Args& a, LAS unsigned char* lds, int tid) {
    LAS float* biasL = (LAS float*)(lds + DS_BIAS);
    for (int i = tid; i < 4 * 129; i += NTHR) { const int h = i / 129, d = i % 129; biasL[h * 132 + d] = a.in[IN_RELB][rel_bucket(d) * 4 + h] * 1.4426950408889634f; }
    __syncthreads();
}
__device__ __forceinline__ void idx_scores(const bf16x8 ka0, const bf16x8 ka1, const bf16x8 (&qf)[8][2], const float (&wv)[8], float (&sc)[16]) {
#pragma unroll
    for (int r = 0; r < 16; ++r) sc[r] = 0.f;
    float zero = 0.f;
#pragma unroll
    for (int hp = 0; hp < 4; ++hp) {
        f32x16 acc0, acc1;
#pragma unroll
        for (int r = 0; r < 16; ++r) { acc0[r] = zero; acc1[r] = zero; }
        acc0 = MFMA32(ka0, qf[2 * hp][0], acc0); acc1 = MFMA32(ka0, qf[2 * hp + 1][0], acc1);
        acc0 = MFMA32(ka1, qf[2 * hp][1], acc0); acc1 = MFMA32(ka1, qf[2 * hp + 1][1], acc1);
#pragma unroll
        for (int r = 0; r < 16; ++r) sc[r] = __builtin_fmaf(fmaxf(acc1[r], 0.f), wv[2 * hp + 1], __builtin_fmaf(fmaxf(acc0[r], 0.f), wv[2 * hp], sc[r]));
        asm volatile("" : "+v"(zero), "+v"(sc[0]), "+v"(sc[1]), "+v"(sc[2]), "+v"(sc[3]), "+v"(sc[4]), "+v"(sc[5]), "+v"(sc[6]), "+v"(sc[7]), "+v"(sc[8]), "+v"(sc[9]), "+v"(sc[10]), "+v"(sc[11]), "+v"(sc[12]), "+v"(sc[13]), "+v"(sc[14]), "+v"(sc[15]));
    }
}
__device__ __forceinline__ void dsa2_item(const Args& a, int item, LAS unsigned char* lds, int tid) {
    const int lane = tid & 63, w = __builtin_amdgcn_readfirstlane(tid >> 6), ql = lane & 31, hh = lane >> 5;
    const int b = item & 7, qi = 63 - (item >> 3), tq0 = qi * 32, ntl = qi + 1;
    const bool sel = qi >= 8;
    const bf16* z = (const bf16*)(a.ws + WS_Z); bf16* mix = (bf16*)(a.ws + WS_MIX);
    const bf16* zb = z + (size_t)b * T * ZW;
    const bf16* zq = zb + (size_t)(tq0 + ql) * ZW;
    LAS unsigned* hist = (LAS unsigned*)(lds + DS_HIST); LAS unsigned* bm = (LAS unsigned*)(lds + DS_BM);
    LAS unsigned* Pp = (LAS unsigned*)(lds + DS_P); LAS unsigned* need = Pp + 32; LAS unsigned* ccnt = Pp + 64; LAS unsigned* ccnt2 = Pp + 96;
    LAS unsigned* cu = (LAS unsigned*)(lds + DS_CU); LAS unsigned* ck = (LAS unsigned*)(lds + DS_CK);
    const LAS float* biasL = (const LAS float*)(lds + DS_BIAS);
    if (sel) {
        for (int i = tid; i < 2048; i += NTHR) bm[i] = 0u;
        if (tid < 32) { Pp[tid] = 0u; need[tid] = 256u; ccnt2[tid] = 0u; }
        bf16x8 qf[8][2]; float wv[8];
#pragma unroll
        for (int hx = 0; hx < 8; ++hx) { qf[hx][0] = *(const bf16x8*)(zq + Z_CQI + hx * 32 + 8 * hh); qf[hx][1] = *(const bf16x8*)(zq + Z_CQI + hx * 32 + 16 + 8 * hh); }
        { const v4u wr = *(const v4u*)(zq + Z_CWI);
          wv[0] = bflo(wr.x) * 0.0625f; wv[1] = bfhi(wr.x) * 0.0625f; wv[2] = bflo(wr.y) * 0.0625f; wv[3] = bfhi(wr.y) * 0.0625f;
          wv[4] = bflo(wr.z) * 0.0625f; wv[5] = bfhi(wr.z) * 0.0625f; wv[6] = bflo(wr.w) * 0.0625f; wv[7] = bfhi(wr.w) * 0.0625f; }
        int sh = 23, nb = 9;
#pragma unroll 1
        for (int level = 0; level < 4; ++level) {
            for (int i = tid; i < 32 * 257; i += NTHR) hist[i] = 0u;
            __syncthreads();
            const unsigned myP = Pp[ql];
#pragma unroll 1
            for (int kt = w; kt < ntl; kt += 8) {
                const bf16* zk = zb + (size_t)(kt * 32 + ql) * ZW + Z_CKI + 8 * hh;
                const bf16x8 ka0 = *(const bf16x8*)zk, ka1 = *(const bf16x8*)(zk + 16);
                float sc[16]; idx_scores(ka0, ka1, qf, wv, sc);
#pragma unroll
                for (int r = 0; r < 16; ++r) { const int kl = (r & 3) + 8 * (r >> 2) + 4 * hh; const unsigned u = ord_u(sc[r] + 0.0f);
                    const bool ok = (kt < qi || kl <= ql) && (level == 0 || (u >> (sh + nb)) == myP);
                    if (ok) { const unsigned digit = (u >> sh) & ((1u << nb) - 1u); LDS_ADD(&hist[ql * 257 + (digit >> 1)], 1u << (16 * (digit & 1))); } }
            }
            __syncthreads();
#pragma unroll 1
            for (int qq = 0; qq < 4; ++qq) { const int q = 4 * w + qq; const int bpl = (1 << nb) >> 6, wpl = bpl >> 1;
                unsigned c[8]; unsigned s = 0u;
#pragma unroll
                for (int i = 0; i < 4; ++i) { const unsigned wd = (i < wpl) ? hist[q * 257 + lane * wpl + i] : 0u; c[2 * i] = wd & 0xffffu; c[2 * i + 1] = wd >> 16; s += c[2 * i] + c[2 * i + 1]; }
                unsigned incl = s;
#pragma unroll
                for (int o = 1; o < 64; o <<= 1) { const unsigned t2 = __shfl_down(incl, o); if (lane + o < 64) incl += t2; }
                const unsigned excl = incl - s, nd = need[q];
                if (excl < nd && nd <= incl) { unsigned run = excl; int dsel = 0; unsigned above = 0u, cand = 0u; bool found = false;
#pragma unroll
                    for (int i = 7; i >= 0; --i) { if (i < bpl && !found) { if (run + c[i] >= nd) { dsel = i; above = run; cand = c[i]; found = true; } else run += c[i]; } }
                    Pp[q] = (Pp[q] << nb) | (unsigned)(lane * bpl + dsel); need[q] = nd - above; ccnt[q] = cand; }
            }
            __syncthreads();
            unsigned mc = ccnt[ql]; mc = (unsigned)wave_max((float)mc);
            if (mc <= (unsigned)DSA_CAP || level == 3) break;
            sh -= (level == 2) ? 7 : 8; nb = (level == 2) ? 7 : 8;
        }
        { const unsigned myP = Pp[ql];
#pragma unroll 1
          for (int kt = w; kt < ntl; kt += 8) {
            const bf16* zk = zb + (size_t)(kt * 32 + ql) * ZW + Z_CKI + 8 * hh;
            const bf16x8 ka0 = *(const bf16x8*)zk, ka1 = *(const bf16x8*)(zk + 16);
            float sc[16]; idx_scores(ka0, ka1, qf, wv, sc); unsigned bits = 0u;
#pragma unroll
            for (int r = 0; r < 16; ++r) { const int kl = (r & 3) + 8 * (r >> 2) + 4 * hh; const unsigned u = ord_u(sc[r] + 0.0f), pfx = u >> sh;
                if (kt < qi || kl <= ql) { if (pfx > myP) bits |= 1u << kl;
                    else if (pfx == myP) { const unsigned slot = __hip_atomic_fetch_add(&ccnt2[ql], 1u, __ATOMIC_RELAXED, __HIP_MEMORY_SCOPE_WORKGROUP);
                        if (slot < (unsigned)DSA_CAP) { cu[ql * DSA_CAP + slot] = u; ck[ql * DSA_CAP + slot] = (unsigned)(kt * 32 + kl); } } } }
            if (bits) (void)__hip_atomic_fetch_or(&bm[kt * 32 + ql], bits, __ATOMIC_RELAXED, __HIP_MEMORY_SCOPE_WORKGROUP);
          } }
        __syncthreads();
        for (int idx = tid; idx < 32 * DSA_CAP; idx += NTHR) { const int q = idx / DSA_CAP, i = idx % DSA_CAP; unsigned n = ccnt2[q]; n = n < (unsigned)DSA_CAP ? n : (unsigned)DSA_CAP;
            if ((unsigned)i < n) { const unsigned ui = cu[q * DSA_CAP + i], ki = ck[q * DSA_CAP + i]; unsigned rank = 0u;
                for (unsigned j = 0; j < n; ++j) { const unsigned uj = cu[q * DSA_CAP + j], kj = ck[q * DSA_CAP + j]; rank += (uj > ui || (uj == ui && kj < ki)) ? 1u : 0u; }
                if (rank < need[q]) (void)__hip_atomic_fetch_or(&bm[(ki >> 5) * 32 + q], 1u << (ki & 31u), __ATOMIC_RELAXED, __HIP_MEMORY_SCOPE_WORKGROUP); } }
        __syncthreads();
    }
    const int hd = w >> 1, half = w & 1;
    bf16x8 qa[4];
#pragma unroll
    for (int s = 0; s < 4; ++s) qa[s] = *(const bf16x8*)(zq + Z_CQ + hd * 64 + 16 * s + 8 * hh);
    f32x16 o0, o1;
#pragma unroll
    for (int r = 0; r < 16; ++r) { o0[r] = 0.f; o1[r] = 0.f; }
    float m = -1e30f, lsum = 0.f;
    const float c31 = biasL[hd * 132 + 128];
    LAS unsigned char* st = lds + DS_ST + w * 4608;
    const unsigned vaddr = (unsigned)(size_t)st + (unsigned)((4 * hh + ((lane >> 2) & 3)) * 64 + 32 * ((lane >> 4) & 1) + 8 * (lane & 3));
    constexpr float SC = 0.18033688011112042f;
#pragma unroll 1
    for (int kt = half; kt < ntl; kt += 2) {
        const int k0 = kt * 32;
        bf16x8 kf[4];
        { const bf16* zk = zb + (size_t)(k0 + ql) * ZW + Z_CK + hd * 64 + 8 * hh;
#pragma unroll
          for (int s = 0; s < 4; ++s) kf[s] = *(const bf16x8*)(zk + 16 * s); }
#pragma unroll
        for (int i = 0; i < 4; ++i) { const int key = (lane >> 3) + 8 * i, ch = lane & 7;
            const v4u v = *(const v4u*)(zb + (size_t)(k0 + key) * ZW + Z_CV + hd * 64 + ch * 8);
            *(LAS v4u*)(st + (ch >> 2) * 2048 + key * 64 + (ch & 3) * 16) = v; }
        f32x16 sacc;
#pragma unroll
        for (int r = 0; r < 16; ++r) sacc[r] = 0.f;
#pragma unroll
        for (int s = 0; s < 4; ++s) sacc = MFMA32(kf[s], qa[s], sacc);
        unsigned word = sel ? bm[kt * 32 + ql] : 0xffffffffu;
        if (kt == qi) word &= (ql == 31) ? 0xffffffffu : ((2u << ql) - 1u);
        const bool nearb = (tq0 - (k0 + 31)) < 128;
        float sv[16]; float tmax = -1e30f;
#pragma unroll
        for (int r = 0; r < 16; ++r) { const int kl = (r & 3) + 8 * (r >> 2) + 4 * hh; float bias = c31;
            if (nearb) { int dd = tq0 + ql - k0 - kl; dd = dd < 0 ? 0 : (dd > 128 ? 128 : dd); bias = biasL[hd * 132 + dd]; }
            const float v = sacc[r] * SC + bias; sv[r] = ((word >> kl) & 1u) ? v : -1e30f; tmax = fmaxf(tmax, sv[r]); }
        tmax = fmaxf(tmax, __shfl_xor(tmax, 32));
        const float mnew = fmaxf(m, tmax), alpha = __builtin_amdgcn_exp2f(m - mnew);
        float p[16]; float ps = 0.f;
#pragma unroll
        for (int r = 0; r < 16; ++r) { p[r] = (sv[r] > -1e29f) ? __builtin_amdgcn_exp2f(sv[r] - mnew) : 0.f; ps += p[r]; }
        ps += __shfl_xor(ps, 32);
        lsum = lsum * alpha + ps; m = mnew;
#pragma unroll
        for (int r = 0; r < 16; ++r) { o0[r] *= alpha; o1[r] *= alpha; }
        bf16x8 pb[2];
#pragma unroll
        for (int s = 0; s < 2; ++s) { v4u t4; t4.x = pg8::cvt_pk_bf16(p[8 * s + 0], p[8 * s + 1]); t4.y = pg8::cvt_pk_bf16(p[8 * s + 2], p[8 * s + 3]); t4.z = pg8::cvt_pk_bf16(p[8 * s + 4], p[8 * s + 5]); t4.w = pg8::cvt_pk_bf16(p[8 * s + 6], p[8 * s + 7]);
            pb[s] = __builtin_bit_cast(bf16x8, t4); }
        bf16x4 t00, t01, t10, t11, u00, u01, u10, u11;
        tr_read_tile(vaddr, t00, t01, t10, t11, u00, u01, u10, u11);
        const bf16x8 va00 = __builtin_shufflevector(t00, t01, 0, 1, 2, 3, 4, 5, 6, 7), va01 = __builtin_shufflevector(t10, t11, 0, 1, 2, 3, 4, 5, 6, 7);
        const bf16x8 va10 = __builtin_shufflevector(u00, u01, 0, 1, 2, 3, 4, 5, 6, 7), va11 = __builtin_shufflevector(u10, u11, 0, 1, 2, 3, 4, 5, 6, 7);
        o0 = MFMA32(va00, pb[0], o0); o0 = MFMA32(va01, pb[1], o0);
        o1 = MFMA32(va10, pb[0], o1); o1 = MFMA32(va11, pb[1], o1);
    }
    LAS float* cmb = (LAS float*)(lds + DS_CMB + hd * 8704);
    if (half == 1) {
#pragma unroll
        for (int r = 0; r < 16; ++r) { cmb[r * 64 + lane] = o0[r]; cmb[(16 + r) * 64 + lane] = o1[r]; }
        cmb[2048 + lane] = m; cmb[2048 + 64 + lane] = lsum;
    }
    __syncthreads();
    if (half == 0) {
        const float mb = cmb[2048 + lane], lb = cmb[2048 + 64 + lane];
        const float mt = fmaxf(m, mb), fa = __builtin_amdgcn_exp2f(m - mt), fb = __builtin_amdgcn_exp2f(mb - mt);
        const float inv = 1.0f / (lsum * fa + lb * fb), ga = fa * inv, gb = fb * inv;
        asm volatile("s_waitcnt lgkmcnt(0)" ::: "memory");
#pragma unroll
        for (int r = 0; r < 16; ++r) { o0[r] = o0[r] * ga + cmb[r * 64 + lane] * gb; o1[r] = o1[r] * ga + cmb[(16 + r) * 64 + lane] * gb; }
#pragma unroll
        for (int g = 0; g < 4; ++g) { v2u w0, w1; w0.x = pg8::cvt_pk_bf16(o0[4 * g], o0[4 * g + 1]); w0.y = pg8::cvt_pk_bf16(o0[4 * g + 2], o0[4 * g + 3]); w1.x = pg8::cvt_pk_bf16(o1[4 * g], o1[4 * g + 1]); w1.y = pg8::cvt_pk_bf16(o1[4 * g + 2], o1[4 * g + 3]);
            *(LAS v2u*)(st + ql * 136 + (8 * g + 4 * hh) * 2) = w0; *(LAS v2u*)(st + ql * 136 + (32 + 8 * g + 4 * hh) * 2) = w1; }
        asm volatile("s_waitcnt lgkmcnt(0)" ::: "memory");
#pragma unroll
        for (int i = 0; i < 4; ++i) { const int q = (lane >> 3) + 8 * i, ch = lane & 7;
            const v2u x0 = *(const LAS v2u*)(st + q * 136 + ch * 16), x1 = *(const LAS v2u*)(st + q * 136 + ch * 16 + 8);
            v4u o; o.x = x0.x; o.y = x0.y; o.z = x1.x; o.w = x1.y;
            *(v4u*)(mix + ((size_t)b * T + tq0 + q) * D + 512 + hd * 64 + ch * 8) = o; }
    }
    __syncthreads();
}


constexpr int XA_V = 0, XA_ST = 32768;
__device__ __forceinline__ void xattn2_item(const Args& a, int l, int item, LAS unsigned char* lds, int tid) {
    const int lane = tid & 63, w = __builtin_amdgcn_readfirstlane(tid >> 6), ql = lane & 31, hh = lane >> 5;
    const int qg = item & 7, h = (item >> 3) & 3, b = item >> 5;
    const bf16* kvm = (const bf16*)(a.ws + WS_KVM + (size_t)l * SZ_KVM) + (size_t)b * MEMLEN * 512;
    const bf16* qx = (const bf16*)(a.ws + WS_QX); bf16* ox = (bf16*)(a.ws + WS_OX);
#pragma unroll
    for (int i = 0; i < 4; ++i) { const int idx = tid + NTHR * i, key = idx >> 3, ch = idx & 7;
        const v4u v = *(const v4u*)(kvm + (size_t)key * 512 + 256 + h * 64 + ch * 8);
        *(LAS v4u*)(lds + XA_V + (key >> 5) * 4096 + (ch >> 2) * 2048 + (key & 31) * 64 + (ch & 3) * 16) = v; }
    __syncthreads();
    const size_t row0 = (size_t)b * T + qg * 256 + w * 32;
    bf16x8 qa[4];
#pragma unroll
    for (int s = 0; s < 4; ++s) qa[s] = *(const bf16x8*)(qx + (row0 + ql) * 256 + h * 64 + 16 * s + 8 * hh);
    f32x16 o0, o1;
#pragma unroll
    for (int r = 0; r < 16; ++r) { o0[r] = 0.f; o1[r] = 0.f; }
    float m = -1e30f, lsum = 0.f;
    const unsigned vaddr = (unsigned)(size_t)(lds + XA_V) + (unsigned)((4 * hh + ((lane >> 2) & 3)) * 64 + 32 * ((lane >> 4) & 1) + 8 * (lane & 3));
#pragma unroll 1
    for (int kt = 0; kt < 8; ++kt) {
        bf16x8 kf[4];
        { const bf16* zk = kvm + (size_t)(kt * 32 + ql) * 512 + h * 64 + 8 * hh;
#pragma unroll
          for (int s = 0; s < 4; ++s) kf[s] = *(const bf16x8*)(zk + 16 * s); }
        f32x16 sacc;
#pragma unroll
        for (int r = 0; r < 16; ++r) sacc[r] = 0.f;
#pragma unroll
        for (int s = 0; s < 4; ++s) sacc = MFMA32(kf[s], qa[s], sacc);
        float sv[16]; float tmax = -1e30f;
#pragma unroll
        for (int r = 0; r < 16; ++r) { sv[r] = sacc[r] * 1.4426950408889634f; tmax = fmaxf(tmax, sv[r]); }
        tmax = fmaxf(tmax, __shfl_xor(tmax, 32));
        const float mnew = fmaxf(m, tmax), alpha = __builtin_amdgcn_exp2f(m - mnew);
        float p[16]; float ps = 0.f;
#pragma unroll
        for (int r = 0; r < 16; ++r) { p[r] = __builtin_amdgcn_exp2f(sv[r] - mnew); ps += p[r]; }
        ps += __shfl_xor(ps, 32);
        lsum = lsum * alpha + ps; m = mnew;
#pragma unroll
        for (int r = 0; r < 16; ++r) { o0[r] *= alpha; o1[r] *= alpha; }
        bf16x8 pb[2];
#pragma unroll
        for (int s = 0; s < 2; ++s) { v4u t4; t4.x = pg8::cvt_pk_bf16(p[8 * s + 0], p[8 * s + 1]); t4.y = pg8::cvt_pk_bf16(p[8 * s + 2], p[8 * s + 3]); t4.z = pg8::cvt_pk_bf16(p[8 * s + 4], p[8 * s + 5]); t4.w = pg8::cvt_pk_bf16(p[8 * s + 6], p[8 * s + 7]);
            pb[s] = __builtin_bit_cast(bf16x8, t4); }
        bf16x4 t00, t01, t10, t11, u00, u01, u10, u11;
        tr_read_tile(vaddr + kt * 4096, t00, t01, t10, t11, u00, u01, u10, u11);
        const bf16x8 va00 = __builtin_shufflevector(t00, t01, 0, 1, 2, 3, 4, 5, 6, 7), va01 = __builtin_shufflevector(t10, t11, 0, 1, 2, 3, 4, 5, 6, 7);
        const bf16x8 va10 = __builtin_shufflevector(u00, u01, 0, 1, 2, 3, 4, 5, 6, 7), va11 = __builtin_shufflevector(u10, u11, 0, 1, 2, 3, 4, 5, 6, 7);
        o0 = MFMA32(va00, pb[0], o0); o0 = MFMA32(va01, pb[1], o0);
        o1 = MFMA32(va10, pb[0], o1); o1 = MFMA32(va11, pb[1], o1);
    }
    const float inv = 1.0f / lsum;
    LAS unsigned char* st = lds + XA_ST + w * 4608;
#pragma unroll
    for (int g = 0; g < 4; ++g) { v2u w0, w1; w0.x = pg8::cvt_pk_bf16(o0[4 * g] * inv, o0[4 * g + 1] * inv); w0.y = pg8::cvt_pk_bf16(o0[4 * g + 2] * inv, o0[4 * g + 3] * inv);
        w1.x = pg8::cvt_pk_bf16(o1[4 * g] * inv, o1[4 * g + 1] * inv); w1.y = pg8::cvt_pk_bf16(o1[4 * g + 2] * inv, o1[4 * g + 3] * inv);
        *(LAS v2u*)(st + ql * 136 + (8 * g + 4 * hh) * 2) = w0; *(LAS v2u*)(st + ql * 136 + (32 + 8 * g + 4 * hh) * 2) = w1; }
    asm volatile("s_waitcnt lgkmcnt(0)" ::: "memory");
#pragma unroll
    for (int i = 0; i < 4; ++i) { const int q = (lane >> 3) + 8 * i, ch = lane & 7;
        const v2u x0 = *(const LAS v2u*)(st + q * 136 + ch * 16), x1 = *(const LAS v2u*)(st + q * 136 + ch * 16 + 8);
        v4u o; o.x = x0.x; o.y = x0.y; o.z = x1.x; o.w = x1.y;
        *(v4u*)(ox + (row0 + q) * 256 + h * 64 + ch * 8) = o; }
    __syncthreads();
}
constexpr int CW_QUEUE = 8192;
__device__ __forceinline__ void mixers_phase(const Args& a, int l, LAS unsigned char* lds, int tid) {
    dsa2_setup(a, lds, tid);
    unsigned* qctr = (unsigned*)(a.ws + WS_CTL) + CW_QUEUE + 64 * l;
    volatile LAS int* qslot = (volatile LAS int*)(lds + MISC_OFF + 64);
    for (;;) {
        if (tid == 0) *qslot = (int)__hip_atomic_fetch_add(qctr, 1u, __ATOMIC_RELAXED, __HIP_MEMORY_SCOPE_AGENT);
        __syncthreads();
        const int it = *qslot;
        __syncthreads();
        if (it >= 3072) break;
        int t2 = tid; asm volatile("" : "+v"(t2));
        if (it < 512) dsa2_item(a, it, lds, t2);
        else if (it < 1536) gla_a_item(a, l, it - 512, lds, t2);
        else if (it < 2560) pool_item(a, l, it - 1536, lds, t2);
        else sgu_item(a, l, it - 2560, lds, t2);
    }
#ifdef PROBE_DSA
    __syncthreads(); dsa_setup(a, lds, tid);
    for (int it = M - 1 - (int)blockIdx.x; it >= 0; it -= gridDim.x) dsa_item(a, it, lds, tid, (bf16*)(a.ws + WS_QX), 256);
#endif
}
#ifdef PROBE_DSA
__device__ __forceinline__ void probe_dsa_compare(const Args& a, LAS unsigned char* lds, int tid) {
    const bf16* mix = (const bf16*)(a.ws + WS_MIX); const bf16* alt = (const bf16*)(a.ws + WS_QX); float d2 = 0.f, r2 = 0.f;
    for (size_t i = (size_t)blockIdx.x * NTHR + tid; i < (size_t)M * 256; i += (size_t)gridDim.x * NTHR) { const size_t row = i >> 8, c = i & 255; const float x = bf1(mix[row * D + 512 + c]), y = bf1(alt[i]); d2 += (x - y) * (x - y); r2 += y * y; }
    d2 = wave_sum(d2); r2 = wave_sum(r2);
    if ((tid & 63) == 0) { atomicAdd((float*)(a.ws + WS_CTL) + 12288, d2); atomicAdd((float*)(a.ws + WS_CTL) + 12289, r2); }
}
#endif

constexpr int NPHASE = 28;
#define OTID() int tid = threadIdx.x; asm volatile("" : "+v"(tid))
__global__ void __launch_bounds__(NTHR, 2) fwd_kernel(Args a) {
    extern __shared__ __attribute__((aligned(16))) unsigned char lds_raw[];
    LAS unsigned char* lds = (LAS unsigned char*)lds_raw;
    const int G = gridDim.x, bid = blockIdx.x;
    volatile LAS unsigned* MISC = (volatile LAS unsigned*)(lds + MISC_OFF);
    if (threadIdx.x < 32) MISC[threadIdx.x] = 0u;
    __syncthreads();
    unsigned char* ws = a.ws;
    XcdBarrier bar; bar.bar = (unsigned*)(ws + WS_CTL) + CW_BAR; bar.x = 0; bar.st = nullptr;
    if (N_LAUNCH_MODE == 1) bar = xcd_barrier_post((unsigned*)(ws + WS_CTL) + CW_BAR, MISC + 8);
    const int lo = a.ph_lo, hi = a.ph_hi;
#define RUN(k) (lo <= (k) && (k) < hi)
#define SEAM() do { if (N_LAUNCH_MODE == 1) xcd_barrier(bar); } while (0)
#define WB(off) ((bf16*)(ws + (off)))
#define WF(off) ((float*)(ws + (off)))
#ifdef REP_PRO
    if (RUN(0)) { int nrep = 2; asm volatile("" : "+s"(nrep));
#pragma unroll 1
        for (int rep = 0; rep < nrep; ++rep) { OTID(); p0_prologue(a, lds, tid, G); } SEAM(); }
#else
    if (RUN(0)) { OTID(); p0_prologue(a, lds, tid, G); SEAM(); }
#endif

    for (int l = 0; l < 2; ++l) {
        const int pb = l ? 10 : 1;
        if (RUN(pb + 0)) {
            { pg8::Gemm g{WB(WS_HB), WB(WS_WIN + l * SZ_WIN), M, ZW, D}; pg8::StaticOrder S; S.init(M, ZW, G, bid);
              EpiScale E{WB(WS_Z), ZW, WF(WS_SS), 1.0f}; pg8::gemm_phase<EpiScale, pg8::StaticOrder, true, true>(lds, g, S, E); }
            if (l == 0) {
                for (int l2 = 0; l2 < 2; ++l2) {
                    pg8::Gemm g{WB(WS_MEMB), WB(WS_WKV + l2 * SZ_WKV), MM, 512, D}; pg8::StaticOrder S; S.init(MM, 512, G, (G - 1 - bid - 16 * l2 + 2 * G) % G);
                    EpiScale E{WB(WS_KVM + l2 * SZ_KVM), 512, WF(WS_SSM), 1.0f}; pg8::gemm_phase<EpiScale, pg8::StaticOrder, true, true>(lds, g, S, E); }
            }
            SEAM();
        }
        if (RUN(pb + 1)) {
#ifdef REP_MIX
            { int nrep = 2; asm volatile("" : "+s"(nrep));
#pragma unroll 1
              for (int rep = 0; rep < nrep; ++rep) { OTID(); mixers_phase(a, l, lds, tid); SEAM(); if (threadIdx.x == 0 && bid == 0) __hip_atomic_store((unsigned*)(ws + WS_CTL) + CW_QUEUE + 64 * l, 0u, __ATOMIC_RELAXED, __HIP_MEMORY_SCOPE_AGENT); SEAM(); } }
#else
            { OTID(); mixers_phase(a, l, lds, tid); }
#endif
            SEAM();
        }
        if (RUN(pb + 2)) { OTID(); for (int it = bid; it < 1024; it += G) gla_c_item(a, l, it, lds, tid);
#ifdef PROBE_DSA
            probe_dsa_compare(a, lds, tid);
#endif
            SEAM(); }
        if (RUN(pb + 3)) {
            pg8::Gemm g{WB(WS_MIX), WB(WS_WOUT + l * SZ_WOUT), M, D, D}; pg8::StaticOrder S; S.init(M, D, G, bid);
            EpiResid E{l == 0 ? a.in[IN_X] : (const float*)a.out, a.out, WB(WS_HB), WF(WS_SS)}; pg8::gemm_phase<EpiResid, pg8::StaticOrder, true, true>(lds, g, S, E); SEAM();
        }
        if (RUN(pb + 4)) {
            pg8::Gemm g{WB(WS_HB), WB(WS_WQ + l * SZ_WQ), M, 256, D}; pg8::StaticOrder S; S.init(M, 256, G, bid);
            EpiScale E{WB(WS_QX), 256, WF(WS_SS), 0.125f}; pg8::gemm_phase<EpiScale, pg8::StaticOrder, true, true>(lds, g, S, E); SEAM();
        }
#ifdef REP_XA
        if (RUN(pb + 5)) { OTID(); int nit = 512; asm volatile("" : "+s"(nit)); for (int it = bid; it < nit; it += G) xattn2_item(a, l, it & 255, lds, tid); SEAM(); }
#else
        if (RUN(pb + 5)) { OTID(); for (int it = bid; it < 256; it += G) xattn2_item(a, l, it, lds, tid); SEAM(); }
#endif
        if (RUN(pb + 6)) {
            pg8::Gemm g{WB(WS_OX), WB(WS_WO + l * SZ_WO), M, D, 256}; pg8::StaticOrder S; S.init(M, D, G, bid);
            EpiResid E{a.out, a.out, WB(WS_HB), WF(WS_SS)}; pg8::gemm_phase<EpiResid, pg8::StaticOrder, true, true>(lds, g, S, E); SEAM();
        }
        if (l == 0) {
            if (RUN(8)) {
                pg8::Gemm g{WB(WS_HB), WB(WS_W13), M, 2 * DFF, D}; pg8::StaticOrder S; S.init(M, 2 * DFF, G, bid);
                EpiSwiglu<false> E{WB(WS_FACT), DFF, WF(WS_SS), nullptr, nullptr}; pg8::gemm_phase<EpiSwiglu<false>, pg8::StaticOrder, true, true>(lds, g, S, E); SEAM();
            }
            if (RUN(9)) {
                pg8::Gemm g{WB(WS_FACT), WB(WS_W2), M, D, DFF}; pg8::StaticOrder S; S.init(M, D, G, bid);
                EpiResid E{a.out, a.out, WB(WS_HB), WF(WS_SS)}; pg8::gemm_phase<EpiResid, pg8::StaticOrder, true, true>(lds, g, S, E); SEAM();
            }
        } else {
            if (RUN(17)) { OTID(); moe_route(a, lds, tid, G); SEAM(); }
#ifdef REP_ROUTE
            if (RUN(18)) { int nrep = 2; asm volatile("" : "+s"(nrep));
#pragma unroll 1
                for (int rep = 0; rep < nrep; ++rep) { OTID(); moe_assign(a, lds, tid, G); __syncthreads(); } SEAM(); }
#else
            if (RUN(18)) { OTID(); moe_assign(a, lds, tid, G); SEAM(); }
#endif
            for (int p = 0; p < MOE_NPASS; ++p) {
                const int* TILEE = (const int*)(ws + WS_TILEE);
                if (RUN(19 + 2 * p)) {
                    const int NT = TILEE[159]; int nt = NT - p * MOE_TP; nt = nt < 0 ? 0 : (nt > MOE_TP ? MOE_TP : nt);
                    pg8::Gemm g{WB(WS_AG), WB(WS_MW13), MAXSLOT, NEXP * 2 * DFE, D}; pg8::MoeOrder S{p * MOE_TP, nt, 2 * DFE / 256, G, bid, 0, TILEE};
                    EpiSwiglu<true> E{WB(WS_MACT), DFE, nullptr, WF(WS_SLOTR), WF(WS_SLOTG)};
                    pg8::gemm_phase<EpiSwiglu<true>, pg8::MoeOrder, true, true>(lds, g, S, E); SEAM();
                }
                if (RUN(20 + 2 * p)) {
                    const int NT = TILEE[159]; int nt = NT - p * MOE_TP; nt = nt < 0 ? 0 : (nt > MOE_TP ? MOE_TP : nt);
                    pg8::Gemm g{WB(WS_MACT), WB(WS_MW2), MOE_TP * 256, NEXP * D, DFE}; pg8::MoeOrder S{p * MOE_TP, nt, D / 256, G, bid, 1, TILEE};
                    EpiPlain E{WB(WS_YS), D};
                    pg8::gemm_phase<EpiPlain, pg8::MoeOrder, true, true>(lds, g, S, E); SEAM();
                }
            }
            if (RUN(27)) { OTID(); final_phase(a, tid, G); }
        }
    }
#undef RUN
#undef SEAM
}

extern "C" void kernel_launch(void* const* d_in, const int* in_sizes, int n_in, void* d_out, int out_size, void* d_ws, size_t ws_size, hipStream_t stream) {
    static int grid = 0;
    if (grid == 0) {
        if (n_in != N_IN || out_size != M * D || ws_size < WS_END) { fprintf(stderr, "kernel_launch: unexpected problem (n_in %d, out %d, ws %zu < %zu)\n", n_in, out_size, ws_size, (size_t)WS_END); grid = -1; return; }
        int dev = 0, cus = 0, per_cu = 0;
        if (hipGetDevice(&dev) != hipSuccess || hipDeviceGetAttribute(&cus, hipDeviceAttributeMultiprocessorCount, dev) != hipSuccess) { grid = -1; return; }
        if (hipFuncSetAttribute((const void*)fwd_kernel, hipFuncAttributeMaxDynamicSharedMemorySize, LDS_BYTES) != hipSuccess) { fprintf(stderr, "kernel_launch: hipFuncSetAttribute failed\n"); grid = -1; return; }
        if (hipOccupancyMaxActiveBlocksPerMultiprocessor(&per_cu, (const void*)fwd_kernel, NTHR, LDS_BYTES) != hipSuccess || per_cu < 1) { fprintf(stderr, "kernel_launch: occupancy query says %d\n", per_cu); }
        (void)hipGetLastError();
        grid = cus > 0 ? cus : 256;
    }
    if (grid < 0) return;
    (void)hipMemsetAsync((char*)d_ws + WS_CTL, 0, CTL_ZERO_BYTES, stream);
    Args a{};
    for (int i = 0; i < N_IN; ++i) a.in[i] = (const float*)d_in[i];
    a.out = (float*)d_out; a.ws = (unsigned char*)d_ws;
#if N_LAUNCH_MODE == 1
    a.ph_lo = 0; a.ph_hi = NPHASE;
    hipLaunchKernelGGL(fwd_kernel, dim3(grid), dim3(NTHR), LDS_BYTES, stream, a);
#else
    for (int p = 0; p < NPHASE; ++p) { a.ph_lo = p; a.ph_hi = p + 1; hipLaunchKernelGGL(fwd_kernel, dim3(grid), dim3(NTHR), LDS_BYTES, stream, a); }
#endif
}
```

```cpp
#include <hip/hip_runtime.h>
#include <cstdio>
#include <cstdint>
#include <cmath>

#ifndef N_LAUNCH_MODE
#define N_LAUNCH_MODE 1
#endif

namespace pg8 {
#define PG8_LAS __attribute__((address_space(3)))
typedef unsigned short bf16_t;
typedef short bf16x8 __attribute__((ext_vector_type(8)));
typedef float f32x4 __attribute__((ext_vector_type(4)));
typedef unsigned u32x4 __attribute__((ext_vector_type(4)));
constexpr int BM = 256, BK = 64, HALF = 128, HTB = HALF * BK * 2  , STAGE_BYTES = 8 * HTB, NXCD = 8, WGM = 8;

__host__ __device__ __forceinline__ int lds_byte(int r, int c) { const int st = (r >> 4) * 2 + (c >> 5), rr = r & 15, cc = c & 31, ob = rr * 64 + cc * 2; return st * 1024 + (ob ^ (((ob >> 9) & 1) << 5)); }
__host__ __device__ __forceinline__ void stage_rc(int b, int& R, int& C) { const int st = b / 1024, sb = b % 1024, swz = sb ^ (((sb >> 9) & 1) << 5); R = (st >> 1) * 16 + swz / 64; C = (st & 1) * 32 + (swz % 64) / 2; }
__host__ __device__ __forceinline__ int perm32(int rho) { const int n = rho >> 4, i = rho & 15; return 8 * (i >> 2) + 4 * n + (i & 3); }

struct Unit { int pm, pn, po, e; };
struct Gemm { const bf16_t* A; const bf16_t* Bt; int M, N, K; };

struct StaticOrder {
    int nM, nN, nwg, G, c;
    __host__ __device__ void init(int M, int N, int G_, int c_) { nM = M / BM; nN = N / BM; nwg = nM * nN; G = G_; c = c_; }
    __host__ __device__ bool next(int i, Unit& u) const {
        const long L = (long)i * G + c; if (L >= nwg) return false;
        int wgid = (int)L; { const int q = nwg / NXCD, r = nwg % NXCD, xcd = wgid % NXCD, off = wgid / NXCD; wgid = (xcd < r ? xcd * (q + 1) : r * (q + 1) + (xcd - r) * q) + off; }
        const int nig = WGM * nN, gid = wgid / nig, fm = gid * WGM, gsz = (nM - fm) < WGM ? (nM - fm) : WGM;
        u.pm = fm + ((wgid % nig) % gsz); u.pn = (wgid % nig) / gsz; u.po = u.pm; u.e = u.pn; return true;
    }
    __device__ __forceinline__ void a_ready(const Unit&) const {}
    __device__ __forceinline__ void done(const Unit&) const {}
};
struct MoeOrder {
    int t0, nt, nNe, G, c, a_local; const int* tile_e;
    __device__ bool next(int i, Unit& u) const {
        const long L = (long)i * G + c; if (L >= (long)nt * nNe) return false;
        const int tl = (int)(L % nt), pn = (int)(L / nt), tile = t0 + tl, e = tile_e[tile];
        u.pm = a_local ? tl : tile; u.po = a_local ? tile : tl; u.pn = e * nNe + pn; u.e = pn; return true;
    }
    __device__ __forceinline__ void a_ready(const Unit&) const {}
    __device__ __forceinline__ void done(const Unit&) const {}
};
__device__ __forceinline__ unsigned cvt_pk_bf16(float lo, float hi) { unsigned r; asm volatile("v_cvt_pk_bf16_f32 %0, %1, %2" : "=v"(r) : "v"(lo), "v"(hi)); return r; }
template <class Epi, class Sched, bool ALIGN_EPI = false, bool SP2 = false>
__device__ __forceinline__ void gemm_phase(PG8_LAS unsigned char* lds, const Gemm g, const Sched& S, const Epi& E) {
    int tid_ = threadIdx.x; asm volatile("" : "+v"(tid_)); const int tid = tid_, wid = __builtin_amdgcn_readfirstlane(tid >> 6), lane = tid & 63, wr = wid >> 2, wc = wid & 3, fr = lane & 15, fq = lane >> 4;
    const int K = g.K, nt = K / BK;
    unsigned voffA[2], voffB[2];
#pragma unroll
    for (int i = 0; i < 2; ++i) { int R, C; stage_rc(tid * 16 + i * 8192, R, C); const int Rb = Epi::PERM ? ((R & ~31) + perm32(R & 31)) : R;
        voffA[i] = (unsigned)(R * K + C) * 2u; voffB[i] = (unsigned)(Rb * K + C) * 2u; }
    const size_t kstep = (size_t)(BK * 2);
    const size_t hstep = (size_t)HALF * K * 2;
    const size_t tstep = 2 * hstep;
    const unsigned ldsw = (unsigned)wid * 1024u;
    const int aoff = lds_byte(wr * 64 + fr, fq * 8), boff = lds_byte(wc * 32 + fr, fq * 8);
#define PG8_SA(b, h) (((b) * 2 + (h)) * HTB)
#define PG8_SB(b, h) ((4 + (b) * 2 + (h)) * HTB)
#define PG8_STAGE(bufoff, gbase, voff) do { _Pragma("unroll") for (int _i = 0; _i < 2; ++_i) \
        __builtin_amdgcn_global_load_lds((const unsigned*)((const char*)(gbase) + (voff)[_i]), (PG8_LAS unsigned*)(lds + (bufoff) + ldsw + _i * 8192), 16, 0, 0); } while (0)
#define PG8_LDA(dst, b, h) do { _Pragma("unroll") for (int m = 0; m < 4; ++m) _Pragma("unroll") for (int k = 0; k < 2; ++k) dst[m][k] = *(const PG8_LAS bf16x8*)(lds + PG8_SA(b, h) + aoff + m * 2048 + k * 1024); } while (0)
#define PG8_LDB(dst, b, h) do { _Pragma("unroll") for (int n = 0; n < 2; ++n) _Pragma("unroll") for (int k = 0; k < 2; ++k) dst[n][k] = *(const PG8_LAS bf16x8*)(lds + PG8_SB(b, h) + boff + n * 2048 + k * 1024); } while (0)
#define PG8_MMA(ai, bj, At, Bt) do { __builtin_amdgcn_s_setprio(1); _Pragma("unroll") for (int m = 0; m < 4; ++m) _Pragma("unroll") for (int n = 0; n < 2; ++n) _Pragma("unroll") for (int k = 0; k < 2; ++k) \
        acc[ai][bj][m][n] = __builtin_amdgcn_mfma_f32_16x16x32_bf16(Bt[n][k], At[m][k], acc[ai][bj][m][n], 0, 0, 0); __builtin_amdgcn_s_setprio(0); } while (0)
#define PG8_WAIT_V(n) asm volatile("s_waitcnt vmcnt(" #n ")" ::: "memory")
#define PG8_WAIT_L(n) asm volatile("s_waitcnt lgkmcnt(" #n ")" ::: "memory")
#define PG8_BAR __builtin_amdgcn_s_barrier()
#define PG8_SCHED __builtin_amdgcn_sched_barrier(0)
    Unit cur, nxt; int ui = 0;
    if (!S.next(0, cur)) return;
    f32x4 acc[2][2][4][2];
#pragma unroll
    for (int a = 0; a < 2; ++a)
#pragma unroll
        for (int b = 0; b < 2; ++b)
#pragma unroll
            for (int m = 0; m < 4; ++m)
#pragma unroll
                for (int n = 0; n < 2; ++n) acc[a][b][m][n] = (f32x4){0.f, 0.f, 0.f, 0.f};
    bf16x8 At[4][2], B0[2][2], B1[2][2];
    const char* cA = (const char*)g.A + (size_t)cur.pm * tstep; const char* cB = (const char*)g.Bt + (size_t)cur.pn * tstep;
    S.a_ready(cur);
    if constexpr (SP2) {
        PG8_STAGE(PG8_SB(0, 0), cB, voffB); PG8_STAGE(PG8_SB(0, 1), cB + hstep, voffB); PG8_STAGE(PG8_SA(0, 0), cA, voffA); PG8_STAGE(PG8_SA(0, 1), cA + hstep, voffA);
        if (wr == 1) PG8_BAR;
        PG8_WAIT_V(2); PG8_BAR;
        PG8_STAGE(PG8_SB(1, 0), cB + kstep, voffB); PG8_STAGE(PG8_SA(1, 0), cA + kstep, voffA); PG8_STAGE(PG8_SB(1, 1), cB + hstep + kstep, voffB);
        PG8_WAIT_V(6); PG8_BAR;
    } else {
        PG8_STAGE(PG8_SB(0, 0), cB, voffB); PG8_STAGE(PG8_SA(0, 0), cA, voffA); PG8_STAGE(PG8_SB(0, 1), cB + hstep, voffB); PG8_STAGE(PG8_SA(0, 1), cA + hstep, voffA);
        if (wr == 1) PG8_BAR;
        PG8_WAIT_V(4); PG8_BAR;
        PG8_STAGE(PG8_SB(1, 0), cB + kstep, voffB); PG8_STAGE(PG8_SA(1, 0), cA + kstep, voffA); PG8_STAGE(PG8_SB(1, 1), cB + hstep + kstep, voffB);
        PG8_WAIT_V(6); PG8_BAR;
    }
    for (;;) {
        const bool has_next = S.next(ui + 1, nxt);
        const char* nA = has_next ? (const char*)g.A + (size_t)nxt.pm * tstep : cA; const char* nB = has_next ? (const char*)g.Bt + (size_t)nxt.pn * tstep : cB;
        for (int t = 0; t < nt; t += 2) {
            const bool last = (t == nt - 2);
            const char* a1 = cA + (size_t)(t + 1) * kstep;
            const char* a2 = last ? nA : cA + (size_t)(t + 2) * kstep; const char* b2 = last ? nB : cB + (size_t)(t + 2) * kstep;
            const char* a3 = a2 + kstep; const char* b3 = b2 + kstep;
            if (last && has_next) S.a_ready(nxt);
            if constexpr (SP2) {
            PG8_LDB(B0, 0, 0); PG8_LDB(B1, 0, 1); PG8_SCHED; PG8_LDA(At, 0, 0); PG8_STAGE(PG8_SA(1, 1), a1 + hstep, voffA);
            PG8_WAIT_V(8); PG8_WAIT_L(0); PG8_BAR; PG8_MMA(0, 0, At, B0); PG8_MMA(0, 1, At, B1); PG8_BAR; PG8_SCHED;
            PG8_LDA(At, 0, 1); PG8_STAGE(PG8_SB(0, 0), b2, voffB); PG8_STAGE(PG8_SB(0, 1), b2 + hstep, voffB); PG8_STAGE(PG8_SA(0, 0), a2, voffA);
            PG8_WAIT_V(8); PG8_WAIT_L(0); PG8_BAR; PG8_MMA(1, 0, At, B0); PG8_MMA(1, 1, At, B1); PG8_BAR; PG8_SCHED;
            PG8_LDB(B0, 1, 0); PG8_LDB(B1, 1, 1); PG8_SCHED; PG8_LDA(At, 1, 0); PG8_STAGE(PG8_SA(0, 1), a2 + hstep, voffA);
            PG8_WAIT_V(8); PG8_WAIT_L(0); PG8_BAR; PG8_MMA(0, 0, At, B0); PG8_MMA(0, 1, At, B1); PG8_BAR; PG8_SCHED;
            PG8_LDA(At, 1, 1); PG8_STAGE(PG8_SB(1, 0), b3, voffB); PG8_STAGE(PG8_SB(1, 1), b3 + hstep, voffB); PG8_STAGE(PG8_SA(1, 0), a3, voffA);
            PG8_WAIT_V(8); PG8_WAIT_L(0); PG8_BAR; PG8_MMA(1, 0, At, B0); PG8_MMA(1, 1, At, B1); PG8_BAR; PG8_SCHED;
            } else {
            PG8_LDB(B0, 0, 0); PG8_SCHED; PG8_LDA(At, 0, 0); PG8_STAGE(PG8_SA(1, 1), a1 + hstep, voffA);
            PG8_WAIT_L(8); PG8_BAR; PG8_WAIT_L(0); PG8_MMA(0, 0, At, B0); PG8_BAR; PG8_SCHED;
            PG8_LDB(B1, 0, 1); PG8_STAGE(PG8_SB(0, 0), b2, voffB);
            PG8_BAR; PG8_WAIT_L(0); PG8_MMA(0, 1, At, B1); PG8_BAR;
            PG8_LDA(At, 0, 1); PG8_STAGE(PG8_SA(0, 0), a2, voffA);
            PG8_BAR; PG8_WAIT_L(0); PG8_MMA(1, 0, At, B0); PG8_BAR; PG8_SCHED;
            PG8_STAGE(PG8_SB(0, 1), b2 + hstep, voffB);
            PG8_WAIT_V(6); PG8_BAR; PG8_MMA(1, 1, At, B1); PG8_BAR;
            PG8_LDB(B0, 1, 0); PG8_SCHED; PG8_LDA(At, 1, 0); PG8_STAGE(PG8_SA(0, 1), a2 + hstep, voffA);
            PG8_WAIT_L(8); PG8_BAR; PG8_WAIT_L(0); PG8_MMA(0, 0, At, B0); PG8_BAR; PG8_SCHED;
            PG8_LDB(B1, 1, 1); PG8_STAGE(PG8_SB(1, 0), b3, voffB);
            PG8_BAR; PG8_WAIT_L(0); PG8_MMA(0, 1, At, B1); PG8_BAR;
            PG8_LDA(At, 1, 1); PG8_STAGE(PG8_SA(1, 0), a3, voffA);
            PG8_BAR; PG8_WAIT_L(0); PG8_MMA(1, 0, At, B0); PG8_BAR; PG8_SCHED;
            PG8_STAGE(PG8_SB(1, 1), b3 + hstep, voffB);
            PG8_WAIT_V(6); PG8_BAR; PG8_MMA(1, 1, At, B1); PG8_BAR;
            }
        }
        if constexpr (ALIGN_EPI) { if (wr == 0) PG8_BAR; }
        if constexpr (!Epi::AFTER_DRAIN) { E(acc, cur, wr, wc, fr, fq); S.done(cur); }
        if (!has_next) break;
#pragma unroll
        for (int a = 0; a < 2; ++a)
#pragma unroll
            for (int b = 0; b < 2; ++b)
#pragma unroll
                for (int m = 0; m < 4; ++m)
#pragma unroll
                    for (int n = 0; n < 2; ++n) acc[a][b][m][n] = (f32x4){0.f, 0.f, 0.f, 0.f};
        cur = nxt; cA = nA; cB = nB; ++ui;
        if constexpr (ALIGN_EPI) { if (wr == 1) PG8_BAR; }
    }
    PG8_WAIT_V(0);
    if constexpr (!ALIGN_EPI) { if (wr == 0) PG8_BAR; }
    PG8_BAR;
    if constexpr (Epi::AFTER_DRAIN) { E.fused(acc, cur, wr, wc, fr, fq, lds, wid, lane); S.done(cur); }
#undef PG8_SA
#undef PG8_SB
#undef PG8_STAGE
#undef PG8_LDA
#undef PG8_LDB
#undef PG8_MMA
#undef PG8_WAIT_V
#undef PG8_WAIT_L
#undef PG8_BAR
#undef PG8_SCHED
}
}

constexpr int BATCH = 8, T = 2048, D = 1024, M = BATCH * T, MEMLEN = 256, MM = BATCH * MEMLEN;
constexpr int INW = 2616, ZW = 2816;
constexpr int DFF = 2816, NEXP = 8, DFE = 3584;
constexpr float EPS = 1e-6f;
constexpr int Z_AQ = 0, Z_AK = 128, Z_AV = 256, Z_AG = 512, Z_ALR = 768, Z_BU = 784, Z_CQ = 1040, Z_CK = 1296, Z_CV = 1552, Z_CQI = 1808, Z_CKI = 2064, Z_CWI = 2096, Z_DUV = 2104;
constexpr int NWAVES = 8, NTHR = 512;
constexpr int MOE_TP = 34, MOE_NPASS = 4, MOE_MAXT = MOE_TP * MOE_NPASS;
constexpr int MAXSLOT = MOE_MAXT * 256;

constexpr size_t MiB = 1u << 20;
constexpr size_t al(size_t x) { return (x + 4095) & ~(size_t)4095; }
constexpr size_t WS_CTL = 0, CTL_ZERO_BYTES = 1 * MiB;
constexpr size_t WS_SS = 1 * MiB;
constexpr size_t WS_SSM = WS_SS + al((size_t)M * 16 * 4);
constexpr size_t WS_TOKE = WS_SSM + al((size_t)MM * 16 * 4);
constexpr size_t WS_TOKG = WS_TOKE + al((size_t)M * 8);
constexpr size_t WS_TOKR = WS_TOKG + al((size_t)M * 8);
constexpr size_t WS_TOKS = WS_TOKR + al((size_t)M * 4);
constexpr size_t WS_CNT = WS_TOKS + al((size_t)M * 8);
constexpr size_t WS_TILEE = WS_CNT + al(256 * 8 * 4);
constexpr size_t WS_SLOTR = WS_TILEE + al(160 * 4);
constexpr size_t WS_SLOTG = WS_SLOTR + al((size_t)MAXSLOT * 4);
constexpr size_t WS_SWT = al(WS_SLOTG + (size_t)MAXSLOT * 4);
constexpr size_t WS_PWT = WS_SWT + (size_t)2 * 4 * 128 * 128 * 2;
constexpr size_t WS_WIN = al(WS_PWT + (size_t)2 * 4 * 64 * 64 * 2 + MiB);
constexpr size_t SZ_WIN = (size_t)ZW * D * 2, SZ_WOUT = (size_t)D * D * 2, SZ_WQ = (size_t)256 * D * 2, SZ_WKV = (size_t)512 * D * 2, SZ_WO = (size_t)D * 256 * 2;
constexpr size_t WS_WOUT = WS_WIN + 2 * SZ_WIN, WS_WQ = WS_WOUT + 2 * SZ_WOUT, WS_WKV = WS_WQ + 2 * SZ_WQ, WS_WO = WS_WKV + 2 * SZ_WKV;
constexpr size_t WS_W13 = WS_WO + 2 * SZ_WO, WS_W2 = WS_W13 + (size_t)2 * DFF * D * 2, WS_MW13 = WS_W2 + (size_t)D * DFF * 2;
constexpr size_t WS_MW2 = WS_MW13 + (size_t)NEXP * 2 * DFE * D * 2, WS_KVM = WS_MW2 + (size_t)NEXP * D * DFE * 2;
constexpr size_t SZ_KVM = (size_t)MM * 512 * 2;
constexpr size_t WS_MEMB = WS_KVM + 2 * SZ_KVM;
constexpr size_t WS_ACT = al(WS_MEMB + (size_t)MM * D * 2);
constexpr size_t WS_HB = WS_ACT, WS_Z = WS_HB + (size_t)M * D * 2, WS_MIX = WS_Z + (size_t)M * ZW * 2, WS_QX = WS_MIX + (size_t)M * D * 2, WS_OX = WS_QX + (size_t)M * 256 * 2;
constexpr size_t WS_GOI = WS_OX + (size_t)M * 256 * 2, WS_GQT = WS_GOI + (size_t)M * 256 * 4, WS_GKV = WS_GQT + (size_t)M * 128 * 4, WS_GDEC = WS_GKV + (size_t)1024 * 2048 * 4;
constexpr size_t WS_ACT_END = WS_GDEC + (size_t)1024 * 32 * 4;
constexpr size_t WS_FACT = WS_Z;
constexpr size_t WS_MACT = WS_ACT, SZ_MACT = (size_t)MOE_TP * 256 * DFE * 2;
constexpr size_t WS_AG = WS_MACT + SZ_MACT, WS_YS = WS_AG + (size_t)MAXSLOT * D * 2, WS_MOE_END = WS_YS + (size_t)MAXSLOT * D * 2;
static_assert(WS_AG >= WS_HB + (size_t)M * D * 2, "AG must not overlay HB");
static_assert(WS_MOE_END <= WS_ACT_END, "MoE overlays fit");
constexpr size_t WS_END = WS_ACT_END;
constexpr int CW_BAR = 4096;

constexpr int LDS_BYTES = 147456;
constexpr int MISC_OFF = 147456 - 128;
constexpr int SCR_BYTES = MISC_OFF;

#define GAS __attribute__((address_space(1)))
#define LAS __attribute__((address_space(3)))
typedef unsigned short bf16;
typedef unsigned v4u __attribute__((ext_vector_type(4)));
typedef unsigned v2u __attribute__((ext_vector_type(2)));
typedef float f32x4 __attribute__((ext_vector_type(4)));
typedef GAS unsigned gu32;
#define RLX_AGENT __ATOMIC_RELAXED, __HIP_MEMORY_SCOPE_AGENT
#define LDS_WAIT() asm volatile("s_waitcnt lgkmcnt(0)" ::: "memory")
#define LDS_ADD(p, v) (void)__hip_atomic_fetch_add((p), (v), __ATOMIC_RELAXED, __HIP_MEMORY_SCOPE_WORKGROUP)
__device__ __forceinline__ unsigned f2bf(float f) { unsigned u = __builtin_bit_cast(unsigned, f); return (u + 0x7fffu + ((u >> 16) & 1u)) >> 16; }
__device__ __forceinline__ unsigned pk2(float lo, float hi) { return f2bf(lo) | (f2bf(hi) << 16); }
__device__ __forceinline__ float bflo(unsigned w) { return __builtin_bit_cast(float, w << 16); }
__device__ __forceinline__ float bfhi(unsigned w) { return __builtin_bit_cast(float, w & 0xffff0000u); }
__device__ __forceinline__ float bf1(bf16 b) { return __builtin_bit_cast(float, ((unsigned)b) << 16); }
__device__ __forceinline__ float wave_sum(float v) {
#pragma unroll
    for (int o = 1; o < 64; o <<= 1) v += __shfl_xor(v, o);
    return v;
}
__device__ __forceinline__ float wave_max(float v) {
#pragma unroll
    for (int o = 1; o < 64; o <<= 1) v = fmaxf(v, __shfl_xor(v, o));
    return v;
}
#define XB_TMO      128
#define XB_XCNT(j)  (256  + 64 * (j))
#define XB_XSUB(j)  (1280 + 64 * (j))
#define XB_XGEN(j)  (2304 + 64 * (j))
#define XB_TOP      3328
#define XB_TOPGEN   3392
#define XCD_BAR_WORDS 3456
#define XB_SPIN_CAP (1u << 18)

__device__ __forceinline__ unsigned xb_ld(unsigned* p)              { return __hip_atomic_load(p, __ATOMIC_RELAXED, __HIP_MEMORY_SCOPE_AGENT); }
__device__ __forceinline__ unsigned xb_add(unsigned* p, unsigned v) { return __hip_atomic_fetch_add(p, v, __ATOMIC_RELAXED, __HIP_MEMORY_SCOPE_AGENT); }
__device__ __forceinline__ unsigned xb_xcc_id() { return (unsigned)__builtin_amdgcn_s_getreg((3 << 11) | 20) & 0xFu; }
#define XB_SPIN(cond, bar) do { unsigned _sp = 0; while (cond) { __builtin_amdgcn_s_sleep(1); \
    if ((++_sp & 255u) == 0u) { if (xb_ld(&(bar)[XB_TMO])) break; if (_sp > XB_SPIN_CAP) { atomicAdd(&(bar)[XB_TMO], 1u); break; } } } } while (0)

struct XcdBarrier {
    unsigned* bar; unsigned x;
    volatile LAS unsigned* st;
};

__device__ __forceinline__ XcdBarrier xcd_barrier_post(unsigned* bar, volatile LAS unsigned* st) {
    XcdBarrier b; b.bar = bar; b.x = xb_xcc_id(); b.st = st;
    if (threadIdx.x == 0) (void)xb_add(&bar[XB_XCNT(b.x)], 1u);
    return b;
}
__device__ __forceinline__ void xcd_barrier_complete(unsigned* bar, unsigned x, unsigned& nloc, unsigned& nx) {
    const unsigned G = gridDim.x * gridDim.y * gridDim.z;
    unsigned sum, cnt, mine, sp = 0u;
    for (;;) {
        sum = 0u; cnt = 0u; mine = 0u;
#pragma unroll
        for (unsigned j = 0; j < 16; ++j) { const unsigned c = xb_ld(&bar[XB_XCNT(j)]); sum += c; cnt += (c > 0u) ? 1u : 0u; mine = (j == x) ? c : mine; }
        if (sum == G) break;
        __builtin_amdgcn_s_sleep(1);
        if ((++sp & 255u) == 0u) { if (xb_ld(&bar[XB_TMO])) break; if (sp > XB_SPIN_CAP) { atomicAdd(&bar[XB_TMO], 1u); break; } }
    }
    nloc = mine > 0u ? mine : 1u; nx = cnt > 0u ? cnt : 1u;
}

__device__ __forceinline__ void xcd_barrier(const XcdBarrier& b) {
    asm volatile("s_waitcnt vmcnt(0)" ::: "memory");
    __syncthreads();
    if (threadIdx.x == 0) {
        unsigned* bar = b.bar;
        __builtin_amdgcn_s_waitcnt(0);
        unsigned nloc = b.st[0], nx = b.st[1];
        if (nloc == 0u) { xcd_barrier_complete(bar, b.x, nloc, nx); b.st[0] = nloc; b.st[1] = nx; }
        const unsigned old = xb_add(&bar[XB_XSUB(b.x)], 1u);
        const unsigned gen = old / nloc;
        if (old + 1u == (gen + 1u) * nloc) {
            __builtin_amdgcn_fence(__ATOMIC_RELEASE, "agent");
            asm volatile("s_waitcnt vmcnt(0)" ::: "memory");
            const unsigned og = xb_add(&bar[XB_TOP], 1u);
            const unsigned tg = og / nx;
            if (og + 1u == (tg + 1u) * nx) xb_add(&bar[XB_TOPGEN], 1u);
            else XB_SPIN(xb_ld(&bar[XB_TOPGEN]) == tg, bar);
            __builtin_amdgcn_fence(__ATOMIC_ACQUIRE, "agent");
            xb_add(&bar[XB_XGEN(b.x)], 1u);
            asm volatile("s_waitcnt vmcnt(0)" ::: "memory");
        } else {
            XB_SPIN(xb_ld(&bar[XB_XGEN(b.x)]) == gen, bar);
            __builtin_amdgcn_fence(__ATOMIC_ACQUIRE, "agent");
            asm volatile("s_waitcnt vmcnt(0)" ::: "memory");
        }
    }
    __syncthreads();
}

enum { IN_X = 0, IN_MEM, IN_RELB, IN_FNORM, IN_NMIX, IN_WIN, IN_WA2, IN_BA, IN_GNORM, IN_PW, IN_PB, IN_PS, IN_LNG, IN_LNB, IN_SW, IN_SB, IN_WOUT,
       IN_NXA, IN_NMEM, IN_WQ, IN_WKV, IN_WO, IN_NFFN, IN_F1, IN_F3, IN_F2, IN_ROUTER, IN_M1, IN_M3, IN_M2, N_IN };
struct Args { const float* in[N_IN]; float* out; unsigned char* ws; int ph_lo, ph_hi; };

__device__ __forceinline__ float rstd16(const float* ss, int row) {
    const f32x4* p = (const f32x4*)(ss + (size_t)row * 16);
    const f32x4 a = p[0], b = p[1], c = p[2], d = p[3];
    const float s = (((a.x + a.y) + (a.z + a.w)) + ((b.x + b.y) + (b.z + b.w))) + (((c.x + c.y) + (c.z + c.w)) + ((d.x + d.y) + (d.z + d.w)));
    return rsqrtf(s * (1.0f / 1024.0f) + EPS);
}
__device__ __forceinline__ v4u pack8(const f32x4 a, const f32x4 b) { v4u w; w.x = pg8::cvt_pk_bf16(a.x, a.y); w.y = pg8::cvt_pk_bf16(a.z, a.w); w.z = pg8::cvt_pk_bf16(b.x, b.y); w.w = pg8::cvt_pk_bf16(b.z, b.w); return w; }

struct EpiScale {
    static constexpr bool PERM = true, AFTER_DRAIN = false;
    bf16* O; int ldc; const float* ss; float scale;
    __device__ __forceinline__ void operator()(const pg8::f32x4 (&acc)[2][2][4][2], const pg8::Unit& u, int wr, int wc, int fr, int fq) const {
        const int row0 = u.po * 256 + wr * 64 + fr, col0 = u.e * 256 + wc * 32 + 8 * fq;
#pragma unroll
        for (int ai = 0; ai < 2; ++ai)
#pragma unroll
            for (int m = 0; m < 4; ++m) { const int row = row0 + ai * 128 + m * 16; const float r = rstd16(ss, row) * scale; bf16* rowp = O + (size_t)row * ldc + col0;
#pragma unroll
                for (int bj = 0; bj < 2; ++bj) *(v4u*)(rowp + bj * 128) = pack8(acc[ai][bj][m][0] * r, acc[ai][bj][m][1] * r); }
    }
};
struct EpiResid {
    static constexpr bool PERM = true, AFTER_DRAIN = false;
    const float* res; float* H; bf16* HB; float* SS;
    __device__ __forceinline__ void operator()(const pg8::f32x4 (&acc)[2][2][4][2], const pg8::Unit& u, int wr, int wc, int fr, int fq) const {
        const int row0 = u.po * 256 + wr * 64 + fr, col0 = u.e * 256 + wc * 32 + 8 * fq;
#pragma unroll
        for (int ai = 0; ai < 2; ++ai)
#pragma unroll
            for (int m = 0; m < 4; ++m) { const int row = row0 + ai * 128 + m * 16; const size_t off = (size_t)row * D + col0; float q = 0.f;
#pragma unroll
                for (int bj = 0; bj < 2; ++bj) {
                    const f32x4 r0 = *(const f32x4*)(res + off + bj * 128), r1 = *(const f32x4*)(res + off + bj * 128 + 4);
                    const f32x4 v0 = acc[ai][bj][m][0] + r0, v1 = acc[ai][bj][m][1] + r1;
                    *(f32x4*)(H + off + bj * 128) = v0; *(f32x4*)(H + off + bj * 128 + 4) = v1;
                    *(v4u*)(HB + off + bj * 128) = pack8(v0, v1);
                    q += ((v0.x * v0.x + v0.y * v0.y) + (v0.z * v0.z + v0.w * v0.w)) + ((v1.x * v1.x + v1.y * v1.y) + (v1.z * v1.z + v1.w * v1.w)); }
                q += __shfl_xor(q, 16); q += __shfl_xor(q, 32);
                if (fq == 0) SS[(size_t)row * 16 + u.e * 4 + wc] = q; }
    }
};
__device__ __forceinline__ float silu_f(float x) { return x * __builtin_amdgcn_rcpf(1.0f + __expf(-x)); }
template <bool MOE> struct EpiSwiglu {
    static constexpr bool PERM = true, AFTER_DRAIN = false;
    bf16* O; int ldc; const float* ss; const float* slot_r; const float* slot_g;
    __device__ __forceinline__ void operator()(const pg8::f32x4 (&acc)[2][2][4][2], const pg8::Unit& u, int wr, int wc, int fr, int fq) const {
        const int rin0 = u.pm * 256 + wr * 64 + fr, rout0 = u.po * 256 + wr * 64 + fr, col0 = u.e * 128 + wc * 32 + 8 * fq;
#pragma unroll
        for (int ai = 0; ai < 2; ++ai)
#pragma unroll
            for (int m = 0; m < 4; ++m) { const int rin = rin0 + ai * 128 + m * 16, rout = rout0 + ai * 128 + m * 16;
                float r, gt; if (MOE) { r = slot_r[rin]; gt = slot_g[rin]; } else { r = rstd16(ss, rin); gt = 1.0f; }
                f32x4 o0, o1;
#pragma unroll
                for (int j = 0; j < 4; ++j) { o0[j] = silu_f(acc[ai][0][m][0][j] * r) * (acc[ai][1][m][0][j] * r) * gt; o1[j] = silu_f(acc[ai][0][m][1][j] * r) * (acc[ai][1][m][1][j] * r) * gt; }
                *(v4u*)(O + (size_t)rout * ldc + col0) = pack8(o0, o1); }
    }
};
struct EpiPlain {
    static constexpr bool PERM = true, AFTER_DRAIN = false;
    bf16* O; int ldc;
    __device__ __forceinline__ void operator()(const pg8::f32x4 (&acc)[2][2][4][2], const pg8::Unit& u, int wr, int wc, int fr, int fq) const {
        const int row0 = u.po * 256 + wr * 64 + fr, col0 = u.e * 256 + wc * 32 + 8 * fq;
#pragma unroll
        for (int ai = 0; ai < 2; ++ai)
#pragma unroll
            for (int m = 0; m < 4; ++m) { bf16* rowp = O + (size_t)(row0 + ai * 128 + m * 16) * ldc + col0;
#pragma unroll
                for (int bj = 0; bj < 2; ++bj) *(v4u*)(rowp + bj * 128) = pack8(acc[ai][bj][m][0], acc[ai][bj][m][1]); }
    }
};

__device__ __forceinline__ void tr_item(const float* W, int N, int K, int k0, int n0, const float* gain, bf16* WT, long dst_row0, LAS float* scr, int lane) {
    const int nn = n0 + lane; const bool ok = nn < N; const float* wp = W + (size_t)k0 * N + (ok ? nn : 0);
    float v[64];
#pragma unroll
    for (int i = 0; i < 64; ++i) v[i] = wp[(size_t)i * N];
#pragma unroll
    for (int i = 0; i < 64; ++i) { float x = ok ? v[i] : 0.f; if (gain) x *= gain[k0 + i]; scr[i * 65 + lane] = x; }
    LDS_WAIT(); asm volatile("" ::: "memory");
    const int c = lane & 7;
#pragma unroll
    for (int j = 0; j < 8; ++j) { const int n = (lane >> 3) + 8 * j; const LAS float* s = scr + (8 * c) * 65 + n;
        v4u o; o.x = pk2(s[0 * 65], s[1 * 65]); o.y = pk2(s[2 * 65], s[3 * 65]); o.z = pk2(s[4 * 65], s[5 * 65]); o.w = pk2(s[6 * 65], s[7 * 65]);
        if (n0 + n < N) *(v4u*)(WT + (size_t)(dst_row0 + n) * K + k0 + 8 * c) = o; }
    LDS_WAIT(); asm volatile("" ::: "memory");
}
__device__ __forceinline__ void conv_job(const float* W, int K, int N, const float* gain, bf16* WT, int mode, LAS float* scr, int gw, int NGW, int lane, long& base) {
    const int nblk = (N + 63) / 64, nitems = (K / 64) * nblk;
    const int first = (int)(((long)gw - (base % NGW) + NGW) % NGW);
    for (int it = first; it < nitems; it += NGW) {
        const int kb = it / nblk, nb = it % nblk, k0 = 64 * kb, n0 = 64 * nb;
        const long dr = (mode == 0) ? (long)n0 : (long)(n0 >> 7) * 256 + (n0 & 127) + (mode == 2 ? 128 : 0);
        tr_item(W, N, K, k0, n0, gain, WT, dr, scr, lane);
    }
    base += nitems;
}
__device__ __forceinline__ void row_cvt(const float* xrow, bf16* orow, float* ssrow, int lane) {
    const f32x4* xr = (const f32x4*)xrow + lane; f32x4 v[4]; float s = 0.f;
#pragma unroll
    for (int j = 0; j < 4; ++j) { v[j] = xr[64 * j]; s += (v[j].x * v[j].x + v[j].y * v[j].y) + (v[j].z * v[j].z + v[j].w * v[j].w); }
    s = wave_sum(s);
    v2u* o8 = (v2u*)orow + lane;
#pragma unroll
    for (int j = 0; j < 4; ++j) { v2u w; w.x = pk2(v[j].x, v[j].y); w.y = pk2(v[j].z, v[j].w); o8[64 * j] = w; }
    if (lane < 16) ssrow[lane] = lane == 0 ? s : 0.f;
}
__device__ __forceinline__ void p0_prologue(const Args& a, LAS unsigned char* lds, int tid, int G) {
    const int lane = tid & 63, wave = tid >> 6, gw = blockIdx.x * NWAVES + wave, NGW = G * NWAVES;
    LAS float* scr = (LAS float*)(lds + wave * 16640);
    unsigned char* ws = a.ws; long base = 0;
    for (int l = 0; l < 2; ++l) {
        conv_job(a.in[IN_WIN] + (size_t)l * D * INW, D, INW, a.in[IN_NMIX] + l * D, (bf16*)(ws + WS_WIN + l * SZ_WIN), 0, scr, gw, NGW, lane, base);
        conv_job(a.in[IN_WOUT] + (size_t)l * D * D, D, D, nullptr, (bf16*)(ws + WS_WOUT + l * SZ_WOUT), 0, scr, gw, NGW, lane, base);
        conv_job(a.in[IN_WQ] + (size_t)l * D * 256, D, 256, a.in[IN_NXA] + l * D, (bf16*)(ws + WS_WQ + l * SZ_WQ), 0, scr, gw, NGW, lane, base);
        conv_job(a.in[IN_WKV] + (size_t)l * D * 512, D, 512, a.in[IN_NMEM] + l * D, (bf16*)(ws + WS_WKV + l * SZ_WKV), 0, scr, gw, NGW, lane, base);
        conv_job(a.in[IN_WO] + (size_t)l * 256 * D, 256, D, nullptr, (bf16*)(ws + WS_WO + l * SZ_WO), 0, scr, gw, NGW, lane, base);
        { v4u* zp = (v4u*)(ws + WS_WIN + l * SZ_WIN + (size_t)INW * D * 2); const int n16 = (ZW - INW) * D * 2 / 16;
          for (int i = blockIdx.x * NTHR + tid; i < n16; i += G * NTHR) zp[i] = (v4u){0u, 0u, 0u, 0u}; }
    }
    conv_job(a.in[IN_F1], D, DFF, a.in[IN_NFFN], (bf16*)(ws + WS_W13), 1, scr, gw, NGW, lane, base);
    conv_job(a.in[IN_F3], D, DFF, a.in[IN_NFFN], (bf16*)(ws + WS_W13), 2, scr, gw, NGW, lane, base);
    conv_job(a.in[IN_F2], DFF, D, nullptr, (bf16*)(ws + WS_W2), 0, scr, gw, NGW, lane, base);
    for (int e = 0; e < NEXP; ++e) {
        conv_job(a.in[IN_M1] + (size_t)e * D * DFE, D, DFE, a.in[IN_NFFN] + D, (bf16*)(ws + WS_MW13) + (size_t)e * 2 * DFE * D, 1, scr, gw, NGW, lane, base);
        conv_job(a.in[IN_M3] + (size_t)e * D * DFE, D, DFE, a.in[IN_NFFN] + D, (bf16*)(ws + WS_MW13) + (size_t)e * 2 * DFE * D, 2, scr, gw, NGW, lane, base);
        conv_job(a.in[IN_M2] + (size_t)e * DFE * D, DFE, D, nullptr, (bf16*)(ws + WS_MW2) + (size_t)e * D * DFE, 0, scr, gw, NGW, lane, base);
    }
    for (int i = blockIdx.x * NTHR + tid; i < 2 * 4 * 128 * 128; i += G * NTHR) { const int s = i & 127, t = (i >> 7) & 127; ((bf16*)(ws + WS_SWT))[i] = (bf16)f2bf(s <= t ? a.in[IN_SW][i] : 0.f); }
    for (int i = blockIdx.x * NTHR + tid; i < 2 * 4 * 64 * 64; i += G * NTHR) { const int c = i & 63, d = (i >> 6) & 63, lg = i >> 12; ((bf16*)(ws + WS_PWT))[i] = (bf16)f2bf(a.in[IN_PW][(size_t)lg * 4096 + c * 64 + d]); }
    for (int m = gw; m < M; m += NGW) row_cvt(a.in[IN_X] + (size_t)m * D, (bf16*)(ws + WS_HB) + (size_t)m * D, (float*)(ws + WS_SS) + (size_t)m * 16, lane);
    for (int m = gw; m < MM; m += NGW) row_cvt(a.in[IN_MEM] + (size_t)m * D, (bf16*)(ws + WS_MEMB) + (size_t)m * D, (float*)(ws + WS_SSM) + (size_t)m * 16, lane);
}

__device__ __forceinline__ float gelu_tanh(float x) { return 0.5f * x * (1.0f + tanhf(0.7978845608028654f * (x + 0.044715f * x * x * x))); }

__device__ __forceinline__ void gla_a_item(const Args& a, int l, int item, LAS unsigned char* lds, int tid) {
    const int n = item & 31, h = (item >> 5) & 3, b = item >> 7, tok0 = b * T + n * 64;
    LAS float* alr = (LAS float*)lds;
    LAS float* wa = alr + 64 * 16;
    LAS float* bb = wa + 16 * 32;
    LAS float* qt = bb + 64 * 33;
    LAS float* kt = qt + 64 * 33;
    LAS float* kd = kt + 64 * 33;
    LAS float* vv = kd + 64 * 33;
    LAS float* att = vv + 64 * 64;
    LAS float* bav = att + 64 * 65;
    const bf16* z = (const bf16*)(a.ws + WS_Z);
    float* OI = (float*)(a.ws + WS_GOI); float* QT = (float*)(a.ws + WS_GQT); float* KV = (float*)(a.ws + WS_GKV); float* DEC = (float*)(a.ws + WS_GDEC);
    for (int i = tid; i < 1024; i += NTHR) alr[i] = bf1(z[(size_t)(tok0 + (i >> 4)) * ZW + Z_ALR + (i & 15)]);
    { const int r = tid >> 5, k = tid & 31; wa[tid] = a.in[IN_WA2][(size_t)l * 16 * 128 + r * 128 + h * 32 + k]; }
    if (tid < 32) bav[tid] = a.in[IN_BA][l * 128 + h * 32 + tid];
    for (int i = tid; i < 4096; i += NTHR) vv[i] = bf1(z[(size_t)(tok0 + (i >> 6)) * ZW + Z_AV + h * 64 + (i & 63)]);
    __syncthreads();
    for (int i = tid; i < 2048; i += NTHR) { const int c = i >> 5, k = i & 31; float x = bav[k];
#pragma unroll
        for (int r = 0; r < 16; ++r) x += alr[c * 16 + r] * wa[r * 32 + k];
        const float ls = fminf(x, 0.f) - log1pf(expf(-fabsf(x)));
        bb[c * 33 + k] = ls * (1.0f / 16.0f); }
    __syncthreads();
    if (tid < 32) { float run = 0.f; for (int c = 0; c < 64; ++c) { run += bb[c * 33 + tid]; bb[c * 33 + tid] = run; } }
    __syncthreads();
    for (int i = tid; i < 2048; i += NTHR) { const int c = i >> 5, k = i & 31; const float bv = bb[c * 33 + k], bl = bb[63 * 33 + k];
        const float q = bf1(z[(size_t)(tok0 + c) * ZW + Z_AQ + h * 32 + k]), kk = bf1(z[(size_t)(tok0 + c) * ZW + Z_AK + h * 32 + k]);
        const float qv = q * 0.17677669529663687f * expf(bv);
        qt[c * 33 + k] = qv; kt[c * 33 + k] = kk * expf(-bv); kd[c * 33 + k] = kk * expf(bl - bv);
        QT[(size_t)(tok0 + c) * 128 + h * 32 + k] = qv; }
    if (tid < 32) DEC[(size_t)item * 32 + tid] = expf(bb[63 * 33 + tid]);
    __syncthreads();
    for (int idx = tid; idx < 4096; idx += NTHR) { const int i = idx >> 6, j = idx & 63; float s = 0.f;
        if (j <= i) {
#pragma unroll 8
            for (int k = 0; k < 32; ++k) s += qt[i * 33 + k] * kt[j * 33 + k]; }
        att[i * 65 + j] = s; }
    __syncthreads();
    for (int idx = tid; idx < 4096; idx += NTHR) { const int i = idx >> 6, v = idx & 63; float s = 0.f;
#pragma unroll 8
        for (int j = 0; j < 64; ++j) s += att[i * 65 + j] * vv[j * 64 + v];
        OI[(size_t)(tok0 + i) * 256 + h * 64 + v] = s; }
    for (int idx = tid; idx < 2048; idx += NTHR) { const int k = idx >> 6, v = idx & 63; float s = 0.f;
#pragma unroll 8
        for (int c = 0; c < 64; ++c) s += kd[c * 33 + k] * vv[c * 64 + v];
        KV[(size_t)item * 2048 + idx] = s; }
    __syncthreads();
}
__device__ __forceinline__ void gla_c_item(const Args& a, int l, int item, LAS unsigned char* lds, int tid) {
    const int n = item & 31, h = (item >> 5) & 3, b = item >> 7, tok0 = b * T + n * 64, lane = tid & 63, w = tid >> 6;
    LAS float* S = (LAS float*)lds;
    LAS float* ql = S + 2048;
    const bf16* z = (const bf16*)(a.ws + WS_Z); bf16* mix = (bf16*)(a.ws + WS_MIX);
    const float* OI = (const float*)(a.ws + WS_GOI); const float* QT = (const float*)(a.ws + WS_GQT); const float* KV = (const float*)(a.ws + WS_GKV); const float* DEC = (const float*)(a.ws + WS_GDEC);
    for (int e = tid; e < 2048; e += NTHR) { const int k = e >> 6; float s = 0.f;
        for (int m = 0; m < n; ++m) { const size_t it = (size_t)(item - n + m); s = s * DEC[it * 32 + k] + KV[it * 2048 + e]; }
        S[e] = s; }
    for (int i = tid; i < 2048; i += NTHR) ql[(i >> 5) * 33 + (i & 31)] = QT[(size_t)(tok0 + (i >> 5)) * 128 + h * 32 + (i & 31)];
    __syncthreads();
    for (int j = 0; j < 8; ++j) { const int i = w + 8 * j; float o = OI[(size_t)(tok0 + i) * 256 + h * 64 + lane];
#pragma unroll 8
        for (int k = 0; k < 32; ++k) o += ql[i * 33 + k] * S[k * 64 + lane];
        const float ms = wave_sum(o * o) * (1.0f / 64.0f);
        float y = o * rsqrtf(ms + EPS) * a.in[IN_GNORM][l * 256 + h * 64 + lane];
        const float g = bf1(z[(size_t)(tok0 + i) * ZW + Z_AG + h * 64 + lane]);
        y *= g / (1.0f + expf(-g));
        mix[(size_t)(tok0 + i) * D + h * 64 + lane] = (bf16)f2bf(y); }
    __syncthreads();
}
__device__ __forceinline__ void pool_item(const Args& a, int l, int item, LAS unsigned char* lds, int tid) {
    const int g = item & 3, tt = (item >> 2) & 31, b = item >> 7, t0 = tt * 64;
    LAS float* u = (LAS float*)lds;
    LAS float* w = u + 79 * 64;
    LAS float* p = w + 4096;
    const bf16* z = (const bf16*)(a.ws + WS_Z); bf16* mix = (bf16*)(a.ws + WS_MIX);
    for (int i = tid; i < 79 * 64; i += NTHR) { const int t = t0 - 15 + (i >> 6); u[i] = t >= 0 ? bf1(z[(size_t)(b * T + t) * ZW + Z_BU + g * 64 + (i & 63)]) : 0.f; }
    for (int i = tid; i < 4096; i += NTHR) w[i] = a.in[IN_PW][(size_t)(l * 4 + g) * 4096 + i];
    __syncthreads();
    const int win = 2 << g;
    for (int i = tid; i < 4096; i += NTHR) { const int tl = i >> 6, c = i & 63, t = t0 + tl, cnt = (t + 1 < win) ? t + 1 : win; float s = 0.f;
        for (int j = 0; j < cnt; ++j) s += u[(tl + 15 - j) * 64 + c];
        p[tl * 65 + c] = s / (float)cnt - u[(tl + 15) * 64 + c]; }
    __syncthreads();
    for (int i = tid; i < 4096; i += NTHR) { const int tl = i >> 6, d = i & 63; float s = a.in[IN_PB][(l * 4 + g) * 64 + d];
#pragma unroll 8
        for (int c = 0; c < 64; ++c) s += p[tl * 65 + c] * w[c * 64 + d];
        s *= a.in[IN_PS][l * 256 + g * 64 + d];
        mix[(size_t)(b * T + t0 + tl) * D + 256 + g * 64 + d] = (bf16)f2bf(s); }
    __syncthreads();
}
__device__ __forceinline__ void sgu_item(const Args& a, int l, int item, LAS unsigned char* lds, int tid) {
    const int g = item & 3, nc = (item >> 2) & 15, b = item >> 6, tok0 = b * T + nc * 128, lane = tid & 63, w = tid >> 6;
    LAS float* vn = (LAS float*)lds;
    const bf16* z = (const bf16*)(a.ws + WS_Z); bf16* mix = (bf16*)(a.ws + WS_MIX);
    for (int j = 0; j < 16; ++j) { const int s = w + 8 * j;
        const v2u raw = *(const v2u*)(z + (size_t)(tok0 + s) * ZW + Z_DUV + 256 + 4 * lane);
        float x[4] = {gelu_tanh(bflo(raw.x)), gelu_tanh(bfhi(raw.x)), gelu_tanh(bflo(raw.y)), gelu_tanh(bfhi(raw.y))};
        const float mu = wave_sum((x[0] + x[1]) + (x[2] + x[3])) * (1.0f / 256.0f);
        float q = 0.f;
#pragma unroll
        for (int i = 0; i < 4; ++i) { x[i] -= mu; q += x[i] * x[i]; }
        const float rstd = rsqrtf(wave_sum(q) * (1.0f / 256.0f) + EPS);
        if ((lane >> 4) == g) {
#pragma unroll
            for (int i = 0; i < 4; ++i) { const int cl = 4 * (lane & 15) + i; vn[s * 64 + cl] = x[i] * rstd * a.in[IN_LNG][l * 256 + g * 64 + cl] + a.in[IN_LNB][l * 256 + g * 64 + cl]; } } }
    __syncthreads();
    const float* sw = a.in[IN_SW] + (size_t)(l * 4 + g) * 128 * 128;
    for (int j = 0; j < 16; ++j) { const int t = w + 8 * j; float acc = a.in[IN_SB][(l * 4 + g) * 128 + t];
        const float* swr = sw + t * 128;
        for (int s = 0; s <= t; ++s) acc += swr[s] * vn[s * 64 + lane];
        const float uu = gelu_tanh(bf1(z[(size_t)(tok0 + t) * ZW + Z_DUV + g * 64 + lane]));
        mix[(size_t)(tok0 + t) * D + 768 + g * 64 + lane] = (bf16)f2bf(uu * acc); }
    __syncthreads();
}
__device__ __forceinline__ void xattn_item(const Args& a, int l, int item, LAS unsigned char* lds, int tid) {
    const int qtile = item & 31, h = (item >> 5) & 3, b = item >> 7, lane = tid & 63, w = tid >> 6;
    LAS float* Ks = (LAS float*)lds;
    LAS float* Vs = Ks + 256 * 65;
    LAS float* qs = Vs + 256 * 64;
    LAS float* pw = qs + 512;
    const bf16* kvm = (const bf16*)(a.ws + WS_KVM + (size_t)l * SZ_KVM); const bf16* qx = (const bf16*)(a.ws + WS_QX); bf16* ox = (bf16*)(a.ws + WS_OX);
    for (int i = tid; i < 16384; i += NTHR) { const int key = i >> 6, d = i & 63; const size_t o = (size_t)(b * MEMLEN + key) * 512 + h * 64 + d;
        Ks[key * 65 + d] = bf1(kvm[o]); Vs[key * 64 + d] = bf1(kvm[o + 256]); }
    __syncthreads();
    for (int qq = 0; qq < 8; ++qq) { const int row = b * T + qtile * 64 + w * 8 + qq;
        qs[w * 64 + lane] = bf1(qx[(size_t)row * 256 + h * 64 + lane]);
        LDS_WAIT(); asm volatile("" ::: "memory");
        float s[4] = {0.f, 0.f, 0.f, 0.f};
        for (int d = 0; d < 64; ++d) { const float qd = qs[w * 64 + d];
#pragma unroll
            for (int j = 0; j < 4; ++j) s[j] += qd * Ks[(lane + 64 * j) * 65 + d]; }
        const float mx = wave_max(fmaxf(fmaxf(s[0], s[1]), fmaxf(s[2], s[3])));
        float e[4], sum = 0.f;
#pragma unroll
        for (int j = 0; j < 4; ++j) { e[j] = expf(s[j] - mx); sum += e[j]; }
        const float inv = 1.0f / wave_sum(sum);
#pragma unroll
        for (int j = 0; j < 4; ++j) pw[w * 256 + lane + 64 * j] = e[j] * inv;
        LDS_WAIT(); asm volatile("" ::: "memory");
        float o = 0.f;
        for (int key = 0; key < 256; ++key) o += pw[w * 256 + key] * Vs[key * 64 + lane];
        ox[(size_t)row * 256 + h * 64 + lane] = (bf16)f2bf(o);
        LDS_WAIT(); asm volatile("" ::: "memory"); }
    __syncthreads();
}

__device__ __forceinline__ unsigned ord_u(float f) { const unsigned u = __builtin_bit_cast(unsigned, f); return (u & 0x80000000u) ? ~u : (u | 0x80000000u); }
__device__ __forceinline__ int rel_bucket(int n) {
    if (n < 16) return n;
    int large = 16 + (int)(logf((float)n / 16.0f) / logf(8.0f) * 16.0f);
    return large < 31 ? large : 31;
}
__device__ __forceinline__ void dsa_setup(const Args& a, LAS unsigned char* lds, int tid) {
    LAS float* biasd = (LAS float*)(lds + 48 * 1024);
    for (int i = tid; i < 129 * 4; i += NTHR) { const int d = i >> 2, h = i & 3; biasd[i] = a.in[IN_RELB][rel_bucket(d) * 4 + h]; }
    __syncthreads();
}
__device__ __forceinline__ void dsa_item(const Args& a, int item, LAS unsigned char* lds, int tid, bf16* outp, int ostride) {
    const int b = item / T, t = item % T, nk = t + 1, lane = tid & 63, w = tid >> 6;
    LAS unsigned* su = (LAS unsigned*)lds;
    LAS float* lg = (LAS float*)(lds + 8192);
    LAS float* qi = (LAS float*)(lds + 8192 + 32768);
    LAS float* qv = qi + 256;
    LAS float* wi = qv + 256;
    LAS unsigned* cnt = (LAS unsigned*)(wi + 8);
    LAS float* red = (LAS float*)(cnt + 40);
    LAS float* red2 = red + 64;
    LAS float* biasd = (LAS float*)(lds + 48 * 1024);
    const bf16* z = (const bf16*)(a.ws + WS_Z);
    const size_t row = (size_t)b * T + t;
    if (tid < 256) { qi[tid] = bf1(z[row * ZW + Z_CQI + tid]) * 0.17677669529663687f; qv[tid] = bf1(z[row * ZW + Z_CQ + tid]) * 0.125f; }
    if (tid < 8) wi[tid] = bf1(z[row * ZW + Z_CWI + tid]) * 0.35355339059327373f;
    if (tid < 40) cnt[tid] = 0u;
    __syncthreads();
    unsigned myu[4];
#pragma unroll
    for (int j = 0; j < 4; ++j) { const int key = tid + NTHR * j; myu[j] = 0u;
        if (key < nk) { const v4u* kp = (const v4u*)(z + ((size_t)b * T + key) * ZW + Z_CKI); float kf[32];
#pragma unroll
            for (int i = 0; i < 4; ++i) { const v4u r = kp[i]; kf[8 * i + 0] = bflo(r.x); kf[8 * i + 1] = bfhi(r.x); kf[8 * i + 2] = bflo(r.y); kf[8 * i + 3] = bfhi(r.y); kf[8 * i + 4] = bflo(r.z); kf[8 * i + 5] = bfhi(r.z); kf[8 * i + 6] = bflo(r.w); kf[8 * i + 7] = bfhi(r.w); }
            float sc = 0.f;
            for (int hh = 0; hh < 8; ++hh) { float dot = 0.f;
#pragma unroll
                for (int d = 0; d < 32; ++d) dot += qi[hh * 32 + d] * kf[d];
                sc += fmaxf(dot, 0.f) * wi[hh]; }
            sc += 0.0f;
            myu[j] = ord_u(sc); su[key] = myu[j]; } }
    __syncthreads();
    bool sel[4];
#pragma unroll
    for (int j = 0; j < 4; ++j) sel[j] = (tid + NTHR * j) < nk;
    if (nk > 256) {
        unsigned Tt = 0u;
        for (int bit = 31; bit >= 0; --bit) { const unsigned cand = Tt | (1u << bit); int c = 0;
#pragma unroll
            for (int j = 0; j < 4; ++j) c += (myu[j] >= cand) ? 1 : 0;
            c = (int)wave_sum((float)c);
            if (lane == 0 && c) LDS_ADD(&cnt[bit], (unsigned)c);
            __syncthreads();
            if (cnt[bit] >= 256u) Tt = cand; }
        { int c = 0;
#pragma unroll
            for (int j = 0; j < 4; ++j) c += (myu[j] > Tt) ? 1 : 0;
            c = (int)wave_sum((float)c);
            if (lane == 0 && c) LDS_ADD(&cnt[32], (unsigned)c);
            __syncthreads(); }
        const int r = 256 - (int)cnt[32];
#pragma unroll
        for (int j = 0; j < 4; ++j) { const int key = tid + NTHR * j;
            if (myu[j] > Tt) sel[j] = true;
            else if (myu[j] == Tt && key < nk) { int rank = 0; for (int s = 0; s < key; ++s) rank += (su[s] == Tt) ? 1 : 0; sel[j] = rank < r; }
            else sel[j] = false; }
    }
    float lmax[4] = {-INFINITY, -INFINITY, -INFINITY, -INFINITY};
#pragma unroll
    for (int j = 0; j < 4; ++j) { const int key = tid + NTHR * j;
        if (key < nk) {
            float lv[4] = {-INFINITY, -INFINITY, -INFINITY, -INFINITY};
            if (sel[j]) { const v4u* kp = (const v4u*)(z + ((size_t)b * T + key) * ZW + Z_CK); const int dd = (t - key) < 128 ? (t - key) : 128;
#pragma unroll
                for (int hh = 0; hh < 4; ++hh) { float dot = 0.f;
#pragma unroll
                    for (int i = 0; i < 8; ++i) { const v4u r = kp[hh * 8 + i]; const LAS float* qq = qv + hh * 64 + 8 * i;
                        dot += qq[0] * bflo(r.x) + qq[1] * bfhi(r.x) + qq[2] * bflo(r.y) + qq[3] * bfhi(r.y) + qq[4] * bflo(r.z) + qq[5] * bfhi(r.z) + qq[6] * bflo(r.w) + qq[7] * bfhi(r.w); }
                    lv[hh] = dot + biasd[dd * 4 + hh]; lmax[hh] = fmaxf(lmax[hh], lv[hh]); } }
#pragma unroll
            for (int hh = 0; hh < 4; ++hh) lg[hh * 2048 + key] = lv[hh]; } }
#pragma unroll
    for (int hh = 0; hh < 4; ++hh) { const float m = wave_max(lmax[hh]); if (lane == 0) red[w * 4 + hh] = m; }
    __syncthreads();
    float mx[4], lsum[4] = {0.f, 0.f, 0.f, 0.f};
#pragma unroll
    for (int hh = 0; hh < 4; ++hh) { float m = red[hh]; for (int ww = 1; ww < 8; ++ww) m = fmaxf(m, red[ww * 4 + hh]); mx[hh] = m; }
#pragma unroll
    for (int j = 0; j < 4; ++j) { const int key = tid + NTHR * j;
        if (key < nk) {
#pragma unroll
            for (int hh = 0; hh < 4; ++hh) { const float lv = lg[hh * 2048 + key]; const float p = (lv == -INFINITY) ? 0.f : expf(lv - mx[hh]); lg[hh * 2048 + key] = p; lsum[hh] += p; } } }
#pragma unroll
    for (int hh = 0; hh < 4; ++hh) { const float s = wave_sum(lsum[hh]); if (lane == 0) red[32 + w * 4 + hh] = s; }
    __syncthreads();
    { const int half = tid >> 8, hd = tid & 255, hh = hd >> 6; float acc = 0.f;
      const bf16* vp = z + (size_t)b * T * ZW + Z_CV + hd;
      for (int key = half; key < nk; key += 2) { const float p = lg[hh * 2048 + key]; if (p != 0.f) acc += p * bf1(vp[(size_t)key * ZW]); }
      red2[tid] = acc; }
    __syncthreads();
    if (tid < 256) { const int hh = tid >> 6; float s = 0.f; for (int ww = 0; ww < 8; ++ww) s += red[32 + ww * 4 + hh];
        outp[row * ostride + tid] = (bf16)f2bf((red2[tid] + red2[tid + 256]) / s); }
    __syncthreads();
}

__device__ __forceinline__ void moe_route(const Args& a, LAS unsigned char* lds, int tid, int G) {
    const int lane = tid & 63, w = tid >> 6;
    LAS float* rt = (LAS float*)lds;
    LAS unsigned* cnt = (LAS unsigned*)(lds + 32768);
    const float* h = a.out; unsigned char* ws = a.ws;
    for (int i = tid; i < 8192; i += NTHR) rt[(i & 7) * 1024 + (i >> 3)] = a.in[IN_ROUTER][i] * a.in[IN_NFFN][D + (i >> 3)];
    __syncthreads();
    for (int chunk = blockIdx.x; chunk < 256; chunk += G) {
        if (tid < 8) cnt[tid] = 0u;
        __syncthreads();
        for (int q = 0; q < 8; ++q) { const int tk = chunk * 64 + w * 8 + q;
            const f32x4* hr = (const f32x4*)(h + (size_t)tk * D) + lane; float lg[8] = {0.f, 0.f, 0.f, 0.f, 0.f, 0.f, 0.f, 0.f}; float ss = 0.f;
#pragma unroll
            for (int j = 0; j < 4; ++j) { const f32x4 v = hr[64 * j]; const int c0 = 4 * (lane + 64 * j);
                ss += (v.x * v.x + v.y * v.y) + (v.z * v.z + v.w * v.w);
#pragma unroll
                for (int e = 0; e < 8; ++e) { const f32x4 r = *(const LAS f32x4*)(rt + e * 1024 + c0); lg[e] += (v.x * r.x + v.y * r.y) + (v.z * r.z + v.w * r.w); } }
            ss = wave_sum(ss); const float rstd = rsqrtf(ss * (1.0f / 1024.0f) + EPS);
#pragma unroll
            for (int e = 0; e < 8; ++e) lg[e] = wave_sum(lg[e]) * rstd;
            int e0 = 0; float v0 = lg[0];
#pragma unroll
            for (int e = 1; e < 8; ++e) if (lg[e] > v0) { v0 = lg[e]; e0 = e; }
            int e1 = -1; float v1 = -INFINITY;
#pragma unroll
            for (int e = 0; e < 8; ++e) if (e != e0 && lg[e] > v1) { v1 = lg[e]; e1 = e; }
            const float g0 = 1.0f / (1.0f + expf(v1 - v0)), g1 = 1.0f - g0;
            if (lane == 0) { ((int*)(ws + WS_TOKE))[2 * tk] = e0; ((int*)(ws + WS_TOKE))[2 * tk + 1] = e1; ((float*)(ws + WS_TOKG))[2 * tk] = g0; ((float*)(ws + WS_TOKG))[2 * tk + 1] = g1;
                ((float*)(ws + WS_TOKR))[tk] = rstd; LDS_ADD(&cnt[e0], 1u); LDS_ADD(&cnt[e1], 1u); } }
        __syncthreads();
        if (tid < 8) ((int*)(ws + WS_CNT))[chunk * 8 + tid] = (int)cnt[tid];
        __syncthreads();
    }
}
__device__ __forceinline__ void moe_assign(const Args& a, LAS unsigned char* lds, int tid, int G) {
    const int lane = tid & 63, w = tid >> 6;
    LAS int* cn = (LAS int*)lds;
    LAS int* tot = cn + 2048;
    LAS int* basee = tot + 8;
    LAS int* sl = basee + 8;
    LAS int* pref = sl + 128;
    unsigned char* ws = a.ws;
    const int* CNT = (const int*)(ws + WS_CNT); int* TILEE = (int*)(ws + WS_TILEE);
    const int* TOKE = (const int*)(ws + WS_TOKE); const float* TOKG = (const float*)(ws + WS_TOKG); const float* TOKR = (const float*)(ws + WS_TOKR); int* TOKS = (int*)(ws + WS_TOKS);
    float* SLOTR = (float*)(ws + WS_SLOTR); float* SLOTG = (float*)(ws + WS_SLOTG);
    const bf16* HB = (const bf16*)(ws + WS_HB); bf16* AG = (bf16*)(ws + WS_AG);
    for (int i = tid; i < 2048; i += NTHR) cn[i] = CNT[i];
    __syncthreads();
    if (tid < 8) { int s = 0; for (int c = 0; c < 256; ++c) s += cn[c * 8 + tid]; tot[tid] = s; }
    __syncthreads();
    if (tid == 0) { int tile = 0; for (int e = 0; e < 8; ++e) { basee[e] = tile * 256; const int nt = (tot[e] + 255) >> 8;
            if (blockIdx.x == 0) for (int q = 0; q < nt; ++q) TILEE[tile + q] = e;
            tile += nt; }
        if (blockIdx.x == 0) { for (int q = tile; q < 159; ++q) TILEE[q] = 0; TILEE[159] = tile; } }
    __syncthreads();
    for (int e = blockIdx.x; e < 8; e += G) { const int s0 = basee[e] + tot[e], s1 = basee[e] + (((tot[e] + 255) >> 8) << 8);
        for (int s = s0 + w; s < s1; s += NWAVES) { v4u* rp = (v4u*)(AG + (size_t)s * D) + lane; rp[0] = (v4u){0u, 0u, 0u, 0u}; rp[64] = (v4u){0u, 0u, 0u, 0u}; if (lane == 0) { SLOTR[s] = 0.f; SLOTG[s] = 0.f; } } }
    for (int chunk = blockIdx.x; chunk < 256; chunk += G) {
        if (tid < 8) { int s = 0; for (int c = 0; c < chunk; ++c) s += cn[c * 8 + tid]; int pos = basee[tid] + s;
            for (int i = 0; i < 128; ++i) { const int tk = chunk * 64 + (i >> 1); if (TOKE[2 * tk + (i & 1)] == tid) { sl[i] = pos; SLOTR[pos] = TOKR[tk]; SLOTG[pos] = TOKG[2 * tk + (i & 1)]; TOKS[2 * tk + (i & 1)] = pos; ++pos; } } }
        __syncthreads();
        for (int q = 0; q < 16; ++q) { const int i = w * 16 + q, tk = chunk * 64 + (i >> 1), s = sl[i];
            const v4u* src = (const v4u*)(HB + (size_t)tk * D) + lane; v4u* dst = (v4u*)(AG + (size_t)s * D) + lane; dst[0] = src[0]; dst[64] = src[64]; }
        __syncthreads();
    }
}
__device__ __forceinline__ void final_phase(const Args& a, int tid, int G) {
    const int lane = tid & 63, gw = blockIdx.x * NWAVES + (tid >> 6), NGW = G * NWAVES;
    const int* TOKS = (const int*)(a.ws + WS_TOKS); const bf16* YS = (const bf16*)(a.ws + WS_YS);
    for (int tk = gw; tk < M; tk += NGW) { const int s0 = TOKS[2 * tk], s1 = TOKS[2 * tk + 1];
        f32x4* hr = (f32x4*)(a.out + (size_t)tk * D) + lane; const v2u* y0 = (const v2u*)(YS + (size_t)s0 * D) + lane; const v2u* y1 = (const v2u*)(YS + (size_t)s1 * D) + lane;
        f32x4 v[4]; float ss = 0.f;
#pragma unroll
        for (int j = 0; j < 4; ++j) { v[j] = hr[64 * j]; const v2u p = y0[64 * j], q = y1[64 * j];
            v[j].x += bflo(p.x) + bflo(q.x); v[j].y += bfhi(p.x) + bfhi(q.x); v[j].z += bflo(p.y) + bflo(q.y); v[j].w += bfhi(p.y) + bfhi(q.y);
            ss += (v[j].x * v[j].x + v[j].y * v[j].y) + (v[j].z * v[j].z + v[j].w * v[j].w); }
        const float rstd = rsqrtf(wave_sum(ss) * (1.0f / 1024.0f) + EPS);
#ifdef PROBE_DSA
        const float* pr = (const float*)(a.ws + WS_CTL) + 12288; const float padd = PROBE_C * sqrtf(pr[0] / fmaxf(pr[1], 1e-30f));
#else
        const float padd = 0.f;
#endif
#pragma unroll
        for (int j = 0; j < 4; ++j) { const f32x4 g = ((const f32x4*)a.in[IN_FNORM])[lane + 64 * j]; hr[64 * j] = v[j] * rstd * g + padd; } }
}

typedef short bf16x8 __attribute__((ext_vector_type(8)));
typedef short bf16x4 __attribute__((ext_vector_type(4)));
typedef float f32x16 __attribute__((ext_vector_type(16)));
#define MFMA32(a, b, c) __builtin_amdgcn_mfma_f32_32x32x16_bf16((a), (b), (c), 0, 0, 0)
constexpr int DS_HIST = 0;
constexpr int DS_BM = 33024;
constexpr int DS_P = DS_BM + 8192;
constexpr int DS_CU = DS_P + 512;
constexpr int DS_CK = DS_CU + 8192;
constexpr int DS_BIAS = DS_CK + 8192;
constexpr int DS_ST = DS_BIAS + 2112;
constexpr int DS_CMB = DS_ST + 8 * 4608;
constexpr int DS_END = DS_CMB + 4 * 8704;
constexpr int DSA_CAP = 64;
static_assert(DS_END <= MISC_OFF - 64, "DSA LDS map");
__device__ __forceinline__ void tr_read_tile(unsigned addr, bf16x4& t00, bf16x4& t01, bf16x4& t10, bf16x4& t11, bf16x4& u00, bf16x4& u01, bf16x4& u10, bf16x4& u11) {
    asm volatile("s_waitcnt lgkmcnt(0)\n\t"
                 "ds_read_b64_tr_b16 %0, %8 offset:0\n\t" "ds_read_b64_tr_b16 %1, %8 offset:512\n\t" "ds_read_b64_tr_b16 %2, %8 offset:1024\n\t" "ds_read_b64_tr_b16 %3, %8 offset:1536\n\t"
                 "ds_read_b64_tr_b16 %4, %8 offset:2048\n\t" "ds_read_b64_tr_b16 %5, %8 offset:2560\n\t" "ds_read_b64_tr_b16 %6, %8 offset:3072\n\t" "ds_read_b64_tr_b16 %7, %8 offset:3584\n\t"
                 "s_waitcnt lgkmcnt(0)"
                 : "=&v"(t00), "=&v"(t01), "=&v"(t10), "=&v"(t11), "=&v"(u00), "=&v"(u01), "=&v"(u10), "=&v"(u11) : "v"(addr) : "memory");
}

__device__ __forceinline__ void dsa2_setup(const Args& a, LAS unsigned char* lds, int tid) {
    LAS float* biasL = (LAS float*)(lds + DS_BIAS);
    for (int i = tid; i < 4 * 129; i += NTHR) { const int h = i / 129, d = i % 129; biasL[h * 132 + d] = a.in[IN_RELB][rel_bucket(d) * 4 + h] * 1.4426950408889634f; }
    __syncthreads();
}
__device__ __forceinline__ void idx_scores(const bf16x8 ka0, const bf16x8 ka1, const bf16x8 (&qf)[8][2], const float (&wv)[8], float (&sc)[16]) {
#pragma unroll
    for (int r = 0; r < 16; ++r) sc[r] = 0.f;
    float zero = 0.f;
#pragma unroll
    for (int hp = 0; hp < 4; ++hp) {
        f32x16 acc0, acc1;
#pragma unroll
        for (int r = 0; r < 16; ++r) { acc0[r] = zero; acc1[r] = zero; }
        acc0 = MFMA32(ka0, qf[2 * hp][0], acc0); acc1 = MFMA32(ka0, qf[2 * hp + 1][0], acc1);
        acc0 = MFMA32(ka1, qf[2 * hp][1], acc0); acc1 = MFMA32(ka1, qf[2 * hp + 1][1], acc1);
#pragma unroll
        for (int r = 0; r < 16; ++r) sc[r] = __builtin_fmaf(fmaxf(acc1[r], 0.f), wv[2 * hp + 1], __builtin_fmaf(fmaxf(acc0[r], 0.f), wv[2 * hp], sc[r]));
        asm volatile("" : "+v"(zero), "+v"(sc[0]), "+v"(sc[1]), "+v"(sc[2]), "+v"(sc[3]), "+v"(sc[4]), "+v"(sc[5]), "+v"(sc[6]), "+v"(sc[7]), "+v"(sc[8]), "+v"(sc[9]), "+v"(sc[10]), "+v"(sc[11]), "+v"(sc[12]), "+v"(sc[13]), "+v"(sc[14]), "+v"(sc[15]));
    }
}
__device__ __forceinline__ void dsa2_item(const Args& a, int item, LAS unsigned char* lds, int tid) {
    const int lane = tid & 63, w = __builtin_amdgcn_readfirstlane(tid >> 6), ql = lane & 31, hh = lane >> 5;
    const int b = item & 7, qi = 63 - (item >> 3), tq0 = qi * 32, ntl = qi + 1;
    const bool sel = qi >= 8;
    const bf16* z = (const bf16*)(a.ws + WS_Z); bf16* mix = (bf16*)(a.ws + WS_MIX);
    const bf16* zb = z + (size_t)b * T * ZW;
    const bf16* zq = zb + (size_t)(tq0 + ql) * ZW;
    LAS unsigned* hist = (LAS unsigned*)(lds + DS_HIST); LAS unsigned* bm = (LAS unsigned*)(lds + DS_BM);
    LAS unsigned* Pp = (LAS unsigned*)(lds + DS_P); LAS unsigned* need = Pp + 32; LAS unsigned* ccnt = Pp + 64; LAS unsigned* ccnt2 = Pp + 96;
    LAS unsigned* cu = (LAS unsigned*)(lds + DS_CU); LAS unsigned* ck = (LAS unsigned*)(lds + DS_CK);
    const LAS float* biasL = (const LAS float*)(lds + DS_BIAS);
    if (sel) {
        for (int i = tid; i < 2048; i += NTHR) bm[i] = 0u;
        if (tid < 32) { Pp[tid] = 0u; need[tid] = 256u; ccnt2[tid] = 0u; }
        bf16x8 qf[8][2]; float wv[8];
#pragma unroll
        for (int hx = 0; hx < 8; ++hx) { qf[hx][0] = *(const bf16x8*)(zq + Z_CQI + hx * 32 + 8 * hh); qf[hx][1] = *(const bf16x8*)(zq + Z_CQI + hx * 32 + 16 + 8 * hh); }
        { const v4u wr = *(const v4u*)(zq + Z_CWI);
          wv[0] = bflo(wr.x) * 0.0625f; wv[1] = bfhi(wr.x) * 0.0625f; wv[2] = bflo(wr.y) * 0.0625f; wv[3] = bfhi(wr.y) * 0.0625f;
          wv[4] = bflo(wr.z) * 0.0625f; wv[5] = bfhi(wr.z) * 0.0625f; wv[6] = bflo(wr.w) * 0.0625f; wv[7] = bfhi(wr.w) * 0.0625f; }
        int sh = 23, nb = 9;
#pragma unroll 1
        for (int level = 0; level < 4; ++level) {
            for (int i = tid; i < 32 * 257; i += NTHR) hist[i] = 0u;
            __syncthreads();
            const unsigned myP = Pp[ql];
#pragma unroll 1
            for (int kt = w; kt < ntl; kt += 8) {
                const bf16* zk = zb + (size_t)(kt * 32 + ql) * ZW + Z_CKI + 8 * hh;
                const bf16x8 ka0 = *(const bf16x8*)zk, ka1 = *(const bf16x8*)(zk + 16);
                float sc[16]; idx_scores(ka0, ka1, qf, wv, sc);
#pragma unroll
                for (int r = 0; r < 16; ++r) { const int kl = (r & 3) + 8 * (r >> 2) + 4 * hh; const unsigned u = ord_u(sc[r] + 0.0f);
                    const bool ok = (kt < qi || kl <= ql) && (level == 0 || (u >> (sh + nb)) == myP);
                    if (ok) { const unsigned digit = (u >> sh) & ((1u << nb) - 1u); LDS_ADD(&hist[ql * 257 + (digit >> 1)], 1u << (16 * (digit & 1))); } }
            }
            __syncthreads();
#pragma unroll 1
            for (int qq = 0; qq < 4; ++qq) { const int q = 4 * w + qq; const int bpl = (1 << nb) >> 6, wpl = bpl >> 1;
                unsigned c[8]; unsigned s = 0u;
#pragma unroll
                for (int i = 0; i < 4; ++i) { const unsigned wd = (i < wpl) ? hist[q * 257 + lane * wpl + i] : 0u; c[2 * i] = wd & 0xffffu; c[2 * i + 1] = wd >> 16; s += c[2 * i] + c[2 * i + 1]; }
                unsigned incl = s;
#pragma unroll
                for (int o = 1; o < 64; o <<= 1) { const unsigned t2 = __shfl_down(incl, o); if (lane + o < 64) incl += t2; }
                const unsigned excl = incl - s, nd = need[q];
                if (excl < nd && nd <= incl) { unsigned run = excl; int dsel = 0; unsigned above = 0u, cand = 0u; bool found = false;
#pragma unroll
                    for (int i = 7; i >= 0; --i) { if (i < bpl && !found) { if (run + c[i] >= nd) { dsel = i; above = run; cand = c[i]; found = true; } else run += c[i]; } }
                    Pp[q] = (Pp[q] << nb) | (unsigned)(lane * bpl + dsel); need[q] = nd - above; ccnt[q] = cand; }
            }
            __syncthreads();
            unsigned mc = ccnt[ql]; mc = (unsigned)wave_max((float)mc);
            if (mc <= (unsigned)DSA_CAP || level == 3) break;
            sh -= (level == 2) ? 7 : 8; nb = (level == 2) ? 7 : 8;
        }
        { const unsigned myP = Pp[ql];
#pragma unroll 1
          for (int kt = w; kt < ntl; kt += 8) {
            const bf16* zk = zb + (size_t)(kt * 32 + ql) * ZW + Z_CKI + 8 * hh;
            const bf16x8 ka0 = *(const bf16x8*)zk, ka1 = *(const bf16x8*)(zk + 16);
            float sc[16]; idx_scores(ka0, ka1, qf, wv, sc); unsigned bits = 0u;
#pragma unroll
            for (int r = 0; r < 16; ++r) { const int kl = (r & 3) + 8 * (r >> 2) + 4 * hh; const unsigned u = ord_u(sc[r] + 0.0f), pfx = u >> sh;
                if (kt < qi || kl <= ql) { if (pfx > myP) bits |= 1u << kl;
                    else if (pfx == myP) { const unsigned slot = __hip_atomic_fetch_add(&ccnt2[ql], 1u, __ATOMIC_RELAXED, __HIP_MEMORY_SCOPE_WORKGROUP);
                        if (slot < (unsigned)DSA_CAP) { cu[ql * DSA_CAP + slot] = u; ck[ql * DSA_CAP + slot] = (unsigned)(kt * 32 + kl); } } } }
            if (bits) (void)__hip_atomic_fetch_or(&bm[kt * 32 + ql], bits, __ATOMIC_RELAXED, __HIP_MEMORY_SCOPE_WORKGROUP);
          } }
        __syncthreads();
        for (int idx = tid; idx < 32 * DSA_CAP; idx += NTHR) { const int q = idx / DSA_CAP, i = idx % DSA_CAP; unsigned n = ccnt2[q]; n = n < (unsigned)DSA_CAP ? n : (unsigned)DSA_CAP;
            if ((unsigned)i < n) { const unsigned ui = cu[q * DSA_CAP + i], ki = ck[q * DSA_CAP + i]; unsigned rank = 0u;
                for (unsigned j = 0; j < n; ++j) { const unsigned uj = cu[q * DSA_CAP + j], kj = ck[q * DSA_CAP + j]; rank += (uj > ui || (uj == ui && kj < ki)) ? 1u : 0u; }
                if (rank < need[q]) (void)__hip_atomic_fetch_or(&bm[(ki >> 5) * 32 + q], 1u << (ki & 31u), __ATOMIC_RELAXED, __HIP_MEMORY_SCOPE_WORKGROUP); } }
        __syncthreads();
    }
    const int hd = w >> 1, half = w & 1;
    bf16x8 qa[4];
#pragma unroll
    for (int s = 0; s < 4; ++s) qa[s] = *(const bf16x8*)(zq + Z_CQ + hd * 64 + 16 * s + 8 * hh);
    f32x16 o0, o1;
#pragma unroll
    for (int r = 0; r < 16; ++r) { o0[r] = 0.f; o1[r] = 0.f; }
    float m = -1e30f, lsum = 0.f;
    const float c31 = biasL[hd * 132 + 128];
    LAS unsigned char* st = lds + DS_ST + w * 4608;
    const unsigned vaddr = (unsigned)(size_t)st + (unsigned)((4 * hh + ((lane >> 2) & 3)) * 64 + 32 * ((lane >> 4) & 1) + 8 * (lane & 3));
    constexpr float SC = 0.18033688011112042f;
#pragma unroll 1
    for (int kt = half; kt < ntl; kt += 2) {
        const int k0 = kt * 32;
        bf16x8 kf[4];
        { const bf16* zk = zb + (size_t)(k0 + ql) * ZW + Z_CK + hd * 64 + 8 * hh;
#pragma unroll
          for (int s = 0; s < 4; ++s) kf[s] = *(const bf16x8*)(zk + 16 * s); }
#pragma unroll
        for (int i = 0; i < 4; ++i) { const int key = (lane >> 3) + 8 * i, ch = lane & 7;
            const v4u v = *(const v4u*)(zb + (size_t)(k0 + key) * ZW + Z_CV + hd * 64 + ch * 8);
            *(LAS v4u*)(st + (ch >> 2) * 2048 + key * 64 + (ch & 3) * 16) = v; }
        f32x16 sacc;
#pragma unroll
        for (int r = 0; r < 16; ++r) sacc[r] = 0.f;
#pragma unroll
        for (int s = 0; s < 4; ++s) sacc = MFMA32(kf[s], qa[s], sacc);
        unsigned word = sel ? bm[kt * 32 + ql] : 0xffffffffu;
        if (kt == qi) word &= (ql == 31) ? 0xffffffffu : ((2u << ql) - 1u);
        const bool nearb = (tq0 - (k0 + 31)) < 128;
        float sv[16]; float tmax = -1e30f;
#pragma unroll
        for (int r = 0; r < 16; ++r) { const int kl = (r & 3) + 8 * (r >> 2) + 4 * hh; float bias = c31;
            if (nearb) { int dd = tq0 + ql - k0 - kl; dd = dd < 0 ? 0 : (dd > 128 ? 128 : dd); bias = biasL[hd * 132 + dd]; }
            const float v = sacc[r] * SC + bias; sv[r] = ((word >> kl) & 1u) ? v : -1e30f; tmax = fmaxf(tmax, sv[r]); }
        tmax = fmaxf(tmax, __shfl_xor(tmax, 32));
        const float mnew = fmaxf(m, tmax), alpha = __builtin_amdgcn_exp2f(m - mnew);
        float p[16]; float ps = 0.f;
#pragma unroll
        for (int r = 0; r < 16; ++r) { p[r] = (sv[r] > -1e29f) ? __builtin_amdgcn_exp2f(sv[r] - mnew) : 0.f; ps += p[r]; }
        ps += __shfl_xor(ps, 32);
        lsum = lsum * alpha + ps; m = mnew;
#pragma unroll
        for (int r = 0; r < 16; ++r) { o0[r] *= alpha; o1[r] *= alpha; }
        bf16x8 pb[2];
#pragma unroll
        for (int s = 0; s < 2; ++s) { v4u t4; t4.x = pg8::cvt_pk_bf16(p[8 * s + 0], p[8 * s + 1]); t4.y = pg8::cvt_pk_bf16(p[8 * s + 2], p[8 * s + 3]); t4.z = pg8::cvt_pk_bf16(p[8 * s + 4], p[8 * s + 5]); t4.w = pg8::cvt_pk_bf16(p[8 * s + 6], p[8 * s + 7]);
            pb[s] = __builtin_bit_cast(bf16x8, t4); }
        bf16x4 t00, t01, t10, t11, u00, u01, u10, u11;
        tr_read_tile(vaddr, t00, t01, t10, t11, u00, u01, u10, u11);
        const bf16x8 va00 = __builtin_shufflevector(t00, t01, 0, 1, 2, 3, 4, 5, 6, 7), va01 = __builtin_shufflevector(t10, t11, 0, 1, 2, 3, 4, 5, 6, 7);
        const bf16x8 va10 = __builtin_shufflevector(u00, u01, 0, 1, 2, 3, 4, 5, 6, 7), va11 = __builtin_shufflevector(u10, u11, 0, 1, 2, 3, 4, 5, 6, 7);
        o0 = MFMA32(va00, pb[0], o0); o0 = MFMA32(va01, pb[1], o0);
        o1 = MFMA32(va10, pb[0], o1); o1 = MFMA32(va11, pb[1], o1);
    }
    LAS float* cmb = (LAS float*)(lds + DS_CMB + hd * 8704);
    if (half == 1) {
#pragma unroll
        for (int r = 0; r < 16; ++r) { cmb[r * 64 + lane] = o0[r]; cmb[(16 + r) * 64 + lane] = o1[r]; }
        cmb[2048 + lane] = m; cmb[2048 + 64 + lane] = lsum;
    }
    __syncthreads();
    if (half == 0) {
        const float mb = cmb[2048 + lane], lb = cmb[2048 + 64 + lane];
        const float mt = fmaxf(m, mb), fa = __builtin_amdgcn_exp2f(m - mt), fb = __builtin_amdgcn_exp2f(mb - mt);
        const float inv = 1.0f / (lsum * fa + lb * fb), ga = fa * inv, gb = fb * inv;
        asm volatile("s_waitcnt lgkmcnt(0)" ::: "memory");
#pragma unroll
        for (int r = 0; r < 16; ++r) { o0[r] = o0[r] * ga + cmb[r * 64 + lane] * gb; o1[r] = o1[r] * ga + cmb[(16 + r) * 64 + lane] * gb; }
#pragma unroll
        for (int g = 0; g < 4; ++g) { v2u w0, w1; w0.x = pg8::cvt_pk_bf16(o0[4 * g], o0[4 * g + 1]); w0.y = pg8::cvt_pk_bf16(o0[4 * g + 2], o0[4 * g + 3]); w1.x = pg8::cvt_pk_bf16(o1[4 * g], o1[4 * g + 1]); w1.y = pg8::cvt_pk_bf16(o1[4 * g + 2], o1[4 * g + 3]);
            *(LAS v2u*)(st + ql * 136 + (8 * g + 4 * hh) * 2) = w0; *(LAS v2u*)(st + ql * 136 + (32 + 8 * g + 4 * hh) * 2) = w1; }
        asm volatile("s_waitcnt lgkmcnt(0)" ::: "memory");
#pragma unroll
        for (int i = 0; i < 4; ++i) { const int q = (lane >> 3) + 8 * i, ch = lane & 7;
            const v2u x0 = *(const LAS v2u*)(st + q * 136 + ch * 16), x1 = *(const LAS v2u*)(st + q * 136 + ch * 16 + 8);
            v4u o; o.x = x0.x; o.y = x0.y; o.z = x1.x; o.w = x1.y;
            *(v4u*)(mix + ((size_t)b * T + tq0 + q) * D + 512 + hd * 64 + ch * 8) = o; }
    }
    __syncthreads();
}


constexpr int XA_V = 0, XA_ST = 32768;
__device__ __forceinline__ void xattn2_item(const Args& a, int l, int item, LAS unsigned char* lds, int tid) {
    const int lane = tid & 63, w = __builtin_amdgcn_readfirstlane(tid >> 6), ql = lane & 31, hh = lane >> 5;
    const int qg = item & 7, h = (item >> 3) & 3, b = item >> 5;
    const bf16* kvm = (const bf16*)(a.ws + WS_KVM + (size_t)l * SZ_KVM) + (size_t)b * MEMLEN * 512;
    const bf16* qx = (const bf16*)(a.ws + WS_QX); bf16* ox = (bf16*)(a.ws + WS_OX);
#pragma unroll
    for (int i = 0; i < 4; ++i) { const int idx = tid + NTHR * i, key = idx >> 3, ch = idx & 7;
        const v4u v = *(const v4u*)(kvm + (size_t)key * 512 + 256 + h * 64 + ch * 8);
        *(LAS v4u*)(lds + XA_V + (key >> 5) * 4096 + (ch >> 2) * 2048 + (key & 31) * 64 + (ch & 3) * 16) = v; }
    __syncthreads();
    const size_t row0 = (size_t)b * T + qg * 256 + w * 32;
    bf16x8 qa[4];
#pragma unroll
    for (int s = 0; s < 4; ++s) qa[s] = *(const bf16x8*)(qx + (row0 + ql) * 256 + h * 64 + 16 * s + 8 * hh);
    f32x16 o0, o1;
#pragma unroll
    for (int r = 0; r < 16; ++r) { o0[r] = 0.f; o1[r] = 0.f; }
    float m = -1e30f, lsum = 0.f;
    const unsigned vaddr = (unsigned)(size_t)(lds + XA_V) + (unsigned)((4 * hh + ((lane >> 2) & 3)) * 64 + 32 * ((lane >> 4) & 1) + 8 * (lane & 3));
#pragma unroll 1
    for (int kt = 0; kt < 8; ++kt) {
        bf16x8 kf[4];
        { const bf16* zk = kvm + (size_t)(kt * 32 + ql) * 512 + h * 64 + 8 * hh;
#pragma unroll
          for (int s = 0; s < 4; ++s) kf[s] = *(const bf16x8*)(zk + 16 * s); }
        f32x16 sacc;
#pragma unroll
        for (int r = 0; r < 16; ++r) sacc[r] = 0.f;
#pragma unroll
        for (int s = 0; s < 4; ++s) sacc = MFMA32(kf[s], qa[s], sacc);
        float sv[16]; float tmax = -1e30f;
#pragma unroll
        for (int r = 0; r < 16; ++r) { sv[r] = sacc[r] * 1.4426950408889634f; tmax = fmaxf(tmax, sv[r]); }
        tmax = fmaxf(tmax, __shfl_xor(tmax, 32));
        const float mnew = fmaxf(m, tmax), alpha = __builtin_amdgcn_exp2f(m - mnew);
        float p[16]; float ps = 0.f;
#pragma unroll
        for (int r = 0; r < 16; ++r) { p[r] = __builtin_amdgcn_exp2f(sv[r] - mnew); ps += p[r]; }
        ps += __shfl_xor(ps, 32);
        lsum = lsum * alpha + ps; m = mnew;
#pragma unroll
        for (int r = 0; r < 16; ++r) { o0[r] *= alpha; o1[r] *= alpha; }
        bf16x8 pb[2];
#pragma unroll
        for (int s = 0; s < 2; ++s) { v4u t4; t4.x = pg8::cvt_pk_bf16(p[8 * s + 0], p[8 * s + 1]); t4.y = pg8::cvt_pk_bf16(p[8 * s + 2], p[8 * s + 3]); t4.z = pg8::cvt_pk_bf16(p[8 * s + 4], p[8 * s + 5]); t4.w = pg8::cvt_pk_bf16(p[8 * s + 6], p[8 * s + 7]);
            pb[s] = __builtin_bit_cast(bf16x8, t4); }
        bf16x4 t00, t01, t10, t11, u00, u01, u10, u11;
        tr_read_tile(vaddr + kt * 4096, t00, t01, t10, t11, u00, u01, u10, u11);
        const bf16x8 va00 = __builtin_shufflevector(t00, t01, 0, 1, 2, 3, 4, 5, 6, 7), va01 = __builtin_shufflevector(t10, t11, 0, 1, 2, 3, 4, 5, 6, 7);
        const bf16x8 va10 = __builtin_shufflevector(u00, u01, 0, 1, 2, 3, 4, 5, 6, 7), va11 = __builtin_shufflevector(u10, u11, 0, 1, 2, 3, 4, 5, 6, 7);
        o0 = MFMA32(va00, pb[0], o0); o0 = MFMA32(va01, pb[1], o0);
        o1 = MFMA32(va10, pb[0], o1); o1 = MFMA32(va11, pb[1], o1);
    }
    const float inv = 1.0f / lsum;
    LAS unsigned char* st = lds + XA_ST + w * 4608;
#pragma unroll
    for (int g = 0; g < 4; ++g) { v2u w0, w1; w0.x = pg8::cvt_pk_bf16(o0[4 * g] * inv, o0[4 * g + 1] * inv); w0.y = pg8::cvt_pk_bf16(o0[4 * g + 2] * inv, o0[4 * g + 3] * inv);
        w1.x = pg8::cvt_pk_bf16(o1[4 * g] * inv, o1[4 * g + 1] * inv); w1.y = pg8::cvt_pk_bf16(o1[4 * g + 2] * inv, o1[4 * g + 3] * inv);
        *(LAS v2u*)(st + ql * 136 + (8 * g + 4 * hh) * 2) = w0; *(LAS v2u*)(st + ql * 136 + (32 + 8 * g + 4 * hh) * 2) = w1; }
    asm volatile("s_waitcnt lgkmcnt(0)" ::: "memory");
#pragma unroll
    for (int i = 0; i < 4; ++i) { const int q = (lane >> 3) + 8 * i, ch = lane & 7;
        const v2u x0 = *(const LAS v2u*)(st + q * 136 + ch * 16), x1 = *(const LAS v2u*)(st + q * 136 + ch * 16 + 8);
        v4u o; o.x = x0.x; o.y = x0.y; o.z = x1.x; o.w = x1.y;
        *(v4u*)(ox + (row0 + q) * 256 + h * 64 + ch * 8) = o; }
    __syncthreads();
}

__device__ __forceinline__ float gelu_fast(float x) {
    const float y = x * (1.0f + 0.044715f * x * x) * -2.302208198f;
    return x * __builtin_amdgcn_rcpf(1.0f + __builtin_amdgcn_exp2f(y));
}
__device__ __forceinline__ bf16x8 tr_frag(unsigned addr) {
    bf16x4 lo, hi;
    asm volatile("ds_read_b64_tr_b16 %0, %2 offset:0\n\tds_read_b64_tr_b16 %1, %2 offset:256\n\ts_waitcnt lgkmcnt(0)" : "=&v"(lo), "=&v"(hi) : "v"(addr) : "memory");
    return __builtin_shufflevector(lo, hi, 0, 1, 2, 3, 4, 5, 6, 7);
}
__device__ __forceinline__ void sgu2_item(const Args& a, int l, int item, LAS unsigned char* lds, int tid) {
    const int lane = tid & 63, w = __builtin_amdgcn_readfirstlane(tid >> 6), ql = lane & 31, hh = lane >> 5;
    const int nc = item & 15, b = item >> 4, tok0 = b * T + nc * 128;
    const bf16* z = (const bf16*)(a.ws + WS_Z); bf16* mix = (bf16*)(a.ws + WS_MIX);
    for (int j = 0; j < 16; ++j) { const int s = 16 * w + j;
        const v2u raw = *(const v2u*)(z + (size_t)(tok0 + s) * ZW + Z_DUV + 256 + 4 * lane);
        float x[4] = {gelu_fast(bflo(raw.x)), gelu_fast(bfhi(raw.x)), gelu_fast(bflo(raw.y)), gelu_fast(bfhi(raw.y))};
        const float mu = wave_sum((x[0] + x[1]) + (x[2] + x[3])) * (1.0f / 256.0f);
        float q = 0.f;
#pragma unroll
        for (int i = 0; i < 4; ++i) { x[i] -= mu; q += x[i] * x[i]; }
        const float rstd = rsqrtf(wave_sum(q) * (1.0f / 256.0f) + EPS);
        const f32x4 gg = *(const f32x4*)(a.in[IN_LNG] + l * 256 + 4 * lane), bb = *(const f32x4*)(a.in[IN_LNB] + l * 256 + 4 * lane);
        v2u o; o.x = pk2(x[0] * rstd * gg.x + bb.x, x[1] * rstd * gg.y + bb.y); o.y = pk2(x[2] * rstd * gg.z + bb.z, x[3] * rstd * gg.w + bb.w);
        const int ch = 4 * lane;
        *(LAS v2u*)(lds + ((s >> 5) * 8 + (ch >> 5)) * 2048 + (s & 31) * 64 + (ch & 31) * 2) = o; }
    __syncthreads();
    const int g = w >> 1, cb = w & 1, cblk = g * 2 + cb;
    bf16x8 af[4][2];
    { const unsigned abase = (unsigned)(size_t)lds + (unsigned)(cblk * 2048 + (8 * hh + ((lane >> 2) & 3)) * 64 + 32 * ((lane >> 4) & 1) + 8 * (lane & 3));
#pragma unroll
      for (int sb = 0; sb < 4; ++sb) { af[sb][0] = tr_frag(abase + sb * 8 * 2048); af[sb][1] = tr_frag(abase + sb * 8 * 2048 + 16 * 64); } }
    const bf16* swt = (const bf16*)(a.ws + WS_SWT) + (size_t)(l * 4 + g) * 128 * 128;
#pragma unroll
    for (int tb = 0; tb < 4; ++tb) {
        f32x16 acc;
#pragma unroll
        for (int r = 0; r < 16; ++r) acc[r] = 0.f;
        const bf16* wrow = swt + (size_t)(32 * tb + ql) * 128 + 8 * hh;
#pragma unroll
        for (int sb = 0; sb <= tb; ++sb) { const bf16x8 b0 = *(const bf16x8*)(wrow + 32 * sb), b1 = *(const bf16x8*)(wrow + 32 * sb + 16);
            acc = MFMA32(af[sb][0], b0, acc); acc = MFMA32(af[sb][1], b1, acc); }
        const int t = 32 * tb + ql; const float bs = a.in[IN_SB][(l * 4 + g) * 128 + t];
        const bf16* up = z + (size_t)(tok0 + t) * ZW + Z_DUV + g * 64 + cb * 32 + 4 * hh; bf16* op = mix + (size_t)(tok0 + t) * D + 768 + g * 64 + cb * 32 + 4 * hh;
#pragma unroll
        for (int q4 = 0; q4 < 4; ++q4) { const v2u raw = *(const v2u*)(up + 8 * q4);
            v2u o; o.x = pk2(gelu_fast(bflo(raw.x)) * (acc[4 * q4] + bs), gelu_fast(bfhi(raw.x)) * (acc[4 * q4 + 1] + bs)); o.y = pk2(gelu_fast(bflo(raw.y)) * (acc[4 * q4 + 2] + bs), gelu_fast(bfhi(raw.y)) * (acc[4 * q4 + 3] + bs));
            *(v2u*)(op + 8 * q4) = o; }
    }
    __syncthreads();
}
__device__ __forceinline__ void pool2_item(const Args& a, int l, int item, LAS unsigned char* lds, int tid) {
    const int lane = tid & 63, w = __builtin_amdgcn_readfirstlane(tid >> 6), ql = lane & 31, hh = lane >> 5;
    const int tt = item & 31, b = item >> 5, t0 = tt * 64;
    const bf16* z = (const bf16*)(a.ws + WS_Z); bf16* mix = (bf16*)(a.ws + WS_MIX);
    for (int i = tid; i < 79 * 32; i += NTHR) { const int r = i >> 5, ch = i & 31, t = t0 - 15 + r;
        v4u v = (v4u){0u, 0u, 0u, 0u}; if (t >= 0) v = *(const v4u*)(z + (size_t)(b * T + t) * ZW + Z_BU + ch * 8);
        *(LAS v4u*)(lds + r * 528 + ch * 16) = v; }
    __syncthreads();
    const int tb = w & 1, g = w >> 1, win = 2 << g, tl = 32 * tb + ql, tabs = t0 + tl;
    const float icnt = 1.0f / (float)((tabs + 1 < win) ? tabs + 1 : win);
    bf16x8 bfr[4];
#pragma unroll
    for (int s = 0; s < 4; ++s) { const LAS unsigned char* p0 = lds + (tl + 15) * 528 + (g * 64 + 16 * s + 8 * hh) * 2; float acc[8] = {0.f, 0.f, 0.f, 0.f, 0.f, 0.f, 0.f, 0.f};
        for (int j = 0; j < win; ++j) { const v4u r = *(const LAS v4u*)(p0 - j * 528);
            acc[0] += bflo(r.x); acc[1] += bfhi(r.x); acc[2] += bflo(r.y); acc[3] += bfhi(r.y); acc[4] += bflo(r.z); acc[5] += bfhi(r.z); acc[6] += bflo(r.w); acc[7] += bfhi(r.w); }
        const v4u r0 = *(const LAS v4u*)p0;
        v4u o; o.x = pg8::cvt_pk_bf16(acc[0] * icnt - bflo(r0.x), acc[1] * icnt - bfhi(r0.x)); o.y = pg8::cvt_pk_bf16(acc[2] * icnt - bflo(r0.y), acc[3] * icnt - bfhi(r0.y));
        o.z = pg8::cvt_pk_bf16(acc[4] * icnt - bflo(r0.z), acc[5] * icnt - bfhi(r0.z)); o.w = pg8::cvt_pk_bf16(acc[6] * icnt - bflo(r0.w), acc[7] * icnt - bfhi(r0.w));
        bfr[s] = __builtin_bit_cast(bf16x8, o); }
    const bf16* pwt = (const bf16*)(a.ws + WS_PWT) + (size_t)(l * 4 + g) * 4096;
    bf16* op = mix + (size_t)(b * T + tabs) * D + 256 + g * 64 + 4 * hh;
#pragma unroll
    for (int db = 0; db < 2; ++db) { f32x16 acc;
#pragma unroll
        for (int r = 0; r < 16; ++r) acc[r] = 0.f;
#pragma unroll
        for (int s = 0; s < 4; ++s) { const bf16x8 af = *(const bf16x8*)(pwt + (size_t)(32 * db + ql) * 64 + 16 * s + 8 * hh); acc = MFMA32(af, bfr[s], acc); }
#pragma unroll
        for (int q4 = 0; q4 < 4; ++q4) { const int d0 = 32 * db + 8 * q4 + 4 * hh;
            const f32x4 pb = *(const f32x4*)(a.in[IN_PB] + (l * 4 + g) * 64 + d0), ps = *(const f32x4*)(a.in[IN_PS] + l * 256 + g * 64 + d0);
            v2u o; o.x = pk2((acc[4 * q4] + pb.x) * ps.x, (acc[4 * q4 + 1] + pb.y) * ps.y); o.y = pk2((acc[4 * q4 + 2] + pb.z) * ps.z, (acc[4 * q4 + 3] + pb.w) * ps.w);
            *(v2u*)(op + 32 * db + 8 * q4) = o; } }
    __syncthreads();
}
constexpr int CW_QUEUE = 8192;
__device__ __forceinline__ void mixers_phase(const Args& a, int l, LAS unsigned char* lds, int tid) {
    dsa2_setup(a, lds, tid);
    unsigned* qctr = (unsigned*)(a.ws + WS_CTL) + CW_QUEUE + 64 * l;
    volatile LAS int* qslot = (volatile LAS int*)(lds + MISC_OFF + 64);
    for (;;) {
        if (tid == 0) *qslot = (int)__hip_atomic_fetch_add(qctr, 1u, __ATOMIC_RELAXED, __HIP_MEMORY_SCOPE_AGENT);
        __syncthreads();
        int it = *qslot;
        __syncthreads();
        if (it >= 1920) break;
        int t2 = tid; asm volatile("" : "+v"(t2));
        if (it < 512) dsa2_item(a, it, lds, t2);
        else if (it < 640) sgu2_item(a, l, it - 512, lds, t2);
        else if (it < 1664) gla_a_item(a, l, it - 640, lds, t2);
        else pool2_item(a, l, it - 1664, lds, t2);
    }
#ifdef PROBE_DSA
    __syncthreads(); dsa_setup(a, lds, tid);
    for (int it = M - 1 - (int)blockIdx.x; it >= 0; it -= gridDim.x) dsa_item(a, it, lds, tid, (bf16*)(a.ws + WS_QX), 256);
#endif
}
#ifdef PROBE_DSA
__device__ __forceinline__ void probe_dsa_compare(const Args& a, LAS unsigned char* lds, int tid) {
    const bf16* mix = (const bf16*)(a.ws + WS_MIX); const bf16* alt = (const bf16*)(a.ws + WS_QX); float d2 = 0.f, r2 = 0.f;
    for (size_t i = (size_t)blockIdx.x * NTHR + tid; i < (size_t)M * 256; i += (size_t)gridDim.x * NTHR) { const size_t row = i >> 8, c = i & 255; const float x = bf1(mix[row * D + 512 + c]), y = bf1(alt[i]); d2 += (x - y) * (x - y); r2 += y * y; }
    d2 = wave_sum(d2); r2 = wave_sum(r2);
    if ((tid & 63) == 0) { atomicAdd((float*)(a.ws + WS_CTL) + 12288, d2); atomicAdd((float*)(a.ws + WS_CTL) + 12289, r2); }
}
#endif

constexpr int NPHASE = 28;
#define OTID() int tid = threadIdx.x; asm volatile("" : "+v"(tid))
__global__ void __launch_bounds__(NTHR, 2) fwd_kernel(Args a) {
    extern __shared__ __attribute__((aligned(16))) unsigned char lds_raw[];
    LAS unsigned char* lds = (LAS unsigned char*)lds_raw;
    const int G = gridDim.x, bid = blockIdx.x;
    volatile LAS unsigned* MISC = (volatile LAS unsigned*)(lds + MISC_OFF);
    if (threadIdx.x < 32) MISC[threadIdx.x] = 0u;
    __syncthreads();
    unsigned char* ws = a.ws;
    XcdBarrier bar; bar.bar = (unsigned*)(ws + WS_CTL) + CW_BAR; bar.x = 0; bar.st = nullptr;
    if (N_LAUNCH_MODE == 1) bar = xcd_barrier_post((unsigned*)(ws + WS_CTL) + CW_BAR, MISC + 8);
    const int lo = a.ph_lo, hi = a.ph_hi;
#define RUN(k) (lo <= (k) && (k) < hi)
#define SEAM() do { if (N_LAUNCH_MODE == 1) xcd_barrier(bar); } while (0)
#define WB(off) ((bf16*)(ws + (off)))
#define WF(off) ((float*)(ws + (off)))
#ifdef REP_PRO
    if (RUN(0)) { int nrep = 2; asm volatile("" : "+s"(nrep));
#pragma unroll 1
        for (int rep = 0; rep < nrep; ++rep) { OTID(); p0_prologue(a, lds, tid, G); } SEAM(); }
#else
    if (RUN(0)) { OTID(); p0_prologue(a, lds, tid, G); SEAM(); }
#endif

    for (int l = 0; l < 2; ++l) {
        const int pb = l ? 10 : 1;
        if (RUN(pb + 0)) {
            { pg8::Gemm g{WB(WS_HB), WB(WS_WIN + l * SZ_WIN), M, ZW, D}; pg8::StaticOrder S; S.init(M, ZW, G, bid);
              EpiScale E{WB(WS_Z), ZW, WF(WS_SS), 1.0f}; pg8::gemm_phase<EpiScale, pg8::StaticOrder, true, true>(lds, g, S, E); }
            if (l == 0) {
                for (int l2 = 0; l2 < 2; ++l2) {
                    pg8::Gemm g{WB(WS_MEMB), WB(WS_WKV + l2 * SZ_WKV), MM, 512, D}; pg8::StaticOrder S; S.init(MM, 512, G, (G - 1 - bid - 16 * l2 + 2 * G) % G);
                    EpiScale E{WB(WS_KVM + l2 * SZ_KVM), 512, WF(WS_SSM), 1.0f}; pg8::gemm_phase<EpiScale, pg8::StaticOrder, true, true>(lds, g, S, E); }
            }
            SEAM();
        }
        if (RUN(pb + 1)) {
            { OTID(); mixers_phase(a, l, lds, tid); }
            SEAM();
        }
#ifdef REP_GLAC
        if (RUN(pb + 2)) { OTID(); int nit = 2048; asm volatile("" : "+s"(nit)); for (int it = bid; it < nit; it += G) gla_c_item(a, l, it & 1023, lds, tid);
#else
        if (RUN(pb + 2)) { OTID(); for (int it = bid; it < 1024; it += G) gla_c_item(a, l, it, lds, tid);
#endif
#ifdef PROBE_DSA
            probe_dsa_compare(a, lds, tid);
#endif
            SEAM(); }
        if (RUN(pb + 3)) {
            pg8::Gemm g{WB(WS_MIX), WB(WS_WOUT + l * SZ_WOUT), M, D, D}; pg8::StaticOrder S; S.init(M, D, G, bid);
            EpiResid E{l == 0 ? a.in[IN_X] : (const float*)a.out, a.out, WB(WS_HB), WF(WS_SS)}; pg8::gemm_phase<EpiResid, pg8::StaticOrder, true, true>(lds, g, S, E); SEAM();
        }
        if (RUN(pb + 4)) {
            pg8::Gemm g{WB(WS_HB), WB(WS_WQ + l * SZ_WQ), M, 256, D}; pg8::StaticOrder S; S.init(M, 256, G, bid);
            EpiScale E{WB(WS_QX), 256, WF(WS_SS), 0.125f}; pg8::gemm_phase<EpiScale, pg8::StaticOrder, true, true>(lds, g, S, E); SEAM();
        }
#ifdef REP_XA
        if (RUN(pb + 5)) { OTID(); int nit = 512; asm volatile("" : "+s"(nit)); for (int it = bid; it < nit; it += G) xattn2_item(a, l, it & 255, lds, tid); SEAM(); }
#else
        if (RUN(pb + 5)) { OTID(); for (int it = bid; it < 256; it += G) xattn2_item(a, l, it, lds, tid); SEAM(); }
#endif
        if (RUN(pb + 6)) {
            pg8::Gemm g{WB(WS_OX), WB(WS_WO + l * SZ_WO), M, D, 256}; pg8::StaticOrder S; S.init(M, D, G, bid);
            EpiResid E{a.out, a.out, WB(WS_HB), WF(WS_SS)}; pg8::gemm_phase<EpiResid, pg8::StaticOrder, true, true>(lds, g, S, E); SEAM();
        }
        if (l == 0) {
            if (RUN(8)) {
                pg8::Gemm g{WB(WS_HB), WB(WS_W13), M, 2 * DFF, D}; pg8::StaticOrder S; S.init(M, 2 * DFF, G, bid);
                EpiSwiglu<false> E{WB(WS_FACT), DFF, WF(WS_SS), nullptr, nullptr}; pg8::gemm_phase<EpiSwiglu<false>, pg8::StaticOrder, true, true>(lds, g, S, E); SEAM();
            }
            if (RUN(9)) {
                pg8::Gemm g{WB(WS_FACT), WB(WS_W2), M, D, DFF}; pg8::StaticOrder S; S.init(M, D, G, bid);
                EpiResid E{a.out, a.out, WB(WS_HB), WF(WS_SS)}; pg8::gemm_phase<EpiResid, pg8::StaticOrder, true, true>(lds, g, S, E); SEAM();
            }
        } else {
            if (RUN(17)) { OTID(); moe_route(a, lds, tid, G); SEAM(); }
#ifdef REP_ROUTE
            if (RUN(18)) { int nrep = 2; asm volatile("" : "+s"(nrep));
#pragma unroll 1
                for (int rep = 0; rep < nrep; ++rep) { OTID(); moe_assign(a, lds, tid, G); __syncthreads(); } SEAM(); }
#else
            if (RUN(18)) { OTID(); moe_assign(a, lds, tid, G); SEAM(); }
#endif
            for (int p = 0; p < MOE_NPASS; ++p) {
                const int* TILEE = (const int*)(ws + WS_TILEE);
                if (RUN(19 + 2 * p)) {
                    const int NT = TILEE[159]; int nt = NT - p * MOE_TP; nt = nt < 0 ? 0 : (nt > MOE_TP ? MOE_TP : nt);
                    pg8::Gemm g{WB(WS_AG), WB(WS_MW13), MAXSLOT, NEXP * 2 * DFE, D}; pg8::MoeOrder S{p * MOE_TP, nt, 2 * DFE / 256, G, bid, 0, TILEE};
                    EpiSwiglu<true> E{WB(WS_MACT), DFE, nullptr, WF(WS_SLOTR), WF(WS_SLOTG)};
                    pg8::gemm_phase<EpiSwiglu<true>, pg8::MoeOrder, true, true>(lds, g, S, E); SEAM();
                }
                if (RUN(20 + 2 * p)) {
                    const int NT = TILEE[159]; int nt = NT - p * MOE_TP; nt = nt < 0 ? 0 : (nt > MOE_TP ? MOE_TP : nt);
                    pg8::Gemm g{WB(WS_MACT), WB(WS_MW2), MOE_TP * 256, NEXP * D, DFE}; pg8::MoeOrder S{p * MOE_TP, nt, D / 256, G, bid, 1, TILEE};
                    EpiPlain E{WB(WS_YS), D};
                    pg8::gemm_phase<EpiPlain, pg8::MoeOrder, true, true>(lds, g, S, E); SEAM();
                }
            }
            if (RUN(27)) { OTID(); final_phase(a, tid, G); }
        }
    }
#undef RUN
#undef SEAM
}

extern "C" void kernel_launch(void* const* d_in, const int* in_sizes, int n_in, void* d_out, int out_size, void* d_ws, size_t ws_size, hipStream_t stream) {
    static int grid = 0;
    if (grid == 0) {
        if (n_in != N_IN || out_size != M * D || ws_size < WS_END) { fprintf(stderr, "kernel_launch: unexpected problem (n_in %d, out %d, ws %zu < %zu)\n", n_in, out_size, ws_size, (size_t)WS_END); grid = -1; return; }
        int dev = 0, cus = 0, per_cu = 0;
        if (hipGetDevice(&dev) != hipSuccess || hipDeviceGetAttribute(&cus, hipDeviceAttributeMultiprocessorCount, dev) != hipSuccess) { grid = -1; return; }
        if (hipFuncSetAttribute((const void*)fwd_kernel, hipFuncAttributeMaxDynamicSharedMemorySize, LDS_BYTES) != hipSuccess) { fprintf(stderr, "kernel_launch: hipFuncSetAttribute failed\n"); grid = -1; return; }
        if (hipOccupancyMaxActiveBlocksPerMultiprocessor(&per_cu, (const void*)fwd_kernel, NTHR, LDS_BYTES) != hipSuccess || per_cu < 1) { fprintf(stderr, "kernel_launch: occupancy query says %d\n", per_cu); }
        (void)hipGetLastError();
        grid = cus > 0 ? cus : 256;
    }
    if (grid < 0) return;
    (void)hipMemsetAsync((char*)d_ws + WS_CTL, 0, CTL_ZERO_BYTES, stream);
    Args a{};
    for (int i = 0; i < N_IN; ++i) a.in[i] = (const float*)d_in[i];
    a.out = (float*)d_out; a.ws = (unsigned char*)d_ws;
#if N_LAUNCH_MODE == 1
    a.ph_lo = 0; a.ph_hi = NPHASE;
    hipLaunchKernelGGL(fwd_kernel, dim3(grid), dim3(NTHR), LDS_BYTES, stream, a);
#else
    for (int p = 0; p < NPHASE; ++p) { a.ph_lo = p; a.ph_hi = p + 1; hipLaunchKernelGGL(fwd_kernel, dim3(grid), dim3(NTHR), LDS_BYTES, stream, a); }
#endif
}
```

```cpp
#include <hip/hip_runtime.h>
#include <cstdio>
#include <cstdint>
#include <cmath>

#ifndef N_LAUNCH_MODE
#define N_LAUNCH_MODE 1
#endif

namespace pg8 {
#define PG8_LAS __attribute__((address_space(3)))
typedef unsigned short bf16_t;
typedef short bf16x8 __attribute__((ext_vector_type(8)));
typedef float f32x4 __attribute__((ext_vector_type(4)));
typedef unsigned u32x4 __attribute__((ext_vector_type(4)));
constexpr int BM = 256, BK = 64, HALF = 128, HTB = HALF * BK * 2  , STAGE_BYTES = 8 * HTB, NXCD = 8, WGM = 8;

__host__ __device__ __forceinline__ int lds_byte(int r, int c) { const int st = (r >> 4) * 2 + (c >> 5), rr = r & 15, cc = c & 31, ob = rr * 64 + cc * 2; return st * 1024 + (ob ^ (((ob >> 9) & 1) << 5)); }
__host__ __device__ __forceinline__ void stage_rc(int b, int& R, int& C) { const int st = b / 1024, sb = b % 1024, swz = sb ^ (((sb >> 9) & 1) << 5); R = (st >> 1) * 16 + swz / 64; C = (st & 1) * 32 + (swz % 64) / 2; }
__host__ __device__ __forceinline__ int perm32(int rho) { const int n = rho >> 4, i = rho & 15; return 8 * (i >> 2) + 4 * n + (i & 3); }

struct Unit { int pm, pn, po, e; };
struct Gemm { const bf16_t* A; const bf16_t* Bt; int M, N, K; const int* rowmap; };

struct StaticOrder {
    int nM, nN, nwg, G, c;
    __host__ __device__ void init(int M, int N, int G_, int c_) { nM = M / BM; nN = N / BM; nwg = nM * nN; G = G_; c = c_; }
    __host__ __device__ bool next(int i, Unit& u) const {
        const long L = (long)i * G + c; if (L >= nwg) return false;
        int wgid = (int)L; { const int q = nwg / NXCD, r = nwg % NXCD, xcd = wgid % NXCD, off = wgid / NXCD; wgid = (xcd < r ? xcd * (q + 1) : r * (q + 1) + (xcd - r) * q) + off; }
        const int nig = WGM * nN, gid = wgid / nig, fm = gid * WGM, gsz = (nM - fm) < WGM ? (nM - fm) : WGM;
        u.pm = fm + ((wgid % nig) % gsz); u.pn = (wgid % nig) / gsz; u.po = u.pm; u.e = u.pn; return true;
    }
    __device__ __forceinline__ void a_ready(const Unit&) const {}
    __device__ __forceinline__ void done(const Unit&) const {}
};
struct MoeOrder {
    int t0, nt, nNe, G, c, a_local; const int* tile_e; int nd, sh;
    __device__ bool next(int i, Unit& u) const {
        const int F = G - nd; long L;
        if (c >= nd) L = (i < sh) ? (long)i * F + (c - nd) : (long)sh * F + (long)(i - sh) * G + c; else L = (long)sh * F + (long)i * G + c;
        if (L >= (long)nt * nNe) return false;
        const int tl = (int)(L % nt), pn = (int)(L / nt), tile = t0 + tl, e = tile_e[tile];
        u.pm = a_local ? tl : tile; u.po = a_local ? tile : tl; u.pn = e * nNe + pn; u.e = pn; return true;
    }
    __device__ __forceinline__ void a_ready(const Unit&) const {}
    __device__ __forceinline__ void done(const Unit&) const {}
};
__device__ __forceinline__ unsigned cvt_pk_bf16(float lo, float hi) { unsigned r; asm volatile("v_cvt_pk_bf16_f32 %0, %1, %2" : "=v"(r) : "v"(lo), "v"(hi)); return r; }
template <class Epi, class Sched, bool ALIGN_EPI = false, bool SP2 = false, bool GATHER = false>
__device__ __forceinline__ void gemm_phase(PG8_LAS unsigned char* lds, const Gemm g, const Sched& S, const Epi& E, int wave_id) {
    unsigned lane_; asm volatile("v_mbcnt_lo_u32_b32 %0, -1, 0\n\tv_mbcnt_hi_u32_b32 %0, -1, %0" : "=v"(lane_)); const int tid_ = wave_id * 64 + (int)lane_; const int tid = tid_, wid = __builtin_amdgcn_readfirstlane(tid >> 6), lane = tid & 63, wr = wid >> 2, wc = wid & 3, fr = lane & 15, fq = lane >> 4;
    static_assert(!GATHER || SP2, "gather staging is written for the two-super-phase loop");
    const int K = g.K, nt = K / BK;
    unsigned voffA[2], voffB[2];
#pragma unroll
    for (int i = 0; i < 2; ++i) { int R, C; stage_rc(tid * 16 + i * 8192, R, C); const int Rb = Epi::PERM ? ((R & ~31) + perm32(R & 31)) : R;
        voffA[i] = (unsigned)(R * K + C) * 2u; voffB[i] = (unsigned)(Rb * K + C) * 2u; }
    unsigned vgC[2][2], vgN[2][2];
#define PG8_GOFF(dst, pm_) do { if constexpr (GATHER) { _Pragma("unroll") for (int _h = 0; _h < 2; ++_h) _Pragma("unroll") for (int _i = 0; _i < 2; ++_i) \
        { int _R, _C; stage_rc(tid * 16 + _i * 8192, _R, _C); dst[_h][_i] = ((unsigned)g.rowmap[(pm_) * BM + _h * HALF + _R] * (unsigned)K + (unsigned)_C) * 2u; } } } while (0)
    const size_t kstep = (size_t)(BK * 2);
    const size_t hstep = (size_t)HALF * K * 2;
    const size_t tstep = 2 * hstep;
    const unsigned ldsw = (unsigned)wid * 1024u;
    const int aoff = lds_byte(wr * 64 + fr, fq * 8), boff = lds_byte(wc * 32 + fr, fq * 8);
#define PG8_SA(b, h) (((b) * 2 + (h)) * HTB)
#define PG8_SB(b, h) ((4 + (b) * 2 + (h)) * HTB)
#define PG8_STAGE_A(b, h, gbase, vg) do { if constexpr (GATHER) { PG8_STAGE(PG8_SA(b, h), gbase, vg[h]); } else { PG8_STAGE(PG8_SA(b, h), (gbase) + (h) * hstep, voffA); } } while (0)
#define PG8_STAGE(bufoff, gbase, voff) do { _Pragma("unroll") for (int _i = 0; _i < 2; ++_i) \
        __builtin_amdgcn_global_load_lds((const unsigned*)((const char*)(gbase) + (voff)[_i]), (PG8_LAS unsigned*)(lds + (bufoff) + ldsw + _i * 8192), 16, 0, 0); } while (0)
#define PG8_LDA(dst, b, h) do { _Pragma("unroll") for (int m = 0; m < 4; ++m) _Pragma("unroll") for (int k = 0; k < 2; ++k) dst[m][k] = *(const PG8_LAS bf16x8*)(lds + PG8_SA(b, h) + aoff + m * 2048 + k * 1024); } while (0)
#define PG8_LDB(dst, b, h) do { _Pragma("unroll") for (int n = 0; n < 2; ++n) _Pragma("unroll") for (int k = 0; k < 2; ++k) dst[n][k] = *(const PG8_LAS bf16x8*)(lds + PG8_SB(b, h) + boff + n * 2048 + k * 1024); } while (0)
#define PG8_MMA(ai, bj, At, Bt) do { __builtin_amdgcn_s_setprio(1); _Pragma("unroll") for (int m = 0; m < 4; ++m) _Pragma("unroll") for (int n = 0; n < 2; ++n) _Pragma("unroll") for (int k = 0; k < 2; ++k) \
        acc[ai][bj][m][n] = __builtin_amdgcn_mfma_f32_16x16x32_bf16(Bt[n][k], At[m][k], acc[ai][bj][m][n], 0, 0, 0); __builtin_amdgcn_s_setprio(0); } while (0)
#define PG8_WAIT_V(n) asm volatile("s_waitcnt vmcnt(" #n ")" ::: "memory")
#define PG8_WAIT_L(n) asm volatile("s_waitcnt lgkmcnt(" #n ")" ::: "memory")
#define PG8_BAR __builtin_amdgcn_s_barrier()
#define PG8_SCHED __builtin_amdgcn_sched_barrier(0)
    Unit cur, nxt; int ui = 0;
    if (!S.next(0, cur)) return;
    f32x4 acc[2][2][4][2];
#pragma unroll
    for (int a = 0; a < 2; ++a)
#pragma unroll
        for (int b = 0; b < 2; ++b)
#pragma unroll
            for (int m = 0; m < 4; ++m)
#pragma unroll
                for (int n = 0; n < 2; ++n) acc[a][b][m][n] = (f32x4){0.f, 0.f, 0.f, 0.f};
    bf16x8 At[4][2], B0[2][2], B1[2][2];
    const char* cA = (const char*)g.A + (GATHER ? (size_t)0 : (size_t)cur.pm * tstep); const char* cB = (const char*)g.Bt + (size_t)cur.pn * tstep;
    PG8_GOFF(vgC, cur.pm);
    S.a_ready(cur);
    if constexpr (SP2) {
        PG8_STAGE(PG8_SB(0, 0), cB, voffB); PG8_STAGE(PG8_SB(0, 1), cB + hstep, voffB); PG8_STAGE_A(0, 0, cA, vgC); PG8_STAGE_A(0, 1, cA, vgC);
        if (wr == 1) PG8_BAR;
        PG8_WAIT_V(2); PG8_BAR;
        PG8_STAGE(PG8_SB(1, 0), cB + kstep, voffB); PG8_STAGE_A(1, 0, cA + kstep, vgC); PG8_STAGE(PG8_SB(1, 1), cB + hstep + kstep, voffB);
        PG8_WAIT_V(6); PG8_BAR;
    } else {
        PG8_STAGE(PG8_SB(0, 0), cB, voffB); PG8_STAGE(PG8_SA(0, 0), cA, voffA); PG8_STAGE(PG8_SB(0, 1), cB + hstep, voffB); PG8_STAGE(PG8_SA(0, 1), cA + hstep, voffA);
        if (wr == 1) PG8_BAR;
        PG8_WAIT_V(4); PG8_BAR;
        PG8_STAGE(PG8_SB(1, 0), cB + kstep, voffB); PG8_STAGE(PG8_SA(1, 0), cA + kstep, voffA); PG8_STAGE(PG8_SB(1, 1), cB + hstep + kstep, voffB);
        PG8_WAIT_V(6); PG8_BAR;
    }
    for (;;) {
        const bool has_next = S.next(ui + 1, nxt);
        const char* nA = (has_next && !GATHER) ? (const char*)g.A + (size_t)nxt.pm * tstep : cA; const char* nB = has_next ? (const char*)g.Bt + (size_t)nxt.pn * tstep : cB;
        if constexpr (GATHER) { if (has_next) { PG8_GOFF(vgN, nxt.pm); } else { _Pragma("unroll") for (int _h = 0; _h < 2; ++_h) _Pragma("unroll") for (int _i = 0; _i < 2; ++_i) vgN[_h][_i] = vgC[_h][_i]; } }
        for (int t = 0; t < nt; t += 2) {
            const bool last = (t == nt - 2);
            const char* a1 = cA + (size_t)(t + 1) * kstep;
            const char* a2 = last ? nA : cA + (size_t)(t + 2) * kstep; const char* b2 = last ? nB : cB + (size_t)(t + 2) * kstep;
            const char* a3 = a2 + kstep; const char* b3 = b2 + kstep;
            if (last && has_next) S.a_ready(nxt);
            if constexpr (SP2) {
            PG8_LDB(B0, 0, 0); PG8_LDB(B1, 0, 1); PG8_SCHED; PG8_LDA(At, 0, 0); PG8_STAGE_A(1, 1, a1, vgC);
            if constexpr (GATHER) { if (last) { _Pragma("unroll") for (int _h = 0; _h < 2; ++_h) _Pragma("unroll") for (int _i = 0; _i < 2; ++_i) vgC[_h][_i] = vgN[_h][_i]; } }
            PG8_WAIT_V(8); PG8_WAIT_L(0); PG8_BAR; PG8_MMA(0, 0, At, B0); PG8_MMA(0, 1, At, B1); PG8_BAR; PG8_SCHED;
            PG8_LDA(At, 0, 1); PG8_STAGE(PG8_SB(0, 0), b2, voffB); PG8_STAGE(PG8_SB(0, 1), b2 + hstep, voffB); PG8_STAGE_A(0, 0, a2, vgC);
            PG8_WAIT_V(8); PG8_WAIT_L(0); PG8_BAR; PG8_MMA(1, 0, At, B0); PG8_MMA(1, 1, At, B1); PG8_BAR; PG8_SCHED;
            PG8_LDB(B0, 1, 0); PG8_LDB(B1, 1, 1); PG8_SCHED; PG8_LDA(At, 1, 0); PG8_STAGE_A(0, 1, a2, vgC);
            PG8_WAIT_V(8); PG8_WAIT_L(0); PG8_BAR; PG8_MMA(0, 0, At, B0); PG8_MMA(0, 1, At, B1); PG8_BAR; PG8_SCHED;
            PG8_LDA(At, 1, 1); PG8_STAGE(PG8_SB(1, 0), b3, voffB); PG8_STAGE(PG8_SB(1, 1), b3 + hstep, voffB); PG8_STAGE_A(1, 0, a3, vgC);
            PG8_WAIT_V(8); PG8_WAIT_L(0); PG8_BAR; PG8_MMA(1, 0, At, B0); PG8_MMA(1, 1, At, B1); PG8_BAR; PG8_SCHED;
            } else {
            PG8_LDB(B0, 0, 0); PG8_SCHED; PG8_LDA(At, 0, 0); PG8_STAGE(PG8_SA(1, 1), a1 + hstep, voffA);
            PG8_WAIT_L(8); PG8_BAR; PG8_WAIT_L(0); PG8_MMA(0, 0, At, B0); PG8_BAR; PG8_SCHED;
            PG8_LDB(B1, 0, 1); PG8_STAGE(PG8_SB(0, 0), b2, voffB);
            PG8_BAR; PG8_WAIT_L(0); PG8_MMA(0, 1, At, B1); PG8_BAR;
            PG8_LDA(At, 0, 1); PG8_STAGE(PG8_SA(0, 0), a2, voffA);
            PG8_BAR; PG8_WAIT_L(0); PG8_MMA(1, 0, At, B0); PG8_BAR; PG8_SCHED;
            PG8_STAGE(PG8_SB(0, 1), b2 + hstep, voffB);
            PG8_WAIT_V(6); PG8_BAR; PG8_MMA(1, 1, At, B1); PG8_BAR;
            PG8_LDB(B0, 1, 0); PG8_SCHED; PG8_LDA(At, 1, 0); PG8_STAGE(PG8_SA(0, 1), a2 + hstep, voffA);
            PG8_WAIT_L(8); PG8_BAR; PG8_WAIT_L(0); PG8_MMA(0, 0, At, B0); PG8_BAR; PG8_SCHED;
            PG8_LDB(B1, 1, 1); PG8_STAGE(PG8_SB(1, 0), b3, voffB);
            PG8_BAR; PG8_WAIT_L(0); PG8_MMA(0, 1, At, B1); PG8_BAR;
            PG8_LDA(At, 1, 1); PG8_STAGE(PG8_SA(1, 0), a3, voffA);
            PG8_BAR; PG8_WAIT_L(0); PG8_MMA(1, 0, At, B0); PG8_BAR; PG8_SCHED;
            PG8_STAGE(PG8_SB(1, 1), b3 + hstep, voffB);
            PG8_WAIT_V(6); PG8_BAR; PG8_MMA(1, 1, At, B1); PG8_BAR;
            }
        }
        if constexpr (ALIGN_EPI) { if (wr == 0) PG8_BAR; }
        if constexpr (!Epi::AFTER_DRAIN) { E(acc, cur, wr, wc, fr, fq); S.done(cur); }
        if (!has_next) break;
#pragma unroll
        for (int a = 0; a < 2; ++a)
#pragma unroll
            for (int b = 0; b < 2; ++b)
#pragma unroll
                for (int m = 0; m < 4; ++m)
#pragma unroll
                    for (int n = 0; n < 2; ++n) acc[a][b][m][n] = (f32x4){0.f, 0.f, 0.f, 0.f};
        cur = nxt; cA = nA; cB = nB; ++ui;
        if constexpr (ALIGN_EPI) { if (wr == 1) PG8_BAR; }
    }
    PG8_WAIT_V(0);
    if constexpr (!ALIGN_EPI) { if (wr == 0) PG8_BAR; }
    PG8_BAR;
    if constexpr (Epi::AFTER_DRAIN) { E.fused(acc, cur, wr, wc, fr, fq, lds, wid, lane); S.done(cur); }
#undef PG8_SA
#undef PG8_SB
#undef PG8_STAGE
#undef PG8_STAGE_A
#undef PG8_GOFF
#undef PG8_LDA
#undef PG8_LDB
#undef PG8_MMA
#undef PG8_WAIT_V
#undef PG8_WAIT_L
#undef PG8_BAR
#undef PG8_SCHED
}
}

constexpr int BATCH = 8, T = 2048, D = 1024, M = BATCH * T, MEMLEN = 256, MM = BATCH * MEMLEN;
constexpr int INW = 2616, ZW = 2816;
constexpr int DFF = 2816, NEXP = 8, DFE = 3584;
constexpr float EPS = 1e-6f;
constexpr int Z_AQ = 0, Z_AK = 128, Z_AV = 256, Z_AG = 512, Z_ALR = 768, Z_BU = 784, Z_CQ = 1040, Z_CK = 1296, Z_CV = 1552, Z_CQI = 1808, Z_CKI = 2064, Z_CWI = 2096, Z_DUV = 2104;
constexpr int NWAVES = 8, NTHR = 512;
constexpr int MOE_TP = 34, MOE_NPASS = 4, MOE_MAXT = MOE_TP * MOE_NPASS;
constexpr int MAXSLOT = MOE_MAXT * 256;

constexpr size_t MiB = 1u << 20;
constexpr size_t al(size_t x) { return (x + 4095) & ~(size_t)4095; }
constexpr size_t WS_CTL = 0, CTL_ZERO_BYTES = 1 * MiB;
constexpr size_t WS_SS = 1 * MiB;
constexpr size_t WS_SSM = WS_SS + al((size_t)M * 16 * 4);
constexpr size_t WS_TOKE = WS_SSM + al((size_t)MM * 16 * 4);
constexpr size_t WS_TOKG = WS_TOKE + al((size_t)M * 8);
constexpr size_t WS_TOKR = WS_TOKG + al((size_t)M * 8);
constexpr size_t WS_TOKS = WS_TOKR + al((size_t)M * 4);
constexpr size_t WS_CNT = WS_TOKS + al((size_t)M * 8);
constexpr size_t WS_TILEE = WS_CNT + al(256 * 8 * 4);
constexpr size_t WS_SLOTR = WS_TILEE + al(160 * 4);
constexpr size_t WS_SLOTG = WS_SLOTR + al((size_t)MAXSLOT * 4);
constexpr size_t WS_SLOTT = WS_SLOTG + al((size_t)MAXSLOT * 4);
constexpr size_t WS_SWT = al(WS_SLOTT + (size_t)MAXSLOT * 4);
constexpr size_t WS_PWT = WS_SWT + (size_t)2 * 4 * 128 * 128 * 2;
constexpr size_t WS_WIN = al(WS_PWT + (size_t)2 * 4 * 64 * 64 * 2 + MiB);
constexpr size_t SZ_WIN = (size_t)ZW * D * 2, SZ_WOUT = (size_t)D * D * 2, SZ_WQ = (size_t)256 * D * 2, SZ_WKV = (size_t)512 * D * 2, SZ_WO = (size_t)D * 256 * 2;
constexpr size_t WS_WOUT = WS_WIN + 2 * SZ_WIN, WS_WQ = WS_WOUT + 2 * SZ_WOUT, WS_WKV = WS_WQ + 2 * SZ_WQ, WS_WO = WS_WKV + 2 * SZ_WKV;
constexpr size_t WS_W13 = WS_WO + 2 * SZ_WO, WS_W2 = WS_W13 + (size_t)2 * DFF * D * 2, WS_MW13 = WS_W2 + (size_t)D * DFF * 2;
constexpr size_t WS_MW2 = WS_MW13 + (size_t)NEXP * 2 * DFE * D * 2, WS_KVM = WS_MW2 + (size_t)NEXP * D * DFE * 2;
constexpr size_t SZ_KVM = (size_t)MM * 512 * 2;
constexpr size_t WS_MEMB = WS_KVM + 2 * SZ_KVM;
constexpr size_t WS_ACT = al(WS_MEMB + (size_t)MM * D * 2);
constexpr size_t WS_HB = WS_ACT, WS_Z = WS_HB + (size_t)M * D * 2, WS_MIX = WS_Z + (size_t)M * ZW * 2, WS_QX = WS_MIX + (size_t)M * D * 2, WS_OX = WS_QX + (size_t)M * 256 * 2;
constexpr size_t WS_GOI = WS_OX + (size_t)M * 256 * 2, WS_GQT = WS_GOI + (size_t)M * 256 * 4, WS_GKV = WS_GQT + (size_t)M * 128 * 4, WS_GDEC = WS_GKV + (size_t)1024 * 2048 * 4;
constexpr size_t WS_ACT_END = WS_GDEC + (size_t)1024 * 32 * 4;
constexpr size_t WS_FACT = WS_Z;
constexpr size_t SZ_MACT = (size_t)MOE_TP * 256 * DFE * 2;
constexpr size_t WS_MACT = WS_HB + (size_t)M * D * 2, WS_YS = WS_MACT + 2 * SZ_MACT, WS_MOE_END = WS_YS + (size_t)MAXSLOT * D * 2;
constexpr size_t WS_DSC = WS_ACT_END;
constexpr size_t WS_END = WS_DSC + (size_t)128 * 262144;
static_assert(WS_MOE_END <= WS_END, "MoE overlays fit");
constexpr int CW_BAR = 4096;

constexpr int LDS_BYTES = 147456;
constexpr int MISC_OFF = 147456 - 512;
constexpr int SCR_BYTES = MISC_OFF, ARGS_OFF = MISC_OFF + 128;

#define GAS __attribute__((address_space(1)))
#define LAS __attribute__((address_space(3)))
typedef unsigned short bf16;
typedef unsigned v4u __attribute__((ext_vector_type(4)));
typedef unsigned v2u __attribute__((ext_vector_type(2)));
typedef float f32x4 __attribute__((ext_vector_type(4)));
typedef GAS unsigned gu32;
#define RLX_AGENT __ATOMIC_RELAXED, __HIP_MEMORY_SCOPE_AGENT
#define LDS_WAIT() asm volatile("s_waitcnt lgkmcnt(0)" ::: "memory")
#define LDS_ADD(p, v) (void)__hip_atomic_fetch_add((p), (v), __ATOMIC_RELAXED, __HIP_MEMORY_SCOPE_WORKGROUP)
__device__ __forceinline__ unsigned f2bf(float f) { unsigned u = __builtin_bit_cast(unsigned, f); return (u + 0x7fffu + ((u >> 16) & 1u)) >> 16; }
__device__ __forceinline__ unsigned pk2(float lo, float hi) { return f2bf(lo) | (f2bf(hi) << 16); }
__device__ __forceinline__ float bflo(unsigned w) { return __builtin_bit_cast(float, w << 16); }
__device__ __forceinline__ float bfhi(unsigned w) { return __builtin_bit_cast(float, w & 0xffff0000u); }
__device__ __forceinline__ float bf1(bf16 b) { return __builtin_bit_cast(float, ((unsigned)b) << 16); }
__device__ __forceinline__ unsigned lane_id_now() { unsigned l; asm volatile("v_mbcnt_lo_u32_b32 %0, -1, 0\n\tv_mbcnt_hi_u32_b32 %0, -1, %0" : "=v"(l)); return l; }
template <int MASK> __device__ __forceinline__ float shfl_xor_c(float v) {
    if constexpr (MASK < 32) return __builtin_bit_cast(float, __builtin_amdgcn_ds_swizzle(__builtin_bit_cast(int, v), (MASK << 10) | 0x1f));
    else return __builtin_bit_cast(float, __builtin_amdgcn_ds_bpermute((int)((lane_id_now() ^ 32u) << 2), __builtin_bit_cast(int, v)));
}
__device__ __forceinline__ float shfl_idx(float v, int src_lane) { return __builtin_bit_cast(float, __builtin_amdgcn_ds_bpermute(src_lane << 2, __builtin_bit_cast(int, v))); }
__device__ __forceinline__ unsigned shfl_idx_u(unsigned v, int src_lane) { return (unsigned)__builtin_amdgcn_ds_bpermute(src_lane << 2, (int)v); }
__device__ __forceinline__ float wave_sum(float v) {
    v += shfl_xor_c<1>(v); v += shfl_xor_c<2>(v); v += shfl_xor_c<4>(v); v += shfl_xor_c<8>(v); v += shfl_xor_c<16>(v); v += shfl_xor_c<32>(v);
    return v;
}
__device__ __forceinline__ float wave_max(float v) {
    v = fmaxf(v, shfl_xor_c<1>(v)); v = fmaxf(v, shfl_xor_c<2>(v)); v = fmaxf(v, shfl_xor_c<4>(v)); v = fmaxf(v, shfl_xor_c<8>(v)); v = fmaxf(v, shfl_xor_c<16>(v)); v = fmaxf(v, shfl_xor_c<32>(v));
    return v;
}
#define XB_TMO      128
#define XB_XCNT(j)  (256  + 64 * (j))
#define XB_XSUB(j)  (1280 + 64 * (j))
#define XB_XGEN(j)  (2304 + 64 * (j))
#define XB_TOP      3328
#define XB_TOPGEN   3392
#define XCD_BAR_WORDS 3456
#define XB_SPIN_CAP (1u << 18)

__device__ __forceinline__ unsigned xb_ld(unsigned* p)              { return __hip_atomic_load(p, __ATOMIC_RELAXED, __HIP_MEMORY_SCOPE_AGENT); }
__device__ __forceinline__ unsigned xb_add(unsigned* p, unsigned v) { return __hip_atomic_fetch_add(p, v, __ATOMIC_RELAXED, __HIP_MEMORY_SCOPE_AGENT); }
__device__ __forceinline__ unsigned xb_xcc_id() { return (unsigned)__builtin_amdgcn_s_getreg((3 << 11) | 20) & 0xFu; }
#define XB_SPIN(cond, bar) do { unsigned _sp = 0; while (cond) { __builtin_amdgcn_s_sleep(1); \
    if ((++_sp & 255u) == 0u) { if (xb_ld(&(bar)[XB_TMO])) break; if (_sp > XB_SPIN_CAP) { atomicAdd(&(bar)[XB_TMO], 1u); break; } } } } while (0)

struct XcdBarrier {
    unsigned* bar; unsigned x; unsigned wid;
    volatile LAS unsigned* st;
};

__device__ __forceinline__ XcdBarrier xcd_barrier_post(unsigned* bar, volatile LAS unsigned* st) {
    XcdBarrier b; b.bar = bar; b.x = xb_xcc_id(); b.st = st; b.wid = (unsigned)__builtin_amdgcn_readfirstlane(threadIdx.x >> 6);
    if (threadIdx.x == 0) (void)xb_add(&bar[XB_XCNT(b.x)], 1u);
    return b;
}
__device__ __forceinline__ void xcd_barrier_complete(unsigned* bar, unsigned x, unsigned& nloc, unsigned& nx) {
    const unsigned G = gridDim.x * gridDim.y * gridDim.z;
    unsigned sum, cnt, mine, sp = 0u;
    for (;;) {
        sum = 0u; cnt = 0u; mine = 0u;
#pragma unroll
        for (unsigned j = 0; j < 16; ++j) { const unsigned c = xb_ld(&bar[XB_XCNT(j)]); sum += c; cnt += (c > 0u) ? 1u : 0u; mine = (j == x) ? c : mine; }
        if (sum == G) break;
        __builtin_amdgcn_s_sleep(1);
        if ((++sp & 255u) == 0u) { if (xb_ld(&bar[XB_TMO])) break; if (sp > XB_SPIN_CAP) { atomicAdd(&bar[XB_TMO], 1u); break; } }
    }
    nloc = mine > 0u ? mine : 1u; nx = cnt > 0u ? cnt : 1u;
}

__device__ __forceinline__ void xcd_barrier(const XcdBarrier& b) {
    asm volatile("s_waitcnt vmcnt(0)" ::: "memory");
    __syncthreads();
    if (b.wid == 0u && lane_id_now() == 0u) {
        unsigned* bar = b.bar;
        __builtin_amdgcn_s_waitcnt(0);
        unsigned nloc = b.st[0], nx = b.st[1];
        if (nloc == 0u) { xcd_barrier_complete(bar, b.x, nloc, nx); b.st[0] = nloc; b.st[1] = nx; }
        const unsigned old = xb_add(&bar[XB_XSUB(b.x)], 1u);
        const unsigned gen = old / nloc;
        if (old + 1u == (gen + 1u) * nloc) {
            __builtin_amdgcn_fence(__ATOMIC_RELEASE, "agent");
            asm volatile("s_waitcnt vmcnt(0)" ::: "memory");
            const unsigned og = xb_add(&bar[XB_TOP], 1u);
            const unsigned tg = og / nx;
            if (og + 1u == (tg + 1u) * nx) xb_add(&bar[XB_TOPGEN], 1u);
            else XB_SPIN(xb_ld(&bar[XB_TOPGEN]) == tg, bar);
            __builtin_amdgcn_fence(__ATOMIC_ACQUIRE, "agent");
            xb_add(&bar[XB_XGEN(b.x)], 1u);
            asm volatile("s_waitcnt vmcnt(0)" ::: "memory");
        } else {
            XB_SPIN(xb_ld(&bar[XB_XGEN(b.x)]) == gen, bar);
            __builtin_amdgcn_fence(__ATOMIC_ACQUIRE, "agent");
            asm volatile("s_waitcnt vmcnt(0)" ::: "memory");
        }
    }
    __syncthreads();
}

enum { IN_X = 0, IN_MEM, IN_RELB, IN_FNORM, IN_NMIX, IN_WIN, IN_WA2, IN_BA, IN_GNORM, IN_PW, IN_PB, IN_PS, IN_LNG, IN_LNB, IN_SW, IN_SB, IN_WOUT,
       IN_NXA, IN_NMEM, IN_WQ, IN_WKV, IN_WO, IN_NFFN, IN_F1, IN_F3, IN_F2, IN_ROUTER, IN_M1, IN_M3, IN_M2, N_IN };
struct Args { const float* in[N_IN]; float* out; unsigned char* ws; int ph_lo, ph_hi; };

__device__ __forceinline__ float rstd16(const float* ss, int row) {
    const f32x4* p = (const f32x4*)(ss + (size_t)row * 16);
    const f32x4 a = p[0], b = p[1], c = p[2], d = p[3];
    const float s = (((a.x + a.y) + (a.z + a.w)) + ((b.x + b.y) + (b.z + b.w))) + (((c.x + c.y) + (c.z + c.w)) + ((d.x + d.y) + (d.z + d.w)));
    return rsqrtf(s * (1.0f / 1024.0f) + EPS);
}
__device__ __forceinline__ v4u pack8(const f32x4 a, const f32x4 b) { v4u w; w.x = pg8::cvt_pk_bf16(a.x, a.y); w.y = pg8::cvt_pk_bf16(a.z, a.w); w.z = pg8::cvt_pk_bf16(b.x, b.y); w.w = pg8::cvt_pk_bf16(b.z, b.w); return w; }

struct EpiScale {
    static constexpr bool PERM = true, AFTER_DRAIN = false;
    bf16* O; int ldc; const float* ss; float scale;
    __device__ __forceinline__ void operator()(const pg8::f32x4 (&acc)[2][2][4][2], const pg8::Unit& u, int wr, int wc, int fr, int fq) const {
        const int row0 = u.po * 256 + wr * 64 + fr, col0 = u.e * 256 + wc * 32 + 8 * fq;
#pragma unroll
        for (int ai = 0; ai < 2; ++ai)
#pragma unroll
            for (int m = 0; m < 4; ++m) { const int row = row0 + ai * 128 + m * 16; const float r = rstd16(ss, row) * scale; bf16* rowp = O + (size_t)row * ldc + col0;
#pragma unroll
                for (int bj = 0; bj < 2; ++bj) *(v4u*)(rowp + bj * 128) = pack8(acc[ai][bj][m][0] * r, acc[ai][bj][m][1] * r); }
    }
};
struct EpiResid {
    static constexpr bool PERM = true, AFTER_DRAIN = false;
    const float* res; float* H; bf16* HB; float* SS;
    __device__ __forceinline__ void operator()(const pg8::f32x4 (&acc)[2][2][4][2], const pg8::Unit& u, int wr, int wc, int fr, int fq) const {
        const int row0 = u.po * 256 + wr * 64 + fr, col0 = u.e * 256 + wc * 32 + 8 * fq;
#pragma unroll
        for (int ai = 0; ai < 2; ++ai)
#pragma unroll
            for (int m = 0; m < 4; ++m) { const int row = row0 + ai * 128 + m * 16; const size_t off = (size_t)row * D + col0; float q = 0.f;
#pragma unroll
                for (int bj = 0; bj < 2; ++bj) {
                    const f32x4 r0 = *(const f32x4*)(res + off + bj * 128), r1 = *(const f32x4*)(res + off + bj * 128 + 4);
                    const f32x4 v0 = acc[ai][bj][m][0] + r0, v1 = acc[ai][bj][m][1] + r1;
                    *(f32x4*)(H + off + bj * 128) = v0; *(f32x4*)(H + off + bj * 128 + 4) = v1;
                    *(v4u*)(HB + off + bj * 128) = pack8(v0, v1);
                    q += ((v0.x * v0.x + v0.y * v0.y) + (v0.z * v0.z + v0.w * v0.w)) + ((v1.x * v1.x + v1.y * v1.y) + (v1.z * v1.z + v1.w * v1.w)); }
                q += shfl_xor_c<16>(q); q += shfl_xor_c<32>(q);
                if (fq == 0) SS[(size_t)row * 16 + u.e * 4 + wc] = q; }
    }
};
__device__ __forceinline__ float silu_f(float x) { return x * __builtin_amdgcn_rcpf(1.0f + __expf(-x)); }
template <bool MOE> struct EpiSwiglu {
    static constexpr bool PERM = true, AFTER_DRAIN = false;
    bf16* O; int ldc; const float* ss; const float* slot_r; const float* slot_g;
    __device__ __forceinline__ void operator()(const pg8::f32x4 (&acc)[2][2][4][2], const pg8::Unit& u, int wr, int wc, int fr, int fq) const {
        const int rin0 = u.pm * 256 + wr * 64 + fr, rout0 = u.po * 256 + wr * 64 + fr, col0 = u.e * 128 + wc * 32 + 8 * fq;
#pragma unroll
        for (int ai = 0; ai < 2; ++ai)
#pragma unroll
            for (int m = 0; m < 4; ++m) { const int rin = rin0 + ai * 128 + m * 16, rout = rout0 + ai * 128 + m * 16;
                float r, gt; if (MOE) { r = slot_r[rin]; gt = slot_g[rin]; } else { r = rstd16(ss, rin); gt = 1.0f; }
                f32x4 o0, o1;
#pragma unroll
                for (int j = 0; j < 4; ++j) { o0[j] = silu_f(acc[ai][0][m][0][j] * r) * (acc[ai][1][m][0][j] * r) * gt; o1[j] = silu_f(acc[ai][0][m][1][j] * r) * (acc[ai][1][m][1][j] * r) * gt; }
                *(v4u*)(O + (size_t)rout * ldc + col0) = pack8(o0, o1); }
    }
};
struct EpiPlain {
    static constexpr bool PERM = true, AFTER_DRAIN = false;
    bf16* O; int ldc;
    __device__ __forceinline__ void operator()(const pg8::f32x4 (&acc)[2][2][4][2], const pg8::Unit& u, int wr, int wc, int fr, int fq) const {
        const int row0 = u.po * 256 + wr * 64 + fr, col0 = u.e * 256 + wc * 32 + 8 * fq;
#pragma unroll
        for (int ai = 0; ai < 2; ++ai)
#pragma unroll
            for (int m = 0; m < 4; ++m) { bf16* rowp = O + (size_t)(row0 + ai * 128 + m * 16) * ldc + col0;
#pragma unroll
                for (int bj = 0; bj < 2; ++bj) *(v4u*)(rowp + bj * 128) = pack8(acc[ai][bj][m][0], acc[ai][bj][m][1]); }
    }
};

__device__ __forceinline__ void tr_item(const float* W, int N, int K, int k0, int n0, const float* gain, bf16* WT, long dst_row0, LAS float* scr, int lane) {
    const int nn = n0 + lane; const bool ok = nn < N; const float* wp = W + (size_t)k0 * N + (ok ? nn : 0);
    float v[64];
#pragma unroll
    for (int i = 0; i < 64; ++i) v[i] = wp[(size_t)i * N];
#pragma unroll
    for (int i = 0; i < 64; ++i) { float x = ok ? v[i] : 0.f; if (gain) x *= gain[k0 + i]; scr[i * 65 + lane] = x; }
    LDS_WAIT(); asm volatile("" ::: "memory");
    const int c = lane & 7;
#pragma unroll
    for (int j = 0; j < 8; ++j) { const int n = (lane >> 3) + 8 * j; const LAS float* s = scr + (8 * c) * 65 + n;
        v4u o; o.x = pk2(s[0 * 65], s[1 * 65]); o.y = pk2(s[2 * 65], s[3 * 65]); o.z = pk2(s[4 * 65], s[5 * 65]); o.w = pk2(s[6 * 65], s[7 * 65]);
        if (n0 + n < N) *(v4u*)(WT + (size_t)(dst_row0 + n) * K + k0 + 8 * c) = o; }
    LDS_WAIT(); asm volatile("" ::: "memory");
}
__device__ __forceinline__ void conv_job(const float* W, int K, int N, const float* gain, bf16* WT, int mode, LAS float* scr, int gw, int NGW, int lane, long& base) {
    const int nblk = (N + 63) / 64, nitems = (K / 64) * nblk;
    const int first = (int)(((long)gw - (base % NGW) + NGW) % NGW);
    for (int it = first; it < nitems; it += NGW) {
        const int kb = it / nblk, nb = it % nblk, k0 = 64 * kb, n0 = 64 * nb;
        const long dr = (mode == 0) ? (long)n0 : (long)(n0 >> 7) * 256 + (n0 & 127) + (mode == 2 ? 128 : 0);
        tr_item(W, N, K, k0, n0, gain, WT, dr, scr, lane);
    }
    base += nitems;
}
__device__ __forceinline__ void row_cvt(const float* xrow, bf16* orow, float* ssrow, int lane) {
    const f32x4* xr = (const f32x4*)xrow + lane; f32x4 v[4]; float s = 0.f;
#pragma unroll
    for (int j = 0; j < 4; ++j) { v[j] = xr[64 * j]; s += (v[j].x * v[j].x + v[j].y * v[j].y) + (v[j].z * v[j].z + v[j].w * v[j].w); }
    s = wave_sum(s);
    v2u* o8 = (v2u*)orow + lane;
#pragma unroll
    for (int j = 0; j < 4; ++j) { v2u w; w.x = pk2(v[j].x, v[j].y); w.y = pk2(v[j].z, v[j].w); o8[64 * j] = w; }
    if (lane < 16) ssrow[lane] = lane == 0 ? s : 0.f;
}
__device__ __forceinline__ void p0_prologue(const Args& a, LAS unsigned char* lds, int tid, int G) {
    const int lane = tid & 63, wave = tid >> 6, gw = blockIdx.x * NWAVES + wave, NGW = G * NWAVES;
    LAS float* scr = (LAS float*)(lds + wave * 16640);
    unsigned char* ws = a.ws; long base = 0;
    for (int l = 0; l < 2; ++l) {
        conv_job(a.in[IN_WIN] + (size_t)l * D * INW, D, INW, a.in[IN_NMIX] + l * D, (bf16*)(ws + WS_WIN + l * SZ_WIN), 0, scr, gw, NGW, lane, base);
        conv_job(a.in[IN_WOUT] + (size_t)l * D * D, D, D, nullptr, (bf16*)(ws + WS_WOUT + l * SZ_WOUT), 0, scr, gw, NGW, lane, base);
        conv_job(a.in[IN_WQ] + (size_t)l * D * 256, D, 256, a.in[IN_NXA] + l * D, (bf16*)(ws + WS_WQ + l * SZ_WQ), 0, scr, gw, NGW, lane, base);
        conv_job(a.in[IN_WKV] + (size_t)l * D * 512, D, 512, a.in[IN_NMEM] + l * D, (bf16*)(ws + WS_WKV + l * SZ_WKV), 0, scr, gw, NGW, lane, base);
        conv_job(a.in[IN_WO] + (size_t)l * 256 * D, 256, D, nullptr, (bf16*)(ws + WS_WO + l * SZ_WO), 0, scr, gw, NGW, lane, base);
        { v4u* zp = (v4u*)(ws + WS_WIN + l * SZ_WIN + (size_t)INW * D * 2); const int n16 = (ZW - INW) * D * 2 / 16;
          for (int i = blockIdx.x * NTHR + tid; i < n16; i += G * NTHR) zp[i] = (v4u){0u, 0u, 0u, 0u}; }
    }
    conv_job(a.in[IN_F1], D, DFF, a.in[IN_NFFN], (bf16*)(ws + WS_W13), 1, scr, gw, NGW, lane, base);
    conv_job(a.in[IN_F3], D, DFF, a.in[IN_NFFN], (bf16*)(ws + WS_W13), 2, scr, gw, NGW, lane, base);
    conv_job(a.in[IN_F2], DFF, D, nullptr, (bf16*)(ws + WS_W2), 0, scr, gw, NGW, lane, base);
    for (int e = 0; e < NEXP; ++e) {
        conv_job(a.in[IN_M1] + (size_t)e * D * DFE, D, DFE, a.in[IN_NFFN] + D, (bf16*)(ws + WS_MW13) + (size_t)e * 2 * DFE * D, 1, scr, gw, NGW, lane, base);
        conv_job(a.in[IN_M3] + (size_t)e * D * DFE, D, DFE, a.in[IN_NFFN] + D, (bf16*)(ws + WS_MW13) + (size_t)e * 2 * DFE * D, 2, scr, gw, NGW, lane, base);
        conv_job(a.in[IN_M2] + (size_t)e * DFE * D, DFE, D, nullptr, (bf16*)(ws + WS_MW2) + (size_t)e * D * DFE, 0, scr, gw, NGW, lane, base);
    }
    for (int i = blockIdx.x * NTHR + tid; i < 2 * 4 * 128 * 128; i += G * NTHR) { const int s = i & 127, t = (i >> 7) & 127; ((bf16*)(ws + WS_SWT))[i] = (bf16)f2bf(s <= t ? a.in[IN_SW][i] : 0.f); }
    for (int i = blockIdx.x * NTHR + tid; i < 2 * 4 * 64 * 64; i += G * NTHR) { const int c = i & 63, d = (i >> 6) & 63, lg = i >> 12; ((bf16*)(ws + WS_PWT))[i] = (bf16)f2bf(a.in[IN_PW][(size_t)lg * 4096 + c * 64 + d]); }
    for (int m = gw; m < M; m += NGW) row_cvt(a.in[IN_X] + (size_t)m * D, (bf16*)(ws + WS_HB) + (size_t)m * D, (float*)(ws + WS_SS) + (size_t)m * 16, lane);
    for (int m = gw; m < MM; m += NGW) row_cvt(a.in[IN_MEM] + (size_t)m * D, (bf16*)(ws + WS_MEMB) + (size_t)m * D, (float*)(ws + WS_SSM) + (size_t)m * 16, lane);
}

__device__ __forceinline__ float gelu_tanh(float x) { return 0.5f * x * (1.0f + tanhf(0.7978845608028654f * (x + 0.044715f * x * x * x))); }

__device__ __forceinline__ void gla_a_item(const Args& a, int l, int item, LAS unsigned char* lds, int tid) {
    const int n = item & 31, h = (item >> 5) & 3, b = item >> 7, tok0 = b * T + n * 64;
    LAS float* alr = (LAS float*)lds;
    LAS float* wa = alr + 64 * 16;
    LAS float* bb = wa + 16 * 32;
    LAS float* qt = bb + 64 * 33;
    LAS float* kt = qt + 64 * 33;
    LAS float* kd = kt + 64 * 33;
    LAS float* vv = kd + 64 * 33;
    LAS float* att = vv + 64 * 64;
    LAS float* bav = att + 64 * 65;
    const bf16* z = (const bf16*)(a.ws + WS_Z);
    float* OI = (float*)(a.ws + WS_GOI); float* QT = (float*)(a.ws + WS_GQT); float* KV = (float*)(a.ws + WS_GKV); float* DEC = (float*)(a.ws + WS_GDEC);
    for (int i = tid; i < 1024; i += NTHR) alr[i] = bf1(z[(size_t)(tok0 + (i >> 4)) * ZW + Z_ALR + (i & 15)]);
    { const int r = tid >> 5, k = tid & 31; wa[tid] = a.in[IN_WA2][(size_t)l * 16 * 128 + r * 128 + h * 32 + k]; }
    if (tid < 32) bav[tid] = a.in[IN_BA][l * 128 + h * 32 + tid];
    for (int i = tid; i < 4096; i += NTHR) vv[i] = bf1(z[(size_t)(tok0 + (i >> 6)) * ZW + Z_AV + h * 64 + (i & 63)]);
    __syncthreads();
    for (int i = tid; i < 2048; i += NTHR) { const int c = i >> 5, k = i & 31; float x = bav[k];
#pragma unroll
        for (int r = 0; r < 16; ++r) x += alr[c * 16 + r] * wa[r * 32 + k];
        const float ls = fminf(x, 0.f) - log1pf(expf(-fabsf(x)));
        bb[c * 33 + k] = ls * (1.0f / 16.0f); }
    __syncthreads();
    if (tid < 32) { float run = 0.f; for (int c = 0; c < 64; ++c) { run += bb[c * 33 + tid]; bb[c * 33 + tid] = run; } }
    __syncthreads();
    for (int i = tid; i < 2048; i += NTHR) { const int c = i >> 5, k = i & 31; const float bv = bb[c * 33 + k], bl = bb[63 * 33 + k];
        const float q = bf1(z[(size_t)(tok0 + c) * ZW + Z_AQ + h * 32 + k]), kk = bf1(z[(size_t)(tok0 + c) * ZW + Z_AK + h * 32 + k]);
        const float qv = q * 0.17677669529663687f * expf(bv);
        qt[c * 33 + k] = qv; kt[c * 33 + k] = kk * expf(-bv); kd[c * 33 + k] = kk * expf(bl - bv);
        QT[(size_t)(tok0 + c) * 128 + h * 32 + k] = qv; }
    if (tid < 32) DEC[(size_t)item * 32 + tid] = expf(bb[63 * 33 + tid]);
    __syncthreads();
    for (int idx = tid; idx < 4096; idx += NTHR) { const int i = idx >> 6, j = idx & 63; float s = 0.f;
        if (j <= i) {
#pragma unroll 8
            for (int k = 0; k < 32; ++k) s += qt[i * 33 + k] * kt[j * 33 + k]; }
        att[i * 65 + j] = s; }
    __syncthreads();
    for (int idx = tid; idx < 4096; idx += NTHR) { const int i = idx >> 6, v = idx & 63; float s = 0.f;
#pragma unroll 8
        for (int j = 0; j < 64; ++j) s += att[i * 65 + j] * vv[j * 64 + v];
        OI[(size_t)(tok0 + i) * 256 + h * 64 + v] = s; }
    for (int idx = tid; idx < 2048; idx += NTHR) { const int k = idx >> 6, v = idx & 63; float s = 0.f;
#pragma unroll 8
        for (int c = 0; c < 64; ++c) s += kd[c * 33 + k] * vv[c * 64 + v];
        KV[(size_t)item * 2048 + idx] = s; }
    __syncthreads();
}
__device__ __forceinline__ void gla_c_item(const Args& a, int l, int item, LAS unsigned char* lds, int tid) {
    const int n = item & 31, h = (item >> 5) & 3, b = item >> 7, tok0 = b * T + n * 64, lane = tid & 63, w = tid >> 6;
    LAS float* S = (LAS float*)lds;
    LAS float* ql = S + 2048;
    const bf16* z = (const bf16*)(a.ws + WS_Z); bf16* mix = (bf16*)(a.ws + WS_MIX);
    const float* OI = (const float*)(a.ws + WS_GOI); const float* QT = (const float*)(a.ws + WS_GQT); const float* KV = (const float*)(a.ws + WS_GKV); const float* DEC = (const float*)(a.ws + WS_GDEC);
    for (int e = tid; e < 2048; e += NTHR) { const int k = e >> 6; float s = 0.f;
        for (int m = 0; m < n; ++m) { const size_t it = (size_t)(item - n + m); s = s * DEC[it * 32 + k] + KV[it * 2048 + e]; }
        S[e] = s; }
    for (int i = tid; i < 2048; i += NTHR) ql[(i >> 5) * 33 + (i & 31)] = QT[(size_t)(tok0 + (i >> 5)) * 128 + h * 32 + (i & 31)];
    __syncthreads();
    for (int j = 0; j < 8; ++j) { const int i = w + 8 * j; float o = OI[(size_t)(tok0 + i) * 256 + h * 64 + lane];
#pragma unroll 8
        for (int k = 0; k < 32; ++k) o += ql[i * 33 + k] * S[k * 64 + lane];
        const float ms = wave_sum(o * o) * (1.0f / 64.0f);
        float y = o * rsqrtf(ms + EPS) * a.in[IN_GNORM][l * 256 + h * 64 + lane];
        const float g = bf1(z[(size_t)(tok0 + i) * ZW + Z_AG + h * 64 + lane]);
        y *= g / (1.0f + expf(-g));
        mix[(size_t)(tok0 + i) * D + h * 64 + lane] = (bf16)f2bf(y); }
    __syncthreads();
}
__device__ __forceinline__ void pool_item(const Args& a, int l, int item, LAS unsigned char* lds, int tid) {
    const int g = item & 3, tt = (item >> 2) & 31, b = item >> 7, t0 = tt * 64;
    LAS float* u = (LAS float*)lds;
    LAS float* w = u + 79 * 64;
    LAS float* p = w + 4096;
    const bf16* z = (const bf16*)(a.ws + WS_Z); bf16* mix = (bf16*)(a.ws + WS_MIX);
    for (int i = tid; i < 79 * 64; i += NTHR) { const int t = t0 - 15 + (i >> 6); u[i] = t >= 0 ? bf1(z[(size_t)(b * T + t) * ZW + Z_BU + g * 64 + (i & 63)]) : 0.f; }
    for (int i = tid; i < 4096; i += NTHR) w[i] = a.in[IN_PW][(size_t)(l * 4 + g) * 4096 + i];
    __syncthreads();
    const int win = 2 << g;
    for (int i = tid; i < 4096; i += NTHR) { const int tl = i >> 6, c = i & 63, t = t0 + tl, cnt = (t + 1 < win) ? t + 1 : win; float s = 0.f;
        for (int j = 0; j < cnt; ++j) s += u[(tl + 15 - j) * 64 + c];
        p[tl * 65 + c] = s / (float)cnt - u[(tl + 15) * 64 + c]; }
    __syncthreads();
    for (int i = tid; i < 4096; i += NTHR) { const int tl = i >> 6, d = i & 63; float s = a.in[IN_PB][(l * 4 + g) * 64 + d];
#pragma unroll 8
        for (int c = 0; c < 64; ++c) s += p[tl * 65 + c] * w[c * 64 + d];
        s *= a.in[IN_PS][l * 256 + g * 64 + d];
        mix[(size_t)(b * T + t0 + tl) * D + 256 + g * 64 + d] = (bf16)f2bf(s); }
    __syncthreads();
}
__device__ __forceinline__ void sgu_item(const Args& a, int l, int item, LAS unsigned char* lds, int tid) {
    const int g = item & 3, nc = (item >> 2) & 15, b = item >> 6, tok0 = b * T + nc * 128, lane = tid & 63, w = tid >> 6;
    LAS float* vn = (LAS float*)lds;
    const bf16* z = (const bf16*)(a.ws + WS_Z); bf16* mix = (bf16*)(a.ws + WS_MIX);
    for (int j = 0; j < 16; ++j) { const int s = w + 8 * j;
        const v2u raw = *(const v2u*)(z + (size_t)(tok0 + s) * ZW + Z_DUV + 256 + 4 * lane);
        float x[4] = {gelu_tanh(bflo(raw.x)), gelu_tanh(bfhi(raw.x)), gelu_tanh(bflo(raw.y)), gelu_tanh(bfhi(raw.y))};
        const float mu = wave_sum((x[0] + x[1]) + (x[2] + x[3])) * (1.0f / 256.0f);
        float q = 0.f;
#pragma unroll
        for (int i = 0; i < 4; ++i) { x[i] -= mu; q += x[i] * x[i]; }
        const float rstd = rsqrtf(wave_sum(q) * (1.0f / 256.0f) + EPS);
        if ((lane >> 4) == g) {
#pragma unroll
            for (int i = 0; i < 4; ++i) { const int cl = 4 * (lane & 15) + i; vn[s * 64 + cl] = x[i] * rstd * a.in[IN_LNG][l * 256 + g * 64 + cl] + a.in[IN_LNB][l * 256 + g * 64 + cl]; } } }
    __syncthreads();
    const float* sw = a.in[IN_SW] + (size_t)(l * 4 + g) * 128 * 128;
    for (int j = 0; j < 16; ++j) { const int t = w + 8 * j; float acc = a.in[IN_SB][(l * 4 + g) * 128 + t];
        const float* swr = sw + t * 128;
        for (int s = 0; s <= t; ++s) acc += swr[s] * vn[s * 64 + lane];
        const float uu = gelu_tanh(bf1(z[(size_t)(tok0 + t) * ZW + Z_DUV + g * 64 + lane]));
        mix[(size_t)(tok0 + t) * D + 768 + g * 64 + lane] = (bf16)f2bf(uu * acc); }
    __syncthreads();
}
__device__ __forceinline__ void xattn_item(const Args& a, int l, int item, LAS unsigned char* lds, int tid) {
    const int qtile = item & 31, h = (item >> 5) & 3, b = item >> 7, lane = tid & 63, w = tid >> 6;
    LAS float* Ks = (LAS float*)lds;
    LAS float* Vs = Ks + 256 * 65;
    LAS float* qs = Vs + 256 * 64;
    LAS float* pw = qs + 512;
    const bf16* kvm = (const bf16*)(a.ws + WS_KVM + (size_t)l * SZ_KVM); const bf16* qx = (const bf16*)(a.ws + WS_QX); bf16* ox = (bf16*)(a.ws + WS_OX);
    for (int i = tid; i < 16384; i += NTHR) { const int key = i >> 6, d = i & 63; const size_t o = (size_t)(b * MEMLEN + key) * 512 + h * 64 + d;
        Ks[key * 65 + d] = bf1(kvm[o]); Vs[key * 64 + d] = bf1(kvm[o + 256]); }
    __syncthreads();
    for (int qq = 0; qq < 8; ++qq) { const int row = b * T + qtile * 64 + w * 8 + qq;
        qs[w * 64 + lane] = bf1(qx[(size_t)row * 256 + h * 64 + lane]);
        LDS_WAIT(); asm volatile("" ::: "memory");
        float s[4] = {0.f, 0.f, 0.f, 0.f};
        for (int d = 0; d < 64; ++d) { const float qd = qs[w * 64 + d];
#pragma unroll
            for (int j = 0; j < 4; ++j) s[j] += qd * Ks[(lane + 64 * j) * 65 + d]; }
        const float mx = wave_max(fmaxf(fmaxf(s[0], s[1]), fmaxf(s[2], s[3])));
        float e[4], sum = 0.f;
#pragma unroll
        for (int j = 0; j < 4; ++j) { e[j] = expf(s[j] - mx); sum += e[j]; }
        const float inv = 1.0f / wave_sum(sum);
#pragma unroll
        for (int j = 0; j < 4; ++j) pw[w * 256 + lane + 64 * j] = e[j] * inv;
        LDS_WAIT(); asm volatile("" ::: "memory");
        float o = 0.f;
        for (int key = 0; key < 256; ++key) o += pw[w * 256 + key] * Vs[key * 64 + lane];
        ox[(size_t)row * 256 + h * 64 + lane] = (bf16)f2bf(o);
        LDS_WAIT(); asm volatile("" ::: "memory"); }
    __syncthreads();
}

__device__ __forceinline__ unsigned ord_u(float f) { const unsigned u = __builtin_bit_cast(unsigned, f); return (u & 0x80000000u) ? ~u : (u | 0x80000000u); }
__device__ __forceinline__ int rel_bucket(int n) {
    if (n < 16) return n;
    int large = 16 + (int)(logf((float)n / 16.0f) / logf(8.0f) * 16.0f);
    return large < 31 ? large : 31;
}
__device__ __forceinline__ void dsa_setup(const Args& a, LAS unsigned char* lds, int tid) {
    LAS float* biasd = (LAS float*)(lds + 48 * 1024);
    for (int i = tid; i < 129 * 4; i += NTHR) { const int d = i >> 2, h = i & 3; biasd[i] = a.in[IN_RELB][rel_bucket(d) * 4 + h]; }
    __syncthreads();
}
__device__ __forceinline__ void dsa_item(const Args& a, int item, LAS unsigned char* lds, int tid, bf16* outp, int ostride) {
    const int b = item / T, t = item % T, nk = t + 1, lane = tid & 63, w = tid >> 6;
    LAS unsigned* su = (LAS unsigned*)lds;
    LAS float* lg = (LAS float*)(lds + 8192);
    LAS float* qi = (LAS float*)(lds + 8192 + 32768);
    LAS float* qv = qi + 256;
    LAS float* wi = qv + 256;
    LAS unsigned* cnt = (LAS unsigned*)(wi + 8);
    LAS float* red = (LAS float*)(cnt + 40);
    LAS float* red2 = red + 64;
    LAS float* biasd = (LAS float*)(lds + 48 * 1024);
    const bf16* z = (const bf16*)(a.ws + WS_Z);
    const size_t row = (size_t)b * T + t;
    if (tid < 256) { qi[tid] = bf1(z[row * ZW + Z_CQI + tid]) * 0.17677669529663687f; qv[tid] = bf1(z[row * ZW + Z_CQ + tid]) * 0.125f; }
    if (tid < 8) wi[tid] = bf1(z[row * ZW + Z_CWI + tid]) * 0.35355339059327373f;
    if (tid < 40) cnt[tid] = 0u;
    __syncthreads();
    unsigned myu[4];
#pragma unroll
    for (int j = 0; j < 4; ++j) { const int key = tid + NTHR * j; myu[j] = 0u;
        if (key < nk) { const v4u* kp = (const v4u*)(z + ((size_t)b * T + key) * ZW + Z_CKI); float kf[32];
#pragma unroll
            for (int i = 0; i < 4; ++i) { const v4u r = kp[i]; kf[8 * i + 0] = bflo(r.x); kf[8 * i + 1] = bfhi(r.x); kf[8 * i + 2] = bflo(r.y); kf[8 * i + 3] = bfhi(r.y); kf[8 * i + 4] = bflo(r.z); kf[8 * i + 5] = bfhi(r.z); kf[8 * i + 6] = bflo(r.w); kf[8 * i + 7] = bfhi(r.w); }
            float sc = 0.f;
            for (int hh = 0; hh < 8; ++hh) { float dot = 0.f;
#pragma unroll
                for (int d = 0; d < 32; ++d) dot += qi[hh * 32 + d] * kf[d];
                sc += fmaxf(dot, 0.f) * wi[hh]; }
            sc += 0.0f;
            myu[j] = ord_u(sc); su[key] = myu[j]; } }
    __syncthreads();
    bool sel[4];
#pragma unroll
    for (int j = 0; j < 4; ++j) sel[j] = (tid + NTHR * j) < nk;
    if (nk > 256) {
        unsigned Tt = 0u;
        for (int bit = 31; bit >= 0; --bit) { const unsigned cand = Tt | (1u << bit); int c = 0;
#pragma unroll
            for (int j = 0; j < 4; ++j) c += (myu[j] >= cand) ? 1 : 0;
            c = (int)wave_sum((float)c);
            if (lane == 0 && c) LDS_ADD(&cnt[bit], (unsigned)c);
            __syncthreads();
            if (cnt[bit] >= 256u) Tt = cand; }
        { int c = 0;
#pragma unroll
            for (int j = 0; j < 4; ++j) c += (myu[j] > Tt) ? 1 : 0;
            c = (int)wave_sum((float)c);
            if (lane == 0 && c) LDS_ADD(&cnt[32], (unsigned)c);
            __syncthreads(); }
        const int r = 256 - (int)cnt[32];
#pragma unroll
        for (int j = 0; j < 4; ++j) { const int key = tid + NTHR * j;
            if (myu[j] > Tt) sel[j] = true;
            else if (myu[j] == Tt && key < nk) { int rank = 0; for (int s = 0; s < key; ++s) rank += (su[s] == Tt) ? 1 : 0; sel[j] = rank < r; }
            else sel[j] = false; }
    }
    float lmax[4] = {-INFINITY, -INFINITY, -INFINITY, -INFINITY};
#pragma unroll
    for (int j = 0; j < 4; ++j) { const int key = tid + NTHR * j;
        if (key < nk) {
            float lv[4] = {-INFINITY, -INFINITY, -INFINITY, -INFINITY};
            if (sel[j]) { const v4u* kp = (const v4u*)(z + ((size_t)b * T + key) * ZW + Z_CK); const int dd = (t - key) < 128 ? (t - key) : 128;
#pragma unroll
                for (int hh = 0; hh < 4; ++hh) { float dot = 0.f;
#pragma unroll
                    for (int i = 0; i < 8; ++i) { const v4u r = kp[hh * 8 + i]; const LAS float* qq = qv + hh * 64 + 8 * i;
                        dot += qq[0] * bflo(r.x) + qq[1] * bfhi(r.x) + qq[2] * bflo(r.y) + qq[3] * bfhi(r.y) + qq[4] * bflo(r.z) + qq[5] * bfhi(r.z) + qq[6] * bflo(r.w) + qq[7] * bfhi(r.w); }
                    lv[hh] = dot + biasd[dd * 4 + hh]; lmax[hh] = fmaxf(lmax[hh], lv[hh]); } }
#pragma unroll
            for (int hh = 0; hh < 4; ++hh) lg[hh * 2048 + key] = lv[hh]; } }
#pragma unroll
    for (int hh = 0; hh < 4; ++hh) { const float m = wave_max(lmax[hh]); if (lane == 0) red[w * 4 + hh] = m; }
    __syncthreads();
    float mx[4], lsum[4] = {0.f, 0.f, 0.f, 0.f};
#pragma unroll
    for (int hh = 0; hh < 4; ++hh) { float m = red[hh]; for (int ww = 1; ww < 8; ++ww) m = fmaxf(m, red[ww * 4 + hh]); mx[hh] = m; }
#pragma unroll
    for (int j = 0; j < 4; ++j) { const int key = tid + NTHR * j;
        if (key < nk) {
#pragma unroll
            for (int hh = 0; hh < 4; ++hh) { const float lv = lg[hh * 2048 + key]; const float p = (lv == -INFINITY) ? 0.f : expf(lv - mx[hh]); lg[hh * 2048 + key] = p; lsum[hh] += p; } } }
#pragma unroll
    for (int hh = 0; hh < 4; ++hh) { const float s = wave_sum(lsum[hh]); if (lane == 0) red[32 + w * 4 + hh] = s; }
    __syncthreads();
    { const int half = tid >> 8, hd = tid & 255, hh = hd >> 6; float acc = 0.f;
      const bf16* vp = z + (size_t)b * T * ZW + Z_CV + hd;
      for (int key = half; key < nk; key += 2) { const float p = lg[hh * 2048 + key]; if (p != 0.f) acc += p * bf1(vp[(size_t)key * ZW]); }
      red2[tid] = acc; }
    __syncthreads();
    if (tid < 256) { const int hh = tid >> 6; float s = 0.f; for (int ww = 0; ww < 8; ++ww) s += red[32 + ww * 4 + hh];
        outp[row * ostride + tid] = (bf16)f2bf((red2[tid] + red2[tid + 256]) / s); }
    __syncthreads();
}

__device__ __forceinline__ void moe_route(const Args& a, LAS unsigned char* lds, int tid, int G) {
    const int lane = tid & 63, w = tid >> 6;
    LAS float* rt = (LAS float*)lds;
    LAS unsigned* cnt = (LAS unsigned*)(lds + 32768);
    const float* h = a.out; unsigned char* ws = a.ws;
    for (int i = tid; i < 8192; i += NTHR) rt[(i & 7) * 1024 + (i >> 3)] = a.in[IN_ROUTER][i] * a.in[IN_NFFN][D + (i >> 3)];
    __syncthreads();
    for (int chunk = blockIdx.x; chunk < 256; chunk += G) {
        if (tid < 8) cnt[tid] = 0u;
        __syncthreads();
        for (int q = 0; q < 8; ++q) { const int tk = chunk * 64 + w * 8 + q;
            const f32x4* hr = (const f32x4*)(h + (size_t)tk * D) + lane; float lg[8] = {0.f, 0.f, 0.f, 0.f, 0.f, 0.f, 0.f, 0.f}; float ss = 0.f;
#pragma unroll
            for (int j = 0; j < 4; ++j) { const f32x4 v = hr[64 * j]; const int c0 = 4 * (lane + 64 * j);
                ss += (v.x * v.x + v.y * v.y) + (v.z * v.z + v.w * v.w);
#pragma unroll
                for (int e = 0; e < 8; ++e) { const f32x4 r = *(const LAS f32x4*)(rt + e * 1024 + c0); lg[e] += (v.x * r.x + v.y * r.y) + (v.z * r.z + v.w * r.w); } }
            ss = wave_sum(ss); const float rstd = rsqrtf(ss * (1.0f / 1024.0f) + EPS);
#pragma unroll
            for (int e = 0; e < 8; ++e) lg[e] = wave_sum(lg[e]) * rstd;
            int e0 = 0; float v0 = lg[0];
#pragma unroll
            for (int e = 1; e < 8; ++e) if (lg[e] > v0) { v0 = lg[e]; e0 = e; }
            int e1 = -1; float v1 = -INFINITY;
#pragma unroll
            for (int e = 0; e < 8; ++e) if (e != e0 && lg[e] > v1) { v1 = lg[e]; e1 = e; }
            const float g0 = 1.0f / (1.0f + expf(v1 - v0)), g1 = 1.0f - g0;
            if (lane == 0) { ((int*)(ws + WS_TOKE))[2 * tk] = e0; ((int*)(ws + WS_TOKE))[2 * tk + 1] = e1; ((float*)(ws + WS_TOKG))[2 * tk] = g0; ((float*)(ws + WS_TOKG))[2 * tk + 1] = g1;
                ((float*)(ws + WS_TOKR))[tk] = rstd; LDS_ADD(&cnt[e0], 1u); LDS_ADD(&cnt[e1], 1u); } }
        __syncthreads();
        if (tid < 8) ((int*)(ws + WS_CNT))[chunk * 8 + tid] = (int)cnt[tid];
        __syncthreads();
    }
}
__device__ __forceinline__ void moe_assign(const Args& a, LAS unsigned char* lds, int tid, int G) {
    LAS int* cn = (LAS int*)lds;
    LAS int* tot = cn + 2048;
    LAS int* basee = tot + 8;
    LAS int* te = basee + 8;
    unsigned char* ws = a.ws;
    const int* CNT = (const int*)(ws + WS_CNT); int* TILEE = (int*)(ws + WS_TILEE);
    const int* TOKE = (const int*)(ws + WS_TOKE); const float* TOKG = (const float*)(ws + WS_TOKG); const float* TOKR = (const float*)(ws + WS_TOKR); int* TOKS = (int*)(ws + WS_TOKS);
    float* SLOTR = (float*)(ws + WS_SLOTR); float* SLOTG = (float*)(ws + WS_SLOTG); int* SLOTT = (int*)(ws + WS_SLOTT);
    for (int i = tid; i < 2048; i += NTHR) cn[i] = CNT[i];
    __syncthreads();
    if (tid < 8) { int s = 0; for (int c = 0; c < 256; ++c) s += cn[c * 8 + tid]; tot[tid] = s; }
    __syncthreads();
    if (tid == 0) { int tile = 0; for (int e = 0; e < 8; ++e) { basee[e] = tile * 256; const int nt = (tot[e] + 255) >> 8;
            if (blockIdx.x == 0) for (int q = 0; q < nt; ++q) TILEE[tile + q] = e;
            tile += nt; }
        if (blockIdx.x == 0) { for (int q = tile; q < 159; ++q) TILEE[q] = 0; TILEE[159] = tile; } }
    __syncthreads();
    for (int e = blockIdx.x; e < 8; e += G) { const int s0 = basee[e] + tot[e], s1 = basee[e] + (((tot[e] + 255) >> 8) << 8);
        for (int s = s0 + tid; s < s1; s += NTHR) { SLOTR[s] = 0.f; SLOTG[s] = 0.f; SLOTT[s] = 0; } }
    for (int chunk = blockIdx.x; chunk < 256; chunk += G) {
        if (tid < 128) te[tid] = TOKE[chunk * 128 + tid];
        __syncthreads();
        if (tid < 8) { int s = 0; for (int c = 0; c < chunk; ++c) s += cn[c * 8 + tid]; int pos = basee[tid] + s;
            for (int i = 0; i < 128; ++i) { if (te[i] == tid) { const int tk = chunk * 64 + (i >> 1); SLOTR[pos] = TOKR[tk]; SLOTG[pos] = TOKG[2 * tk + (i & 1)]; SLOTT[pos] = tk; TOKS[2 * tk + (i & 1)] = pos; ++pos; } } }
        __syncthreads();
    }
}
__device__ __forceinline__ void final_phase(const Args& a, int tid, int G) {
    const int lane = tid & 63, gw = blockIdx.x * NWAVES + (tid >> 6), NGW = G * NWAVES;
    const int* TOKS = (const int*)(a.ws + WS_TOKS); const bf16* YS = (const bf16*)(a.ws + WS_YS);
    for (int tk = gw; tk < M; tk += NGW) { const int s0 = TOKS[2 * tk], s1 = TOKS[2 * tk + 1];
        f32x4* hr = (f32x4*)(a.out + (size_t)tk * D) + lane; const v2u* y0 = (const v2u*)(YS + (size_t)s0 * D) + lane; const v2u* y1 = (const v2u*)(YS + (size_t)s1 * D) + lane;
        f32x4 v[4]; float ss = 0.f;
#pragma unroll
        for (int j = 0; j < 4; ++j) { v[j] = hr[64 * j]; const v2u p = y0[64 * j], q = y1[64 * j];
            v[j].x += bflo(p.x) + bflo(q.x); v[j].y += bfhi(p.x) + bfhi(q.x); v[j].z += bflo(p.y) + bflo(q.y); v[j].w += bfhi(p.y) + bfhi(q.y);
            ss += (v[j].x * v[j].x + v[j].y * v[j].y) + (v[j].z * v[j].z + v[j].w * v[j].w); }
        const float rstd = rsqrtf(wave_sum(ss) * (1.0f / 1024.0f) + EPS);
#ifdef PROBE_DSA
        const float* pr = (const float*)(a.ws + WS_CTL) + 12288; const float padd = PROBE_C * sqrtf(pr[0] / fmaxf(pr[1], 1e-30f));
#else
        const float padd = 0.f;
#endif
#pragma unroll
        for (int j = 0; j < 4; ++j) { const f32x4 g = ((const f32x4*)a.in[IN_FNORM])[lane + 64 * j]; hr[64 * j] = v[j] * rstd * g + padd; } }
}

typedef short bf16x8 __attribute__((ext_vector_type(8)));
typedef short bf16x4 __attribute__((ext_vector_type(4)));
typedef float f32x16 __attribute__((ext_vector_type(16)));
#define MFMA32(a, b, c) __builtin_amdgcn_mfma_f32_32x32x16_bf16((a), (b), (c), 0, 0, 0)
constexpr int DS_HIST = 0;
constexpr int DS_CMB = 0;
constexpr int DS_BM = 65792;
constexpr int DS_P = DS_BM + 8192;
constexpr int DS_CU = DS_P + 512;
constexpr int DS_CK = DS_CU + 8192;
constexpr int DS_BIAS = DS_CK + 8192;
constexpr int DS_ST = DS_BIAS + 2112;
constexpr int DS_END = DS_ST + 8 * 4608;
constexpr int DSA_CAP = 64;
static_assert(DS_END <= MISC_OFF - 64 && 4 * 8704 <= DS_BM, "DSA LDS map");
__device__ __forceinline__ void tr_read_tile(unsigned addr, bf16x4& t00, bf16x4& t01, bf16x4& t10, bf16x4& t11, bf16x4& u00, bf16x4& u01, bf16x4& u10, bf16x4& u11) {
    asm volatile("s_waitcnt lgkmcnt(0)\n\t"
                 "ds_read_b64_tr_b16 %0, %8 offset:0\n\t" "ds_read_b64_tr_b16 %1, %8 offset:512\n\t" "ds_read_b64_tr_b16 %2, %8 offset:1024\n\t" "ds_read_b64_tr_b16 %3, %8 offset:1536\n\t"
                 "ds_read_b64_tr_b16 %4, %8 offset:2048\n\t" "ds_read_b64_tr_b16 %5, %8 offset:2560\n\t" "ds_read_b64_tr_b16 %6, %8 offset:3072\n\t" "ds_read_b64_tr_b16 %7, %8 offset:3584\n\t"
                 "s_waitcnt lgkmcnt(0)"
                 : "=&v"(t00), "=&v"(t01), "=&v"(t10), "=&v"(t11), "=&v"(u00), "=&v"(u01), "=&v"(u10), "=&v"(u11) : "v"(addr) : "memory");
}

__device__ __forceinline__ void dsa2_setup(const Args& a, LAS unsigned char* lds, int tid) {
    LAS float* biasL = (LAS float*)(lds + DS_BIAS);
    for (int i = tid; i < 4 * 129; i += NTHR) { const int h = i / 129, d = i % 129; biasL[h * 132 + d] = a.in[IN_RELB][rel_bucket(d) * 4 + h] * 1.4426950408889634f; }
    __syncthreads();
}
__device__ __forceinline__ void idx_scores(const bf16x8 ka0, const bf16x8 ka1, const LAS bf16x8* qfl  , const float (&wv)[8], float (&sc)[16]) {
#pragma unroll
    for (int r = 0; r < 16; ++r) sc[r] = 0.f;
    float zero = 0.f;
#pragma unroll
    for (int hp = 0; hp < 4; ++hp) {
        const bf16x8 q00 = qfl[(4 * hp + 0) * 64], q01 = qfl[(4 * hp + 1) * 64], q10 = qfl[(4 * hp + 2) * 64], q11 = qfl[(4 * hp + 3) * 64];
        f32x16 acc0, acc1;
#pragma unroll
        for (int r = 0; r < 16; ++r) { acc0[r] = zero; acc1[r] = zero; }
        acc0 = MFMA32(ka0, q00, acc0); acc1 = MFMA32(ka0, q10, acc1);
        acc0 = MFMA32(ka1, q01, acc0); acc1 = MFMA32(ka1, q11, acc1);
#pragma unroll
        for (int r = 0; r < 16; ++r) sc[r] = __builtin_fmaf(fmaxf(acc1[r], 0.f), wv[2 * hp + 1], __builtin_fmaf(fmaxf(acc0[r], 0.f), wv[2 * hp], sc[r]));
        asm volatile("" : "+v"(zero), "+v"(sc[0]), "+v"(sc[1]), "+v"(sc[2]), "+v"(sc[3]), "+v"(sc[4]), "+v"(sc[5]), "+v"(sc[6]), "+v"(sc[7]), "+v"(sc[8]), "+v"(sc[9]), "+v"(sc[10]), "+v"(sc[11]), "+v"(sc[12]), "+v"(sc[13]), "+v"(sc[14]), "+v"(sc[15]));
    }
}
template <bool NEAR> __device__ __forceinline__ void dsa_att_tile(const bf16x8 (&kf)[4], const bf16x8 (&qa)[4], unsigned word, int dbase  , int hh, const LAS float* biasH, float c31,
                                                                 unsigned vaddr, f32x16& o0, f32x16& o1, float& m, float& lsum) {
    constexpr float SC = 0.18033688011112042f;
    f32x16 sacc;
#pragma unroll
    for (int r = 0; r < 16; ++r) sacc[r] = 0.f;
#pragma unroll
    for (int s = 0; s < 4; ++s) sacc = MFMA32(kf[s], qa[s], sacc);
    float sv[16]; float tmax = -1e30f;
#pragma unroll
    for (int r = 0; r < 16; ++r) { const int kl = (r & 3) + 8 * (r >> 2) + 4 * hh; float bias = c31;
        if (NEAR) { int dd = dbase - kl; dd = dd < 0 ? 0 : (dd > 128 ? 128 : dd); bias = biasH[dd]; }
        const float v = __builtin_fmaf(sacc[r], SC, bias); sv[r] = ((word >> kl) & 1u) ? v : -1e30f; tmax = fmaxf(tmax, sv[r]); }
    tmax = fmaxf(tmax, shfl_xor_c<32>(tmax));
    const float mnew = fmaxf(m, tmax);
    if (__any(mnew != m)) { const float alpha = __builtin_amdgcn_exp2f(m - mnew); lsum *= alpha;
#pragma unroll
        for (int r = 0; r < 16; ++r) { o0[r] *= alpha; o1[r] *= alpha; } }
    m = mnew;
    float p[16]; float ps = 0.f;
#pragma unroll
    for (int r = 0; r < 16; ++r) { p[r] = __builtin_amdgcn_exp2f(sv[r] - mnew); ps += p[r]; }
    ps += shfl_xor_c<32>(ps);
    lsum += ps;
    bf16x8 pb[2];
#pragma unroll
    for (int s = 0; s < 2; ++s) { v4u t4; t4.x = pg8::cvt_pk_bf16(p[8 * s + 0], p[8 * s + 1]); t4.y = pg8::cvt_pk_bf16(p[8 * s + 2], p[8 * s + 3]); t4.z = pg8::cvt_pk_bf16(p[8 * s + 4], p[8 * s + 5]); t4.w = pg8::cvt_pk_bf16(p[8 * s + 6], p[8 * s + 7]);
        pb[s] = __builtin_bit_cast(bf16x8, t4); }
    bf16x4 t00, t01, t10, t11, u00, u01, u10, u11;
    tr_read_tile(vaddr, t00, t01, t10, t11, u00, u01, u10, u11);
    o0 = MFMA32(__builtin_shufflevector(t00, t01, 0, 1, 2, 3, 4, 5, 6, 7), pb[0], o0); o0 = MFMA32(__builtin_shufflevector(t10, t11, 0, 1, 2, 3, 4, 5, 6, 7), pb[1], o0);
    o1 = MFMA32(__builtin_shufflevector(u00, u01, 0, 1, 2, 3, 4, 5, 6, 7), pb[0], o1); o1 = MFMA32(__builtin_shufflevector(u10, u11, 0, 1, 2, 3, 4, 5, 6, 7), pb[1], o1);
}
__device__ __forceinline__ void dsa2_item(const Args& a, int item, LAS unsigned char* lds, int tid) {
    const int lane = tid & 63, w = __builtin_amdgcn_readfirstlane(tid >> 6), ql = lane & 31, hh = lane >> 5;
    const int b = item & 7, qi = 63 - (item >> 3), tq0 = qi * 32, ntl = qi + 1;
    const bool sel = qi >= 8;
    const bf16* z = (const bf16*)(a.ws + WS_Z); bf16* mix = (bf16*)(a.ws + WS_MIX);
    const bf16* zb = z + (size_t)b * T * ZW;
    const bf16* zq = zb + (size_t)(tq0 + ql) * ZW;
    LAS unsigned* hist = (LAS unsigned*)(lds + DS_HIST); LAS unsigned* bm = (LAS unsigned*)(lds + DS_BM);
    LAS unsigned* Pp = (LAS unsigned*)(lds + DS_P); LAS unsigned* need = Pp + 32; LAS unsigned* ccnt = Pp + 64; LAS unsigned* ccnt2 = Pp + 96;
    LAS unsigned* cu = (LAS unsigned*)(lds + DS_CU); LAS unsigned* ck = (LAS unsigned*)(lds + DS_CK);
    const LAS float* biasL = (const LAS float*)(lds + DS_BIAS);
    if (sel) {
        f32x4* scr = (f32x4*)(blockIdx.x < 128 ? a.ws + WS_HB + (size_t)blockIdx.x * 262144 : a.ws + WS_DSC + (size_t)(blockIdx.x - 128) * 262144) + lane;
        for (int i = tid; i < 2048; i += NTHR) bm[i] = 0u;
        for (int i = tid; i < 32 * 513; i += NTHR) hist[i] = 0u;
        if (tid < 32) { Pp[tid] = 0u; need[tid] = 256u; ccnt2[tid] = 0u; }
        __syncthreads();
        {
            float wv[8];
            LAS bf16x8* qfl = (LAS bf16x8*)(lds + DS_ST);
            if (w < 2) {
#pragma unroll
                for (int i = 0; i < 8; ++i) { const int fi = 8 * w + i; qfl[fi * 64 + lane] = *(const bf16x8*)(zq + Z_CQI + (fi >> 1) * 32 + 16 * (fi & 1) + 8 * hh); } }
            __syncthreads();
            { const v4u wr = *(const v4u*)(zq + Z_CWI);
              wv[0] = bflo(wr.x) * 0.0625f; wv[1] = bfhi(wr.x) * 0.0625f; wv[2] = bflo(wr.y) * 0.0625f; wv[3] = bfhi(wr.y) * 0.0625f;
              wv[4] = bflo(wr.z) * 0.0625f; wv[5] = bfhi(wr.z) * 0.0625f; wv[6] = bflo(wr.w) * 0.0625f; wv[7] = bfhi(wr.w) * 0.0625f; }
            const bf16* zk0 = zb + (size_t)ql * ZW + Z_CKI + 8 * hh;
            bf16x8 ka0 = *(const bf16x8*)(zk0 + (size_t)(w * 32) * ZW), ka1 = *(const bf16x8*)(zk0 + (size_t)(w * 32) * ZW + 16);
#pragma unroll 1
            for (int kt = w; kt < ntl; kt += 8) {
                const int ktn = (kt + 8 < ntl) ? kt + 8 : kt;
                const bf16x8 kn0 = *(const bf16x8*)(zk0 + (size_t)(ktn * 32) * ZW), kn1 = *(const bf16x8*)(zk0 + (size_t)(ktn * 32) * ZW + 16);
                float sc[16]; idx_scores(ka0, ka1, qfl + lane, wv, sc);
#pragma unroll
                for (int q4 = 0; q4 < 4; ++q4) scr[(size_t)kt * 256 + q4 * 64] = (f32x4){sc[4 * q4] + 0.0f, sc[4 * q4 + 1] + 0.0f, sc[4 * q4 + 2] + 0.0f, sc[4 * q4 + 3] + 0.0f};
#pragma unroll
                for (int r = 0; r < 16; ++r) { const int kl = (r & 3) + 8 * (r >> 2) + 4 * hh; const unsigned u = ord_u(sc[r] + 0.0f);
                    if (kt < qi || kl <= ql) LDS_ADD(&hist[ql * 513 + (u >> 23)], 1u); }
                ka0 = kn0; ka1 = kn1;
            }
        }
        int sh = 23, nb = 9;
#pragma unroll 1
        for (int level = 0; level < 4; ++level) {
            if (level > 0) {
                for (int i = tid; i < 32 * 513; i += NTHR) hist[i] = 0u;
                __syncthreads();
                const unsigned myP = Pp[ql];
#pragma unroll 1
                for (int kt = w; kt < ntl; kt += 8) {
#pragma unroll
                    for (int q4 = 0; q4 < 4; ++q4) { const f32x4 s4 = scr[(size_t)kt * 256 + q4 * 64];
#pragma unroll
                        for (int e = 0; e < 4; ++e) { const int kl = e + 8 * q4 + 4 * hh; const unsigned u = ord_u(s4[e]);
                            if ((kt < qi || kl <= ql) && (u >> (sh + nb)) == myP) LDS_ADD(&hist[ql * 513 + ((u >> sh) & ((1u << nb) - 1u))], 1u); } }
                }
            }
            __syncthreads();
#pragma unroll 1
            for (int qq = 0; qq < 4; ++qq) { const int q = 4 * w + qq; const int bpl = (1 << nb) >> 6;
                unsigned c[8]; unsigned s = 0u;
#pragma unroll
                for (int i = 0; i < 8; ++i) { c[i] = (i < bpl) ? hist[q * 513 + lane * bpl + i] : 0u; s += c[i]; }
                unsigned incl = s;
#pragma unroll
                for (int o = 1; o < 64; o <<= 1) { const unsigned t2 = shfl_idx_u(incl, (lane + o) & 63); if (lane + o < 64) incl += t2; }
                const unsigned excl = incl - s, nd = need[q];
                if (excl < nd && nd <= incl) { unsigned run = excl; int dsel = 0; unsigned above = 0u, cand = 0u; bool found = false;
#pragma unroll
                    for (int i = 7; i >= 0; --i) { if (i < bpl && !found) { if (run + c[i] >= nd) { dsel = i; above = run; cand = c[i]; found = true; } else run += c[i]; } }
                    Pp[q] = (Pp[q] << nb) | (unsigned)(lane * bpl + dsel); need[q] = nd - above; ccnt[q] = cand; }
            }
            __syncthreads();
            unsigned mc = ccnt[ql]; mc = (unsigned)wave_max((float)mc);
            if (mc <= (unsigned)DSA_CAP || level == 3) break;
            sh -= (level == 2) ? 7 : 8; nb = (level == 2) ? 7 : 8;
        }
        { const unsigned myP = Pp[ql];
#pragma unroll 1
          for (int kt = w; kt < ntl; kt += 8) { unsigned bits = 0u;
#pragma unroll
            for (int q4 = 0; q4 < 4; ++q4) { const f32x4 s4 = scr[(size_t)kt * 256 + q4 * 64];
#pragma unroll
                for (int e = 0; e < 4; ++e) { const int kl = e + 8 * q4 + 4 * hh; const unsigned u = ord_u(s4[e]), pfx = u >> sh;
                    if (kt < qi || kl <= ql) { if (pfx > myP) bits |= 1u << kl;
                        else if (pfx == myP) { const unsigned slot = __hip_atomic_fetch_add(&ccnt2[ql], 1u, __ATOMIC_RELAXED, __HIP_MEMORY_SCOPE_WORKGROUP);
                            if (slot < (unsigned)DSA_CAP) { cu[ql * DSA_CAP + slot] = u; ck[ql * DSA_CAP + slot] = (unsigned)(kt * 32 + kl); } } } } }
            if (bits) (void)__hip_atomic_fetch_or(&bm[kt * 32 + ql], bits, __ATOMIC_RELAXED, __HIP_MEMORY_SCOPE_WORKGROUP);
          } }
        __syncthreads();
        for (int idx = tid; idx < 32 * DSA_CAP; idx += NTHR) { const int q = idx / DSA_CAP, i = idx % DSA_CAP; unsigned n = ccnt2[q]; n = n < (unsigned)DSA_CAP ? n : (unsigned)DSA_CAP;
            if ((unsigned)i < n) { const unsigned ui = cu[q * DSA_CAP + i], ki = ck[q * DSA_CAP + i]; unsigned rank = 0u;
                for (unsigned j = 0; j < n; ++j) { const unsigned uj = cu[q * DSA_CAP + j], kj = ck[q * DSA_CAP + j]; rank += (uj > ui || (uj == ui && kj < ki)) ? 1u : 0u; }
                if (rank < need[q]) (void)__hip_atomic_fetch_or(&bm[(ki >> 5) * 32 + q], 1u << (ki & 31u), __ATOMIC_RELAXED, __HIP_MEMORY_SCOPE_WORKGROUP); } }
        __syncthreads();
    }
    const int hd = w >> 1, half = w & 1;
    bf16x8 qa[4];
#pragma unroll
    for (int s = 0; s < 4; ++s) qa[s] = *(const bf16x8*)(zq + Z_CQ + hd * 64 + 16 * s + 8 * hh);
    f32x16 o0, o1; float m, lsum;
    const LAS float* biasH = biasL + hd * 132; const float c31 = biasH[128];
    LAS unsigned char* st = lds + DS_ST + w * 4608;
    const unsigned vaddr = (unsigned)(size_t)st + (unsigned)((4 * hh + ((lane >> 2) & 3)) * 64 + 32 * ((lane >> 4) & 1) + 8 * (lane & 3));
    const bf16* kbase = zb + (size_t)ql * ZW + Z_CK + hd * 64 + 8 * hh;
    const bf16* vbase = zb + (size_t)(lane >> 3) * ZW + Z_CV + hd * 64 + (lane & 7) * 8;
    LAS unsigned char* vst = st + ((lane & 7) >> 2) * 2048 + (lane >> 3) * 64 + (lane & 3) * 16;
#pragma unroll
    for (int r = 0; r < 16; ++r) { o0[r] = 0.f; o1[r] = 0.f; }
    m = -30000.f; lsum = 0.f;
    bf16x8 kf[4]; v4u vr[4];
    { const int k0t = (half < ntl) ? half : 0;
#pragma unroll
      for (int s = 0; s < 4; ++s) kf[s] = *(const bf16x8*)(kbase + (size_t)(k0t * 32) * ZW + 16 * s);
#pragma unroll
      for (int i = 0; i < 4; ++i) vr[i] = *(const v4u*)(vbase + (size_t)(k0t * 32 + 8 * i) * ZW); }
#pragma unroll 1
    for (int kt = half; kt < ntl; kt += 2) {
#pragma unroll
        for (int i = 0; i < 4; ++i) *(LAS v4u*)(vst + i * 512) = vr[i];
        const int ktn = (kt + 2 < ntl) ? kt + 2 : kt;
        bf16x8 kn[4]; v4u vn[4];
#pragma unroll
        for (int s = 0; s < 4; ++s) kn[s] = *(const bf16x8*)(kbase + (size_t)(ktn * 32) * ZW + 16 * s);
#pragma unroll
        for (int i = 0; i < 4; ++i) vn[i] = *(const v4u*)(vbase + (size_t)(ktn * 32 + 8 * i) * ZW);
        unsigned word = sel ? bm[kt * 32 + ql] : 0xffffffffu;
        if (kt == qi) word &= (ql == 31) ? 0xffffffffu : ((2u << ql) - 1u);
        if (qi - kt >= 5) dsa_att_tile<false>(kf, qa, word, 0, hh, biasH, c31, vaddr, o0, o1, m, lsum);
        else dsa_att_tile<true>(kf, qa, word, tq0 + ql - kt * 32, hh, biasH, c31, vaddr, o0, o1, m, lsum);
#pragma unroll
        for (int s = 0; s < 4; ++s) kf[s] = kn[s];
#pragma unroll
        for (int i = 0; i < 4; ++i) vr[i] = vn[i];
    }
    LAS float* cmb = (LAS float*)(lds + DS_CMB + hd * 8704);
    if (half == 1) {
#pragma unroll
        for (int r = 0; r < 16; ++r) { cmb[r * 64 + lane] = o0[r]; cmb[(16 + r) * 64 + lane] = o1[r]; }
        cmb[2048 + lane] = m; cmb[2048 + 64 + lane] = lsum;
    }
    __syncthreads();
    if (half == 0) {
        const float mb = cmb[2048 + lane], lb = cmb[2048 + 64 + lane];
        const float mt = fmaxf(m, mb), fa = __builtin_amdgcn_exp2f(m - mt), fb = __builtin_amdgcn_exp2f(mb - mt);
        const float inv = 1.0f / (lsum * fa + lb * fb), ga = fa * inv, gb = fb * inv;
#pragma unroll
        for (int r = 0; r < 16; ++r) { o0[r] = o0[r] * ga + cmb[r * 64 + lane] * gb; o1[r] = o1[r] * ga + cmb[(16 + r) * 64 + lane] * gb; }
#pragma unroll
        for (int g = 0; g < 4; ++g) { v2u w0, w1; w0.x = pg8::cvt_pk_bf16(o0[4 * g], o0[4 * g + 1]); w0.y = pg8::cvt_pk_bf16(o0[4 * g + 2], o0[4 * g + 3]); w1.x = pg8::cvt_pk_bf16(o1[4 * g], o1[4 * g + 1]); w1.y = pg8::cvt_pk_bf16(o1[4 * g + 2], o1[4 * g + 3]);
            *(LAS v2u*)(st + ql * 136 + (8 * g + 4 * hh) * 2) = w0; *(LAS v2u*)(st + ql * 136 + (32 + 8 * g + 4 * hh) * 2) = w1; }
        asm volatile("s_waitcnt lgkmcnt(0)" ::: "memory");
#pragma unroll
        for (int i = 0; i < 4; ++i) { const int q = (lane >> 3) + 8 * i, ch = lane & 7;
            const v2u x0 = *(const LAS v2u*)(st + q * 136 + ch * 16), x1 = *(const LAS v2u*)(st + q * 136 + ch * 16 + 8);
            v4u o; o.x = x0.x; o.y = x0.y; o.z = x1.x; o.w = x1.y;
            *(v4u*)(mix + ((size_t)b * T + tq0 + q) * D + 512 + hd * 64 + ch * 8) = o; }
    }
    __syncthreads();
}
constexpr int XA_V = 0, XA_ST = 32768;
__device__ __forceinline__ void xattn2_item(const Args& a, int l, int item, LAS unsigned char* lds, int tid) {
    const int lane = tid & 63, w = __builtin_amdgcn_readfirstlane(tid >> 6), ql = lane & 31, hh = lane >> 5;
    const int qg = item & 7, h = (item >> 3) & 3, b = item >> 5;
    const bf16* kvm = (const bf16*)(a.ws + WS_KVM + (size_t)l * SZ_KVM) + (size_t)b * MEMLEN * 512;
    const bf16* qx = (const bf16*)(a.ws + WS_QX); bf16* ox = (bf16*)(a.ws + WS_OX);
#pragma unroll
    for (int i = 0; i < 4; ++i) { const int idx = tid + NTHR * i, key = idx >> 3, ch = idx & 7;
        const v4u v = *(const v4u*)(kvm + (size_t)key * 512 + 256 + h * 64 + ch * 8);
        *(LAS v4u*)(lds + XA_V + (key >> 5) * 4096 + (ch >> 2) * 2048 + (key & 31) * 64 + (ch & 3) * 16) = v; }
    __syncthreads();
    const size_t row0 = (size_t)b * T + qg * 256 + w * 32;
    bf16x8 qa[4];
#pragma unroll
    for (int s = 0; s < 4; ++s) qa[s] = *(const bf16x8*)(qx + (row0 + ql) * 256 + h * 64 + 16 * s + 8 * hh);
    f32x16 o0, o1;
#pragma unroll
    for (int r = 0; r < 16; ++r) { o0[r] = 0.f; o1[r] = 0.f; }
    float m = -1e30f, lsum = 0.f;
    const unsigned vaddr = (unsigned)(size_t)(lds + XA_V) + (unsigned)((4 * hh + ((lane >> 2) & 3)) * 64 + 32 * ((lane >> 4) & 1) + 8 * (lane & 3));
#pragma unroll 1
    for (int kt = 0; kt < 8; ++kt) {
        bf16x8 kf[4];
        { const bf16* zk = kvm + (size_t)(kt * 32 + ql) * 512 + h * 64 + 8 * hh;
#pragma unroll
          for (int s = 0; s < 4; ++s) kf[s] = *(const bf16x8*)(zk + 16 * s); }
        f32x16 sacc;
#pragma unroll
        for (int r = 0; r < 16; ++r) sacc[r] = 0.f;
#pragma unroll
        for (int s = 0; s < 4; ++s) sacc = MFMA32(kf[s], qa[s], sacc);
        float sv[16]; float tmax = -1e30f;
#pragma unroll
        for (int r = 0; r < 16; ++r) { sv[r] = sacc[r] * 1.4426950408889634f; tmax = fmaxf(tmax, sv[r]); }
        tmax = fmaxf(tmax, shfl_xor_c<32>(tmax));
        const float mnew = fmaxf(m, tmax), alpha = __builtin_amdgcn_exp2f(m - mnew);
        float p[16]; float ps = 0.f;
#pragma unroll
        for (int r = 0; r < 16; ++r) { p[r] = __builtin_amdgcn_exp2f(sv[r] - mnew); ps += p[r]; }
        ps += shfl_xor_c<32>(ps);
        lsum = lsum * alpha + ps; m = mnew;
#pragma unroll
        for (int r = 0; r < 16; ++r) { o0[r] *= alpha; o1[r] *= alpha; }
        bf16x8 pb[2];
#pragma unroll
        for (int s = 0; s < 2; ++s) { v4u t4; t4.x = pg8::cvt_pk_bf16(p[8 * s + 0], p[8 * s + 1]); t4.y = pg8::cvt_pk_bf16(p[8 * s + 2], p[8 * s + 3]); t4.z = pg8::cvt_pk_bf16(p[8 * s + 4], p[8 * s + 5]); t4.w = pg8::cvt_pk_bf16(p[8 * s + 6], p[8 * s + 7]);
            pb[s] = __builtin_bit_cast(bf16x8, t4); }
        bf16x4 t00, t01, t10, t11, u00, u01, u10, u11;
        tr_read_tile(vaddr + kt * 4096, t00, t01, t10, t11, u00, u01, u10, u11);
        const bf16x8 va00 = __builtin_shufflevector(t00, t01, 0, 1, 2, 3, 4, 5, 6, 7), va01 = __builtin_shufflevector(t10, t11, 0, 1, 2, 3, 4, 5, 6, 7);
        const bf16x8 va10 = __builtin_shufflevector(u00, u01, 0, 1, 2, 3, 4, 5, 6, 7), va11 = __builtin_shufflevector(u10, u11, 0, 1, 2, 3, 4, 5, 6, 7);
        o0 = MFMA32(va00, pb[0], o0); o0 = MFMA32(va01, pb[1], o0);
        o1 = MFMA32(va10, pb[0], o1); o1 = MFMA32(va11, pb[1], o1);
    }
    const float inv = 1.0f / lsum;
    LAS unsigned char* st = lds + XA_ST + w * 4608;
#pragma unroll
    for (int g = 0; g < 4; ++g) { v2u w0, w1; w0.x = pg8::cvt_pk_bf16(o0[4 * g] * inv, o0[4 * g + 1] * inv); w0.y = pg8::cvt_pk_bf16(o0[4 * g + 2] * inv, o0[4 * g + 3] * inv);
        w1.x = pg8::cvt_pk_bf16(o1[4 * g] * inv, o1[4 * g + 1] * inv); w1.y = pg8::cvt_pk_bf16(o1[4 * g + 2] * inv, o1[4 * g + 3] * inv);
        *(LAS v2u*)(st + ql * 136 + (8 * g + 4 * hh) * 2) = w0; *(LAS v2u*)(st + ql * 136 + (32 + 8 * g + 4 * hh) * 2) = w1; }
    asm volatile("s_waitcnt lgkmcnt(0)" ::: "memory");
#pragma unroll
    for (int i = 0; i < 4; ++i) { const int q = (lane >> 3) + 8 * i, ch = lane & 7;
        const v2u x0 = *(const LAS v2u*)(st + q * 136 + ch * 16), x1 = *(const LAS v2u*)(st + q * 136 + ch * 16 + 8);
        v4u o; o.x = x0.x; o.y = x0.y; o.z = x1.x; o.w = x1.y;
        *(v4u*)(ox + (row0 + q) * 256 + h * 64 + ch * 8) = o; }
    __syncthreads();
}

__device__ __forceinline__ float gelu_fast(float x) {
    const float y = x * (1.0f + 0.044715f * x * x) * -2.302208198f;
    return x * __builtin_amdgcn_rcpf(1.0f + __builtin_amdgcn_exp2f(y));
}
__device__ __forceinline__ bf16x8 tr_frag(unsigned addr) {
    bf16x4 lo, hi;
    asm volatile("ds_read_b64_tr_b16 %0, %2 offset:0\n\tds_read_b64_tr_b16 %1, %2 offset:256\n\ts_waitcnt lgkmcnt(0)" : "=&v"(lo), "=&v"(hi) : "v"(addr) : "memory");
    return __builtin_shufflevector(lo, hi, 0, 1, 2, 3, 4, 5, 6, 7);
}
__device__ __forceinline__ void sgu2_item(const Args& a, int l, int item, LAS unsigned char* lds, int tid) {
    const int lane = tid & 63, w = __builtin_amdgcn_readfirstlane(tid >> 6), ql = lane & 31, hh = lane >> 5;
    const int nc = item & 15, b = item >> 4, tok0 = b * T + nc * 128;
    const bf16* z = (const bf16*)(a.ws + WS_Z); bf16* mix = (bf16*)(a.ws + WS_MIX);
    for (int j = 0; j < 16; ++j) { const int s = 16 * w + j;
        const v2u raw = *(const v2u*)(z + (size_t)(tok0 + s) * ZW + Z_DUV + 256 + 4 * lane);
        float x[4] = {gelu_fast(bflo(raw.x)), gelu_fast(bfhi(raw.x)), gelu_fast(bflo(raw.y)), gelu_fast(bfhi(raw.y))};
        const float mu = wave_sum((x[0] + x[1]) + (x[2] + x[3])) * (1.0f / 256.0f);
        float q = 0.f;
#pragma unroll
        for (int i = 0; i < 4; ++i) { x[i] -= mu; q += x[i] * x[i]; }
        const float rstd = rsqrtf(wave_sum(q) * (1.0f / 256.0f) + EPS);
        const f32x4 gg = *(const f32x4*)(a.in[IN_LNG] + l * 256 + 4 * lane), bb = *(const f32x4*)(a.in[IN_LNB] + l * 256 + 4 * lane);
        v2u o; o.x = pk2(x[0] * rstd * gg.x + bb.x, x[1] * rstd * gg.y + bb.y); o.y = pk2(x[2] * rstd * gg.z + bb.z, x[3] * rstd * gg.w + bb.w);
        const int ch = 4 * lane;
        *(LAS v2u*)(lds + ((s >> 5) * 8 + (ch >> 5)) * 2048 + (s & 31) * 64 + (ch & 31) * 2) = o; }
    __syncthreads();
    const int g = w >> 1, cb = w & 1, cblk = g * 2 + cb;
    bf16x8 af[4][2];
    { const unsigned abase = (unsigned)(size_t)lds + (unsigned)(cblk * 2048 + (8 * hh + ((lane >> 2) & 3)) * 64 + 32 * ((lane >> 4) & 1) + 8 * (lane & 3));
#pragma unroll
      for (int sb = 0; sb < 4; ++sb) { af[sb][0] = tr_frag(abase + sb * 8 * 2048); af[sb][1] = tr_frag(abase + sb * 8 * 2048 + 16 * 64); } }
    const bf16* swt = (const bf16*)(a.ws + WS_SWT) + (size_t)(l * 4 + g) * 128 * 128;
#pragma unroll
    for (int tb = 0; tb < 4; ++tb) {
        f32x16 acc;
#pragma unroll
        for (int r = 0; r < 16; ++r) acc[r] = 0.f;
        const bf16* wrow = swt + (size_t)(32 * tb + ql) * 128 + 8 * hh;
#pragma unroll
        for (int sb = 0; sb <= tb; ++sb) { const bf16x8 b0 = *(const bf16x8*)(wrow + 32 * sb), b1 = *(const bf16x8*)(wrow + 32 * sb + 16);
            acc = MFMA32(af[sb][0], b0, acc); acc = MFMA32(af[sb][1], b1, acc); }
        const int t = 32 * tb + ql; const float bs = a.in[IN_SB][(l * 4 + g) * 128 + t];
        const bf16* up = z + (size_t)(tok0 + t) * ZW + Z_DUV + g * 64 + cb * 32 + 4 * hh; bf16* op = mix + (size_t)(tok0 + t) * D + 768 + g * 64 + cb * 32 + 4 * hh;
#pragma unroll
        for (int q4 = 0; q4 < 4; ++q4) { const v2u raw = *(const v2u*)(up + 8 * q4);
            v2u o; o.x = pk2(gelu_fast(bflo(raw.x)) * (acc[4 * q4] + bs), gelu_fast(bfhi(raw.x)) * (acc[4 * q4 + 1] + bs)); o.y = pk2(gelu_fast(bflo(raw.y)) * (acc[4 * q4 + 2] + bs), gelu_fast(bfhi(raw.y)) * (acc[4 * q4 + 3] + bs));
            *(v2u*)(op + 8 * q4) = o; }
    }
    __syncthreads();
}
__device__ __forceinline__ void pool2_item(const Args& a, int l, int item, LAS unsigned char* lds, int tid) {
    const int lane = tid & 63, w = __builtin_amdgcn_readfirstlane(tid >> 6), ql = lane & 31, hh = lane >> 5;
    const int tt = item & 31, b = item >> 5, t0 = tt * 64;
    const bf16* z = (const bf16*)(a.ws + WS_Z); bf16* mix = (bf16*)(a.ws + WS_MIX);
    for (int i = tid; i < 79 * 32; i += NTHR) { const int r = i >> 5, ch = i & 31, t = t0 - 15 + r;
        v4u v = (v4u){0u, 0u, 0u, 0u}; if (t >= 0) v = *(const v4u*)(z + (size_t)(b * T + t) * ZW + Z_BU + ch * 8);
        *(LAS v4u*)(lds + r * 528 + ch * 16) = v; }
    __syncthreads();
    const int tb = w & 1, g = w >> 1, win = 2 << g, tl = 32 * tb + ql, tabs = t0 + tl;
    const float icnt = 1.0f / (float)((tabs + 1 < win) ? tabs + 1 : win);
    bf16x8 bfr[4];
#pragma unroll
    for (int s = 0; s < 4; ++s) { const LAS unsigned char* p0 = lds + (tl + 15) * 528 + (g * 64 + 16 * s + 8 * hh) * 2; float acc[8] = {0.f, 0.f, 0.f, 0.f, 0.f, 0.f, 0.f, 0.f};
        for (int j = 0; j < win; ++j) { const v4u r = *(const LAS v4u*)(p0 - j * 528);
            acc[0] += bflo(r.x); acc[1] += bfhi(r.x); acc[2] += bflo(r.y); acc[3] += bfhi(r.y); acc[4] += bflo(r.z); acc[5] += bfhi(r.z); acc[6] += bflo(r.w); acc[7] += bfhi(r.w); }
        const v4u r0 = *(const LAS v4u*)p0;
        v4u o; o.x = pg8::cvt_pk_bf16(acc[0] * icnt - bflo(r0.x), acc[1] * icnt - bfhi(r0.x)); o.y = pg8::cvt_pk_bf16(acc[2] * icnt - bflo(r0.y), acc[3] * icnt - bfhi(r0.y));
        o.z = pg8::cvt_pk_bf16(acc[4] * icnt - bflo(r0.z), acc[5] * icnt - bfhi(r0.z)); o.w = pg8::cvt_pk_bf16(acc[6] * icnt - bflo(r0.w), acc[7] * icnt - bfhi(r0.w));
        bfr[s] = __builtin_bit_cast(bf16x8, o); }
    const bf16* pwt = (const bf16*)(a.ws + WS_PWT) + (size_t)(l * 4 + g) * 4096;
    bf16* op = mix + (size_t)(b * T + tabs) * D + 256 + g * 64 + 4 * hh;
#pragma unroll
    for (int db = 0; db < 2; ++db) { f32x16 acc;
#pragma unroll
        for (int r = 0; r < 16; ++r) acc[r] = 0.f;
#pragma unroll
        for (int s = 0; s < 4; ++s) { const bf16x8 af = *(const bf16x8*)(pwt + (size_t)(32 * db + ql) * 64 + 16 * s + 8 * hh); acc = MFMA32(af, bfr[s], acc); }
#pragma unroll
        for (int q4 = 0; q4 < 4; ++q4) { const int d0 = 32 * db + 8 * q4 + 4 * hh;
            const f32x4 pb = *(const f32x4*)(a.in[IN_PB] + (l * 4 + g) * 64 + d0), ps = *(const f32x4*)(a.in[IN_PS] + l * 256 + g * 64 + d0);
            v2u o; o.x = pk2((acc[4 * q4] + pb.x) * ps.x, (acc[4 * q4 + 1] + pb.y) * ps.y); o.y = pk2((acc[4 * q4 + 2] + pb.z) * ps.z, (acc[4 * q4 + 3] + pb.w) * ps.w);
            *(v2u*)(op + 32 * db + 8 * q4) = o; } }
    __syncthreads();
}

constexpr int GL_V = 0;
constexpr int GL_KD = 32768;

__device__ __forceinline__ void gla_decay(const Args& a, int l, int h, const bf16* zc  , int lane, float (&b0)[16], float (&b1)[16]) {
    const int ql = lane & 31, hh = lane >> 5;
    bf16x8 wfrag; { float wv[8];
#pragma unroll
        for (int j = 0; j < 8; ++j) wv[j] = a.in[IN_WA2][(size_t)l * 2048 + (8 * hh + j) * 128 + h * 32 + ql];
        v4u t4; t4.x = pk2(wv[0], wv[1]); t4.y = pk2(wv[2], wv[3]); t4.z = pk2(wv[4], wv[5]); t4.w = pk2(wv[6], wv[7]); wfrag = __builtin_bit_cast(bf16x8, t4); }
    f32x16 binit;
#pragma unroll
    for (int q4 = 0; q4 < 4; ++q4) { const f32x4 t = *(const f32x4*)(a.in[IN_BA] + l * 128 + h * 32 + 8 * q4 + 4 * hh); binit[4 * q4] = t.x; binit[4 * q4 + 1] = t.y; binit[4 * q4 + 2] = t.z; binit[4 * q4 + 3] = t.w; }
#pragma unroll
    for (int rb = 0; rb < 2; ++rb) {
        const bf16x8 afrag = *(const bf16x8*)(zc + (size_t)(32 * rb + ql) * ZW + Z_ALR + 8 * hh);
        f32x16 lg = MFMA32(wfrag, afrag, binit);
#pragma unroll
        for (int r = 0; r < 16; ++r) { const float x = lg[r]; float v = (fminf(x, 0.f) - __logf(1.0f + __expf(-fabsf(x)))) * 0.0625f;
#pragma unroll
            for (int d = 1; d < 32; d <<= 1) { const float t = shfl_idx(v, (lane - d) & 63); if (ql >= d) v += t; }
            if (rb == 0) b0[r] = v; else b1[r] = v + shfl_idx(b0[r], lane | 31); }
    }
}
__device__ __forceinline__ void ld16acc(const bf16* p  , float (&x)[16]) {
#pragma unroll
    for (int q4 = 0; q4 < 4; ++q4) { const v2u t = *(const v2u*)(p + 8 * q4); x[4 * q4] = bflo(t.x); x[4 * q4 + 1] = bfhi(t.x); x[4 * q4 + 2] = bflo(t.y); x[4 * q4 + 3] = bfhi(t.y); }
}
__device__ __forceinline__ bf16x8 pack_frag(const float (&x)[16], int s) { v4u t4; t4.x = pg8::cvt_pk_bf16(x[8 * s], x[8 * s + 1]); t4.y = pg8::cvt_pk_bf16(x[8 * s + 2], x[8 * s + 3]); t4.z = pg8::cvt_pk_bf16(x[8 * s + 4], x[8 * s + 5]); t4.w = pg8::cvt_pk_bf16(x[8 * s + 6], x[8 * s + 7]); return __builtin_bit_cast(bf16x8, t4); }
__device__ __forceinline__ void gla2_a_item(const Args& a, int l, int item, LAS unsigned char* lds, int tid) {
    const int lane = tid & 63, w = __builtin_amdgcn_readfirstlane(tid >> 6), ql = lane & 31, hh = lane >> 5;
    const int n = item & 31, b = item >> 5, h = w >> 1, ib = w & 1, tok0 = b * T + n * 64, it4 = (b * 4 + h) * 32 + n;
    const bf16* z = (const bf16*)(a.ws + WS_Z); const bf16* zc = z + (size_t)tok0 * ZW;
    float* OI = (float*)(a.ws + WS_GOI); v4u* QTF = (v4u*)(a.ws + WS_GQT); float* KVT = (float*)(a.ws + WS_GKV); float* DEC = (float*)(a.ws + WS_GDEC);
#pragma unroll
    for (int i = 0; i < 4; ++i) { const int tk = (lane >> 3) + 8 * i, ch = lane & 7;
        const v4u v = *(const v4u*)(zc + (size_t)(32 * ib + tk) * ZW + Z_AV + h * 64 + ch * 8);
        *(LAS v4u*)(lds + GL_V + h * 8192 + (ib * 2 + (ch >> 2)) * 2048 + tk * 64 + (ch & 3) * 16) = v; }
    float b0[16], b1[16]; gla_decay(a, l, h, zc, lane, b0, b1);
    float blast[16];
#pragma unroll
    for (int r = 0; r < 16; ++r) blast[r] = shfl_idx(b1[r], lane | 31);
    float x[16], qt[16], kt[16], kd[16];
    ld16acc(zc + (size_t)(32 * ib + ql) * ZW + Z_AQ + h * 32 + 4 * hh, x);
#pragma unroll
    for (int r = 0; r < 16; ++r) qt[r] = x[r] * 0.17677669529663687f * __expf(ib ? b1[r] : b0[r]);
    ld16acc(zc + (size_t)(32 * ib + ql) * ZW + Z_AK + h * 32 + 4 * hh, x);
#pragma unroll
    for (int r = 0; r < 16; ++r) { const float bv = ib ? b1[r] : b0[r]; kt[r] = x[r] * __expf(-bv); kd[r] = x[r] * __expf(blast[r] - bv); }
    const bf16x8 qf0 = pack_frag(qt, 0), qf1 = pack_frag(qt, 1);
    QTF[((size_t)it4 * 2 + ib) * 128 + lane] = __builtin_bit_cast(v4u, qf0); QTF[((size_t)it4 * 2 + ib) * 128 + 64 + lane] = __builtin_bit_cast(v4u, qf1);
#pragma unroll
    for (int q4 = 0; q4 < 4; ++q4) { v2u o; o.x = pg8::cvt_pk_bf16(kd[4 * q4], kd[4 * q4 + 1]); o.y = pg8::cvt_pk_bf16(kd[4 * q4 + 2], kd[4 * q4 + 3]);
        *(LAS v2u*)(lds + GL_KD + h * 4096 + (32 * ib + ql) * 64 + (8 * q4 + 4 * hh) * 2) = o; }
    if (ib == 1 && ql == 31) {
#pragma unroll
        for (int q4 = 0; q4 < 4; ++q4) { f32x4 d; d.x = __expf(b1[4 * q4]); d.y = __expf(b1[4 * q4 + 1]); d.z = __expf(b1[4 * q4 + 2]); d.w = __expf(b1[4 * q4 + 3]); *(f32x4*)(DEC + (size_t)it4 * 32 + 8 * q4 + 4 * hh) = d; } }
    __syncthreads();
    f32x16 o0, o1;
#pragma unroll
    for (int r = 0; r < 16; ++r) { o0[r] = 0.f; o1[r] = 0.f; }
    const unsigned vaddr = (unsigned)(size_t)(lds + GL_V + h * 8192) + (unsigned)((4 * hh + ((lane >> 2) & 3)) * 64 + 32 * ((lane >> 4) & 1) + 8 * (lane & 3));
#pragma unroll
    for (int jb = 0; jb < 2; ++jb) {
        if (jb <= ib) {
            bf16x8 kf0, kf1;
            if (jb == ib) { kf0 = pack_frag(kt, 0); kf1 = pack_frag(kt, 1); }
            else { float kx[16]; ld16acc(zc + (size_t)ql * ZW + Z_AK + h * 32 + 4 * hh, kx);
#pragma unroll
                for (int r = 0; r < 16; ++r) kx[r] *= __expf(-b0[r]);
                kf0 = pack_frag(kx, 0); kf1 = pack_frag(kx, 1); }
            f32x16 at;
#pragma unroll
            for (int r = 0; r < 16; ++r) at[r] = 0.f;
            at = MFMA32(kf0, qf0, at); at = MFMA32(kf1, qf1, at);
            float pa[16];
#pragma unroll
            for (int r = 0; r < 16; ++r) { const int jl = (r & 3) + 8 * (r >> 2) + 4 * hh; pa[r] = (jb < ib || jl <= ql) ? at[r] : 0.f; }
            const bf16x8 pb0 = pack_frag(pa, 0), pb1 = pack_frag(pa, 1);
            bf16x4 t00, t01, t10, t11, u00, u01, u10, u11;
            tr_read_tile(vaddr + jb * 4096, t00, t01, t10, t11, u00, u01, u10, u11);
            o0 = MFMA32(__builtin_shufflevector(t00, t01, 0, 1, 2, 3, 4, 5, 6, 7), pb0, o0); o0 = MFMA32(__builtin_shufflevector(t10, t11, 0, 1, 2, 3, 4, 5, 6, 7), pb1, o0);
            o1 = MFMA32(__builtin_shufflevector(u00, u01, 0, 1, 2, 3, 4, 5, 6, 7), pb0, o1); o1 = MFMA32(__builtin_shufflevector(u10, u11, 0, 1, 2, 3, 4, 5, 6, 7), pb1, o1);
        }
    }
    { float* op = OI + (size_t)(tok0 + 32 * ib + ql) * 256 + h * 64 + 4 * hh;
#pragma unroll
      for (int q4 = 0; q4 < 4; ++q4) { *(f32x4*)(op + 8 * q4) = (f32x4){o0[4 * q4], o0[4 * q4 + 1], o0[4 * q4 + 2], o0[4 * q4 + 3]}; *(f32x4*)(op + 32 + 8 * q4) = (f32x4){o1[4 * q4], o1[4 * q4 + 1], o1[4 * q4 + 2], o1[4 * q4 + 3]}; } }
    { f32x16 sa;
#pragma unroll
      for (int r = 0; r < 16; ++r) sa[r] = 0.f;
      const unsigned lp = (unsigned)((8 * hh + ((lane >> 2) & 3)) * 64 + 32 * ((lane >> 4) & 1) + 8 * (lane & 3));
      const unsigned va = (unsigned)(size_t)(lds + GL_V + h * 8192) + lp, ka = (unsigned)(size_t)(lds + GL_KD + h * 4096) + lp;
#pragma unroll
      for (int tt = 0; tt < 2; ++tt)
#pragma unroll
        for (int ks = 0; ks < 2; ++ks) { const bf16x8 af = tr_frag(va + (tt * 2 + ib) * 2048 + ks * 1024), bfv = tr_frag(ka + (32 * tt + 16 * ks) * 64); sa = MFMA32(af, bfv, sa); }
      float* kp = KVT + (size_t)it4 * 2048 + (size_t)(32 * ib + 4 * hh) * 32 + ql;
#pragma unroll
      for (int r = 0; r < 16; ++r) kp[((r & 3) + 8 * (r >> 2)) * 32] = sa[r]; }
    __syncthreads();
}
__device__ __forceinline__ void gla2_c_item(const Args& a, int l, int item, LAS unsigned char* lds, int tid) {
    const int lane = tid & 63, w = __builtin_amdgcn_readfirstlane(tid >> 6), ql = lane & 31, hh = lane >> 5;
    const int n = item & 31, b = item >> 5, h = w >> 1, ib = w & 1, tok0 = b * T + n * 64, it4 = (b * 4 + h) * 32 + n;
    const bf16* z = (const bf16*)(a.ws + WS_Z); bf16* mix = (bf16*)(a.ws + WS_MIX);
    const float* OI = (const float*)(a.ws + WS_GOI); const v4u* QTF = (const v4u*)(a.ws + WS_GQT); const float* KVT = (const float*)(a.ws + WS_GKV); const float* DEC = (const float*)(a.ws + WS_GDEC);
    { LAS float* Sf = (LAS float*)lds; const int e0 = tid * 4;
      f32x4 S[4];
#pragma unroll
      for (int j = 0; j < 4; ++j) S[j] = (f32x4){0.f, 0.f, 0.f, 0.f};
      const float* kb = KVT + (size_t)(b * 4 * 32) * 2048 + e0; const float* db = DEC + (size_t)(b * 4 * 32) * 32 + (e0 & 31);
#pragma unroll 4
      for (int m = 0; m < n; ++m) {
#pragma unroll
          for (int j = 0; j < 4; ++j) { const f32x4 kv = *(const f32x4*)(kb + (size_t)(j * 32 + m) * 2048), dc = *(const f32x4*)(db + (size_t)(j * 32 + m) * 32); S[j] = S[j] * dc + kv; } }
#pragma unroll
      for (int j = 0; j < 4; ++j) *(LAS f32x4*)(Sf + j * 2048 + e0) = S[j];
      __syncthreads(); }
    float S0[16], S1[16];
    { const LAS float* sp = (const LAS float*)lds + h * 2048 + ql * 32 + 4 * hh;
#pragma unroll
      for (int q4 = 0; q4 < 4; ++q4) { const f32x4 t0 = *(const LAS f32x4*)(sp + 8 * q4), t1 = *(const LAS f32x4*)(sp + 1024 + 8 * q4);
          S0[4 * q4] = t0.x; S0[4 * q4 + 1] = t0.y; S0[4 * q4 + 2] = t0.z; S0[4 * q4 + 3] = t0.w; S1[4 * q4] = t1.x; S1[4 * q4 + 1] = t1.y; S1[4 * q4 + 2] = t1.z; S1[4 * q4 + 3] = t1.w; } }
    const bf16x8 qf0 = __builtin_bit_cast(bf16x8, QTF[((size_t)it4 * 2 + ib) * 128 + lane]), qf1 = __builtin_bit_cast(bf16x8, QTF[((size_t)it4 * 2 + ib) * 128 + 64 + lane]);
    f32x16 o0, o1;
    { const float* op = OI + (size_t)(tok0 + 32 * ib + ql) * 256 + h * 64 + 4 * hh;
#pragma unroll
      for (int q4 = 0; q4 < 4; ++q4) { const f32x4 t0 = *(const f32x4*)(op + 8 * q4), t1 = *(const f32x4*)(op + 32 + 8 * q4);
          o0[4 * q4] = t0.x; o0[4 * q4 + 1] = t0.y; o0[4 * q4 + 2] = t0.z; o0[4 * q4 + 3] = t0.w; o1[4 * q4] = t1.x; o1[4 * q4 + 1] = t1.y; o1[4 * q4 + 2] = t1.z; o1[4 * q4 + 3] = t1.w; } }
    o0 = MFMA32(pack_frag(S0, 0), qf0, o0); o0 = MFMA32(pack_frag(S0, 1), qf1, o0);
    o1 = MFMA32(pack_frag(S1, 0), qf0, o1); o1 = MFMA32(pack_frag(S1, 1), qf1, o1);
    float ss = 0.f;
#pragma unroll
    for (int r = 0; r < 16; ++r) ss += o0[r] * o0[r] + o1[r] * o1[r];
    ss += shfl_xor_c<32>(ss);
    const float rstd = rsqrtf(ss * (1.0f / 64.0f) + EPS);
    const size_t row = (size_t)(tok0 + 32 * ib + ql);
#pragma unroll
    for (int vb = 0; vb < 2; ++vb)
#pragma unroll
        for (int q4 = 0; q4 < 4; ++q4) { const int v0 = 32 * vb + 8 * q4 + 4 * hh;
            const f32x4 gn = *(const f32x4*)(a.in[IN_GNORM] + l * 256 + h * 64 + v0); const v2u gr = *(const v2u*)(z + row * ZW + Z_AG + h * 64 + v0);
            const float g0 = bflo(gr.x), g1 = bfhi(gr.x), g2 = bflo(gr.y), g3 = bfhi(gr.y);
            const float y0 = (vb ? o1[4 * q4] : o0[4 * q4]) * rstd * gn.x * silu_f(g0), y1 = (vb ? o1[4 * q4 + 1] : o0[4 * q4 + 1]) * rstd * gn.y * silu_f(g1);
            const float y2 = (vb ? o1[4 * q4 + 2] : o0[4 * q4 + 2]) * rstd * gn.z * silu_f(g2), y3 = (vb ? o1[4 * q4 + 3] : o0[4 * q4 + 3]) * rstd * gn.w * silu_f(g3);
            v2u o; o.x = pk2(y0, y1); o.y = pk2(y2, y3); *(v2u*)(mix + row * D + h * 64 + v0) = o; }
    __syncthreads();
}
constexpr int CW_QUEUE = 8192;
__device__ __forceinline__ void mixers_phase(const Args& a, int l, LAS unsigned char* lds, int tid) {
    dsa2_setup(a, lds, tid);
    unsigned* qctr = (unsigned*)(a.ws + WS_CTL) + CW_QUEUE + 64 * l;
    volatile LAS int* qslot = (volatile LAS int*)(lds + MISC_OFF + 64);
    for (;;) {
        if (tid == 0) *qslot = (int)__hip_atomic_fetch_add(qctr, 1u, __ATOMIC_RELAXED, __HIP_MEMORY_SCOPE_AGENT);
        __syncthreads();
        int it = *qslot;
        __syncthreads();
#ifdef REP_MIX
        if (it >= 2304) break;
        if (it >= 1152) it -= 1152;
        if (it < 512) dsa2_setup(a, lds, tid);
#elif defined(REP_DSA)
        if (it >= 1152 + 512) break;
        if (it >= 1152) it -= 1152;
        if (it < 512) dsa2_setup(a, lds, tid);
#else
        if (it >= 1152) break;
#endif
        const int t2 = (tid & ~63) + (int)lane_id_now();
        if (it < 512) dsa2_item(a, it, lds, t2);
        else if (it < 640) sgu2_item(a, l, it - 512, lds, t2);
        else if (it < 896) gla2_a_item(a, l, it - 640, lds, t2);
        else pool2_item(a, l, it - 896, lds, t2);
    }
#if defined(PROBE_DSA) && !defined(PROBE_GLA) && !defined(PROBE_SGU) && !defined(PROBE_POOL)
    __syncthreads(); dsa_setup(a, lds, tid);
    for (int it = M - 1 - (int)blockIdx.x; it >= 0; it -= gridDim.x) dsa_item(a, it, lds, tid, (bf16*)(a.ws + WS_QX), 256);
#endif
}
#ifdef PROBE_DSA
__device__ __forceinline__ void probe_dsa_compare(const Args& a, LAS unsigned char* lds, int tid, int col0 = 512) {
    const bf16* mix = (const bf16*)(a.ws + WS_MIX); const bf16* alt = (const bf16*)(a.ws + WS_QX); float d2 = 0.f, r2 = 0.f;
    for (size_t i = (size_t)blockIdx.x * NTHR + tid; i < (size_t)M * 256; i += (size_t)gridDim.x * NTHR) { const size_t row = i >> 8, c = i & 255; const float x = bf1(mix[row * D + col0 + c]), y = bf1(alt[i]); d2 += (x - y) * (x - y); r2 += y * y; }
    d2 = wave_sum(d2); r2 = wave_sum(r2);
    if ((tid & 63) == 0) { atomicAdd((float*)(a.ws + WS_CTL) + 12288, d2); atomicAdd((float*)(a.ws + WS_CTL) + 12289, r2); }
}
#endif

__device__ __forceinline__ unsigned long long uniform_u64(unsigned long long v) { const unsigned lo = __builtin_amdgcn_readfirstlane((unsigned)v), hi = __builtin_amdgcn_readfirstlane((unsigned)(v >> 32)); return ((unsigned long long)hi << 32) | lo; }
__device__ __forceinline__ void load_args(Args& la, LAS unsigned char* lds) {
    const LAS unsigned long long* p = (const LAS unsigned long long*)(lds + ARGS_OFF);
#pragma unroll
    for (int i = 0; i < N_IN; ++i) la.in[i] = (const float*)(const GAS float*)uniform_u64(p[i]);
    la.out = (float*)(GAS float*)uniform_u64(p[N_IN]); la.ws = (unsigned char*)(GAS unsigned char*)uniform_u64(p[N_IN + 1]);
}
constexpr int NPHASE = 28;
#define REPEAT_BEGIN(flag) { int nrep_ = (flag) ? 2 : 1; asm volatile("" : "+s"(nrep_)); _Pragma("unroll 1") for (int rep_ = 0; rep_ < nrep_; ++rep_) {
#define REPEAT_END() } }
#ifndef REP_Z
#define REP_Z 0
#endif
#ifndef REP_Q
#define REP_Q 0
#endif
#ifndef REP_FUP
#define REP_FUP 0
#endif
#ifndef REP_MUP
#define REP_MUP 0
#endif
#ifndef REP_MDN
#define REP_MDN 0
#endif
#define OTID() const int tid = wave_id * 64 + (int)lane_id_now(); Args la; load_args(la, lds)
__global__ void __launch_bounds__(NTHR, 2) fwd_kernel(Args a) {
    extern __shared__ __attribute__((aligned(16))) unsigned char lds_raw[];
    LAS unsigned char* lds = (LAS unsigned char*)lds_raw;
    const int G = gridDim.x, bid = blockIdx.x, wave_id = __builtin_amdgcn_readfirstlane(threadIdx.x >> 6);
    volatile LAS unsigned* MISC = (volatile LAS unsigned*)(lds + MISC_OFF);
    if (threadIdx.x < 32) MISC[threadIdx.x] = 0u;
    if (threadIdx.x < N_IN + 2) {
        const __attribute__((address_space(4))) unsigned long long* ka = (const __attribute__((address_space(4))) unsigned long long*)__builtin_amdgcn_kernarg_segment_ptr();
        ((LAS unsigned long long*)(lds + ARGS_OFF))[threadIdx.x] = ka[threadIdx.x]; }
    __syncthreads();
    unsigned char* ws0 = a.ws; unsigned char* ws = ws0;
#define PH() GAS unsigned char* wsg_ = (GAS unsigned char*)ws0; asm volatile("" : "+s"(wsg_)); unsigned char* ws = (unsigned char*)wsg_
    XcdBarrier bar; bar.bar = (unsigned*)(ws + WS_CTL) + CW_BAR; bar.x = 0; bar.st = nullptr; bar.wid = (unsigned)wave_id;
    if (N_LAUNCH_MODE == 1) bar = xcd_barrier_post((unsigned*)(ws + WS_CTL) + CW_BAR, MISC + 8);
    const int lo = a.ph_lo, hi = a.ph_hi;
#if defined(PROBE_GLA) || defined(PROBE_SGU) || defined(PROBE_POOL)
#define RUN(k) ((k) <= 3 && lo <= (k) && (k) < hi)
#else
#define RUN(k) (lo <= (k) && (k) < hi)
#endif
#define SEAM() do { if (N_LAUNCH_MODE == 1) xcd_barrier(bar); } while (0)
#define WB(off) ((bf16*)(ws + (off)))
#define WF(off) ((float*)(ws + (off)))
#ifdef REP_PRO
    if (RUN(0)) { PH(); int nrep = 2; asm volatile("" : "+s"(nrep));
#pragma unroll 1
        for (int rep = 0; rep < nrep; ++rep) { OTID(); p0_prologue(la, lds, tid, G); } SEAM(); }
#else
    if (RUN(0)) { PH(); OTID(); p0_prologue(la, lds, tid, G); SEAM(); }
#endif

    for (int l = 0; l < 2; ++l) {
        const int pb = l ? 10 : 1;
        if (RUN(pb + 0)) { PH();
            REPEAT_BEGIN(REP_Z)
            { pg8::Gemm g{WB(WS_HB), WB(WS_WIN + l * SZ_WIN), M, ZW, D}; pg8::StaticOrder S; S.init(M, ZW, G, bid);
              EpiScale E{WB(WS_Z), ZW, WF(WS_SS), 1.0f}; pg8::gemm_phase<EpiScale, pg8::StaticOrder, true, true>(lds, g, S, E, wave_id); }
            REPEAT_END()
            if (l == 0) {
                for (int l2 = 0; l2 < 2; ++l2) {
                    pg8::Gemm g{WB(WS_MEMB), WB(WS_WKV + l2 * SZ_WKV), MM, 512, D}; pg8::StaticOrder S; S.init(MM, 512, G, (G - 1 - bid - 16 * l2 + 2 * G) % G);
                    EpiScale E{WB(WS_KVM + l2 * SZ_KVM), 512, WF(WS_SSM), 1.0f}; pg8::gemm_phase<EpiScale, pg8::StaticOrder, true, true>(lds, g, S, E, wave_id); }
            }
            SEAM();
        }
        if (RUN(pb + 1)) { PH();
            { OTID(); mixers_phase(la, l, lds, tid); }
#if defined(PROBE_SGU) || defined(PROBE_POOL)
            SEAM();
            { constexpr int PCOL =
#ifdef PROBE_SGU
                768;
#else
                256;
#endif
              bf16* mixp = WB(WS_MIX); bf16* alt = WB(WS_QX);
              for (size_t i = (size_t)bid * NTHR + threadIdx.x; i < (size_t)M * 256; i += (size_t)G * NTHR) alt[i] = mixp[(i >> 8) * D + PCOL + (i & 255)];
              SEAM();
#ifdef PROBE_SGU
              { OTID(); for (int it = bid; it < 512; it += G) sgu_item(la, l, it, lds, tid); }
#else
              { OTID(); for (int it = bid; it < 1024; it += G) pool_item(la, l, it, lds, tid); }
#endif
              SEAM();
              { OTID(); probe_dsa_compare(la, lds, tid, PCOL); }
              SEAM();
              { const float* pr = (const float*)(ws + WS_CTL) + 12288; const float padd = PROBE_C * sqrtf(pr[0] / fmaxf(pr[1], 1e-30f));
                for (size_t i = (size_t)bid * NTHR + threadIdx.x; i < (size_t)M * D; i += (size_t)G * NTHR) la.out[i] = padd; return; } }
#endif
            SEAM();
        }
#ifdef REP_GLAC
        if (RUN(pb + 2)) { PH(); OTID(); int nit = 512; asm volatile("" : "+s"(nit)); for (int it = bid; it < nit; it += G) gla2_c_item(la, l, it & 255, lds, tid);
#else
        if (RUN(pb + 2)) { PH(); OTID(); for (int it = bid; it < 256; it += G) gla2_c_item(la, l, it, lds, tid);
#endif
#if defined(PROBE_DSA) && !defined(PROBE_GLA) && !defined(PROBE_SGU) && !defined(PROBE_POOL)
            probe_dsa_compare(la, lds, tid);
#endif
            SEAM();
#ifdef PROBE_GLA
            { bf16* mixp = WB(WS_MIX); bf16* alt = WB(WS_QX);
              for (size_t i = (size_t)bid * NTHR + threadIdx.x; i < (size_t)M * 256; i += (size_t)G * NTHR) alt[i] = mixp[(i >> 8) * D + (i & 255)];
              SEAM();
              { OTID(); for (int it = bid; it < 1024; it += G) gla_a_item(la, l, it, lds, tid); }
              SEAM();
              { OTID(); for (int it = bid; it < 1024; it += G) gla_c_item(la, l, it, lds, tid); }
              SEAM();
              { OTID(); probe_dsa_compare(la, lds, tid, 0); }
              SEAM();
              { const float* pr = (const float*)(ws + WS_CTL) + 12288; const float padd = PROBE_C * sqrtf(pr[0] / fmaxf(pr[1], 1e-30f));
                for (size_t i = (size_t)bid * NTHR + threadIdx.x; i < (size_t)M * D; i += (size_t)G * NTHR) la.out[i] = padd; return; } }
#endif
            }
        if (RUN(pb + 3)) { PH();
            pg8::Gemm g{WB(WS_MIX), WB(WS_WOUT + l * SZ_WOUT), M, D, D}; pg8::StaticOrder S; S.init(M, D, G, bid);
            Args la; load_args(la, lds); EpiResid E{l == 0 ? la.in[IN_X] : (const float*)la.out, la.out, WB(WS_HB), WF(WS_SS)}; pg8::gemm_phase<EpiResid, pg8::StaticOrder, true, true>(lds, g, S, E, wave_id); SEAM();
        }
        if (RUN(pb + 4)) { PH();
            REPEAT_BEGIN(REP_Q)
            pg8::Gemm g{WB(WS_HB), WB(WS_WQ + l * SZ_WQ), M, 256, D}; pg8::StaticOrder S; S.init(M, 256, G, bid);
            EpiScale E{WB(WS_QX), 256, WF(WS_SS), 0.125f}; pg8::gemm_phase<EpiScale, pg8::StaticOrder, true, true>(lds, g, S, E, wave_id);
            REPEAT_END()
            SEAM();
        }
#ifdef REP_XA
        if (RUN(pb + 5)) { PH(); OTID(); int nit = 512; asm volatile("" : "+s"(nit)); for (int it = bid; it < nit; it += G) xattn2_item(la, l, it & 255, lds, tid); SEAM(); }
#else
        if (RUN(pb + 5)) { PH(); OTID(); for (int it = bid; it < 256; it += G) xattn2_item(la, l, it, lds, tid); SEAM(); }
#endif
        if (RUN(pb + 6)) { PH();
            pg8::Gemm g{WB(WS_OX), WB(WS_WO + l * SZ_WO), M, D, 256}; pg8::StaticOrder S; S.init(M, D, G, bid);
            Args la; load_args(la, lds); EpiResid E{la.out, la.out, WB(WS_HB), WF(WS_SS)}; pg8::gemm_phase<EpiResid, pg8::StaticOrder, true, true>(lds, g, S, E, wave_id); SEAM();
        }
        if (l == 0) {
            if (RUN(8)) { PH();
                REPEAT_BEGIN(REP_FUP)
                pg8::Gemm g{WB(WS_HB), WB(WS_W13), M, 2 * DFF, D}; pg8::StaticOrder S; S.init(M, 2 * DFF, G, bid);
                EpiSwiglu<false> E{WB(WS_FACT), DFF, WF(WS_SS), nullptr, nullptr}; pg8::gemm_phase<EpiSwiglu<false>, pg8::StaticOrder, true, true>(lds, g, S, E, wave_id);
                REPEAT_END()
                SEAM();
            }
            if (RUN(9)) { PH();
                pg8::Gemm g{WB(WS_FACT), WB(WS_W2), M, D, DFF}; pg8::StaticOrder S; S.init(M, D, G, bid);
                Args la; load_args(la, lds); EpiResid E{la.out, la.out, WB(WS_HB), WF(WS_SS)}; pg8::gemm_phase<EpiResid, pg8::StaticOrder, true, true>(lds, g, S, E, wave_id); SEAM();
            }
        } else {
#ifdef REP_R1
            if (RUN(17)) { PH(); OTID(); moe_route(la, lds, tid, G); __syncthreads(); moe_route(la, lds, tid, G); SEAM(); }
#else
            if (RUN(17)) { PH(); OTID(); moe_route(la, lds, tid, G); SEAM(); }
#endif
#ifdef REP_ROUTE
            if (RUN(18)) { PH(); int nrep = 2; asm volatile("" : "+s"(nrep));
#pragma unroll 1
                for (int rep = 0; rep < nrep; ++rep) { OTID(); moe_assign(la, lds, tid, G); __syncthreads(); } SEAM(); }
#else
            if (RUN(18)) { PH(); OTID(); moe_assign(la, lds, tid, G); SEAM(); }
#endif
            for (int ph = 0; ph <= MOE_NPASS; ++ph) {
                const int* TILEE = (const int*)(ws + WS_TILEE);
                if (RUN(19 + ph)) { PH();
                    const int NT = TILEE[159]; int ndown = 0;
                    if (ph > 0) { const int p = ph - 1; int nt = NT - p * MOE_TP; nt = nt < 0 ? 0 : (nt > MOE_TP ? MOE_TP : nt); ndown = nt * (D / 256); if (ndown > G) ndown = G;
                        REPEAT_BEGIN(REP_MDN)
                        pg8::Gemm g{WB(WS_MACT + (p & 1) * SZ_MACT), WB(WS_MW2), MOE_TP * 256, NEXP * D, DFE}; pg8::MoeOrder S{p * MOE_TP, nt, D / 256, G, bid, 1, TILEE, 0, 0};
                        EpiPlain E{WB(WS_YS), D};
                        pg8::gemm_phase<EpiPlain, pg8::MoeOrder, true, true>(lds, g, S, E, wave_id);
                        REPEAT_END() }
                    if (ph < MOE_NPASS) { const int p = ph; int nt = NT - p * MOE_TP; nt = nt < 0 ? 0 : (nt > MOE_TP ? MOE_TP : nt);
                        REPEAT_BEGIN(REP_MUP)
                        pg8::Gemm g{WB(WS_HB), WB(WS_MW13), M, NEXP * 2 * DFE, D, (const int*)(ws + WS_SLOTT)}; pg8::MoeOrder S{p * MOE_TP, nt, 2 * DFE / 256, G, bid, 0, TILEE, ndown, 4};
                        EpiSwiglu<true> E{WB(WS_MACT + (p & 1) * SZ_MACT), DFE, nullptr, WF(WS_SLOTR), WF(WS_SLOTG)};
                        pg8::gemm_phase<EpiSwiglu<true>, pg8::MoeOrder, true, true, true>(lds, g, S, E, wave_id);
                        REPEAT_END() }
                    SEAM();
                }
            }
            if (RUN(27)) { PH(); OTID(); final_phase(la, tid, G); }
        }
    }
#undef RUN
#undef SEAM
}

extern "C" void kernel_launch(void* const* d_in, const int* in_sizes, int n_in, void* d_out, int out_size, void* d_ws, size_t ws_size, hipStream_t stream) {
    static int grid = 0;
    if (grid == 0) {
        if (n_in != N_IN || out_size != M * D || ws_size < WS_END) { fprintf(stderr, "kernel_launch: unexpected problem (n_in %d, out %d, ws %zu < %zu)\n", n_in, out_size, ws_size, (size_t)WS_END); grid = -1; return; }
        int dev = 0, cus = 0, per_cu = 0;
        if (hipGetDevice(&dev) != hipSuccess || hipDeviceGetAttribute(&cus, hipDeviceAttributeMultiprocessorCount, dev) != hipSuccess) { grid = -1; return; }
        if (hipFuncSetAttribute((const void*)fwd_kernel, hipFuncAttributeMaxDynamicSharedMemorySize, LDS_BYTES) != hipSuccess) { fprintf(stderr, "kernel_launch: hipFuncSetAttribute failed\n"); grid = -1; return; }
        if (hipOccupancyMaxActiveBlocksPerMultiprocessor(&per_cu, (const void*)fwd_kernel, NTHR, LDS_BYTES) != hipSuccess || per_cu < 1) { fprintf(stderr, "kernel_launch: occupancy query says %d\n", per_cu); }
        (void)hipGetLastError();
        grid = (cus > 0 && cus < 256) ? cus : 256;
    }
    if (grid < 0) return;
    (void)hipMemsetAsync((char*)d_ws + WS_CTL, 0, CTL_ZERO_BYTES, stream);
    Args a{};
    for (int i = 0; i < N_IN; ++i) a.in[i] = (const float*)d_in[i];
    a.out = (float*)d_out; a.ws = (unsigned char*)d_ws;
#if N_LAUNCH_MODE == 1
    a.ph_lo = 0; a.ph_hi = NPHASE;
    hipLaunchKernelGGL(fwd_kernel, dim3(grid), dim3(NTHR), LDS_BYTES, stream, a);
#else
    for (int p = 0; p < NPHASE; ++p) { a.ph_lo = p; a.ph_hi = p + 1; hipLaunchKernelGGL(fwd_kernel, dim3(grid), dim3(NTHR), LDS_BYTES, stream, a); }
#endif
}
```

```cpp
#include <hip/hip_runtime.h>
#include <cstdio>
#include <cstdint>
#include <cmath>

#ifndef N_LAUNCH_MODE
#define N_LAUNCH_MODE 1
#endif

namespace pg8 {
#define PG8_LAS __attribute__((address_space(3)))
typedef unsigned short bf16_t;
typedef short bf16x8 __attribute__((ext_vector_type(8)));
typedef float f32x4 __attribute__((ext_vector_type(4)));
typedef unsigned u32x4 __attribute__((ext_vector_type(4)));
constexpr int BM = 256, BK = 64, HALF = 128, HTB = HALF * BK * 2  , STAGE_BYTES = 8 * HTB, NXCD = 8, WGM = 8;

__host__ __device__ __forceinline__ int lds_byte(int r, int c) { const int st = (r >> 4) * 2 + (c >> 5), rr = r & 15, cc = c & 31, ob = rr * 64 + cc * 2; return st * 1024 + (ob ^ (((ob >> 9) & 1) << 5)); }
__host__ __device__ __forceinline__ void stage_rc(int b, int& R, int& C) { const int st = b / 1024, sb = b % 1024, swz = sb ^ (((sb >> 9) & 1) << 5); R = (st >> 1) * 16 + swz / 64; C = (st & 1) * 32 + (swz % 64) / 2; }
__host__ __device__ __forceinline__ int perm32(int rho) { const int n = rho >> 4, i = rho & 15; return 8 * (i >> 2) + 4 * n + (i & 3); }

struct Unit { int pm, pn, po, e; };
struct Gemm { const bf16_t* A; const bf16_t* Bt; int M, N, K; const int* rowmap; };

struct StaticOrder {
    int nM, nN, nwg, G, c;
    __host__ __device__ void init(int M, int N, int G_, int c_) { nM = M / BM; nN = N / BM; nwg = nM * nN; G = G_; c = c_; }
    __host__ __device__ bool next(int i, Unit& u) const {
        const long L = (long)i * G + c; if (L >= nwg) return false;
        int wgid = (int)L; { const int q = nwg / NXCD, r = nwg % NXCD, xcd = wgid % NXCD, off = wgid / NXCD; wgid = (xcd < r ? xcd * (q + 1) : r * (q + 1) + (xcd - r) * q) + off; }
        const int nig = WGM * nN, gid = wgid / nig, fm = gid * WGM, gsz = (nM - fm) < WGM ? (nM - fm) : WGM;
        u.pm = fm + ((wgid % nig) % gsz); u.pn = (wgid % nig) / gsz; u.po = u.pm; u.e = u.pn; return true;
    }
    __device__ __forceinline__ void a_ready(const Unit&) const {}
    __device__ __forceinline__ void done(const Unit&) const {}
};
struct MoeOrder {
    int t0, nt, nNe, G, c, a_local; const int* tile_e; int nd, sh;
    __device__ bool next(int i, Unit& u) const {
        const int F = G - nd; long L;
        if (c >= nd) L = (i < sh) ? (long)i * F + (c - nd) : (long)sh * F + (long)(i - sh) * G + c; else L = (long)sh * F + (long)i * G + c;
        if (L >= (long)nt * nNe) return false;
        const int tl = (int)(L % nt), pn = (int)(L / nt), tile = t0 + tl, e = tile_e[tile];
        u.pm = a_local ? tl : tile; u.po = a_local ? tile : tl; u.pn = e * nNe + pn; u.e = pn; return true;
    }
    __device__ __forceinline__ void a_ready(const Unit&) const {}
    __device__ __forceinline__ void done(const Unit&) const {}
};
__device__ __forceinline__ unsigned cvt_pk_bf16(float lo, float hi) { unsigned r; asm volatile("v_cvt_pk_bf16_f32 %0, %1, %2" : "=v"(r) : "v"(lo), "v"(hi)); return r; }
template <class Epi, class Sched, bool ALIGN_EPI = false, bool SP2 = false, bool GATHER = false, int ES = 2>
__device__ __forceinline__ void gemm_phase(PG8_LAS unsigned char* lds, const Gemm g, const Sched& S, const Epi& E, int wave_id) {
    unsigned lane_; asm volatile("v_mbcnt_lo_u32_b32 %0, -1, 0\n\tv_mbcnt_hi_u32_b32 %0, -1, %0" : "=v"(lane_)); const int tid_ = wave_id * 64 + (int)lane_; const int tid = tid_, wid = __builtin_amdgcn_readfirstlane(tid >> 6), lane = tid & 63, wr = wid >> 2, wc = wid & 3, fr = lane & 15, fq = lane >> 4;
    static_assert(!GATHER || SP2, "gather staging is written for the two-super-phase loop");
    const int K = g.K, nt = (K * ES) / (BK * 2);
    unsigned voffA[2], voffB[2];
#pragma unroll
    for (int i = 0; i < 2; ++i) { int R, C; stage_rc(tid * 16 + i * 8192, R, C); const int Rb = Epi::PERM ? ((R & ~31) + perm32(R & 31)) : R;
        voffA[i] = (unsigned)(R * K * ES + C * 2); voffB[i] = (unsigned)(Rb * K * ES + C * 2); }
    unsigned vgC[2][2], vgN[2][2];
#define PG8_GOFF(dst, pm_) do { if constexpr (GATHER) { _Pragma("unroll") for (int _h = 0; _h < 2; ++_h) _Pragma("unroll") for (int _i = 0; _i < 2; ++_i) \
        { int _R, _C; stage_rc(tid * 16 + _i * 8192, _R, _C); dst[_h][_i] = (unsigned)g.rowmap[(pm_) * BM + _h * HALF + _R] * (unsigned)(K * ES) + (unsigned)_C * 2u; } } } while (0)
    const size_t kstep = (size_t)(BK * 2);
    const size_t hstep = (size_t)HALF * K * ES;
    const size_t tstep = 2 * hstep;
    const unsigned ldsw = (unsigned)wid * 1024u;
    const int aoff = ES == 2 ? lds_byte(wr * 64 + fr, fq * 8) : lds_byte(wr * 64 + fr, fq * 16), boff = ES == 2 ? lds_byte(wc * 32 + fr, fq * 8) : lds_byte(wc * 32 + fr, fq * 16);
    const int aoff2 = ES == 2 ? aoff + 1024 : lds_byte(wr * 64 + fr, fq * 16 + 8), boff2 = ES == 2 ? boff + 1024 : lds_byte(wc * 32 + fr, fq * 16 + 8);
#define PG8_SA(b, h) (((b) * 2 + (h)) * HTB)
#define PG8_SB(b, h) ((4 + (b) * 2 + (h)) * HTB)
#define PG8_STAGE_A(b, h, gbase, vg) do { if constexpr (GATHER) { PG8_STAGE(PG8_SA(b, h), gbase, vg[h]); } else { PG8_STAGE(PG8_SA(b, h), (gbase) + (h) * hstep, voffA); } } while (0)
#define PG8_STAGE(bufoff, gbase, voff) do { _Pragma("unroll") for (int _i = 0; _i < 2; ++_i) \
        __builtin_amdgcn_global_load_lds((const unsigned*)((const char*)(gbase) + (voff)[_i]), (PG8_LAS unsigned*)(lds + (bufoff) + ldsw + _i * 8192), 16, 0, 0); } while (0)
#define PG8_LDA(dst, b, h) do { _Pragma("unroll") for (int m = 0; m < 4; ++m) _Pragma("unroll") for (int k = 0; k < 2; ++k) dst[m][k] = *(const PG8_LAS bf16x8*)(lds + PG8_SA(b, h) + (k ? aoff2 : aoff) + m * 2048); } while (0)
#define PG8_LDB(dst, b, h) do { _Pragma("unroll") for (int n = 0; n < 2; ++n) _Pragma("unroll") for (int k = 0; k < 2; ++k) dst[n][k] = *(const PG8_LAS bf16x8*)(lds + PG8_SB(b, h) + (k ? boff2 : boff) + n * 2048); } while (0)
#define PG8_MMA(ai, bj, At, Bt) do { __builtin_amdgcn_s_setprio(1); _Pragma("unroll") for (int m = 0; m < 4; ++m) _Pragma("unroll") for (int n = 0; n < 2; ++n) { \
        if constexpr (ES == 2) { _Pragma("unroll") for (int k = 0; k < 2; ++k) acc[ai][bj][m][n] = __builtin_amdgcn_mfma_f32_16x16x32_bf16(Bt[n][k], At[m][k], acc[ai][bj][m][n], 0, 0, 0); } \
        else { const i32x4_ bl_ = __builtin_bit_cast(i32x4_, Bt[n][0]), bh_ = __builtin_bit_cast(i32x4_, Bt[n][1]), al_ = __builtin_bit_cast(i32x4_, At[m][0]), ah_ = __builtin_bit_cast(i32x4_, At[m][1]); \
               acc[ai][bj][m][n] = __builtin_amdgcn_mfma_scale_f32_16x16x128_f8f6f4(__builtin_shufflevector(bl_, bh_, 0, 1, 2, 3, 4, 5, 6, 7), __builtin_shufflevector(al_, ah_, 0, 1, 2, 3, 4, 5, 6, 7), \
                                                                                     acc[ai][bj][m][n], 0, 0, 0, 0x7f7f7f7f, 0, 0x7f7f7f7f); } } \
        __builtin_amdgcn_s_setprio(0); } while (0)
#define PG8_WAIT_V(n) asm volatile("s_waitcnt vmcnt(" #n ")" ::: "memory")
#define PG8_WAIT_L(n) asm volatile("s_waitcnt lgkmcnt(" #n ")" ::: "memory")
#define PG8_BAR __builtin_amdgcn_s_barrier()
#define PG8_SCHED __builtin_amdgcn_sched_barrier(0)
    Unit cur, nxt; int ui = 0;
    if (!S.next(0, cur)) return;
    f32x4 acc[2][2][4][2];
#pragma unroll
    for (int a = 0; a < 2; ++a)
#pragma unroll
        for (int b = 0; b < 2; ++b)
#pragma unroll
            for (int m = 0; m < 4; ++m)
#pragma unroll
                for (int n = 0; n < 2; ++n) acc[a][b][m][n] = (f32x4){0.f, 0.f, 0.f, 0.f};
    typedef int i32x4_ __attribute__((ext_vector_type(4))); typedef int i32x8_ __attribute__((ext_vector_type(8)));
    bf16x8 At[4][2], B0[2][2], B1[2][2];
    const char* cA = (const char*)g.A + (GATHER ? (size_t)0 : (size_t)cur.pm * tstep); const char* cB = (const char*)g.Bt + (size_t)cur.pn * tstep;
    PG8_GOFF(vgC, cur.pm);
    S.a_ready(cur);
    if constexpr (SP2) {
        PG8_STAGE(PG8_SB(0, 0), cB, voffB); PG8_STAGE(PG8_SB(0, 1), cB + hstep, voffB); PG8_STAGE_A(0, 0, cA, vgC); PG8_STAGE_A(0, 1, cA, vgC);
        if (wr == 1) PG8_BAR;
        PG8_WAIT_V(2); PG8_BAR;
        PG8_STAGE(PG8_SB(1, 0), cB + kstep, voffB); PG8_STAGE_A(1, 0, cA + kstep, vgC); PG8_STAGE(PG8_SB(1, 1), cB + hstep + kstep, voffB);
        PG8_WAIT_V(6); PG8_BAR;
    } else {
        PG8_STAGE(PG8_SB(0, 0), cB, voffB); PG8_STAGE(PG8_SA(0, 0), cA, voffA); PG8_STAGE(PG8_SB(0, 1), cB + hstep, voffB); PG8_STAGE(PG8_SA(0, 1), cA + hstep, voffA);
        if (wr == 1) PG8_BAR;
        PG8_WAIT_V(4); PG8_BAR;
        PG8_STAGE(PG8_SB(1, 0), cB + kstep, voffB); PG8_STAGE(PG8_SA(1, 0), cA + kstep, voffA); PG8_STAGE(PG8_SB(1, 1), cB + hstep + kstep, voffB);
        PG8_WAIT_V(6); PG8_BAR;
    }
    for (;;) {
        const bool has_next = S.next(ui + 1, nxt);
        const char* nA = (has_next && !GATHER) ? (const char*)g.A + (size_t)nxt.pm * tstep : cA; const char* nB = has_next ? (const char*)g.Bt + (size_t)nxt.pn * tstep : cB;
        if constexpr (GATHER) { if (has_next) { PG8_GOFF(vgN, nxt.pm); } else { _Pragma("unroll") for (int _h = 0; _h < 2; ++_h) _Pragma("unroll") for (int _i = 0; _i < 2; ++_i) vgN[_h][_i] = vgC[_h][_i]; } }
#pragma unroll 1
        for (int t = 0; t < nt; t += 2) {
            const bool last = (t == nt - 2);
            const char* a1 = cA + (size_t)(t + 1) * kstep;
            const char* a2 = last ? nA : cA + (size_t)(t + 2) * kstep; const char* b2 = last ? nB : cB + (size_t)(t + 2) * kstep;
            const char* a3 = a2 + kstep; const char* b3 = b2 + kstep;
            if (last && has_next) S.a_ready(nxt);
            if constexpr (SP2) {
            PG8_LDB(B0, 0, 0); PG8_LDB(B1, 0, 1); PG8_SCHED; PG8_LDA(At, 0, 0); PG8_STAGE_A(1, 1, a1, vgC);
            if constexpr (GATHER) { if (last) { _Pragma("unroll") for (int _h = 0; _h < 2; ++_h) _Pragma("unroll") for (int _i = 0; _i < 2; ++_i) vgC[_h][_i] = vgN[_h][_i]; } }
            PG8_WAIT_V(8); PG8_WAIT_L(0); PG8_BAR; PG8_MMA(0, 0, At, B0); PG8_MMA(0, 1, At, B1); PG8_BAR; PG8_SCHED;
            PG8_LDA(At, 0, 1); PG8_STAGE(PG8_SB(0, 0), b2, voffB); PG8_STAGE(PG8_SB(0, 1), b2 + hstep, voffB); PG8_STAGE_A(0, 0, a2, vgC);
            PG8_WAIT_V(8); PG8_WAIT_L(0); PG8_BAR; PG8_MMA(1, 0, At, B0); PG8_MMA(1, 1, At, B1); PG8_BAR; PG8_SCHED;
            PG8_LDB(B0, 1, 0); PG8_LDB(B1, 1, 1); PG8_SCHED; PG8_LDA(At, 1, 0); PG8_STAGE_A(0, 1, a2, vgC);
            PG8_WAIT_V(8); PG8_WAIT_L(0); PG8_BAR; PG8_MMA(0, 0, At, B0); PG8_MMA(0, 1, At, B1); PG8_BAR; PG8_SCHED;
            PG8_LDA(At, 1, 1); PG8_STAGE(PG8_SB(1, 0), b3, voffB); PG8_STAGE(PG8_SB(1, 1), b3 + hstep, voffB); PG8_STAGE_A(1, 0, a3, vgC);
            PG8_WAIT_V(8); PG8_WAIT_L(0); PG8_BAR; PG8_MMA(1, 0, At, B0); PG8_MMA(1, 1, At, B1); PG8_BAR; PG8_SCHED;
            } else {
            PG8_LDB(B0, 0, 0); PG8_SCHED; PG8_LDA(At, 0, 0); PG8_STAGE(PG8_SA(1, 1), a1 + hstep, voffA);
            PG8_WAIT_L(8); PG8_BAR; PG8_WAIT_L(0); PG8_MMA(0, 0, At, B0); PG8_BAR; PG8_SCHED;
            PG8_LDB(B1, 0, 1); PG8_STAGE(PG8_SB(0, 0), b2, voffB);
            PG8_BAR; PG8_WAIT_L(0); PG8_MMA(0, 1, At, B1); PG8_BAR;
            PG8_LDA(At, 0, 1); PG8_STAGE(PG8_SA(0, 0), a2, voffA);
            PG8_BAR; PG8_WAIT_L(0); PG8_MMA(1, 0, At, B0); PG8_BAR; PG8_SCHED;
            PG8_STAGE(PG8_SB(0, 1), b2 + hstep, voffB);
            PG8_WAIT_V(6); PG8_BAR; PG8_MMA(1, 1, At, B1); PG8_BAR;
            PG8_LDB(B0, 1, 0); PG8_SCHED; PG8_LDA(At, 1, 0); PG8_STAGE(PG8_SA(0, 1), a2 + hstep, voffA);
            PG8_WAIT_L(8); PG8_BAR; PG8_WAIT_L(0); PG8_MMA(0, 0, At, B0); PG8_BAR; PG8_SCHED;
            PG8_LDB(B1, 1, 1); PG8_STAGE(PG8_SB(1, 0), b3, voffB);
            PG8_BAR; PG8_WAIT_L(0); PG8_MMA(0, 1, At, B1); PG8_BAR;
            PG8_LDA(At, 1, 1); PG8_STAGE(PG8_SA(1, 0), a3, voffA);
            PG8_BAR; PG8_WAIT_L(0); PG8_MMA(1, 0, At, B0); PG8_BAR; PG8_SCHED;
            PG8_STAGE(PG8_SB(1, 1), b3 + hstep, voffB);
            PG8_WAIT_V(6); PG8_BAR; PG8_MMA(1, 1, At, B1); PG8_BAR;
            }
        }
        if constexpr (ALIGN_EPI) { if (wr == 0) PG8_BAR; }
        if constexpr (!Epi::AFTER_DRAIN) { E(acc, cur, wr, wc, fr, fq); S.done(cur); }
        if (!has_next) break;
#pragma unroll
        for (int a = 0; a < 2; ++a)
#pragma unroll
            for (int b = 0; b < 2; ++b)
#pragma unroll
                for (int m = 0; m < 4; ++m)
#pragma unroll
                    for (int n = 0; n < 2; ++n) acc[a][b][m][n] = (f32x4){0.f, 0.f, 0.f, 0.f};
        cur = nxt; cA = nA; cB = nB; ++ui;
        if constexpr (ALIGN_EPI) { if (wr == 1) PG8_BAR; }
    }
    PG8_WAIT_V(0);
    if constexpr (!ALIGN_EPI) { if (wr == 0) PG8_BAR; }
    PG8_BAR;
    if constexpr (Epi::AFTER_DRAIN) { E.fused(acc, cur, wr, wc, fr, fq, lds, wid, lane); S.done(cur); }
#undef PG8_SA
#undef PG8_SB
#undef PG8_STAGE
#undef PG8_STAGE_A
#undef PG8_GOFF
#undef PG8_LDA
#undef PG8_LDB
#undef PG8_MMA
#undef PG8_WAIT_V
#undef PG8_WAIT_L
#undef PG8_BAR
#undef PG8_SCHED
}
}

constexpr int BATCH = 8, T = 2048, D = 1024, M = BATCH * T, MEMLEN = 256, MM = BATCH * MEMLEN;
constexpr int INW = 2616, ZW = 2816;
constexpr int DFF = 2816, NEXP = 8, DFE = 3584;
constexpr float EPS = 1e-6f;
constexpr int Z_AQ = 0, Z_AK = 128, Z_AV = 256, Z_AG = 512, Z_CQ = 768, Z_CK = 1024, Z_CV = 1280, Z_CQI = 1536, Z_DUV = 1792, Z_BU = 2304, Z_ALR = 2560, Z_CKI = 2576, Z_CWI = 2608;
__host__ __device__ constexpr int zcol_of(int n) {
    return n < 768 ? n : n < 784 ? Z_ALR + (n - 768) : n < 1040 ? Z_BU + (n - 784) : n < 2064 ? Z_CQ + (n - 1040) : n < 2096 ? Z_CKI + (n - 2064) : n < 2104 ? Z_CWI + (n - 2096) : Z_DUV + (n - 2104);
}
constexpr int NWAVES = 8, NTHR = 512;
constexpr int MOE_TP = 72, MOE_NPASS = 2, MOE_MAXT = MOE_TP * MOE_NPASS;
constexpr int MAXSLOT = MOE_MAXT * 256;
constexpr int MOE_TS = 72;
__host__ __device__ constexpr int moe_pass_nt(int NT, int p) { const int r = NT - p * MOE_TS, cap = (p == MOE_NPASS - 1) ? MOE_TP : MOE_TS; return r < 0 ? 0 : (r > cap ? cap : r); }
static_assert((MOE_NPASS - 1) * MOE_TS + MOE_TP >= 136, "pass capacity");

constexpr size_t MiB = 1u << 20;
constexpr size_t al(size_t x) { return (x + 4095) & ~(size_t)4095; }
constexpr size_t WS_CTL = 0, CTL_ZERO_BYTES = 1 * MiB;
constexpr size_t WS_SS = 1 * MiB;
constexpr size_t WS_SSM = WS_SS + al((size_t)M * 16 * 4);
constexpr size_t WS_TOKE = WS_SSM + al((size_t)MM * 16 * 4);
constexpr size_t WS_TOKG = WS_TOKE + al((size_t)M * 8);
constexpr size_t WS_TOKR = WS_TOKG + al((size_t)M * 8);
constexpr size_t WS_TOKS = WS_TOKR + al((size_t)M * 4);
constexpr size_t WS_CNT = WS_TOKS + al((size_t)M * 8);
constexpr size_t WS_TILEE = WS_CNT + al(256 * 8 * 4);
constexpr size_t WS_SLOTR = WS_TILEE + al(160 * 4);
constexpr size_t WS_SLOTG = WS_SLOTR + al((size_t)MAXSLOT * 4);
constexpr size_t WS_SLOTT = WS_SLOTG + al((size_t)MAXSLOT * 4);
constexpr size_t WS_IDMAP = WS_SLOTT + al((size_t)MAXSLOT * 4);
constexpr size_t WS_SWT = al(WS_IDMAP + (size_t)MOE_TP * 256 * 4);
constexpr size_t WS_PWT = WS_SWT + (size_t)2 * 4 * 128 * 128 * 2;
constexpr size_t WS_WIN = al(WS_PWT + (size_t)2 * 4 * 64 * 64 * 2 + MiB);
constexpr size_t SZ_WIN = (size_t)ZW * D * 2, SZ_WOUT = (size_t)D * D * 2, SZ_WQ = (size_t)256 * D * 2, SZ_WKV = (size_t)512 * D * 2, SZ_WO = (size_t)D * 256 * 2;
constexpr size_t WS_WOUT = WS_WIN + 2 * SZ_WIN, WS_WQ = WS_WOUT + 2 * SZ_WOUT, WS_WKV = WS_WQ + 2 * SZ_WQ, WS_WO = WS_WKV + 2 * SZ_WKV;
constexpr size_t WS_W13 = WS_WO + 2 * SZ_WO, WS_W2 = WS_W13 + (size_t)2 * DFF * D * 2, WS_MW13 = WS_W2 + (size_t)D * DFF * 2;
constexpr size_t WS_MW2 = WS_MW13 + (size_t)NEXP * 2 * DFE * D * 2, WS_KVM = WS_MW2 + (size_t)NEXP * D * DFE * 2;
constexpr size_t SZ_KVM = (size_t)MM * 512 * 2;
constexpr size_t WS_MEMB = WS_KVM + 2 * SZ_KVM;
constexpr size_t WS_ACT = al(WS_MEMB + (size_t)MM * D * 2);
constexpr size_t WS_HB = WS_ACT, WS_Z = WS_HB + (size_t)M * D * 2, WS_MIX = WS_Z + (size_t)M * ZW * 2, WS_QX = WS_MIX + (size_t)M * D * 2, WS_OX = WS_QX + (size_t)M * 256 * 2;
constexpr size_t WS_GOI = WS_OX + (size_t)M * 256 * 2, WS_GQT = WS_GOI + (size_t)M * 256 * 4, WS_GKV = WS_GQT + (size_t)M * 128 * 4, WS_GDEC = WS_GKV + (size_t)1024 * 2048 * 4;
constexpr size_t WS_ACT_END = WS_GDEC + (size_t)1024 * 32 * 4;
constexpr size_t WS_FACT = WS_Z;
constexpr size_t SZ_MACT = (size_t)MOE_TP * 256 * DFE;
constexpr size_t WS_HB8 = WS_HB;
constexpr size_t WS_MACT = WS_HB + (size_t)M * D, WS_YS = WS_MACT + 2 * SZ_MACT, WS_MOE_END = WS_YS + (size_t)MAXSLOT * D * 2;
constexpr size_t WS_H16 = WS_MOE_END > WS_ACT_END ? WS_MOE_END : WS_ACT_END;
constexpr size_t WS_VF = WS_H16 + (size_t)M * D * 2;
constexpr size_t WS_KF = WS_VF + 2 * (size_t)MM * 256 * 2, WS_WQF = WS_KF + 2 * (size_t)MM * 256 * 2, WS_WOF = WS_WQF + 2 * (size_t)256 * D * 2;
constexpr size_t WS_DKF = WS_WOF + 2 * (size_t)D * 256 * 2;
constexpr size_t WS_END = WS_DKF + (size_t)M * 256 * 2;
static_assert(WS_MOE_END <= WS_H16, "MoE overlays end below the residual stream");
constexpr int CW_BAR = 4096;

constexpr int LDS_BYTES = 147456;
constexpr int MISC_OFF = 147456 - 512;
constexpr int SCR_BYTES = MISC_OFF, ARGS_OFF = MISC_OFF + 128;

#define GAS __attribute__((address_space(1)))
#define LAS __attribute__((address_space(3)))
typedef unsigned short bf16;
typedef unsigned v4u __attribute__((ext_vector_type(4)));
typedef unsigned v2u __attribute__((ext_vector_type(2)));
typedef float f32x4 __attribute__((ext_vector_type(4)));
typedef GAS unsigned gu32;
#define RLX_AGENT __ATOMIC_RELAXED, __HIP_MEMORY_SCOPE_AGENT
#define LDS_WAIT() asm volatile("s_waitcnt lgkmcnt(0)" ::: "memory")
#define LDS_ADD(p, v) (void)__hip_atomic_fetch_add((p), (v), __ATOMIC_RELAXED, __HIP_MEMORY_SCOPE_WORKGROUP)
__device__ __forceinline__ unsigned f2bf(float f) { unsigned u = __builtin_bit_cast(unsigned, f); return (u + 0x7fffu + ((u >> 16) & 1u)) >> 16; }
__device__ __forceinline__ unsigned pk2(float lo, float hi) { return f2bf(lo) | (f2bf(hi) << 16); }
__device__ __forceinline__ unsigned pk4_fp8(float a, float b, float c, float d) { int p = 0; p = __builtin_amdgcn_cvt_pk_fp8_f32(a, b, p, false); p = __builtin_amdgcn_cvt_pk_fp8_f32(c, d, p, true); return (unsigned)p; }
constexpr float W8_SCALE = 64.0f, A8_SCALE = 8.0f, X8_SCALE = 16.0f;
__device__ __forceinline__ float bflo(unsigned w) { return __builtin_bit_cast(float, w << 16); }
__device__ __forceinline__ float bfhi(unsigned w) { return __builtin_bit_cast(float, w & 0xffff0000u); }
__device__ __forceinline__ f32x4 bf4(v2u p) { f32x4 r; r.x = bflo(p.x); r.y = bfhi(p.x); r.z = bflo(p.y); r.w = bfhi(p.y); return r; }
__device__ __forceinline__ float bf1(bf16 b) { return __builtin_bit_cast(float, ((unsigned)b) << 16); }
__device__ __forceinline__ unsigned lane_id_now() { unsigned l; asm volatile("v_mbcnt_lo_u32_b32 %0, -1, 0\n\tv_mbcnt_hi_u32_b32 %0, -1, %0" : "=v"(l)); return l; }
template <int MASK> __device__ __forceinline__ float shfl_xor_c(float v) {
    if constexpr (MASK < 32) return __builtin_bit_cast(float, __builtin_amdgcn_ds_swizzle(__builtin_bit_cast(int, v), (MASK << 10) | 0x1f));
    else return __builtin_bit_cast(float, __builtin_amdgcn_ds_bpermute((int)((lane_id_now() ^ 32u) << 2), __builtin_bit_cast(int, v)));
}
__device__ __forceinline__ float shfl_idx(float v, int src_lane) { return __builtin_bit_cast(float, __builtin_amdgcn_ds_bpermute(src_lane << 2, __builtin_bit_cast(int, v))); }
__device__ __forceinline__ unsigned shfl_idx_u(unsigned v, int src_lane) { return (unsigned)__builtin_amdgcn_ds_bpermute(src_lane << 2, (int)v); }
__device__ __forceinline__ float wave_sum(float v) {
    v += shfl_xor_c<1>(v); v += shfl_xor_c<2>(v); v += shfl_xor_c<4>(v); v += shfl_xor_c<8>(v); v += shfl_xor_c<16>(v); v += shfl_xor_c<32>(v);
    return v;
}
__device__ __forceinline__ float wave_max(float v) {
    v = fmaxf(v, shfl_xor_c<1>(v)); v = fmaxf(v, shfl_xor_c<2>(v)); v = fmaxf(v, shfl_xor_c<4>(v)); v = fmaxf(v, shfl_xor_c<8>(v)); v = fmaxf(v, shfl_xor_c<16>(v)); v = fmaxf(v, shfl_xor_c<32>(v));
    return v;
}
#define XB_TMO      128
#define XB_XCNT(j)  (256  + 64 * (j))
#define XB_XSUB(j)  (1280 + 64 * (j))
#define XB_XGEN(j)  (2304 + 64 * (j))
#define XB_TOP      3328
#define XB_TOPGEN   3392
#define XCD_BAR_WORDS 3456
#define XB_SPIN_CAP (1u << 18)

__device__ __forceinline__ unsigned xb_ld(unsigned* p)              { return __hip_atomic_load(p, __ATOMIC_RELAXED, __HIP_MEMORY_SCOPE_AGENT); }
__device__ __forceinline__ unsigned xb_add(unsigned* p, unsigned v) { return __hip_atomic_fetch_add(p, v, __ATOMIC_RELAXED, __HIP_MEMORY_SCOPE_AGENT); }
__device__ __forceinline__ unsigned xb_xcc_id() { return (unsigned)__builtin_amdgcn_s_getreg((3 << 11) | 20) & 0xFu; }
#define XB_SPIN(cond, bar) do { unsigned _sp = 0; while (cond) { __builtin_amdgcn_s_sleep(1); \
    if ((++_sp & 255u) == 0u) { if (xb_ld(&(bar)[XB_TMO])) break; if (_sp > XB_SPIN_CAP) { atomicAdd(&(bar)[XB_TMO], 1u); break; } } } } while (0)

struct XcdBarrier {
    unsigned* bar; unsigned x; unsigned wid;
    volatile LAS unsigned* st;
};

__device__ __forceinline__ XcdBarrier xcd_barrier_post(unsigned* bar, volatile LAS unsigned* st) {
    XcdBarrier b; b.bar = bar; b.x = xb_xcc_id(); b.st = st; b.wid = (unsigned)__builtin_amdgcn_readfirstlane(threadIdx.x >> 6);
    if (threadIdx.x == 0) (void)xb_add(&bar[XB_XCNT(b.x)], 1u);
    return b;
}
__device__ __forceinline__ void xcd_barrier_complete(unsigned* bar, unsigned x, unsigned& nloc, unsigned& nx) {
    const unsigned G = gridDim.x * gridDim.y * gridDim.z;
    unsigned sum, cnt, mine, sp = 0u;
    for (;;) {
        sum = 0u; cnt = 0u; mine = 0u;
#pragma unroll
        for (unsigned j = 0; j < 16; ++j) { const unsigned c = xb_ld(&bar[XB_XCNT(j)]); sum += c; cnt += (c > 0u) ? 1u : 0u; mine = (j == x) ? c : mine; }
        if (sum == G) break;
        __builtin_amdgcn_s_sleep(1);
        if ((++sp & 255u) == 0u) { if (xb_ld(&bar[XB_TMO])) break; if (sp > XB_SPIN_CAP) { atomicAdd(&bar[XB_TMO], 1u); break; } }
    }
    nloc = mine > 0u ? mine : 1u; nx = cnt > 0u ? cnt : 1u;
}

__device__ __forceinline__ void xcd_barrier(const XcdBarrier& b) {
    asm volatile("s_waitcnt vmcnt(0)" ::: "memory");
    __syncthreads();
    if (b.wid == 0u && lane_id_now() == 0u) {
        unsigned* bar = b.bar;
        __builtin_amdgcn_s_waitcnt(0);
        unsigned nloc = b.st[0], nx = b.st[1];
        if (nloc == 0u) { xcd_barrier_complete(bar, b.x, nloc, nx); b.st[0] = nloc; b.st[1] = nx; }
        const unsigned old = xb_add(&bar[XB_XSUB(b.x)], 1u);
        const unsigned gen = old / nloc;
        if (old + 1u == (gen + 1u) * nloc) {
            __builtin_amdgcn_fence(__ATOMIC_RELEASE, "agent");
            asm volatile("s_waitcnt vmcnt(0)" ::: "memory");
            const unsigned og = xb_add(&bar[XB_TOP], 1u);
            const unsigned tg = og / nx;
            if (og + 1u == (tg + 1u) * nx) xb_add(&bar[XB_TOPGEN], 1u);
            else XB_SPIN(xb_ld(&bar[XB_TOPGEN]) == tg, bar);
            __builtin_amdgcn_fence(__ATOMIC_ACQUIRE, "agent");
            xb_add(&bar[XB_XGEN(b.x)], 1u);
            asm volatile("s_waitcnt vmcnt(0)" ::: "memory");
        } else {
            XB_SPIN(xb_ld(&bar[XB_XGEN(b.x)]) == gen, bar);
            __builtin_amdgcn_fence(__ATOMIC_ACQUIRE, "agent");
            asm volatile("s_waitcnt vmcnt(0)" ::: "memory");
        }
    }
    __syncthreads();
}

enum { IN_X = 0, IN_MEM, IN_RELB, IN_FNORM, IN_NMIX, IN_WIN, IN_WA2, IN_BA, IN_GNORM, IN_PW, IN_PB, IN_PS, IN_LNG, IN_LNB, IN_SW, IN_SB, IN_WOUT,
       IN_NXA, IN_NMEM, IN_WQ, IN_WKV, IN_WO, IN_NFFN, IN_F1, IN_F3, IN_F2, IN_ROUTER, IN_M1, IN_M3, IN_M2, N_IN };
struct Args { const float* in[N_IN]; float* out; unsigned char* ws; int ph_lo, ph_hi; };

__device__ __forceinline__ float rstd16(const float* ss, int row) {
    const f32x4* p = (const f32x4*)(ss + (size_t)row * 16);
    const f32x4 a = p[0], b = p[1], c = p[2], d = p[3];
    const float s = (((a.x + a.y) + (a.z + a.w)) + ((b.x + b.y) + (b.z + b.w))) + (((c.x + c.y) + (c.z + c.w)) + ((d.x + d.y) + (d.z + d.w)));
    return rsqrtf(s * (1.0f / 1024.0f) + EPS);
}
__device__ __forceinline__ v4u pack8(const f32x4 a, const f32x4 b) { v4u w; w.x = pg8::cvt_pk_bf16(a.x, a.y); w.y = pg8::cvt_pk_bf16(a.z, a.w); w.z = pg8::cvt_pk_bf16(b.x, b.y); w.w = pg8::cvt_pk_bf16(b.z, b.w); return w; }

struct EpiScale {
    static constexpr bool PERM = true, AFTER_DRAIN = false;
    bf16* O; int ldc; const float* ss; float scale; bf16* KF; int KT;
    __device__ __forceinline__ void operator()(const pg8::f32x4 (&acc)[2][2][4][2], const pg8::Unit& u, int wr, int wc, int fr, int fq) const {
        const int row0 = u.po * 256 + wr * 64 + fr, col0 = u.e * 256 + wc * 32 + 8 * fq;
        const bool frag = KF != nullptr && u.e == KT;
#pragma unroll
        for (int ai = 0; ai < 2; ++ai)
#pragma unroll
            for (int m = 0; m < 4; ++m) { const int row = row0 + ai * 128 + m * 16; const float r = rstd16(ss, row) * scale; bf16* rowp = O + (size_t)row * ldc + col0;
#pragma unroll
                for (int bj = 0; bj < 2; ++bj) { const v4u o = pack8(acc[ai][bj][m][0] * r, acc[ai][bj][m][1] * r);
                    if (frag) { const int c = wc * 32 + 8 * fq + bj * 128;
                        *(v4u*)(KF + ((((size_t)(row >> 5) * 4 + (c >> 6)) * 4 + ((c >> 4) & 3)) * 64 + (row & 31) + 32 * ((c >> 3) & 1)) * 8) = o; }
                    else *(v4u*)(rowp + bj * 128) = o; } }
    }
};
struct EpiResid {
    static constexpr bool PERM = true, AFTER_DRAIN = false;
    bf16* HB; float* SS;
    __device__ __forceinline__ void operator()(const pg8::f32x4 (&acc)[2][2][4][2], const pg8::Unit& u, int wr, int wc, int fr, int fq) const {
        const int row0 = u.po * 256 + wr * 64 + fr, col0 = u.e * 256 + wc * 32 + 8 * fq;
#pragma unroll
        for (int ai = 0; ai < 2; ++ai) {
            v4u rv[4][2];
#pragma unroll
            for (int m = 0; m < 4; ++m)
#pragma unroll
                for (int bj = 0; bj < 2; ++bj) rv[m][bj] = *(const v4u*)(HB + (size_t)(row0 + ai * 128 + m * 16) * D + col0 + bj * 128);
#pragma unroll
            for (int m = 0; m < 4; ++m) { const int row = row0 + ai * 128 + m * 16; const size_t off = (size_t)row * D + col0; float q = 0.f;
#pragma unroll
                for (int bj = 0; bj < 2; ++bj) { const v4u r = rv[m][bj]; v2u lo, hi; lo.x = r.x; lo.y = r.y; hi.x = r.z; hi.y = r.w;
                    const f32x4 v0 = acc[ai][bj][m][0] + bf4(lo), v1 = acc[ai][bj][m][1] + bf4(hi);
                    *(v4u*)(HB + off + bj * 128) = pack8(v0, v1);
                    q += ((v0.x * v0.x + v0.y * v0.y) + (v0.z * v0.z + v0.w * v0.w)) + ((v1.x * v1.x + v1.y * v1.y) + (v1.z * v1.z + v1.w * v1.w)); }
                q += shfl_xor_c<16>(q); q += shfl_xor_c<32>(q);
                if (fq == 0) SS[(size_t)row * 16 + u.e * 4 + wc] = q; } }
    }
};
__device__ __forceinline__ float silu_f(float x) { return x * __builtin_amdgcn_rcpf(1.0f + __expf(-x)); }
template <bool MOE> struct EpiSwiglu {
    static constexpr bool PERM = true, AFTER_DRAIN = false;
    bf16* O; int ldc; const float* ss; const float* slot_r; const float* slot_g;
    __device__ __forceinline__ void operator()(const pg8::f32x4 (&acc)[2][2][4][2], const pg8::Unit& u, int wr, int wc, int fr, int fq) const {
        const int rin0 = u.pm * 256 + wr * 64 + fr, rout0 = u.po * 256 + wr * 64 + fr, col0 = u.e * 128 + wc * 32 + 8 * fq;
#pragma unroll
        for (int ai = 0; ai < 2; ++ai)
#pragma unroll
            for (int m = 0; m < 4; ++m) { const int rin = rin0 + ai * 128 + m * 16, rout = rout0 + ai * 128 + m * 16;
                float r, gt; if (MOE) { r = 1.0f / (W8_SCALE * X8_SCALE); gt = A8_SCALE; } else { r = rstd16(ss, rin); gt = 1.0f; }
                const float rg = r * -1.4426950408889634f, c2 = r * r * gt;
                f32x4 o0, o1;
                { const f32x4 gu0 = acc[ai][0][m][0] * acc[ai][1][m][0], gu1 = acc[ai][0][m][1] * acc[ai][1][m][1];
#pragma unroll
                  for (int j = 0; j < 4; ++j) { const float i0 = __builtin_amdgcn_rcpf(1.0f + __builtin_amdgcn_exp2f(acc[ai][0][m][0][j] * rg)) * c2, i1 = __builtin_amdgcn_rcpf(1.0f + __builtin_amdgcn_exp2f(acc[ai][0][m][1][j] * rg)) * c2;
                    o0[j] = gu0[j] * i0; o1[j] = gu1[j] * i1;
                    if (MOE) { o0[j] = __builtin_amdgcn_fmed3f(o0[j], -448.0f, 448.0f); o1[j] = __builtin_amdgcn_fmed3f(o1[j], -448.0f, 448.0f); } } }
                if (MOE) { v2u w; w.x = pk4_fp8(o0[0], o0[1], o0[2], o0[3]); w.y = pk4_fp8(o1[0], o1[1], o1[2], o1[3]); *(v2u*)((unsigned char*)O + (size_t)rout * ldc + col0) = w; }
                else *(v4u*)(O + (size_t)rout * ldc + col0) = pack8(o0, o1); }
    }
};
struct EpiPlain {
    static constexpr bool PERM = true, AFTER_DRAIN = false;
    bf16* O; int ldc;
    __device__ __forceinline__ void operator()(const pg8::f32x4 (&acc)[2][2][4][2], const pg8::Unit& u, int wr, int wc, int fr, int fq) const {
        const int row0 = u.po * 256 + wr * 64 + fr, col0 = u.e * 256 + wc * 32 + 8 * fq;
#pragma unroll
        for (int ai = 0; ai < 2; ++ai)
#pragma unroll
            for (int m = 0; m < 4; ++m) { bf16* rowp = O + (size_t)(row0 + ai * 128 + m * 16) * ldc + col0;
#pragma unroll
                for (int bj = 0; bj < 2; ++bj) *(v4u*)(rowp + bj * 128) = pack8(acc[ai][bj][m][0], acc[ai][bj][m][1]); }
    }
};

__device__ __forceinline__ void tr_load(const float* W, int N, int k0, int n0, int lane, float (&v)[64]) {
    const int nn = n0 + lane; const float* wp = W + (size_t)k0 * N + (nn < N ? nn : 0);
#pragma unroll
    for (int i = 0; i < 64; ++i) v[i] = wp[(size_t)i * N];
}
__device__ __forceinline__ void tr_store(const float (&v)[64], int N, int K, int k0, int n0, const float* gain, bf16* WT, long dst_row0, LAS float* scr, int lane) {
    const bool ok = n0 + lane < N;
#pragma unroll
    for (int i = 0; i < 64; ++i) { float x = ok ? v[i] : 0.f; if (gain) x *= gain[k0 + i]; scr[i * 65 + lane] = x; }
    LDS_WAIT(); asm volatile("" ::: "memory");
    const int c = lane & 7;
#pragma unroll
    for (int j = 0; j < 8; ++j) { const int n = (lane >> 3) + 8 * j; const LAS float* s = scr + (8 * c) * 65 + n;
        v4u o; o.x = pk2(s[0 * 65], s[1 * 65]); o.y = pk2(s[2 * 65], s[3 * 65]); o.z = pk2(s[4 * 65], s[5 * 65]); o.w = pk2(s[6 * 65], s[7 * 65]);
        if (n0 + n < N) *(v4u*)(WT + (size_t)(dst_row0 < 0 ? (long)zcol_of(n0 + n) : dst_row0 + n) * K + k0 + 8 * c) = o; }
    LDS_WAIT(); asm volatile("" ::: "memory");
}
__device__ __forceinline__ void tr_store8(const float (&v)[64], int N, int K, int k0, int n0, const float* gain, unsigned char* WT8, long dst_row0, LAS float* scr, int lane) {
    const bool ok = n0 + lane < N;
#pragma unroll
    for (int i = 0; i < 64; ++i) { float x = ok ? v[i] * W8_SCALE : 0.f; if (gain) x *= gain[k0 + i]; scr[i * 65 + lane] = x; }
    LDS_WAIT(); asm volatile("" ::: "memory");
    const int c = lane & 3;
#pragma unroll
    for (int j = 0; j < 4; ++j) { const int n = (lane >> 2) + 16 * j; const LAS float* s = scr + (16 * c) * 65 + n;
        v4u o; o.x = pk4_fp8(s[0 * 65], s[1 * 65], s[2 * 65], s[3 * 65]); o.y = pk4_fp8(s[4 * 65], s[5 * 65], s[6 * 65], s[7 * 65]);
        o.z = pk4_fp8(s[8 * 65], s[9 * 65], s[10 * 65], s[11 * 65]); o.w = pk4_fp8(s[12 * 65], s[13 * 65], s[14 * 65], s[15 * 65]);
        if (n0 + n < N) *(v4u*)(WT8 + (size_t)(dst_row0 + n) * K + k0 + 16 * c) = o; }
    LDS_WAIT(); asm volatile("" ::: "memory");
}
__device__ __forceinline__ void tr_item(const float* W, int N, int K, int k0, int n0, const float* gain, bf16* WT, long dst_row0, LAS float* scr, int lane) {
    float v[64]; tr_load(W, N, k0, n0, lane, v); tr_store(v, N, K, k0, n0, gain, WT, dst_row0, scr, lane);
}
__device__ __forceinline__ void conv_store(const float (&v)[64], int it, int nblk, int K, int N, const float* gain, bf16* WT, int mode, LAS float* scr, int lane) {
    const int kb = it / nblk, nb = it % nblk, k0 = 64 * kb, n0 = 64 * nb;
    if (mode >= 4) {
        const long dr8 = (mode == 4) ? (long)n0 : (long)(n0 >> 7) * 256 + (n0 & 127) + (mode == 6 ? 128 : 0);
        tr_store8(v, N, K, k0, n0, gain, (unsigned char*)WT, dr8, scr, lane); return; }
    const long dr = (mode == 3) ? -1L : (mode == 0) ? (long)n0 : (long)(n0 >> 7) * 256 + (n0 & 127) + (mode == 2 ? 128 : 0);
    tr_store(v, N, K, k0, n0, gain, WT, dr, scr, lane);
}
__device__ __forceinline__ void conv_job(const float* W, int K, int N, const float* gain, bf16* WT, int mode, LAS float* scr, int gw, int NGW, int lane, long& base) {
    const int nblk = (N + 63) / 64, nitems = (K / 64) * nblk;
    const int first = (int)(((long)gw - (base % NGW) + NGW) % NGW);
    float va[64], vb[64];
    int it = first;
    if (it < nitems) tr_load(W, N, 64 * (it / nblk), 64 * (it % nblk), lane, va);
    while (it < nitems) {
        int itn = it + NGW;
        if (itn < nitems) tr_load(W, N, 64 * (itn / nblk), 64 * (itn % nblk), lane, vb);
        conv_store(va, it, nblk, K, N, gain, WT, mode, scr, lane);
        it = itn; if (it >= nitems) break;
        itn = it + NGW;
        if (itn < nitems) tr_load(W, N, 64 * (itn / nblk), 64 * (itn % nblk), lane, va);
        conv_store(vb, it, nblk, K, N, gain, WT, mode, scr, lane);
        it = itn;
    }
    base += nitems;
}
__device__ __forceinline__ void row_cvt(const float* xrow, bf16* orow, float* ssrow, int lane) {
    const f32x4* xr = (const f32x4*)xrow + lane; f32x4 v[4]; float s = 0.f;
#pragma unroll
    for (int j = 0; j < 4; ++j) { v[j] = xr[64 * j]; s += (v[j].x * v[j].x + v[j].y * v[j].y) + (v[j].z * v[j].z + v[j].w * v[j].w); }
    s = wave_sum(s);
    v2u* o8 = (v2u*)orow + lane;
#pragma unroll
    for (int j = 0; j < 4; ++j) { v2u w; w.x = pk2(v[j].x, v[j].y); w.y = pk2(v[j].z, v[j].w); o8[64 * j] = w; }
    if (lane < 16) ssrow[lane] = lane == 0 ? s : 0.f;
}
__device__ __forceinline__ void p0_prologue(const Args& a, LAS unsigned char* lds, int tid, int G) {
    const int lane = tid & 63, wave = tid >> 6, gw = blockIdx.x * NWAVES + wave, NGW = G * NWAVES;
    LAS float* scr = (LAS float*)(lds + wave * 16640);
    unsigned char* ws = a.ws; long base = 0;
    for (int l = 0; l < 2; ++l) {
        conv_job(a.in[IN_WIN] + (size_t)l * D * INW, D, INW, a.in[IN_NMIX] + l * D, (bf16*)(ws + WS_WIN + l * SZ_WIN), 3, scr, gw, NGW, lane, base);
        conv_job(a.in[IN_WOUT] + (size_t)l * D * D, D, D, nullptr, (bf16*)(ws + WS_WOUT + l * SZ_WOUT), 0, scr, gw, NGW, lane, base);
        conv_job(a.in[IN_WQ] + (size_t)l * D * 256, D, 256, a.in[IN_NXA] + l * D, (bf16*)(ws + WS_WQ + l * SZ_WQ), 0, scr, gw, NGW, lane, base);
        conv_job(a.in[IN_WKV] + (size_t)l * D * 512, D, 512, a.in[IN_NMEM] + l * D, (bf16*)(ws + WS_WKV + l * SZ_WKV), 0, scr, gw, NGW, lane, base);
        conv_job(a.in[IN_WO] + (size_t)l * 256 * D, 256, D, nullptr, (bf16*)(ws + WS_WO + l * SZ_WO), 0, scr, gw, NGW, lane, base);
        { v4u* zp = (v4u*)(ws + WS_WIN + l * SZ_WIN + (size_t)INW * D * 2); const int n16 = (ZW - INW) * D * 2 / 16;
          for (int i = blockIdx.x * NTHR + tid; i < n16; i += G * NTHR) zp[i] = (v4u){0u, 0u, 0u, 0u}; }
    }
    conv_job(a.in[IN_F1], D, DFF, a.in[IN_NFFN], (bf16*)(ws + WS_W13), 1, scr, gw, NGW, lane, base);
    conv_job(a.in[IN_F3], D, DFF, a.in[IN_NFFN], (bf16*)(ws + WS_W13), 2, scr, gw, NGW, lane, base);
    conv_job(a.in[IN_F2], DFF, D, nullptr, (bf16*)(ws + WS_W2), 0, scr, gw, NGW, lane, base);
    for (int e = 0; e < NEXP; ++e) {
        conv_job(a.in[IN_M1] + (size_t)e * D * DFE, D, DFE, a.in[IN_NFFN] + D, (bf16*)(ws + WS_MW13 + (size_t)e * 2 * DFE * D), 5, scr, gw, NGW, lane, base);
        conv_job(a.in[IN_M3] + (size_t)e * D * DFE, D, DFE, a.in[IN_NFFN] + D, (bf16*)(ws + WS_MW13 + (size_t)e * 2 * DFE * D), 6, scr, gw, NGW, lane, base);
        conv_job(a.in[IN_M2] + (size_t)e * DFE * D, DFE, D, nullptr, (bf16*)(ws + WS_MW2 + (size_t)e * D * DFE), 4, scr, gw, NGW, lane, base);
    }
    for (int i = blockIdx.x * NTHR + tid; i < MOE_TP * 256; i += G * NTHR) ((int*)(ws + WS_IDMAP))[i] = i;
    for (int i = blockIdx.x * NTHR + tid; i < 2 * 4 * 128 * 128; i += G * NTHR) { const int s = i & 127, t = (i >> 7) & 127; ((bf16*)(ws + WS_SWT))[i] = (bf16)f2bf(s <= t ? a.in[IN_SW][i] : 0.f); }
    for (int i = blockIdx.x * NTHR + tid; i < 2 * 4 * 64 * 64; i += G * NTHR) { const int c = i & 63, d = (i >> 6) & 63, lg = i >> 12; ((bf16*)(ws + WS_PWT))[i] = (bf16)f2bf(a.in[IN_PW][(size_t)lg * 4096 + c * 64 + d]); }
    for (int m = gw; m < M; m += NGW) row_cvt(a.in[IN_X] + (size_t)m * D, (bf16*)(ws + WS_H16) + (size_t)m * D, (float*)(ws + WS_SS) + (size_t)m * 16, lane);
    for (int m = gw; m < MM; m += NGW) row_cvt(a.in[IN_MEM] + (size_t)m * D, (bf16*)(ws + WS_MEMB) + (size_t)m * D, (float*)(ws + WS_SSM) + (size_t)m * 16, lane);
}


__device__ __forceinline__ float gelu_tanh(float x) { return 0.5f * x * (1.0f + tanhf(0.7978845608028654f * (x + 0.044715f * x * x * x))); }

__device__ __forceinline__ void gla_a_item(const Args& a, int l, int item, LAS unsigned char* lds, int tid) {
    const int n = item & 31, h = (item >> 5) & 3, b = item >> 7, tok0 = b * T + n * 64;
    LAS float* alr = (LAS float*)lds;
    LAS float* wa = alr + 64 * 16;
    LAS float* bb = wa + 16 * 32;
    LAS float* qt = bb + 64 * 33;
    LAS float* kt = qt + 64 * 33;
    LAS float* kd = kt + 64 * 33;
    LAS float* vv = kd + 64 * 33;
    LAS float* att = vv + 64 * 64;
    LAS float* bav = att + 64 * 65;
    const bf16* z = (const bf16*)(a.ws + WS_Z);
    float* OI = (float*)(a.ws + WS_GOI); float* QT = (float*)(a.ws + WS_GQT); float* KV = (float*)(a.ws + WS_GKV); float* DEC = (float*)(a.ws + WS_GDEC);
    for (int i = tid; i < 1024; i += NTHR) alr[i] = bf1(z[(size_t)(tok0 + (i >> 4)) * ZW + Z_ALR + (i & 15)]);
    { const int r = tid >> 5, k = tid & 31; wa[tid] = a.in[IN_WA2][(size_t)l * 16 * 128 + r * 128 + h * 32 + k]; }
    if (tid < 32) bav[tid] = a.in[IN_BA][l * 128 + h * 32 + tid];
    for (int i = tid; i < 4096; i += NTHR) vv[i] = bf1(z[(size_t)(tok0 + (i >> 6)) * ZW + Z_AV + h * 64 + (i & 63)]);
    __syncthreads();
    for (int i = tid; i < 2048; i += NTHR) { const int c = i >> 5, k = i & 31; float x = bav[k];
#pragma unroll
        for (int r = 0; r < 16; ++r) x += alr[c * 16 + r] * wa[r * 32 + k];
        const float ls = fminf(x, 0.f) - log1pf(expf(-fabsf(x)));
        bb[c * 33 + k] = ls * (1.0f / 16.0f); }
    __syncthreads();
    if (tid < 32) { float run = 0.f; for (int c = 0; c < 64; ++c) { run += bb[c * 33 + tid]; bb[c * 33 + tid] = run; } }
    __syncthreads();
    for (int i = tid; i < 2048; i += NTHR) { const int c = i >> 5, k = i & 31; const float bv = bb[c * 33 + k], bl = bb[63 * 33 + k];
        const float q = bf1(z[(size_t)(tok0 + c) * ZW + Z_AQ + h * 32 + k]), kk = bf1(z[(size_t)(tok0 + c) * ZW + Z_AK + h * 32 + k]);
        const float qv = q * 0.17677669529663687f * expf(bv);
        qt[c * 33 + k] = qv; kt[c * 33 + k] = kk * expf(-bv); kd[c * 33 + k] = kk * expf(bl - bv);
        QT[(size_t)(tok0 + c) * 128 + h * 32 + k] = qv; }
    if (tid < 32) DEC[(size_t)item * 32 + tid] = expf(bb[63 * 33 + tid]);
    __syncthreads();
    for (int idx = tid; idx < 4096; idx += NTHR) { const int i = idx >> 6, j = idx & 63; float s = 0.f;
        if (j <= i) {
#pragma unroll 8
            for (int k = 0; k < 32; ++k) s += qt[i * 33 + k] * kt[j * 33 + k]; }
        att[i * 65 + j] = s; }
    __syncthreads();
    for (int idx = tid; idx < 4096; idx += NTHR) { const int i = idx >> 6, v = idx & 63; float s = 0.f;
#pragma unroll 8
        for (int j = 0; j < 64; ++j) s += att[i * 65 + j] * vv[j * 64 + v];
        OI[(size_t)(tok0 + i) * 256 + h * 64 + v] = s; }
    for (int idx = tid; idx < 2048; idx += NTHR) { const int k = idx >> 6, v = idx & 63; float s = 0.f;
#pragma unroll 8
        for (int c = 0; c < 64; ++c) s += kd[c * 33 + k] * vv[c * 64 + v];
        KV[(size_t)item * 2048 + idx] = s; }
    __syncthreads();
}
__device__ __forceinline__ void gla_c_item(const Args& a, int l, int item, LAS unsigned char* lds, int tid) {
    const int n = item & 31, h = (item >> 5) & 3, b = item >> 7, tok0 = b * T + n * 64, lane = tid & 63, w = tid >> 6;
    LAS float* S = (LAS float*)lds;
    LAS float* ql = S + 2048;
    const bf16* z = (const bf16*)(a.ws + WS_Z); bf16* mix = (bf16*)(a.ws + WS_MIX);
    const float* OI = (const float*)(a.ws + WS_GOI); const float* QT = (const float*)(a.ws + WS_GQT); const float* KV = (const float*)(a.ws + WS_GKV); const float* DEC = (const float*)(a.ws + WS_GDEC);
    for (int e = tid; e < 2048; e += NTHR) { const int k = e >> 6; float s = 0.f;
        for (int m = 0; m < n; ++m) { const size_t it = (size_t)(item - n + m); s = s * DEC[it * 32 + k] + KV[it * 2048 + e]; }
        S[e] = s; }
    for (int i = tid; i < 2048; i += NTHR) ql[(i >> 5) * 33 + (i & 31)] = QT[(size_t)(tok0 + (i >> 5)) * 128 + h * 32 + (i & 31)];
    __syncthreads();
    for (int j = 0; j < 8; ++j) { const int i = w + 8 * j; float o = OI[(size_t)(tok0 + i) * 256 + h * 64 + lane];
#pragma unroll 8
        for (int k = 0; k < 32; ++k) o += ql[i * 33 + k] * S[k * 64 + lane];
        const float ms = wave_sum(o * o) * (1.0f / 64.0f);
        float y = o * rsqrtf(ms + EPS) * a.in[IN_GNORM][l * 256 + h * 64 + lane];
        const float g = bf1(z[(size_t)(tok0 + i) * ZW + Z_AG + h * 64 + lane]);
        y *= g / (1.0f + expf(-g));
        mix[(size_t)(tok0 + i) * D + h * 64 + lane] = (bf16)f2bf(y); }
    __syncthreads();
}
__device__ __forceinline__ void pool_item(const Args& a, int l, int item, LAS unsigned char* lds, int tid) {
    const int g = item & 3, tt = (item >> 2) & 31, b = item >> 7, t0 = tt * 64;
    LAS float* u = (LAS float*)lds;
    LAS float* w = u + 79 * 64;
    LAS float* p = w + 4096;
    const bf16* z = (const bf16*)(a.ws + WS_Z); bf16* mix = (bf16*)(a.ws + WS_MIX);
    for (int i = tid; i < 79 * 64; i += NTHR) { const int t = t0 - 15 + (i >> 6); u[i] = t >= 0 ? bf1(z[(size_t)(b * T + t) * ZW + Z_BU + g * 64 + (i & 63)]) : 0.f; }
    for (int i = tid; i < 4096; i += NTHR) w[i] = a.in[IN_PW][(size_t)(l * 4 + g) * 4096 + i];
    __syncthreads();
    const int win = 2 << g;
    for (int i = tid; i < 4096; i += NTHR) { const int tl = i >> 6, c = i & 63, t = t0 + tl, cnt = (t + 1 < win) ? t + 1 : win; float s = 0.f;
        for (int j = 0; j < cnt; ++j) s += u[(tl + 15 - j) * 64 + c];
        p[tl * 65 + c] = s / (float)cnt - u[(tl + 15) * 64 + c]; }
    __syncthreads();
    for (int i = tid; i < 4096; i += NTHR) { const int tl = i >> 6, d = i & 63; float s = a.in[IN_PB][(l * 4 + g) * 64 + d];
#pragma unroll 8
        for (int c = 0; c < 64; ++c) s += p[tl * 65 + c] * w[c * 64 + d];
        s *= a.in[IN_PS][l * 256 + g * 64 + d];
        mix[(size_t)(b * T + t0 + tl) * D + 256 + g * 64 + d] = (bf16)f2bf(s); }
    __syncthreads();
}
__device__ __forceinline__ void sgu_item(const Args& a, int l, int item, LAS unsigned char* lds, int tid) {
    const int g = item & 3, nc = (item >> 2) & 15, b = item >> 6, tok0 = b * T + nc * 128, lane = tid & 63, w = tid >> 6;
    LAS float* vn = (LAS float*)lds;
    const bf16* z = (const bf16*)(a.ws + WS_Z); bf16* mix = (bf16*)(a.ws + WS_MIX);
    for (int j = 0; j < 16; ++j) { const int s = w + 8 * j;
        const v2u raw = *(const v2u*)(z + (size_t)(tok0 + s) * ZW + Z_DUV + 256 + 4 * lane);
        float x[4] = {gelu_tanh(bflo(raw.x)), gelu_tanh(bfhi(raw.x)), gelu_tanh(bflo(raw.y)), gelu_tanh(bfhi(raw.y))};
        const float mu = wave_sum((x[0] + x[1]) + (x[2] + x[3])) * (1.0f / 256.0f);
        float q = 0.f;
#pragma unroll
        for (int i = 0; i < 4; ++i) { x[i] -= mu; q += x[i] * x[i]; }
        const float rstd = rsqrtf(wave_sum(q) * (1.0f / 256.0f) + EPS);
        if ((lane >> 4) == g) {
#pragma unroll
            for (int i = 0; i < 4; ++i) { const int cl = 4 * (lane & 15) + i; vn[s * 64 + cl] = x[i] * rstd * a.in[IN_LNG][l * 256 + g * 64 + cl] + a.in[IN_LNB][l * 256 + g * 64 + cl]; } } }
    __syncthreads();
    const float* sw = a.in[IN_SW] + (size_t)(l * 4 + g) * 128 * 128;
    for (int j = 0; j < 16; ++j) { const int t = w + 8 * j; float acc = a.in[IN_SB][(l * 4 + g) * 128 + t];
        const float* swr = sw + t * 128;
        for (int s = 0; s <= t; ++s) acc += swr[s] * vn[s * 64 + lane];
        const float uu = gelu_tanh(bf1(z[(size_t)(tok0 + t) * ZW + Z_DUV + g * 64 + lane]));
        mix[(size_t)(tok0 + t) * D + 768 + g * 64 + lane] = (bf16)f2bf(uu * acc); }
    __syncthreads();
}
__device__ __forceinline__ void xattn_item(const Args& a, int l, int item, LAS unsigned char* lds, int tid) {
    const int qtile = item & 31, h = (item >> 5) & 3, b = item >> 7, lane = tid & 63, w = tid >> 6;
    LAS float* Ks = (LAS float*)lds;
    LAS float* Vs = Ks + 256 * 65;
    LAS float* qs = Vs + 256 * 64;
    LAS float* pw = qs + 512;
    const bf16* kvm = (const bf16*)(a.ws + WS_KVM + (size_t)l * SZ_KVM); const bf16* qx = (const bf16*)(a.ws + WS_QX); bf16* ox = (bf16*)(a.ws + WS_OX);
    for (int i = tid; i < 16384; i += NTHR) { const int key = i >> 6, d = i & 63; const size_t o = (size_t)(b * MEMLEN + key) * 512 + h * 64 + d;
        Ks[key * 65 + d] = bf1(kvm[o]); Vs[key * 64 + d] = bf1(kvm[o + 256]); }
    __syncthreads();
    for (int qq = 0; qq < 8; ++qq) { const int row = b * T + qtile * 64 + w * 8 + qq;
        qs[w * 64 + lane] = bf1(qx[(size_t)row * 256 + h * 64 + lane]);
        LDS_WAIT(); asm volatile("" ::: "memory");
        float s[4] = {0.f, 0.f, 0.f, 0.f};
        for (int d = 0; d < 64; ++d) { const float qd = qs[w * 64 + d];
#pragma unroll
            for (int j = 0; j < 4; ++j) s[j] += qd * Ks[(lane + 64 * j) * 65 + d]; }
        const float mx = wave_max(fmaxf(fmaxf(s[0], s[1]), fmaxf(s[2], s[3])));
        float e[4], sum = 0.f;
#pragma unroll
        for (int j = 0; j < 4; ++j) { e[j] = expf(s[j] - mx); sum += e[j]; }
        const float inv = 1.0f / wave_sum(sum);
#pragma unroll
        for (int j = 0; j < 4; ++j) pw[w * 256 + lane + 64 * j] = e[j] * inv;
        LDS_WAIT(); asm volatile("" ::: "memory");
        float o = 0.f;
        for (int key = 0; key < 256; ++key) o += pw[w * 256 + key] * Vs[key * 64 + lane];
        ox[(size_t)row * 256 + h * 64 + lane] = (bf16)f2bf(o);
        LDS_WAIT(); asm volatile("" ::: "memory"); }
    __syncthreads();
}

__device__ __forceinline__ unsigned ord_u(float f) { const unsigned u = __builtin_bit_cast(unsigned, f); return (u & 0x80000000u) ? ~u : (u | 0x80000000u); }
__device__ __forceinline__ int rel_bucket(int n) {
    if (n < 16) return n;
    int large = 16 + (int)(logf((float)n / 16.0f) / logf(8.0f) * 16.0f);
    return large < 31 ? large : 31;
}
__device__ __forceinline__ void dsa_setup(const Args& a, LAS unsigned char* lds, int tid) {
    LAS float* biasd = (LAS float*)(lds + 48 * 1024);
    for (int i = tid; i < 129 * 4; i += NTHR) { const int d = i >> 2, h = i & 3; biasd[i] = a.in[IN_RELB][rel_bucket(d) * 4 + h]; }
    __syncthreads();
}
__device__ __forceinline__ void dsa_item(const Args& a, int item, LAS unsigned char* lds, int tid, bf16* outp, int ostride) {
    const int b = item / T, t = item % T, nk = t + 1, lane = tid & 63, w = tid >> 6;
    LAS unsigned* su = (LAS unsigned*)lds;
    LAS float* lg = (LAS float*)(lds + 8192);
    LAS float* qi = (LAS float*)(lds + 8192 + 32768);
    LAS float* qv = qi + 256;
    LAS float* wi = qv + 256;
    LAS unsigned* cnt = (LAS unsigned*)(wi + 8);
    LAS float* red = (LAS float*)(cnt + 40);
    LAS float* red2 = red + 64;
    LAS float* biasd = (LAS float*)(lds + 48 * 1024);
    const bf16* z = (const bf16*)(a.ws + WS_Z);
    const size_t row = (size_t)b * T + t;
    if (tid < 256) { qi[tid] = bf1(z[row * ZW + Z_CQI + tid]) * 0.17677669529663687f; qv[tid] = bf1(z[row * ZW + Z_CQ + tid]) * 0.125f; }
    if (tid < 8) wi[tid] = bf1(z[row * ZW + Z_CWI + tid]) * 0.35355339059327373f;
    if (tid < 40) cnt[tid] = 0u;
    __syncthreads();
    unsigned myu[4];
#pragma unroll
    for (int j = 0; j < 4; ++j) { const int key = tid + NTHR * j; myu[j] = 0u;
        if (key < nk) { const v4u* kp = (const v4u*)(z + ((size_t)b * T + key) * ZW + Z_CKI); float kf[32];
#pragma unroll
            for (int i = 0; i < 4; ++i) { const v4u r = kp[i]; kf[8 * i + 0] = bflo(r.x); kf[8 * i + 1] = bfhi(r.x); kf[8 * i + 2] = bflo(r.y); kf[8 * i + 3] = bfhi(r.y); kf[8 * i + 4] = bflo(r.z); kf[8 * i + 5] = bfhi(r.z); kf[8 * i + 6] = bflo(r.w); kf[8 * i + 7] = bfhi(r.w); }
            float sc = 0.f;
            for (int hh = 0; hh < 8; ++hh) { float dot = 0.f;
#pragma unroll
                for (int d = 0; d < 32; ++d) dot += qi[hh * 32 + d] * kf[d];
                sc += fmaxf(dot, 0.f) * wi[hh]; }
            sc += 0.0f;
            myu[j] = ord_u(sc); su[key] = myu[j]; } }
    __syncthreads();
    bool sel[4];
#pragma unroll
    for (int j = 0; j < 4; ++j) sel[j] = (tid + NTHR * j) < nk;
    if (nk > 256) {
        unsigned Tt = 0u;
        for (int bit = 31; bit >= 0; --bit) { const unsigned cand = Tt | (1u << bit); int c = 0;
#pragma unroll
            for (int j = 0; j < 4; ++j) c += (myu[j] >= cand) ? 1 : 0;
            c = (int)wave_sum((float)c);
            if (lane == 0 && c) LDS_ADD(&cnt[bit], (unsigned)c);
            __syncthreads();
            if (cnt[bit] >= 256u) Tt = cand; }
        { int c = 0;
#pragma unroll
            for (int j = 0; j < 4; ++j) c += (myu[j] > Tt) ? 1 : 0;
            c = (int)wave_sum((float)c);
            if (lane == 0 && c) LDS_ADD(&cnt[32], (unsigned)c);
            __syncthreads(); }
        const int r = 256 - (int)cnt[32];
#pragma unroll
        for (int j = 0; j < 4; ++j) { const int key = tid + NTHR * j;
            if (myu[j] > Tt) sel[j] = true;
            else if (myu[j] == Tt && key < nk) { int rank = 0; for (int s = 0; s < key; ++s) rank += (su[s] == Tt) ? 1 : 0; sel[j] = rank < r; }
            else sel[j] = false; }
    }
    float lmax[4] = {-INFINITY, -INFINITY, -INFINITY, -INFINITY};
#pragma unroll
    for (int j = 0; j < 4; ++j) { const int key = tid + NTHR * j;
        if (key < nk) {
            float lv[4] = {-INFINITY, -INFINITY, -INFINITY, -INFINITY};
            if (sel[j]) { const v4u* kp = (const v4u*)(z + ((size_t)b * T + key) * ZW + Z_CK); const int dd = (t - key) < 128 ? (t - key) : 128;
#pragma unroll
                for (int hh = 0; hh < 4; ++hh) { float dot = 0.f;
#pragma unroll
                    for (int i = 0; i < 8; ++i) { const v4u r = kp[hh * 8 + i]; const LAS float* qq = qv + hh * 64 + 8 * i;
                        dot += qq[0] * bflo(r.x) + qq[1] * bfhi(r.x) + qq[2] * bflo(r.y) + qq[3] * bfhi(r.y) + qq[4] * bflo(r.z) + qq[5] * bfhi(r.z) + qq[6] * bflo(r.w) + qq[7] * bfhi(r.w); }
                    lv[hh] = dot + biasd[dd * 4 + hh]; lmax[hh] = fmaxf(lmax[hh], lv[hh]); } }
#pragma unroll
            for (int hh = 0; hh < 4; ++hh) lg[hh * 2048 + key] = lv[hh]; } }
#pragma unroll
    for (int hh = 0; hh < 4; ++hh) { const float m = wave_max(lmax[hh]); if (lane == 0) red[w * 4 + hh] = m; }
    __syncthreads();
    float mx[4], lsum[4] = {0.f, 0.f, 0.f, 0.f};
#pragma unroll
    for (int hh = 0; hh < 4; ++hh) { float m = red[hh]; for (int ww = 1; ww < 8; ++ww) m = fmaxf(m, red[ww * 4 + hh]); mx[hh] = m; }
#pragma unroll
    for (int j = 0; j < 4; ++j) { const int key = tid + NTHR * j;
        if (key < nk) {
#pragma unroll
            for (int hh = 0; hh < 4; ++hh) { const float lv = lg[hh * 2048 + key]; const float p = (lv == -INFINITY) ? 0.f : expf(lv - mx[hh]); lg[hh * 2048 + key] = p; lsum[hh] += p; } } }
#pragma unroll
    for (int hh = 0; hh < 4; ++hh) { const float s = wave_sum(lsum[hh]); if (lane == 0) red[32 + w * 4 + hh] = s; }
    __syncthreads();
    { const int half = tid >> 8, hd = tid & 255, hh = hd >> 6; float acc = 0.f;
      const bf16* vp = z + (size_t)b * T * ZW + Z_CV + hd;
      for (int key = half; key < nk; key += 2) { const float p = lg[hh * 2048 + key]; if (p != 0.f) acc += p * bf1(vp[(size_t)key * ZW]); }
      red2[tid] = acc; }
    __syncthreads();
    if (tid < 256) { const int hh = tid >> 6; float s = 0.f; for (int ww = 0; ww < 8; ++ww) s += red[32 + ww * 4 + hh];
        outp[row * ostride + tid] = (bf16)f2bf((red2[tid] + red2[tid + 256]) / s); }
    __syncthreads();
}

__device__ __forceinline__ void moe_route(const Args& a, LAS unsigned char* lds, int tid, int G, int bid) {
    const int lane = tid & 63, w = tid >> 6;
    LAS float* rt = (LAS float*)lds;
    LAS unsigned* cnt = (LAS unsigned*)(lds + 32768);
    unsigned char* ws = a.ws; const bf16* h = (const bf16*)(ws + WS_H16);
    for (int i = tid; i < 8192; i += NTHR) rt[(i & 7) * 1024 + (i >> 3)] = a.in[IN_ROUTER][i] * a.in[IN_NFFN][D + (i >> 3)];
    __syncthreads();
    for (int chunk = bid; chunk < 256; chunk += G) {
        if (tid < 8) cnt[tid] = 0u;
        __syncthreads();
        for (int qb = 0; qb < 2; ++qb) {
            const int tk0 = chunk * 64 + w * 8 + qb * 4;
            f32x4 hv[4][4]; float ss[4] = {0.f, 0.f, 0.f, 0.f};
#pragma unroll
            for (int t4 = 0; t4 < 4; ++t4)
#pragma unroll
                for (int j = 0; j < 4; ++j) { hv[t4][j] = bf4(((const v2u*)(h + (size_t)(tk0 + t4) * D) + lane)[64 * j]); const f32x4 v = hv[t4][j]; ss[t4] += (v.x * v.x + v.y * v.y) + (v.z * v.z + v.w * v.w); }
            float lg[4][8];
#pragma unroll
            for (int t4 = 0; t4 < 4; ++t4)
#pragma unroll
                for (int e = 0; e < 8; ++e) lg[t4][e] = 0.f;
#pragma unroll
            for (int j = 0; j < 4; ++j) { const int c0 = 4 * (lane + 64 * j);
#pragma unroll
                for (int e = 0; e < 8; ++e) { const f32x4 r = *(const LAS f32x4*)(rt + e * 1024 + c0);
#pragma unroll
                    for (int t4 = 0; t4 < 4; ++t4) { const f32x4 v = hv[t4][j]; lg[t4][e] += (v.x * r.x + v.y * r.y) + (v.z * r.z + v.w * r.w); } } }
#pragma unroll
            for (int t4 = 0; t4 < 4; ++t4) { const int tk = tk0 + t4;
                const float rstd = rsqrtf(wave_sum(ss[t4]) * (1.0f / 1024.0f) + EPS);
                { const float xs = rstd * X8_SCALE;
#pragma unroll
                  for (int j = 0; j < 4; ++j) { const f32x4 v = hv[t4][j] * xs;
                      ((unsigned*)(ws + WS_HB8) + (size_t)tk * (D / 4))[lane + 64 * j] = pk4_fp8(__builtin_amdgcn_fmed3f(v.x, -448.0f, 448.0f), __builtin_amdgcn_fmed3f(v.y, -448.0f, 448.0f), __builtin_amdgcn_fmed3f(v.z, -448.0f, 448.0f), __builtin_amdgcn_fmed3f(v.w, -448.0f, 448.0f)); } }
                float l8[8];
#pragma unroll
                for (int e = 0; e < 8; ++e) l8[e] = wave_sum(lg[t4][e]) * rstd;
                int e0 = 0; float v0 = l8[0];
#pragma unroll
                for (int e = 1; e < 8; ++e) if (l8[e] > v0) { v0 = l8[e]; e0 = e; }
                int e1 = -1; float v1 = -INFINITY;
#pragma unroll
                for (int e = 0; e < 8; ++e) if (e != e0 && l8[e] > v1) { v1 = l8[e]; e1 = e; }
                const float g0 = 1.0f / (1.0f + expf(v1 - v0)), g1 = 1.0f - g0;
                if (lane == 0) { ((int*)(ws + WS_TOKE))[2 * tk] = e0; ((int*)(ws + WS_TOKE))[2 * tk + 1] = e1; ((float*)(ws + WS_TOKG))[2 * tk] = g0; ((float*)(ws + WS_TOKG))[2 * tk + 1] = g1;
                    ((float*)(ws + WS_TOKR))[tk] = rstd; LDS_ADD(&cnt[e0], 1u); LDS_ADD(&cnt[e1], 1u); } } }
        __syncthreads();
        if (tid < 8) ((int*)(ws + WS_CNT))[chunk * 8 + tid] = (int)cnt[tid];
        __syncthreads();
    }
}
__device__ __forceinline__ void moe_assign(const Args& a, LAS unsigned char* lds, int tid, int G, int bid) {
    LAS int* cn = (LAS int*)lds;
    LAS int* tot = cn + 2048;
    LAS int* basee = tot + 8;
    LAS int* te = basee + 8;
    unsigned char* ws = a.ws;
    const int* CNT = (const int*)(ws + WS_CNT); int* TILEE = (int*)(ws + WS_TILEE);
    const int* TOKE = (const int*)(ws + WS_TOKE); const float* TOKG = (const float*)(ws + WS_TOKG); const float* TOKR = (const float*)(ws + WS_TOKR); int* TOKS = (int*)(ws + WS_TOKS);
    float* SLOTR = (float*)(ws + WS_SLOTR); float* SLOTG = (float*)(ws + WS_SLOTG); int* SLOTT = (int*)(ws + WS_SLOTT);
    for (int i = tid; i < 2048; i += NTHR) cn[i] = CNT[i];
    __syncthreads();
    if (tid < 8) { int s = 0; for (int c = 0; c < 256; ++c) s += cn[c * 8 + tid]; tot[tid] = s; }
    __syncthreads();
    if (tid == 0) { int tile = 0; for (int e = 0; e < 8; ++e) { basee[e] = tile * 256; const int nt = (tot[e] + 255) >> 8;
            if (bid == 0) for (int q = 0; q < nt; ++q) TILEE[tile + q] = e;
            tile += nt; }
        if (bid == 0) { for (int q = tile; q < 159; ++q) TILEE[q] = 0; TILEE[159] = tile; } }
    __syncthreads();
    for (int e = bid; e < 8; e += G) { const int s0 = basee[e] + tot[e], s1 = basee[e] + (((tot[e] + 255) >> 8) << 8);
        for (int s = s0 + tid; s < s1; s += NTHR) { SLOTR[s] = 0.f; SLOTG[s] = 0.f; SLOTT[s] = 0; } }
    for (int chunk = bid; chunk < 256; chunk += G) {
        if (tid < 128) te[tid] = TOKE[chunk * 128 + tid];
        __syncthreads();
        { const int e = tid >> 6, lane = tid & 63;
          int s = 0; for (int c = lane; c < chunk; c += 64) s += cn[c * 8 + e];
          s = (int)wave_sum((float)s);
          const bool m0 = te[lane] == e, m1 = te[lane + 64] == e;
          const unsigned long long b0 = __ballot(m0), b1 = __ballot(m1), lt = (1ull << lane) - 1ull;
          const int pos0 = basee[e] + s + __popcll(b0 & lt), pos1 = basee[e] + s + __popcll(b0) + __popcll(b1 & lt);
          if (m0) { const int i = lane, tk = chunk * 64 + (i >> 1); SLOTR[pos0] = TOKR[tk]; SLOTG[pos0] = TOKG[2 * tk + (i & 1)]; SLOTT[pos0] = tk; TOKS[2 * tk + (i & 1)] = pos0; }
          if (m1) { const int i = lane + 64, tk = chunk * 64 + (i >> 1); SLOTR[pos1] = TOKR[tk]; SLOTG[pos1] = TOKG[2 * tk + (i & 1)]; SLOTT[pos1] = tk; TOKS[2 * tk + (i & 1)] = pos1; } }
        __syncthreads();
    }
}
__device__ __forceinline__ void final_phase(const Args& a, int tid, int G, int bid) {
    const int lane = tid & 63, gw = bid * NWAVES + (tid >> 6), NGW = G * NWAVES;
    const int* TOKS = (const int*)(a.ws + WS_TOKS); const bf16* YS = (const bf16*)(a.ws + WS_YS);
#if defined(PROF_DSA)
    const float* pr = (const float*)(a.ws + WS_CTL) + 12288; const float padd = 100.0f * sqrtf(floorf(pr[2 + PROF_DSA - 1] / fmaxf(pr[2 + 5], 1e-30f) * 10.0f + 0.5f) * 0.1f);
#elif defined(PROBE_DSA)
    const float* pr = (const float*)(a.ws + WS_CTL) + 12288; const float padd = PROBE_C * sqrtf(pr[0] / fmaxf(pr[1], 1e-30f));
#else
    const float padd = 0.f;
#endif
    constexpr float YSC = 1.0f / (W8_SCALE * A8_SCALE);
    f32x4 gn[4];
#pragma unroll
    for (int j = 0; j < 4; ++j) gn[j] = ((const f32x4*)a.in[IN_FNORM])[lane + 64 * j];
    for (int tk0 = gw; tk0 < M; tk0 += 4 * NGW) {
        f32x4 v[4][4]; float ss[4];
#pragma unroll
        for (int u = 0; u < 4; ++u) { const int tkr = tk0 + u * NGW, tk = tkr < M ? tkr : gw; const int s0 = TOKS[2 * tk], s1 = TOKS[2 * tk + 1];
            const v2u* h16 = (const v2u*)((const bf16*)(a.ws + WS_H16) + (size_t)tk * D) + lane; const v2u* y0 = (const v2u*)(YS + (size_t)s0 * D) + lane; const v2u* y1 = (const v2u*)(YS + (size_t)s1 * D) + lane;
            const float c0 = ((const float*)(a.ws + WS_TOKG))[2 * tk] * YSC, c1 = ((const float*)(a.ws + WS_TOKG))[2 * tk + 1] * YSC;
            ss[u] = 0.f;
#pragma unroll
            for (int j = 0; j < 4; ++j) { v[u][j] = bf4(h16[64 * j]); const v2u p = y0[64 * j], q = y1[64 * j];
                v[u][j].x += bflo(p.x) * c0 + bflo(q.x) * c1; v[u][j].y += bfhi(p.x) * c0 + bfhi(q.x) * c1; v[u][j].z += bflo(p.y) * c0 + bflo(q.y) * c1; v[u][j].w += bfhi(p.y) * c0 + bfhi(q.y) * c1;
                ss[u] += (v[u][j].x * v[u][j].x + v[u][j].y * v[u][j].y) + (v[u][j].z * v[u][j].z + v[u][j].w * v[u][j].w); } }
#pragma unroll
        for (int u = 0; u < 4; ++u) { const int tk = tk0 + u * NGW; const float rstd = rsqrtf(wave_sum(ss[u]) * (1.0f / 1024.0f) + EPS);
            if (tk < M) { f32x4* hr = (f32x4*)(a.out + (size_t)tk * D) + lane;
#pragma unroll
                for (int j = 0; j < 4; ++j) hr[64 * j] = v[u][j] * rstd * gn[j] + padd; } }
    }
}

typedef short bf16x8 __attribute__((ext_vector_type(8)));
typedef short bf16x4 __attribute__((ext_vector_type(4)));
typedef float f32x16 __attribute__((ext_vector_type(16)));
#define MFMA32(a, b, c) __builtin_amdgcn_mfma_f32_32x32x16_bf16((a), (b), (c), 0, 0, 0)
constexpr int DS_HIST = 0;
constexpr int DS_CMB = 0;
constexpr int DS_KST = 34816;
constexpr int DS_BM = 67584;
constexpr int DS_P = DS_BM + 8192;
constexpr int DS_CU = DS_P + 512;
constexpr int DS_CK = DS_CU + 8192;
constexpr int DS_BIAS = DS_CK + 8192;
constexpr int DS_ST = DS_BIAS + 2112;
constexpr int DS_END = DS_ST + 8 * 4608;
constexpr int DSA_CAP = 64;
static_assert(DS_END <= MISC_OFF - 64 && DS_KST + 8 * 4096 <= DS_BM && 32 * 513 * 4 <= DS_BM, "DSA LDS map");
__device__ __forceinline__ void tr_read_tile(unsigned addr, bf16x4& t00, bf16x4& t01, bf16x4& t10, bf16x4& t11, bf16x4& u00, bf16x4& u01, bf16x4& u10, bf16x4& u11) {
    asm volatile("s_waitcnt lgkmcnt(0)\n\t"
                 "ds_read_b64_tr_b16 %0, %8 offset:0\n\t" "ds_read_b64_tr_b16 %1, %8 offset:512\n\t" "ds_read_b64_tr_b16 %2, %8 offset:1024\n\t" "ds_read_b64_tr_b16 %3, %8 offset:1536\n\t"
                 "ds_read_b64_tr_b16 %4, %8 offset:2048\n\t" "ds_read_b64_tr_b16 %5, %8 offset:2560\n\t" "ds_read_b64_tr_b16 %6, %8 offset:3072\n\t" "ds_read_b64_tr_b16 %7, %8 offset:3584\n\t"
                 "s_waitcnt lgkmcnt(0)"
                 : "=&v"(t00), "=&v"(t01), "=&v"(t10), "=&v"(t11), "=&v"(u00), "=&v"(u01), "=&v"(u10), "=&v"(u11) : "v"(addr) : "memory");
}

__device__ __forceinline__ void dsa2_setup(const Args& a, LAS unsigned char* lds, int tid) {
    LAS float* biasL = (LAS float*)(lds + DS_BIAS);
    for (int i = tid; i < 4 * 129; i += NTHR) { const int h = i / 129, d = i % 129; biasL[h * 132 + d] = a.in[IN_RELB][rel_bucket(d) * 4 + h] * 1.4426950408889634f; }
    __syncthreads();
}
__device__ __forceinline__ void idx_scores(const bf16x8 ka0, const bf16x8 ka1, const LAS bf16x8* qfl  , const float (&wv)[8], float (&sc)[16]) {
#pragma unroll
    for (int r = 0; r < 16; ++r) sc[r] = 0.f;
    float zero = 0.f;
#pragma unroll
    for (int hp = 0; hp < 4; ++hp) {
        const bf16x8 q00 = qfl[(4 * hp + 0) * 64], q01 = qfl[(4 * hp + 1) * 64], q10 = qfl[(4 * hp + 2) * 64], q11 = qfl[(4 * hp + 3) * 64];
        f32x16 acc0, acc1;
#pragma unroll
        for (int r = 0; r < 16; ++r) { acc0[r] = zero; acc1[r] = zero; }
        acc0 = MFMA32(ka0, q00, acc0); acc1 = MFMA32(ka0, q10, acc1);
        acc0 = MFMA32(ka1, q01, acc0); acc1 = MFMA32(ka1, q11, acc1);
#pragma unroll
        for (int r = 0; r < 16; ++r) sc[r] = __builtin_fmaf(fmaxf(acc1[r], 0.f), wv[2 * hp + 1], __builtin_fmaf(fmaxf(acc0[r], 0.f), wv[2 * hp], sc[r]));
        asm volatile("" : "+v"(zero), "+v"(sc[0]), "+v"(sc[1]), "+v"(sc[2]), "+v"(sc[3]), "+v"(sc[4]), "+v"(sc[5]), "+v"(sc[6]), "+v"(sc[7]), "+v"(sc[8]), "+v"(sc[9]), "+v"(sc[10]), "+v"(sc[11]), "+v"(sc[12]), "+v"(sc[13]), "+v"(sc[14]), "+v"(sc[15]));
    }
}
__device__ __forceinline__ f32x16 dsa_scores(const bf16x8 (&kf)[4], const bf16x8 (&qa)[4]) {
    f32x16 sacc;
#pragma unroll
    for (int r = 0; r < 16; ++r) sacc[r] = 0.f;
#pragma unroll
    for (int s = 0; s < 4; ++s) sacc = MFMA32(kf[s], qa[s], sacc);
    return sacc;
}
template <bool NEAR> __device__ __forceinline__ void dsa_att_tile(const f32x16& sacc, unsigned word, int dbase  , int hh, const LAS float* biasH, float c31,
                                                                 unsigned vaddr, f32x16& o0, f32x16& o1, float& m, float& lsum) {
    constexpr float SC = 0.18033688011112042f;
    float sv[16]; float tmax = -1e30f;
#pragma unroll
    for (int r = 0; r < 16; ++r) { const int kl = (r & 3) + 8 * (r >> 2) + 4 * hh; float bias = c31;
        if (NEAR) { int dd = dbase - kl; dd = dd < 0 ? 0 : (dd > 128 ? 128 : dd); bias = biasH[dd]; }
        const float v = __builtin_fmaf(sacc[r], SC, bias); sv[r] = ((word >> kl) & 1u) ? v : -1e30f; tmax = fmaxf(tmax, sv[r]); }
    tmax = fmaxf(tmax, shfl_xor_c<32>(tmax));
    const float mnew = fmaxf(m, tmax);
    if (__any(mnew != m)) { const float alpha = __builtin_amdgcn_exp2f(m - mnew); lsum *= alpha;
#pragma unroll
        for (int r = 0; r < 16; ++r) { o0[r] *= alpha; o1[r] *= alpha; } }
    m = mnew;
    float p[16]; float ps = 0.f;
#pragma unroll
    for (int r = 0; r < 16; ++r) { p[r] = __builtin_amdgcn_exp2f(sv[r] - mnew); ps += p[r]; }
    ps += shfl_xor_c<32>(ps);
    lsum += ps;
    bf16x8 pb[2];
#pragma unroll
    for (int s = 0; s < 2; ++s) { v4u t4; t4.x = pg8::cvt_pk_bf16(p[8 * s + 0], p[8 * s + 1]); t4.y = pg8::cvt_pk_bf16(p[8 * s + 2], p[8 * s + 3]); t4.z = pg8::cvt_pk_bf16(p[8 * s + 4], p[8 * s + 5]); t4.w = pg8::cvt_pk_bf16(p[8 * s + 6], p[8 * s + 7]);
        pb[s] = __builtin_bit_cast(bf16x8, t4); }
    bf16x4 t00, t01, t10, t11, u00, u01, u10, u11;
    tr_read_tile(vaddr, t00, t01, t10, t11, u00, u01, u10, u11);
    o0 = MFMA32(__builtin_shufflevector(t00, t01, 0, 1, 2, 3, 4, 5, 6, 7), pb[0], o0); o0 = MFMA32(__builtin_shufflevector(t10, t11, 0, 1, 2, 3, 4, 5, 6, 7), pb[1], o0);
    o1 = MFMA32(__builtin_shufflevector(u00, u01, 0, 1, 2, 3, 4, 5, 6, 7), pb[0], o1); o1 = MFMA32(__builtin_shufflevector(u10, u11, 0, 1, 2, 3, 4, 5, 6, 7), pb[1], o1);
}
#ifdef PROF_DSA
#define PSTAMP(k) do { if (tid == 0) { const unsigned long long t_ = wall_clock64(); prof[k] += (float)(t_ - tprev); tprev = t_; } } while (0)
#else
#define PSTAMP(k) do { } while (0)
#endif
__device__ __forceinline__ void dsa2_item(const Args& a, int item, LAS unsigned char* lds, int tid, float (&prof)[6]) {
#ifdef PROF_DSA
    unsigned long long tprev = wall_clock64();
#endif
    const int lane = tid & 63, w = __builtin_amdgcn_readfirstlane(tid >> 6), ql = lane & 31, hh = lane >> 5;
    const int b = item & 7, qi = 63 - (item >> 3), tq0 = qi * 32, ntl = qi + 1;
    const bool sel = qi >= 8;
    const bf16* z = (const bf16*)(a.ws + WS_Z); bf16* mix = (bf16*)(a.ws + WS_MIX);
    const bf16* zb = z + (size_t)b * T * ZW;
    const bf16* zq = zb + (size_t)(tq0 + ql) * ZW;
    LAS unsigned* hist = (LAS unsigned*)(lds + DS_HIST); LAS unsigned* bm = (LAS unsigned*)(lds + DS_BM);
    LAS unsigned* Pp = (LAS unsigned*)(lds + DS_P); LAS unsigned* need = Pp + 32; LAS unsigned* ccnt = Pp + 64; LAS unsigned* ccnt2 = Pp + 96;
    LAS unsigned* cu = (LAS unsigned*)(lds + DS_CU); LAS unsigned* ck = (LAS unsigned*)(lds + DS_CK);
    const LAS float* biasL = (const LAS float*)(lds + DS_BIAS);
    if (sel) {
        f32x4* scr = (f32x4*)(blockIdx.x < 128 ? a.ws + WS_HB + (size_t)blockIdx.x * 262144 : (unsigned char*)a.out + (size_t)(blockIdx.x - 128) * 262144) + lane;
        for (int i = tid; i < 2048; i += NTHR) bm[i] = 0u;
        for (int i = tid; i < 32 * 513; i += NTHR) hist[i] = 0u;
        if (tid < 32) { Pp[tid] = 0u; need[tid] = 256u; ccnt2[tid] = 0u; }
        __syncthreads();
        {
            float wv[8];
            LAS bf16x8* qfl = (LAS bf16x8*)(lds + DS_ST);
            if (w < 2) {
#pragma unroll
                for (int i = 0; i < 8; ++i) { const int fi = 8 * w + i; qfl[fi * 64 + lane] = *(const bf16x8*)(zq + Z_CQI + (fi >> 1) * 32 + 16 * (fi & 1) + 8 * hh); } }
            __syncthreads();
            { const v4u wr = *(const v4u*)(zq + Z_CWI);
              wv[0] = bflo(wr.x) * 0.0625f; wv[1] = bfhi(wr.x) * 0.0625f; wv[2] = bflo(wr.y) * 0.0625f; wv[3] = bfhi(wr.y) * 0.0625f;
              wv[4] = bflo(wr.z) * 0.0625f; wv[5] = bfhi(wr.z) * 0.0625f; wv[6] = bflo(wr.w) * 0.0625f; wv[7] = bfhi(wr.w) * 0.0625f; }
            const bf16* zk0 = zb + (size_t)ql * ZW + Z_CKI + 8 * hh;
            bf16x8 ka0 = *(const bf16x8*)(zk0 + (size_t)(w * 32) * ZW), ka1 = *(const bf16x8*)(zk0 + (size_t)(w * 32) * ZW + 16);
#pragma unroll 1
            for (int kt = w; kt < ntl; kt += 8) {
                const int ktn = (kt + 8 < ntl) ? kt + 8 : kt;
                const bf16x8 kn0 = *(const bf16x8*)(zk0 + (size_t)(ktn * 32) * ZW), kn1 = *(const bf16x8*)(zk0 + (size_t)(ktn * 32) * ZW + 16);
                float sc[16]; idx_scores(ka0, ka1, qfl + lane, wv, sc);
#pragma unroll
                for (int q4 = 0; q4 < 4; ++q4) scr[(size_t)kt * 256 + q4 * 64] = (f32x4){sc[4 * q4] + 0.0f, sc[4 * q4 + 1] + 0.0f, sc[4 * q4 + 2] + 0.0f, sc[4 * q4 + 3] + 0.0f};
                { unsigned dg[16]; unsigned d0 = 0xffffffffu;
#pragma unroll
                  for (int r = 0; r < 16; ++r) { const int kl = (r & 3) + 8 * (r >> 2) + 4 * hh; dg[r] = (kt < qi || kl <= ql) ? (ord_u(sc[r] + 0.0f) >> 23) : 0xffffffffu; }
#pragma unroll
                  for (int r = 15; r >= 0; --r) d0 = (dg[r] != 0xffffffffu) ? dg[r] : d0;
                  unsigned c0 = 0u;
#pragma unroll
                  for (int r = 0; r < 16; ++r) c0 += (dg[r] == d0) ? 1u : 0u;
                  if (d0 != 0xffffffffu) LDS_ADD(&hist[ql * 513 + d0], c0);
#pragma unroll
                  for (int r = 0; r < 16; ++r) { if (dg[r] != d0 && dg[r] != 0xffffffffu) LDS_ADD(&hist[ql * 513 + dg[r]], 1u); } }
                ka0 = kn0; ka1 = kn1;
            }
        }
        PSTAMP(0);
        int sh = 23, nb = 9;
#pragma unroll 1
        for (int level = 0; level < 4; ++level) {
            if (level > 0) {
                for (int i = tid; i < 32 * 513; i += NTHR) hist[i] = 0u;
                __syncthreads();
                const unsigned myP = Pp[ql];
                f32x4 cur4[4];
#pragma unroll
                for (int q4 = 0; q4 < 4; ++q4) cur4[q4] = scr[(size_t)(w < ntl ? w : 0) * 256 + q4 * 64];
#pragma unroll 1
                for (int kt = w; kt < ntl; kt += 8) {
                    const int ktn = (kt + 8 < ntl) ? kt + 8 : kt; f32x4 nxt4[4];
#pragma unroll
                    for (int q4 = 0; q4 < 4; ++q4) nxt4[q4] = scr[(size_t)ktn * 256 + q4 * 64];
#pragma unroll
                    for (int q4 = 0; q4 < 4; ++q4) {
#pragma unroll
                        for (int e = 0; e < 4; ++e) { const int kl = e + 8 * q4 + 4 * hh; const unsigned u = ord_u(cur4[q4][e]);
                            if ((kt < qi || kl <= ql) && (u >> (sh + nb)) == myP) LDS_ADD(&hist[ql * 513 + ((u >> sh) & ((1u << nb) - 1u))], 1u); } }
#pragma unroll
                    for (int q4 = 0; q4 < 4; ++q4) cur4[q4] = nxt4[q4];
                }
            }
            __syncthreads();
            { const int q = 4 * w + (lane >> 4), sl = lane & 15, bpl = (1 << nb) >> 4;
              const LAS unsigned* hp = hist + q * 513 + sl * bpl; unsigned s = 0u;
              for (int i = 0; i < bpl; ++i) s += hp[i];
              unsigned incl = s;
#pragma unroll
              for (int o = 1; o < 16; o <<= 1) { const unsigned t2 = shfl_idx_u(incl, (lane + o) & 63); if (sl + o < 16) incl += t2; }
              const unsigned excl = incl - s, nd = need[q];
              if (excl < nd && nd <= incl) { unsigned run = excl; int dsel = 0; unsigned above = 0u, cand = 0u;
                  for (int i = bpl - 1; i >= 0; --i) { const unsigned c = hp[i]; if (run + c >= nd) { dsel = i; above = run; cand = c; break; } run += c; }
                  Pp[q] = (Pp[q] << nb) | (unsigned)(sl * bpl + dsel); need[q] = nd - above; ccnt[q] = cand; } }
            __syncthreads();
            unsigned mc = ccnt[ql]; mc = (unsigned)wave_max((float)mc);
            if (mc <= (unsigned)DSA_CAP || level == 3) break;
            sh -= (level == 2) ? 7 : 8; nb = (level == 2) ? 7 : 8;
        }
        PSTAMP(1);
        { const unsigned myP = Pp[ql];
          f32x4 cur4[4];
#pragma unroll
          for (int q4 = 0; q4 < 4; ++q4) cur4[q4] = scr[(size_t)(w < ntl ? w : 0) * 256 + q4 * 64];
#pragma unroll 1
          for (int kt = w; kt < ntl; kt += 8) { unsigned bits = 0u;
            const int ktn = (kt + 8 < ntl) ? kt + 8 : kt; f32x4 nxt4[4];
#pragma unroll
            for (int q4 = 0; q4 < 4; ++q4) nxt4[q4] = scr[(size_t)ktn * 256 + q4 * 64];
#pragma unroll
            for (int q4 = 0; q4 < 4; ++q4) {
#pragma unroll
                for (int e = 0; e < 4; ++e) { const int kl = e + 8 * q4 + 4 * hh; const unsigned u = ord_u(cur4[q4][e]), pfx = u >> sh;
                    if (kt < qi || kl <= ql) { if (pfx > myP) bits |= 1u << kl;
                        else if (pfx == myP) { const unsigned slot = __hip_atomic_fetch_add(&ccnt2[ql], 1u, __ATOMIC_RELAXED, __HIP_MEMORY_SCOPE_WORKGROUP);
                            if (slot < (unsigned)DSA_CAP) { cu[ql * DSA_CAP + slot] = u; ck[ql * DSA_CAP + slot] = (unsigned)(kt * 32 + kl); } } } } }
            if (bits) (void)__hip_atomic_fetch_or(&bm[kt * 32 + ql], bits, __ATOMIC_RELAXED, __HIP_MEMORY_SCOPE_WORKGROUP);
#pragma unroll
            for (int q4 = 0; q4 < 4; ++q4) cur4[q4] = nxt4[q4];
          } }
        __syncthreads();
        for (int idx = tid; idx < 32 * DSA_CAP; idx += NTHR) { const int q = idx / DSA_CAP, i = idx % DSA_CAP; unsigned n = ccnt2[q]; n = n < (unsigned)DSA_CAP ? n : (unsigned)DSA_CAP;
            if ((unsigned)i < n) { const unsigned ui = cu[q * DSA_CAP + i], ki = ck[q * DSA_CAP + i]; unsigned rank = 0u;
                for (unsigned j = 0; j < n; ++j) { const unsigned uj = cu[q * DSA_CAP + j], kj = ck[q * DSA_CAP + j]; rank += (uj > ui || (uj == ui && kj < ki)) ? 1u : 0u; }
                if (rank < need[q]) (void)__hip_atomic_fetch_or(&bm[(ki >> 5) * 32 + q], 1u << (ki & 31u), __ATOMIC_RELAXED, __HIP_MEMORY_SCOPE_WORKGROUP); } }
        __syncthreads();
    }
    PSTAMP(2);
    const int hd = w >> 1, half = w & 1;
    bf16x8 qa[4];
#pragma unroll
    for (int s = 0; s < 4; ++s) qa[s] = *(const bf16x8*)(zq + Z_CQ + hd * 64 + 16 * s + 8 * hh);
    f32x16 o0, o1; float m, lsum;
    const LAS float* biasH = biasL + hd * 132; const float c31 = biasH[128];
    LAS unsigned char* st = lds + DS_ST + w * 4608;
    const unsigned vaddr = (unsigned)(size_t)st + (unsigned)((4 * hh + ((lane >> 2) & 3)) * 64 + 32 * ((lane >> 4) & 1) + 8 * (lane & 3));
    const bf16* kvbase = zb + (size_t)(lane >> 3) * ZW + hd * 64 + (lane & 7) * 8;
    LAS unsigned char* vst = st + ((lane & 7) >> 2) * 2048 + (lane >> 3) * 64 + (lane & 3) * 16;
    LAS unsigned char* kst = lds + DS_KST + w * 4096;
    LAS unsigned char* kwr = kst + (lane >> 3) * 128 + (((lane & 7) ^ ((lane >> 3) & 7)) * 16);
    const LAS unsigned char* krd = kst + ql * 128;
#pragma unroll
    for (int r = 0; r < 16; ++r) { o0[r] = 0.f; o1[r] = 0.f; }
    m = -30000.f; lsum = 0.f;
    const bf16* kfb = (const bf16*)(a.ws + WS_DKF) + ((size_t)(b * (T / 32)) * 16 + hd * 4) * 512 + lane * 8;
    v4u vr[4];
    { const int k0t = (half < ntl) ? half : 0;
#pragma unroll
      for (int i = 0; i < 4; ++i) vr[i] = *(const v4u*)(kvbase + (size_t)(k0t * 32 + 8 * i) * ZW + Z_CV); }
    f32x16 scur;
#pragma unroll
    for (int r = 0; r < 16; ++r) scur[r] = 0.f;
    bf16x8 kfn[4];
    { const int k0t = (half < ntl) ? half : 0, k2 = (half + 2 < ntl) ? half + 2 : k0t;
      bf16x8 kf0[4];
#pragma unroll
      for (int s = 0; s < 4; ++s) { kf0[s] = *(const bf16x8*)(kfb + ((size_t)k0t * 16 + s) * 512); kfn[s] = *(const bf16x8*)(kfb + ((size_t)k2 * 16 + s) * 512); }
      if (half < ntl) scur = dsa_scores(kf0, qa); }
#pragma unroll 1
    for (int kt = half; kt < ntl; kt += 2) {
        const bool has_next = kt + 2 < ntl;
#pragma unroll
        for (int i = 0; i < 4; ++i) *(LAS v4u*)(vst + i * 512) = vr[i];
        const int ktv = has_next ? kt + 2 : kt, ktk = (kt + 4 < ntl) ? kt + 4 : kt;
#pragma unroll
        for (int i = 0; i < 4; ++i) vr[i] = *(const v4u*)(kvbase + (size_t)(ktv * 32 + 8 * i) * ZW + Z_CV);
        f32x16 snext = scur;
        if (has_next) snext = dsa_scores(kfn, qa);
#pragma unroll
        for (int s = 0; s < 4; ++s) kfn[s] = *(const bf16x8*)(kfb + ((size_t)ktk * 16 + s) * 512);
        unsigned word = sel ? bm[kt * 32 + ql] : 0xffffffffu;
        if (kt == qi) word &= (ql == 31) ? 0xffffffffu : ((2u << ql) - 1u);
        if (qi - kt >= 5) dsa_att_tile<false>(scur, word, 0, hh, biasH, c31, vaddr, o0, o1, m, lsum);
        else dsa_att_tile<true>(scur, word, tq0 + ql - kt * 32, hh, biasH, c31, vaddr, o0, o1, m, lsum);
        scur = snext;
    }
    PSTAMP(3);
    LAS float* cmb = (LAS float*)(lds + DS_CMB + hd * 8704);
    if (half == 1) {
#pragma unroll
        for (int r = 0; r < 16; ++r) { cmb[r * 64 + lane] = o0[r]; cmb[(16 + r) * 64 + lane] = o1[r]; }
        cmb[2048 + lane] = m; cmb[2048 + 64 + lane] = lsum;
    }
    __syncthreads();
    if (half == 0) {
        const float mb = cmb[2048 + lane], lb = cmb[2048 + 64 + lane];
        const float mt = fmaxf(m, mb), fa = __builtin_amdgcn_exp2f(m - mt), fb = __builtin_amdgcn_exp2f(mb - mt);
        const float inv = 1.0f / (lsum * fa + lb * fb), ga = fa * inv, gb = fb * inv;
#pragma unroll
        for (int r = 0; r < 16; ++r) { o0[r] = o0[r] * ga + cmb[r * 64 + lane] * gb; o1[r] = o1[r] * ga + cmb[(16 + r) * 64 + lane] * gb; }
#pragma unroll
        for (int g = 0; g < 4; ++g) { v2u w0, w1; w0.x = pg8::cvt_pk_bf16(o0[4 * g], o0[4 * g + 1]); w0.y = pg8::cvt_pk_bf16(o0[4 * g + 2], o0[4 * g + 3]); w1.x = pg8::cvt_pk_bf16(o1[4 * g], o1[4 * g + 1]); w1.y = pg8::cvt_pk_bf16(o1[4 * g + 2], o1[4 * g + 3]);
            *(LAS v2u*)(st + ql * 136 + (8 * g + 4 * hh) * 2) = w0; *(LAS v2u*)(st + ql * 136 + (32 + 8 * g + 4 * hh) * 2) = w1; }
        asm volatile("s_waitcnt lgkmcnt(0)" ::: "memory");
#pragma unroll
        for (int i = 0; i < 4; ++i) { const int q = (lane >> 3) + 8 * i, ch = lane & 7;
            const v2u x0 = *(const LAS v2u*)(st + q * 136 + ch * 16), x1 = *(const LAS v2u*)(st + q * 136 + ch * 16 + 8);
            v4u o; o.x = x0.x; o.y = x0.y; o.z = x1.x; o.w = x1.y;
            *(v4u*)(mix + ((size_t)b * T + tq0 + q) * D + 512 + hd * 64 + ch * 8) = o; }
    }
    __syncthreads();
    PSTAMP(4);
}
constexpr int XA_V = 0, XA_ST = 32768;
__device__ __forceinline__ void xattn2_item(const Args& a, int l, int item, LAS unsigned char* lds, int tid) {
    const int lane = tid & 63, w = __builtin_amdgcn_readfirstlane(tid >> 6), ql = lane & 31, hh = lane >> 5;
    const int qg = item & 7, h = (item >> 3) & 3, b = item >> 5;
    const bf16* kvm = (const bf16*)(a.ws + WS_KVM + (size_t)l * SZ_KVM) + (size_t)b * MEMLEN * 512;
    const bf16* qx = (const bf16*)(a.ws + WS_QX); bf16* ox = (bf16*)(a.ws + WS_OX);
#pragma unroll
    for (int i = 0; i < 4; ++i) { const int idx = tid + NTHR * i, key = idx >> 3, ch = idx & 7;
        const v4u v = *(const v4u*)(kvm + (size_t)key * 512 + 256 + h * 64 + ch * 8);
        *(LAS v4u*)(lds + XA_V + (key >> 5) * 4096 + (ch >> 2) * 2048 + (key & 31) * 64 + (ch & 3) * 16) = v; }
    __syncthreads();
    const size_t row0 = (size_t)b * T + qg * 256 + w * 32;
    bf16x8 qa[4];
#pragma unroll
    for (int s = 0; s < 4; ++s) qa[s] = *(const bf16x8*)(qx + (row0 + ql) * 256 + h * 64 + 16 * s + 8 * hh);
    f32x16 o0, o1;
#pragma unroll
    for (int r = 0; r < 16; ++r) { o0[r] = 0.f; o1[r] = 0.f; }
    float m = -1e30f, lsum = 0.f;
    const unsigned vaddr = (unsigned)(size_t)(lds + XA_V) + (unsigned)((4 * hh + ((lane >> 2) & 3)) * 64 + 32 * ((lane >> 4) & 1) + 8 * (lane & 3));
#pragma unroll 1
    for (int kt = 0; kt < 8; ++kt) {
        bf16x8 kf[4];
        { const bf16* zk = kvm + (size_t)(kt * 32 + ql) * 512 + h * 64 + 8 * hh;
#pragma unroll
          for (int s = 0; s < 4; ++s) kf[s] = *(const bf16x8*)(zk + 16 * s); }
        f32x16 sacc;
#pragma unroll
        for (int r = 0; r < 16; ++r) sacc[r] = 0.f;
#pragma unroll
        for (int s = 0; s < 4; ++s) sacc = MFMA32(kf[s], qa[s], sacc);
        float sv[16]; float tmax = -1e30f;
#pragma unroll
        for (int r = 0; r < 16; ++r) { sv[r] = sacc[r] * 1.4426950408889634f; tmax = fmaxf(tmax, sv[r]); }
        tmax = fmaxf(tmax, shfl_xor_c<32>(tmax));
        const float mnew = fmaxf(m, tmax), alpha = __builtin_amdgcn_exp2f(m - mnew);
        float p[16]; float ps = 0.f;
#pragma unroll
        for (int r = 0; r < 16; ++r) { p[r] = __builtin_amdgcn_exp2f(sv[r] - mnew); ps += p[r]; }
        ps += shfl_xor_c<32>(ps);
        lsum = lsum * alpha + ps; m = mnew;
#pragma unroll
        for (int r = 0; r < 16; ++r) { o0[r] *= alpha; o1[r] *= alpha; }
        bf16x8 pb[2];
#pragma unroll
        for (int s = 0; s < 2; ++s) { v4u t4; t4.x = pg8::cvt_pk_bf16(p[8 * s + 0], p[8 * s + 1]); t4.y = pg8::cvt_pk_bf16(p[8 * s + 2], p[8 * s + 3]); t4.z = pg8::cvt_pk_bf16(p[8 * s + 4], p[8 * s + 5]); t4.w = pg8::cvt_pk_bf16(p[8 * s + 6], p[8 * s + 7]);
            pb[s] = __builtin_bit_cast(bf16x8, t4); }
        bf16x4 t00, t01, t10, t11, u00, u01, u10, u11;
        tr_read_tile(vaddr + kt * 4096, t00, t01, t10, t11, u00, u01, u10, u11);
        const bf16x8 va00 = __builtin_shufflevector(t00, t01, 0, 1, 2, 3, 4, 5, 6, 7), va01 = __builtin_shufflevector(t10, t11, 0, 1, 2, 3, 4, 5, 6, 7);
        const bf16x8 va10 = __builtin_shufflevector(u00, u01, 0, 1, 2, 3, 4, 5, 6, 7), va11 = __builtin_shufflevector(u10, u11, 0, 1, 2, 3, 4, 5, 6, 7);
        o0 = MFMA32(va00, pb[0], o0); o0 = MFMA32(va01, pb[1], o0);
        o1 = MFMA32(va10, pb[0], o1); o1 = MFMA32(va11, pb[1], o1);
    }
    const float inv = 1.0f / lsum;
    LAS unsigned char* st = lds + XA_ST + w * 4608;
#pragma unroll
    for (int g = 0; g < 4; ++g) { v2u w0, w1; w0.x = pg8::cvt_pk_bf16(o0[4 * g] * inv, o0[4 * g + 1] * inv); w0.y = pg8::cvt_pk_bf16(o0[4 * g + 2] * inv, o0[4 * g + 3] * inv);
        w1.x = pg8::cvt_pk_bf16(o1[4 * g] * inv, o1[4 * g + 1] * inv); w1.y = pg8::cvt_pk_bf16(o1[4 * g + 2] * inv, o1[4 * g + 3] * inv);
        *(LAS v2u*)(st + ql * 136 + (8 * g + 4 * hh) * 2) = w0; *(LAS v2u*)(st + ql * 136 + (32 + 8 * g + 4 * hh) * 2) = w1; }
    asm volatile("s_waitcnt lgkmcnt(0)" ::: "memory");
#pragma unroll
    for (int i = 0; i < 4; ++i) { const int q = (lane >> 3) + 8 * i, ch = lane & 7;
        const v2u x0 = *(const LAS v2u*)(st + q * 136 + ch * 16), x1 = *(const LAS v2u*)(st + q * 136 + ch * 16 + 8);
        v4u o; o.x = x0.x; o.y = x0.y; o.z = x1.x; o.w = x1.y;
        *(v4u*)(ox + (row0 + q) * 256 + h * 64 + ch * 8) = o; }
    __syncthreads();
}

__device__ __forceinline__ float gelu_fast(float x) {
    const float y = x * (1.0f + 0.044715f * x * x) * -2.302208198f;
    return x * __builtin_amdgcn_rcpf(1.0f + __builtin_amdgcn_exp2f(y));
}
__device__ __forceinline__ void frag_phase(const Args& a, int tid, int G, int bid) {
    for (int P = bid * NTHR + tid; P < 393216; P += G * NTHR) {
        const int lane = P & 63, ql = lane & 31, hh = lane >> 5;
        if (P < 65536) { const int l2 = P >> 15, fr = (P & 32767) >> 6, w = fr >> 6, kk = fr & 63;
            *(v4u*)((bf16*)(a.ws + WS_WQF) + (size_t)P * 8) = *(const v4u*)((const bf16*)(a.ws + WS_WQ + (size_t)l2 * SZ_WQ) + (size_t)(32 * w + ql) * D + 16 * kk + 8 * hh); }
        else if (P < 131072) { const int Q = P - 65536, l2 = Q >> 15, fr = (Q & 32767) >> 6, nt = fr >> 4, kk = fr & 15;
            *(v4u*)((bf16*)(a.ws + WS_WOF) + (size_t)Q * 8) = *(const v4u*)((const bf16*)(a.ws + WS_WO + (size_t)l2 * SZ_WO) + (size_t)(32 * nt + ql) * 256 + 16 * kk + 8 * hh); }
        else if (P < 262144) { const int Q = P - 131072, l2 = Q >> 16, r1 = Q & 65535, b = r1 >> 13, r2 = r1 & 8191, h = r2 >> 11, kt = (r2 >> 8) & 7, s4 = (r2 >> 6) & 3;
            *(v4u*)((bf16*)(a.ws + WS_KF) + (size_t)Q * 8) = *(const v4u*)((const bf16*)(a.ws + WS_KVM + (size_t)l2 * SZ_KVM) + (size_t)(b * MEMLEN + 32 * kt + ql) * 512 + h * 64 + 16 * s4 + 8 * hh); }
        else { const int Q = P - 262144, l2 = Q >> 16, r1 = Q & 65535, b = r1 >> 13, r2 = r1 & 8191, h = r2 >> 11, kt = (r2 >> 8) & 7, dd = (r2 >> 7) & 1, j = (r2 >> 6) & 1;
            const bf16* vsrc = (const bf16*)(a.ws + WS_KVM + (size_t)l2 * SZ_KVM) + (size_t)(b * MEMLEN + 32 * kt + 16 * j + 4 * hh) * 512 + 256 + h * 64 + 32 * dd + ql;
            unsigned short e8[8];
#pragma unroll
            for (int e = 0; e < 8; ++e) e8[e] = *(const unsigned short*)(vsrc + (size_t)((e & 3) + 8 * (e >> 2)) * 512);
            v4u w; w.x = e8[0] | ((unsigned)e8[1] << 16); w.y = e8[2] | ((unsigned)e8[3] << 16); w.z = e8[4] | ((unsigned)e8[5] << 16); w.w = e8[6] | ((unsigned)e8[7] << 16);
            *(v4u*)((bf16*)(a.ws + WS_VF) + (size_t)Q * 8) = w; }
    }
}
#define XF_NREP(name) int name = 3; asm volatile("" : "+s"(name))
constexpr int XF_HBS = 2064, XF_QS = 528, XF_Q = 0, XF_O = 64 * XF_QS;
__device__ __forceinline__ void xfuse_item(const Args& a, int l, int item, LAS unsigned char* lds, int tid) {
    const int lane = tid & 63, w = __builtin_amdgcn_readfirstlane(tid >> 6), ql = lane & 31, hh = lane >> 5;
    const int tok0 = item * 64, b = item >> 5;
    const bf16* hbp = (const bf16*)(a.ws + WS_H16) + (size_t)tok0 * D;
#ifdef XF_REPA
    XF_NREP(nra);
#pragma unroll 1
    for (int rep = 0; rep < nra; ++rep)
#endif
#pragma unroll
    for (int i = 0; i < 16; ++i) { const int chunk = tid + NTHR * i, row = chunk >> 7, c16 = chunk & 127;
        *(LAS v4u*)(lds + row * XF_HBS + c16 * 16) = *(const v4u*)(hbp + (size_t)row * D + c16 * 8); }
    const float* ss = (const float*)(a.ws + WS_SS);
    const float rs0 = rstd16(ss, tok0 + ql) * 0.125f, rs1 = rstd16(ss, tok0 + 32 + ql) * 0.125f;
    __syncthreads();
    { f32x16 q0, q1;
#pragma unroll
      for (int r = 0; r < 16; ++r) { q0[r] = 0.f; q1[r] = 0.f; }
      const bf16* wq = (const bf16*)(a.ws + WS_WQF) + (size_t)(l * 8 + w) * 64 * 512 + lane * 8;
      const LAS unsigned char* hb0 = lds + ql * XF_HBS + 16 * hh;
#ifdef XF_REPB
      XF_NREP(nrb);
#pragma unroll 1
      for (int rep = 0; rep < nrb; ++rep) {
#pragma unroll
      for (int r = 0; r < 16; ++r) { q0[r] = 0.f; q1[r] = 0.f; }
#endif
#pragma unroll 8
      for (int kk = 0; kk < 64; ++kk) {
          const bf16x8 af = *(const bf16x8*)(wq + 512 * kk);
          const bf16x8 b0 = *(const LAS bf16x8*)(hb0 + 32 * kk), b1 = *(const LAS bf16x8*)(hb0 + 32 * XF_HBS + 32 * kk);
          q0 = MFMA32(af, b0, q0); q1 = MFMA32(af, b1, q1); }
#ifdef XF_REPB
      }
#endif
      __syncthreads();
#pragma unroll
      for (int g = 0; g < 4; ++g) { v2u w0, w1;
          w0.x = pg8::cvt_pk_bf16(q0[4 * g] * rs0, q0[4 * g + 1] * rs0); w0.y = pg8::cvt_pk_bf16(q0[4 * g + 2] * rs0, q0[4 * g + 3] * rs0);
          w1.x = pg8::cvt_pk_bf16(q1[4 * g] * rs1, q1[4 * g + 1] * rs1); w1.y = pg8::cvt_pk_bf16(q1[4 * g + 2] * rs1, q1[4 * g + 3] * rs1);
          *(LAS v2u*)(lds + XF_Q + ql * XF_QS + (32 * w + 8 * g + 4 * hh) * 2) = w0; *(LAS v2u*)(lds + XF_Q + (32 + ql) * XF_QS + (32 * w + 8 * g + 4 * hh) * 2) = w1; }
    }
    __syncthreads();
    { const int h = w >> 1, th = w & 1;
      const bf16* kfb = (const bf16*)(a.ws + WS_KF) + (size_t)((l * 8 + b) * 4 + h) * 32 * 512 + lane * 8;
      const bf16* vfb = (const bf16*)(a.ws + WS_VF) + (size_t)((l * 8 + b) * 4 + h) * 32 * 512 + lane * 8;
      bf16x8 qa[4];
#pragma unroll
      for (int s = 0; s < 4; ++s) qa[s] = *(const LAS bf16x8*)(lds + XF_Q + (32 * th + ql) * XF_QS + (h * 64 + 16 * s + 8 * hh) * 2);
      f32x16 o0, o1;
#pragma unroll
      for (int r = 0; r < 16; ++r) { o0[r] = 0.f; o1[r] = 0.f; }
      float m = -1e30f, lsum = 0.f;
      bf16x8 kf[4], va00, va01, va10, va11;
#pragma unroll
      for (int s = 0; s < 4; ++s) kf[s] = *(const bf16x8*)(kfb + 512 * s);
      va00 = *(const bf16x8*)(vfb); va01 = *(const bf16x8*)(vfb + 512); va10 = *(const bf16x8*)(vfb + 1024); va11 = *(const bf16x8*)(vfb + 1536);
#ifdef XF_REPC
      XF_NREP(nrc);
#pragma unroll 1
      for (int rep = 0; rep < nrc; ++rep) { m = -1e30f; lsum = 0.f;
#pragma unroll
      for (int s = 0; s < 4; ++s) kf[s] = *(const bf16x8*)(kfb + 512 * s);
      va00 = *(const bf16x8*)(vfb); va01 = *(const bf16x8*)(vfb + 512); va10 = *(const bf16x8*)(vfb + 1024); va11 = *(const bf16x8*)(vfb + 1536);
#pragma unroll
      for (int r = 0; r < 16; ++r) { o0[r] = 0.f; o1[r] = 0.f; }
#endif
#pragma unroll 1
      for (int kt = 0; kt < 8; ++kt) {
          const int kn = kt < 7 ? kt + 1 : 7;
          bf16x8 nk[4];
#pragma unroll
          for (int s = 0; s < 4; ++s) nk[s] = *(const bf16x8*)(kfb + (size_t)(kn * 4 + s) * 512);
          const bf16x8 n00 = *(const bf16x8*)(vfb + (size_t)kn * 2048), n01 = *(const bf16x8*)(vfb + (size_t)kn * 2048 + 512), n10 = *(const bf16x8*)(vfb + (size_t)kn * 2048 + 1024), n11 = *(const bf16x8*)(vfb + (size_t)kn * 2048 + 1536);
          f32x16 sacc;
#pragma unroll
          for (int r = 0; r < 16; ++r) sacc[r] = 0.f;
#pragma unroll
          for (int s = 0; s < 4; ++s) sacc = MFMA32(kf[s], qa[s], sacc);
          float sv[16]; float tmax = -1e30f;
#pragma unroll
          for (int r = 0; r < 16; ++r) { sv[r] = sacc[r] * 1.4426950408889634f; tmax = fmaxf(tmax, sv[r]); }
          tmax = fmaxf(tmax, shfl_xor_c<32>(tmax));
          const float mnew = fmaxf(m, tmax), alpha = __builtin_amdgcn_exp2f(m - mnew);
          float p[16]; float ps = 0.f;
#pragma unroll
          for (int r = 0; r < 16; ++r) { p[r] = __builtin_amdgcn_exp2f(sv[r] - mnew); ps += p[r]; }
          ps += shfl_xor_c<32>(ps);
          lsum = lsum * alpha + ps; m = mnew;
#pragma unroll
          for (int r = 0; r < 16; ++r) { o0[r] *= alpha; o1[r] *= alpha; }
          bf16x8 pb[2];
#pragma unroll
          for (int s = 0; s < 2; ++s) { v4u t4; t4.x = pg8::cvt_pk_bf16(p[8 * s + 0], p[8 * s + 1]); t4.y = pg8::cvt_pk_bf16(p[8 * s + 2], p[8 * s + 3]); t4.z = pg8::cvt_pk_bf16(p[8 * s + 4], p[8 * s + 5]); t4.w = pg8::cvt_pk_bf16(p[8 * s + 6], p[8 * s + 7]);
              pb[s] = __builtin_bit_cast(bf16x8, t4); }
          o0 = MFMA32(va00, pb[0], o0); o0 = MFMA32(va01, pb[1], o0);
          o1 = MFMA32(va10, pb[0], o1); o1 = MFMA32(va11, pb[1], o1);
#pragma unroll
          for (int s = 0; s < 4; ++s) kf[s] = nk[s];
          va00 = n00; va01 = n01; va10 = n10; va11 = n11;
      }
#ifdef XF_REPC
      }
#endif
      const float inv = 1.0f / lsum;
      LAS unsigned char* orow = lds + XF_O + (32 * th + ql) * XF_QS + (h * 64 + 4 * hh) * 2;
#pragma unroll
      for (int g = 0; g < 4; ++g) { v2u w0, w1; w0.x = pg8::cvt_pk_bf16(o0[4 * g] * inv, o0[4 * g + 1] * inv); w0.y = pg8::cvt_pk_bf16(o0[4 * g + 2] * inv, o0[4 * g + 3] * inv);
          w1.x = pg8::cvt_pk_bf16(o1[4 * g] * inv, o1[4 * g + 1] * inv); w1.y = pg8::cvt_pk_bf16(o1[4 * g + 2] * inv, o1[4 * g + 3] * inv);
          *(LAS v2u*)(orow + 16 * g) = w0; *(LAS v2u*)(orow + 64 + 16 * g) = w1; }
    }
    __syncthreads();
    { f32x16 acc[4][2];
#pragma unroll
      for (int c = 0; c < 4; ++c)
#pragma unroll
          for (int t = 0; t < 2; ++t)
#pragma unroll
              for (int r = 0; r < 16; ++r) acc[c][t][r] = 0.f;
      const bf16* wo = (const bf16*)(a.ws + WS_WOF) + (size_t)(l * 32 + 4 * w) * 16 * 512 + lane * 8;
      const LAS unsigned char* ob = lds + XF_O + ql * XF_QS + 16 * hh;
#ifdef XF_REPD
      XF_NREP(nrd);
#pragma unroll 1
      for (int rep = 0; rep < nrd; ++rep) {
#pragma unroll
      for (int c = 0; c < 4; ++c)
#pragma unroll
          for (int t = 0; t < 2; ++t)
#pragma unroll
              for (int r = 0; r < 16; ++r) acc[c][t][r] = 0.f;
#endif
#pragma unroll 4
      for (int kk = 0; kk < 16; ++kk) {
          const bf16x8 b0 = *(const LAS bf16x8*)(ob + 32 * kk), b1 = *(const LAS bf16x8*)(ob + 32 * XF_QS + 32 * kk);
#pragma unroll
          for (int c = 0; c < 4; ++c) { const bf16x8 af = *(const bf16x8*)(wo + (size_t)(c * 16 + kk) * 512);
              acc[c][0] = MFMA32(af, b0, acc[c][0]); acc[c][1] = MFMA32(af, b1, acc[c][1]); } }
#ifdef XF_REPD
      }
#endif
      bf16* HB = (bf16*)(a.ws + WS_H16); float* SSw = (float*)(a.ws + WS_SS);
#pragma unroll
      for (int t = 0; t < 2; ++t) { const size_t row = (size_t)tok0 + 32 * t + ql; float q = 0.f;
          const size_t off0 = row * D + 128 * w + 4 * hh;
          v2u rv[4][4];
#pragma unroll
          for (int c = 0; c < 4; ++c)
#pragma unroll
              for (int g = 0; g < 4; ++g) rv[c][g] = *(const v2u*)(HB + off0 + 32 * c + 8 * g);
#pragma unroll
          for (int c = 0; c < 4; ++c)
#pragma unroll
              for (int g = 0; g < 4; ++g) { const f32x4 r0 = bf4(rv[c][g]);
                  f32x4 v; v.x = acc[c][t][4 * g] + r0.x; v.y = acc[c][t][4 * g + 1] + r0.y; v.z = acc[c][t][4 * g + 2] + r0.z; v.w = acc[c][t][4 * g + 3] + r0.w;
                  q += (v.x * v.x + v.y * v.y) + (v.z * v.z + v.w * v.w);
                  v2u pk; pk.x = pg8::cvt_pk_bf16(v.x, v.y); pk.y = pg8::cvt_pk_bf16(v.z, v.w); rv[c][g] = pk; }
          asm volatile("" ::: "memory");
#pragma unroll
          for (int c = 0; c < 4; ++c)
#pragma unroll
              for (int g = 0; g < 4; ++g) *(v2u*)(HB + off0 + 32 * c + 8 * g) = rv[c][g];
          q += shfl_xor_c<32>(q);
          SSw[row * 16 + 2 * w + hh] = hh ? 0.f : q; }
    }
    __syncthreads();
}
__device__ __forceinline__ bf16x8 tr_frag(unsigned addr) {
    bf16x4 lo, hi;
    asm volatile("ds_read_b64_tr_b16 %0, %2 offset:0\n\tds_read_b64_tr_b16 %1, %2 offset:256\n\ts_waitcnt lgkmcnt(0)" : "=&v"(lo), "=&v"(hi) : "v"(addr) : "memory");
    return __builtin_shufflevector(lo, hi, 0, 1, 2, 3, 4, 5, 6, 7);
}
__device__ __forceinline__ void sgu2_item(const Args& a, int l, int item, LAS unsigned char* lds, int tid) {
    const int lane = tid & 63, w = __builtin_amdgcn_readfirstlane(tid >> 6), ql = lane & 31, hh = lane >> 5;
    const int nc = item & 15, b = item >> 4, tok0 = b * T + nc * 128;
    const bf16* z = (const bf16*)(a.ws + WS_Z); bf16* mix = (bf16*)(a.ws + WS_MIX);
    for (int j = 0; j < 16; ++j) { const int s = 16 * w + j;
        const v2u raw = *(const v2u*)(z + (size_t)(tok0 + s) * ZW + Z_DUV + 256 + 4 * lane);
        float x[4] = {gelu_fast(bflo(raw.x)), gelu_fast(bfhi(raw.x)), gelu_fast(bflo(raw.y)), gelu_fast(bfhi(raw.y))};
        const float mu = wave_sum((x[0] + x[1]) + (x[2] + x[3])) * (1.0f / 256.0f);
        float q = 0.f;
#pragma unroll
        for (int i = 0; i < 4; ++i) { x[i] -= mu; q += x[i] * x[i]; }
        const float rstd = rsqrtf(wave_sum(q) * (1.0f / 256.0f) + EPS);
        const f32x4 gg = *(const f32x4*)(a.in[IN_LNG] + l * 256 + 4 * lane), bb = *(const f32x4*)(a.in[IN_LNB] + l * 256 + 4 * lane);
        v2u o; o.x = pk2(x[0] * rstd * gg.x + bb.x, x[1] * rstd * gg.y + bb.y); o.y = pk2(x[2] * rstd * gg.z + bb.z, x[3] * rstd * gg.w + bb.w);
        const int ch = 4 * lane;
        *(LAS v2u*)(lds + ((s >> 5) * 8 + (ch >> 5)) * 2048 + (s & 31) * 64 + (ch & 31) * 2) = o; }
    __syncthreads();
    const int g = w >> 1, cb = w & 1, cblk = g * 2 + cb;
    bf16x8 af[4][2];
    { const unsigned abase = (unsigned)(size_t)lds + (unsigned)(cblk * 2048 + (8 * hh + ((lane >> 2) & 3)) * 64 + 32 * ((lane >> 4) & 1) + 8 * (lane & 3));
#pragma unroll
      for (int sb = 0; sb < 4; ++sb) { af[sb][0] = tr_frag(abase + sb * 8 * 2048); af[sb][1] = tr_frag(abase + sb * 8 * 2048 + 16 * 64); } }
    const bf16* swt = (const bf16*)(a.ws + WS_SWT) + (size_t)(l * 4 + g) * 128 * 128;
#pragma unroll
    for (int tb = 0; tb < 4; ++tb) {
        f32x16 acc;
#pragma unroll
        for (int r = 0; r < 16; ++r) acc[r] = 0.f;
        const bf16* wrow = swt + (size_t)(32 * tb + ql) * 128 + 8 * hh;
#pragma unroll
        for (int sb = 0; sb <= tb; ++sb) { const bf16x8 b0 = *(const bf16x8*)(wrow + 32 * sb), b1 = *(const bf16x8*)(wrow + 32 * sb + 16);
            acc = MFMA32(af[sb][0], b0, acc); acc = MFMA32(af[sb][1], b1, acc); }
        const int t = 32 * tb + ql; const float bs = a.in[IN_SB][(l * 4 + g) * 128 + t];
        const bf16* up = z + (size_t)(tok0 + t) * ZW + Z_DUV + g * 64 + cb * 32 + 4 * hh; bf16* op = mix + (size_t)(tok0 + t) * D + 768 + g * 64 + cb * 32 + 4 * hh;
#pragma unroll
        for (int q4 = 0; q4 < 4; ++q4) { const v2u raw = *(const v2u*)(up + 8 * q4);
            v2u o; o.x = pk2(gelu_fast(bflo(raw.x)) * (acc[4 * q4] + bs), gelu_fast(bfhi(raw.x)) * (acc[4 * q4 + 1] + bs)); o.y = pk2(gelu_fast(bflo(raw.y)) * (acc[4 * q4 + 2] + bs), gelu_fast(bfhi(raw.y)) * (acc[4 * q4 + 3] + bs));
            *(v2u*)(op + 8 * q4) = o; }
    }
    __syncthreads();
}
__device__ __forceinline__ void pool2_item(const Args& a, int l, int item, LAS unsigned char* lds, int tid) {
    const int lane = tid & 63, w = __builtin_amdgcn_readfirstlane(tid >> 6), ql = lane & 31, hh = lane >> 5;
    const int tt = item & 31, b = item >> 5, t0 = tt * 64;
    const bf16* z = (const bf16*)(a.ws + WS_Z); bf16* mix = (bf16*)(a.ws + WS_MIX);
    for (int i = tid; i < 79 * 32; i += NTHR) { const int r = i >> 5, ch = i & 31, t = t0 - 15 + r;
        v4u v = (v4u){0u, 0u, 0u, 0u}; if (t >= 0) v = *(const v4u*)(z + (size_t)(b * T + t) * ZW + Z_BU + ch * 8);
        *(LAS v4u*)(lds + r * 528 + ch * 16) = v; }
    __syncthreads();
    const int tb = w & 1, g = w >> 1, win = 2 << g, tl = 32 * tb + ql, tabs = t0 + tl;
    const float icnt = 1.0f / (float)((tabs + 1 < win) ? tabs + 1 : win);
    bf16x8 bfr[4];
#pragma unroll
    for (int s = 0; s < 4; ++s) { const LAS unsigned char* p0 = lds + (tl + 15) * 528 + (g * 64 + 16 * s + 8 * hh) * 2; float acc[8] = {0.f, 0.f, 0.f, 0.f, 0.f, 0.f, 0.f, 0.f};
        for (int j = 0; j < win; ++j) { const v4u r = *(const LAS v4u*)(p0 - j * 528);
            acc[0] += bflo(r.x); acc[1] += bfhi(r.x); acc[2] += bflo(r.y); acc[3] += bfhi(r.y); acc[4] += bflo(r.z); acc[5] += bfhi(r.z); acc[6] += bflo(r.w); acc[7] += bfhi(r.w); }
        const v4u r0 = *(const LAS v4u*)p0;
        v4u o; o.x = pg8::cvt_pk_bf16(acc[0] * icnt - bflo(r0.x), acc[1] * icnt - bfhi(r0.x)); o.y = pg8::cvt_pk_bf16(acc[2] * icnt - bflo(r0.y), acc[3] * icnt - bfhi(r0.y));
        o.z = pg8::cvt_pk_bf16(acc[4] * icnt - bflo(r0.z), acc[5] * icnt - bfhi(r0.z)); o.w = pg8::cvt_pk_bf16(acc[6] * icnt - bflo(r0.w), acc[7] * icnt - bfhi(r0.w));
        bfr[s] = __builtin_bit_cast(bf16x8, o); }
    const bf16* pwt = (const bf16*)(a.ws + WS_PWT) + (size_t)(l * 4 + g) * 4096;
    bf16* op = mix + (size_t)(b * T + tabs) * D + 256 + g * 64 + 4 * hh;
#pragma unroll
    for (int db = 0; db < 2; ++db) { f32x16 acc;
#pragma unroll
        for (int r = 0; r < 16; ++r) acc[r] = 0.f;
#pragma unroll
        for (int s = 0; s < 4; ++s) { const bf16x8 af = *(const bf16x8*)(pwt + (size_t)(32 * db + ql) * 64 + 16 * s + 8 * hh); acc = MFMA32(af, bfr[s], acc); }
#pragma unroll
        for (int q4 = 0; q4 < 4; ++q4) { const int d0 = 32 * db + 8 * q4 + 4 * hh;
            const f32x4 pb = *(const f32x4*)(a.in[IN_PB] + (l * 4 + g) * 64 + d0), ps = *(const f32x4*)(a.in[IN_PS] + l * 256 + g * 64 + d0);
            v2u o; o.x = pk2((acc[4 * q4] + pb.x) * ps.x, (acc[4 * q4 + 1] + pb.y) * ps.y); o.y = pk2((acc[4 * q4 + 2] + pb.z) * ps.z, (acc[4 * q4 + 3] + pb.w) * ps.w);
            *(v2u*)(op + 32 * db + 8 * q4) = o; } }
    __syncthreads();
}

constexpr int GL_V = 0;
constexpr int GL_KD = 32768;

__device__ __forceinline__ void gla_decay(const Args& a, int l, int h, const bf16* zc  , int lane, float (&b0)[16], float (&b1)[16]) {
    const int ql = lane & 31, hh = lane >> 5;
    bf16x8 wfrag; { float wv[8];
#pragma unroll
        for (int j = 0; j < 8; ++j) wv[j] = a.in[IN_WA2][(size_t)l * 2048 + (8 * hh + j) * 128 + h * 32 + ql];
        v4u t4; t4.x = pk2(wv[0], wv[1]); t4.y = pk2(wv[2], wv[3]); t4.z = pk2(wv[4], wv[5]); t4.w = pk2(wv[6], wv[7]); wfrag = __builtin_bit_cast(bf16x8, t4); }
    f32x16 binit;
#pragma unroll
    for (int q4 = 0; q4 < 4; ++q4) { const f32x4 t = *(const f32x4*)(a.in[IN_BA] + l * 128 + h * 32 + 8 * q4 + 4 * hh); binit[4 * q4] = t.x; binit[4 * q4 + 1] = t.y; binit[4 * q4 + 2] = t.z; binit[4 * q4 + 3] = t.w; }
#pragma unroll
    for (int rb = 0; rb < 2; ++rb) {
        const bf16x8 afrag = *(const bf16x8*)(zc + (size_t)(32 * rb + ql) * ZW + Z_ALR + 8 * hh);
        f32x16 lg = MFMA32(wfrag, afrag, binit);
#pragma unroll
        for (int r = 0; r < 16; ++r) { const float x = lg[r]; float v = (fminf(x, 0.f) - __logf(1.0f + __expf(-fabsf(x)))) * 0.0625f;
#pragma unroll
            for (int d = 1; d < 32; d <<= 1) { const float t = shfl_idx(v, (lane - d) & 63); if (ql >= d) v += t; }
            if (rb == 0) b0[r] = v; else b1[r] = v + shfl_idx(b0[r], lane | 31); }
    }
}
__device__ __forceinline__ void ld16acc(const bf16* p  , float (&x)[16]) {
#pragma unroll
    for (int q4 = 0; q4 < 4; ++q4) { const v2u t = *(const v2u*)(p + 8 * q4); x[4 * q4] = bflo(t.x); x[4 * q4 + 1] = bfhi(t.x); x[4 * q4 + 2] = bflo(t.y); x[4 * q4 + 3] = bfhi(t.y); }
}
__device__ __forceinline__ bf16x8 pack_frag(const float (&x)[16], int s) { v4u t4; t4.x = pg8::cvt_pk_bf16(x[8 * s], x[8 * s + 1]); t4.y = pg8::cvt_pk_bf16(x[8 * s + 2], x[8 * s + 3]); t4.z = pg8::cvt_pk_bf16(x[8 * s + 4], x[8 * s + 5]); t4.w = pg8::cvt_pk_bf16(x[8 * s + 6], x[8 * s + 7]); return __builtin_bit_cast(bf16x8, t4); }
__device__ __forceinline__ void gla2_a_item(const Args& a, int l, int item, LAS unsigned char* lds, int tid) {
    const int lane = tid & 63, w = __builtin_amdgcn_readfirstlane(tid >> 6), ql = lane & 31, hh = lane >> 5;
    const int n = item & 31, b = item >> 5, h = w >> 1, ib = w & 1, tok0 = b * T + n * 64, it4 = (b * 4 + h) * 32 + n;
    const bf16* z = (const bf16*)(a.ws + WS_Z); const bf16* zc = z + (size_t)tok0 * ZW;
    float* OI = (float*)(a.ws + WS_GOI); v4u* QTF = (v4u*)(a.ws + WS_GQT); float* KVT = (float*)(a.ws + WS_GKV); float* DEC = (float*)(a.ws + WS_GDEC);
#pragma unroll
    for (int i = 0; i < 4; ++i) { const int tk = (lane >> 3) + 8 * i, ch = lane & 7;
        const v4u v = *(const v4u*)(zc + (size_t)(32 * ib + tk) * ZW + Z_AV + h * 64 + ch * 8);
        *(LAS v4u*)(lds + GL_V + h * 8192 + (ib * 2 + (ch >> 2)) * 2048 + tk * 64 + (ch & 3) * 16) = v; }
    float b0[16], b1[16]; gla_decay(a, l, h, zc, lane, b0, b1);
    float blast[16];
#pragma unroll
    for (int r = 0; r < 16; ++r) blast[r] = shfl_idx(b1[r], lane | 31);
    float x[16], qt[16], kt[16], kd[16];
    ld16acc(zc + (size_t)(32 * ib + ql) * ZW + Z_AQ + h * 32 + 4 * hh, x);
#pragma unroll
    for (int r = 0; r < 16; ++r) qt[r] = x[r] * 0.17677669529663687f * __expf(ib ? b1[r] : b0[r]);
    ld16acc(zc + (size_t)(32 * ib + ql) * ZW + Z_AK + h * 32 + 4 * hh, x);
#pragma unroll
    for (int r = 0; r < 16; ++r) { const float bv = ib ? b1[r] : b0[r]; kt[r] = x[r] * __expf(-bv); kd[r] = x[r] * __expf(blast[r] - bv); }
    const bf16x8 qf0 = pack_frag(qt, 0), qf1 = pack_frag(qt, 1);
    QTF[((size_t)it4 * 2 + ib) * 128 + lane] = __builtin_bit_cast(v4u, qf0); QTF[((size_t)it4 * 2 + ib) * 128 + 64 + lane] = __builtin_bit_cast(v4u, qf1);
#pragma unroll
    for (int q4 = 0; q4 < 4; ++q4) { v2u o; o.x = pg8::cvt_pk_bf16(kd[4 * q4], kd[4 * q4 + 1]); o.y = pg8::cvt_pk_bf16(kd[4 * q4 + 2], kd[4 * q4 + 3]);
        *(LAS v2u*)(lds + GL_KD + h * 4096 + (32 * ib + ql) * 64 + (8 * q4 + 4 * hh) * 2) = o; }
    if (ib == 1 && ql == 31) {
#pragma unroll
        for (int q4 = 0; q4 < 4; ++q4) { f32x4 d; d.x = __expf(b1[4 * q4]); d.y = __expf(b1[4 * q4 + 1]); d.z = __expf(b1[4 * q4 + 2]); d.w = __expf(b1[4 * q4 + 3]); *(f32x4*)(DEC + (size_t)it4 * 32 + 8 * q4 + 4 * hh) = d; } }
    __syncthreads();
    f32x16 o0, o1;
#pragma unroll
    for (int r = 0; r < 16; ++r) { o0[r] = 0.f; o1[r] = 0.f; }
    const unsigned vaddr = (unsigned)(size_t)(lds + GL_V + h * 8192) + (unsigned)((4 * hh + ((lane >> 2) & 3)) * 64 + 32 * ((lane >> 4) & 1) + 8 * (lane & 3));
#pragma unroll
    for (int jb = 0; jb < 2; ++jb) {
        if (jb <= ib) {
            bf16x8 kf0, kf1;
            if (jb == ib) { kf0 = pack_frag(kt, 0); kf1 = pack_frag(kt, 1); }
            else { float kx[16]; ld16acc(zc + (size_t)ql * ZW + Z_AK + h * 32 + 4 * hh, kx);
#pragma unroll
                for (int r = 0; r < 16; ++r) kx[r] *= __expf(-b0[r]);
                kf0 = pack_frag(kx, 0); kf1 = pack_frag(kx, 1); }
            f32x16 at;
#pragma unroll
            for (int r = 0; r < 16; ++r) at[r] = 0.f;
            at = MFMA32(kf0, qf0, at); at = MFMA32(kf1, qf1, at);
            float pa[16];
#pragma unroll
            for (int r = 0; r < 16; ++r) { const int jl = (r & 3) + 8 * (r >> 2) + 4 * hh; pa[r] = (jb < ib || jl <= ql) ? at[r] : 0.f; }
            const bf16x8 pb0 = pack_frag(pa, 0), pb1 = pack_frag(pa, 1);
            bf16x4 t00, t01, t10, t11, u00, u01, u10, u11;
            tr_read_tile(vaddr + jb * 4096, t00, t01, t10, t11, u00, u01, u10, u11);
            o0 = MFMA32(__builtin_shufflevector(t00, t01, 0, 1, 2, 3, 4, 5, 6, 7), pb0, o0); o0 = MFMA32(__builtin_shufflevector(t10, t11, 0, 1, 2, 3, 4, 5, 6, 7), pb1, o0);
            o1 = MFMA32(__builtin_shufflevector(u00, u01, 0, 1, 2, 3, 4, 5, 6, 7), pb0, o1); o1 = MFMA32(__builtin_shufflevector(u10, u11, 0, 1, 2, 3, 4, 5, 6, 7), pb1, o1);
        }
    }
    { float* op = OI + (size_t)(tok0 + 32 * ib + ql) * 256 + h * 64 + 4 * hh;
#pragma unroll
      for (int q4 = 0; q4 < 4; ++q4) { *(f32x4*)(op + 8 * q4) = (f32x4){o0[4 * q4], o0[4 * q4 + 1], o0[4 * q4 + 2], o0[4 * q4 + 3]}; *(f32x4*)(op + 32 + 8 * q4) = (f32x4){o1[4 * q4], o1[4 * q4 + 1], o1[4 * q4 + 2], o1[4 * q4 + 3]}; } }
    { f32x16 sa;
#pragma unroll
      for (int r = 0; r < 16; ++r) sa[r] = 0.f;
      const unsigned lp = (unsigned)((8 * hh + ((lane >> 2) & 3)) * 64 + 32 * ((lane >> 4) & 1) + 8 * (lane & 3));
      const unsigned va = (unsigned)(size_t)(lds + GL_V + h * 8192) + lp, ka = (unsigned)(size_t)(lds + GL_KD + h * 4096) + lp;
#pragma unroll
      for (int tt = 0; tt < 2; ++tt)
#pragma unroll
        for (int ks = 0; ks < 2; ++ks) { const bf16x8 af = tr_frag(va + (tt * 2 + ib) * 2048 + ks * 1024), bfv = tr_frag(ka + (32 * tt + 16 * ks) * 64); sa = MFMA32(af, bfv, sa); }
      float* kp = KVT + (size_t)it4 * 2048 + (size_t)(32 * ib + 4 * hh) * 32 + ql;
#pragma unroll
      for (int r = 0; r < 16; ++r) kp[((r & 3) + 8 * (r >> 2)) * 32] = sa[r]; }
    __syncthreads();
}
__device__ __forceinline__ void gla2_c_item(const Args& a, int l, int item, LAS unsigned char* lds, int tid) {
    const int lane = tid & 63, w = __builtin_amdgcn_readfirstlane(tid >> 6), ql = lane & 31, hh = lane >> 5;
    const int n = item & 31, b = item >> 5, h = w >> 1, ib = w & 1, tok0 = b * T + n * 64, it4 = (b * 4 + h) * 32 + n;
    const bf16* z = (const bf16*)(a.ws + WS_Z); bf16* mix = (bf16*)(a.ws + WS_MIX);
    const float* OI = (const float*)(a.ws + WS_GOI); const v4u* QTF = (const v4u*)(a.ws + WS_GQT); const float* KVT = (const float*)(a.ws + WS_GKV); const float* DEC = (const float*)(a.ws + WS_GDEC);
    float S0[16], S1[16];
    { const float* sp = KVT + (size_t)it4 * 2048 + ql * 32 + 4 * hh;
#pragma unroll
      for (int q4 = 0; q4 < 4; ++q4) { const f32x4 t0 = *(const f32x4*)(sp + 8 * q4), t1 = *(const f32x4*)(sp + 1024 + 8 * q4);
          S0[4 * q4] = t0.x; S0[4 * q4 + 1] = t0.y; S0[4 * q4 + 2] = t0.z; S0[4 * q4 + 3] = t0.w; S1[4 * q4] = t1.x; S1[4 * q4 + 1] = t1.y; S1[4 * q4 + 2] = t1.z; S1[4 * q4 + 3] = t1.w; } }
    const bf16x8 qf0 = __builtin_bit_cast(bf16x8, QTF[((size_t)it4 * 2 + ib) * 128 + lane]), qf1 = __builtin_bit_cast(bf16x8, QTF[((size_t)it4 * 2 + ib) * 128 + 64 + lane]);
    f32x16 o0, o1;
    { const float* op = OI + (size_t)(tok0 + 32 * ib + ql) * 256 + h * 64 + 4 * hh;
#pragma unroll
      for (int q4 = 0; q4 < 4; ++q4) { const f32x4 t0 = *(const f32x4*)(op + 8 * q4), t1 = *(const f32x4*)(op + 32 + 8 * q4);
          o0[4 * q4] = t0.x; o0[4 * q4 + 1] = t0.y; o0[4 * q4 + 2] = t0.z; o0[4 * q4 + 3] = t0.w; o1[4 * q4] = t1.x; o1[4 * q4 + 1] = t1.y; o1[4 * q4 + 2] = t1.z; o1[4 * q4 + 3] = t1.w; } }
    o0 = MFMA32(pack_frag(S0, 0), qf0, o0); o0 = MFMA32(pack_frag(S0, 1), qf1, o0);
    o1 = MFMA32(pack_frag(S1, 0), qf0, o1); o1 = MFMA32(pack_frag(S1, 1), qf1, o1);
    float ss = 0.f;
#pragma unroll
    for (int r = 0; r < 16; ++r) ss += o0[r] * o0[r] + o1[r] * o1[r];
    ss += shfl_xor_c<32>(ss);
    const float rstd = rsqrtf(ss * (1.0f / 64.0f) + EPS);
    const size_t row = (size_t)(tok0 + 32 * ib + ql);
#pragma unroll
    for (int vb = 0; vb < 2; ++vb)
#pragma unroll
        for (int q4 = 0; q4 < 4; ++q4) { const int v0 = 32 * vb + 8 * q4 + 4 * hh;
            const f32x4 gn = *(const f32x4*)(a.in[IN_GNORM] + l * 256 + h * 64 + v0); const v2u gr = *(const v2u*)(z + row * ZW + Z_AG + h * 64 + v0);
            const float g0 = bflo(gr.x), g1 = bfhi(gr.x), g2 = bflo(gr.y), g3 = bfhi(gr.y);
            const float y0 = (vb ? o1[4 * q4] : o0[4 * q4]) * rstd * gn.x * silu_f(g0), y1 = (vb ? o1[4 * q4 + 1] : o0[4 * q4 + 1]) * rstd * gn.y * silu_f(g1);
            const float y2 = (vb ? o1[4 * q4 + 2] : o0[4 * q4 + 2]) * rstd * gn.z * silu_f(g2), y3 = (vb ? o1[4 * q4 + 3] : o0[4 * q4 + 3]) * rstd * gn.w * silu_f(g3);
            v2u o; o.x = pk2(y0, y1); o.y = pk2(y2, y3); *(v2u*)(mix + row * D + h * 64 + v0) = o; }
}
__device__ __forceinline__ void gla_scan_phase(const Args& a, int tid, int G, int bid) {
    float* KVT = (float*)(a.ws + WS_GKV); const float* DEC = (const float*)(a.ws + WS_GDEC);
    typedef float f32x2v __attribute__((ext_vector_type(2)));
    for (int u = bid * NTHR + tid; u < 32 * 1024; u += G * NTHR) { const int bh = u >> 10, e0 = (u & 1023) * 2;
        float* kp = KVT + (size_t)bh * 32 * 2048 + e0; const float* dp = DEC + (size_t)bh * 32 * 32 + (e0 & 31);
        f32x2v kv[32], dc[32];
#pragma unroll
        for (int m = 0; m < 32; ++m) { kv[m] = *(const f32x2v*)(kp + (size_t)m * 2048); dc[m] = *(const f32x2v*)(dp + m * 32); }
        f32x2v S = (f32x2v){0.f, 0.f};
#pragma unroll
        for (int m = 0; m < 32; ++m) { *(f32x2v*)(kp + (size_t)m * 2048) = S; S = S * dc[m] + kv[m]; } }
}
constexpr int CW_QUEUE = 8192;
__device__ __forceinline__ void mixers_phase(const Args& a, int l, LAS unsigned char* lds, int tid) {
    dsa2_setup(a, lds, tid);
    float prof[6] = {0.f, 0.f, 0.f, 0.f, 0.f, 0.f};
#ifdef PROF_DSA
    const unsigned long long tph0 = wall_clock64();
#endif
    unsigned* qctr = (unsigned*)(a.ws + WS_CTL) + CW_QUEUE + 64 * l;
    volatile LAS int* qslot = (volatile LAS int*)(lds + MISC_OFF + 64);
    for (;;) {
        if (tid == 0) *qslot = (int)__hip_atomic_fetch_add(qctr, 1u, __ATOMIC_RELAXED, __HIP_MEMORY_SCOPE_AGENT);
        __syncthreads();
        int it = *qslot;
        __syncthreads();
#ifdef REP_MIX
        if (it >= 2304) break;
        if (it >= 1152) it -= 1152;
        if (it < 512) dsa2_setup(a, lds, tid);
#elif defined(REP_DSA)
        if (it >= 1152 + 512) break;
        if (it >= 1152) it -= 1152;
        if (it < 512) dsa2_setup(a, lds, tid);
#else
        if (it >= 1152) break;
#endif
        const int t2 = (tid & ~63) + (int)lane_id_now();
        if (it < 512) dsa2_item(a, it, lds, t2, prof);
        else if (it < 640) sgu2_item(a, l, it - 512, lds, t2);
        else if (it < 896) gla2_a_item(a, l, it - 640, lds, t2);
        else pool2_item(a, l, it - 896, lds, t2);
    }
#ifdef PROF_DSA
    if (tid == 0) { prof[5] = (float)(wall_clock64() - tph0); float* pr = (float*)(a.ws + WS_CTL) + 12288;
#pragma unroll
        for (int k2 = 0; k2 < 6; ++k2) atomicAdd(pr + 2 + k2, prof[k2]); }
#endif
#if defined(PROBE_DSA) && !defined(PROBE_GLA) && !defined(PROBE_SGU) && !defined(PROBE_POOL)
    __syncthreads(); dsa_setup(a, lds, tid);
    for (int it = M - 1 - (int)blockIdx.x; it >= 0; it -= gridDim.x) dsa_item(a, it, lds, tid, (bf16*)(a.ws + WS_QX), 256);
#endif
}
#ifdef PROBE_DSA
__device__ __forceinline__ void probe_dsa_compare(const Args& a, LAS unsigned char* lds, int tid, int col0 = 512) {
    const bf16* mix = (const bf16*)(a.ws + WS_MIX); const bf16* alt = (const bf16*)(a.ws + WS_QX); float d2 = 0.f, r2 = 0.f;
    for (size_t i = (size_t)blockIdx.x * NTHR + tid; i < (size_t)M * 256; i += (size_t)gridDim.x * NTHR) { const size_t row = i >> 8, c = i & 255; const float x = bf1(mix[row * D + col0 + c]), y = bf1(alt[i]); d2 += (x - y) * (x - y); r2 += y * y; }
    d2 = wave_sum(d2); r2 = wave_sum(r2);
    if ((tid & 63) == 0) { atomicAdd((float*)(a.ws + WS_CTL) + 12288, d2); atomicAdd((float*)(a.ws + WS_CTL) + 12289, r2); }
}
#endif

__device__ __forceinline__ unsigned long long uniform_u64(unsigned long long v) { const unsigned lo = __builtin_amdgcn_readfirstlane((unsigned)v), hi = __builtin_amdgcn_readfirstlane((unsigned)(v >> 32)); return ((unsigned long long)hi << 32) | lo; }
__device__ __forceinline__ void load_args(Args& la, LAS unsigned char* lds) {
    const LAS unsigned long long* p = (const LAS unsigned long long*)(lds + ARGS_OFF);
#pragma unroll
    for (int i = 0; i < N_IN; ++i) la.in[i] = (const float*)(const GAS float*)uniform_u64(p[i]);
    la.out = (float*)(GAS float*)uniform_u64(p[N_IN]); la.ws = (unsigned char*)(GAS unsigned char*)uniform_u64(p[N_IN + 1]);
}
constexpr int NPHASE = 28;
#define REPEAT_BEGIN(flag) { int nrep_ = (flag) ? 2 : 1; asm volatile("" : "+s"(nrep_)); _Pragma("unroll 1") for (int rep_ = 0; rep_ < nrep_; ++rep_) {
#define REPEAT_END() } }
#ifndef REP_Z
#define REP_Z 0
#endif
#ifndef REP_Q
#define REP_Q 0
#endif
#ifndef REP_FUP
#define REP_FUP 0
#endif
#ifndef REP_MUP
#define REP_MUP 0
#endif
#ifndef REP_MDN
#define REP_MDN 0
#endif
#define OTID() const int tid = wave_id * 64 + (int)lane_id_now(); Args la; load_args(la, lds)
__global__ void __launch_bounds__(NTHR, 2) fwd_kernel(Args a) {
    extern __shared__ __attribute__((aligned(16))) unsigned char lds_raw[];
    LAS unsigned char* lds = (LAS unsigned char*)lds_raw;
    const int G0 = gridDim.x, bid0 = blockIdx.x, wave_id = __builtin_amdgcn_readfirstlane(threadIdx.x >> 6); const int G = G0, bid = bid0;
    volatile LAS unsigned* MISC = (volatile LAS unsigned*)(lds + MISC_OFF);
    if (threadIdx.x < 32) MISC[threadIdx.x] = 0u;
    if (threadIdx.x < N_IN + 2) {
        const __attribute__((address_space(4))) unsigned long long* ka = (const __attribute__((address_space(4))) unsigned long long*)__builtin_amdgcn_kernarg_segment_ptr();
        ((LAS unsigned long long*)(lds + ARGS_OFF))[threadIdx.x] = ka[threadIdx.x]; }
    __syncthreads();
    unsigned char* ws0 = a.ws; unsigned char* ws = ws0;
#define PH() GAS unsigned char* wsg_ = (GAS unsigned char*)ws0; asm volatile("" : "+s"(wsg_)); unsigned char* ws = (unsigned char*)wsg_; int G = G0, bid = bid0; asm volatile("" : "+s"(G), "+s"(bid))
    XcdBarrier bar; bar.bar = (unsigned*)(ws + WS_CTL) + CW_BAR; bar.x = 0; bar.st = nullptr; bar.wid = (unsigned)wave_id;
    if (N_LAUNCH_MODE == 1) bar = xcd_barrier_post((unsigned*)(ws + WS_CTL) + CW_BAR, MISC + 8);
    const int lo = a.ph_lo, hi = a.ph_hi;
#if defined(PROBE_GLA) || defined(PROBE_SGU) || defined(PROBE_POOL)
#define RUN(k) ((k) <= 3 && lo <= (k) && (k) < hi)
#else
#define RUN(k) (lo <= (k) && (k) < hi)
#endif
#define SEAM() do { if (N_LAUNCH_MODE == 1) xcd_barrier(bar); } while (0)
#define WB(off) ((bf16*)(ws + (off)))
#define WF(off) ((float*)(ws + (off)))
#ifdef REP_PRO
    if (RUN(0)) { PH(); int nrep = 2; asm volatile("" : "+s"(nrep));
#pragma unroll 1
        for (int rep = 0; rep < nrep; ++rep) { OTID(); p0_prologue(la, lds, tid, G); } SEAM(); }
#else
    if (RUN(0)) { PH(); OTID(); p0_prologue(la, lds, tid, G); SEAM(); }
#ifdef REP_BAR
    { int nb_ = 20; asm volatile("" : "+s"(nb_));
#pragma unroll 1
      for (int i_ = 0; i_ < nb_; ++i_) SEAM(); }
#endif
#endif

    { constexpr int l = 0;
        const int pb = l ? 10 : 1;
        if (RUN(pb + 0)) { PH();
            REPEAT_BEGIN(REP_Z)
            { pg8::Gemm g{WB(WS_H16), WB(WS_WIN + l * SZ_WIN), M, ZW, D}; pg8::StaticOrder S; S.init(M, ZW, G, bid);
              EpiScale E{WB(WS_Z), ZW, WF(WS_SS), 1.0f, WB(WS_DKF), Z_CK / 256}; pg8::gemm_phase<EpiScale, pg8::StaticOrder, true, true>(lds, g, S, E, wave_id); }
            REPEAT_END()
            if (l == 0) {
                for (int l2 = 0; l2 < 2; ++l2) {
                    pg8::Gemm g{WB(WS_MEMB), WB(WS_WKV + l2 * SZ_WKV), MM, 512, D}; pg8::StaticOrder S; S.init(MM, 512, G, (G - 1 - bid - 16 * l2 + 2 * G) % G);
                    EpiScale E{WB(WS_KVM + l2 * SZ_KVM), 512, WF(WS_SSM), 1.0f, nullptr, 0}; pg8::gemm_phase<EpiScale, pg8::StaticOrder, true, true>(lds, g, S, E, wave_id); }
            }
            SEAM();
        }
        if (RUN(pb + 1)) { PH();
            { OTID(); mixers_phase(la, l, lds, tid); }
#if defined(PROBE_SGU) || defined(PROBE_POOL)
            SEAM();
            { constexpr int PCOL =
#ifdef PROBE_SGU
                768;
#else
                256;
#endif
              bf16* mixp = WB(WS_MIX); bf16* alt = WB(WS_QX);
              for (size_t i = (size_t)bid * NTHR + threadIdx.x; i < (size_t)M * 256; i += (size_t)G * NTHR) alt[i] = mixp[(i >> 8) * D + PCOL + (i & 255)];
              SEAM();
#ifdef PROBE_SGU
              { OTID(); for (int it = bid; it < 512; it += G) sgu_item(la, l, it, lds, tid); }
#else
              { OTID(); for (int it = bid; it < 1024; it += G) pool_item(la, l, it, lds, tid); }
#endif
              SEAM();
              { OTID(); probe_dsa_compare(la, lds, tid, PCOL); }
              SEAM();
              { const float* pr = (const float*)(ws + WS_CTL) + 12288; const float padd = PROBE_C * sqrtf(pr[0] / fmaxf(pr[1], 1e-30f));
                for (size_t i = (size_t)bid * NTHR + threadIdx.x; i < (size_t)M * D; i += (size_t)G * NTHR) la.out[i] = padd; return; } }
#endif
            SEAM();
        }
#ifdef REP_GLAC
        if (RUN(pb + 2)) { PH(); OTID(); int nit = 512; asm volatile("" : "+s"(nit)); for (int it = bid; it < nit; it += G) gla2_c_item(la, l, it & 255, lds, tid);
#else
        if (RUN(pb + 2)) { PH(); OTID(); if (l == 0) frag_phase(la, tid, G, bid); gla_scan_phase(la, tid, G, bid); SEAM(); for (int it = bid; it < 256; it += G) gla2_c_item(la, l, it, lds, tid);
#endif
#if defined(PROBE_DSA) && !defined(PROBE_GLA) && !defined(PROBE_SGU) && !defined(PROBE_POOL)
            probe_dsa_compare(la, lds, tid);
#endif
            SEAM();
#ifdef PROBE_GLA
            { bf16* mixp = WB(WS_MIX); bf16* alt = WB(WS_QX);
              for (size_t i = (size_t)bid * NTHR + threadIdx.x; i < (size_t)M * 256; i += (size_t)G * NTHR) alt[i] = mixp[(i >> 8) * D + (i & 255)];
              SEAM();
              { OTID(); for (int it = bid; it < 1024; it += G) gla_a_item(la, l, it, lds, tid); }
              SEAM();
              { OTID(); for (int it = bid; it < 1024; it += G) gla_c_item(la, l, it, lds, tid); }
              SEAM();
              { OTID(); probe_dsa_compare(la, lds, tid, 0); }
              SEAM();
              { const float* pr = (const float*)(ws + WS_CTL) + 12288; const float padd = PROBE_C * sqrtf(pr[0] / fmaxf(pr[1], 1e-30f));
                for (size_t i = (size_t)bid * NTHR + threadIdx.x; i < (size_t)M * D; i += (size_t)G * NTHR) la.out[i] = padd; return; } }
#endif
            }
        if (RUN(pb + 3)) { PH();
            pg8::Gemm g{WB(WS_MIX), WB(WS_WOUT + l * SZ_WOUT), M, D, D}; pg8::StaticOrder S; S.init(M, D, G, bid);
            EpiResid E{WB(WS_H16), WF(WS_SS)}; pg8::gemm_phase<EpiResid, pg8::StaticOrder, true, true>(lds, g, S, E, wave_id); SEAM();
        }
        if (RUN(pb + 4)) { PH(); OTID(); for (int it = bid; it < 256; it += G) { const int t2 = (tid & ~63) + (int)lane_id_now(); xfuse_item(la, l, it, lds, t2); } SEAM(); }
        if (l == 0) {
            if (RUN(8)) { PH();
                REPEAT_BEGIN(REP_FUP)
                pg8::Gemm g{WB(WS_H16), WB(WS_W13), M, 2 * DFF, D}; pg8::StaticOrder S; S.init(M, 2 * DFF, G, bid);
                EpiSwiglu<false> E{WB(WS_FACT), DFF, WF(WS_SS), nullptr, nullptr}; pg8::gemm_phase<EpiSwiglu<false>, pg8::StaticOrder, true, true>(lds, g, S, E, wave_id);
                REPEAT_END()
                    SEAM();
            }
            if (RUN(9)) { PH();
                pg8::Gemm g{WB(WS_FACT), WB(WS_W2), M, D, DFF}; pg8::StaticOrder S; S.init(M, D, G, bid);
                EpiResid E{WB(WS_H16), WF(WS_SS)}; pg8::gemm_phase<EpiResid, pg8::StaticOrder, true, true>(lds, g, S, E, wave_id); SEAM();
            }
        } else {
#ifdef REP_R1
            if (RUN(17)) { PH(); OTID(); moe_route(la, lds, tid, G, bid); __syncthreads(); moe_route(la, lds, tid, G, bid); SEAM(); }
#else
            if (RUN(17)) { PH(); OTID(); moe_route(la, lds, tid, G, bid); SEAM(); }
#endif
#ifdef REP_ROUTE
            if (RUN(18)) { PH(); int nrep = 2; asm volatile("" : "+s"(nrep));
#pragma unroll 1
                for (int rep = 0; rep < nrep; ++rep) { OTID(); moe_assign(la, lds, tid, G, bid); __syncthreads(); } SEAM(); }
#else
            if (RUN(18)) { PH(); OTID(); moe_assign(la, lds, tid, G, bid); SEAM(); }
#endif
            for (int ph = 0; ph <= MOE_NPASS; ++ph) {
                const int* TILEE = (const int*)(ws + WS_TILEE);
                if (RUN(19 + ph)) { PH();
                    const int NT = TILEE[159]; int ndown = 0, ndsh = 3;
                    if (ph > 0) { const int p = ph - 1; const int nt = moe_pass_nt(NT, p); ndown = nt * (D / 256); if (ndown > G) { ndown -= G; ndsh = 3; if (ndown > G) ndown = G; }
                        REPEAT_BEGIN(REP_MDN)
                        pg8::Gemm g{WB(WS_MACT + (p & 1) * SZ_MACT), WB(WS_MW2), MOE_TP * 256, NEXP * D, DFE, (const int*)(ws + WS_IDMAP)}; pg8::MoeOrder S{p * MOE_TS, nt, D / 256, G, bid, 1, TILEE, 0, 0};
                        EpiPlain E{WB(WS_YS), D};
                        pg8::gemm_phase<EpiPlain, pg8::MoeOrder, true, true, true, 1>(lds, g, S, E, wave_id);
                        REPEAT_END() }
                    if (ph < MOE_NPASS) { const int p = ph; const int nt = moe_pass_nt(NT, p);
                        REPEAT_BEGIN(REP_MUP)
                        pg8::Gemm g{WB(WS_HB8), WB(WS_MW13), M, NEXP * 2 * DFE, D, (const int*)(ws + WS_SLOTT)}; pg8::MoeOrder S{p * MOE_TS, nt, 2 * DFE / 256, G, bid, 0, TILEE, ndown, ndsh};
                        EpiSwiglu<true> E{WB(WS_MACT + (p & 1) * SZ_MACT), DFE, nullptr, WF(WS_SLOTR), WF(WS_SLOTG)};
                        pg8::gemm_phase<EpiSwiglu<true>, pg8::MoeOrder, true, true, true, 1>(lds, g, S, E, wave_id);
                        REPEAT_END() }
                    SEAM();
                }
            }
#ifdef REP_FINAL
            if (RUN(27)) { PH(); OTID(); final_phase(la, tid, G, bid); }
#else
            if (RUN(27)) { PH(); OTID(); final_phase(la, tid, G, bid); }
#endif
        }
        }
    { constexpr int l = 1;
        const int pb = l ? 10 : 1;
        if (RUN(pb + 0)) { PH();
            REPEAT_BEGIN(REP_Z)
            { pg8::Gemm g{WB(WS_H16), WB(WS_WIN + l * SZ_WIN), M, ZW, D}; pg8::StaticOrder S; S.init(M, ZW, G, bid);
              EpiScale E{WB(WS_Z), ZW, WF(WS_SS), 1.0f, WB(WS_DKF), Z_CK / 256}; pg8::gemm_phase<EpiScale, pg8::StaticOrder, true, true>(lds, g, S, E, wave_id); }
            REPEAT_END()
            if (l == 0) {
                for (int l2 = 0; l2 < 2; ++l2) {
                    pg8::Gemm g{WB(WS_MEMB), WB(WS_WKV + l2 * SZ_WKV), MM, 512, D}; pg8::StaticOrder S; S.init(MM, 512, G, (G - 1 - bid - 16 * l2 + 2 * G) % G);
                    EpiScale E{WB(WS_KVM + l2 * SZ_KVM), 512, WF(WS_SSM), 1.0f, nullptr, 0}; pg8::gemm_phase<EpiScale, pg8::StaticOrder, true, true>(lds, g, S, E, wave_id); }
            }
            SEAM();
        }
        if (RUN(pb + 1)) { PH();
            { OTID(); mixers_phase(la, l, lds, tid); }
#if defined(PROBE_SGU) || defined(PROBE_POOL)
            SEAM();
            { constexpr int PCOL =
#ifdef PROBE_SGU
                768;
#else
                256;
#endif
              bf16* mixp = WB(WS_MIX); bf16* alt = WB(WS_QX);
              for (size_t i = (size_t)bid * NTHR + threadIdx.x; i < (size_t)M * 256; i += (size_t)G * NTHR) alt[i] = mixp[(i >> 8) * D + PCOL + (i & 255)];
              SEAM();
#ifdef PROBE_SGU
              { OTID(); for (int it = bid; it < 512; it += G) sgu_item(la, l, it, lds, tid); }
#else
              { OTID(); for (int it = bid; it < 1024; it += G) pool_item(la, l, it, lds, tid); }
#endif
              SEAM();
              { OTID(); probe_dsa_compare(la, lds, tid, PCOL); }
              SEAM();
              { const float* pr = (const float*)(ws + WS_CTL) + 12288; const float padd = PROBE_C * sqrtf(pr[0] / fmaxf(pr[1], 1e-30f));
                for (size_t i = (size_t)bid * NTHR + threadIdx.x; i < (size_t)M * D; i += (size_t)G * NTHR) la.out[i] = padd; return; } }
#endif
            SEAM();
        }
#ifdef REP_GLAC
        if (RUN(pb + 2)) { PH(); OTID(); int nit = 512; asm volatile("" : "+s"(nit)); for (int it = bid; it < nit; it += G) gla2_c_item(la, l, it & 255, lds, tid);
#else
        if (RUN(pb + 2)) { PH(); OTID(); if (l == 0) frag_phase(la, tid, G, bid); gla_scan_phase(la, tid, G, bid); SEAM(); for (int it = bid; it < 256; it += G) gla2_c_item(la, l, it, lds, tid);
#endif
#if defined(PROBE_DSA) && !defined(PROBE_GLA) && !defined(PROBE_SGU) && !defined(PROBE_POOL)
            probe_dsa_compare(la, lds, tid);
#endif
            SEAM();
#ifdef PROBE_GLA
            { bf16* mixp = WB(WS_MIX); bf16* alt = WB(WS_QX);
              for (size_t i = (size_t)bid * NTHR + threadIdx.x; i < (size_t)M * 256; i += (size_t)G * NTHR) alt[i] = mixp[(i >> 8) * D + (i & 255)];
              SEAM();
              { OTID(); for (int it = bid; it < 1024; it += G) gla_a_item(la, l, it, lds, tid); }
              SEAM();
              { OTID(); for (int it = bid; it < 1024; it += G) gla_c_item(la, l, it, lds, tid); }
              SEAM();
              { OTID(); probe_dsa_compare(la, lds, tid, 0); }
              SEAM();
              { const float* pr = (const float*)(ws + WS_CTL) + 12288; const float padd = PROBE_C * sqrtf(pr[0] / fmaxf(pr[1], 1e-30f));
                for (size_t i = (size_t)bid * NTHR + threadIdx.x; i < (size_t)M * D; i += (size_t)G * NTHR) la.out[i] = padd; return; } }
#endif
            }
        if (RUN(pb + 3)) { PH();
            pg8::Gemm g{WB(WS_MIX), WB(WS_WOUT + l * SZ_WOUT), M, D, D}; pg8::StaticOrder S; S.init(M, D, G, bid);
            EpiResid E{WB(WS_H16), WF(WS_SS)}; pg8::gemm_phase<EpiResid, pg8::StaticOrder, true, true>(lds, g, S, E, wave_id); SEAM();
        }
        if (RUN(pb + 4)) { PH(); OTID(); for (int it = bid; it < 256; it += G) { const int t2 = (tid & ~63) + (int)lane_id_now(); xfuse_item(la, l, it, lds, t2); } SEAM(); }
        if (l == 0) {
            if (RUN(8)) { PH();
                REPEAT_BEGIN(REP_FUP)
                pg8::Gemm g{WB(WS_H16), WB(WS_W13), M, 2 * DFF, D}; pg8::StaticOrder S; S.init(M, 2 * DFF, G, bid);
                EpiSwiglu<false> E{WB(WS_FACT), DFF, WF(WS_SS), nullptr, nullptr}; pg8::gemm_phase<EpiSwiglu<false>, pg8::StaticOrder, true, true>(lds, g, S, E, wave_id);
                REPEAT_END()
                    SEAM();
            }
            if (RUN(9)) { PH();
                pg8::Gemm g{WB(WS_FACT), WB(WS_W2), M, D, DFF}; pg8::StaticOrder S; S.init(M, D, G, bid);
                EpiResid E{WB(WS_H16), WF(WS_SS)}; pg8::gemm_phase<EpiResid, pg8::StaticOrder, true, true>(lds, g, S, E, wave_id); SEAM();
            }
        } else {
#ifdef REP_R1
            if (RUN(17)) { PH(); OTID(); moe_route(la, lds, tid, G, bid); __syncthreads(); moe_route(la, lds, tid, G, bid); SEAM(); }
#else
            if (RUN(17)) { PH(); OTID(); moe_route(la, lds, tid, G, bid); SEAM(); }
#endif
#ifdef REP_ROUTE
            if (RUN(18)) { PH(); int nrep = 2; asm volatile("" : "+s"(nrep));
#pragma unroll 1
                for (int rep = 0; rep < nrep; ++rep) { OTID(); moe_assign(la, lds, tid, G, bid); __syncthreads(); } SEAM(); }
#else
            if (RUN(18)) { PH(); OTID(); moe_assign(la, lds, tid, G, bid); SEAM(); }
#endif
            for (int ph = 0; ph <= MOE_NPASS; ++ph) {
                const int* TILEE = (const int*)(ws + WS_TILEE);
                if (RUN(19 + ph)) { PH();
                    const int NT = TILEE[159]; int ndown = 0, ndsh = 3;
                    if (ph > 0) { const int p = ph - 1; const int nt = moe_pass_nt(NT, p); ndown = nt * (D / 256); if (ndown > G) { ndown -= G; ndsh = 3; if (ndown > G) ndown = G; }
                        REPEAT_BEGIN(REP_MDN)
                        pg8::Gemm g{WB(WS_MACT + (p & 1) * SZ_MACT), WB(WS_MW2), MOE_TP * 256, NEXP * D, DFE, (const int*)(ws + WS_IDMAP)}; pg8::MoeOrder S{p * MOE_TS, nt, D / 256, G, bid, 1, TILEE, 0, 0};
                        EpiPlain E{WB(WS_YS), D};
                        pg8::gemm_phase<EpiPlain, pg8::MoeOrder, true, true, true, 1>(lds, g, S, E, wave_id);
                        REPEAT_END() }
                    if (ph < MOE_NPASS) { const int p = ph; const int nt = moe_pass_nt(NT, p);
                        REPEAT_BEGIN(REP_MUP)
                        pg8::Gemm g{WB(WS_HB8), WB(WS_MW13), M, NEXP * 2 * DFE, D, (const int*)(ws + WS_SLOTT)}; pg8::MoeOrder S{p * MOE_TS, nt, 2 * DFE / 256, G, bid, 0, TILEE, ndown, ndsh};
                        EpiSwiglu<true> E{WB(WS_MACT + (p & 1) * SZ_MACT), DFE, nullptr, WF(WS_SLOTR), WF(WS_SLOTG)};
                        pg8::gemm_phase<EpiSwiglu<true>, pg8::MoeOrder, true, true, true, 1>(lds, g, S, E, wave_id);
                        REPEAT_END() }
                    SEAM();
                }
            }
#ifdef REP_FINAL
            if (RUN(27)) { PH(); OTID(); final_phase(la, tid, G, bid); }
#else
            if (RUN(27)) { PH(); OTID(); final_phase(la, tid, G, bid); }
#endif
        }
        }
#undef RUN
#undef SEAM
}

extern "C" void kernel_launch(void* const* d_in, const int* in_sizes, int n_in, void* d_out, int out_size, void* d_ws, size_t ws_size, hipStream_t stream) {
    static int grid = 0;
    if (grid == 0) {
        if (n_in != N_IN || out_size != M * D || ws_size < WS_END) { fprintf(stderr, "kernel_launch: unexpected problem (n_in %d, out %d, ws %zu < %zu)\n", n_in, out_size, ws_size, (size_t)WS_END); grid = -1; return; }
        int dev = 0, cus = 0, per_cu = 0;
        if (hipGetDevice(&dev) != hipSuccess || hipDeviceGetAttribute(&cus, hipDeviceAttributeMultiprocessorCount, dev) != hipSuccess) { grid = -1; return; }
        if (hipFuncSetAttribute((const void*)fwd_kernel, hipFuncAttributeMaxDynamicSharedMemorySize, LDS_BYTES) != hipSuccess) { fprintf(stderr, "kernel_launch: hipFuncSetAttribute failed\n"); grid = -1; return; }
        if (hipOccupancyMaxActiveBlocksPerMultiprocessor(&per_cu, (const void*)fwd_kernel, NTHR, LDS_BYTES) != hipSuccess || per_cu < 1) { fprintf(stderr, "kernel_launch: occupancy query says %d\n", per_cu); }
        (void)hipGetLastError();
        grid = (cus > 0 && cus < 256) ? cus : 256;
    }
    if (grid < 0) return;
    (void)hipMemsetAsync((char*)d_ws + WS_CTL, 0, CTL_ZERO_BYTES, stream);
    Args a{};
    for (int i = 0; i < N_IN; ++i) a.in[i] = (const float*)d_in[i];
    a.out = (float*)d_out; a.ws = (unsigned char*)d_ws;
#if N_LAUNCH_MODE == 1
    a.ph_lo = 0; a.ph_hi = NPHASE;
    hipLaunchKernelGGL(fwd_kernel, dim3(grid), dim3(NTHR), LDS_BYTES, stream, a);
#else
    for (int p = 0; p < NPHASE; ++p) { a.ph_lo = p; a.ph_hi = p + 1; hipLaunchKernelGGL(fwd_kernel, dim3(grid), dim3(NTHR), LDS_BYTES, stream, a); }
#endif
}
```

```cpp
#include <hip/hip_runtime.h>
#include <cstdio>
#include <cstdint>
#include <cmath>

#ifndef N_LAUNCH_MODE
#define N_LAUNCH_MODE 1
#endif

namespace pg8 {
#define PG8_LAS __attribute__((address_space(3)))
typedef unsigned short bf16_t;
typedef short bf16x8 __attribute__((ext_vector_type(8)));
typedef float f32x4 __attribute__((ext_vector_type(4)));
typedef unsigned u32x4 __attribute__((ext_vector_type(4)));
constexpr int BM = 256, BK = 64, HALF = 128, HTB = HALF * BK * 2  , STAGE_BYTES = 8 * HTB, NXCD = 8, WGM = 8;

__host__ __device__ __forceinline__ int lds_byte(int r, int c) { const int st = (r >> 4) * 2 + (c >> 5), rr = r & 15, cc = c & 31, ob = rr * 64 + cc * 2; return st * 1024 + (ob ^ (((ob >> 9) & 1) << 5)); }
__host__ __device__ __forceinline__ void stage_rc(int b, int& R, int& C) { const int st = b / 1024, sb = b % 1024, swz = sb ^ (((sb >> 9) & 1) << 5); R = (st >> 1) * 16 + swz / 64; C = (st & 1) * 32 + (swz % 64) / 2; }
__host__ __device__ __forceinline__ int perm32(int rho) { const int n = rho >> 4, i = rho & 15; return 8 * (i >> 2) + 4 * n + (i & 3); }

struct Unit { int pm, pn, po, e; };
struct Gemm { const bf16_t* A; const bf16_t* Bt; int M, N, K; const int* rowmap; };

struct StaticOrder {
    int nM, nN, nwg, G, c;
    __host__ __device__ void init(int M, int N, int G_, int c_) { nM = M / BM; nN = N / BM; nwg = nM * nN; G = G_; c = c_; }
    __host__ __device__ bool next(int i, Unit& u) const {
        const long L = (long)i * G + c; if (L >= nwg) return false;
        int wgid = (int)L; { const int q = nwg / NXCD, r = nwg % NXCD, xcd = wgid % NXCD, off = wgid / NXCD; wgid = (xcd < r ? xcd * (q + 1) : r * (q + 1) + (xcd - r) * q) + off; }
        const int nig = WGM * nN, gid = wgid / nig, fm = gid * WGM, gsz = (nM - fm) < WGM ? (nM - fm) : WGM;
        u.pm = fm + ((wgid % nig) % gsz); u.pn = (wgid % nig) / gsz; u.po = u.pm; u.e = u.pn; return true;
    }
    __device__ __forceinline__ void a_ready(const Unit&) const {}
    __device__ __forceinline__ void done(const Unit&) const {}
};
struct MoeOrder {
    int t0, nt, nNe, G, c, a_local; const int* tile_e; int nd, sh;
    __device__ bool next(int i, Unit& u) const {
        const int F = G - nd; long L;
        if (c >= nd) L = (i < sh) ? (long)i * F + (c - nd) : (long)sh * F + (long)(i - sh) * G + c; else L = (long)sh * F + (long)i * G + c;
        if (L >= (long)nt * nNe) return false;
        const int tl = (int)(L % nt), pn = (int)(L / nt), tile = t0 + tl, e = tile_e[tile];
        u.pm = a_local ? tl : tile; u.po = a_local ? tile : tl; u.pn = e * nNe + pn; u.e = pn; return true;
    }
    __device__ __forceinline__ void a_ready(const Unit&) const {}
    __device__ __forceinline__ void done(const Unit&) const {}
};
__device__ __forceinline__ unsigned cvt_pk_bf16(float lo, float hi) { unsigned r; asm volatile("v_cvt_pk_bf16_f32 %0, %1, %2" : "=v"(r) : "v"(lo), "v"(hi)); return r; }
template <class Epi, class Sched, bool ALIGN_EPI = false, bool SP2 = false, bool GATHER = false, int ES = 2>
__device__ __forceinline__ void gemm_phase(PG8_LAS unsigned char* lds, const Gemm g, const Sched& S, const Epi& E, int wave_id) {
    unsigned lane_; asm volatile("v_mbcnt_lo_u32_b32 %0, -1, 0\n\tv_mbcnt_hi_u32_b32 %0, -1, %0" : "=v"(lane_)); const int tid_ = wave_id * 64 + (int)lane_; const int tid = tid_, wid = __builtin_amdgcn_readfirstlane(tid >> 6), lane = tid & 63, wr = wid >> 2, wc = wid & 3, fr = lane & 15, fq = lane >> 4;
    static_assert(!GATHER || SP2, "gather staging is written for the two-super-phase loop");
    const int K = g.K, nt = (K * ES) / (BK * 2);
    unsigned voffA[2], voffB[2];
#pragma unroll
    for (int i = 0; i < 2; ++i) { int R, C; stage_rc(tid * 16 + i * 8192, R, C); const int Rb = Epi::PERM ? ((R & ~31) + perm32(R & 31)) : R;
        voffA[i] = (unsigned)(R * K * ES + C * 2); voffB[i] = (unsigned)(Rb * K * ES + C * 2); }
    unsigned vgC[2][2], vgN[2][2];
#define PG8_GOFF(dst, pm_) do { if constexpr (GATHER) { _Pragma("unroll") for (int _h = 0; _h < 2; ++_h) _Pragma("unroll") for (int _i = 0; _i < 2; ++_i) \
        { int _R, _C; stage_rc(tid * 16 + _i * 8192, _R, _C); dst[_h][_i] = (unsigned)g.rowmap[(pm_) * BM + _h * HALF + _R] * (unsigned)(K * ES) + (unsigned)_C * 2u; } } } while (0)
    const size_t kstep = (size_t)(BK * 2);
    const size_t hstep = (size_t)HALF * K * ES;
    const size_t tstep = 2 * hstep;
    const unsigned ldsw = (unsigned)wid * 1024u;
    const int aoff = ES == 2 ? lds_byte(wr * 64 + fr, fq * 8) : lds_byte(wr * 64 + fr, fq * 16), boff = ES == 2 ? lds_byte(wc * 32 + fr, fq * 8) : lds_byte(wc * 32 + fr, fq * 16);
    const int aoff2 = ES == 2 ? aoff + 1024 : lds_byte(wr * 64 + fr, fq * 16 + 8), boff2 = ES == 2 ? boff + 1024 : lds_byte(wc * 32 + fr, fq * 16 + 8);
#define PG8_SA(b, h) (((b) * 2 + (h)) * HTB)
#define PG8_SB(b, h) ((4 + (b) * 2 + (h)) * HTB)
#define PG8_STAGE_A(b, h, gbase, vg) do { if constexpr (GATHER) { PG8_STAGE(PG8_SA(b, h), gbase, vg[h]); } else { PG8_STAGE(PG8_SA(b, h), (gbase) + (h) * hstep, voffA); } } while (0)
#define PG8_STAGE(bufoff, gbase, voff) do { _Pragma("unroll") for (int _i = 0; _i < 2; ++_i) \
        __builtin_amdgcn_global_load_lds((const unsigned*)((const char*)(gbase) + (voff)[_i]), (PG8_LAS unsigned*)(lds + (bufoff) + ldsw + _i * 8192), 16, 0, 0); } while (0)
#define PG8_LDA(dst, b, h) do { _Pragma("unroll") for (int m = 0; m < 4; ++m) _Pragma("unroll") for (int k = 0; k < 2; ++k) dst[m][k] = *(const PG8_LAS bf16x8*)(lds + PG8_SA(b, h) + (k ? aoff2 : aoff) + m * 2048); } while (0)
#define PG8_LDB(dst, b, h) do { _Pragma("unroll") for (int n = 0; n < 2; ++n) _Pragma("unroll") for (int k = 0; k < 2; ++k) dst[n][k] = *(const PG8_LAS bf16x8*)(lds + PG8_SB(b, h) + (k ? boff2 : boff) + n * 2048); } while (0)
#define PG8_MMA(ai, bj, At, Bt) do { __builtin_amdgcn_s_setprio(1); _Pragma("unroll") for (int m = 0; m < 4; ++m) _Pragma("unroll") for (int n = 0; n < 2; ++n) { \
        if constexpr (ES == 2) { _Pragma("unroll") for (int k = 0; k < 2; ++k) acc[ai][bj][m][n] = __builtin_amdgcn_mfma_f32_16x16x32_bf16(Bt[n][k], At[m][k], acc[ai][bj][m][n], 0, 0, 0); } \
        else { const i32x4_ bl_ = __builtin_bit_cast(i32x4_, Bt[n][0]), bh_ = __builtin_bit_cast(i32x4_, Bt[n][1]), al_ = __builtin_bit_cast(i32x4_, At[m][0]), ah_ = __builtin_bit_cast(i32x4_, At[m][1]); \
               acc[ai][bj][m][n] = __builtin_amdgcn_mfma_scale_f32_16x16x128_f8f6f4(__builtin_shufflevector(bl_, bh_, 0, 1, 2, 3, 4, 5, 6, 7), __builtin_shufflevector(al_, ah_, 0, 1, 2, 3, 4, 5, 6, 7), \
                                                                                     acc[ai][bj][m][n], 0, 0, 0, 0x7f7f7f7f, 0, 0x7f7f7f7f); } } \
        __builtin_amdgcn_s_setprio(0); } while (0)
#define PG8_WAIT_V(n) asm volatile("s_waitcnt vmcnt(" #n ")" ::: "memory")
#define PG8_WAIT_L(n) asm volatile("s_waitcnt lgkmcnt(" #n ")" ::: "memory")
#define PG8_BAR __builtin_amdgcn_s_barrier()
#define PG8_SCHED __builtin_amdgcn_sched_barrier(0)
    Unit cur, nxt; int ui = 0;
    if (!S.next(0, cur)) return;
    f32x4 acc[2][2][4][2];
#pragma unroll
    for (int a = 0; a < 2; ++a)
#pragma unroll
        for (int b = 0; b < 2; ++b)
#pragma unroll
            for (int m = 0; m < 4; ++m)
#pragma unroll
                for (int n = 0; n < 2; ++n) acc[a][b][m][n] = (f32x4){0.f, 0.f, 0.f, 0.f};
    typedef int i32x4_ __attribute__((ext_vector_type(4))); typedef int i32x8_ __attribute__((ext_vector_type(8)));
    bf16x8 At[4][2], B0[2][2], B1[2][2];
    const char* cA = (const char*)g.A + (GATHER ? (size_t)0 : (size_t)cur.pm * tstep); const char* cB = (const char*)g.Bt + (size_t)cur.pn * tstep;
    PG8_GOFF(vgC, cur.pm);
    S.a_ready(cur);
    if constexpr (SP2) {
        PG8_STAGE(PG8_SB(0, 0), cB, voffB); PG8_STAGE(PG8_SB(0, 1), cB + hstep, voffB); PG8_STAGE_A(0, 0, cA, vgC); PG8_STAGE_A(0, 1, cA, vgC);
        if (wr == 1) PG8_BAR;
        PG8_WAIT_V(2); PG8_BAR;
        PG8_STAGE(PG8_SB(1, 0), cB + kstep, voffB); PG8_STAGE_A(1, 0, cA + kstep, vgC); PG8_STAGE(PG8_SB(1, 1), cB + hstep + kstep, voffB);
        PG8_WAIT_V(6); PG8_BAR;
    } else {
        PG8_STAGE(PG8_SB(0, 0), cB, voffB); PG8_STAGE(PG8_SA(0, 0), cA, voffA); PG8_STAGE(PG8_SB(0, 1), cB + hstep, voffB); PG8_STAGE(PG8_SA(0, 1), cA + hstep, voffA);
        if (wr == 1) PG8_BAR;
        PG8_WAIT_V(4); PG8_BAR;
        PG8_STAGE(PG8_SB(1, 0), cB + kstep, voffB); PG8_STAGE(PG8_SA(1, 0), cA + kstep, voffA); PG8_STAGE(PG8_SB(1, 1), cB + hstep + kstep, voffB);
        PG8_WAIT_V(6); PG8_BAR;
    }
    for (;;) {
        const bool has_next = S.next(ui + 1, nxt);
        const char* nA = (has_next && !GATHER) ? (const char*)g.A + (size_t)nxt.pm * tstep : cA; const char* nB = has_next ? (const char*)g.Bt + (size_t)nxt.pn * tstep : cB;
        if constexpr (GATHER) { if (has_next) { PG8_GOFF(vgN, nxt.pm); } else { _Pragma("unroll") for (int _h = 0; _h < 2; ++_h) _Pragma("unroll") for (int _i = 0; _i < 2; ++_i) vgN[_h][_i] = vgC[_h][_i]; } }
#pragma unroll 1
        for (int t = 0; t < nt; t += 2) {
            const bool last = (t == nt - 2);
            const char* a1 = cA + (size_t)(t + 1) * kstep;
            const char* a2 = last ? nA : cA + (size_t)(t + 2) * kstep; const char* b2 = last ? nB : cB + (size_t)(t + 2) * kstep;
            const char* a3 = a2 + kstep; const char* b3 = b2 + kstep;
            if (last && has_next) S.a_ready(nxt);
            if constexpr (SP2) {
            PG8_LDB(B0, 0, 0); PG8_LDB(B1, 0, 1); PG8_SCHED; PG8_LDA(At, 0, 0); PG8_STAGE_A(1, 1, a1, vgC);
            if constexpr (GATHER) { if (last) { _Pragma("unroll") for (int _h = 0; _h < 2; ++_h) _Pragma("unroll") for (int _i = 0; _i < 2; ++_i) vgC[_h][_i] = vgN[_h][_i]; } }
            PG8_WAIT_V(8); PG8_WAIT_L(0); PG8_BAR; PG8_MMA(0, 0, At, B0); PG8_MMA(0, 1, At, B1); PG8_BAR; PG8_SCHED;
            PG8_LDA(At, 0, 1); PG8_STAGE(PG8_SB(0, 0), b2, voffB); PG8_STAGE(PG8_SB(0, 1), b2 + hstep, voffB); PG8_STAGE_A(0, 0, a2, vgC);
            PG8_WAIT_V(8); PG8_WAIT_L(0); PG8_BAR; PG8_MMA(1, 0, At, B0); PG8_MMA(1, 1, At, B1); PG8_BAR; PG8_SCHED;
            PG8_LDB(B0, 1, 0); PG8_LDB(B1, 1, 1); PG8_SCHED; PG8_LDA(At, 1, 0); PG8_STAGE_A(0, 1, a2, vgC);
            PG8_WAIT_V(8); PG8_WAIT_L(0); PG8_BAR; PG8_MMA(0, 0, At, B0); PG8_MMA(0, 1, At, B1); PG8_BAR; PG8_SCHED;
            PG8_LDA(At, 1, 1); PG8_STAGE(PG8_SB(1, 0), b3, voffB); PG8_STAGE(PG8_SB(1, 1), b3 + hstep, voffB); PG8_STAGE_A(1, 0, a3, vgC);
            PG8_WAIT_V(8); PG8_WAIT_L(0); PG8_BAR; PG8_MMA(1, 0, At, B0); PG8_MMA(1, 1, At, B1); PG8_BAR; PG8_SCHED;
            } else {
            PG8_LDB(B0, 0, 0); PG8_SCHED; PG8_LDA(At, 0, 0); PG8_STAGE(PG8_SA(1, 1), a1 + hstep, voffA);
            PG8_WAIT_L(8); PG8_BAR; PG8_WAIT_L(0); PG8_MMA(0, 0, At, B0); PG8_BAR; PG8_SCHED;
            PG8_LDB(B1, 0, 1); PG8_STAGE(PG8_SB(0, 0), b2, voffB);
            PG8_BAR; PG8_WAIT_L(0); PG8_MMA(0, 1, At, B1); PG8_BAR;
            PG8_LDA(At, 0, 1); PG8_STAGE(PG8_SA(0, 0), a2, voffA);
            PG8_BAR; PG8_WAIT_L(0); PG8_MMA(1, 0, At, B0); PG8_BAR; PG8_SCHED;
            PG8_STAGE(PG8_SB(0, 1), b2 + hstep, voffB);
            PG8_WAIT_V(6); PG8_BAR; PG8_MMA(1, 1, At, B1); PG8_BAR;
            PG8_LDB(B0, 1, 0); PG8_SCHED; PG8_LDA(At, 1, 0); PG8_STAGE(PG8_SA(0, 1), a2 + hstep, voffA);
            PG8_WAIT_L(8); PG8_BAR; PG8_WAIT_L(0); PG8_MMA(0, 0, At, B0); PG8_BAR; PG8_SCHED;
            PG8_LDB(B1, 1, 1); PG8_STAGE(PG8_SB(1, 0), b3, voffB);
            PG8_BAR; PG8_WAIT_L(0); PG8_MMA(0, 1, At, B1); PG8_BAR;
            PG8_LDA(At, 1, 1); PG8_STAGE(PG8_SA(1, 0), a3, voffA);
            PG8_BAR; PG8_WAIT_L(0); PG8_MMA(1, 0, At, B0); PG8_BAR; PG8_SCHED;
            PG8_STAGE(PG8_SB(1, 1), b3 + hstep, voffB);
            PG8_WAIT_V(6); PG8_BAR; PG8_MMA(1, 1, At, B1); PG8_BAR;
            }
        }
        if constexpr (ALIGN_EPI) { if (wr == 0) PG8_BAR; }
        if constexpr (!Epi::AFTER_DRAIN) { E(acc, cur, wr, wc, fr, fq); S.done(cur); }
        if (!has_next) break;
#pragma unroll
        for (int a = 0; a < 2; ++a)
#pragma unroll
            for (int b = 0; b < 2; ++b)
#pragma unroll
                for (int m = 0; m < 4; ++m)
#pragma unroll
                    for (int n = 0; n < 2; ++n) acc[a][b][m][n] = (f32x4){0.f, 0.f, 0.f, 0.f};
        cur = nxt; cA = nA; cB = nB; ++ui;
        if constexpr (ALIGN_EPI) { if (wr == 1) PG8_BAR; }
    }
    PG8_WAIT_V(0);
    if constexpr (!ALIGN_EPI) { if (wr == 0) PG8_BAR; }
    PG8_BAR;
    if constexpr (Epi::AFTER_DRAIN) { E.fused(acc, cur, wr, wc, fr, fq, lds, wid, lane); S.done(cur); }
#undef PG8_SA
#undef PG8_SB
#undef PG8_STAGE
#undef PG8_STAGE_A
#undef PG8_GOFF
#undef PG8_LDA
#undef PG8_LDB
#undef PG8_MMA
#undef PG8_WAIT_V
#undef PG8_WAIT_L
#undef PG8_BAR
#undef PG8_SCHED
}
}

constexpr int BATCH = 8, T = 2048, D = 1024, M = BATCH * T, MEMLEN = 256, MM = BATCH * MEMLEN;
constexpr int INW = 2616, ZW = 2816;
constexpr int DFF = 2816, NEXP = 8, DFE = 3584;
constexpr float EPS = 1e-6f;
constexpr int Z_AQ = 0, Z_AK = 128, Z_AV = 256, Z_AG = 512, Z_CQ = 768, Z_CK = 1024, Z_CV = 1280, Z_CQI = 1536, Z_DUV = 1792, Z_BU = 2304, Z_ALR = 2560, Z_CKI = 2576, Z_CWI = 2608;
__host__ __device__ constexpr int zcol_of(int n) {
    return n < 768 ? n : n < 784 ? Z_ALR + (n - 768) : n < 1040 ? Z_BU + (n - 784) : n < 2064 ? Z_CQ + (n - 1040) : n < 2096 ? Z_CKI + (n - 2064) : n < 2104 ? Z_CWI + (n - 2096) : Z_DUV + (n - 2104);
}
constexpr int NWAVES = 8, NTHR = 512;
constexpr int MOE_TP = 72, MOE_NPASS = 2, MOE_MAXT = MOE_TP * MOE_NPASS;
constexpr int MAXSLOT = MOE_MAXT * 256;
constexpr int MOE_TS = 72;
__host__ __device__ constexpr int moe_pass_nt(int NT, int p) { const int r = NT - p * MOE_TS, cap = (p == MOE_NPASS - 1) ? MOE_TP : MOE_TS; return r < 0 ? 0 : (r > cap ? cap : r); }
static_assert((MOE_NPASS - 1) * MOE_TS + MOE_TP >= 136, "pass capacity");

constexpr size_t MiB = 1u << 20;
constexpr size_t al(size_t x) { return (x + 4095) & ~(size_t)4095; }
constexpr size_t WS_CTL = 0, CTL_ZERO_BYTES = 1 * MiB;
constexpr size_t WS_SS = 1 * MiB;
constexpr size_t WS_SSM = WS_SS + al((size_t)M * 16 * 4);
constexpr size_t WS_TOKE = WS_SSM + al((size_t)MM * 16 * 4);
constexpr size_t WS_TOKG = WS_TOKE + al((size_t)M * 8);
constexpr size_t WS_TOKR = WS_TOKG + al((size_t)M * 8);
constexpr size_t WS_TOKS = WS_TOKR + al((size_t)M * 4);
constexpr size_t WS_CNT = WS_TOKS + al((size_t)M * 8);
constexpr size_t WS_TILEE = WS_CNT + al(256 * 8 * 4);
constexpr size_t WS_SLOTR = WS_TILEE + al(160 * 4);
constexpr size_t WS_SLOTG = WS_SLOTR + al((size_t)MAXSLOT * 4);
constexpr size_t WS_SLOTT = WS_SLOTG + al((size_t)MAXSLOT * 4);
constexpr size_t WS_IDMAP = WS_SLOTT + al((size_t)MAXSLOT * 4);
constexpr size_t WS_SWT = al(WS_IDMAP + (size_t)MOE_TP * 256 * 4);
constexpr size_t WS_PWT = WS_SWT + (size_t)2 * 4 * 128 * 128 * 2;
constexpr size_t WS_WIN = al(WS_PWT + (size_t)2 * 4 * 64 * 64 * 2 + MiB);
constexpr size_t SZ_WIN = (size_t)ZW * D * 2, SZ_WOUT = (size_t)D * D * 2, SZ_WQ = (size_t)256 * D * 2, SZ_WKV = (size_t)512 * D * 2, SZ_WO = (size_t)D * 256 * 2;
constexpr size_t WS_WOUT = WS_WIN + 2 * SZ_WIN, WS_WQ = WS_WOUT + 2 * SZ_WOUT, WS_WKV = WS_WQ + 2 * SZ_WQ, WS_WO = WS_WKV + 2 * SZ_WKV;
constexpr size_t WS_W13 = WS_WO + 2 * SZ_WO, WS_W2 = WS_W13 + (size_t)2 * DFF * D * 2, WS_MW13 = WS_W2 + (size_t)D * DFF * 2;
constexpr size_t WS_MW2 = WS_MW13 + (size_t)NEXP * 2 * DFE * D * 2, WS_KVM = WS_MW2 + (size_t)NEXP * D * DFE * 2;
constexpr size_t SZ_KVM = (size_t)MM * 512 * 2;
constexpr size_t WS_MEMB = WS_KVM + 2 * SZ_KVM;
constexpr size_t WS_ACT = al(WS_MEMB + (size_t)MM * D * 2);
constexpr size_t WS_HB = WS_ACT, WS_Z = WS_HB + (size_t)M * D * 2, WS_MIX = WS_Z + (size_t)M * ZW * 2, WS_QX = WS_MIX + (size_t)M * D * 2, WS_OX = WS_QX + (size_t)M * 256 * 2;
constexpr size_t WS_GOI = WS_OX + (size_t)M * 256 * 2, WS_GQT = WS_GOI + (size_t)M * 256 * 4, WS_GKV = WS_GQT + (size_t)M * 128 * 4, WS_GDEC = WS_GKV + (size_t)1024 * 2048 * 4;
constexpr size_t WS_ACT_END = WS_GDEC + (size_t)1024 * 32 * 4;
constexpr size_t WS_FACT = WS_Z;
constexpr size_t SZ_MACT = (size_t)MOE_TP * 256 * DFE;
constexpr size_t WS_HB8 = WS_HB;
constexpr size_t WS_MACT = WS_HB + (size_t)M * D, WS_YS = WS_MACT + 2 * SZ_MACT, WS_MOE_END = WS_YS + (size_t)MAXSLOT * D * 2;
constexpr size_t WS_H16 = WS_MOE_END > WS_ACT_END ? WS_MOE_END : WS_ACT_END;
constexpr size_t WS_VF = WS_H16 + (size_t)M * D * 2;
constexpr size_t WS_KF = WS_VF + 2 * (size_t)MM * 256 * 2, WS_WQF = WS_KF + 2 * (size_t)MM * 256 * 2, WS_WOF = WS_WQF + 2 * (size_t)256 * D * 2;
constexpr size_t WS_DKF = WS_WOF + 2 * (size_t)D * 256 * 2;
constexpr size_t WS_END = WS_DKF + (size_t)M * 256 * 2;
static_assert(WS_MOE_END <= WS_H16, "MoE overlays end below the residual stream");
constexpr int CW_BAR = 4096;

constexpr int LDS_BYTES = 147456;
constexpr int MISC_OFF = 147456 - 512;
constexpr int SCR_BYTES = MISC_OFF, ARGS_OFF = MISC_OFF + 128;

#define GAS __attribute__((address_space(1)))
#define LAS __attribute__((address_space(3)))
typedef unsigned short bf16;
typedef unsigned v4u __attribute__((ext_vector_type(4)));
typedef unsigned v2u __attribute__((ext_vector_type(2)));
typedef float f32x4 __attribute__((ext_vector_type(4)));
typedef GAS unsigned gu32;
#define RLX_AGENT __ATOMIC_RELAXED, __HIP_MEMORY_SCOPE_AGENT
#define LDS_WAIT() asm volatile("s_waitcnt lgkmcnt(0)" ::: "memory")
#define LDS_ADD(p, v) (void)__hip_atomic_fetch_add((p), (v), __ATOMIC_RELAXED, __HIP_MEMORY_SCOPE_WORKGROUP)
__device__ __forceinline__ unsigned f2bf(float f) { unsigned u = __builtin_bit_cast(unsigned, f); return (u + 0x7fffu + ((u >> 16) & 1u)) >> 16; }
__device__ __forceinline__ unsigned pk2(float lo, float hi) { return f2bf(lo) | (f2bf(hi) << 16); }
__device__ __forceinline__ unsigned pk4_fp8(float a, float b, float c, float d) { int p = 0; p = __builtin_amdgcn_cvt_pk_fp8_f32(a, b, p, false); p = __builtin_amdgcn_cvt_pk_fp8_f32(c, d, p, true); return (unsigned)p; }
constexpr float W8_SCALE = 64.0f, A8_SCALE = 8.0f, X8_SCALE = 16.0f;
__device__ __forceinline__ float bflo(unsigned w) { return __builtin_bit_cast(float, w << 16); }
__device__ __forceinline__ float bfhi(unsigned w) { return __builtin_bit_cast(float, w & 0xffff0000u); }
__device__ __forceinline__ f32x4 bf4(v2u p) { f32x4 r; r.x = bflo(p.x); r.y = bfhi(p.x); r.z = bflo(p.y); r.w = bfhi(p.y); return r; }
__device__ __forceinline__ float bf1(bf16 b) { return __builtin_bit_cast(float, ((unsigned)b) << 16); }
__device__ __forceinline__ unsigned lane_id_now() { unsigned l; asm volatile("v_mbcnt_lo_u32_b32 %0, -1, 0\n\tv_mbcnt_hi_u32_b32 %0, -1, %0" : "=v"(l)); return l; }
template <int MASK> __device__ __forceinline__ float shfl_xor_c(float v) {
    if constexpr (MASK < 32) return __builtin_bit_cast(float, __builtin_amdgcn_ds_swizzle(__builtin_bit_cast(int, v), (MASK << 10) | 0x1f));
    else return __builtin_bit_cast(float, __builtin_amdgcn_ds_bpermute((int)((lane_id_now() ^ 32u) << 2), __builtin_bit_cast(int, v)));
}
__device__ __forceinline__ float shfl_idx(float v, int src_lane) { return __builtin_bit_cast(float, __builtin_amdgcn_ds_bpermute(src_lane << 2, __builtin_bit_cast(int, v))); }
__device__ __forceinline__ unsigned shfl_idx_u(unsigned v, int src_lane) { return (unsigned)__builtin_amdgcn_ds_bpermute(src_lane << 2, (int)v); }
__device__ __forceinline__ float wave_sum(float v) {
    v += shfl_xor_c<1>(v); v += shfl_xor_c<2>(v); v += shfl_xor_c<4>(v); v += shfl_xor_c<8>(v); v += shfl_xor_c<16>(v); v += shfl_xor_c<32>(v);
    return v;
}
__device__ __forceinline__ float wave_max(float v) {
    v = fmaxf(v, shfl_xor_c<1>(v)); v = fmaxf(v, shfl_xor_c<2>(v)); v = fmaxf(v, shfl_xor_c<4>(v)); v = fmaxf(v, shfl_xor_c<8>(v)); v = fmaxf(v, shfl_xor_c<16>(v)); v = fmaxf(v, shfl_xor_c<32>(v));
    return v;
}
#define XB_TMO      128
#define XB_XCNT(j)  (256  + 64 * (j))
#define XB_XSUB(j)  (1280 + 64 * (j))
#define XB_XGEN(j)  (2304 + 64 * (j))
#define XB_TOP      3328
#define XB_TOPGEN   3392
#define XCD_BAR_WORDS 3456
#define XB_SPIN_CAP (1u << 18)

__device__ __forceinline__ unsigned xb_ld(unsigned* p)              { return __hip_atomic_load(p, __ATOMIC_RELAXED, __HIP_MEMORY_SCOPE_AGENT); }
__device__ __forceinline__ unsigned xb_add(unsigned* p, unsigned v) { return __hip_atomic_fetch_add(p, v, __ATOMIC_RELAXED, __HIP_MEMORY_SCOPE_AGENT); }
__device__ __forceinline__ unsigned xb_xcc_id() { return (unsigned)__builtin_amdgcn_s_getreg((3 << 11) | 20) & 0xFu; }
#define XB_SPIN(cond, bar) do { unsigned _sp = 0; while (cond) { __builtin_amdgcn_s_sleep(1); \
    if ((++_sp & 255u) == 0u) { if (xb_ld(&(bar)[XB_TMO])) break; if (_sp > XB_SPIN_CAP) { atomicAdd(&(bar)[XB_TMO], 1u); break; } } } } while (0)

struct XcdBarrier {
    unsigned* bar; unsigned x; unsigned wid;
    volatile LAS unsigned* st;
};

__device__ __forceinline__ XcdBarrier xcd_barrier_post(unsigned* bar, volatile LAS unsigned* st) {
    XcdBarrier b; b.bar = bar; b.x = xb_xcc_id(); b.st = st; b.wid = (unsigned)__builtin_amdgcn_readfirstlane(threadIdx.x >> 6);
    if (threadIdx.x == 0) (void)xb_add(&bar[XB_XCNT(b.x)], 1u);
    return b;
}
__device__ __forceinline__ void xcd_barrier_complete(unsigned* bar, unsigned x, unsigned& nloc, unsigned& nx) {
    const unsigned G = gridDim.x * gridDim.y * gridDim.z;
    unsigned sum, cnt, mine, sp = 0u;
    for (;;) {
        sum = 0u; cnt = 0u; mine = 0u;
#pragma unroll
        for (unsigned j = 0; j < 16; ++j) { const unsigned c = xb_ld(&bar[XB_XCNT(j)]); sum += c; cnt += (c > 0u) ? 1u : 0u; mine = (j == x) ? c : mine; }
        if (sum == G) break;
        __builtin_amdgcn_s_sleep(1);
        if ((++sp & 255u) == 0u) { if (xb_ld(&bar[XB_TMO])) break; if (sp > XB_SPIN_CAP) { atomicAdd(&bar[XB_TMO], 1u); break; } }
    }
    nloc = mine > 0u ? mine : 1u; nx = cnt > 0u ? cnt : 1u;
}

__device__ __forceinline__ void xcd_barrier(const XcdBarrier& b) {
    asm volatile("s_waitcnt vmcnt(0)" ::: "memory");
    __syncthreads();
    if (b.wid == 0u && lane_id_now() == 0u) {
        unsigned* bar = b.bar;
        __builtin_amdgcn_s_waitcnt(0);
        unsigned nloc = b.st[0], nx = b.st[1];
        if (nloc == 0u) { xcd_barrier_complete(bar, b.x, nloc, nx); b.st[0] = nloc; b.st[1] = nx; }
        const unsigned old = xb_add(&bar[XB_XSUB(b.x)], 1u);
        const unsigned gen = old / nloc;
        if (old + 1u == (gen + 1u) * nloc) {
            __builtin_amdgcn_fence(__ATOMIC_RELEASE, "agent");
            asm volatile("s_waitcnt vmcnt(0)" ::: "memory");
            const unsigned og = xb_add(&bar[XB_TOP], 1u);
            const unsigned tg = og / nx;
            if (og + 1u == (tg + 1u) * nx) xb_add(&bar[XB_TOPGEN], 1u);
            else XB_SPIN(xb_ld(&bar[XB_TOPGEN]) == tg, bar);
            __builtin_amdgcn_fence(__ATOMIC_ACQUIRE, "agent");
            xb_add(&bar[XB_XGEN(b.x)], 1u);
            asm volatile("s_waitcnt vmcnt(0)" ::: "memory");
        } else {
            XB_SPIN(xb_ld(&bar[XB_XGEN(b.x)]) == gen, bar);
            __builtin_amdgcn_fence(__ATOMIC_ACQUIRE, "agent");
            asm volatile("s_waitcnt vmcnt(0)" ::: "memory");
        }
    }
    __syncthreads();
}

enum { IN_X = 0, IN_MEM, IN_RELB, IN_FNORM, IN_NMIX, IN_WIN, IN_WA2, IN_BA, IN_GNORM, IN_PW, IN_PB, IN_PS, IN_LNG, IN_LNB, IN_SW, IN_SB, IN_WOUT,
       IN_NXA, IN_NMEM, IN_WQ, IN_WKV, IN_WO, IN_NFFN, IN_F1, IN_F3, IN_F2, IN_ROUTER, IN_M1, IN_M3, IN_M2, N_IN };
struct Args { const float* in[N_IN]; float* out; unsigned char* ws; int ph_lo, ph_hi; };

__device__ __forceinline__ float rstd16(const float* ss, int row) {
    const f32x4* p = (const f32x4*)(ss + (size_t)row * 16);
    const f32x4 a = p[0], b = p[1], c = p[2], d = p[3];
    const float s = (((a.x + a.y) + (a.z + a.w)) + ((b.x + b.y) + (b.z + b.w))) + (((c.x + c.y) + (c.z + c.w)) + ((d.x + d.y) + (d.z + d.w)));
    return rsqrtf(s * (1.0f / 1024.0f) + EPS);
}
__device__ __forceinline__ v4u pack8(const f32x4 a, const f32x4 b) { v4u w; w.x = pg8::cvt_pk_bf16(a.x, a.y); w.y = pg8::cvt_pk_bf16(a.z, a.w); w.z = pg8::cvt_pk_bf16(b.x, b.y); w.w = pg8::cvt_pk_bf16(b.z, b.w); return w; }

struct EpiScale {
    static constexpr bool PERM = true, AFTER_DRAIN = false;
    bf16* O; int ldc; const float* ss; float scale; bf16* KF; int KT;
    __device__ __forceinline__ void operator()(const pg8::f32x4 (&acc)[2][2][4][2], const pg8::Unit& u, int wr, int wc, int fr, int fq) const {
        const int row0 = u.po * 256 + wr * 64 + fr, col0 = u.e * 256 + wc * 32 + 8 * fq;
        const bool frag = KF != nullptr && u.e == KT;
#pragma unroll
        for (int ai = 0; ai < 2; ++ai)
#pragma unroll
            for (int m = 0; m < 4; ++m) { const int row = row0 + ai * 128 + m * 16; const float r = rstd16(ss, row) * scale; bf16* rowp = O + (size_t)row * ldc + col0;
#pragma unroll
                for (int bj = 0; bj < 2; ++bj) { const v4u o = pack8(acc[ai][bj][m][0] * r, acc[ai][bj][m][1] * r);
                    if (frag) { const int c = wc * 32 + 8 * fq + bj * 128;
                        *(v4u*)(KF + ((((size_t)(row >> 5) * 4 + (c >> 6)) * 4 + ((c >> 4) & 3)) * 64 + (row & 31) + 32 * ((c >> 3) & 1)) * 8) = o; }
                    else *(v4u*)(rowp + bj * 128) = o; } }
    }
};
struct EpiResid {
    static constexpr bool PERM = true, AFTER_DRAIN = false;
    bf16* HB; float* SS;
    __device__ __forceinline__ void operator()(const pg8::f32x4 (&acc)[2][2][4][2], const pg8::Unit& u, int wr, int wc, int fr, int fq) const {
        const int row0 = u.po * 256 + wr * 64 + fr, col0 = u.e * 256 + wc * 32 + 8 * fq;
#pragma unroll
        for (int ai = 0; ai < 2; ++ai) {
            v4u rv[4][2];
#pragma unroll
            for (int m = 0; m < 4; ++m)
#pragma unroll
                for (int bj = 0; bj < 2; ++bj) rv[m][bj] = *(const v4u*)(HB + (size_t)(row0 + ai * 128 + m * 16) * D + col0 + bj * 128);
#pragma unroll
            for (int m = 0; m < 4; ++m) { const int row = row0 + ai * 128 + m * 16; const size_t off = (size_t)row * D + col0; float q = 0.f;
#pragma unroll
                for (int bj = 0; bj < 2; ++bj) { const v4u r = rv[m][bj]; v2u lo, hi; lo.x = r.x; lo.y = r.y; hi.x = r.z; hi.y = r.w;
                    const f32x4 v0 = acc[ai][bj][m][0] + bf4(lo), v1 = acc[ai][bj][m][1] + bf4(hi);
                    *(v4u*)(HB + off + bj * 128) = pack8(v0, v1);
                    q += ((v0.x * v0.x + v0.y * v0.y) + (v0.z * v0.z + v0.w * v0.w)) + ((v1.x * v1.x + v1.y * v1.y) + (v1.z * v1.z + v1.w * v1.w)); }
                q += shfl_xor_c<16>(q); q += shfl_xor_c<32>(q);
                if (fq == 0) SS[(size_t)row * 16 + u.e * 4 + wc] = q; } }
    }
};
__device__ __forceinline__ float silu_f(float x) { return x * __builtin_amdgcn_rcpf(1.0f + __expf(-x)); }
template <bool MOE> struct EpiSwiglu {
    static constexpr bool PERM = true, AFTER_DRAIN = false;
    bf16* O; int ldc; const float* ss; const float* slot_r; const float* slot_g;
    __device__ __forceinline__ void operator()(const pg8::f32x4 (&acc)[2][2][4][2], const pg8::Unit& u, int wr, int wc, int fr, int fq) const {
        const int rin0 = u.pm * 256 + wr * 64 + fr, rout0 = u.po * 256 + wr * 64 + fr, col0 = u.e * 128 + wc * 32 + 8 * fq;
#pragma unroll
        for (int ai = 0; ai < 2; ++ai)
#pragma unroll
            for (int m = 0; m < 4; ++m) { const int rin = rin0 + ai * 128 + m * 16, rout = rout0 + ai * 128 + m * 16;
                float r, gt; if (MOE) { r = 1.0f / (W8_SCALE * X8_SCALE); gt = A8_SCALE; } else { r = rstd16(ss, rin); gt = 1.0f; }
                const float rg = r * -1.4426950408889634f, c2 = r * r * gt;
                f32x4 o0, o1;
                { const f32x4 gu0 = acc[ai][0][m][0] * acc[ai][1][m][0], gu1 = acc[ai][0][m][1] * acc[ai][1][m][1];
#pragma unroll
                  for (int j = 0; j < 4; ++j) { const float i0 = __builtin_amdgcn_rcpf(1.0f + __builtin_amdgcn_exp2f(acc[ai][0][m][0][j] * rg)) * c2, i1 = __builtin_amdgcn_rcpf(1.0f + __builtin_amdgcn_exp2f(acc[ai][0][m][1][j] * rg)) * c2;
                    o0[j] = gu0[j] * i0; o1[j] = gu1[j] * i1;
                    if (MOE) { o0[j] = __builtin_amdgcn_fmed3f(o0[j], -448.0f, 448.0f); o1[j] = __builtin_amdgcn_fmed3f(o1[j], -448.0f, 448.0f); } } }
                if (MOE) { v2u w; w.x = pk4_fp8(o0[0], o0[1], o0[2], o0[3]); w.y = pk4_fp8(o1[0], o1[1], o1[2], o1[3]); *(v2u*)((unsigned char*)O + (size_t)rout * ldc + col0) = w; }
                else *(v4u*)(O + (size_t)rout * ldc + col0) = pack8(o0, o1); }
    }
};
struct EpiPlain {
    static constexpr bool PERM = true, AFTER_DRAIN = false;
    bf16* O; int ldc;
    __device__ __forceinline__ void operator()(const pg8::f32x4 (&acc)[2][2][4][2], const pg8::Unit& u, int wr, int wc, int fr, int fq) const {
        const int row0 = u.po * 256 + wr * 64 + fr, col0 = u.e * 256 + wc * 32 + 8 * fq;
#pragma unroll
        for (int ai = 0; ai < 2; ++ai)
#pragma unroll
            for (int m = 0; m < 4; ++m) { bf16* rowp = O + (size_t)(row0 + ai * 128 + m * 16) * ldc + col0;
#pragma unroll
                for (int bj = 0; bj < 2; ++bj) *(v4u*)(rowp + bj * 128) = pack8(acc[ai][bj][m][0], acc[ai][bj][m][1]); }
    }
};

__device__ __forceinline__ void tr_load(const float* W, int N, int k0, int n0, int lane, float (&v)[64]) {
    const int nn = n0 + lane; const float* wp = W + (size_t)k0 * N + (nn < N ? nn : 0);
#pragma unroll
    for (int i = 0; i < 64; ++i) v[i] = wp[(size_t)i * N];
}
__device__ __forceinline__ void tr_store(const float (&v)[64], int N, int K, int k0, int n0, const float* gain, bf16* WT, long dst_row0, LAS float* scr, int lane) {
    const bool ok = n0 + lane < N;
#pragma unroll
    for (int i = 0; i < 64; ++i) { float x = ok ? v[i] : 0.f; if (gain) x *= gain[k0 + i]; scr[i * 65 + lane] = x; }
    LDS_WAIT(); asm volatile("" ::: "memory");
    const int c = lane & 7;
#pragma unroll
    for (int j = 0; j < 8; ++j) { const int n = (lane >> 3) + 8 * j; const LAS float* s = scr + (8 * c) * 65 + n;
        v4u o; o.x = pk2(s[0 * 65], s[1 * 65]); o.y = pk2(s[2 * 65], s[3 * 65]); o.z = pk2(s[4 * 65], s[5 * 65]); o.w = pk2(s[6 * 65], s[7 * 65]);
        if (n0 + n < N) *(v4u*)(WT + (size_t)(dst_row0 < 0 ? (long)zcol_of(n0 + n) : dst_row0 + n) * K + k0 + 8 * c) = o; }
    LDS_WAIT(); asm volatile("" ::: "memory");
}
__device__ __forceinline__ void tr_store8(const float (&v)[64], int N, int K, int k0, int n0, const float* gain, unsigned char* WT8, long dst_row0, LAS float* scr, int lane) {
    const bool ok = n0 + lane < N;
#pragma unroll
    for (int i = 0; i < 64; ++i) { float x = ok ? v[i] * W8_SCALE : 0.f; if (gain) x *= gain[k0 + i]; scr[i * 65 + lane] = x; }
    LDS_WAIT(); asm volatile("" ::: "memory");
    const int c = lane & 3;
#pragma unroll
    for (int j = 0; j < 4; ++j) { const int n = (lane >> 2) + 16 * j; const LAS float* s = scr + (16 * c) * 65 + n;
        v4u o; o.x = pk4_fp8(s[0 * 65], s[1 * 65], s[2 * 65], s[3 * 65]); o.y = pk4_fp8(s[4 * 65], s[5 * 65], s[6 * 65], s[7 * 65]);
        o.z = pk4_fp8(s[8 * 65], s[9 * 65], s[10 * 65], s[11 * 65]); o.w = pk4_fp8(s[12 * 65], s[13 * 65], s[14 * 65], s[15 * 65]);
        if (n0 + n < N) *(v4u*)(WT8 + (size_t)(dst_row0 + n) * K + k0 + 16 * c) = o; }
    LDS_WAIT(); asm volatile("" ::: "memory");
}
__device__ __forceinline__ void tr_item(const float* W, int N, int K, int k0, int n0, const float* gain, bf16* WT, long dst_row0, LAS float* scr, int lane) {
    float v[64]; tr_load(W, N, k0, n0, lane, v); tr_store(v, N, K, k0, n0, gain, WT, dst_row0, scr, lane);
}
__device__ __forceinline__ void conv_store(const float (&v)[64], int it, int nblk, int K, int N, const float* gain, bf16* WT, int mode, LAS float* scr, int lane) {
    const int kb = it / nblk, nb = it % nblk, k0 = 64 * kb, n0 = 64 * nb;
    if (mode >= 4) {
        const long dr8 = (mode == 4) ? (long)n0 : (long)(n0 >> 7) * 256 + (n0 & 127) + (mode == 6 ? 128 : 0);
        tr_store8(v, N, K, k0, n0, gain, (unsigned char*)WT, dr8, scr, lane); return; }
    const long dr = (mode == 3) ? -1L : (mode == 0) ? (long)n0 : (long)(n0 >> 7) * 256 + (n0 & 127) + (mode == 2 ? 128 : 0);
    tr_store(v, N, K, k0, n0, gain, WT, dr, scr, lane);
}
__device__ __forceinline__ void conv_job(const float* W, int K, int N, const float* gain, bf16* WT, int mode, LAS float* scr, int gw, int NGW, int lane, long& base) {
    const int nblk = (N + 63) / 64, nitems = (K / 64) * nblk;
    const int first = (int)(((long)gw - (base % NGW) + NGW) % NGW);
    float va[64], vb[64];
    int it = first;
    if (it < nitems) tr_load(W, N, 64 * (it / nblk), 64 * (it % nblk), lane, va);
    while (it < nitems) {
        int itn = it + NGW;
        if (itn < nitems) tr_load(W, N, 64 * (itn / nblk), 64 * (itn % nblk), lane, vb);
        conv_store(va, it, nblk, K, N, gain, WT, mode, scr, lane);
        it = itn; if (it >= nitems) break;
        itn = it + NGW;
        if (itn < nitems) tr_load(W, N, 64 * (itn / nblk), 64 * (itn % nblk), lane, va);
        conv_store(vb, it, nblk, K, N, gain, WT, mode, scr, lane);
        it = itn;
    }
    base += nitems;
}
__device__ __forceinline__ void row_cvt(const float* xrow, bf16* orow, float* ssrow, int lane) {
    const f32x4* xr = (const f32x4*)xrow + lane; f32x4 v[4]; float s = 0.f;
#pragma unroll
    for (int j = 0; j < 4; ++j) { v[j] = xr[64 * j]; s += (v[j].x * v[j].x + v[j].y * v[j].y) + (v[j].z * v[j].z + v[j].w * v[j].w); }
    s = wave_sum(s);
    v2u* o8 = (v2u*)orow + lane;
#pragma unroll
    for (int j = 0; j < 4; ++j) { v2u w; w.x = pk2(v[j].x, v[j].y); w.y = pk2(v[j].z, v[j].w); o8[64 * j] = w; }
    if (lane < 16) ssrow[lane] = lane == 0 ? s : 0.f;
}
__device__ __forceinline__ void p0_prologue(const Args& a, LAS unsigned char* lds, int tid, int G) {
    const int lane = tid & 63, wave = tid >> 6, gw = blockIdx.x * NWAVES + wave, NGW = G * NWAVES;
    LAS float* scr = (LAS float*)(lds + wave * 16640);
    unsigned char* ws = a.ws; long base = 0;
    for (int l = 0; l < 2; ++l) {
        conv_job(a.in[IN_WIN] + (size_t)l * D * INW, D, INW, a.in[IN_NMIX] + l * D, (bf16*)(ws + WS_WIN + l * SZ_WIN), 3, scr, gw, NGW, lane, base);
        conv_job(a.in[IN_WOUT] + (size_t)l * D * D, D, D, nullptr, (bf16*)(ws + WS_WOUT + l * SZ_WOUT), 0, scr, gw, NGW, lane, base);
        conv_job(a.in[IN_WQ] + (size_t)l * D * 256, D, 256, a.in[IN_NXA] + l * D, (bf16*)(ws + WS_WQ + l * SZ_WQ), 0, scr, gw, NGW, lane, base);
        conv_job(a.in[IN_WKV] + (size_t)l * D * 512, D, 512, a.in[IN_NMEM] + l * D, (bf16*)(ws + WS_WKV + l * SZ_WKV), 0, scr, gw, NGW, lane, base);
        conv_job(a.in[IN_WO] + (size_t)l * 256 * D, 256, D, nullptr, (bf16*)(ws + WS_WO + l * SZ_WO), 0, scr, gw, NGW, lane, base);
        { v4u* zp = (v4u*)(ws + WS_WIN + l * SZ_WIN + (size_t)INW * D * 2); const int n16 = (ZW - INW) * D * 2 / 16;
          for (int i = blockIdx.x * NTHR + tid; i < n16; i += G * NTHR) zp[i] = (v4u){0u, 0u, 0u, 0u}; }
    }
    conv_job(a.in[IN_F1], D, DFF, a.in[IN_NFFN], (bf16*)(ws + WS_W13), 1, scr, gw, NGW, lane, base);
    conv_job(a.in[IN_F3], D, DFF, a.in[IN_NFFN], (bf16*)(ws + WS_W13), 2, scr, gw, NGW, lane, base);
    conv_job(a.in[IN_F2], DFF, D, nullptr, (bf16*)(ws + WS_W2), 0, scr, gw, NGW, lane, base);
    for (int e = 0; e < NEXP; ++e) {
        conv_job(a.in[IN_M1] + (size_t)e * D * DFE, D, DFE, a.in[IN_NFFN] + D, (bf16*)(ws + WS_MW13 + (size_t)e * 2 * DFE * D), 5, scr, gw, NGW, lane, base);
        conv_job(a.in[IN_M3] + (size_t)e * D * DFE, D, DFE, a.in[IN_NFFN] + D, (bf16*)(ws + WS_MW13 + (size_t)e * 2 * DFE * D), 6, scr, gw, NGW, lane, base);
        conv_job(a.in[IN_M2] + (size_t)e * DFE * D, DFE, D, nullptr, (bf16*)(ws + WS_MW2 + (size_t)e * D * DFE), 4, scr, gw, NGW, lane, base);
    }
    for (int i = blockIdx.x * NTHR + tid; i < MOE_TP * 256; i += G * NTHR) ((int*)(ws + WS_IDMAP))[i] = i;
    for (int i = blockIdx.x * NTHR + tid; i < 2 * 4 * 128 * 128; i += G * NTHR) { const int s = i & 127, t = (i >> 7) & 127; ((bf16*)(ws + WS_SWT))[i] = (bf16)f2bf(s <= t ? a.in[IN_SW][i] : 0.f); }
    for (int i = blockIdx.x * NTHR + tid; i < 2 * 4 * 64 * 64; i += G * NTHR) { const int c = i & 63, d = (i >> 6) & 63, lg = i >> 12; ((bf16*)(ws + WS_PWT))[i] = (bf16)f2bf(a.in[IN_PW][(size_t)lg * 4096 + c * 64 + d]); }
    for (int m = gw; m < M; m += NGW) row_cvt(a.in[IN_X] + (size_t)m * D, (bf16*)(ws + WS_H16) + (size_t)m * D, (float*)(ws + WS_SS) + (size_t)m * 16, lane);
    for (int m = gw; m < MM; m += NGW) row_cvt(a.in[IN_MEM] + (size_t)m * D, (bf16*)(ws + WS_MEMB) + (size_t)m * D, (float*)(ws + WS_SSM) + (size_t)m * 16, lane);
}


__device__ __forceinline__ float gelu_tanh(float x) { return 0.5f * x * (1.0f + tanhf(0.7978845608028654f * (x + 0.044715f * x * x * x))); }

__device__ __forceinline__ void gla_a_item(const Args& a, int l, int item, LAS unsigned char* lds, int tid) {
    const int n = item & 31, h = (item >> 5) & 3, b = item >> 7, tok0 = b * T + n * 64;
    LAS float* alr = (LAS float*)lds;
    LAS float* wa = alr + 64 * 16;
    LAS float* bb = wa + 16 * 32;
    LAS float* qt = bb + 64 * 33;
    LAS float* kt = qt + 64 * 33;
    LAS float* kd = kt + 64 * 33;
    LAS float* vv = kd + 64 * 33;
    LAS float* att = vv + 64 * 64;
    LAS float* bav = att + 64 * 65;
    const bf16* z = (const bf16*)(a.ws + WS_Z);
    float* OI = (float*)(a.ws + WS_GOI); float* QT = (float*)(a.ws + WS_GQT); float* KV = (float*)(a.ws + WS_GKV); float* DEC = (float*)(a.ws + WS_GDEC);
    for (int i = tid; i < 1024; i += NTHR) alr[i] = bf1(z[(size_t)(tok0 + (i >> 4)) * ZW + Z_ALR + (i & 15)]);
    { const int r = tid >> 5, k = tid & 31; wa[tid] = a.in[IN_WA2][(size_t)l * 16 * 128 + r * 128 + h * 32 + k]; }
    if (tid < 32) bav[tid] = a.in[IN_BA][l * 128 + h * 32 + tid];
    for (int i = tid; i < 4096; i += NTHR) vv[i] = bf1(z[(size_t)(tok0 + (i >> 6)) * ZW + Z_AV + h * 64 + (i & 63)]);
    __syncthreads();
    for (int i = tid; i < 2048; i += NTHR) { const int c = i >> 5, k = i & 31; float x = bav[k];
#pragma unroll
        for (int r = 0; r < 16; ++r) x += alr[c * 16 + r] * wa[r * 32 + k];
        const float ls = fminf(x, 0.f) - log1pf(expf(-fabsf(x)));
        bb[c * 33 + k] = ls * (1.0f / 16.0f); }
    __syncthreads();
    if (tid < 32) { float run = 0.f; for (int c = 0; c < 64; ++c) { run += bb[c * 33 + tid]; bb[c * 33 + tid] = run; } }
    __syncthreads();
    for (int i = tid; i < 2048; i += NTHR) { const int c = i >> 5, k = i & 31; const float bv = bb[c * 33 + k], bl = bb[63 * 33 + k];
        const float q = bf1(z[(size_t)(tok0 + c) * ZW + Z_AQ + h * 32 + k]), kk = bf1(z[(size_t)(tok0 + c) * ZW + Z_AK + h * 32 + k]);
        const float qv = q * 0.17677669529663687f * expf(bv);
        qt[c * 33 + k] = qv; kt[c * 33 + k] = kk * expf(-bv); kd[c * 33 + k] = kk * expf(bl - bv);
        QT[(size_t)(tok0 + c) * 128 + h * 32 + k] = qv; }
    if (tid < 32) DEC[(size_t)item * 32 + tid] = expf(bb[63 * 33 + tid]);
    __syncthreads();
    for (int idx = tid; idx < 4096; idx += NTHR) { const int i = idx >> 6, j = idx & 63; float s = 0.f;
        if (j <= i) {
#pragma unroll 8
            for (int k = 0; k < 32; ++k) s += qt[i * 33 + k] * kt[j * 33 + k]; }
        att[i * 65 + j] = s; }
    __syncthreads();
    for (int idx = tid; idx < 4096; idx += NTHR) { const int i = idx >> 6, v = idx & 63; float s = 0.f;
#pragma unroll 8
        for (int j = 0; j < 64; ++j) s += att[i * 65 + j] * vv[j * 64 + v];
        OI[(size_t)(tok0 + i) * 256 + h * 64 + v] = s; }
    for (int idx = tid; idx < 2048; idx += NTHR) { const int k = idx >> 6, v = idx & 63; float s = 0.f;
#pragma unroll 8
        for (int c = 0; c < 64; ++c) s += kd[c * 33 + k] * vv[c * 64 + v];
        KV[(size_t)item * 2048 + idx] = s; }
    __syncthreads();
}
__device__ __forceinline__ void gla_c_item(const Args& a, int l, int item, LAS unsigned char* lds, int tid) {
    const int n = item & 31, h = (item >> 5) & 3, b = item >> 7, tok0 = b * T + n * 64, lane = tid & 63, w = tid >> 6;
    LAS float* S = (LAS float*)lds;
    LAS float* ql = S + 2048;
    const bf16* z = (const bf16*)(a.ws + WS_Z); bf16* mix = (bf16*)(a.ws + WS_MIX);
    const float* OI = (const float*)(a.ws + WS_GOI); const float* QT = (const float*)(a.ws + WS_GQT); const float* KV = (const float*)(a.ws + WS_GKV); const float* DEC = (const float*)(a.ws + WS_GDEC);
    for (int e = tid; e < 2048; e += NTHR) { const int k = e >> 6; float s = 0.f;
        for (int m = 0; m < n; ++m) { const size_t it = (size_t)(item - n + m); s = s * DEC[it * 32 + k] + KV[it * 2048 + e]; }
        S[e] = s; }
    for (int i = tid; i < 2048; i += NTHR) ql[(i >> 5) * 33 + (i & 31)] = QT[(size_t)(tok0 + (i >> 5)) * 128 + h * 32 + (i & 31)];
    __syncthreads();
    for (int j = 0; j < 8; ++j) { const int i = w + 8 * j; float o = OI[(size_t)(tok0 + i) * 256 + h * 64 + lane];
#pragma unroll 8
        for (int k = 0; k < 32; ++k) o += ql[i * 33 + k] * S[k * 64 + lane];
        const float ms = wave_sum(o * o) * (1.0f / 64.0f);
        float y = o * rsqrtf(ms + EPS) * a.in[IN_GNORM][l * 256 + h * 64 + lane];
        const float g = bf1(z[(size_t)(tok0 + i) * ZW + Z_AG + h * 64 + lane]);
        y *= g / (1.0f + expf(-g));
        mix[(size_t)(tok0 + i) * D + h * 64 + lane] = (bf16)f2bf(y); }
    __syncthreads();
}
__device__ __forceinline__ void pool_item(const Args& a, int l, int item, LAS unsigned char* lds, int tid) {
    const int g = item & 3, tt = (item >> 2) & 31, b = item >> 7, t0 = tt * 64;
    LAS float* u = (LAS float*)lds;
    LAS float* w = u + 79 * 64;
    LAS float* p = w + 4096;
    const bf16* z = (const bf16*)(a.ws + WS_Z); bf16* mix = (bf16*)(a.ws + WS_MIX);
    for (int i = tid; i < 79 * 64; i += NTHR) { const int t = t0 - 15 + (i >> 6); u[i] = t >= 0 ? bf1(z[(size_t)(b * T + t) * ZW + Z_BU + g * 64 + (i & 63)]) : 0.f; }
    for (int i = tid; i < 4096; i += NTHR) w[i] = a.in[IN_PW][(size_t)(l * 4 + g) * 4096 + i];
    __syncthreads();
    const int win = 2 << g;
    for (int i = tid; i < 4096; i += NTHR) { const int tl = i >> 6, c = i & 63, t = t0 + tl, cnt = (t + 1 < win) ? t + 1 : win; float s = 0.f;
        for (int j = 0; j < cnt; ++j) s += u[(tl + 15 - j) * 64 + c];
        p[tl * 65 + c] = s / (float)cnt - u[(tl + 15) * 64 + c]; }
    __syncthreads();
    for (int i = tid; i < 4096; i += NTHR) { const int tl = i >> 6, d = i & 63; float s = a.in[IN_PB][(l * 4 + g) * 64 + d];
#pragma unroll 8
        for (int c = 0; c < 64; ++c) s += p[tl * 65 + c] * w[c * 64 + d];
        s *= a.in[IN_PS][l * 256 + g * 64 + d];
        mix[(size_t)(b * T + t0 + tl) * D + 256 + g * 64 + d] = (bf16)f2bf(s); }
    __syncthreads();
}
__device__ __forceinline__ void sgu_item(const Args& a, int l, int item, LAS unsigned char* lds, int tid) {
    const int g = item & 3, nc = (item >> 2) & 15, b = item >> 6, tok0 = b * T + nc * 128, lane = tid & 63, w = tid >> 6;
    LAS float* vn = (LAS float*)lds;
    const bf16* z = (const bf16*)(a.ws + WS_Z); bf16* mix = (bf16*)(a.ws + WS_MIX);
    for (int j = 0; j < 16; ++j) { const int s = w + 8 * j;
        const v2u raw = *(const v2u*)(z + (size_t)(tok0 + s) * ZW + Z_DUV + 256 + 4 * lane);
        float x[4] = {gelu_tanh(bflo(raw.x)), gelu_tanh(bfhi(raw.x)), gelu_tanh(bflo(raw.y)), gelu_tanh(bfhi(raw.y))};
        const float mu = wave_sum((x[0] + x[1]) + (x[2] + x[3])) * (1.0f / 256.0f);
        float q = 0.f;
#pragma unroll
        for (int i = 0; i < 4; ++i) { x[i] -= mu; q += x[i] * x[i]; }
        const float rstd = rsqrtf(wave_sum(q) * (1.0f / 256.0f) + EPS);
        if ((lane >> 4) == g) {
#pragma unroll
            for (int i = 0; i < 4; ++i) { const int cl = 4 * (lane & 15) + i; vn[s * 64 + cl] = x[i] * rstd * a.in[IN_LNG][l * 256 + g * 64 + cl] + a.in[IN_LNB][l * 256 + g * 64 + cl]; } } }
    __syncthreads();
    const float* sw = a.in[IN_SW] + (size_t)(l * 4 + g) * 128 * 128;
    for (int j = 0; j < 16; ++j) { const int t = w + 8 * j; float acc = a.in[IN_SB][(l * 4 + g) * 128 + t];
        const float* swr = sw + t * 128;
        for (int s = 0; s <= t; ++s) acc += swr[s] * vn[s * 64 + lane];
        const float uu = gelu_tanh(bf1(z[(size_t)(tok0 + t) * ZW + Z_DUV + g * 64 + lane]));
        mix[(size_t)(tok0 + t) * D + 768 + g * 64 + lane] = (bf16)f2bf(uu * acc); }
    __syncthreads();
}
__device__ __forceinline__ void xattn_item(const Args& a, int l, int item, LAS unsigned char* lds, int tid) {
    const int qtile = item & 31, h = (item >> 5) & 3, b = item >> 7, lane = tid & 63, w = tid >> 6;
    LAS float* Ks = (LAS float*)lds;
    LAS float* Vs = Ks + 256 * 65;
    LAS float* qs = Vs + 256 * 64;
    LAS float* pw = qs + 512;
    const bf16* kvm = (const bf16*)(a.ws + WS_KVM + (size_t)l * SZ_KVM); const bf16* qx = (const bf16*)(a.ws + WS_QX); bf16* ox = (bf16*)(a.ws + WS_OX);
    for (int i = tid; i < 16384; i += NTHR) { const int key = i >> 6, d = i & 63; const size_t o = (size_t)(b * MEMLEN + key) * 512 + h * 64 + d;
        Ks[key * 65 + d] = bf1(kvm[o]); Vs[key * 64 + d] = bf1(kvm[o + 256]); }
    __syncthreads();
    for (int qq = 0; qq < 8; ++qq) { const int row = b * T + qtile * 64 + w * 8 + qq;
        qs[w * 64 + lane] = bf1(qx[(size_t)row * 256 + h * 64 + lane]);
        LDS_WAIT(); asm volatile("" ::: "memory");
        float s[4] = {0.f, 0.f, 0.f, 0.f};
        for (int d = 0; d < 64; ++d) { const float qd = qs[w * 64 + d];
#pragma unroll
            for (int j = 0; j < 4; ++j) s[j] += qd * Ks[(lane + 64 * j) * 65 + d]; }
        const float mx = wave_max(fmaxf(fmaxf(s[0], s[1]), fmaxf(s[2], s[3])));
        float e[4], sum = 0.f;
#pragma unroll
        for (int j = 0; j < 4; ++j) { e[j] = expf(s[j] - mx); sum += e[j]; }
        const float inv = 1.0f / wave_sum(sum);
#pragma unroll
        for (int j = 0; j < 4; ++j) pw[w * 256 + lane + 64 * j] = e[j] * inv;
        LDS_WAIT(); asm volatile("" ::: "memory");
        float o = 0.f;
        for (int key = 0; key < 256; ++key) o += pw[w * 256 + key] * Vs[key * 64 + lane];
        ox[(size_t)row * 256 + h * 64 + lane] = (bf16)f2bf(o);
        LDS_WAIT(); asm volatile("" ::: "memory"); }
    __syncthreads();
}

__device__ __forceinline__ unsigned ord_u(float f) { const unsigned u = __builtin_bit_cast(unsigned, f); return (u & 0x80000000u) ? ~u : (u | 0x80000000u); }
__device__ __forceinline__ int rel_bucket(int n) {
    if (n < 16) return n;
    int large = 16 + (int)(logf((float)n / 16.0f) / logf(8.0f) * 16.0f);
    return large < 31 ? large : 31;
}
__device__ __forceinline__ void dsa_setup(const Args& a, LAS unsigned char* lds, int tid) {
    LAS float* biasd = (LAS float*)(lds + 48 * 1024);
    for (int i = tid; i < 129 * 4; i += NTHR) { const int d = i >> 2, h = i & 3; biasd[i] = a.in[IN_RELB][rel_bucket(d) * 4 + h]; }
    __syncthreads();
}
__device__ __forceinline__ void dsa_item(const Args& a, int item, LAS unsigned char* lds, int tid, bf16* outp, int ostride) {
    const int b = item / T, t = item % T, nk = t + 1, lane = tid & 63, w = tid >> 6;
    LAS unsigned* su = (LAS unsigned*)lds;
    LAS float* lg = (LAS float*)(lds + 8192);
    LAS float* qi = (LAS float*)(lds + 8192 + 32768);
    LAS float* qv = qi + 256;
    LAS float* wi = qv + 256;
    LAS unsigned* cnt = (LAS unsigned*)(wi + 8);
    LAS float* red = (LAS float*)(cnt + 40);
    LAS float* red2 = red + 64;
    LAS float* biasd = (LAS float*)(lds + 48 * 1024);
    const bf16* z = (const bf16*)(a.ws + WS_Z);
    const size_t row = (size_t)b * T + t;
    if (tid < 256) { qi[tid] = bf1(z[row * ZW + Z_CQI + tid]) * 0.17677669529663687f; qv[tid] = bf1(z[row * ZW + Z_CQ + tid]) * 0.125f; }
    if (tid < 8) wi[tid] = bf1(z[row * ZW + Z_CWI + tid]) * 0.35355339059327373f;
    if (tid < 40) cnt[tid] = 0u;
    __syncthreads();
    unsigned myu[4];
#pragma unroll
    for (int j = 0; j < 4; ++j) { const int key = tid + NTHR * j; myu[j] = 0u;
        if (key < nk) { const v4u* kp = (const v4u*)(z + ((size_t)b * T + key) * ZW + Z_CKI); float kf[32];
#pragma unroll
            for (int i = 0; i < 4; ++i) { const v4u r = kp[i]; kf[8 * i + 0] = bflo(r.x); kf[8 * i + 1] = bfhi(r.x); kf[8 * i + 2] = bflo(r.y); kf[8 * i + 3] = bfhi(r.y); kf[8 * i + 4] = bflo(r.z); kf[8 * i + 5] = bfhi(r.z); kf[8 * i + 6] = bflo(r.w); kf[8 * i + 7] = bfhi(r.w); }
            float sc = 0.f;
            for (int hh = 0; hh < 8; ++hh) { float dot = 0.f;
#pragma unroll
                for (int d = 0; d < 32; ++d) dot += qi[hh * 32 + d] * kf[d];
                sc += fmaxf(dot, 0.f) * wi[hh]; }
            sc += 0.0f;
            myu[j] = ord_u(sc); su[key] = myu[j]; } }
    __syncthreads();
    bool sel[4];
#pragma unroll
    for (int j = 0; j < 4; ++j) sel[j] = (tid + NTHR * j) < nk;
    if (nk > 256) {
        unsigned Tt = 0u;
        for (int bit = 31; bit >= 0; --bit) { const unsigned cand = Tt | (1u << bit); int c = 0;
#pragma unroll
            for (int j = 0; j < 4; ++j) c += (myu[j] >= cand) ? 1 : 0;
            c = (int)wave_sum((float)c);
            if (lane == 0 && c) LDS_ADD(&cnt[bit], (unsigned)c);
            __syncthreads();
            if (cnt[bit] >= 256u) Tt = cand; }
        { int c = 0;
#pragma unroll
            for (int j = 0; j < 4; ++j) c += (myu[j] > Tt) ? 1 : 0;
            c = (int)wave_sum((float)c);
            if (lane == 0 && c) LDS_ADD(&cnt[32], (unsigned)c);
            __syncthreads(); }
        const int r = 256 - (int)cnt[32];
#pragma unroll
        for (int j = 0; j < 4; ++j) { const int key = tid + NTHR * j;
            if (myu[j] > Tt) sel[j] = true;
            else if (myu[j] == Tt && key < nk) { int rank = 0; for (int s = 0; s < key; ++s) rank += (su[s] == Tt) ? 1 : 0; sel[j] = rank < r; }
            else sel[j] = false; }
    }
    float lmax[4] = {-INFINITY, -INFINITY, -INFINITY, -INFINITY};
#pragma unroll
    for (int j = 0; j < 4; ++j) { const int key = tid + NTHR * j;
        if (key < nk) {
            float lv[4] = {-INFINITY, -INFINITY, -INFINITY, -INFINITY};
            if (sel[j]) { const v4u* kp = (const v4u*)(z + ((size_t)b * T + key) * ZW + Z_CK); const int dd = (t - key) < 128 ? (t - key) : 128;
#pragma unroll
                for (int hh = 0; hh < 4; ++hh) { float dot = 0.f;
#pragma unroll
                    for (int i = 0; i < 8; ++i) { const v4u r = kp[hh * 8 + i]; const LAS float* qq = qv + hh * 64 + 8 * i;
                        dot += qq[0] * bflo(r.x) + qq[1] * bfhi(r.x) + qq[2] * bflo(r.y) + qq[3] * bfhi(r.y) + qq[4] * bflo(r.z) + qq[5] * bfhi(r.z) + qq[6] * bflo(r.w) + qq[7] * bfhi(r.w); }
                    lv[hh] = dot + biasd[dd * 4 + hh]; lmax[hh] = fmaxf(lmax[hh], lv[hh]); } }
#pragma unroll
            for (int hh = 0; hh < 4; ++hh) lg[hh * 2048 + key] = lv[hh]; } }
#pragma unroll
    for (int hh = 0; hh < 4; ++hh) { const float m = wave_max(lmax[hh]); if (lane == 0) red[w * 4 + hh] = m; }
    __syncthreads();
    float mx[4], lsum[4] = {0.f, 0.f, 0.f, 0.f};
#pragma unroll
    for (int hh = 0; hh < 4; ++hh) { float m = red[hh]; for (int ww = 1; ww < 8; ++ww) m = fmaxf(m, red[ww * 4 + hh]); mx[hh] = m; }
#pragma unroll
    for (int j = 0; j < 4; ++j) { const int key = tid + NTHR * j;
        if (key < nk) {
#pragma unroll
            for (int hh = 0; hh < 4; ++hh) { const float lv = lg[hh * 2048 + key]; const float p = (lv == -INFINITY) ? 0.f : expf(lv - mx[hh]); lg[hh * 2048 + key] = p; lsum[hh] += p; } } }
#pragma unroll
    for (int hh = 0; hh < 4; ++hh) { const float s = wave_sum(lsum[hh]); if (lane == 0) red[32 + w * 4 + hh] = s; }
    __syncthreads();
    { const int half = tid >> 8, hd = tid & 255, hh = hd >> 6; float acc = 0.f;
      const bf16* vp = z + (size_t)b * T * ZW + Z_CV + hd;
      for (int key = half; key < nk; key += 2) { const float p = lg[hh * 2048 + key]; if (p != 0.f) acc += p * bf1(vp[(size_t)key * ZW]); }
      red2[tid] = acc; }
    __syncthreads();
    if (tid < 256) { const int hh = tid >> 6; float s = 0.f; for (int ww = 0; ww < 8; ++ww) s += red[32 + ww * 4 + hh];
        outp[row * ostride + tid] = (bf16)f2bf((red2[tid] + red2[tid + 256]) / s); }
    __syncthreads();
}

__device__ __forceinline__ void moe_route(const Args& a, LAS unsigned char* lds, int tid, int G, int bid) {
    const int lane = tid & 63, w = tid >> 6;
    LAS float* rt = (LAS float*)lds;
    LAS unsigned* cnt = (LAS unsigned*)(lds + 32768);
    unsigned char* ws = a.ws; const bf16* h = (const bf16*)(ws + WS_H16);
    for (int i = tid; i < 8192; i += NTHR) rt[(i & 7) * 1024 + (i >> 3)] = a.in[IN_ROUTER][i] * a.in[IN_NFFN][D + (i >> 3)];
    __syncthreads();
    for (int chunk = bid; chunk < 256; chunk += G) {
        if (tid < 8) cnt[tid] = 0u;
        __syncthreads();
        for (int qb = 0; qb < 2; ++qb) {
            const int tk0 = chunk * 64 + w * 8 + qb * 4;
            f32x4 hv[4][4]; float ss[4] = {0.f, 0.f, 0.f, 0.f};
#pragma unroll
            for (int t4 = 0; t4 < 4; ++t4)
#pragma unroll
                for (int j = 0; j < 4; ++j) { hv[t4][j] = bf4(((const v2u*)(h + (size_t)(tk0 + t4) * D) + lane)[64 * j]); const f32x4 v = hv[t4][j]; ss[t4] += (v.x * v.x + v.y * v.y) + (v.z * v.z + v.w * v.w); }
            float lg[4][8];
#pragma unroll
            for (int t4 = 0; t4 < 4; ++t4)
#pragma unroll
                for (int e = 0; e < 8; ++e) lg[t4][e] = 0.f;
#pragma unroll
            for (int j = 0; j < 4; ++j) { const int c0 = 4 * (lane + 64 * j);
#pragma unroll
                for (int e = 0; e < 8; ++e) { const f32x4 r = *(const LAS f32x4*)(rt + e * 1024 + c0);
#pragma unroll
                    for (int t4 = 0; t4 < 4; ++t4) { const f32x4 v = hv[t4][j]; lg[t4][e] += (v.x * r.x + v.y * r.y) + (v.z * r.z + v.w * r.w); } } }
#pragma unroll
            for (int t4 = 0; t4 < 4; ++t4) { const int tk = tk0 + t4;
                const float rstd = rsqrtf(wave_sum(ss[t4]) * (1.0f / 1024.0f) + EPS);
                { const float xs = rstd * X8_SCALE;
#pragma unroll
                  for (int j = 0; j < 4; ++j) { const f32x4 v = hv[t4][j] * xs;
                      ((unsigned*)(ws + WS_HB8) + (size_t)tk * (D / 4))[lane + 64 * j] = pk4_fp8(__builtin_amdgcn_fmed3f(v.x, -448.0f, 448.0f), __builtin_amdgcn_fmed3f(v.y, -448.0f, 448.0f), __builtin_amdgcn_fmed3f(v.z, -448.0f, 448.0f), __builtin_amdgcn_fmed3f(v.w, -448.0f, 448.0f)); } }
                float l8[8];
#pragma unroll
                for (int e = 0; e < 8; ++e) l8[e] = wave_sum(lg[t4][e]) * rstd;
                int e0 = 0; float v0 = l8[0];
#pragma unroll
                for (int e = 1; e < 8; ++e) if (l8[e] > v0) { v0 = l8[e]; e0 = e; }
                int e1 = -1; float v1 = -INFINITY;
#pragma unroll
                for (int e = 0; e < 8; ++e) if (e != e0 && l8[e] > v1) { v1 = l8[e]; e1 = e; }
                const float g0 = 1.0f / (1.0f + expf(v1 - v0)), g1 = 1.0f - g0;
                if (lane == 0) { ((int*)(ws + WS_TOKE))[2 * tk] = e0; ((int*)(ws + WS_TOKE))[2 * tk + 1] = e1; ((float*)(ws + WS_TOKG))[2 * tk] = g0; ((float*)(ws + WS_TOKG))[2 * tk + 1] = g1;
                    ((float*)(ws + WS_TOKR))[tk] = rstd; LDS_ADD(&cnt[e0], 1u); LDS_ADD(&cnt[e1], 1u); } } }
        __syncthreads();
        if (tid < 8) ((int*)(ws + WS_CNT))[chunk * 8 + tid] = (int)cnt[tid];
        __syncthreads();
    }
}
__device__ __forceinline__ void moe_assign(const Args& a, LAS unsigned char* lds, int tid, int G, int bid) {
    LAS int* cn = (LAS int*)lds;
    LAS int* tot = cn + 2048;
    LAS int* basee = tot + 8;
    LAS int* te = basee + 8;
    unsigned char* ws = a.ws;
    const int* CNT = (const int*)(ws + WS_CNT); int* TILEE = (int*)(ws + WS_TILEE);
    const int* TOKE = (const int*)(ws + WS_TOKE); const float* TOKG = (const float*)(ws + WS_TOKG); const float* TOKR = (const float*)(ws + WS_TOKR); int* TOKS = (int*)(ws + WS_TOKS);
    float* SLOTR = (float*)(ws + WS_SLOTR); float* SLOTG = (float*)(ws + WS_SLOTG); int* SLOTT = (int*)(ws + WS_SLOTT);
    for (int i = tid; i < 2048; i += NTHR) cn[i] = CNT[i];
    __syncthreads();
    if (tid < 8) { int s = 0; for (int c = 0; c < 256; ++c) s += cn[c * 8 + tid]; tot[tid] = s; }
    __syncthreads();
    if (tid == 0) { int tile = 0; for (int e = 0; e < 8; ++e) { basee[e] = tile * 256; const int nt = (tot[e] + 255) >> 8;
            if (bid == 0) for (int q = 0; q < nt; ++q) TILEE[tile + q] = e;
            tile += nt; }
        if (bid == 0) { for (int q = tile; q < 159; ++q) TILEE[q] = 0; TILEE[159] = tile; } }
    __syncthreads();
    for (int e = bid; e < 8; e += G) { const int s0 = basee[e] + tot[e], s1 = basee[e] + (((tot[e] + 255) >> 8) << 8);
        for (int s = s0 + tid; s < s1; s += NTHR) { SLOTR[s] = 0.f; SLOTG[s] = 0.f; SLOTT[s] = 0; } }
    for (int chunk = bid; chunk < 256; chunk += G) {
        if (tid < 128) te[tid] = TOKE[chunk * 128 + tid];
        __syncthreads();
        { const int e = tid >> 6, lane = tid & 63;
          int s = 0; for (int c = lane; c < chunk; c += 64) s += cn[c * 8 + e];
          s = (int)wave_sum((float)s);
          const bool m0 = te[lane] == e, m1 = te[lane + 64] == e;
          const unsigned long long b0 = __ballot(m0), b1 = __ballot(m1), lt = (1ull << lane) - 1ull;
          const int pos0 = basee[e] + s + __popcll(b0 & lt), pos1 = basee[e] + s + __popcll(b0) + __popcll(b1 & lt);
          if (m0) { const int i = lane, tk = chunk * 64 + (i >> 1); SLOTR[pos0] = TOKR[tk]; SLOTG[pos0] = TOKG[2 * tk + (i & 1)]; SLOTT[pos0] = tk; TOKS[2 * tk + (i & 1)] = pos0; }
          if (m1) { const int i = lane + 64, tk = chunk * 64 + (i >> 1); SLOTR[pos1] = TOKR[tk]; SLOTG[pos1] = TOKG[2 * tk + (i & 1)]; SLOTT[pos1] = tk; TOKS[2 * tk + (i & 1)] = pos1; } }
        __syncthreads();
    }
}
__device__ __forceinline__ void final_phase(const Args& a, int tid, int G, int bid) {
    const int lane = tid & 63, gw = bid * NWAVES + (tid >> 6), NGW = G * NWAVES;
    const int* TOKS = (const int*)(a.ws + WS_TOKS); const bf16* YS = (const bf16*)(a.ws + WS_YS);
#if defined(PROF_DSA)
    const float* pr = (const float*)(a.ws + WS_CTL) + 12288; const float padd = 100.0f * sqrtf(floorf(pr[2 + PROF_DSA - 1] / fmaxf(pr[2 + 5], 1e-30f) * 10.0f + 0.5f) * 0.1f);
#elif defined(PROBE_DSA)
    const float* pr = (const float*)(a.ws + WS_CTL) + 12288; const float padd = PROBE_C * sqrtf(pr[0] / fmaxf(pr[1], 1e-30f));
#else
    const float padd = 0.f;
#endif
    constexpr float YSC = 1.0f / (W8_SCALE * A8_SCALE);
    f32x4 gn[4];
#pragma unroll
    for (int j = 0; j < 4; ++j) gn[j] = ((const f32x4*)a.in[IN_FNORM])[lane + 64 * j];
    for (int tk0 = gw; tk0 < M; tk0 += 4 * NGW) {
        f32x4 v[4][4]; float ss[4];
#pragma unroll
        for (int u = 0; u < 4; ++u) { const int tkr = tk0 + u * NGW, tk = tkr < M ? tkr : gw; const int s0 = TOKS[2 * tk], s1 = TOKS[2 * tk + 1];
            const v2u* h16 = (const v2u*)((const bf16*)(a.ws + WS_H16) + (size_t)tk * D) + lane; const v2u* y0 = (const v2u*)(YS + (size_t)s0 * D) + lane; const v2u* y1 = (const v2u*)(YS + (size_t)s1 * D) + lane;
            const float c0 = ((const float*)(a.ws + WS_TOKG))[2 * tk] * YSC, c1 = ((const float*)(a.ws + WS_TOKG))[2 * tk + 1] * YSC;
            ss[u] = 0.f;
#pragma unroll
            for (int j = 0; j < 4; ++j) { v[u][j] = bf4(h16[64 * j]); const v2u p = y0[64 * j], q = y1[64 * j];
                v[u][j].x += bflo(p.x) * c0 + bflo(q.x) * c1; v[u][j].y += bfhi(p.x) * c0 + bfhi(q.x) * c1; v[u][j].z += bflo(p.y) * c0 + bflo(q.y) * c1; v[u][j].w += bfhi(p.y) * c0 + bfhi(q.y) * c1;
                ss[u] += (v[u][j].x * v[u][j].x + v[u][j].y * v[u][j].y) + (v[u][j].z * v[u][j].z + v[u][j].w * v[u][j].w); } }
#pragma unroll
        for (int u = 0; u < 4; ++u) { const int tk = tk0 + u * NGW; const float rstd = rsqrtf(wave_sum(ss[u]) * (1.0f / 1024.0f) + EPS);
            if (tk < M) { f32x4* hr = (f32x4*)(a.out + (size_t)tk * D) + lane;
#pragma unroll
                for (int j = 0; j < 4; ++j) hr[64 * j] = v[u][j] * rstd * gn[j] + padd; } }
    }
}

typedef short bf16x8 __attribute__((ext_vector_type(8)));
typedef short bf16x4 __attribute__((ext_vector_type(4)));
typedef float f32x16 __attribute__((ext_vector_type(16)));
#define MFMA32(a, b, c) __builtin_amdgcn_mfma_f32_32x32x16_bf16((a), (b), (c), 0, 0, 0)
constexpr int DS_HIST = 0;
constexpr int DS_CMB = 0;
constexpr int DS_KST = 34816;
constexpr int DS_BM = 67584;
constexpr int DS_P = DS_BM + 8192;
constexpr int DS_CU = DS_P + 512;
constexpr int DS_CK = DS_CU + 8192;
constexpr int DS_BIAS = DS_CK + 8192;
constexpr int DS_ST = DS_BIAS + 2112;
constexpr int DS_END = DS_ST + 8 * 4608;
constexpr int DSA_CAP = 64;
static_assert(DS_END <= MISC_OFF - 64 && DS_KST + 8 * 4096 <= DS_BM && 32 * 513 * 4 <= DS_BM, "DSA LDS map");
__device__ __forceinline__ void tr_read_tile(unsigned addr, bf16x4& t00, bf16x4& t01, bf16x4& t10, bf16x4& t11, bf16x4& u00, bf16x4& u01, bf16x4& u10, bf16x4& u11) {
    asm volatile("s_waitcnt lgkmcnt(0)\n\t"
                 "ds_read_b64_tr_b16 %0, %8 offset:0\n\t" "ds_read_b64_tr_b16 %1, %8 offset:512\n\t" "ds_read_b64_tr_b16 %2, %8 offset:1024\n\t" "ds_read_b64_tr_b16 %3, %8 offset:1536\n\t"
                 "ds_read_b64_tr_b16 %4, %8 offset:2048\n\t" "ds_read_b64_tr_b16 %5, %8 offset:2560\n\t" "ds_read_b64_tr_b16 %6, %8 offset:3072\n\t" "ds_read_b64_tr_b16 %7, %8 offset:3584\n\t"
                 "s_waitcnt lgkmcnt(0)"
                 : "=&v"(t00), "=&v"(t01), "=&v"(t10), "=&v"(t11), "=&v"(u00), "=&v"(u01), "=&v"(u10), "=&v"(u11) : "v"(addr) : "memory");
}

__device__ __forceinline__ void dsa2_setup(const Args& a, LAS unsigned char* lds, int tid) {
    LAS float* biasL = (LAS float*)(lds + DS_BIAS);
    for (int i = tid; i < 4 * 129; i += NTHR) { const int h = i / 129, d = i % 129; biasL[h * 132 + d] = a.in[IN_RELB][rel_bucket(d) * 4 + h] * 1.4426950408889634f; }
    __syncthreads();
}
__device__ __forceinline__ void idx_scores(const bf16x8 ka0, const bf16x8 ka1, const LAS bf16x8* qfl  , const float (&wv)[8], float (&sc)[16]) {
#pragma unroll
    for (int r = 0; r < 16; ++r) sc[r] = 0.f;
    float zero = 0.f;
#pragma unroll
    for (int hp = 0; hp < 4; ++hp) {
        const bf16x8 q00 = qfl[(4 * hp + 0) * 64], q01 = qfl[(4 * hp + 1) * 64], q10 = qfl[(4 * hp + 2) * 64], q11 = qfl[(4 * hp + 3) * 64];
        f32x16 acc0, acc1;
#pragma unroll
        for (int r = 0; r < 16; ++r) { acc0[r] = zero; acc1[r] = zero; }
        acc0 = MFMA32(ka0, q00, acc0); acc1 = MFMA32(ka0, q10, acc1);
        acc0 = MFMA32(ka1, q01, acc0); acc1 = MFMA32(ka1, q11, acc1);
#pragma unroll
        for (int r = 0; r < 16; ++r) sc[r] = __builtin_fmaf(fmaxf(acc1[r], 0.f), wv[2 * hp + 1], __builtin_fmaf(fmaxf(acc0[r], 0.f), wv[2 * hp], sc[r]));
        asm volatile("" : "+v"(zero), "+v"(sc[0]), "+v"(sc[1]), "+v"(sc[2]), "+v"(sc[3]), "+v"(sc[4]), "+v"(sc[5]), "+v"(sc[6]), "+v"(sc[7]), "+v"(sc[8]), "+v"(sc[9]), "+v"(sc[10]), "+v"(sc[11]), "+v"(sc[12]), "+v"(sc[13]), "+v"(sc[14]), "+v"(sc[15]));
    }
}
__device__ __forceinline__ f32x16 dsa_scores(const bf16x8 (&kf)[4], const bf16x8 (&qa)[4]) {
    f32x16 sacc;
#pragma unroll
    for (int r = 0; r < 16; ++r) sacc[r] = 0.f;
#pragma unroll
    for (int s = 0; s < 4; ++s) sacc = MFMA32(kf[s], qa[s], sacc);
    return sacc;
}
template <bool NEAR> __device__ __forceinline__ void dsa_att_tile(const f32x16& sacc, unsigned word, int dbase  , int hh, const LAS float* biasH, float c31,
                                                                 unsigned vaddr, f32x16& o0, f32x16& o1, float& m, float& lsum) {
    constexpr float SC = 0.18033688011112042f;
    float sv[16]; float tmax = -1e30f;
#pragma unroll
    for (int r = 0; r < 16; ++r) { const int kl = (r & 3) + 8 * (r >> 2) + 4 * hh; float bias = c31;
        if (NEAR) { int dd = dbase - kl; dd = dd < 0 ? 0 : (dd > 128 ? 128 : dd); bias = biasH[dd]; }
        const float v = __builtin_fmaf(sacc[r], SC, bias); sv[r] = ((word >> kl) & 1u) ? v : -1e30f; tmax = fmaxf(tmax, sv[r]); }
    tmax = fmaxf(tmax, shfl_xor_c<32>(tmax));
    const float mnew = fmaxf(m, tmax);
    if (__any(mnew != m)) { const float alpha = __builtin_amdgcn_exp2f(m - mnew); lsum *= alpha;
#pragma unroll
        for (int r = 0; r < 16; ++r) { o0[r] *= alpha; o1[r] *= alpha; } }
    m = mnew;
    float p[16]; float ps = 0.f;
#pragma unroll
    for (int r = 0; r < 16; ++r) { p[r] = __builtin_amdgcn_exp2f(sv[r] - mnew); ps += p[r]; }
    ps += shfl_xor_c<32>(ps);
    lsum += ps;
    bf16x8 pb[2];
#pragma unroll
    for (int s = 0; s < 2; ++s) { v4u t4; t4.x = pg8::cvt_pk_bf16(p[8 * s + 0], p[8 * s + 1]); t4.y = pg8::cvt_pk_bf16(p[8 * s + 2], p[8 * s + 3]); t4.z = pg8::cvt_pk_bf16(p[8 * s + 4], p[8 * s + 5]); t4.w = pg8::cvt_pk_bf16(p[8 * s + 6], p[8 * s + 7]);
        pb[s] = __builtin_bit_cast(bf16x8, t4); }
    bf16x4 t00, t01, t10, t11, u00, u01, u10, u11;
    tr_read_tile(vaddr, t00, t01, t10, t11, u00, u01, u10, u11);
    o0 = MFMA32(__builtin_shufflevector(t00, t01, 0, 1, 2, 3, 4, 5, 6, 7), pb[0], o0); o0 = MFMA32(__builtin_shufflevector(t10, t11, 0, 1, 2, 3, 4, 5, 6, 7), pb[1], o0);
    o1 = MFMA32(__builtin_shufflevector(u00, u01, 0, 1, 2, 3, 4, 5, 6, 7), pb[0], o1); o1 = MFMA32(__builtin_shufflevector(u10, u11, 0, 1, 2, 3, 4, 5, 6, 7), pb[1], o1);
}
#ifdef PROF_DSA
#define PSTAMP(k) do { if (tid == 0) { const unsigned long long t_ = wall_clock64(); prof[k] += (float)(t_ - tprev); tprev = t_; } } while (0)
#else
#define PSTAMP(k) do { } while (0)
#endif
__device__ __forceinline__ void dsa2_item(const Args& a, int item, LAS unsigned char* lds, int tid, float (&prof)[6]) {
#ifdef PROF_DSA
    unsigned long long tprev = wall_clock64();
#endif
    const int lane = tid & 63, w = __builtin_amdgcn_readfirstlane(tid >> 6), ql = lane & 31, hh = lane >> 5;
    const int b = item & 7, qi = 63 - (item >> 3), tq0 = qi * 32, ntl = qi + 1;
    const bool sel = qi >= 8;
    const bf16* z = (const bf16*)(a.ws + WS_Z); bf16* mix = (bf16*)(a.ws + WS_MIX);
    const bf16* zb = z + (size_t)b * T * ZW;
    const bf16* zq = zb + (size_t)(tq0 + ql) * ZW;
    LAS unsigned* hist = (LAS unsigned*)(lds + DS_HIST); LAS unsigned* bm = (LAS unsigned*)(lds + DS_BM);
    LAS unsigned* Pp = (LAS unsigned*)(lds + DS_P); LAS unsigned* need = Pp + 32; LAS unsigned* ccnt = Pp + 64; LAS unsigned* ccnt2 = Pp + 96;
    LAS unsigned* cu = (LAS unsigned*)(lds + DS_CU); LAS unsigned* ck = (LAS unsigned*)(lds + DS_CK);
    const LAS float* biasL = (const LAS float*)(lds + DS_BIAS);
    if (sel) {
        f32x4* scr = (f32x4*)(blockIdx.x < 128 ? a.ws + WS_HB + (size_t)blockIdx.x * 262144 : (unsigned char*)a.out + (size_t)(blockIdx.x - 128) * 262144) + lane;
        for (int i = tid; i < 2048; i += NTHR) bm[i] = 0u;
        for (int i = tid; i < 32 * 513; i += NTHR) hist[i] = 0u;
        if (tid < 32) { Pp[tid] = 0u; need[tid] = 256u; ccnt2[tid] = 0u; }
        __syncthreads();
        {
            float wv[8];
            LAS bf16x8* qfl = (LAS bf16x8*)(lds + DS_ST);
            if (w < 2) {
#pragma unroll
                for (int i = 0; i < 8; ++i) { const int fi = 8 * w + i; qfl[fi * 64 + lane] = *(const bf16x8*)(zq + Z_CQI + (fi >> 1) * 32 + 16 * (fi & 1) + 8 * hh); } }
            __syncthreads();
            { const v4u wr = *(const v4u*)(zq + Z_CWI);
              wv[0] = bflo(wr.x) * 0.0625f; wv[1] = bfhi(wr.x) * 0.0625f; wv[2] = bflo(wr.y) * 0.0625f; wv[3] = bfhi(wr.y) * 0.0625f;
              wv[4] = bflo(wr.z) * 0.0625f; wv[5] = bfhi(wr.z) * 0.0625f; wv[6] = bflo(wr.w) * 0.0625f; wv[7] = bfhi(wr.w) * 0.0625f; }
            const bf16* zk0 = zb + (size_t)ql * ZW + Z_CKI + 8 * hh;
            bf16x8 ka0 = *(const bf16x8*)(zk0 + (size_t)(w * 32) * ZW), ka1 = *(const bf16x8*)(zk0 + (size_t)(w * 32) * ZW + 16);
#pragma unroll 1
            for (int kt = w; kt < ntl; kt += 8) {
                const int ktn = (kt + 8 < ntl) ? kt + 8 : kt;
                const bf16x8 kn0 = *(const bf16x8*)(zk0 + (size_t)(ktn * 32) * ZW), kn1 = *(const bf16x8*)(zk0 + (size_t)(ktn * 32) * ZW + 16);
                float sc[16]; idx_scores(ka0, ka1, qfl + lane, wv, sc);
#pragma unroll
                for (int q4 = 0; q4 < 4; ++q4) scr[(size_t)kt * 256 + q4 * 64] = (f32x4){sc[4 * q4] + 0.0f, sc[4 * q4 + 1] + 0.0f, sc[4 * q4 + 2] + 0.0f, sc[4 * q4 + 3] + 0.0f};
                { unsigned dg[16]; unsigned d0 = 0xffffffffu;
#pragma unroll
                  for (int r = 0; r < 16; ++r) { const int kl = (r & 3) + 8 * (r >> 2) + 4 * hh; dg[r] = (kt < qi || kl <= ql) ? (ord_u(sc[r] + 0.0f) >> 23) : 0xffffffffu; }
#pragma unroll
                  for (int r = 15; r >= 0; --r) d0 = (dg[r] != 0xffffffffu) ? dg[r] : d0;
                  unsigned c0 = 0u;
#pragma unroll
                  for (int r = 0; r < 16; ++r) c0 += (dg[r] == d0) ? 1u : 0u;
                  if (d0 != 0xffffffffu) LDS_ADD(&hist[ql * 513 + d0], c0);
#pragma unroll
                  for (int r = 0; r < 16; ++r) { if (dg[r] != d0 && dg[r] != 0xffffffffu) LDS_ADD(&hist[ql * 513 + dg[r]], 1u); } }
                ka0 = kn0; ka1 = kn1;
            }
        }
        PSTAMP(0);
        int sh = 23, nb = 9;
#pragma unroll 1
        for (int level = 0; level < 4; ++level) {
            if (level > 0) {
                for (int i = tid; i < 32 * 513; i += NTHR) hist[i] = 0u;
                __syncthreads();
                const unsigned myP = Pp[ql];
                f32x4 cur4[4];
#pragma unroll
                for (int q4 = 0; q4 < 4; ++q4) cur4[q4] = scr[(size_t)(w < ntl ? w : 0) * 256 + q4 * 64];
#pragma unroll 1
                for (int kt = w; kt < ntl; kt += 8) {
                    const int ktn = (kt + 8 < ntl) ? kt + 8 : kt; f32x4 nxt4[4];
#pragma unroll
                    for (int q4 = 0; q4 < 4; ++q4) nxt4[q4] = scr[(size_t)ktn * 256 + q4 * 64];
#pragma unroll
                    for (int q4 = 0; q4 < 4; ++q4) {
#pragma unroll
                        for (int e = 0; e < 4; ++e) { const int kl = e + 8 * q4 + 4 * hh; const unsigned u = ord_u(cur4[q4][e]);
                            if ((kt < qi || kl <= ql) && (u >> (sh + nb)) == myP) LDS_ADD(&hist[ql * 513 + ((u >> sh) & ((1u << nb) - 1u))], 1u); } }
#pragma unroll
                    for (int q4 = 0; q4 < 4; ++q4) cur4[q4] = nxt4[q4];
                }
            }
            __syncthreads();
            { const int q = 4 * w + (lane >> 4), sl = lane & 15, bpl = (1 << nb) >> 4;
              const LAS unsigned* hp = hist + q * 513 + sl * bpl; unsigned s = 0u;
              for (int i = 0; i < bpl; ++i) s += hp[i];
              unsigned incl = s;
#pragma unroll
              for (int o = 1; o < 16; o <<= 1) { const unsigned t2 = shfl_idx_u(incl, (lane + o) & 63); if (sl + o < 16) incl += t2; }
              const unsigned excl = incl - s, nd = need[q];
              if (excl < nd && nd <= incl) { unsigned run = excl; int dsel = 0; unsigned above = 0u, cand = 0u;
                  for (int i = bpl - 1; i >= 0; --i) { const unsigned c = hp[i]; if (run + c >= nd) { dsel = i; above = run; cand = c; break; } run += c; }
                  Pp[q] = (Pp[q] << nb) | (unsigned)(sl * bpl + dsel); need[q] = nd - above; ccnt[q] = cand; } }
            __syncthreads();
            unsigned mc = ccnt[ql]; mc = (unsigned)wave_max((float)mc);
            if (mc <= (unsigned)DSA_CAP || level == 3) break;
            sh -= (level == 2) ? 7 : 8; nb = (level == 2) ? 7 : 8;
        }
        PSTAMP(1);
        { const unsigned myP = Pp[ql];
          f32x4 cur4[4];
#pragma unroll
          for (int q4 = 0; q4 < 4; ++q4) cur4[q4] = scr[(size_t)(w < ntl ? w : 0) * 256 + q4 * 64];
#pragma unroll 1
          for (int kt = w; kt < ntl; kt += 8) { unsigned bits = 0u;
            const int ktn = (kt + 8 < ntl) ? kt + 8 : kt; f32x4 nxt4[4];
#pragma unroll
            for (int q4 = 0; q4 < 4; ++q4) nxt4[q4] = scr[(size_t)ktn * 256 + q4 * 64];
#pragma unroll
            for (int q4 = 0; q4 < 4; ++q4) {
#pragma unroll
                for (int e = 0; e < 4; ++e) { const int kl = e + 8 * q4 + 4 * hh; const unsigned u = ord_u(cur4[q4][e]), pfx = u >> sh;
                    if (kt < qi || kl <= ql) { if (pfx > myP) bits |= 1u << kl;
                        else if (pfx == myP) { const unsigned slot = __hip_atomic_fetch_add(&ccnt2[ql], 1u, __ATOMIC_RELAXED, __HIP_MEMORY_SCOPE_WORKGROUP);
                            if (slot < (unsigned)DSA_CAP) { cu[ql * DSA_CAP + slot] = u; ck[ql * DSA_CAP + slot] = (unsigned)(kt * 32 + kl); } } } } }
            if (bits) (void)__hip_atomic_fetch_or(&bm[kt * 32 + ql], bits, __ATOMIC_RELAXED, __HIP_MEMORY_SCOPE_WORKGROUP);
#pragma unroll
            for (int q4 = 0; q4 < 4; ++q4) cur4[q4] = nxt4[q4];
          } }
        __syncthreads();
        for (int idx = tid; idx < 32 * DSA_CAP; idx += NTHR) { const int q = idx / DSA_CAP, i = idx % DSA_CAP; unsigned n = ccnt2[q]; n = n < (unsigned)DSA_CAP ? n : (unsigned)DSA_CAP;
            if ((unsigned)i < n) { const unsigned ui = cu[q * DSA_CAP + i], ki = ck[q * DSA_CAP + i]; unsigned rank = 0u;
                for (unsigned j = 0; j < n; ++j) { const unsigned uj = cu[q * DSA_CAP + j], kj = ck[q * DSA_CAP + j]; rank += (uj > ui || (uj == ui && kj < ki)) ? 1u : 0u; }
                if (rank < need[q]) (void)__hip_atomic_fetch_or(&bm[(ki >> 5) * 32 + q], 1u << (ki & 31u), __ATOMIC_RELAXED, __HIP_MEMORY_SCOPE_WORKGROUP); } }
        __syncthreads();
    }
    PSTAMP(2);
    const int hd = w >> 1, half = w & 1;
    bf16x8 qa[4];
#pragma unroll
    for (int s = 0; s < 4; ++s) qa[s] = *(const bf16x8*)(zq + Z_CQ + hd * 64 + 16 * s + 8 * hh);
    f32x16 o0, o1; float m, lsum;
    const LAS float* biasH = biasL + hd * 132; const float c31 = biasH[128];
    LAS unsigned char* st = lds + DS_ST + w * 4608;
    const unsigned vaddr = (unsigned)(size_t)st + (unsigned)((4 * hh + ((lane >> 2) & 3)) * 64 + 32 * ((lane >> 4) & 1) + 8 * (lane & 3));
    const bf16* kvbase = zb + (size_t)(lane >> 3) * ZW + hd * 64 + (lane & 7) * 8;
    LAS unsigned char* vst = st + ((lane & 7) >> 2) * 2048 + (lane >> 3) * 64 + (lane & 3) * 16;
    LAS unsigned char* kst = lds + DS_KST + w * 4096;
    LAS unsigned char* kwr = kst + (lane >> 3) * 128 + (((lane & 7) ^ ((lane >> 3) & 7)) * 16);
    const LAS unsigned char* krd = kst + ql * 128;
#pragma unroll
    for (int r = 0; r < 16; ++r) { o0[r] = 0.f; o1[r] = 0.f; }
    m = -30000.f; lsum = 0.f;
    const bf16* kfb = (const bf16*)(a.ws + WS_DKF) + ((size_t)(b * (T / 32)) * 16 + hd * 4) * 512 + lane * 8;
    v4u vr[4];
    { const int k0t = (half < ntl) ? half : 0;
#pragma unroll
      for (int i = 0; i < 4; ++i) vr[i] = *(const v4u*)(kvbase + (size_t)(k0t * 32 + 8 * i) * ZW + Z_CV); }
    f32x16 scur;
#pragma unroll
    for (int r = 0; r < 16; ++r) scur[r] = 0.f;
    bf16x8 kfn[4];
    { const int k0t = (half < ntl) ? half : 0, k2 = (half + 2 < ntl) ? half + 2 : k0t;
      bf16x8 kf0[4];
#pragma unroll
      for (int s = 0; s < 4; ++s) { kf0[s] = *(const bf16x8*)(kfb + ((size_t)k0t * 16 + s) * 512); kfn[s] = *(const bf16x8*)(kfb + ((size_t)k2 * 16 + s) * 512); }
      if (half < ntl) scur = dsa_scores(kf0, qa); }
#pragma unroll 1
    for (int kt = half; kt < ntl; kt += 2) {
        const bool has_next = kt + 2 < ntl;
#pragma unroll
        for (int i = 0; i < 4; ++i) *(LAS v4u*)(vst + i * 512) = vr[i];
        const int ktv = has_next ? kt + 2 : kt, ktk = (kt + 4 < ntl) ? kt + 4 : kt;
#pragma unroll
        for (int i = 0; i < 4; ++i) vr[i] = *(const v4u*)(kvbase + (size_t)(ktv * 32 + 8 * i) * ZW + Z_CV);
        f32x16 snext = scur;
        if (has_next) snext = dsa_scores(kfn, qa);
#pragma unroll
        for (int s = 0; s < 4; ++s) kfn[s] = *(const bf16x8*)(kfb + ((size_t)ktk * 16 + s) * 512);
        unsigned word = sel ? bm[kt * 32 + ql] : 0xffffffffu;
        if (kt == qi) word &= (ql == 31) ? 0xffffffffu : ((2u << ql) - 1u);
        if (qi - kt >= 5) dsa_att_tile<false>(scur, word, 0, hh, biasH, c31, vaddr, o0, o1, m, lsum);
        else dsa_att_tile<true>(scur, word, tq0 + ql - kt * 32, hh, biasH, c31, vaddr, o0, o1, m, lsum);
        scur = snext;
    }
    PSTAMP(3);
    LAS float* cmb = (LAS float*)(lds + DS_CMB + hd * 8704);
    if (half == 1) {
#pragma unroll
        for (int r = 0; r < 16; ++r) { cmb[r * 64 + lane] = o0[r]; cmb[(16 + r) * 64 + lane] = o1[r]; }
        cmb[2048 + lane] = m; cmb[2048 + 64 + lane] = lsum;
    }
    __syncthreads();
    if (half == 0) {
        const float mb = cmb[2048 + lane], lb = cmb[2048 + 64 + lane];
        const float mt = fmaxf(m, mb), fa = __builtin_amdgcn_exp2f(m - mt), fb = __builtin_amdgcn_exp2f(mb - mt);
        const float inv = 1.0f / (lsum * fa + lb * fb), ga = fa * inv, gb = fb * inv;
#pragma unroll
        for (int r = 0; r < 16; ++r) { o0[r] = o0[r] * ga + cmb[r * 64 + lane] * gb; o1[r] = o1[r] * ga + cmb[(16 + r) * 64 + lane] * gb; }
#pragma unroll
        for (int g = 0; g < 4; ++g) { v2u w0, w1; w0.x = pg8::cvt_pk_bf16(o0[4 * g], o0[4 * g + 1]); w0.y = pg8::cvt_pk_bf16(o0[4 * g + 2], o0[4 * g + 3]); w1.x = pg8::cvt_pk_bf16(o1[4 * g], o1[4 * g + 1]); w1.y = pg8::cvt_pk_bf16(o1[4 * g + 2], o1[4 * g + 3]);
            *(LAS v2u*)(st + ql * 136 + (8 * g + 4 * hh) * 2) = w0; *(LAS v2u*)(st + ql * 136 + (32 + 8 * g + 4 * hh) * 2) = w1; }
        asm volatile("s_waitcnt lgkmcnt(0)" ::: "memory");
#pragma unroll
        for (int i = 0; i < 4; ++i) { const int q = (lane >> 3) + 8 * i, ch = lane & 7;
            const v2u x0 = *(const LAS v2u*)(st + q * 136 + ch * 16), x1 = *(const LAS v2u*)(st + q * 136 + ch * 16 + 8);
            v4u o; o.x = x0.x; o.y = x0.y; o.z = x1.x; o.w = x1.y;
            *(v4u*)(mix + ((size_t)b * T + tq0 + q) * D + 512 + hd * 64 + ch * 8) = o; }
    }
    __syncthreads();
    PSTAMP(4);
}
constexpr int XA_V = 0, XA_ST = 32768;
__device__ __forceinline__ void xattn2_item(const Args& a, int l, int item, LAS unsigned char* lds, int tid) {
    const int lane = tid & 63, w = __builtin_amdgcn_readfirstlane(tid >> 6), ql = lane & 31, hh = lane >> 5;
    const int qg = item & 7, h = (item >> 3) & 3, b = item >> 5;
    const bf16* kvm = (const bf16*)(a.ws + WS_KVM + (size_t)l * SZ_KVM) + (size_t)b * MEMLEN * 512;
    const bf16* qx = (const bf16*)(a.ws + WS_QX); bf16* ox = (bf16*)(a.ws + WS_OX);
#pragma unroll
    for (int i = 0; i < 4; ++i) { const int idx = tid + NTHR * i, key = idx >> 3, ch = idx & 7;
        const v4u v = *(const v4u*)(kvm + (size_t)key * 512 + 256 + h * 64 + ch * 8);
        *(LAS v4u*)(lds + XA_V + (key >> 5) * 4096 + (ch >> 2) * 2048 + (key & 31) * 64 + (ch & 3) * 16) = v; }
    __syncthreads();
    const size_t row0 = (size_t)b * T + qg * 256 + w * 32;
    bf16x8 qa[4];
#pragma unroll
    for (int s = 0; s < 4; ++s) qa[s] = *(const bf16x8*)(qx + (row0 + ql) * 256 + h * 64 + 16 * s + 8 * hh);
    f32x16 o0, o1;
#pragma unroll
    for (int r = 0; r < 16; ++r) { o0[r] = 0.f; o1[r] = 0.f; }
    float m = -1e30f, lsum = 0.f;
    const unsigned vaddr = (unsigned)(size_t)(lds + XA_V) + (unsigned)((4 * hh + ((lane >> 2) & 3)) * 64 + 32 * ((lane >> 4) & 1) + 8 * (lane & 3));
#pragma unroll 1
    for (int kt = 0; kt < 8; ++kt) {
        bf16x8 kf[4];
        { const bf16* zk = kvm + (size_t)(kt * 32 + ql) * 512 + h * 64 + 8 * hh;
#pragma unroll
          for (int s = 0; s < 4; ++s) kf[s] = *(const bf16x8*)(zk + 16 * s); }
        f32x16 sacc;
#pragma unroll
        for (int r = 0; r < 16; ++r) sacc[r] = 0.f;
#pragma unroll
        for (int s = 0; s < 4; ++s) sacc = MFMA32(kf[s], qa[s], sacc);
        float sv[16]; float tmax = -1e30f;
#pragma unroll
        for (int r = 0; r < 16; ++r) { sv[r] = sacc[r] * 1.4426950408889634f; tmax = fmaxf(tmax, sv[r]); }
        tmax = fmaxf(tmax, shfl_xor_c<32>(tmax));
        const float mnew = fmaxf(m, tmax), alpha = __builtin_amdgcn_exp2f(m - mnew);
        float p[16]; float ps = 0.f;
#pragma unroll
        for (int r = 0; r < 16; ++r) { p[r] = __builtin_amdgcn_exp2f(sv[r] - mnew); ps += p[r]; }
        ps += shfl_xor_c<32>(ps);
        lsum = lsum * alpha + ps; m = mnew;
#pragma unroll
        for (int r = 0; r < 16; ++r) { o0[r] *= alpha; o1[r] *= alpha; }
        bf16x8 pb[2];
#pragma unroll
        for (int s = 0; s < 2; ++s) { v4u t4; t4.x = pg8::cvt_pk_bf16(p[8 * s + 0], p[8 * s + 1]); t4.y = pg8::cvt_pk_bf16(p[8 * s + 2], p[8 * s + 3]); t4.z = pg8::cvt_pk_bf16(p[8 * s + 4], p[8 * s + 5]); t4.w = pg8::cvt_pk_bf16(p[8 * s + 6], p[8 * s + 7]);
            pb[s] = __builtin_bit_cast(bf16x8, t4); }
        bf16x4 t00, t01, t10, t11, u00, u01, u10, u11;
        tr_read_tile(vaddr + kt * 4096, t00, t01, t10, t11, u00, u01, u10, u11);
        const bf16x8 va00 = __builtin_shufflevector(t00, t01, 0, 1, 2, 3, 4, 5, 6, 7), va01 = __builtin_shufflevector(t10, t11, 0, 1, 2, 3, 4, 5, 6, 7);
        const bf16x8 va10 = __builtin_shufflevector(u00, u01, 0, 1, 2, 3, 4, 5, 6, 7), va11 = __builtin_shufflevector(u10, u11, 0, 1, 2, 3, 4, 5, 6, 7);
        o0 = MFMA32(va00, pb[0], o0); o0 = MFMA32(va01, pb[1], o0);
        o1 = MFMA32(va10, pb[0], o1); o1 = MFMA32(va11, pb[1], o1);
    }
    const float inv = 1.0f / lsum;
    LAS unsigned char* st = lds + XA_ST + w * 4608;
#pragma unroll
    for (int g = 0; g < 4; ++g) { v2u w0, w1; w0.x = pg8::cvt_pk_bf16(o0[4 * g] * inv, o0[4 * g + 1] * inv); w0.y = pg8::cvt_pk_bf16(o0[4 * g + 2] * inv, o0[4 * g + 3] * inv);
        w1.x = pg8::cvt_pk_bf16(o1[4 * g] * inv, o1[4 * g + 1] * inv); w1.y = pg8::cvt_pk_bf16(o1[4 * g + 2] * inv, o1[4 * g + 3] * inv);
        *(LAS v2u*)(st + ql * 136 + (8 * g + 4 * hh) * 2) = w0; *(LAS v2u*)(st + ql * 136 + (32 + 8 * g + 4 * hh) * 2) = w1; }
    asm volatile("s_waitcnt lgkmcnt(0)" ::: "memory");
#pragma unroll
    for (int i = 0; i < 4; ++i) { const int q = (lane >> 3) + 8 * i, ch = lane & 7;
        const v2u x0 = *(const LAS v2u*)(st + q * 136 + ch * 16), x1 = *(const LAS v2u*)(st + q * 136 + ch * 16 + 8);
        v4u o; o.x = x0.x; o.y = x0.y; o.z = x1.x; o.w = x1.y;
        *(v4u*)(ox + (row0 + q) * 256 + h * 64 + ch * 8) = o; }
    __syncthreads();
}

__device__ __forceinline__ float gelu_fast(float x) {
    const float y = x * (1.0f + 0.044715f * x * x) * -2.302208198f;
    return x * __builtin_amdgcn_rcpf(1.0f + __builtin_amdgcn_exp2f(y));
}
__device__ __forceinline__ void frag_phase(const Args& a, int tid, int G, int bid) {
    for (int P = bid * NTHR + tid; P < 393216; P += G * NTHR) {
        const int lane = P & 63, ql = lane & 31, hh = lane >> 5;
        if (P < 65536) { const int l2 = P >> 15, fr = (P & 32767) >> 6, w = fr >> 6, kk = fr & 63;
            *(v4u*)((bf16*)(a.ws + WS_WQF) + (size_t)P * 8) = *(const v4u*)((const bf16*)(a.ws + WS_WQ + (size_t)l2 * SZ_WQ) + (size_t)(32 * w + ql) * D + 16 * kk + 8 * hh); }
        else if (P < 131072) { const int Q = P - 65536, l2 = Q >> 15, fr = (Q & 32767) >> 6, nt = fr >> 4, kk = fr & 15;
            *(v4u*)((bf16*)(a.ws + WS_WOF) + (size_t)Q * 8) = *(const v4u*)((const bf16*)(a.ws + WS_WO + (size_t)l2 * SZ_WO) + (size_t)(32 * nt + ql) * 256 + 16 * kk + 8 * hh); }
        else if (P < 262144) { const int Q = P - 131072, l2 = Q >> 16, r1 = Q & 65535, b = r1 >> 13, r2 = r1 & 8191, h = r2 >> 11, kt = (r2 >> 8) & 7, s4 = (r2 >> 6) & 3;
            *(v4u*)((bf16*)(a.ws + WS_KF) + (size_t)Q * 8) = *(const v4u*)((const bf16*)(a.ws + WS_KVM + (size_t)l2 * SZ_KVM) + (size_t)(b * MEMLEN + 32 * kt + ql) * 512 + h * 64 + 16 * s4 + 8 * hh); }
        else { const int Q = P - 262144, l2 = Q >> 16, r1 = Q & 65535, b = r1 >> 13, r2 = r1 & 8191, h = r2 >> 11, kt = (r2 >> 8) & 7, dd = (r2 >> 7) & 1, j = (r2 >> 6) & 1;
            const bf16* vsrc = (const bf16*)(a.ws + WS_KVM + (size_t)l2 * SZ_KVM) + (size_t)(b * MEMLEN + 32 * kt + 16 * j + 4 * hh) * 512 + 256 + h * 64 + 32 * dd + ql;
            unsigned short e8[8];
#pragma unroll
            for (int e = 0; e < 8; ++e) e8[e] = *(const unsigned short*)(vsrc + (size_t)((e & 3) + 8 * (e >> 2)) * 512);
            v4u w; w.x = e8[0] | ((unsigned)e8[1] << 16); w.y = e8[2] | ((unsigned)e8[3] << 16); w.z = e8[4] | ((unsigned)e8[5] << 16); w.w = e8[6] | ((unsigned)e8[7] << 16);
            *(v4u*)((bf16*)(a.ws + WS_VF) + (size_t)Q * 8) = w; }
    }
}
#define XF_NREP(name) int name = 3; asm volatile("" : "+s"(name))
constexpr int XF_HBS = 2064, XF_QS = 528, XF_Q = 0, XF_O = 64 * XF_QS;
__device__ __forceinline__ void xfuse_item(const Args& a, int l, int item, LAS unsigned char* lds, int tid) {
    const int lane = tid & 63, w = __builtin_amdgcn_readfirstlane(tid >> 6), ql = lane & 31, hh = lane >> 5;
    const int tok0 = item * 64, b = item >> 5;
    const bf16* hbp = (const bf16*)(a.ws + WS_H16) + (size_t)tok0 * D;
#ifdef XF_REPA
    XF_NREP(nra);
#pragma unroll 1
    for (int rep = 0; rep < nra; ++rep)
#endif
#pragma unroll
    for (int i = 0; i < 16; ++i) { const int chunk = tid + NTHR * i, row = chunk >> 7, c16 = chunk & 127;
        *(LAS v4u*)(lds + row * XF_HBS + c16 * 16) = *(const v4u*)(hbp + (size_t)row * D + c16 * 8); }
    const float* ss = (const float*)(a.ws + WS_SS);
    const float rs0 = rstd16(ss, tok0 + ql) * 0.125f, rs1 = rstd16(ss, tok0 + 32 + ql) * 0.125f;
    __syncthreads();
    { f32x16 q0, q1;
#pragma unroll
      for (int r = 0; r < 16; ++r) { q0[r] = 0.f; q1[r] = 0.f; }
      const bf16* wq = (const bf16*)(a.ws + WS_WQF) + (size_t)(l * 8 + w) * 64 * 512 + lane * 8;
      const LAS unsigned char* hb0 = lds + ql * XF_HBS + 16 * hh;
#ifdef XF_REPB
      XF_NREP(nrb);
#pragma unroll 1
      for (int rep = 0; rep < nrb; ++rep) {
#pragma unroll
      for (int r = 0; r < 16; ++r) { q0[r] = 0.f; q1[r] = 0.f; }
#endif
#pragma unroll 8
      for (int kk = 0; kk < 64; ++kk) {
          const bf16x8 af = *(const bf16x8*)(wq + 512 * kk);
          const bf16x8 b0 = *(const LAS bf16x8*)(hb0 + 32 * kk), b1 = *(const LAS bf16x8*)(hb0 + 32 * XF_HBS + 32 * kk);
          q0 = MFMA32(af, b0, q0); q1 = MFMA32(af, b1, q1); }
#ifdef XF_REPB
      }
#endif
      __syncthreads();
#pragma unroll
      for (int g = 0; g < 4; ++g) { v2u w0, w1;
          w0.x = pg8::cvt_pk_bf16(q0[4 * g] * rs0, q0[4 * g + 1] * rs0); w0.y = pg8::cvt_pk_bf16(q0[4 * g + 2] * rs0, q0[4 * g + 3] * rs0);
          w1.x = pg8::cvt_pk_bf16(q1[4 * g] * rs1, q1[4 * g + 1] * rs1); w1.y = pg8::cvt_pk_bf16(q1[4 * g + 2] * rs1, q1[4 * g + 3] * rs1);
          *(LAS v2u*)(lds + XF_Q + ql * XF_QS + (32 * w + 8 * g + 4 * hh) * 2) = w0; *(LAS v2u*)(lds + XF_Q + (32 + ql) * XF_QS + (32 * w + 8 * g + 4 * hh) * 2) = w1; }
    }
    __syncthreads();
    { const int h = w >> 1, th = w & 1;
      const bf16* kfb = (const bf16*)(a.ws + WS_KF) + (size_t)((l * 8 + b) * 4 + h) * 32 * 512 + lane * 8;
      const bf16* vfb = (const bf16*)(a.ws + WS_VF) + (size_t)((l * 8 + b) * 4 + h) * 32 * 512 + lane * 8;
      bf16x8 qa[4];
#pragma unroll
      for (int s = 0; s < 4; ++s) qa[s] = *(const LAS bf16x8*)(lds + XF_Q + (32 * th + ql) * XF_QS + (h * 64 + 16 * s + 8 * hh) * 2);
      f32x16 o0, o1;
#pragma unroll
      for (int r = 0; r < 16; ++r) { o0[r] = 0.f; o1[r] = 0.f; }
      float m = -1e30f, lsum = 0.f;
      bf16x8 kf[4], va00, va01, va10, va11;
#pragma unroll
      for (int s = 0; s < 4; ++s) kf[s] = *(const bf16x8*)(kfb + 512 * s);
      va00 = *(const bf16x8*)(vfb); va01 = *(const bf16x8*)(vfb + 512); va10 = *(const bf16x8*)(vfb + 1024); va11 = *(const bf16x8*)(vfb + 1536);
#ifdef XF_REPC
      XF_NREP(nrc);
#pragma unroll 1
      for (int rep = 0; rep < nrc; ++rep) { m = -1e30f; lsum = 0.f;
#pragma unroll
      for (int s = 0; s < 4; ++s) kf[s] = *(const bf16x8*)(kfb + 512 * s);
      va00 = *(const bf16x8*)(vfb); va01 = *(const bf16x8*)(vfb + 512); va10 = *(const bf16x8*)(vfb + 1024); va11 = *(const bf16x8*)(vfb + 1536);
#pragma unroll
      for (int r = 0; r < 16; ++r) { o0[r] = 0.f; o1[r] = 0.f; }
#endif
#pragma unroll 1
      for (int kt = 0; kt < 8; ++kt) {
          const int kn = kt < 7 ? kt + 1 : 7;
          bf16x8 nk[4];
#pragma unroll
          for (int s = 0; s < 4; ++s) nk[s] = *(const bf16x8*)(kfb + (size_t)(kn * 4 + s) * 512);
          const bf16x8 n00 = *(const bf16x8*)(vfb + (size_t)kn * 2048), n01 = *(const bf16x8*)(vfb + (size_t)kn * 2048 + 512), n10 = *(const bf16x8*)(vfb + (size_t)kn * 2048 + 1024), n11 = *(const bf16x8*)(vfb + (size_t)kn * 2048 + 1536);
          f32x16 sacc;
#pragma unroll
          for (int r = 0; r < 16; ++r) sacc[r] = 0.f;
#pragma unroll
          for (int s = 0; s < 4; ++s) sacc = MFMA32(kf[s], qa[s], sacc);
          float sv[16]; float tmax = -1e30f;
#pragma unroll
          for (int r = 0; r < 16; ++r) { sv[r] = sacc[r] * 1.4426950408889634f; tmax = fmaxf(tmax, sv[r]); }
          tmax = fmaxf(tmax, shfl_xor_c<32>(tmax));
          const float mnew = fmaxf(m, tmax), alpha = __builtin_amdgcn_exp2f(m - mnew);
          float p[16]; float ps = 0.f;
#pragma unroll
          for (int r = 0; r < 16; ++r) { p[r] = __builtin_amdgcn_exp2f(sv[r] - mnew); ps += p[r]; }
          ps += shfl_xor_c<32>(ps);
          lsum = lsum * alpha + ps; m = mnew;
#pragma unroll
          for (int r = 0; r < 16; ++r) { o0[r] *= alpha; o1[r] *= alpha; }
          bf16x8 pb[2];
#pragma unroll
          for (int s = 0; s < 2; ++s) { v4u t4; t4.x = pg8::cvt_pk_bf16(p[8 * s + 0], p[8 * s + 1]); t4.y = pg8::cvt_pk_bf16(p[8 * s + 2], p[8 * s + 3]); t4.z = pg8::cvt_pk_bf16(p[8 * s + 4], p[8 * s + 5]); t4.w = pg8::cvt_pk_bf16(p[8 * s + 6], p[8 * s + 7]);
              pb[s] = __builtin_bit_cast(bf16x8, t4); }
          o0 = MFMA32(va00, pb[0], o0); o0 = MFMA32(va01, pb[1], o0);
          o1 = MFMA32(va10, pb[0], o1); o1 = MFMA32(va11, pb[1], o1);
#pragma unroll
          for (int s = 0; s < 4; ++s) kf[s] = nk[s];
          va00 = n00; va01 = n01; va10 = n10; va11 = n11;
      }
#ifdef XF_REPC
      }
#endif
      const float inv = 1.0f / lsum;
      LAS unsigned char* orow = lds + XF_O + (32 * th + ql) * XF_QS + (h * 64 + 4 * hh) * 2;
#pragma unroll
      for (int g = 0; g < 4; ++g) { v2u w0, w1; w0.x = pg8::cvt_pk_bf16(o0[4 * g] * inv, o0[4 * g + 1] * inv); w0.y = pg8::cvt_pk_bf16(o0[4 * g + 2] * inv, o0[4 * g + 3] * inv);
          w1.x = pg8::cvt_pk_bf16(o1[4 * g] * inv, o1[4 * g + 1] * inv); w1.y = pg8::cvt_pk_bf16(o1[4 * g + 2] * inv, o1[4 * g + 3] * inv);
          *(LAS v2u*)(orow + 16 * g) = w0; *(LAS v2u*)(orow + 64 + 16 * g) = w1; }
    }
    __syncthreads();
    { f32x16 acc[4][2];
#pragma unroll
      for (int c = 0; c < 4; ++c)
#pragma unroll
          for (int t = 0; t < 2; ++t)
#pragma unroll
              for (int r = 0; r < 16; ++r) acc[c][t][r] = 0.f;
      const bf16* wo = (const bf16*)(a.ws + WS_WOF) + (size_t)(l * 32 + 4 * w) * 16 * 512 + lane * 8;
      const LAS unsigned char* ob = lds + XF_O + ql * XF_QS + 16 * hh;
#ifdef XF_REPD
      XF_NREP(nrd);
#pragma unroll 1
      for (int rep = 0; rep < nrd; ++rep) {
#pragma unroll
      for (int c = 0; c < 4; ++c)
#pragma unroll
          for (int t = 0; t < 2; ++t)
#pragma unroll
              for (int r = 0; r < 16; ++r) acc[c][t][r] = 0.f;
#endif
#pragma unroll 4
      for (int kk = 0; kk < 16; ++kk) {
          const bf16x8 b0 = *(const LAS bf16x8*)(ob + 32 * kk), b1 = *(const LAS bf16x8*)(ob + 32 * XF_QS + 32 * kk);
#pragma unroll
          for (int c = 0; c < 4; ++c) { const bf16x8 af = *(const bf16x8*)(wo + (size_t)(c * 16 + kk) * 512);
              acc[c][0] = MFMA32(af, b0, acc[c][0]); acc[c][1] = MFMA32(af, b1, acc[c][1]); } }
#ifdef XF_REPD
      }
#endif
      bf16* HB = (bf16*)(a.ws + WS_H16); float* SSw = (float*)(a.ws + WS_SS);
#pragma unroll
      for (int t = 0; t < 2; ++t) { const size_t row = (size_t)tok0 + 32 * t + ql; float q = 0.f;
          const size_t off0 = row * D + 128 * w + 4 * hh;
          v2u rv[4][4];
#pragma unroll
          for (int c = 0; c < 4; ++c)
#pragma unroll
              for (int g = 0; g < 4; ++g) rv[c][g] = *(const v2u*)(HB + off0 + 32 * c + 8 * g);
#pragma unroll
          for (int c = 0; c < 4; ++c)
#pragma unroll
              for (int g = 0; g < 4; ++g) { const f32x4 r0 = bf4(rv[c][g]);
                  f32x4 v; v.x = acc[c][t][4 * g] + r0.x; v.y = acc[c][t][4 * g + 1] + r0.y; v.z = acc[c][t][4 * g + 2] + r0.z; v.w = acc[c][t][4 * g + 3] + r0.w;
                  q += (v.x * v.x + v.y * v.y) + (v.z * v.z + v.w * v.w);
                  v2u pk; pk.x = pg8::cvt_pk_bf16(v.x, v.y); pk.y = pg8::cvt_pk_bf16(v.z, v.w); rv[c][g] = pk; }
          asm volatile("" ::: "memory");
#pragma unroll
          for (int c = 0; c < 4; ++c)
#pragma unroll
              for (int g = 0; g < 4; ++g) *(v2u*)(HB + off0 + 32 * c + 8 * g) = rv[c][g];
          q += shfl_xor_c<32>(q);
          SSw[row * 16 + 2 * w + hh] = hh ? 0.f : q; }
    }
    __syncthreads();
}
__device__ __forceinline__ bf16x8 tr_frag(unsigned addr) {
    bf16x4 lo, hi;
    asm volatile("ds_read_b64_tr_b16 %0, %2 offset:0\n\tds_read_b64_tr_b16 %1, %2 offset:256\n\ts_waitcnt lgkmcnt(0)" : "=&v"(lo), "=&v"(hi) : "v"(addr) : "memory");
    return __builtin_shufflevector(lo, hi, 0, 1, 2, 3, 4, 5, 6, 7);
}
__device__ __forceinline__ void sgu2_item(const Args& a, int l, int item, LAS unsigned char* lds, int tid) {
    const int lane = tid & 63, w = __builtin_amdgcn_readfirstlane(tid >> 6), ql = lane & 31, hh = lane >> 5;
    const int nc = item & 15, b = item >> 4, tok0 = b * T + nc * 128;
    const bf16* z = (const bf16*)(a.ws + WS_Z); bf16* mix = (bf16*)(a.ws + WS_MIX);
    for (int j = 0; j < 16; ++j) { const int s = 16 * w + j;
        const v2u raw = *(const v2u*)(z + (size_t)(tok0 + s) * ZW + Z_DUV + 256 + 4 * lane);
        float x[4] = {gelu_fast(bflo(raw.x)), gelu_fast(bfhi(raw.x)), gelu_fast(bflo(raw.y)), gelu_fast(bfhi(raw.y))};
        const float mu = wave_sum((x[0] + x[1]) + (x[2] + x[3])) * (1.0f / 256.0f);
        float q = 0.f;
#pragma unroll
        for (int i = 0; i < 4; ++i) { x[i] -= mu; q += x[i] * x[i]; }
        const float rstd = rsqrtf(wave_sum(q) * (1.0f / 256.0f) + EPS);
        const f32x4 gg = *(const f32x4*)(a.in[IN_LNG] + l * 256 + 4 * lane), bb = *(const f32x4*)(a.in[IN_LNB] + l * 256 + 4 * lane);
        v2u o; o.x = pk2(x[0] * rstd * gg.x + bb.x, x[1] * rstd * gg.y + bb.y); o.y = pk2(x[2] * rstd * gg.z + bb.z, x[3] * rstd * gg.w + bb.w);
        const int ch = 4 * lane;
        *(LAS v2u*)(lds + ((s >> 5) * 8 + (ch >> 5)) * 2048 + (s & 31) * 64 + (ch & 31) * 2) = o; }
    __syncthreads();
    const int g = w >> 1, cb = w & 1, cblk = g * 2 + cb;
    bf16x8 af[4][2];
    { const unsigned abase = (unsigned)(size_t)lds + (unsigned)(cblk * 2048 + (8 * hh + ((lane >> 2) & 3)) * 64 + 32 * ((lane >> 4) & 1) + 8 * (lane & 3));
#pragma unroll
      for (int sb = 0; sb < 4; ++sb) { af[sb][0] = tr_frag(abase + sb * 8 * 2048); af[sb][1] = tr_frag(abase + sb * 8 * 2048 + 16 * 64); } }
    const bf16* swt = (const bf16*)(a.ws + WS_SWT) + (size_t)(l * 4 + g) * 128 * 128;
#pragma unroll
    for (int tb = 0; tb < 4; ++tb) {
        f32x16 acc;
#pragma unroll
        for (int r = 0; r < 16; ++r) acc[r] = 0.f;
        const bf16* wrow = swt + (size_t)(32 * tb + ql) * 128 + 8 * hh;
#pragma unroll
        for (int sb = 0; sb <= tb; ++sb) { const bf16x8 b0 = *(const bf16x8*)(wrow + 32 * sb), b1 = *(const bf16x8*)(wrow + 32 * sb + 16);
            acc = MFMA32(af[sb][0], b0, acc); acc = MFMA32(af[sb][1], b1, acc); }
        const int t = 32 * tb + ql; const float bs = a.in[IN_SB][(l * 4 + g) * 128 + t];
        const bf16* up = z + (size_t)(tok0 + t) * ZW + Z_DUV + g * 64 + cb * 32 + 4 * hh; bf16* op = mix + (size_t)(tok0 + t) * D + 768 + g * 64 + cb * 32 + 4 * hh;
#pragma unroll
        for (int q4 = 0; q4 < 4; ++q4) { const v2u raw = *(const v2u*)(up + 8 * q4);
            v2u o; o.x = pk2(gelu_fast(bflo(raw.x)) * (acc[4 * q4] + bs), gelu_fast(bfhi(raw.x)) * (acc[4 * q4 + 1] + bs)); o.y = pk2(gelu_fast(bflo(raw.y)) * (acc[4 * q4 + 2] + bs), gelu_fast(bfhi(raw.y)) * (acc[4 * q4 + 3] + bs));
            *(v2u*)(op + 8 * q4) = o; }
    }
    __syncthreads();
}
__device__ __forceinline__ void pool2_item(const Args& a, int l, int item, LAS unsigned char* lds, int tid) {
    const int lane = tid & 63, w = __builtin_amdgcn_readfirstlane(tid >> 6), ql = lane & 31, hh = lane >> 5;
    const int tt = item & 31, b = item >> 5, t0 = tt * 64;
    const bf16* z = (const bf16*)(a.ws + WS_Z); bf16* mix = (bf16*)(a.ws + WS_MIX);
    for (int i = tid; i < 79 * 32; i += NTHR) { const int r = i >> 5, ch = i & 31, t = t0 - 15 + r;
        v4u v = (v4u){0u, 0u, 0u, 0u}; if (t >= 0) v = *(const v4u*)(z + (size_t)(b * T + t) * ZW + Z_BU + ch * 8);
        *(LAS v4u*)(lds + r * 528 + ch * 16) = v; }
    __syncthreads();
    const int tb = w & 1, g = w >> 1, win = 2 << g, tl = 32 * tb + ql, tabs = t0 + tl;
    const float icnt = 1.0f / (float)((tabs + 1 < win) ? tabs + 1 : win);
    bf16x8 bfr[4];
#pragma unroll
    for (int s = 0; s < 4; ++s) { const LAS unsigned char* p0 = lds + (tl + 15) * 528 + (g * 64 + 16 * s + 8 * hh) * 2; float acc[8] = {0.f, 0.f, 0.f, 0.f, 0.f, 0.f, 0.f, 0.f};
        for (int j = 0; j < win; ++j) { const v4u r = *(const LAS v4u*)(p0 - j * 528);
            acc[0] += bflo(r.x); acc[1] += bfhi(r.x); acc[2] += bflo(r.y); acc[3] += bfhi(r.y); acc[4] += bflo(r.z); acc[5] += bfhi(r.z); acc[6] += bflo(r.w); acc[7] += bfhi(r.w); }
        const v4u r0 = *(const LAS v4u*)p0;
        v4u o; o.x = pg8::cvt_pk_bf16(acc[0] * icnt - bflo(r0.x), acc[1] * icnt - bfhi(r0.x)); o.y = pg8::cvt_pk_bf16(acc[2] * icnt - bflo(r0.y), acc[3] * icnt - bfhi(r0.y));
        o.z = pg8::cvt_pk_bf16(acc[4] * icnt - bflo(r0.z), acc[5] * icnt - bfhi(r0.z)); o.w = pg8::cvt_pk_bf16(acc[6] * icnt - bflo(r0.w), acc[7] * icnt - bfhi(r0.w));
        bfr[s] = __builtin_bit_cast(bf16x8, o); }
    const bf16* pwt = (const bf16*)(a.ws + WS_PWT) + (size_t)(l * 4 + g) * 4096;
    bf16* op = mix + (size_t)(b * T + tabs) * D + 256 + g * 64 + 4 * hh;
#pragma unroll
    for (int db = 0; db < 2; ++db) { f32x16 acc;
#pragma unroll
        for (int r = 0; r < 16; ++r) acc[r] = 0.f;
#pragma unroll
        for (int s = 0; s < 4; ++s) { const bf16x8 af = *(const bf16x8*)(pwt + (size_t)(32 * db + ql) * 64 + 16 * s + 8 * hh); acc = MFMA32(af, bfr[s], acc); }
#pragma unroll
        for (int q4 = 0; q4 < 4; ++q4) { const int d0 = 32 * db + 8 * q4 + 4 * hh;
            const f32x4 pb = *(const f32x4*)(a.in[IN_PB] + (l * 4 + g) * 64 + d0), ps = *(const f32x4*)(a.in[IN_PS] + l * 256 + g * 64 + d0);
            v2u o; o.x = pk2((acc[4 * q4] + pb.x) * ps.x, (acc[4 * q4 + 1] + pb.y) * ps.y); o.y = pk2((acc[4 * q4 + 2] + pb.z) * ps.z, (acc[4 * q4 + 3] + pb.w) * ps.w);
            *(v2u*)(op + 32 * db + 8 * q4) = o; } }
    __syncthreads();
}

constexpr int GL_V = 0;
constexpr int GL_KD = 32768;

__device__ __forceinline__ void gla_decay(const Args& a, int l, int h, const bf16* zc  , int lane, float (&b0)[16], float (&b1)[16]) {
    const int ql = lane & 31, hh = lane >> 5;
    bf16x8 wfrag; { float wv[8];
#pragma unroll
        for (int j = 0; j < 8; ++j) wv[j] = a.in[IN_WA2][(size_t)l * 2048 + (8 * hh + j) * 128 + h * 32 + ql];
        v4u t4; t4.x = pk2(wv[0], wv[1]); t4.y = pk2(wv[2], wv[3]); t4.z = pk2(wv[4], wv[5]); t4.w = pk2(wv[6], wv[7]); wfrag = __builtin_bit_cast(bf16x8, t4); }
    f32x16 binit;
#pragma unroll
    for (int q4 = 0; q4 < 4; ++q4) { const f32x4 t = *(const f32x4*)(a.in[IN_BA] + l * 128 + h * 32 + 8 * q4 + 4 * hh); binit[4 * q4] = t.x; binit[4 * q4 + 1] = t.y; binit[4 * q4 + 2] = t.z; binit[4 * q4 + 3] = t.w; }
#pragma unroll
    for (int rb = 0; rb < 2; ++rb) {
        const bf16x8 afrag = *(const bf16x8*)(zc + (size_t)(32 * rb + ql) * ZW + Z_ALR + 8 * hh);
        f32x16 lg = MFMA32(wfrag, afrag, binit);
#pragma unroll
        for (int r = 0; r < 16; ++r) { const float x = lg[r]; float v = (fminf(x, 0.f) - __logf(1.0f + __expf(-fabsf(x)))) * 0.0625f;
#pragma unroll
            for (int d = 1; d < 32; d <<= 1) { const float t = shfl_idx(v, (lane - d) & 63); if (ql >= d) v += t; }
            if (rb == 0) b0[r] = v; else b1[r] = v + shfl_idx(b0[r], lane | 31); }
    }
}
__device__ __forceinline__ void ld16acc(const bf16* p  , float (&x)[16]) {
#pragma unroll
    for (int q4 = 0; q4 < 4; ++q4) { const v2u t = *(const v2u*)(p + 8 * q4); x[4 * q4] = bflo(t.x); x[4 * q4 + 1] = bfhi(t.x); x[4 * q4 + 2] = bflo(t.y); x[4 * q4 + 3] = bfhi(t.y); }
}
__device__ __forceinline__ bf16x8 pack_frag(const float (&x)[16], int s) { v4u t4; t4.x = pg8::cvt_pk_bf16(x[8 * s], x[8 * s + 1]); t4.y = pg8::cvt_pk_bf16(x[8 * s + 2], x[8 * s + 3]); t4.z = pg8::cvt_pk_bf16(x[8 * s + 4], x[8 * s + 5]); t4.w = pg8::cvt_pk_bf16(x[8 * s + 6], x[8 * s + 7]); return __builtin_bit_cast(bf16x8, t4); }
__device__ __forceinline__ void gla2_a_item(const Args& a, int l, int item, LAS unsigned char* lds, int tid) {
    const int lane = tid & 63, w = __builtin_amdgcn_readfirstlane(tid >> 6), ql = lane & 31, hh = lane >> 5;
    const int n = item & 31, b = item >> 5, h = w >> 1, ib = w & 1, tok0 = b * T + n * 64, it4 = (b * 4 + h) * 32 + n;
    const bf16* z = (const bf16*)(a.ws + WS_Z); const bf16* zc = z + (size_t)tok0 * ZW;
    float* OI = (float*)(a.ws + WS_GOI); v4u* QTF = (v4u*)(a.ws + WS_GQT); float* KVT = (float*)(a.ws + WS_GKV); float* DEC = (float*)(a.ws + WS_GDEC);
#pragma unroll
    for (int i = 0; i < 4; ++i) { const int tk = (lane >> 3) + 8 * i, ch = lane & 7;
        const v4u v = *(const v4u*)(zc + (size_t)(32 * ib + tk) * ZW + Z_AV + h * 64 + ch * 8);
        *(LAS v4u*)(lds + GL_V + h * 8192 + (ib * 2 + (ch >> 2)) * 2048 + tk * 64 + (ch & 3) * 16) = v; }
    float b0[16], b1[16]; gla_decay(a, l, h, zc, lane, b0, b1);
    float blast[16];
#pragma unroll
    for (int r = 0; r < 16; ++r) blast[r] = shfl_idx(b1[r], lane | 31);
    float x[16], qt[16], kt[16], kd[16];
    ld16acc(zc + (size_t)(32 * ib + ql) * ZW + Z_AQ + h * 32 + 4 * hh, x);
#pragma unroll
    for (int r = 0; r < 16; ++r) qt[r] = x[r] * 0.17677669529663687f * __expf(ib ? b1[r] : b0[r]);
    ld16acc(zc + (size_t)(32 * ib + ql) * ZW + Z_AK + h * 32 + 4 * hh, x);
#pragma unroll
    for (int r = 0; r < 16; ++r) { const float bv = ib ? b1[r] : b0[r]; kt[r] = x[r] * __expf(-bv); kd[r] = x[r] * __expf(blast[r] - bv); }
    const bf16x8 qf0 = pack_frag(qt, 0), qf1 = pack_frag(qt, 1);
    QTF[((size_t)it4 * 2 + ib) * 128 + lane] = __builtin_bit_cast(v4u, qf0); QTF[((size_t)it4 * 2 + ib) * 128 + 64 + lane] = __builtin_bit_cast(v4u, qf1);
#pragma unroll
    for (int q4 = 0; q4 < 4; ++q4) { v2u o; o.x = pg8::cvt_pk_bf16(kd[4 * q4], kd[4 * q4 + 1]); o.y = pg8::cvt_pk_bf16(kd[4 * q4 + 2], kd[4 * q4 + 3]);
        *(LAS v2u*)(lds + GL_KD + h * 4096 + (32 * ib + ql) * 64 + (8 * q4 + 4 * hh) * 2) = o; }
    if (ib == 1 && ql == 31) {
#pragma unroll
        for (int q4 = 0; q4 < 4; ++q4) { f32x4 d; d.x = __expf(b1[4 * q4]); d.y = __expf(b1[4 * q4 + 1]); d.z = __expf(b1[4 * q4 + 2]); d.w = __expf(b1[4 * q4 + 3]); *(f32x4*)(DEC + (size_t)it4 * 32 + 8 * q4 + 4 * hh) = d; } }
    __syncthreads();
    f32x16 o0, o1;
#pragma unroll
    for (int r = 0; r < 16; ++r) { o0[r] = 0.f; o1[r] = 0.f; }
    const unsigned vaddr = (unsigned)(size_t)(lds + GL_V + h * 8192) + (unsigned)((4 * hh + ((lane >> 2) & 3)) * 64 + 32 * ((lane >> 4) & 1) + 8 * (lane & 3));
#pragma unroll
    for (int jb = 0; jb < 2; ++jb) {
        if (jb <= ib) {
            bf16x8 kf0, kf1;
            if (jb == ib) { kf0 = pack_frag(kt, 0); kf1 = pack_frag(kt, 1); }
            else { float kx[16]; ld16acc(zc + (size_t)ql * ZW + Z_AK + h * 32 + 4 * hh, kx);
#pragma unroll
                for (int r = 0; r < 16; ++r) kx[r] *= __expf(-b0[r]);
                kf0 = pack_frag(kx, 0); kf1 = pack_frag(kx, 1); }
            f32x16 at;
#pragma unroll
            for (int r = 0; r < 16; ++r) at[r] = 0.f;
            at = MFMA32(kf0, qf0, at); at = MFMA32(kf1, qf1, at);
            float pa[16];
#pragma unroll
            for (int r = 0; r < 16; ++r) { const int jl = (r & 3) + 8 * (r >> 2) + 4 * hh; pa[r] = (jb < ib || jl <= ql) ? at[r] : 0.f; }
            const bf16x8 pb0 = pack_frag(pa, 0), pb1 = pack_frag(pa, 1);
            bf16x4 t00, t01, t10, t11, u00, u01, u10, u11;
            tr_read_tile(vaddr + jb * 4096, t00, t01, t10, t11, u00, u01, u10, u11);
            o0 = MFMA32(__builtin_shufflevector(t00, t01, 0, 1, 2, 3, 4, 5, 6, 7), pb0, o0); o0 = MFMA32(__builtin_shufflevector(t10, t11, 0, 1, 2, 3, 4, 5, 6, 7), pb1, o0);
            o1 = MFMA32(__builtin_shufflevector(u00, u01, 0, 1, 2, 3, 4, 5, 6, 7), pb0, o1); o1 = MFMA32(__builtin_shufflevector(u10, u11, 0, 1, 2, 3, 4, 5, 6, 7), pb1, o1);
        }
    }
    { float* op = OI + (size_t)(tok0 + 32 * ib + ql) * 256 + h * 64 + 4 * hh;
#pragma unroll
      for (int q4 = 0; q4 < 4; ++q4) { *(f32x4*)(op + 8 * q4) = (f32x4){o0[4 * q4], o0[4 * q4 + 1], o0[4 * q4 + 2], o0[4 * q4 + 3]}; *(f32x4*)(op + 32 + 8 * q4) = (f32x4){o1[4 * q4], o1[4 * q4 + 1], o1[4 * q4 + 2], o1[4 * q4 + 3]}; } }
    { f32x16 sa;
#pragma unroll
      for (int r = 0; r < 16; ++r) sa[r] = 0.f;
      const unsigned lp = (unsigned)((8 * hh + ((lane >> 2) & 3)) * 64 + 32 * ((lane >> 4) & 1) + 8 * (lane & 3));
      const unsigned va = (unsigned)(size_t)(lds + GL_V + h * 8192) + lp, ka = (unsigned)(size_t)(lds + GL_KD + h * 4096) + lp;
#pragma unroll
      for (int tt = 0; tt < 2; ++tt)
#pragma unroll
        for (int ks = 0; ks < 2; ++ks) { const bf16x8 af = tr_frag(va + (tt * 2 + ib) * 2048 + ks * 1024), bfv = tr_frag(ka + (32 * tt + 16 * ks) * 64); sa = MFMA32(af, bfv, sa); }
      float* kp = KVT + (size_t)it4 * 2048 + (size_t)(32 * ib + 4 * hh) * 32 + ql;
#pragma unroll
      for (int r = 0; r < 16; ++r) kp[((r & 3) + 8 * (r >> 2)) * 32] = sa[r]; }
    __syncthreads();
}
__device__ __forceinline__ void gla2_c_item(const Args& a, int l, int item, LAS unsigned char* lds, int tid) {
    const int lane = tid & 63, w = __builtin_amdgcn_readfirstlane(tid >> 6), ql = lane & 31, hh = lane >> 5;
    const int n = item & 31, b = item >> 5, h = w >> 1, ib = w & 1, tok0 = b * T + n * 64, it4 = (b * 4 + h) * 32 + n;
    const bf16* z = (const bf16*)(a.ws + WS_Z); bf16* mix = (bf16*)(a.ws + WS_MIX);
    const float* OI = (const float*)(a.ws + WS_GOI); const v4u* QTF = (const v4u*)(a.ws + WS_GQT); const float* KVT = (const float*)(a.ws + WS_GKV); const float* DEC = (const float*)(a.ws + WS_GDEC);
    float S0[16], S1[16];
    { const float* sp = KVT + (size_t)it4 * 2048 + ql * 32 + 4 * hh;
#pragma unroll
      for (int q4 = 0; q4 < 4; ++q4) { const f32x4 t0 = *(const f32x4*)(sp + 8 * q4), t1 = *(const f32x4*)(sp + 1024 + 8 * q4);
          S0[4 * q4] = t0.x; S0[4 * q4 + 1] = t0.y; S0[4 * q4 + 2] = t0.z; S0[4 * q4 + 3] = t0.w; S1[4 * q4] = t1.x; S1[4 * q4 + 1] = t1.y; S1[4 * q4 + 2] = t1.z; S1[4 * q4 + 3] = t1.w; } }
    const bf16x8 qf0 = __builtin_bit_cast(bf16x8, QTF[((size_t)it4 * 2 + ib) * 128 + lane]), qf1 = __builtin_bit_cast(bf16x8, QTF[((size_t)it4 * 2 + ib) * 128 + 64 + lane]);
    f32x16 o0, o1;
    { const float* op = OI + (size_t)(tok0 + 32 * ib + ql) * 256 + h * 64 + 4 * hh;
#pragma unroll
      for (int q4 = 0; q4 < 4; ++q4) { const f32x4 t0 = *(const f32x4*)(op + 8 * q4), t1 = *(const f32x4*)(op + 32 + 8 * q4);
          o0[4 * q4] = t0.x; o0[4 * q4 + 1] = t0.y; o0[4 * q4 + 2] = t0.z; o0[4 * q4 + 3] = t0.w; o1[4 * q4] = t1.x; o1[4 * q4 + 1] = t1.y; o1[4 * q4 + 2] = t1.z; o1[4 * q4 + 3] = t1.w; } }
    o0 = MFMA32(pack_frag(S0, 0), qf0, o0); o0 = MFMA32(pack_frag(S0, 1), qf1, o0);
    o1 = MFMA32(pack_frag(S1, 0), qf0, o1); o1 = MFMA32(pack_frag(S1, 1), qf1, o1);
    float ss = 0.f;
#pragma unroll
    for (int r = 0; r < 16; ++r) ss += o0[r] * o0[r] + o1[r] * o1[r];
    ss += shfl_xor_c<32>(ss);
    const float rstd = rsqrtf(ss * (1.0f / 64.0f) + EPS);
    const size_t row = (size_t)(tok0 + 32 * ib + ql);
#pragma unroll
    for (int vb = 0; vb < 2; ++vb)
#pragma unroll
        for (int q4 = 0; q4 < 4; ++q4) { const int v0 = 32 * vb + 8 * q4 + 4 * hh;
            const f32x4 gn = *(const f32x4*)(a.in[IN_GNORM] + l * 256 + h * 64 + v0); const v2u gr = *(const v2u*)(z + row * ZW + Z_AG + h * 64 + v0);
            const float g0 = bflo(gr.x), g1 = bfhi(gr.x), g2 = bflo(gr.y), g3 = bfhi(gr.y);
            const float y0 = (vb ? o1[4 * q4] : o0[4 * q4]) * rstd * gn.x * silu_f(g0), y1 = (vb ? o1[4 * q4 + 1] : o0[4 * q4 + 1]) * rstd * gn.y * silu_f(g1);
            const float y2 = (vb ? o1[4 * q4 + 2] : o0[4 * q4 + 2]) * rstd * gn.z * silu_f(g2), y3 = (vb ? o1[4 * q4 + 3] : o0[4 * q4 + 3]) * rstd * gn.w * silu_f(g3);
            v2u o; o.x = pk2(y0, y1); o.y = pk2(y2, y3); *(v2u*)(mix + row * D + h * 64 + v0) = o; }
}
__device__ __forceinline__ void gla_scan_phase(const Args& a, int tid, int G, int bid) {
    float* KVT = (float*)(a.ws + WS_GKV); const float* DEC = (const float*)(a.ws + WS_GDEC);
    typedef float f32x2v __attribute__((ext_vector_type(2)));
    for (int u = bid * NTHR + tid; u < 32 * 1024; u += G * NTHR) { const int bh = u >> 10, e0 = (u & 1023) * 2;
        float* kp = KVT + (size_t)bh * 32 * 2048 + e0; const float* dp = DEC + (size_t)bh * 32 * 32 + (e0 & 31);
        f32x2v kv[32], dc[32];
#pragma unroll
        for (int m = 0; m < 32; ++m) { kv[m] = *(const f32x2v*)(kp + (size_t)m * 2048); dc[m] = *(const f32x2v*)(dp + m * 32); }
        f32x2v S = (f32x2v){0.f, 0.f};
#pragma unroll
        for (int m = 0; m < 32; ++m) { *(f32x2v*)(kp + (size_t)m * 2048) = S; S = S * dc[m] + kv[m]; } }
}
constexpr int CW_QUEUE = 8192;
__device__ __forceinline__ void mixers_phase(const Args& a, int l, LAS unsigned char* lds, int tid) {
    dsa2_setup(a, lds, tid);
    float prof[6] = {0.f, 0.f, 0.f, 0.f, 0.f, 0.f};
#ifdef PROF_DSA
    const unsigned long long tph0 = wall_clock64();
#endif
    unsigned* qctr = (unsigned*)(a.ws + WS_CTL) + CW_QUEUE + 64 * l;
    volatile LAS int* qslot = (volatile LAS int*)(lds + MISC_OFF + 64);
    for (;;) {
        if (tid == 0) *qslot = (int)__hip_atomic_fetch_add(qctr, 1u, __ATOMIC_RELAXED, __HIP_MEMORY_SCOPE_AGENT);
        __syncthreads();
        int it = *qslot;
        __syncthreads();
#ifdef REP_MIX
        if (it >= 2304) break;
        if (it >= 1152) it -= 1152;
        if (it < 512) dsa2_setup(a, lds, tid);
#elif defined(REP_DSA)
        if (it >= 1152 + 512) break;
        if (it >= 1152) it -= 1152;
        if (it < 512) dsa2_setup(a, lds, tid);
#else
        if (it >= 1152) break;
#endif
        const int t2 = (tid & ~63) + (int)lane_id_now();
        if (it < 512) dsa2_item(a, it, lds, t2, prof);
        else if (it < 640) sgu2_item(a, l, it - 512, lds, t2);
        else if (it < 896) gla2_a_item(a, l, it - 640, lds, t2);
        else pool2_item(a, l, it - 896, lds, t2);
    }
#ifdef PROF_DSA
    if (tid == 0) { prof[5] = (float)(wall_clock64() - tph0); float* pr = (float*)(a.ws + WS_CTL) + 12288;
#pragma unroll
        for (int k2 = 0; k2 < 6; ++k2) atomicAdd(pr + 2 + k2, prof[k2]); }
#endif
#if defined(PROBE_DSA) && !defined(PROBE_GLA) && !defined(PROBE_SGU) && !defined(PROBE_POOL)
    __syncthreads(); dsa_setup(a, lds, tid);
    for (int it = M - 1 - (int)blockIdx.x; it >= 0; it -= gridDim.x) dsa_item(a, it, lds, tid, (bf16*)(a.ws + WS_QX), 256);
#endif
}
#ifdef PROBE_DSA
__device__ __forceinline__ void probe_dsa_compare(const Args& a, LAS unsigned char* lds, int tid, int col0 = 512) {
    const bf16* mix = (const bf16*)(a.ws + WS_MIX); const bf16* alt = (const bf16*)(a.ws + WS_QX); float d2 = 0.f, r2 = 0.f;
    for (size_t i = (size_t)blockIdx.x * NTHR + tid; i < (size_t)M * 256; i += (size_t)gridDim.x * NTHR) { const size_t row = i >> 8, c = i & 255; const float x = bf1(mix[row * D + col0 + c]), y = bf1(alt[i]); d2 += (x - y) * (x - y); r2 += y * y; }
    d2 = wave_sum(d2); r2 = wave_sum(r2);
    if ((tid & 63) == 0) { atomicAdd((float*)(a.ws + WS_CTL) + 12288, d2); atomicAdd((float*)(a.ws + WS_CTL) + 12289, r2); }
}
#endif

__device__ __forceinline__ unsigned long long uniform_u64(unsigned long long v) { const unsigned lo = __builtin_amdgcn_readfirstlane((unsigned)v), hi = __builtin_amdgcn_readfirstlane((unsigned)(v >> 32)); return ((unsigned long long)hi << 32) | lo; }
__device__ __forceinline__ void load_args(Args& la, LAS unsigned char* lds) {
    const LAS unsigned long long* p = (const LAS unsigned long long*)(lds + ARGS_OFF);
#pragma unroll
    for (int i = 0; i < N_IN; ++i) la.in[i] = (const float*)(const GAS float*)uniform_u64(p[i]);
    la.out = (float*)(GAS float*)uniform_u64(p[N_IN]); la.ws = (unsigned char*)(GAS unsigned char*)uniform_u64(p[N_IN + 1]);
}
constexpr int NPHASE = 28;
#define REPEAT_BEGIN(flag) { int nrep_ = (flag) ? 2 : 1; asm volatile("" : "+s"(nrep_)); _Pragma("unroll 1") for (int rep_ = 0; rep_ < nrep_; ++rep_) {
#define REPEAT_END() } }
#ifndef REP_Z
#define REP_Z 0
#endif
#ifndef REP_Q
#define REP_Q 0
#endif
#ifndef REP_FUP
#define REP_FUP 0
#endif
#ifndef REP_MUP
#define REP_MUP 0
#endif
#ifndef REP_MDN
#define REP_MDN 0
#endif
#define OTID() const int tid = wave_id * 64 + (int)lane_id_now(); Args la; load_args(la, lds)
__global__ void __launch_bounds__(NTHR, 2) fwd_kernel(Args a) {
    extern __shared__ __attribute__((aligned(16))) unsigned char lds_raw[];
    LAS unsigned char* lds = (LAS unsigned char*)lds_raw;
    const int G0 = gridDim.x, bid0 = blockIdx.x, wave_id = __builtin_amdgcn_readfirstlane(threadIdx.x >> 6); const int G = G0, bid = bid0;
    volatile LAS unsigned* MISC = (volatile LAS unsigned*)(lds + MISC_OFF);
    if (threadIdx.x < 32) MISC[threadIdx.x] = 0u;
    if (threadIdx.x < N_IN + 2) {
        const __attribute__((address_space(4))) unsigned long long* ka = (const __attribute__((address_space(4))) unsigned long long*)__builtin_amdgcn_kernarg_segment_ptr();
        ((LAS unsigned long long*)(lds + ARGS_OFF))[threadIdx.x] = ka[threadIdx.x]; }
    __syncthreads();
    unsigned char* ws0 = a.ws; unsigned char* ws = ws0;
#define PH() GAS unsigned char* wsg_ = (GAS unsigned char*)ws0; asm volatile("" : "+s"(wsg_)); unsigned char* ws = (unsigned char*)wsg_; int G = G0, bid = bid0; asm volatile("" : "+s"(G), "+s"(bid))
    XcdBarrier bar; bar.bar = (unsigned*)(ws + WS_CTL) + CW_BAR; bar.x = 0; bar.st = nullptr; bar.wid = (unsigned)wave_id;
    if (N_LAUNCH_MODE == 1) bar = xcd_barrier_post((unsigned*)(ws + WS_CTL) + CW_BAR, MISC + 8);
    const int lo = a.ph_lo, hi = a.ph_hi;
#if defined(PROBE_GLA) || defined(PROBE_SGU) || defined(PROBE_POOL)
#define RUN(k) ((k) <= 3 && lo <= (k) && (k) < hi)
#else
#define RUN(k) (lo <= (k) && (k) < hi)
#endif
#define SEAM() do { if (N_LAUNCH_MODE == 1) xcd_barrier(bar); } while (0)
#define WB(off) ((bf16*)(ws + (off)))
#define WF(off) ((float*)(ws + (off)))
#ifdef REP_PRO
    if (RUN(0)) { PH(); int nrep = 2; asm volatile("" : "+s"(nrep));
#pragma unroll 1
        for (int rep = 0; rep < nrep; ++rep) { OTID(); p0_prologue(la, lds, tid, G); } SEAM(); }
#else
    if (RUN(0)) { PH(); OTID(); p0_prologue(la, lds, tid, G); SEAM(); }
#ifdef REP_BAR
    { int nb_ = 20; asm volatile("" : "+s"(nb_));
#pragma unroll 1
      for (int i_ = 0; i_ < nb_; ++i_) SEAM(); }
#endif
#endif

    { constexpr int l = 0;
        const int pb = l ? 10 : 1;
        if (RUN(pb + 0)) { PH();
            REPEAT_BEGIN(REP_Z)
            { pg8::Gemm g{WB(WS_H16), WB(WS_WIN + l * SZ_WIN), M, ZW, D}; pg8::StaticOrder S; S.init(M, ZW, G, bid);
              EpiScale E{WB(WS_Z), ZW, WF(WS_SS), 1.0f, WB(WS_DKF), Z_CK / 256}; pg8::gemm_phase<EpiScale, pg8::StaticOrder, true, true>(lds, g, S, E, wave_id); }
            REPEAT_END()
            if (l == 0) {
                for (int l2 = 0; l2 < 2; ++l2) {
                    pg8::Gemm g{WB(WS_MEMB), WB(WS_WKV + l2 * SZ_WKV), MM, 512, D}; pg8::StaticOrder S; S.init(MM, 512, G, (G - 1 - bid - 16 * l2 + 2 * G) % G);
                    EpiScale E{WB(WS_KVM + l2 * SZ_KVM), 512, WF(WS_SSM), 1.0f, nullptr, 0}; pg8::gemm_phase<EpiScale, pg8::StaticOrder, true, true>(lds, g, S, E, wave_id); }
            }
            SEAM();
        }
        if (RUN(pb + 1)) { PH();
            { OTID(); mixers_phase(la, l, lds, tid); }
#if defined(PROBE_SGU) || defined(PROBE_POOL)
            SEAM();
            { constexpr int PCOL =
#ifdef PROBE_SGU
                768;
#else
                256;
#endif
              bf16* mixp = WB(WS_MIX); bf16* alt = WB(WS_QX);
              for (size_t i = (size_t)bid * NTHR + threadIdx.x; i < (size_t)M * 256; i += (size_t)G * NTHR) alt[i] = mixp[(i >> 8) * D + PCOL + (i & 255)];
              SEAM();
#ifdef PROBE_SGU
              { OTID(); for (int it = bid; it < 512; it += G) sgu_item(la, l, it, lds, tid); }
#else
              { OTID(); for (int it = bid; it < 1024; it += G) pool_item(la, l, it, lds, tid); }
#endif
              SEAM();
              { OTID(); probe_dsa_compare(la, lds, tid, PCOL); }
              SEAM();
              { const float* pr = (const float*)(ws + WS_CTL) + 12288; const float padd = PROBE_C * sqrtf(pr[0] / fmaxf(pr[1], 1e-30f));
                for (size_t i = (size_t)bid * NTHR + threadIdx.x; i < (size_t)M * D; i += (size_t)G * NTHR) la.out[i] = padd; return; } }
#endif
            SEAM();
        }
#ifdef REP_GLAC
        if (RUN(pb + 2)) { PH(); OTID(); int nit = 512; asm volatile("" : "+s"(nit)); for (int it = bid; it < nit; it += G) gla2_c_item(la, l, it & 255, lds, tid);
#else
        if (RUN(pb + 2)) { PH(); OTID(); if (l == 0) frag_phase(la, tid, G, bid); gla_scan_phase(la, tid, G, bid); SEAM(); for (int it = bid; it < 256; it += G) gla2_c_item(la, l, it, lds, tid);
#endif
#if defined(PROBE_DSA) && !defined(PROBE_GLA) && !defined(PROBE_SGU) && !defined(PROBE_POOL)
            probe_dsa_compare(la, lds, tid);
#endif
            SEAM();
#ifdef PROBE_GLA
            { bf16* mixp = WB(WS_MIX); bf16* alt = WB(WS_QX);
              for (size_t i = (size_t)bid * NTHR + threadIdx.x; i < (size_t)M * 256; i += (size_t)G * NTHR) alt[i] = mixp[(i >> 8) * D + (i & 255)];
              SEAM();
              { OTID(); for (int it = bid; it < 1024; it += G) gla_a_item(la, l, it, lds, tid); }
              SEAM();
              { OTID(); for (int it = bid; it < 1024; it += G) gla_c_item(la, l, it, lds, tid); }
              SEAM();
              { OTID(); probe_dsa_compare(la, lds, tid, 0); }
              SEAM();
              { const float* pr = (const float*)(ws + WS_CTL) + 12288; const float padd = PROBE_C * sqrtf(pr[0] / fmaxf(pr[1], 1e-30f));
                for (size_t i = (size_t)bid * NTHR + threadIdx.x; i < (size_t)M * D; i += (size_t)G * NTHR) la.out[i] = padd; return; } }
#endif
            }
        if (RUN(pb + 3)) { PH();
            pg8::Gemm g{WB(WS_MIX), WB(WS_WOUT + l * SZ_WOUT), M, D, D}; pg8::StaticOrder S; S.init(M, D, G, bid);
            EpiResid E{WB(WS_H16), WF(WS_SS)}; pg8::gemm_phase<EpiResid, pg8::StaticOrder, true, true>(lds, g, S, E, wave_id); SEAM();
        }
        if (RUN(pb + 4)) { PH(); OTID(); for (int it = bid; it < 256; it += G) { const int t2 = (tid & ~63) + (int)lane_id_now(); xfuse_item(la, l, it, lds, t2); }
            if (l == 1) { __syncthreads(); const int t3 = (tid & ~63) + (int)lane_id_now(); moe_route(la, lds, t3, G, bid); }
            SEAM(); }
        if (l == 0) {
            if (RUN(8)) { PH();
                REPEAT_BEGIN(REP_FUP)
                pg8::Gemm g{WB(WS_H16), WB(WS_W13), M, 2 * DFF, D}; pg8::StaticOrder S; S.init(M, 2 * DFF, G, bid);
                EpiSwiglu<false> E{WB(WS_FACT), DFF, WF(WS_SS), nullptr, nullptr}; pg8::gemm_phase<EpiSwiglu<false>, pg8::StaticOrder, true, true>(lds, g, S, E, wave_id);
                REPEAT_END()
                    SEAM();
            }
            if (RUN(9)) { PH();
                pg8::Gemm g{WB(WS_FACT), WB(WS_W2), M, D, DFF}; pg8::StaticOrder S; S.init(M, D, G, bid);
                EpiResid E{WB(WS_H16), WF(WS_SS)}; pg8::gemm_phase<EpiResid, pg8::StaticOrder, true, true>(lds, g, S, E, wave_id); SEAM();
            }
        } else {
#ifdef REP_R1
            if (RUN(17)) { PH(); OTID(); moe_route(la, lds, tid, G, bid); __syncthreads(); moe_route(la, lds, tid, G, bid); SEAM(); }
#else
#endif
#ifdef REP_ROUTE
            if (RUN(18)) { PH(); int nrep = 2; asm volatile("" : "+s"(nrep));
#pragma unroll 1
                for (int rep = 0; rep < nrep; ++rep) { OTID(); moe_assign(la, lds, tid, G, bid); __syncthreads(); } SEAM(); }
#else
            if (RUN(18)) { PH(); OTID(); moe_assign(la, lds, tid, G, bid); SEAM(); }
#endif
            for (int ph = 0; ph <= MOE_NPASS; ++ph) {
                const int* TILEE = (const int*)(ws + WS_TILEE);
                if (RUN(19 + ph)) { PH();
                    const int NT = TILEE[159]; int ndown = 0, ndsh = 3;
                    if (ph > 0) { const int p = ph - 1; const int nt = moe_pass_nt(NT, p); ndown = nt * (D / 256); if (ndown > G) { ndown -= G; ndsh = 3; if (ndown > G) ndown = G; }
                        REPEAT_BEGIN(REP_MDN)
                        pg8::Gemm g{WB(WS_MACT + (p & 1) * SZ_MACT), WB(WS_MW2), MOE_TP * 256, NEXP * D, DFE, (const int*)(ws + WS_IDMAP)}; pg8::MoeOrder S{p * MOE_TS, nt, D / 256, G, bid, 1, TILEE, 0, 0};
                        EpiPlain E{WB(WS_YS), D};
                        pg8::gemm_phase<EpiPlain, pg8::MoeOrder, true, true, true, 1>(lds, g, S, E, wave_id);
                        REPEAT_END() }
                    if (ph < MOE_NPASS) { const int p = ph; const int nt = moe_pass_nt(NT, p);
                        REPEAT_BEGIN(REP_MUP)
                        pg8::Gemm g{WB(WS_HB8), WB(WS_MW13), M, NEXP * 2 * DFE, D, (const int*)(ws + WS_SLOTT)}; pg8::MoeOrder S{p * MOE_TS, nt, 2 * DFE / 256, G, bid, 0, TILEE, ndown, ndsh};
                        EpiSwiglu<true> E{WB(WS_MACT + (p & 1) * SZ_MACT), DFE, nullptr, WF(WS_SLOTR), WF(WS_SLOTG)};
                        pg8::gemm_phase<EpiSwiglu<true>, pg8::MoeOrder, true, true, true, 1>(lds, g, S, E, wave_id);
                        REPEAT_END() }
                    SEAM();
                }
            }
#ifdef REP_FINAL
            if (RUN(27)) { PH(); OTID(); final_phase(la, tid, G, bid); }
#else
            if (RUN(27)) { PH(); OTID(); final_phase(la, tid, G, bid); }
#endif
        }
        }
    { constexpr int l = 1;
        const int pb = l ? 10 : 1;
        if (RUN(pb + 0)) { PH();
            REPEAT_BEGIN(REP_Z)
            { pg8::Gemm g{WB(WS_H16), WB(WS_WIN + l * SZ_WIN), M, ZW, D}; pg8::StaticOrder S; S.init(M, ZW, G, bid);
              EpiScale E{WB(WS_Z), ZW, WF(WS_SS), 1.0f, WB(WS_DKF), Z_CK / 256}; pg8::gemm_phase<EpiScale, pg8::StaticOrder, true, true>(lds, g, S, E, wave_id); }
            REPEAT_END()
            if (l == 0) {
                for (int l2 = 0; l2 < 2; ++l2) {
                    pg8::Gemm g{WB(WS_MEMB), WB(WS_WKV + l2 * SZ_WKV), MM, 512, D}; pg8::StaticOrder S; S.init(MM, 512, G, (G - 1 - bid - 16 * l2 + 2 * G) % G);
                    EpiScale E{WB(WS_KVM + l2 * SZ_KVM), 512, WF(WS_SSM), 1.0f, nullptr, 0}; pg8::gemm_phase<EpiScale, pg8::StaticOrder, true, true>(lds, g, S, E, wave_id); }
            }
            SEAM();
        }
        if (RUN(pb + 1)) { PH();
            { OTID(); mixers_phase(la, l, lds, tid); }
#if defined(PROBE_SGU) || defined(PROBE_POOL)
            SEAM();
            { constexpr int PCOL =
#ifdef PROBE_SGU
                768;
#else
                256;
#endif
              bf16* mixp = WB(WS_MIX); bf16* alt = WB(WS_QX);
              for (size_t i = (size_t)bid * NTHR + threadIdx.x; i < (size_t)M * 256; i += (size_t)G * NTHR) alt[i] = mixp[(i >> 8) * D + PCOL + (i & 255)];
              SEAM();
#ifdef PROBE_SGU
              { OTID(); for (int it = bid; it < 512; it += G) sgu_item(la, l, it, lds, tid); }
#else
              { OTID(); for (int it = bid; it < 1024; it += G) pool_item(la, l, it, lds, tid); }
#endif
              SEAM();
              { OTID(); probe_dsa_compare(la, lds, tid, PCOL); }
              SEAM();
              { const float* pr = (const float*)(ws + WS_CTL) + 12288; const float padd = PROBE_C * sqrtf(pr[0] / fmaxf(pr[1], 1e-30f));
                for (size_t i = (size_t)bid * NTHR + threadIdx.x; i < (size_t)M * D; i += (size_t)G * NTHR) la.out[i] = padd; return; } }
#endif
            SEAM();
        }
#ifdef REP_GLAC
        if (RUN(pb + 2)) { PH(); OTID(); int nit = 512; asm volatile("" : "+s"(nit)); for (int it = bid; it < nit; it += G) gla2_c_item(la, l, it & 255, lds, tid);
#else
        if (RUN(pb + 2)) { PH(); OTID(); if (l == 0) frag_phase(la, tid, G, bid); gla_scan_phase(la, tid, G, bid); SEAM(); for (int it = bid; it < 256; it += G) gla2_c_item(la, l, it, lds, tid);
#endif
#if defined(PROBE_DSA) && !defined(PROBE_GLA) && !defined(PROBE_SGU) && !defined(PROBE_POOL)
            probe_dsa_compare(la, lds, tid);
#endif
            SEAM();
#ifdef PROBE_GLA
            { bf16* mixp = WB(WS_MIX); bf16* alt = WB(WS_QX);
              for (size_t i = (size_t)bid * NTHR + threadIdx.x; i < (size_t)M * 256; i += (size_t)G * NTHR) alt[i] = mixp[(i >> 8) * D + (i & 255)];
              SEAM();
              { OTID(); for (int it = bid; it < 1024; it += G) gla_a_item(la, l, it, lds, tid); }
              SEAM();
              { OTID(); for (int it = bid; it < 1024; it += G) gla_c_item(la, l, it, lds, tid); }
              SEAM();
              { OTID(); probe_dsa_compare(la, lds, tid, 0); }
              SEAM();
              { const float* pr = (const float*)(ws + WS_CTL) + 12288; const float padd = PROBE_C * sqrtf(pr[0] / fmaxf(pr[1], 1e-30f));
                for (size_t i = (size_t)bid * NTHR + threadIdx.x; i < (size_t)M * D; i += (size_t)G * NTHR) la.out[i] = padd; return; } }
#endif
            }
        if (RUN(pb + 3)) { PH();
            pg8::Gemm g{WB(WS_MIX), WB(WS_WOUT + l * SZ_WOUT), M, D, D}; pg8::StaticOrder S; S.init(M, D, G, bid);
            EpiResid E{WB(WS_H16), WF(WS_SS)}; pg8::gemm_phase<EpiResid, pg8::StaticOrder, true, true>(lds, g, S, E, wave_id); SEAM();
        }
        if (RUN(pb + 4)) { PH(); OTID(); for (int it = bid; it < 256; it += G) { const int t2 = (tid & ~63) + (int)lane_id_now(); xfuse_item(la, l, it, lds, t2); }
            if (l == 1) { __syncthreads(); const int t3 = (tid & ~63) + (int)lane_id_now(); moe_route(la, lds, t3, G, bid); }
            SEAM(); }
        if (l == 0) {
            if (RUN(8)) { PH();
                REPEAT_BEGIN(REP_FUP)
                pg8::Gemm g{WB(WS_H16), WB(WS_W13), M, 2 * DFF, D}; pg8::StaticOrder S; S.init(M, 2 * DFF, G, bid);
                EpiSwiglu<false> E{WB(WS_FACT), DFF, WF(WS_SS), nullptr, nullptr}; pg8::gemm_phase<EpiSwiglu<false>, pg8::StaticOrder, true, true>(lds, g, S, E, wave_id);
                REPEAT_END()
                    SEAM();
            }
            if (RUN(9)) { PH();
                pg8::Gemm g{WB(WS_FACT), WB(WS_W2), M, D, DFF}; pg8::StaticOrder S; S.init(M, D, G, bid);
                EpiResid E{WB(WS_H16), WF(WS_SS)}; pg8::gemm_phase<EpiResid, pg8::StaticOrder, true, true>(lds, g, S, E, wave_id); SEAM();
            }
        } else {
#ifdef REP_R1
            if (RUN(17)) { PH(); OTID(); moe_route(la, lds, tid, G, bid); __syncthreads(); moe_route(la, lds, tid, G, bid); SEAM(); }
#else
#endif
#ifdef REP_ROUTE
            if (RUN(18)) { PH(); int nrep = 2; asm volatile("" : "+s"(nrep));
#pragma unroll 1
                for (int rep = 0; rep < nrep; ++rep) { OTID(); moe_assign(la, lds, tid, G, bid); __syncthreads(); } SEAM(); }
#else
            if (RUN(18)) { PH(); OTID(); moe_assign(la, lds, tid, G, bid); SEAM(); }
#endif
            for (int ph = 0; ph <= MOE_NPASS; ++ph) {
                const int* TILEE = (const int*)(ws + WS_TILEE);
                if (RUN(19 + ph)) { PH();
                    const int NT = TILEE[159]; int ndown = 0, ndsh = 3;
                    if (ph > 0) { const int p = ph - 1; const int nt = moe_pass_nt(NT, p); ndown = nt * (D / 256); if (ndown > G) { ndown -= G; ndsh = 3; if (ndown > G) ndown = G; }
                        REPEAT_BEGIN(REP_MDN)
                        pg8::Gemm g{WB(WS_MACT + (p & 1) * SZ_MACT), WB(WS_MW2), MOE_TP * 256, NEXP * D, DFE, (const int*)(ws + WS_IDMAP)}; pg8::MoeOrder S{p * MOE_TS, nt, D / 256, G, bid, 1, TILEE, 0, 0};
                        EpiPlain E{WB(WS_YS), D};
                        pg8::gemm_phase<EpiPlain, pg8::MoeOrder, true, true, true, 1>(lds, g, S, E, wave_id);
                        REPEAT_END() }
                    if (ph < MOE_NPASS) { const int p = ph; const int nt = moe_pass_nt(NT, p);
                        REPEAT_BEGIN(REP_MUP)
                        pg8::Gemm g{WB(WS_HB8), WB(WS_MW13), M, NEXP * 2 * DFE, D, (const int*)(ws + WS_SLOTT)}; pg8::MoeOrder S{p * MOE_TS, nt, 2 * DFE / 256, G, bid, 0, TILEE, ndown, ndsh};
                        EpiSwiglu<true> E{WB(WS_MACT + (p & 1) * SZ_MACT), DFE, nullptr, WF(WS_SLOTR), WF(WS_SLOTG)};
                        pg8::gemm_phase<EpiSwiglu<true>, pg8::MoeOrder, true, true, true, 1>(lds, g, S, E, wave_id);
                        REPEAT_END() }
                    SEAM();
                }
            }
#ifdef REP_FINAL
            if (RUN(27)) { PH(); OTID(); final_phase(la, tid, G, bid); }
#else
            if (RUN(27)) { PH(); OTID(); final_phase(la, tid, G, bid); }
#endif
        }
        }
#undef RUN
#undef SEAM
}

extern "C" void kernel_launch(void* const* d_in, const int* in_sizes, int n_in, void* d_out, int out_size, void* d_ws, size_t ws_size, hipStream_t stream) {
    static int grid = 0;
    if (grid == 0) {
        if (n_in != N_IN || out_size != M * D || ws_size < WS_END) { fprintf(stderr, "kernel_launch: unexpected problem (n_in %d, out %d, ws %zu < %zu)\n", n_in, out_size, ws_size, (size_t)WS_END); grid = -1; return; }
        int dev = 0, cus = 0, per_cu = 0;
        if (hipGetDevice(&dev) != hipSuccess || hipDeviceGetAttribute(&cus, hipDeviceAttributeMultiprocessorCount, dev) != hipSuccess) { grid = -1; return; }
        if (hipFuncSetAttribute((const void*)fwd_kernel, hipFuncAttributeMaxDynamicSharedMemorySize, LDS_BYTES) != hipSuccess) { fprintf(stderr, "kernel_launch: hipFuncSetAttribute failed\n"); grid = -1; return; }
        if (hipOccupancyMaxActiveBlocksPerMultiprocessor(&per_cu, (const void*)fwd_kernel, NTHR, LDS_BYTES) != hipSuccess || per_cu < 1) { fprintf(stderr, "kernel_launch: occupancy query says %d\n", per_cu); }
        (void)hipGetLastError();
        grid = (cus > 0 && cus < 256) ? cus : 256;
    }
    if (grid < 0) return;
    (void)hipMemsetAsync((char*)d_ws + WS_CTL, 0, CTL_ZERO_BYTES, stream);
    Args a{};
    for (int i = 0; i < N_IN; ++i) a.in[i] = (const float*)d_in[i];
    a.out = (float*)d_out; a.ws = (unsigned char*)d_ws;
#if N_LAUNCH_MODE == 1
    a.ph_lo = 0; a.ph_hi = NPHASE;
    hipLaunchKernelGGL(fwd_kernel, dim3(grid), dim3(NTHR), LDS_BYTES, stream, a);
#else
    for (int p = 0; p < NPHASE; ++p) { a.ph_lo = p; a.ph_hi = p + 1; hipLaunchKernelGGL(fwd_kernel, dim3(grid), dim3(NTHR), LDS_BYTES, stream, a); }
#endif
}
```

```cpp
#include <hip/hip_runtime.h>
#include <cstdio>
#include <cstdint>
#include <cmath>

#ifndef N_LAUNCH_MODE
#define N_LAUNCH_MODE 1
#endif

namespace pg8 {
#define PG8_LAS __attribute__((address_space(3)))
typedef unsigned short bf16_t;
typedef short bf16x8 __attribute__((ext_vector_type(8)));
typedef float f32x4 __attribute__((ext_vector_type(4)));
typedef unsigned u32x4 __attribute__((ext_vector_type(4)));
constexpr int BM = 256, BK = 64, HALF = 128, HTB = HALF * BK * 2  , STAGE_BYTES = 8 * HTB, NXCD = 8, WGM = 8;

__host__ __device__ __forceinline__ int lds_byte(int r, int c) { const int st = (r >> 4) * 2 + (c >> 5), rr = r & 15, cc = c & 31, ob = rr * 64 + cc * 2; return st * 1024 + (ob ^ (((ob >> 9) & 1) << 5)); }
__host__ __device__ __forceinline__ void stage_rc(int b, int& R, int& C) { const int st = b / 1024, sb = b % 1024, swz = sb ^ (((sb >> 9) & 1) << 5); R = (st >> 1) * 16 + swz / 64; C = (st & 1) * 32 + (swz % 64) / 2; }
__host__ __device__ __forceinline__ int perm32(int rho) { const int n = rho >> 4, i = rho & 15; return 8 * (i >> 2) + 4 * n + (i & 3); }

struct Unit { int pm, pn, po, e; };
struct Gemm { const bf16_t* A; const bf16_t* Bt; int M, N, K; const int* rowmap; };

struct StaticOrder {
    int nM, nN, nwg, G, c;
    __host__ __device__ void init(int M, int N, int G_, int c_) { nM = M / BM; nN = N / BM; nwg = nM * nN; G = G_; c = c_; }
    __host__ __device__ bool next(int i, Unit& u) const {
        const long L = (long)i * G + c; if (L >= nwg) return false;
        int wgid = (int)L; { const int q = nwg / NXCD, r = nwg % NXCD, xcd = wgid % NXCD, off = wgid / NXCD; wgid = (xcd < r ? xcd * (q + 1) : r * (q + 1) + (xcd - r) * q) + off; }
        const int nig = WGM * nN, gid = wgid / nig, fm = gid * WGM, gsz = (nM - fm) < WGM ? (nM - fm) : WGM;
        u.pm = fm + ((wgid % nig) % gsz); u.pn = (wgid % nig) / gsz; u.po = u.pm; u.e = u.pn; return true;
    }
    __device__ __forceinline__ void a_ready(const Unit&) const {}
    __device__ __forceinline__ void done(const Unit&) const {}
};
struct MoeOrder {
    int t0, nt, nNe, G, c, a_local; const int* tile_e; int nd, sh;
    __device__ bool next(int i, Unit& u) const {
        const int F = G - nd; long L;
        if (c >= nd) L = (i < sh) ? (long)i * F + (c - nd) : (long)sh * F + (long)(i - sh) * G + c; else L = (long)sh * F + (long)i * G + c;
        if (L >= (long)nt * nNe) return false;
        const int tl = (int)(L % nt), pn = (int)(L / nt), tile = t0 + tl, e = tile_e[tile];
        u.pm = a_local ? tl : tile; u.po = a_local ? tile : tl; u.pn = e * nNe + pn; u.e = pn; return true;
    }
    __device__ __forceinline__ void a_ready(const Unit&) const {}
    __device__ __forceinline__ void done(const Unit&) const {}
};
__device__ __forceinline__ unsigned cvt_pk_bf16(float lo, float hi) { unsigned r; asm volatile("v_cvt_pk_bf16_f32 %0, %1, %2" : "=v"(r) : "v"(lo), "v"(hi)); return r; }
template <class Epi, class Sched, bool ALIGN_EPI = false, bool SP2 = false, bool GATHER = false, int ES = 2>
__device__ __forceinline__ void gemm_phase(PG8_LAS unsigned char* lds, const Gemm g, const Sched& S, const Epi& E, int wave_id) {
    unsigned lane_; asm volatile("v_mbcnt_lo_u32_b32 %0, -1, 0\n\tv_mbcnt_hi_u32_b32 %0, -1, %0" : "=v"(lane_)); const int tid_ = wave_id * 64 + (int)lane_; const int tid = tid_, wid = __builtin_amdgcn_readfirstlane(tid >> 6), lane = tid & 63, wr = wid >> 2, wc = wid & 3, fr = lane & 15, fq = lane >> 4;
    static_assert(!GATHER || SP2, "gather staging is written for the two-super-phase loop");
    const int K = g.K, nt = (K * ES) / (BK * 2);
    unsigned voffA[2], voffB[2];
#pragma unroll
    for (int i = 0; i < 2; ++i) { int R, C; stage_rc(tid * 16 + i * 8192, R, C); const int Rb = Epi::PERM ? ((R & ~31) + perm32(R & 31)) : R;
        voffA[i] = (unsigned)(R * K * ES + C * 2); voffB[i] = (unsigned)(Rb * K * ES + C * 2); }
    unsigned vgC[2][2], vgN[2][2];
#define PG8_GOFF(dst, pm_) do { if constexpr (GATHER) { _Pragma("unroll") for (int _h = 0; _h < 2; ++_h) _Pragma("unroll") for (int _i = 0; _i < 2; ++_i) \
        { int _R, _C; stage_rc(tid * 16 + _i * 8192, _R, _C); dst[_h][_i] = (unsigned)g.rowmap[(pm_) * BM + _h * HALF + _R] * (unsigned)(K * ES) + (unsigned)_C * 2u; } } } while (0)
    const size_t kstep = (size_t)(BK * 2);
    const size_t hstep = (size_t)HALF * K * ES;
    const size_t tstep = 2 * hstep;
    const unsigned ldsw = (unsigned)wid * 1024u;
    const int aoff = ES == 2 ? lds_byte(wr * 64 + fr, fq * 8) : lds_byte(wr * 64 + fr, fq * 16), boff = ES == 2 ? lds_byte(wc * 32 + fr, fq * 8) : lds_byte(wc * 32 + fr, fq * 16);
    const int aoff2 = ES == 2 ? aoff + 1024 : lds_byte(wr * 64 + fr, fq * 16 + 8), boff2 = ES == 2 ? boff + 1024 : lds_byte(wc * 32 + fr, fq * 16 + 8);
#define PG8_SA(b, h) (((b) * 2 + (h)) * HTB)
#define PG8_SB(b, h) ((4 + (b) * 2 + (h)) * HTB)
#define PG8_STAGE_A(b, h, gbase, vg) do { if constexpr (GATHER) { PG8_STAGE(PG8_SA(b, h), gbase, vg[h]); } else { PG8_STAGE(PG8_SA(b, h), (gbase) + (h) * hstep, voffA); } } while (0)
#define PG8_STAGE(bufoff, gbase, voff) do { _Pragma("unroll") for (int _i = 0; _i < 2; ++_i) \
        __builtin_amdgcn_global_load_lds((const unsigned*)((const char*)(gbase) + (voff)[_i]), (PG8_LAS unsigned*)(lds + (bufoff) + ldsw + _i * 8192), 16, 0, 0); } while (0)
#define PG8_LDA(dst, b, h) do { _Pragma("unroll") for (int m = 0; m < 4; ++m) _Pragma("unroll") for (int k = 0; k < 2; ++k) dst[m][k] = *(const PG8_LAS bf16x8*)(lds + PG8_SA(b, h) + (k ? aoff2 : aoff) + m * 2048); } while (0)
#define PG8_LDB(dst, b, h) do { _Pragma("unroll") for (int n = 0; n < 2; ++n) _Pragma("unroll") for (int k = 0; k < 2; ++k) dst[n][k] = *(const PG8_LAS bf16x8*)(lds + PG8_SB(b, h) + (k ? boff2 : boff) + n * 2048); } while (0)
#define PG8_MMA(ai, bj, At, Bt) do { __builtin_amdgcn_s_setprio(1); _Pragma("unroll") for (int m = 0; m < 4; ++m) _Pragma("unroll") for (int n = 0; n < 2; ++n) { \
        if constexpr (ES == 2) { _Pragma("unroll") for (int k = 0; k < 2; ++k) acc[ai][bj][m][n] = __builtin_amdgcn_mfma_f32_16x16x32_bf16(Bt[n][k], At[m][k], acc[ai][bj][m][n], 0, 0, 0); } \
        else { const i32x4_ bl_ = __builtin_bit_cast(i32x4_, Bt[n][0]), bh_ = __builtin_bit_cast(i32x4_, Bt[n][1]), al_ = __builtin_bit_cast(i32x4_, At[m][0]), ah_ = __builtin_bit_cast(i32x4_, At[m][1]); \
               acc[ai][bj][m][n] = __builtin_amdgcn_mfma_scale_f32_16x16x128_f8f6f4(__builtin_shufflevector(bl_, bh_, 0, 1, 2, 3, 4, 5, 6, 7), __builtin_shufflevector(al_, ah_, 0, 1, 2, 3, 4, 5, 6, 7), \
                                                                                     acc[ai][bj][m][n], 0, 0, 0, 0x7f7f7f7f, 0, 0x7f7f7f7f); } } \
        __builtin_amdgcn_s_setprio(0); } while (0)
#define PG8_WAIT_V(n) asm volatile("s_waitcnt vmcnt(" #n ")" ::: "memory")
#define PG8_WAIT_L(n) asm volatile("s_waitcnt lgkmcnt(" #n ")" ::: "memory")
#define PG8_BAR __builtin_amdgcn_s_barrier()
#define PG8_SCHED __builtin_amdgcn_sched_barrier(0)
    Unit cur, nxt; int ui = 0;
    if (!S.next(0, cur)) return;
    f32x4 acc[2][2][4][2];
#pragma unroll
    for (int a = 0; a < 2; ++a)
#pragma unroll
        for (int b = 0; b < 2; ++b)
#pragma unroll
            for (int m = 0; m < 4; ++m)
#pragma unroll
                for (int n = 0; n < 2; ++n) acc[a][b][m][n] = (f32x4){0.f, 0.f, 0.f, 0.f};
    typedef int i32x4_ __attribute__((ext_vector_type(4))); typedef int i32x8_ __attribute__((ext_vector_type(8)));
    bf16x8 At[4][2], B0[2][2], B1[2][2];
    const char* cA = (const char*)g.A + (GATHER ? (size_t)0 : (size_t)cur.pm * tstep); const char* cB = (const char*)g.Bt + (size_t)cur.pn * tstep;
    PG8_GOFF(vgC, cur.pm);
    S.a_ready(cur);
    if constexpr (SP2) {
        PG8_STAGE(PG8_SB(0, 0), cB, voffB); PG8_STAGE(PG8_SB(0, 1), cB + hstep, voffB); PG8_STAGE_A(0, 0, cA, vgC); PG8_STAGE_A(0, 1, cA, vgC);
        if (wr == 1) PG8_BAR;
        PG8_WAIT_V(2); PG8_BAR;
        PG8_STAGE(PG8_SB(1, 0), cB + kstep, voffB); PG8_STAGE_A(1, 0, cA + kstep, vgC); PG8_STAGE(PG8_SB(1, 1), cB + hstep + kstep, voffB);
        PG8_WAIT_V(6); PG8_BAR;
    } else {
        PG8_STAGE(PG8_SB(0, 0), cB, voffB); PG8_STAGE(PG8_SA(0, 0), cA, voffA); PG8_STAGE(PG8_SB(0, 1), cB + hstep, voffB); PG8_STAGE(PG8_SA(0, 1), cA + hstep, voffA);
        if (wr == 1) PG8_BAR;
        PG8_WAIT_V(4); PG8_BAR;
        PG8_STAGE(PG8_SB(1, 0), cB + kstep, voffB); PG8_STAGE(PG8_SA(1, 0), cA + kstep, voffA); PG8_STAGE(PG8_SB(1, 1), cB + hstep + kstep, voffB);
        PG8_WAIT_V(6); PG8_BAR;
    }
    for (;;) {
        const bool has_next = S.next(ui + 1, nxt);
        const char* nA = (has_next && !GATHER) ? (const char*)g.A + (size_t)nxt.pm * tstep : cA; const char* nB = has_next ? (const char*)g.Bt + (size_t)nxt.pn * tstep : cB;
        if constexpr (GATHER) { if (has_next) { PG8_GOFF(vgN, nxt.pm); } else { _Pragma("unroll") for (int _h = 0; _h < 2; ++_h) _Pragma("unroll") for (int _i = 0; _i < 2; ++_i) vgN[_h][_i] = vgC[_h][_i]; } }
#pragma unroll 1
        for (int t = 0; t < nt; t += 2) {
            const bool last = (t == nt - 2);
            const char* a1 = cA + (size_t)(t + 1) * kstep;
            const char* a2 = last ? nA : cA + (size_t)(t + 2) * kstep; const char* b2 = last ? nB : cB + (size_t)(t + 2) * kstep;
            const char* a3 = a2 + kstep; const char* b3 = b2 + kstep;
            if (last && has_next) S.a_ready(nxt);
            if constexpr (SP2) {
            PG8_LDB(B0, 0, 0); PG8_LDB(B1, 0, 1); PG8_SCHED; PG8_LDA(At, 0, 0); PG8_STAGE_A(1, 1, a1, vgC);
            if constexpr (GATHER) { if (last) { _Pragma("unroll") for (int _h = 0; _h < 2; ++_h) _Pragma("unroll") for (int _i = 0; _i < 2; ++_i) vgC[_h][_i] = vgN[_h][_i]; } }
            PG8_WAIT_V(8); PG8_WAIT_L(0); PG8_BAR; PG8_MMA(0, 0, At, B0); PG8_MMA(0, 1, At, B1); PG8_BAR; PG8_SCHED;
            PG8_LDA(At, 0, 1); PG8_STAGE(PG8_SB(0, 0), b2, voffB); PG8_STAGE(PG8_SB(0, 1), b2 + hstep, voffB); PG8_STAGE_A(0, 0, a2, vgC);
            PG8_WAIT_V(8); PG8_WAIT_L(0); PG8_BAR; PG8_MMA(1, 0, At, B0); PG8_MMA(1, 1, At, B1); PG8_BAR; PG8_SCHED;
            PG8_LDB(B0, 1, 0); PG8_LDB(B1, 1, 1); PG8_SCHED; PG8_LDA(At, 1, 0); PG8_STAGE_A(0, 1, a2, vgC);
            PG8_WAIT_V(8); PG8_WAIT_L(0); PG8_BAR; PG8_MMA(0, 0, At, B0); PG8_MMA(0, 1, At, B1); PG8_BAR; PG8_SCHED;
            PG8_LDA(At, 1, 1); PG8_STAGE(PG8_SB(1, 0), b3, voffB); PG8_STAGE(PG8_SB(1, 1), b3 + hstep, voffB); PG8_STAGE_A(1, 0, a3, vgC);
            PG8_WAIT_V(8); PG8_WAIT_L(0); PG8_BAR; PG8_MMA(1, 0, At, B0); PG8_MMA(1, 1, At, B1); PG8_BAR; PG8_SCHED;
            } else {
            PG8_LDB(B0, 0, 0); PG8_SCHED; PG8_LDA(At, 0, 0); PG8_STAGE(PG8_SA(1, 1), a1 + hstep, voffA);
            PG8_WAIT_L(8); PG8_BAR; PG8_WAIT_L(0); PG8_MMA(0, 0, At, B0); PG8_BAR; PG8_SCHED;
            PG8_LDB(B1, 0, 1); PG8_STAGE(PG8_SB(0, 0), b2, voffB);
            PG8_BAR; PG8_WAIT_L(0); PG8_MMA(0, 1, At, B1); PG8_BAR;
            PG8_LDA(At, 0, 1); PG8_STAGE(PG8_SA(0, 0), a2, voffA);
            PG8_BAR; PG8_WAIT_L(0); PG8_MMA(1, 0, At, B0); PG8_BAR; PG8_SCHED;
            PG8_STAGE(PG8_SB(0, 1), b2 + hstep, voffB);
            PG8_WAIT_V(6); PG8_BAR; PG8_MMA(1, 1, At, B1); PG8_BAR;
            PG8_LDB(B0, 1, 0); PG8_SCHED; PG8_LDA(At, 1, 0); PG8_STAGE(PG8_SA(0, 1), a2 + hstep, voffA);
            PG8_WAIT_L(8); PG8_BAR; PG8_WAIT_L(0); PG8_MMA(0, 0, At, B0); PG8_BAR; PG8_SCHED;
            PG8_LDB(B1, 1, 1); PG8_STAGE(PG8_SB(1, 0), b3, voffB);
            PG8_BAR; PG8_WAIT_L(0); PG8_MMA(0, 1, At, B1); PG8_BAR;
            PG8_LDA(At, 1, 1); PG8_STAGE(PG8_SA(1, 0), a3, voffA);
            PG8_BAR; PG8_WAIT_L(0); PG8_MMA(1, 0, At, B0); PG8_BAR; PG8_SCHED;
            PG8_STAGE(PG8_SB(1, 1), b3 + hstep, voffB);
            PG8_WAIT_V(6); PG8_BAR; PG8_MMA(1, 1, At, B1); PG8_BAR;
            }
        }
        if constexpr (ALIGN_EPI) { if (wr == 0) PG8_BAR; }
        if constexpr (!Epi::AFTER_DRAIN) { E(acc, cur, wr, wc, fr, fq); S.done(cur); }
        if (!has_next) break;
#pragma unroll
        for (int a = 0; a < 2; ++a)
#pragma unroll
            for (int b = 0; b < 2; ++b)
#pragma unroll
                for (int m = 0; m < 4; ++m)
#pragma unroll
                    for (int n = 0; n < 2; ++n) acc[a][b][m][n] = (f32x4){0.f, 0.f, 0.f, 0.f};
        cur = nxt; cA = nA; cB = nB; ++ui;
        if constexpr (ALIGN_EPI) { if (wr == 1) PG8_BAR; }
    }
    PG8_WAIT_V(0);
    if constexpr (!ALIGN_EPI) { if (wr == 0) PG8_BAR; }
    PG8_BAR;
    if constexpr (Epi::AFTER_DRAIN) { E.fused(acc, cur, wr, wc, fr, fq, lds, wid, lane); S.done(cur); }
#undef PG8_SA
#undef PG8_SB
#undef PG8_STAGE
#undef PG8_STAGE_A
#undef PG8_GOFF
#undef PG8_LDA
#undef PG8_LDB
#undef PG8_MMA
#undef PG8_WAIT_V
#undef PG8_WAIT_L
#undef PG8_BAR
#undef PG8_SCHED
}
}

constexpr int BATCH = 8, T = 2048, D = 1024, M = BATCH * T, MEMLEN = 256, MM = BATCH * MEMLEN;
constexpr int INW = 2616, ZW = 2816;
constexpr int DFF = 2816, NEXP = 8, DFE = 3584;
constexpr float EPS = 1e-6f;
constexpr int Z_AQ = 0, Z_AK = 128, Z_AV = 256, Z_AG = 512, Z_CQ = 768, Z_CK = 1024, Z_CV = 1280, Z_CQI = 1536, Z_DUV = 1792, Z_BU = 2304, Z_ALR = 2560, Z_CKI = 2576, Z_CWI = 2608;
__host__ __device__ constexpr int zcol_of(int n) {
    return n < 768 ? n : n < 784 ? Z_ALR + (n - 768) : n < 1040 ? Z_BU + (n - 784) : n < 2064 ? Z_CQ + (n - 1040) : n < 2096 ? Z_CKI + (n - 2064) : n < 2104 ? Z_CWI + (n - 2096) : Z_DUV + (n - 2104);
}
constexpr int NWAVES = 8, NTHR = 512;
constexpr int MOE_TP = 72, MOE_NPASS = 2, MOE_MAXT = MOE_TP * MOE_NPASS;
constexpr int MAXSLOT = MOE_MAXT * 256;
constexpr int MOE_TS = 72;
__host__ __device__ constexpr int moe_pass_nt(int NT, int p) { const int r = NT - p * MOE_TS, cap = (p == MOE_NPASS - 1) ? MOE_TP : MOE_TS; return r < 0 ? 0 : (r > cap ? cap : r); }
static_assert((MOE_NPASS - 1) * MOE_TS + MOE_TP >= 136, "pass capacity");

constexpr size_t MiB = 1u << 20;
constexpr size_t al(size_t x) { return (x + 4095) & ~(size_t)4095; }
constexpr size_t WS_CTL = 0, CTL_ZERO_BYTES = 64 * 1024;
constexpr size_t WS_SS = 1 * MiB;
constexpr size_t WS_SSM = WS_SS + al((size_t)M * 16 * 4);
constexpr size_t WS_TOKE = WS_SSM + al((size_t)MM * 16 * 4);
constexpr size_t WS_TOKG = WS_TOKE + al((size_t)M * 8);
constexpr size_t WS_TOKR = WS_TOKG + al((size_t)M * 8);
constexpr size_t WS_TOKS = WS_TOKR + al((size_t)M * 4);
constexpr size_t WS_CNT = WS_TOKS + al((size_t)M * 8);
constexpr size_t WS_TILEE = WS_CNT + al(256 * 8 * 4);
constexpr size_t WS_SLOTR = WS_TILEE + al(160 * 4);
constexpr size_t WS_SLOTG = WS_SLOTR + al((size_t)MAXSLOT * 4);
constexpr size_t WS_SLOTT = WS_SLOTG + al((size_t)MAXSLOT * 4);
constexpr size_t WS_IDMAP = WS_SLOTT + al((size_t)MAXSLOT * 4);
constexpr size_t WS_SWT = al(WS_IDMAP + (size_t)MOE_TP * 256 * 4);
constexpr size_t WS_PWT = WS_SWT + (size_t)2 * 4 * 128 * 128 * 2;
constexpr size_t WS_WIN = al(WS_PWT + (size_t)2 * 4 * 64 * 64 * 2 + MiB);
constexpr size_t SZ_WIN = (size_t)ZW * D * 2, SZ_WOUT = (size_t)D * D * 2, SZ_WQ = (size_t)256 * D * 2, SZ_WKV = (size_t)512 * D * 2, SZ_WO = (size_t)D * 256 * 2;
constexpr size_t WS_WOUT = WS_WIN + 2 * SZ_WIN, WS_WQ = WS_WOUT + 2 * SZ_WOUT, WS_WKV = WS_WQ + 2 * SZ_WQ, WS_WO = WS_WKV + 2 * SZ_WKV;
constexpr size_t WS_W13 = WS_WO + 2 * SZ_WO, WS_W2 = WS_W13 + (size_t)2 * DFF * D * 2, WS_MW13 = WS_W2 + (size_t)D * DFF * 2;
constexpr size_t WS_MW2 = WS_MW13 + (size_t)NEXP * 2 * DFE * D * 2, WS_KVM = WS_MW2 + (size_t)NEXP * D * DFE * 2;
constexpr size_t SZ_KVM = (size_t)MM * 512 * 2;
constexpr size_t WS_MEMB = WS_KVM + 2 * SZ_KVM;
constexpr size_t WS_ACT = al(WS_MEMB + (size_t)MM * D * 2);
constexpr size_t WS_HB = WS_ACT, WS_Z = WS_HB + (size_t)M * D * 2, WS_MIX = WS_Z + (size_t)M * ZW * 2, WS_QX = WS_MIX + (size_t)M * D * 2, WS_OX = WS_QX + (size_t)M * 256 * 2;
constexpr size_t WS_GOI = WS_OX + (size_t)M * 256 * 2, WS_GQT = WS_GOI + (size_t)M * 256 * 4, WS_GKV = WS_GQT + (size_t)M * 128 * 4, WS_GDEC = WS_GKV + (size_t)1024 * 2048 * 4;
constexpr size_t WS_ACT_END = WS_GDEC + (size_t)1024 * 32 * 4;
constexpr size_t WS_FACT = WS_Z;
constexpr size_t SZ_MACT = (size_t)MOE_TP * 256 * DFE;
constexpr size_t WS_HB8 = WS_HB;
constexpr size_t WS_MACT = WS_HB + (size_t)M * D, WS_YS = WS_MACT + 2 * SZ_MACT, WS_MOE_END = WS_YS + (size_t)MAXSLOT * D * 2;
constexpr size_t WS_H16 = WS_MOE_END > WS_ACT_END ? WS_MOE_END : WS_ACT_END;
constexpr size_t WS_VF = WS_H16 + (size_t)M * D * 2;
constexpr size_t WS_KF = WS_VF + 2 * (size_t)MM * 256 * 2, WS_WQF = WS_KF + 2 * (size_t)MM * 256 * 2, WS_WOF = WS_WQF + 2 * (size_t)256 * D * 2;
constexpr size_t WS_DKF = WS_WOF + 2 * (size_t)D * 256 * 2;
constexpr size_t WS_END = WS_DKF + (size_t)M * 256 * 2;
static_assert(WS_MOE_END <= WS_H16, "MoE overlays end below the residual stream");
constexpr int CW_BAR = 4096;

constexpr int LDS_BYTES = 147456;
constexpr int MISC_OFF = 147456 - 512;
constexpr int SCR_BYTES = MISC_OFF, ARGS_OFF = MISC_OFF + 128;

#define GAS __attribute__((address_space(1)))
#define LAS __attribute__((address_space(3)))
typedef unsigned short bf16;
typedef unsigned v4u __attribute__((ext_vector_type(4)));
typedef unsigned v2u __attribute__((ext_vector_type(2)));
typedef float f32x4 __attribute__((ext_vector_type(4)));
typedef GAS unsigned gu32;
#define RLX_AGENT __ATOMIC_RELAXED, __HIP_MEMORY_SCOPE_AGENT
#define LDS_WAIT() asm volatile("s_waitcnt lgkmcnt(0)" ::: "memory")
#define LDS_ADD(p, v) (void)__hip_atomic_fetch_add((p), (v), __ATOMIC_RELAXED, __HIP_MEMORY_SCOPE_WORKGROUP)
__device__ __forceinline__ unsigned f2bf(float f) { unsigned u = __builtin_bit_cast(unsigned, f); return (u + 0x7fffu + ((u >> 16) & 1u)) >> 16; }
__device__ __forceinline__ unsigned pk2(float lo, float hi) { return f2bf(lo) | (f2bf(hi) << 16); }
__device__ __forceinline__ unsigned pk4_fp8(float a, float b, float c, float d) { int p = 0; p = __builtin_amdgcn_cvt_pk_fp8_f32(a, b, p, false); p = __builtin_amdgcn_cvt_pk_fp8_f32(c, d, p, true); return (unsigned)p; }
constexpr float W8_SCALE = 64.0f, A8_SCALE = 8.0f, X8_SCALE = 16.0f;
__device__ __forceinline__ float bflo(unsigned w) { return __builtin_bit_cast(float, w << 16); }
__device__ __forceinline__ float bfhi(unsigned w) { return __builtin_bit_cast(float, w & 0xffff0000u); }
__device__ __forceinline__ f32x4 bf4(v2u p) { f32x4 r; r.x = bflo(p.x); r.y = bfhi(p.x); r.z = bflo(p.y); r.w = bfhi(p.y); return r; }
__device__ __forceinline__ float bf1(bf16 b) { return __builtin_bit_cast(float, ((unsigned)b) << 16); }
__device__ __forceinline__ unsigned lane_id_now() { unsigned l; asm volatile("v_mbcnt_lo_u32_b32 %0, -1, 0\n\tv_mbcnt_hi_u32_b32 %0, -1, %0" : "=v"(l)); return l; }
template <int MASK> __device__ __forceinline__ float shfl_xor_c(float v) {
    if constexpr (MASK < 32) return __builtin_bit_cast(float, __builtin_amdgcn_ds_swizzle(__builtin_bit_cast(int, v), (MASK << 10) | 0x1f));
    else return __builtin_bit_cast(float, __builtin_amdgcn_ds_bpermute((int)((lane_id_now() ^ 32u) << 2), __builtin_bit_cast(int, v)));
}
__device__ __forceinline__ float shfl_idx(float v, int src_lane) { return __builtin_bit_cast(float, __builtin_amdgcn_ds_bpermute(src_lane << 2, __builtin_bit_cast(int, v))); }
__device__ __forceinline__ unsigned shfl_idx_u(unsigned v, int src_lane) { return (unsigned)__builtin_amdgcn_ds_bpermute(src_lane << 2, (int)v); }
__device__ __forceinline__ float wave_sum(float v) {
    v += shfl_xor_c<1>(v); v += shfl_xor_c<2>(v); v += shfl_xor_c<4>(v); v += shfl_xor_c<8>(v); v += shfl_xor_c<16>(v); v += shfl_xor_c<32>(v);
    return v;
}
__device__ __forceinline__ float wave_max(float v) {
    v = fmaxf(v, shfl_xor_c<1>(v)); v = fmaxf(v, shfl_xor_c<2>(v)); v = fmaxf(v, shfl_xor_c<4>(v)); v = fmaxf(v, shfl_xor_c<8>(v)); v = fmaxf(v, shfl_xor_c<16>(v)); v = fmaxf(v, shfl_xor_c<32>(v));
    return v;
}
#define XB_TMO      128
#define XB_XCNT(j)  (256  + 64 * (j))
#define XB_XSUB(j)  (1280 + 64 * (j))
#define XB_XGEN(j)  (2304 + 64 * (j))
#define XB_TOP      3328
#define XB_TOPGEN   3392
#define XCD_BAR_WORDS 3456
#define XB_SPIN_CAP (1u << 18)

__device__ __forceinline__ unsigned xb_ld(unsigned* p)              { return __hip_atomic_load(p, __ATOMIC_RELAXED, __HIP_MEMORY_SCOPE_AGENT); }
__device__ __forceinline__ unsigned xb_add(unsigned* p, unsigned v) { return __hip_atomic_fetch_add(p, v, __ATOMIC_RELAXED, __HIP_MEMORY_SCOPE_AGENT); }
__device__ __forceinline__ unsigned xb_xcc_id() { return (unsigned)__builtin_amdgcn_s_getreg((3 << 11) | 20) & 0xFu; }
#define XB_SPIN(cond, bar) do { unsigned _sp = 0; while (cond) { __builtin_amdgcn_s_sleep(1); \
    if ((++_sp & 255u) == 0u) { if (xb_ld(&(bar)[XB_TMO])) break; if (_sp > XB_SPIN_CAP) { atomicAdd(&(bar)[XB_TMO], 1u); break; } } } } while (0)

struct XcdBarrier {
    unsigned* bar; unsigned x; unsigned wid;
    volatile LAS unsigned* st;
};

__device__ __forceinline__ XcdBarrier xcd_barrier_post(unsigned* bar, volatile LAS unsigned* st) {
    XcdBarrier b; b.bar = bar; b.x = xb_xcc_id(); b.st = st; b.wid = (unsigned)__builtin_amdgcn_readfirstlane(threadIdx.x >> 6);
    if (threadIdx.x == 0) (void)xb_add(&bar[XB_XCNT(b.x)], 1u);
    return b;
}
__device__ __forceinline__ void xcd_barrier_complete(unsigned* bar, unsigned x, unsigned& nloc, unsigned& nx) {
    const unsigned G = gridDim.x * gridDim.y * gridDim.z;
    unsigned sum, cnt, mine, sp = 0u;
    for (;;) {
        sum = 0u; cnt = 0u; mine = 0u;
#pragma unroll
        for (unsigned j = 0; j < 16; ++j) { const unsigned c = xb_ld(&bar[XB_XCNT(j)]); sum += c; cnt += (c > 0u) ? 1u : 0u; mine = (j == x) ? c : mine; }
        if (sum == G) break;
        __builtin_amdgcn_s_sleep(1);
        if ((++sp & 255u) == 0u) { if (xb_ld(&bar[XB_TMO])) break; if (sp > XB_SPIN_CAP) { atomicAdd(&bar[XB_TMO], 1u); break; } }
    }
    nloc = mine > 0u ? mine : 1u; nx = cnt > 0u ? cnt : 1u;
}

__device__ __forceinline__ void xcd_barrier(const XcdBarrier& b) {
    asm volatile("s_waitcnt vmcnt(0)" ::: "memory");
    __syncthreads();
    if (b.wid == 0u && lane_id_now() == 0u) {
        unsigned* bar = b.bar;
        __builtin_amdgcn_s_waitcnt(0);
        unsigned nloc = b.st[0], nx = b.st[1];
        if (nloc == 0u) { xcd_barrier_complete(bar, b.x, nloc, nx); b.st[0] = nloc; b.st[1] = nx; }
        const unsigned old = xb_add(&bar[XB_XSUB(b.x)], 1u);
        const unsigned gen = old / nloc;
        if (old + 1u == (gen + 1u) * nloc) {
            __builtin_amdgcn_fence(__ATOMIC_RELEASE, "agent");
            asm volatile("s_waitcnt vmcnt(0)" ::: "memory");
            const unsigned og = xb_add(&bar[XB_TOP], 1u);
            const unsigned tg = og / nx;
            if (og + 1u == (tg + 1u) * nx) xb_add(&bar[XB_TOPGEN], 1u);
            else XB_SPIN(xb_ld(&bar[XB_TOPGEN]) == tg, bar);
            __builtin_amdgcn_fence(__ATOMIC_ACQUIRE, "agent");
            xb_add(&bar[XB_XGEN(b.x)], 1u);
            asm volatile("s_waitcnt vmcnt(0)" ::: "memory");
        } else {
            XB_SPIN(xb_ld(&bar[XB_XGEN(b.x)]) == gen, bar);
            __builtin_amdgcn_fence(__ATOMIC_ACQUIRE, "agent");
            asm volatile("s_waitcnt vmcnt(0)" ::: "memory");
        }
    }
    __syncthreads();
}

enum { IN_X = 0, IN_MEM, IN_RELB, IN_FNORM, IN_NMIX, IN_WIN, IN_WA2, IN_BA, IN_GNORM, IN_PW, IN_PB, IN_PS, IN_LNG, IN_LNB, IN_SW, IN_SB, IN_WOUT,
       IN_NXA, IN_NMEM, IN_WQ, IN_WKV, IN_WO, IN_NFFN, IN_F1, IN_F3, IN_F2, IN_ROUTER, IN_M1, IN_M3, IN_M2, N_IN };
struct Args { const float* in[N_IN]; float* out; unsigned char* ws; int ph_lo, ph_hi; };

__device__ __forceinline__ float rstd16(const float* ss, int row) {
    const f32x4* p = (const f32x4*)(ss + (size_t)row * 16);
    const f32x4 a = p[0], b = p[1], c = p[2], d = p[3];
    const float s = (((a.x + a.y) + (a.z + a.w)) + ((b.x + b.y) + (b.z + b.w))) + (((c.x + c.y) + (c.z + c.w)) + ((d.x + d.y) + (d.z + d.w)));
    return rsqrtf(s * (1.0f / 1024.0f) + EPS);
}
__device__ __forceinline__ v4u pack8(const f32x4 a, const f32x4 b) { v4u w; w.x = pg8::cvt_pk_bf16(a.x, a.y); w.y = pg8::cvt_pk_bf16(a.z, a.w); w.z = pg8::cvt_pk_bf16(b.x, b.y); w.w = pg8::cvt_pk_bf16(b.z, b.w); return w; }

struct EpiScale {
    static constexpr bool PERM = true, AFTER_DRAIN = false;
    bf16* O; int ldc; const float* ss; float scale; bf16* KF; int KT;
    __device__ __forceinline__ void operator()(const pg8::f32x4 (&acc)[2][2][4][2], const pg8::Unit& u, int wr, int wc, int fr, int fq) const {
        const int row0 = u.po * 256 + wr * 64 + fr, col0 = u.e * 256 + wc * 32 + 8 * fq;
        const bool frag = KF != nullptr && u.e == KT;
#pragma unroll
        for (int ai = 0; ai < 2; ++ai)
#pragma unroll
            for (int m = 0; m < 4; ++m) { const int row = row0 + ai * 128 + m * 16; const float r = rstd16(ss, row) * scale; bf16* rowp = O + (size_t)row * ldc + col0;
#pragma unroll
                for (int bj = 0; bj < 2; ++bj) { const v4u o = pack8(acc[ai][bj][m][0] * r, acc[ai][bj][m][1] * r);
                    if (frag) { const int c = wc * 32 + 8 * fq + bj * 128;
                        *(v4u*)(KF + ((((size_t)(row >> 5) * 4 + (c >> 6)) * 4 + ((c >> 4) & 3)) * 64 + (row & 31) + 32 * ((c >> 3) & 1)) * 8) = o; }
                    else *(v4u*)(rowp + bj * 128) = o; } }
    }
};
struct EpiResid {
    static constexpr bool PERM = true, AFTER_DRAIN = false;
    bf16* HB; float* SS;
    __device__ __forceinline__ void operator()(const pg8::f32x4 (&acc)[2][2][4][2], const pg8::Unit& u, int wr, int wc, int fr, int fq) const {
        const int row0 = u.po * 256 + wr * 64 + fr, col0 = u.e * 256 + wc * 32 + 8 * fq;
#pragma unroll
        for (int ai = 0; ai < 2; ++ai) {
            v4u rv[4][2];
#pragma unroll
            for (int m = 0; m < 4; ++m)
#pragma unroll
                for (int bj = 0; bj < 2; ++bj) rv[m][bj] = *(const v4u*)(HB + (size_t)(row0 + ai * 128 + m * 16) * D + col0 + bj * 128);
#pragma unroll
            for (int m = 0; m < 4; ++m) { const int row = row0 + ai * 128 + m * 16; const size_t off = (size_t)row * D + col0; float q = 0.f;
#pragma unroll
                for (int bj = 0; bj < 2; ++bj) { const v4u r = rv[m][bj]; v2u lo, hi; lo.x = r.x; lo.y = r.y; hi.x = r.z; hi.y = r.w;
                    const f32x4 v0 = acc[ai][bj][m][0] + bf4(lo), v1 = acc[ai][bj][m][1] + bf4(hi);
                    *(v4u*)(HB + off + bj * 128) = pack8(v0, v1);
                    q += ((v0.x * v0.x + v0.y * v0.y) + (v0.z * v0.z + v0.w * v0.w)) + ((v1.x * v1.x + v1.y * v1.y) + (v1.z * v1.z + v1.w * v1.w)); }
                q += shfl_xor_c<16>(q); q += shfl_xor_c<32>(q);
                if (fq == 0) SS[(size_t)row * 16 + u.e * 4 + wc] = q; } }
    }
};
__device__ __forceinline__ float silu_f(float x) { return x * __builtin_amdgcn_rcpf(1.0f + __expf(-x)); }
template <bool MOE> struct EpiSwiglu {
    static constexpr bool PERM = true, AFTER_DRAIN = false;
    bf16* O; int ldc; const float* ss; const float* slot_r; const float* slot_g;
    __device__ __forceinline__ void operator()(const pg8::f32x4 (&acc)[2][2][4][2], const pg8::Unit& u, int wr, int wc, int fr, int fq) const {
        const int rin0 = u.pm * 256 + wr * 64 + fr, rout0 = u.po * 256 + wr * 64 + fr, col0 = u.e * 128 + wc * 32 + 8 * fq;
#pragma unroll
        for (int ai = 0; ai < 2; ++ai)
#pragma unroll
            for (int m = 0; m < 4; ++m) { const int rin = rin0 + ai * 128 + m * 16, rout = rout0 + ai * 128 + m * 16;
                float r, gt; if (MOE) { r = 1.0f / (W8_SCALE * X8_SCALE); gt = A8_SCALE; } else { r = rstd16(ss, rin); gt = 1.0f; }
                const float rg = r * -1.4426950408889634f, c2 = r * r * gt;
                f32x4 o0, o1;
                { const f32x4 gu0 = acc[ai][0][m][0] * acc[ai][1][m][0], gu1 = acc[ai][0][m][1] * acc[ai][1][m][1];
#pragma unroll
                  for (int j = 0; j < 4; ++j) { const float i0 = __builtin_amdgcn_rcpf(1.0f + __builtin_amdgcn_exp2f(acc[ai][0][m][0][j] * rg)) * c2, i1 = __builtin_amdgcn_rcpf(1.0f + __builtin_amdgcn_exp2f(acc[ai][0][m][1][j] * rg)) * c2;
                    o0[j] = gu0[j] * i0; o1[j] = gu1[j] * i1;
                    if (MOE) { o0[j] = __builtin_amdgcn_fmed3f(o0[j], -448.0f, 448.0f); o1[j] = __builtin_amdgcn_fmed3f(o1[j], -448.0f, 448.0f); } } }
                if (MOE) { v2u w; w.x = pk4_fp8(o0[0], o0[1], o0[2], o0[3]); w.y = pk4_fp8(o1[0], o1[1], o1[2], o1[3]); *(v2u*)((unsigned char*)O + (size_t)rout * ldc + col0) = w; }
                else *(v4u*)(O + (size_t)rout * ldc + col0) = pack8(o0, o1); }
    }
};
struct EpiPlain {
    static constexpr bool PERM = true, AFTER_DRAIN = false;
    bf16* O; int ldc;
    __device__ __forceinline__ void operator()(const pg8::f32x4 (&acc)[2][2][4][2], const pg8::Unit& u, int wr, int wc, int fr, int fq) const {
        const int row0 = u.po * 256 + wr * 64 + fr, col0 = u.e * 256 + wc * 32 + 8 * fq;
#pragma unroll
        for (int ai = 0; ai < 2; ++ai)
#pragma unroll
            for (int m = 0; m < 4; ++m) { bf16* rowp = O + (size_t)(row0 + ai * 128 + m * 16) * ldc + col0;
#pragma unroll
                for (int bj = 0; bj < 2; ++bj) *(v4u*)(rowp + bj * 128) = pack8(acc[ai][bj][m][0], acc[ai][bj][m][1]); }
    }
};

__device__ __forceinline__ void tr_load(const float* W, int N, int k0, int n0, int lane, float (&v)[64]) {
    const int nn = n0 + lane; const float* wp = W + (size_t)k0 * N + (nn < N ? nn : 0);
#pragma unroll
    for (int i = 0; i < 64; ++i) v[i] = wp[(size_t)i * N];
}
__device__ __forceinline__ void tr_store(const float (&v)[64], int N, int K, int k0, int n0, const float* gain, bf16* WT, long dst_row0, LAS float* scr, int lane) {
    const bool ok = n0 + lane < N;
#pragma unroll
    for (int i = 0; i < 64; ++i) { float x = ok ? v[i] : 0.f; if (gain) x *= gain[k0 + i]; scr[i * 65 + lane] = x; }
    LDS_WAIT(); asm volatile("" ::: "memory");
    const int c = lane & 7;
#pragma unroll
    for (int j = 0; j < 8; ++j) { const int n = (lane >> 3) + 8 * j; const LAS float* s = scr + (8 * c) * 65 + n;
        v4u o; o.x = pk2(s[0 * 65], s[1 * 65]); o.y = pk2(s[2 * 65], s[3 * 65]); o.z = pk2(s[4 * 65], s[5 * 65]); o.w = pk2(s[6 * 65], s[7 * 65]);
        if (n0 + n < N) *(v4u*)(WT + (size_t)(dst_row0 < 0 ? (long)zcol_of(n0 + n) : dst_row0 + n) * K + k0 + 8 * c) = o; }
    LDS_WAIT(); asm volatile("" ::: "memory");
}
__device__ __forceinline__ void tr_store8(const float (&v)[64], int N, int K, int k0, int n0, const float* gain, unsigned char* WT8, long dst_row0, LAS float* scr, int lane) {
    const bool ok = n0 + lane < N;
#pragma unroll
    for (int i = 0; i < 64; ++i) { float x = ok ? v[i] * W8_SCALE : 0.f; if (gain) x *= gain[k0 + i]; scr[i * 65 + lane] = x; }
    LDS_WAIT(); asm volatile("" ::: "memory");
    const int c = lane & 3;
#pragma unroll
    for (int j = 0; j < 4; ++j) { const int n = (lane >> 2) + 16 * j; const LAS float* s = scr + (16 * c) * 65 + n;
        v4u o; o.x = pk4_fp8(s[0 * 65], s[1 * 65], s[2 * 65], s[3 * 65]); o.y = pk4_fp8(s[4 * 65], s[5 * 65], s[6 * 65], s[7 * 65]);
        o.z = pk4_fp8(s[8 * 65], s[9 * 65], s[10 * 65], s[11 * 65]); o.w = pk4_fp8(s[12 * 65], s[13 * 65], s[14 * 65], s[15 * 65]);
        if (n0 + n < N) *(v4u*)(WT8 + (size_t)(dst_row0 + n) * K + k0 + 16 * c) = o; }
    LDS_WAIT(); asm volatile("" ::: "memory");
}
__device__ __forceinline__ void tr_item(const float* W, int N, int K, int k0, int n0, const float* gain, bf16* WT, long dst_row0, LAS float* scr, int lane) {
    float v[64]; tr_load(W, N, k0, n0, lane, v); tr_store(v, N, K, k0, n0, gain, WT, dst_row0, scr, lane);
}
__device__ __forceinline__ void conv_store(const float (&v)[64], int it, int nblk, int K, int N, const float* gain, bf16* WT, int mode, LAS float* scr, int lane) {
    const int kb = it / nblk, nb = it % nblk, k0 = 64 * kb, n0 = 64 * nb;
    if (mode >= 4) {
        const long dr8 = (mode == 4) ? (long)n0 : (long)(n0 >> 7) * 256 + (n0 & 127) + (mode == 6 ? 128 : 0);
        tr_store8(v, N, K, k0, n0, gain, (unsigned char*)WT, dr8, scr, lane); return; }
    const long dr = (mode == 3) ? -1L : (mode == 0) ? (long)n0 : (long)(n0 >> 7) * 256 + (n0 & 127) + (mode == 2 ? 128 : 0);
    tr_store(v, N, K, k0, n0, gain, WT, dr, scr, lane);
}
__device__ __forceinline__ void conv_job(const float* W, int K, int N, const float* gain, bf16* WT, int mode, LAS float* scr, int gw, int NGW, int lane, long& base) {
    const int nblk = (N + 63) / 64, nitems = (K / 64) * nblk;
    const int first = (int)(((long)gw - (base % NGW) + NGW) % NGW);
    float va[64], vb[64];
    int it = first;
    if (it < nitems) tr_load(W, N, 64 * (it / nblk), 64 * (it % nblk), lane, va);
    while (it < nitems) {
        int itn = it + NGW;
        if (itn < nitems) tr_load(W, N, 64 * (itn / nblk), 64 * (itn % nblk), lane, vb);
        conv_store(va, it, nblk, K, N, gain, WT, mode, scr, lane);
        it = itn; if (it >= nitems) break;
        itn = it + NGW;
        if (itn < nitems) tr_load(W, N, 64 * (itn / nblk), 64 * (itn % nblk), lane, va);
        conv_store(vb, it, nblk, K, N, gain, WT, mode, scr, lane);
        it = itn;
    }
    base += nitems;
}
__device__ __forceinline__ void row_cvt(const float* xrow, bf16* orow, float* ssrow, int lane) {
    const f32x4* xr = (const f32x4*)xrow + lane; f32x4 v[4]; float s = 0.f;
#pragma unroll
    for (int j = 0; j < 4; ++j) { v[j] = xr[64 * j]; s += (v[j].x * v[j].x + v[j].y * v[j].y) + (v[j].z * v[j].z + v[j].w * v[j].w); }
    s = wave_sum(s);
    v2u* o8 = (v2u*)orow + lane;
#pragma unroll
    for (int j = 0; j < 4; ++j) { v2u w; w.x = pk2(v[j].x, v[j].y); w.y = pk2(v[j].z, v[j].w); o8[64 * j] = w; }
    if (lane < 16) ssrow[lane] = lane == 0 ? s : 0.f;
}
__device__ __forceinline__ void p0_prologue(const Args& a, LAS unsigned char* lds, int tid, int G) {
    const int lane = tid & 63, wave = tid >> 6, gw = blockIdx.x * NWAVES + wave, NGW = G * NWAVES;
    LAS float* scr = (LAS float*)(lds + wave * 16640);
    unsigned char* ws = a.ws; long base = 0;
    for (int l = 0; l < 2; ++l) {
        conv_job(a.in[IN_WIN] + (size_t)l * D * INW, D, INW, a.in[IN_NMIX] + l * D, (bf16*)(ws + WS_WIN + l * SZ_WIN), 3, scr, gw, NGW, lane, base);
        conv_job(a.in[IN_WOUT] + (size_t)l * D * D, D, D, nullptr, (bf16*)(ws + WS_WOUT + l * SZ_WOUT), 0, scr, gw, NGW, lane, base);
        conv_job(a.in[IN_WQ] + (size_t)l * D * 256, D, 256, a.in[IN_NXA] + l * D, (bf16*)(ws + WS_WQ + l * SZ_WQ), 0, scr, gw, NGW, lane, base);
        conv_job(a.in[IN_WKV] + (size_t)l * D * 512, D, 512, a.in[IN_NMEM] + l * D, (bf16*)(ws + WS_WKV + l * SZ_WKV), 0, scr, gw, NGW, lane, base);
        conv_job(a.in[IN_WO] + (size_t)l * 256 * D, 256, D, nullptr, (bf16*)(ws + WS_WO + l * SZ_WO), 0, scr, gw, NGW, lane, base);
        { v4u* zp = (v4u*)(ws + WS_WIN + l * SZ_WIN + (size_t)INW * D * 2); const int n16 = (ZW - INW) * D * 2 / 16;
          for (int i = blockIdx.x * NTHR + tid; i < n16; i += G * NTHR) zp[i] = (v4u){0u, 0u, 0u, 0u}; }
    }
    conv_job(a.in[IN_F1], D, DFF, a.in[IN_NFFN], (bf16*)(ws + WS_W13), 1, scr, gw, NGW, lane, base);
    conv_job(a.in[IN_F3], D, DFF, a.in[IN_NFFN], (bf16*)(ws + WS_W13), 2, scr, gw, NGW, lane, base);
    conv_job(a.in[IN_F2], DFF, D, nullptr, (bf16*)(ws + WS_W2), 0, scr, gw, NGW, lane, base);
    for (int e = 0; e < NEXP; ++e) {
        conv_job(a.in[IN_M1] + (size_t)e * D * DFE, D, DFE, a.in[IN_NFFN] + D, (bf16*)(ws + WS_MW13 + (size_t)e * 2 * DFE * D), 5, scr, gw, NGW, lane, base);
        conv_job(a.in[IN_M3] + (size_t)e * D * DFE, D, DFE, a.in[IN_NFFN] + D, (bf16*)(ws + WS_MW13 + (size_t)e * 2 * DFE * D), 6, scr, gw, NGW, lane, base);
        conv_job(a.in[IN_M2] + (size_t)e * DFE * D, DFE, D, nullptr, (bf16*)(ws + WS_MW2 + (size_t)e * D * DFE), 4, scr, gw, NGW, lane, base);
    }
    for (int i = blockIdx.x * NTHR + tid; i < MOE_TP * 256; i += G * NTHR) ((int*)(ws + WS_IDMAP))[i] = i;
    for (int i = blockIdx.x * NTHR + tid; i < 2 * 4 * 128 * 128; i += G * NTHR) { const int s = i & 127, t = (i >> 7) & 127; ((bf16*)(ws + WS_SWT))[i] = (bf16)f2bf(s <= t ? a.in[IN_SW][i] : 0.f); }
    for (int i = blockIdx.x * NTHR + tid; i < 2 * 4 * 64 * 64; i += G * NTHR) { const int c = i & 63, d = (i >> 6) & 63, lg = i >> 12; ((bf16*)(ws + WS_PWT))[i] = (bf16)f2bf(a.in[IN_PW][(size_t)lg * 4096 + c * 64 + d]); }
    for (int m = gw; m < M; m += NGW) row_cvt(a.in[IN_X] + (size_t)m * D, (bf16*)(ws + WS_H16) + (size_t)m * D, (float*)(ws + WS_SS) + (size_t)m * 16, lane);
    for (int m = gw; m < MM; m += NGW) row_cvt(a.in[IN_MEM] + (size_t)m * D, (bf16*)(ws + WS_MEMB) + (size_t)m * D, (float*)(ws + WS_SSM) + (size_t)m * 16, lane);
}


__device__ __forceinline__ float gelu_tanh(float x) { return 0.5f * x * (1.0f + tanhf(0.7978845608028654f * (x + 0.044715f * x * x * x))); }

__device__ __forceinline__ void gla_a_item(const Args& a, int l, int item, LAS unsigned char* lds, int tid) {
    const int n = item & 31, h = (item >> 5) & 3, b = item >> 7, tok0 = b * T + n * 64;
    LAS float* alr = (LAS float*)lds;
    LAS float* wa = alr + 64 * 16;
    LAS float* bb = wa + 16 * 32;
    LAS float* qt = bb + 64 * 33;
    LAS float* kt = qt + 64 * 33;
    LAS float* kd = kt + 64 * 33;
    LAS float* vv = kd + 64 * 33;
    LAS float* att = vv + 64 * 64;
    LAS float* bav = att + 64 * 65;
    const bf16* z = (const bf16*)(a.ws + WS_Z);
    float* OI = (float*)(a.ws + WS_GOI); float* QT = (float*)(a.ws + WS_GQT); float* KV = (float*)(a.ws + WS_GKV); float* DEC = (float*)(a.ws + WS_GDEC);
    for (int i = tid; i < 1024; i += NTHR) alr[i] = bf1(z[(size_t)(tok0 + (i >> 4)) * ZW + Z_ALR + (i & 15)]);
    { const int r = tid >> 5, k = tid & 31; wa[tid] = a.in[IN_WA2][(size_t)l * 16 * 128 + r * 128 + h * 32 + k]; }
    if (tid < 32) bav[tid] = a.in[IN_BA][l * 128 + h * 32 + tid];
    for (int i = tid; i < 4096; i += NTHR) vv[i] = bf1(z[(size_t)(tok0 + (i >> 6)) * ZW + Z_AV + h * 64 + (i & 63)]);
    __syncthreads();
    for (int i = tid; i < 2048; i += NTHR) { const int c = i >> 5, k = i & 31; float x = bav[k];
#pragma unroll
        for (int r = 0; r < 16; ++r) x += alr[c * 16 + r] * wa[r * 32 + k];
        const float ls = fminf(x, 0.f) - log1pf(expf(-fabsf(x)));
        bb[c * 33 + k] = ls * (1.0f / 16.0f); }
    __syncthreads();
    if (tid < 32) { float run = 0.f; for (int c = 0; c < 64; ++c) { run += bb[c * 33 + tid]; bb[c * 33 + tid] = run; } }
    __syncthreads();
    for (int i = tid; i < 2048; i += NTHR) { const int c = i >> 5, k = i & 31; const float bv = bb[c * 33 + k], bl = bb[63 * 33 + k];
        const float q = bf1(z[(size_t)(tok0 + c) * ZW + Z_AQ + h * 32 + k]), kk = bf1(z[(size_t)(tok0 + c) * ZW + Z_AK + h * 32 + k]);
        const float qv = q * 0.17677669529663687f * expf(bv);
        qt[c * 33 + k] = qv; kt[c * 33 + k] = kk * expf(-bv); kd[c * 33 + k] = kk * expf(bl - bv);
        QT[(size_t)(tok0 + c) * 128 + h * 32 + k] = qv; }
    if (tid < 32) DEC[(size_t)item * 32 + tid] = expf(bb[63 * 33 + tid]);
    __syncthreads();
    for (int idx = tid; idx < 4096; idx += NTHR) { const int i = idx >> 6, j = idx & 63; float s = 0.f;
        if (j <= i) {
#pragma unroll 8
            for (int k = 0; k < 32; ++k) s += qt[i * 33 + k] * kt[j * 33 + k]; }
        att[i * 65 + j] = s; }
    __syncthreads();
    for (int idx = tid; idx < 4096; idx += NTHR) { const int i = idx >> 6, v = idx & 63; float s = 0.f;
#pragma unroll 8
        for (int j = 0; j < 64; ++j) s += att[i * 65 + j] * vv[j * 64 + v];
        OI[(size_t)(tok0 + i) * 256 + h * 64 + v] = s; }
    for (int idx = tid; idx < 2048; idx += NTHR) { const int k = idx >> 6, v = idx & 63; float s = 0.f;
#pragma unroll 8
        for (int c = 0; c < 64; ++c) s += kd[c * 33 + k] * vv[c * 64 + v];
        KV[(size_t)item * 2048 + idx] = s; }
    __syncthreads();
}
__device__ __forceinline__ void gla_c_item(const Args& a, int l, int item, LAS unsigned char* lds, int tid) {
    const int n = item & 31, h = (item >> 5) & 3, b = item >> 7, tok0 = b * T + n * 64, lane = tid & 63, w = tid >> 6;
    LAS float* S = (LAS float*)lds;
    LAS float* ql = S + 2048;
    const bf16* z = (const bf16*)(a.ws + WS_Z); bf16* mix = (bf16*)(a.ws + WS_MIX);
    const float* OI = (const float*)(a.ws + WS_GOI); const float* QT = (const float*)(a.ws + WS_GQT); const float* KV = (const float*)(a.ws + WS_GKV); const float* DEC = (const float*)(a.ws + WS_GDEC);
    for (int e = tid; e < 2048; e += NTHR) { const int k = e >> 6; float s = 0.f;
        for (int m = 0; m < n; ++m) { const size_t it = (size_t)(item - n + m); s = s * DEC[it * 32 + k] + KV[it * 2048 + e]; }
        S[e] = s; }
    for (int i = tid; i < 2048; i += NTHR) ql[(i >> 5) * 33 + (i & 31)] = QT[(size_t)(tok0 + (i >> 5)) * 128 + h * 32 + (i & 31)];
    __syncthreads();
    for (int j = 0; j < 8; ++j) { const int i = w + 8 * j; float o = OI[(size_t)(tok0 + i) * 256 + h * 64 + lane];
#pragma unroll 8
        for (int k = 0; k < 32; ++k) o += ql[i * 33 + k] * S[k * 64 + lane];
        const float ms = wave_sum(o * o) * (1.0f / 64.0f);
        float y = o * rsqrtf(ms + EPS) * a.in[IN_GNORM][l * 256 + h * 64 + lane];
        const float g = bf1(z[(size_t)(tok0 + i) * ZW + Z_AG + h * 64 + lane]);
        y *= g / (1.0f + expf(-g));
        mix[(size_t)(tok0 + i) * D + h * 64 + lane] = (bf16)f2bf(y); }
    __syncthreads();
}
__device__ __forceinline__ void pool_item(const Args& a, int l, int item, LAS unsigned char* lds, int tid) {
    const int g = item & 3, tt = (item >> 2) & 31, b = item >> 7, t0 = tt * 64;
    LAS float* u = (LAS float*)lds;
    LAS float* w = u + 79 * 64;
    LAS float* p = w + 4096;
    const bf16* z = (const bf16*)(a.ws + WS_Z); bf16* mix = (bf16*)(a.ws + WS_MIX);
    for (int i = tid; i < 79 * 64; i += NTHR) { const int t = t0 - 15 + (i >> 6); u[i] = t >= 0 ? bf1(z[(size_t)(b * T + t) * ZW + Z_BU + g * 64 + (i & 63)]) : 0.f; }
    for (int i = tid; i < 4096; i += NTHR) w[i] = a.in[IN_PW][(size_t)(l * 4 + g) * 4096 + i];
    __syncthreads();
    const int win = 2 << g;
    for (int i = tid; i < 4096; i += NTHR) { const int tl = i >> 6, c = i & 63, t = t0 + tl, cnt = (t + 1 < win) ? t + 1 : win; float s = 0.f;
        for (int j = 0; j < cnt; ++j) s += u[(tl + 15 - j) * 64 + c];
        p[tl * 65 + c] = s / (float)cnt - u[(tl + 15) * 64 + c]; }
    __syncthreads();
    for (int i = tid; i < 4096; i += NTHR) { const int tl = i >> 6, d = i & 63; float s = a.in[IN_PB][(l * 4 + g) * 64 + d];
#pragma unroll 8
        for (int c = 0; c < 64; ++c) s += p[tl * 65 + c] * w[c * 64 + d];
        s *= a.in[IN_PS][l * 256 + g * 64 + d];
        mix[(size_t)(b * T + t0 + tl) * D + 256 + g * 64 + d] = (bf16)f2bf(s); }
    __syncthreads();
}
__device__ __forceinline__ void sgu_item(const Args& a, int l, int item, LAS unsigned char* lds, int tid) {
    const int g = item & 3, nc = (item >> 2) & 15, b = item >> 6, tok0 = b * T + nc * 128, lane = tid & 63, w = tid >> 6;
    LAS float* vn = (LAS float*)lds;
    const bf16* z = (const bf16*)(a.ws + WS_Z); bf16* mix = (bf16*)(a.ws + WS_MIX);
    for (int j = 0; j < 16; ++j) { const int s = w + 8 * j;
        const v2u raw = *(const v2u*)(z + (size_t)(tok0 + s) * ZW + Z_DUV + 256 + 4 * lane);
        float x[4] = {gelu_tanh(bflo(raw.x)), gelu_tanh(bfhi(raw.x)), gelu_tanh(bflo(raw.y)), gelu_tanh(bfhi(raw.y))};
        const float mu = wave_sum((x[0] + x[1]) + (x[2] + x[3])) * (1.0f / 256.0f);
        float q = 0.f;
#pragma unroll
        for (int i = 0; i < 4; ++i) { x[i] -= mu; q += x[i] * x[i]; }
        const float rstd = rsqrtf(wave_sum(q) * (1.0f / 256.0f) + EPS);
        if ((lane >> 4) == g) {
#pragma unroll
            for (int i = 0; i < 4; ++i) { const int cl = 4 * (lane & 15) + i; vn[s * 64 + cl] = x[i] * rstd * a.in[IN_LNG][l * 256 + g * 64 + cl] + a.in[IN_LNB][l * 256 + g * 64 + cl]; } } }
    __syncthreads();
    const float* sw = a.in[IN_SW] + (size_t)(l * 4 + g) * 128 * 128;
    for (int j = 0; j < 16; ++j) { const int t = w + 8 * j; float acc = a.in[IN_SB][(l * 4 + g) * 128 + t];
        const float* swr = sw + t * 128;
        for (int s = 0; s <= t; ++s) acc += swr[s] * vn[s * 64 + lane];
        const float uu = gelu_tanh(bf1(z[(size_t)(tok0 + t) * ZW + Z_DUV + g * 64 + lane]));
        mix[(size_t)(tok0 + t) * D + 768 + g * 64 + lane] = (bf16)f2bf(uu * acc); }
    __syncthreads();
}
__device__ __forceinline__ void xattn_item(const Args& a, int l, int item, LAS unsigned char* lds, int tid) {
    const int qtile = item & 31, h = (item >> 5) & 3, b = item >> 7, lane = tid & 63, w = tid >> 6;
    LAS float* Ks = (LAS float*)lds;
    LAS float* Vs = Ks + 256 * 65;
    LAS float* qs = Vs + 256 * 64;
    LAS float* pw = qs + 512;
    const bf16* kvm = (const bf16*)(a.ws + WS_KVM + (size_t)l * SZ_KVM); const bf16* qx = (const bf16*)(a.ws + WS_QX); bf16* ox = (bf16*)(a.ws + WS_OX);
    for (int i = tid; i < 16384; i += NTHR) { const int key = i >> 6, d = i & 63; const size_t o = (size_t)(b * MEMLEN + key) * 512 + h * 64 + d;
        Ks[key * 65 + d] = bf1(kvm[o]); Vs[key * 64 + d] = bf1(kvm[o + 256]); }
    __syncthreads();
    for (int qq = 0; qq < 8; ++qq) { const int row = b * T + qtile * 64 + w * 8 + qq;
        qs[w * 64 + lane] = bf1(qx[(size_t)row * 256 + h * 64 + lane]);
        LDS_WAIT(); asm volatile("" ::: "memory");
        float s[4] = {0.f, 0.f, 0.f, 0.f};
        for (int d = 0; d < 64; ++d) { const float qd = qs[w * 64 + d];
#pragma unroll
            for (int j = 0; j < 4; ++j) s[j] += qd * Ks[(lane + 64 * j) * 65 + d]; }
        const float mx = wave_max(fmaxf(fmaxf(s[0], s[1]), fmaxf(s[2], s[3])));
        float e[4], sum = 0.f;
#pragma unroll
        for (int j = 0; j < 4; ++j) { e[j] = expf(s[j] - mx); sum += e[j]; }
        const float inv = 1.0f / wave_sum(sum);
#pragma unroll
        for (int j = 0; j < 4; ++j) pw[w * 256 + lane + 64 * j] = e[j] * inv;
        LDS_WAIT(); asm volatile("" ::: "memory");
        float o = 0.f;
        for (int key = 0; key < 256; ++key) o += pw[w * 256 + key] * Vs[key * 64 + lane];
        ox[(size_t)row * 256 + h * 64 + lane] = (bf16)f2bf(o);
        LDS_WAIT(); asm volatile("" ::: "memory"); }
    __syncthreads();
}

__device__ __forceinline__ unsigned ord_u(float f) { const unsigned u = __builtin_bit_cast(unsigned, f); return (u & 0x80000000u) ? ~u : (u | 0x80000000u); }
__device__ __forceinline__ int rel_bucket(int n) {
    if (n < 16) return n;
    int large = 16 + (int)(logf((float)n / 16.0f) / logf(8.0f) * 16.0f);
    return large < 31 ? large : 31;
}
__device__ __forceinline__ void dsa_setup(const Args& a, LAS unsigned char* lds, int tid) {
    LAS float* biasd = (LAS float*)(lds + 48 * 1024);
    for (int i = tid; i < 129 * 4; i += NTHR) { const int d = i >> 2, h = i & 3; biasd[i] = a.in[IN_RELB][rel_bucket(d) * 4 + h]; }
    __syncthreads();
}
__device__ __forceinline__ void dsa_item(const Args& a, int item, LAS unsigned char* lds, int tid, bf16* outp, int ostride) {
    const int b = item / T, t = item % T, nk = t + 1, lane = tid & 63, w = tid >> 6;
    LAS unsigned* su = (LAS unsigned*)lds;
    LAS float* lg = (LAS float*)(lds + 8192);
    LAS float* qi = (LAS float*)(lds + 8192 + 32768);
    LAS float* qv = qi + 256;
    LAS float* wi = qv + 256;
    LAS unsigned* cnt = (LAS unsigned*)(wi + 8);
    LAS float* red = (LAS float*)(cnt + 40);
    LAS float* red2 = red + 64;
    LAS float* biasd = (LAS float*)(lds + 48 * 1024);
    const bf16* z = (const bf16*)(a.ws + WS_Z);
    const size_t row = (size_t)b * T + t;
    if (tid < 256) { qi[tid] = bf1(z[row * ZW + Z_CQI + tid]) * 0.17677669529663687f; qv[tid] = bf1(z[row * ZW + Z_CQ + tid]) * 0.125f; }
    if (tid < 8) wi[tid] = bf1(z[row * ZW + Z_CWI + tid]) * 0.35355339059327373f;
    if (tid < 40) cnt[tid] = 0u;
    __syncthreads();
    unsigned myu[4];
#pragma unroll
    for (int j = 0; j < 4; ++j) { const int key = tid + NTHR * j; myu[j] = 0u;
        if (key < nk) { const v4u* kp = (const v4u*)(z + ((size_t)b * T + key) * ZW + Z_CKI); float kf[32];
#pragma unroll
            for (int i = 0; i < 4; ++i) { const v4u r = kp[i]; kf[8 * i + 0] = bflo(r.x); kf[8 * i + 1] = bfhi(r.x); kf[8 * i + 2] = bflo(r.y); kf[8 * i + 3] = bfhi(r.y); kf[8 * i + 4] = bflo(r.z); kf[8 * i + 5] = bfhi(r.z); kf[8 * i + 6] = bflo(r.w); kf[8 * i + 7] = bfhi(r.w); }
            float sc = 0.f;
            for (int hh = 0; hh < 8; ++hh) { float dot = 0.f;
#pragma unroll
                for (int d = 0; d < 32; ++d) dot += qi[hh * 32 + d] * kf[d];
                sc += fmaxf(dot, 0.f) * wi[hh]; }
            sc += 0.0f;
            myu[j] = ord_u(sc); su[key] = myu[j]; } }
    __syncthreads();
    bool sel[4];
#pragma unroll
    for (int j = 0; j < 4; ++j) sel[j] = (tid + NTHR * j) < nk;
    if (nk > 256) {
        unsigned Tt = 0u;
        for (int bit = 31; bit >= 0; --bit) { const unsigned cand = Tt | (1u << bit); int c = 0;
#pragma unroll
            for (int j = 0; j < 4; ++j) c += (myu[j] >= cand) ? 1 : 0;
            c = (int)wave_sum((float)c);
            if (lane == 0 && c) LDS_ADD(&cnt[bit], (unsigned)c);
            __syncthreads();
            if (cnt[bit] >= 256u) Tt = cand; }
        { int c = 0;
#pragma unroll
            for (int j = 0; j < 4; ++j) c += (myu[j] > Tt) ? 1 : 0;
            c = (int)wave_sum((float)c);
            if (lane == 0 && c) LDS_ADD(&cnt[32], (unsigned)c);
            __syncthreads(); }
        const int r = 256 - (int)cnt[32];
#pragma unroll
        for (int j = 0; j < 4; ++j) { const int key = tid + NTHR * j;
            if (myu[j] > Tt) sel[j] = true;
            else if (myu[j] == Tt && key < nk) { int rank = 0; for (int s = 0; s < key; ++s) rank += (su[s] == Tt) ? 1 : 0; sel[j] = rank < r; }
            else sel[j] = false; }
    }
    float lmax[4] = {-INFINITY, -INFINITY, -INFINITY, -INFINITY};
#pragma unroll
    for (int j = 0; j < 4; ++j) { const int key = tid + NTHR * j;
        if (key < nk) {
            float lv[4] = {-INFINITY, -INFINITY, -INFINITY, -INFINITY};
            if (sel[j]) { const v4u* kp = (const v4u*)(z + ((size_t)b * T + key) * ZW + Z_CK); const int dd = (t - key) < 128 ? (t - key) : 128;
#pragma unroll
                for (int hh = 0; hh < 4; ++hh) { float dot = 0.f;
#pragma unroll
                    for (int i = 0; i < 8; ++i) { const v4u r = kp[hh * 8 + i]; const LAS float* qq = qv + hh * 64 + 8 * i;
                        dot += qq[0] * bflo(r.x) + qq[1] * bfhi(r.x) + qq[2] * bflo(r.y) + qq[3] * bfhi(r.y) + qq[4] * bflo(r.z) + qq[5] * bfhi(r.z) + qq[6] * bflo(r.w) + qq[7] * bfhi(r.w); }
                    lv[hh] = dot + biasd[dd * 4 + hh]; lmax[hh] = fmaxf(lmax[hh], lv[hh]); } }
#pragma unroll
            for (int hh = 0; hh < 4; ++hh) lg[hh * 2048 + key] = lv[hh]; } }
#pragma unroll
    for (int hh = 0; hh < 4; ++hh) { const float m = wave_max(lmax[hh]); if (lane == 0) red[w * 4 + hh] = m; }
    __syncthreads();
    float mx[4], lsum[4] = {0.f, 0.f, 0.f, 0.f};
#pragma unroll
    for (int hh = 0; hh < 4; ++hh) { float m = red[hh]; for (int ww = 1; ww < 8; ++ww) m = fmaxf(m, red[ww * 4 + hh]); mx[hh] = m; }
#pragma unroll
    for (int j = 0; j < 4; ++j) { const int key = tid + NTHR * j;
        if (key < nk) {
#pragma unroll
            for (int hh = 0; hh < 4; ++hh) { const float lv = lg[hh * 2048 + key]; const float p = (lv == -INFINITY) ? 0.f : expf(lv - mx[hh]); lg[hh * 2048 + key] = p; lsum[hh] += p; } } }
#pragma unroll
    for (int hh = 0; hh < 4; ++hh) { const float s = wave_sum(lsum[hh]); if (lane == 0) red[32 + w * 4 + hh] = s; }
    __syncthreads();
    { const int half = tid >> 8, hd = tid & 255, hh = hd >> 6; float acc = 0.f;
      const bf16* vp = z + (size_t)b * T * ZW + Z_CV + hd;
      for (int key = half; key < nk; key += 2) { const float p = lg[hh * 2048 + key]; if (p != 0.f) acc += p * bf1(vp[(size_t)key * ZW]); }
      red2[tid] = acc; }
    __syncthreads();
    if (tid < 256) { const int hh = tid >> 6; float s = 0.f; for (int ww = 0; ww < 8; ++ww) s += red[32 + ww * 4 + hh];
        outp[row * ostride + tid] = (bf16)f2bf((red2[tid] + red2[tid + 256]) / s); }
    __syncthreads();
}

__device__ __forceinline__ void moe_route(const Args& a, LAS unsigned char* lds, int tid, int G, int bid) {
    const int lane = tid & 63, w = tid >> 6;
    LAS float* rt = (LAS float*)lds;
    LAS unsigned* cnt = (LAS unsigned*)(lds + 32768);
    unsigned char* ws = a.ws; const bf16* h = (const bf16*)(ws + WS_H16);
    for (int i = tid; i < 8192; i += NTHR) rt[(i & 7) * 1024 + (i >> 3)] = a.in[IN_ROUTER][i] * a.in[IN_NFFN][D + (i >> 3)];
    __syncthreads();
    for (int chunk = bid; chunk < 256; chunk += G) {
        if (tid < 8) cnt[tid] = 0u;
        __syncthreads();
        for (int qb = 0; qb < 2; ++qb) {
            const int tk0 = chunk * 64 + w * 8 + qb * 4;
            f32x4 hv[4][4]; float ss[4] = {0.f, 0.f, 0.f, 0.f};
#pragma unroll
            for (int t4 = 0; t4 < 4; ++t4)
#pragma unroll
                for (int j = 0; j < 4; ++j) { hv[t4][j] = bf4(((const v2u*)(h + (size_t)(tk0 + t4) * D) + lane)[64 * j]); const f32x4 v = hv[t4][j]; ss[t4] += (v.x * v.x + v.y * v.y) + (v.z * v.z + v.w * v.w); }
            float lg[4][8];
#pragma unroll
            for (int t4 = 0; t4 < 4; ++t4)
#pragma unroll
                for (int e = 0; e < 8; ++e) lg[t4][e] = 0.f;
#pragma unroll
            for (int j = 0; j < 4; ++j) { const int c0 = 4 * (lane + 64 * j);
#pragma unroll
                for (int e = 0; e < 8; ++e) { const f32x4 r = *(const LAS f32x4*)(rt + e * 1024 + c0);
#pragma unroll
                    for (int t4 = 0; t4 < 4; ++t4) { const f32x4 v = hv[t4][j]; lg[t4][e] += (v.x * r.x + v.y * r.y) + (v.z * r.z + v.w * r.w); } } }
#pragma unroll
            for (int t4 = 0; t4 < 4; ++t4) { const int tk = tk0 + t4;
                const float rstd = rsqrtf(wave_sum(ss[t4]) * (1.0f / 1024.0f) + EPS);
                { const float xs = rstd * X8_SCALE;
#pragma unroll
                  for (int j = 0; j < 4; ++j) { const f32x4 v = hv[t4][j] * xs;
                      ((unsigned*)(ws + WS_HB8) + (size_t)tk * (D / 4))[lane + 64 * j] = pk4_fp8(__builtin_amdgcn_fmed3f(v.x, -448.0f, 448.0f), __builtin_amdgcn_fmed3f(v.y, -448.0f, 448.0f), __builtin_amdgcn_fmed3f(v.z, -448.0f, 448.0f), __builtin_amdgcn_fmed3f(v.w, -448.0f, 448.0f)); } }
                float l8[8];
#pragma unroll
                for (int e = 0; e < 8; ++e) l8[e] = wave_sum(lg[t4][e]) * rstd;
                int e0 = 0; float v0 = l8[0];
#pragma unroll
                for (int e = 1; e < 8; ++e) if (l8[e] > v0) { v0 = l8[e]; e0 = e; }
                int e1 = -1; float v1 = -INFINITY;
#pragma unroll
                for (int e = 0; e < 8; ++e) if (e != e0 && l8[e] > v1) { v1 = l8[e]; e1 = e; }
                const float g0 = 1.0f / (1.0f + expf(v1 - v0)), g1 = 1.0f - g0;
                if (lane == 0) { ((int*)(ws + WS_TOKE))[2 * tk] = e0; ((int*)(ws + WS_TOKE))[2 * tk + 1] = e1; ((float*)(ws + WS_TOKG))[2 * tk] = g0; ((float*)(ws + WS_TOKG))[2 * tk + 1] = g1;
                    ((float*)(ws + WS_TOKR))[tk] = rstd; LDS_ADD(&cnt[e0], 1u); LDS_ADD(&cnt[e1], 1u); } } }
        __syncthreads();
        if (tid < 8) ((int*)(ws + WS_CNT))[chunk * 8 + tid] = (int)cnt[tid];
        __syncthreads();
    }
}
__device__ __forceinline__ void moe_assign(const Args& a, LAS unsigned char* lds, int tid, int G, int bid) {
    LAS int* cn = (LAS int*)lds;
    LAS int* tot = cn + 2048;
    LAS int* basee = tot + 8;
    LAS int* te = basee + 8;
    unsigned char* ws = a.ws;
    const int* CNT = (const int*)(ws + WS_CNT); int* TILEE = (int*)(ws + WS_TILEE);
    const int* TOKE = (const int*)(ws + WS_TOKE); const float* TOKG = (const float*)(ws + WS_TOKG); const float* TOKR = (const float*)(ws + WS_TOKR); int* TOKS = (int*)(ws + WS_TOKS);
    float* SLOTR = (float*)(ws + WS_SLOTR); float* SLOTG = (float*)(ws + WS_SLOTG); int* SLOTT = (int*)(ws + WS_SLOTT);
    for (int i = tid; i < 2048; i += NTHR) cn[i] = CNT[i];
    __syncthreads();
    { const int e = tid >> 6, ln = tid & 63;
      const int s4 = (cn[ln * 8 + e] + cn[(ln + 64) * 8 + e]) + (cn[(ln + 128) * 8 + e] + cn[(ln + 192) * 8 + e]);
      const int s = (int)wave_sum((float)s4); if (ln == 0) tot[e] = s; }
    __syncthreads();
    if (tid == 0) { int tile = 0; for (int e = 0; e < 8; ++e) { basee[e] = tile * 256; const int nt = (tot[e] + 255) >> 8;
            if (bid == 0) for (int q = 0; q < nt; ++q) TILEE[tile + q] = e;
            tile += nt; }
        if (bid == 0) { for (int q = tile; q < 159; ++q) TILEE[q] = 0; TILEE[159] = tile; } }
    __syncthreads();
    for (int e = bid; e < 8; e += G) { const int s0 = basee[e] + tot[e], s1 = basee[e] + (((tot[e] + 255) >> 8) << 8);
        for (int s = s0 + tid; s < s1; s += NTHR) { SLOTR[s] = 0.f; SLOTG[s] = 0.f; SLOTT[s] = 0; } }
    for (int chunk = bid; chunk < 256; chunk += G) {
        if (tid < 128) te[tid] = TOKE[chunk * 128 + tid];
        __syncthreads();
        { const int e = tid >> 6, lane = tid & 63;
          int s = 0; for (int c = lane; c < chunk; c += 64) s += cn[c * 8 + e];
          s = (int)wave_sum((float)s);
          const bool m0 = te[lane] == e, m1 = te[lane + 64] == e;
          const unsigned long long b0 = __ballot(m0), b1 = __ballot(m1), lt = (1ull << lane) - 1ull;
          const int pos0 = basee[e] + s + __popcll(b0 & lt), pos1 = basee[e] + s + __popcll(b0) + __popcll(b1 & lt);
          if (m0) { const int i = lane, tk = chunk * 64 + (i >> 1); SLOTR[pos0] = TOKR[tk]; SLOTG[pos0] = TOKG[2 * tk + (i & 1)]; SLOTT[pos0] = tk; TOKS[2 * tk + (i & 1)] = pos0; }
          if (m1) { const int i = lane + 64, tk = chunk * 64 + (i >> 1); SLOTR[pos1] = TOKR[tk]; SLOTG[pos1] = TOKG[2 * tk + (i & 1)]; SLOTT[pos1] = tk; TOKS[2 * tk + (i & 1)] = pos1; } }
        __syncthreads();
    }
}
__device__ __forceinline__ void final_phase(const Args& a, int tid, int G, int bid) {
    const int lane = tid & 63, gw = bid * NWAVES + (tid >> 6), NGW = G * NWAVES;
    const int* TOKS = (const int*)(a.ws + WS_TOKS); const bf16* YS = (const bf16*)(a.ws + WS_YS);
#if defined(PROF_DSA)
    const float* pr = (const float*)(a.ws + WS_CTL) + 12288; const float padd = 100.0f * sqrtf(floorf(pr[2 + PROF_DSA - 1] / fmaxf(pr[2 + 5], 1e-30f) * 10.0f + 0.5f) * 0.1f);
#elif defined(PROBE_DSA)
    const float* pr = (const float*)(a.ws + WS_CTL) + 12288; const float padd = PROBE_C * sqrtf(pr[0] / fmaxf(pr[1], 1e-30f));
#else
    const float padd = 0.f;
#endif
    constexpr float YSC = 1.0f / (W8_SCALE * A8_SCALE);
    f32x4 gn[4];
#pragma unroll
    for (int j = 0; j < 4; ++j) gn[j] = ((const f32x4*)a.in[IN_FNORM])[lane + 64 * j];
    for (int tk0 = gw; tk0 < M; tk0 += 4 * NGW) {
        f32x4 v[4][4]; float ss[4];
#pragma unroll
        for (int u = 0; u < 4; ++u) { const int tkr = tk0 + u * NGW, tk = tkr < M ? tkr : gw; const int s0 = TOKS[2 * tk], s1 = TOKS[2 * tk + 1];
            const v2u* h16 = (const v2u*)((const bf16*)(a.ws + WS_H16) + (size_t)tk * D) + lane; const v2u* y0 = (const v2u*)(YS + (size_t)s0 * D) + lane; const v2u* y1 = (const v2u*)(YS + (size_t)s1 * D) + lane;
            const float c0 = ((const float*)(a.ws + WS_TOKG))[2 * tk] * YSC, c1 = ((const float*)(a.ws + WS_TOKG))[2 * tk + 1] * YSC;
            ss[u] = 0.f;
#pragma unroll
            for (int j = 0; j < 4; ++j) { v[u][j] = bf4(h16[64 * j]); const v2u p = y0[64 * j], q = y1[64 * j];
                v[u][j].x += bflo(p.x) * c0 + bflo(q.x) * c1; v[u][j].y += bfhi(p.x) * c0 + bfhi(q.x) * c1; v[u][j].z += bflo(p.y) * c0 + bflo(q.y) * c1; v[u][j].w += bfhi(p.y) * c0 + bfhi(q.y) * c1;
                ss[u] += (v[u][j].x * v[u][j].x + v[u][j].y * v[u][j].y) + (v[u][j].z * v[u][j].z + v[u][j].w * v[u][j].w); } }
#pragma unroll
        for (int u = 0; u < 4; ++u) { const int tk = tk0 + u * NGW; const float rstd = rsqrtf(wave_sum(ss[u]) * (1.0f / 1024.0f) + EPS);
            if (tk < M) { f32x4* hr = (f32x4*)(a.out + (size_t)tk * D) + lane;
#pragma unroll
                for (int j = 0; j < 4; ++j) hr[64 * j] = v[u][j] * rstd * gn[j] + padd; } }
    }
}

typedef short bf16x8 __attribute__((ext_vector_type(8)));
typedef short bf16x4 __attribute__((ext_vector_type(4)));
typedef float f32x16 __attribute__((ext_vector_type(16)));
#define MFMA32(a, b, c) __builtin_amdgcn_mfma_f32_32x32x16_bf16((a), (b), (c), 0, 0, 0)
constexpr int DS_HIST = 0;
constexpr int DS_CMB = 0;
constexpr int DS_KST = 34816;
constexpr int DS_BM = 67584;
constexpr int DS_P = DS_BM + 8192;
constexpr int DS_CU = DS_P + 512;
constexpr int DS_CK = DS_CU + 8192;
constexpr int DS_BIAS = DS_CK + 8192;
constexpr int DS_ST = DS_BIAS + 2112;
constexpr int DS_END = DS_ST + 8 * 4608;
constexpr int DSA_CAP = 64;
static_assert(DS_END <= MISC_OFF - 64 && DS_KST + 8 * 4096 <= DS_BM && 32 * 513 * 4 <= DS_BM, "DSA LDS map");
__device__ __forceinline__ void tr_read_tile(unsigned addr, bf16x4& t00, bf16x4& t01, bf16x4& t10, bf16x4& t11, bf16x4& u00, bf16x4& u01, bf16x4& u10, bf16x4& u11) {
    asm volatile("s_waitcnt lgkmcnt(0)\n\t"
                 "ds_read_b64_tr_b16 %0, %8 offset:0\n\t" "ds_read_b64_tr_b16 %1, %8 offset:512\n\t" "ds_read_b64_tr_b16 %2, %8 offset:1024\n\t" "ds_read_b64_tr_b16 %3, %8 offset:1536\n\t"
                 "ds_read_b64_tr_b16 %4, %8 offset:2048\n\t" "ds_read_b64_tr_b16 %5, %8 offset:2560\n\t" "ds_read_b64_tr_b16 %6, %8 offset:3072\n\t" "ds_read_b64_tr_b16 %7, %8 offset:3584\n\t"
                 "s_waitcnt lgkmcnt(0)"
                 : "=&v"(t00), "=&v"(t01), "=&v"(t10), "=&v"(t11), "=&v"(u00), "=&v"(u01), "=&v"(u10), "=&v"(u11) : "v"(addr) : "memory");
}

__device__ __forceinline__ void dsa2_setup(const Args& a, LAS unsigned char* lds, int tid) {
    LAS float* biasL = (LAS float*)(lds + DS_BIAS);
    for (int i = tid; i < 4 * 129; i += NTHR) { const int h = i / 129, d = i % 129; biasL[h * 132 + d] = a.in[IN_RELB][rel_bucket(d) * 4 + h] * 1.4426950408889634f; }
    __syncthreads();
}
__device__ __forceinline__ void idx_scores(const bf16x8 ka0, const bf16x8 ka1, const LAS bf16x8* qfl  , const float (&wv)[8], float (&sc)[16]) {
#pragma unroll
    for (int r = 0; r < 16; ++r) sc[r] = 0.f;
    float zero = 0.f;
#pragma unroll
    for (int hp = 0; hp < 4; ++hp) {
        const bf16x8 q00 = qfl[(4 * hp + 0) * 64], q01 = qfl[(4 * hp + 1) * 64], q10 = qfl[(4 * hp + 2) * 64], q11 = qfl[(4 * hp + 3) * 64];
        f32x16 acc0, acc1;
#pragma unroll
        for (int r = 0; r < 16; ++r) { acc0[r] = zero; acc1[r] = zero; }
        acc0 = MFMA32(ka0, q00, acc0); acc1 = MFMA32(ka0, q10, acc1);
        acc0 = MFMA32(ka1, q01, acc0); acc1 = MFMA32(ka1, q11, acc1);
#pragma unroll
        for (int r = 0; r < 16; ++r) sc[r] = __builtin_fmaf(fmaxf(acc1[r], 0.f), wv[2 * hp + 1], __builtin_fmaf(fmaxf(acc0[r], 0.f), wv[2 * hp], sc[r]));
        asm volatile("" : "+v"(zero), "+v"(sc[0]), "+v"(sc[1]), "+v"(sc[2]), "+v"(sc[3]), "+v"(sc[4]), "+v"(sc[5]), "+v"(sc[6]), "+v"(sc[7]), "+v"(sc[8]), "+v"(sc[9]), "+v"(sc[10]), "+v"(sc[11]), "+v"(sc[12]), "+v"(sc[13]), "+v"(sc[14]), "+v"(sc[15]));
    }
}
__device__ __forceinline__ f32x16 dsa_scores(const bf16x8 (&kf)[4], const bf16x8 (&qa)[4]) {
    f32x16 sacc;
#pragma unroll
    for (int r = 0; r < 16; ++r) sacc[r] = 0.f;
#pragma unroll
    for (int s = 0; s < 4; ++s) sacc = MFMA32(kf[s], qa[s], sacc);
    return sacc;
}
template <bool NEAR> __device__ __forceinline__ void dsa_att_tile(const f32x16& sacc, unsigned word, int dbase  , int hh, const LAS float* biasH, float c31,
                                                                 unsigned vaddr, f32x16& o0, f32x16& o1, float& m, float& lsum) {
    constexpr float SC = 0.18033688011112042f;
    float sv[16]; float tmax = -1e30f;
#pragma unroll
    for (int r = 0; r < 16; ++r) { const int kl = (r & 3) + 8 * (r >> 2) + 4 * hh; float bias = c31;
        if (NEAR) { int dd = dbase - kl; dd = dd < 0 ? 0 : (dd > 128 ? 128 : dd); bias = biasH[dd]; }
        const float v = __builtin_fmaf(sacc[r], SC, bias); sv[r] = ((word >> kl) & 1u) ? v : -1e30f; tmax = fmaxf(tmax, sv[r]); }
    tmax = fmaxf(tmax, shfl_xor_c<32>(tmax));
    const float mnew = fmaxf(m, tmax);
    if (__any(mnew != m)) { const float alpha = __builtin_amdgcn_exp2f(m - mnew); lsum *= alpha;
#pragma unroll
        for (int r = 0; r < 16; ++r) { o0[r] *= alpha; o1[r] *= alpha; } }
    m = mnew;
    float p[16]; float ps = 0.f;
#pragma unroll
    for (int r = 0; r < 16; ++r) { p[r] = __builtin_amdgcn_exp2f(sv[r] - mnew); ps += p[r]; }
    ps += shfl_xor_c<32>(ps);
    lsum += ps;
    bf16x8 pb[2];
#pragma unroll
    for (int s = 0; s < 2; ++s) { v4u t4; t4.x = pg8::cvt_pk_bf16(p[8 * s + 0], p[8 * s + 1]); t4.y = pg8::cvt_pk_bf16(p[8 * s + 2], p[8 * s + 3]); t4.z = pg8::cvt_pk_bf16(p[8 * s + 4], p[8 * s + 5]); t4.w = pg8::cvt_pk_bf16(p[8 * s + 6], p[8 * s + 7]);
        pb[s] = __builtin_bit_cast(bf16x8, t4); }
    bf16x4 t00, t01, t10, t11, u00, u01, u10, u11;
    tr_read_tile(vaddr, t00, t01, t10, t11, u00, u01, u10, u11);
    o0 = MFMA32(__builtin_shufflevector(t00, t01, 0, 1, 2, 3, 4, 5, 6, 7), pb[0], o0); o0 = MFMA32(__builtin_shufflevector(t10, t11, 0, 1, 2, 3, 4, 5, 6, 7), pb[1], o0);
    o1 = MFMA32(__builtin_shufflevector(u00, u01, 0, 1, 2, 3, 4, 5, 6, 7), pb[0], o1); o1 = MFMA32(__builtin_shufflevector(u10, u11, 0, 1, 2, 3, 4, 5, 6, 7), pb[1], o1);
}
#ifdef PROF_DSA
#define PSTAMP(k) do { if (tid == 0) { const unsigned long long t_ = wall_clock64(); prof[k] += (float)(t_ - tprev); tprev = t_; } } while (0)
#else
#define PSTAMP(k) do { } while (0)
#endif
__device__ __forceinline__ void dsa2_item(const Args& a, int item, LAS unsigned char* lds, int tid, float (&prof)[6]) {
#ifdef PROF_DSA
    unsigned long long tprev = wall_clock64();
#endif
    const int lane = tid & 63, w = __builtin_amdgcn_readfirstlane(tid >> 6), ql = lane & 31, hh = lane >> 5;
    const int b = item & 7, qi = 63 - (item >> 3), tq0 = qi * 32, ntl = qi + 1;
    const bool sel = qi >= 8;
    const bf16* z = (const bf16*)(a.ws + WS_Z); bf16* mix = (bf16*)(a.ws + WS_MIX);
    const bf16* zb = z + (size_t)b * T * ZW;
    const bf16* zq = zb + (size_t)(tq0 + ql) * ZW;
    LAS unsigned* hist = (LAS unsigned*)(lds + DS_HIST); LAS unsigned* bm = (LAS unsigned*)(lds + DS_BM);
    LAS unsigned* Pp = (LAS unsigned*)(lds + DS_P); LAS unsigned* need = Pp + 32; LAS unsigned* ccnt = Pp + 64; LAS unsigned* ccnt2 = Pp + 96;
    LAS unsigned* cu = (LAS unsigned*)(lds + DS_CU); LAS unsigned* ck = (LAS unsigned*)(lds + DS_CK);
    const LAS float* biasL = (const LAS float*)(lds + DS_BIAS);
    if (sel) {
        f32x4* scr = (f32x4*)(blockIdx.x < 128 ? a.ws + WS_HB + (size_t)blockIdx.x * 262144 : (unsigned char*)a.out + (size_t)(blockIdx.x - 128) * 262144) + lane;
        for (int i = tid; i < 2048; i += NTHR) bm[i] = 0u;
        for (int i = tid; i < 32 * 513; i += NTHR) hist[i] = 0u;
        if (tid < 32) { Pp[tid] = 0u; need[tid] = 256u; ccnt2[tid] = 0u; }
        __syncthreads();
        {
            float wv[8];
            LAS bf16x8* qfl = (LAS bf16x8*)(lds + DS_ST);
            if (w < 2) {
#pragma unroll
                for (int i = 0; i < 8; ++i) { const int fi = 8 * w + i; qfl[fi * 64 + lane] = *(const bf16x8*)(zq + Z_CQI + (fi >> 1) * 32 + 16 * (fi & 1) + 8 * hh); } }
            __syncthreads();
            { const v4u wr = *(const v4u*)(zq + Z_CWI);
              wv[0] = bflo(wr.x) * 0.0625f; wv[1] = bfhi(wr.x) * 0.0625f; wv[2] = bflo(wr.y) * 0.0625f; wv[3] = bfhi(wr.y) * 0.0625f;
              wv[4] = bflo(wr.z) * 0.0625f; wv[5] = bfhi(wr.z) * 0.0625f; wv[6] = bflo(wr.w) * 0.0625f; wv[7] = bfhi(wr.w) * 0.0625f; }
            const bf16* zk0 = zb + (size_t)ql * ZW + Z_CKI + 8 * hh;
            bf16x8 ka0 = *(const bf16x8*)(zk0 + (size_t)(w * 32) * ZW), ka1 = *(const bf16x8*)(zk0 + (size_t)(w * 32) * ZW + 16);
#pragma unroll 1
            for (int kt = w; kt < ntl; kt += 8) {
                const int ktn = (kt + 8 < ntl) ? kt + 8 : kt;
                const bf16x8 kn0 = *(const bf16x8*)(zk0 + (size_t)(ktn * 32) * ZW), kn1 = *(const bf16x8*)(zk0 + (size_t)(ktn * 32) * ZW + 16);
                float sc[16]; idx_scores(ka0, ka1, qfl + lane, wv, sc);
#pragma unroll
                for (int q4 = 0; q4 < 4; ++q4) scr[(size_t)kt * 256 + q4 * 64] = (f32x4){sc[4 * q4] + 0.0f, sc[4 * q4 + 1] + 0.0f, sc[4 * q4 + 2] + 0.0f, sc[4 * q4 + 3] + 0.0f};
                { unsigned dg[16]; unsigned d0 = 0xffffffffu;
#pragma unroll
                  for (int r = 0; r < 16; ++r) { const int kl = (r & 3) + 8 * (r >> 2) + 4 * hh; dg[r] = (kt < qi || kl <= ql) ? (ord_u(sc[r] + 0.0f) >> 23) : 0xffffffffu; }
#pragma unroll
                  for (int r = 15; r >= 0; --r) d0 = (dg[r] != 0xffffffffu) ? dg[r] : d0;
                  unsigned c0 = 0u;
#pragma unroll
                  for (int r = 0; r < 16; ++r) c0 += (dg[r] == d0) ? 1u : 0u;
                  if (d0 != 0xffffffffu) LDS_ADD(&hist[ql * 513 + d0], c0);
#pragma unroll
                  for (int r = 0; r < 16; ++r) { if (dg[r] != d0 && dg[r] != 0xffffffffu) LDS_ADD(&hist[ql * 513 + dg[r]], 1u); } }
                ka0 = kn0; ka1 = kn1;
            }
        }
        PSTAMP(0);
        int sh = 23, nb = 9;
#pragma unroll 1
        for (int level = 0; level < 4; ++level) {
            if (level > 0) {
                for (int i = tid; i < 32 * 513; i += NTHR) hist[i] = 0u;
                __syncthreads();
                const unsigned myP = Pp[ql];
                f32x4 cur4[4];
#pragma unroll
                for (int q4 = 0; q4 < 4; ++q4) cur4[q4] = scr[(size_t)(w < ntl ? w : 0) * 256 + q4 * 64];
#pragma unroll 1
                for (int kt = w; kt < ntl; kt += 8) {
                    const int ktn = (kt + 8 < ntl) ? kt + 8 : kt; f32x4 nxt4[4];
#pragma unroll
                    for (int q4 = 0; q4 < 4; ++q4) nxt4[q4] = scr[(size_t)ktn * 256 + q4 * 64];
#pragma unroll
                    for (int q4 = 0; q4 < 4; ++q4) {
#pragma unroll
                        for (int e = 0; e < 4; ++e) { const int kl = e + 8 * q4 + 4 * hh; const unsigned u = ord_u(cur4[q4][e]);
                            if ((kt < qi || kl <= ql) && (u >> (sh + nb)) == myP) LDS_ADD(&hist[ql * 513 + ((u >> sh) & ((1u << nb) - 1u))], 1u); } }
#pragma unroll
                    for (int q4 = 0; q4 < 4; ++q4) cur4[q4] = nxt4[q4];
                }
            }
            __syncthreads();
            { const int q = 4 * w + (lane >> 4), sl = lane & 15, bpl = (1 << nb) >> 4;
              const LAS unsigned* hp = hist + q * 513 + sl * bpl; unsigned s = 0u;
              for (int i = 0; i < bpl; ++i) s += hp[i];
              unsigned incl = s;
#pragma unroll
              for (int o = 1; o < 16; o <<= 1) { const unsigned t2 = shfl_idx_u(incl, (lane + o) & 63); if (sl + o < 16) incl += t2; }
              const unsigned excl = incl - s, nd = need[q];
              if (excl < nd && nd <= incl) { unsigned run = excl; int dsel = 0; unsigned above = 0u, cand = 0u;
                  for (int i = bpl - 1; i >= 0; --i) { const unsigned c = hp[i]; if (run + c >= nd) { dsel = i; above = run; cand = c; break; } run += c; }
                  Pp[q] = (Pp[q] << nb) | (unsigned)(sl * bpl + dsel); need[q] = nd - above; ccnt[q] = cand; } }
            __syncthreads();
            unsigned mc = ccnt[ql]; mc = (unsigned)wave_max((float)mc);
            if (mc <= (unsigned)DSA_CAP || level == 3) break;
            sh -= (level == 2) ? 7 : 8; nb = (level == 2) ? 7 : 8;
        }
        PSTAMP(1);
        { const unsigned myP = Pp[ql];
          f32x4 cur4[4];
#pragma unroll
          for (int q4 = 0; q4 < 4; ++q4) cur4[q4] = scr[(size_t)(w < ntl ? w : 0) * 256 + q4 * 64];
#pragma unroll 1
          for (int kt = w; kt < ntl; kt += 8) { unsigned bits = 0u;
            const int ktn = (kt + 8 < ntl) ? kt + 8 : kt; f32x4 nxt4[4];
#pragma unroll
            for (int q4 = 0; q4 < 4; ++q4) nxt4[q4] = scr[(size_t)ktn * 256 + q4 * 64];
#pragma unroll
            for (int q4 = 0; q4 < 4; ++q4) {
#pragma unroll
                for (int e = 0; e < 4; ++e) { const int kl = e + 8 * q4 + 4 * hh; const unsigned u = ord_u(cur4[q4][e]), pfx = u >> sh;
                    if (kt < qi || kl <= ql) { if (pfx > myP) bits |= 1u << kl;
                        else if (pfx == myP) { const unsigned slot = __hip_atomic_fetch_add(&ccnt2[ql], 1u, __ATOMIC_RELAXED, __HIP_MEMORY_SCOPE_WORKGROUP);
                            if (slot < (unsigned)DSA_CAP) { cu[ql * DSA_CAP + slot] = u; ck[ql * DSA_CAP + slot] = (unsigned)(kt * 32 + kl); } } } } }
            if (bits) (void)__hip_atomic_fetch_or(&bm[kt * 32 + ql], bits, __ATOMIC_RELAXED, __HIP_MEMORY_SCOPE_WORKGROUP);
#pragma unroll
            for (int q4 = 0; q4 < 4; ++q4) cur4[q4] = nxt4[q4];
          } }
        __syncthreads();
        for (int idx = tid; idx < 32 * DSA_CAP; idx += NTHR) { const int q = idx / DSA_CAP, i = idx % DSA_CAP; unsigned n = ccnt2[q]; n = n < (unsigned)DSA_CAP ? n : (unsigned)DSA_CAP;
            if ((unsigned)i < n) { const unsigned ui = cu[q * DSA_CAP + i], ki = ck[q * DSA_CAP + i]; unsigned rank = 0u;
                for (unsigned j = 0; j < n; ++j) { const unsigned uj = cu[q * DSA_CAP + j], kj = ck[q * DSA_CAP + j]; rank += (uj > ui || (uj == ui && kj < ki)) ? 1u : 0u; }
                if (rank < need[q]) (void)__hip_atomic_fetch_or(&bm[(ki >> 5) * 32 + q], 1u << (ki & 31u), __ATOMIC_RELAXED, __HIP_MEMORY_SCOPE_WORKGROUP); } }
        __syncthreads();
    }
    PSTAMP(2);
    const int hd = w >> 1, half = w & 1;
    bf16x8 qa[4];
#pragma unroll
    for (int s = 0; s < 4; ++s) qa[s] = *(const bf16x8*)(zq + Z_CQ + hd * 64 + 16 * s + 8 * hh);
    f32x16 o0, o1; float m, lsum;
    const LAS float* biasH = biasL + hd * 132; const float c31 = biasH[128];
    LAS unsigned char* st = lds + DS_ST + w * 4608;
    const unsigned vaddr = (unsigned)(size_t)st + (unsigned)((4 * hh + ((lane >> 2) & 3)) * 64 + 32 * ((lane >> 4) & 1) + 8 * (lane & 3));
    const bf16* kvbase = zb + (size_t)(lane >> 3) * ZW + hd * 64 + (lane & 7) * 8;
    LAS unsigned char* vst = st + ((lane & 7) >> 2) * 2048 + (lane >> 3) * 64 + (lane & 3) * 16;
    LAS unsigned char* kst = lds + DS_KST + w * 4096;
    LAS unsigned char* kwr = kst + (lane >> 3) * 128 + (((lane & 7) ^ ((lane >> 3) & 7)) * 16);
    const LAS unsigned char* krd = kst + ql * 128;
#pragma unroll
    for (int r = 0; r < 16; ++r) { o0[r] = 0.f; o1[r] = 0.f; }
    m = -30000.f; lsum = 0.f;
    const bf16* kfb = (const bf16*)(a.ws + WS_DKF) + ((size_t)(b * (T / 32)) * 16 + hd * 4) * 512 + lane * 8;
    v4u vr[4];
    { const int k0t = (half < ntl) ? half : 0;
#pragma unroll
      for (int i = 0; i < 4; ++i) vr[i] = *(const v4u*)(kvbase + (size_t)(k0t * 32 + 8 * i) * ZW + Z_CV); }
    f32x16 scur;
#pragma unroll
    for (int r = 0; r < 16; ++r) scur[r] = 0.f;
    bf16x8 kfn[4];
    { const int k0t = (half < ntl) ? half : 0, k2 = (half + 2 < ntl) ? half + 2 : k0t;
      bf16x8 kf0[4];
#pragma unroll
      for (int s = 0; s < 4; ++s) { kf0[s] = *(const bf16x8*)(kfb + ((size_t)k0t * 16 + s) * 512); kfn[s] = *(const bf16x8*)(kfb + ((size_t)k2 * 16 + s) * 512); }
      if (half < ntl) scur = dsa_scores(kf0, qa); }
#pragma unroll 1
    for (int kt = half; kt < ntl; kt += 2) {
        const bool has_next = kt + 2 < ntl;
#pragma unroll
        for (int i = 0; i < 4; ++i) *(LAS v4u*)(vst + i * 512) = vr[i];
        const int ktv = has_next ? kt + 2 : kt, ktk = (kt + 4 < ntl) ? kt + 4 : kt;
#pragma unroll
        for (int i = 0; i < 4; ++i) vr[i] = *(const v4u*)(kvbase + (size_t)(ktv * 32 + 8 * i) * ZW + Z_CV);
        f32x16 snext = scur;
        if (has_next) snext = dsa_scores(kfn, qa);
#pragma unroll
        for (int s = 0; s < 4; ++s) kfn[s] = *(const bf16x8*)(kfb + ((size_t)ktk * 16 + s) * 512);
        unsigned word = sel ? bm[kt * 32 + ql] : 0xffffffffu;
        if (kt == qi) word &= (ql == 31) ? 0xffffffffu : ((2u << ql) - 1u);
        if (qi - kt >= 5) dsa_att_tile<false>(scur, word, 0, hh, biasH, c31, vaddr, o0, o1, m, lsum);
        else dsa_att_tile<true>(scur, word, tq0 + ql - kt * 32, hh, biasH, c31, vaddr, o0, o1, m, lsum);
        scur = snext;
    }
    PSTAMP(3);
    LAS float* cmb = (LAS float*)(lds + DS_CMB + hd * 8704);
    if (half == 1) {
#pragma unroll
        for (int r = 0; r < 16; ++r) { cmb[r * 64 + lane] = o0[r]; cmb[(16 + r) * 64 + lane] = o1[r]; }
        cmb[2048 + lane] = m; cmb[2048 + 64 + lane] = lsum;
    }
    __syncthreads();
    if (half == 0) {
        const float mb = cmb[2048 + lane], lb = cmb[2048 + 64 + lane];
        const float mt = fmaxf(m, mb), fa = __builtin_amdgcn_exp2f(m - mt), fb = __builtin_amdgcn_exp2f(mb - mt);
        const float inv = 1.0f / (lsum * fa + lb * fb), ga = fa * inv, gb = fb * inv;
#pragma unroll
        for (int r = 0; r < 16; ++r) { o0[r] = o0[r] * ga + cmb[r * 64 + lane] * gb; o1[r] = o1[r] * ga + cmb[(16 + r) * 64 + lane] * gb; }
#pragma unroll
        for (int g = 0; g < 4; ++g) { v2u w0, w1; w0.x = pg8::cvt_pk_bf16(o0[4 * g], o0[4 * g + 1]); w0.y = pg8::cvt_pk_bf16(o0[4 * g + 2], o0[4 * g + 3]); w1.x = pg8::cvt_pk_bf16(o1[4 * g], o1[4 * g + 1]); w1.y = pg8::cvt_pk_bf16(o1[4 * g + 2], o1[4 * g + 3]);
            *(LAS v2u*)(st + ql * 136 + (8 * g + 4 * hh) * 2) = w0; *(LAS v2u*)(st + ql * 136 + (32 + 8 * g + 4 * hh) * 2) = w1; }
        asm volatile("s_waitcnt lgkmcnt(0)" ::: "memory");
#pragma unroll
        for (int i = 0; i < 4; ++i) { const int q = (lane >> 3) + 8 * i, ch = lane & 7;
            const v2u x0 = *(const LAS v2u*)(st + q * 136 + ch * 16), x1 = *(const LAS v2u*)(st + q * 136 + ch * 16 + 8);
            v4u o; o.x = x0.x; o.y = x0.y; o.z = x1.x; o.w = x1.y;
            *(v4u*)(mix + ((size_t)b * T + tq0 + q) * D + 512 + hd * 64 + ch * 8) = o; }
    }
    __syncthreads();
    PSTAMP(4);
}
constexpr int XA_V = 0, XA_ST = 32768;
__device__ __forceinline__ void xattn2_item(const Args& a, int l, int item, LAS unsigned char* lds, int tid) {
    const int lane = tid & 63, w = __builtin_amdgcn_readfirstlane(tid >> 6), ql = lane & 31, hh = lane >> 5;
    const int qg = item & 7, h = (item >> 3) & 3, b = item >> 5;
    const bf16* kvm = (const bf16*)(a.ws + WS_KVM + (size_t)l * SZ_KVM) + (size_t)b * MEMLEN * 512;
    const bf16* qx = (const bf16*)(a.ws + WS_QX); bf16* ox = (bf16*)(a.ws + WS_OX);
#pragma unroll
    for (int i = 0; i < 4; ++i) { const int idx = tid + NTHR * i, key = idx >> 3, ch = idx & 7;
        const v4u v = *(const v4u*)(kvm + (size_t)key * 512 + 256 + h * 64 + ch * 8);
        *(LAS v4u*)(lds + XA_V + (key >> 5) * 4096 + (ch >> 2) * 2048 + (key & 31) * 64 + (ch & 3) * 16) = v; }
    __syncthreads();
    const size_t row0 = (size_t)b * T + qg * 256 + w * 32;
    bf16x8 qa[4];
#pragma unroll
    for (int s = 0; s < 4; ++s) qa[s] = *(const bf16x8*)(qx + (row0 + ql) * 256 + h * 64 + 16 * s + 8 * hh);
    f32x16 o0, o1;
#pragma unroll
    for (int r = 0; r < 16; ++r) { o0[r] = 0.f; o1[r] = 0.f; }
    float m = -1e30f, lsum = 0.f;
    const unsigned vaddr = (unsigned)(size_t)(lds + XA_V) + (unsigned)((4 * hh + ((lane >> 2) & 3)) * 64 + 32 * ((lane >> 4) & 1) + 8 * (lane & 3));
#pragma unroll 1
    for (int kt = 0; kt < 8; ++kt) {
        bf16x8 kf[4];
        { const bf16* zk = kvm + (size_t)(kt * 32 + ql) * 512 + h * 64 + 8 * hh;
#pragma unroll
          for (int s = 0; s < 4; ++s) kf[s] = *(const bf16x8*)(zk + 16 * s); }
        f32x16 sacc;
#pragma unroll
        for (int r = 0; r < 16; ++r) sacc[r] = 0.f;
#pragma unroll
        for (int s = 0; s < 4; ++s) sacc = MFMA32(kf[s], qa[s], sacc);
        float sv[16]; float tmax = -1e30f;
#pragma unroll
        for (int r = 0; r < 16; ++r) { sv[r] = sacc[r] * 1.4426950408889634f; tmax = fmaxf(tmax, sv[r]); }
        tmax = fmaxf(tmax, shfl_xor_c<32>(tmax));
        const float mnew = fmaxf(m, tmax), alpha = __builtin_amdgcn_exp2f(m - mnew);
        float p[16]; float ps = 0.f;
#pragma unroll
        for (int r = 0; r < 16; ++r) { p[r] = __builtin_amdgcn_exp2f(sv[r] - mnew); ps += p[r]; }
        ps += shfl_xor_c<32>(ps);
        lsum = lsum * alpha + ps; m = mnew;
#pragma unroll
        for (int r = 0; r < 16; ++r) { o0[r] *= alpha; o1[r] *= alpha; }
        bf16x8 pb[2];
#pragma unroll
        for (int s = 0; s < 2; ++s) { v4u t4; t4.x = pg8::cvt_pk_bf16(p[8 * s + 0], p[8 * s + 1]); t4.y = pg8::cvt_pk_bf16(p[8 * s + 2], p[8 * s + 3]); t4.z = pg8::cvt_pk_bf16(p[8 * s + 4], p[8 * s + 5]); t4.w = pg8::cvt_pk_bf16(p[8 * s + 6], p[8 * s + 7]);
            pb[s] = __builtin_bit_cast(bf16x8, t4); }
        bf16x4 t00, t01, t10, t11, u00, u01, u10, u11;
        tr_read_tile(vaddr + kt * 4096, t00, t01, t10, t11, u00, u01, u10, u11);
        const bf16x8 va00 = __builtin_shufflevector(t00, t01, 0, 1, 2, 3, 4, 5, 6, 7), va01 = __builtin_shufflevector(t10, t11, 0, 1, 2, 3, 4, 5, 6, 7);
        const bf16x8 va10 = __builtin_shufflevector(u00, u01, 0, 1, 2, 3, 4, 5, 6, 7), va11 = __builtin_shufflevector(u10, u11, 0, 1, 2, 3, 4, 5, 6, 7);
        o0 = MFMA32(va00, pb[0], o0); o0 = MFMA32(va01, pb[1], o0);
        o1 = MFMA32(va10, pb[0], o1); o1 = MFMA32(va11, pb[1], o1);
    }
    const float inv = 1.0f / lsum;
    LAS unsigned char* st = lds + XA_ST + w * 4608;
#pragma unroll
    for (int g = 0; g < 4; ++g) { v2u w0, w1; w0.x = pg8::cvt_pk_bf16(o0[4 * g] * inv, o0[4 * g + 1] * inv); w0.y = pg8::cvt_pk_bf16(o0[4 * g + 2] * inv, o0[4 * g + 3] * inv);
        w1.x = pg8::cvt_pk_bf16(o1[4 * g] * inv, o1[4 * g + 1] * inv); w1.y = pg8::cvt_pk_bf16(o1[4 * g + 2] * inv, o1[4 * g + 3] * inv);
        *(LAS v2u*)(st + ql * 136 + (8 * g + 4 * hh) * 2) = w0; *(LAS v2u*)(st + ql * 136 + (32 + 8 * g + 4 * hh) * 2) = w1; }
    asm volatile("s_waitcnt lgkmcnt(0)" ::: "memory");
#pragma unroll
    for (int i = 0; i < 4; ++i) { const int q = (lane >> 3) + 8 * i, ch = lane & 7;
        const v2u x0 = *(const LAS v2u*)(st + q * 136 + ch * 16), x1 = *(const LAS v2u*)(st + q * 136 + ch * 16 + 8);
        v4u o; o.x = x0.x; o.y = x0.y; o.z = x1.x; o.w = x1.y;
        *(v4u*)(ox + (row0 + q) * 256 + h * 64 + ch * 8) = o; }
    __syncthreads();
}

__device__ __forceinline__ float gelu_fast(float x) {
    const float y = x * (1.0f + 0.044715f * x * x) * -2.302208198f;
    return x * __builtin_amdgcn_rcpf(1.0f + __builtin_amdgcn_exp2f(y));
}
__device__ __forceinline__ void frag_phase(const Args& a, int tid, int G, int bid) {
    for (int P = bid * NTHR + tid; P < 393216; P += G * NTHR) {
        const int lane = P & 63, ql = lane & 31, hh = lane >> 5;
        if (P < 65536) { const int l2 = P >> 15, fr = (P & 32767) >> 6, w = fr >> 6, kk = fr & 63;
            *(v4u*)((bf16*)(a.ws + WS_WQF) + (size_t)P * 8) = *(const v4u*)((const bf16*)(a.ws + WS_WQ + (size_t)l2 * SZ_WQ) + (size_t)(32 * w + ql) * D + 16 * kk + 8 * hh); }
        else if (P < 131072) { const int Q = P - 65536, l2 = Q >> 15, fr = (Q & 32767) >> 6, nt = fr >> 4, kk = fr & 15;
            *(v4u*)((bf16*)(a.ws + WS_WOF) + (size_t)Q * 8) = *(const v4u*)((const bf16*)(a.ws + WS_WO + (size_t)l2 * SZ_WO) + (size_t)(32 * nt + ql) * 256 + 16 * kk + 8 * hh); }
        else if (P < 262144) { const int Q = P - 131072, l2 = Q >> 16, r1 = Q & 65535, b = r1 >> 13, r2 = r1 & 8191, h = r2 >> 11, kt = (r2 >> 8) & 7, s4 = (r2 >> 6) & 3;
            *(v4u*)((bf16*)(a.ws + WS_KF) + (size_t)Q * 8) = *(const v4u*)((const bf16*)(a.ws + WS_KVM + (size_t)l2 * SZ_KVM) + (size_t)(b * MEMLEN + 32 * kt + ql) * 512 + h * 64 + 16 * s4 + 8 * hh); }
        else { const int Q = P - 262144, l2 = Q >> 16, r1 = Q & 65535, b = r1 >> 13, r2 = r1 & 8191, h = r2 >> 11, kt = (r2 >> 8) & 7, dd = (r2 >> 7) & 1, j = (r2 >> 6) & 1;
            const bf16* vsrc = (const bf16*)(a.ws + WS_KVM + (size_t)l2 * SZ_KVM) + (size_t)(b * MEMLEN + 32 * kt + 16 * j + 4 * hh) * 512 + 256 + h * 64 + 32 * dd + ql;
            unsigned short e8[8];
#pragma unroll
            for (int e = 0; e < 8; ++e) e8[e] = *(const unsigned short*)(vsrc + (size_t)((e & 3) + 8 * (e >> 2)) * 512);
            v4u w; w.x = e8[0] | ((unsigned)e8[1] << 16); w.y = e8[2] | ((unsigned)e8[3] << 16); w.z = e8[4] | ((unsigned)e8[5] << 16); w.w = e8[6] | ((unsigned)e8[7] << 16);
            *(v4u*)((bf16*)(a.ws + WS_VF) + (size_t)Q * 8) = w; }
    }
}
#define XF_NREP(name) int name = 3; asm volatile("" : "+s"(name))
constexpr int XF_HBS = 2064, XF_QS = 528, XF_Q = 0, XF_O = 64 * XF_QS;
__device__ __forceinline__ void xfuse_item(const Args& a, int l, int item, LAS unsigned char* lds, int tid) {
    const int lane = tid & 63, w = __builtin_amdgcn_readfirstlane(tid >> 6), ql = lane & 31, hh = lane >> 5;
    const int tok0 = item * 64, b = item >> 5;
    const bf16* hbp = (const bf16*)(a.ws + WS_H16) + (size_t)tok0 * D;
#ifdef XF_REPA
    XF_NREP(nra);
#pragma unroll 1
    for (int rep = 0; rep < nra; ++rep)
#endif
#pragma unroll
    for (int i = 0; i < 16; ++i) { const int chunk = tid + NTHR * i, row = chunk >> 7, c16 = chunk & 127;
        *(LAS v4u*)(lds + row * XF_HBS + c16 * 16) = *(const v4u*)(hbp + (size_t)row * D + c16 * 8); }
    const float* ss = (const float*)(a.ws + WS_SS);
    const float rs0 = rstd16(ss, tok0 + ql) * 0.125f, rs1 = rstd16(ss, tok0 + 32 + ql) * 0.125f;
    __syncthreads();
    { f32x16 q0, q1;
#pragma unroll
      for (int r = 0; r < 16; ++r) { q0[r] = 0.f; q1[r] = 0.f; }
      const bf16* wq = (const bf16*)(a.ws + WS_WQF) + (size_t)(l * 8 + w) * 64 * 512 + lane * 8;
      const LAS unsigned char* hb0 = lds + ql * XF_HBS + 16 * hh;
#ifdef XF_REPB
      XF_NREP(nrb);
#pragma unroll 1
      for (int rep = 0; rep < nrb; ++rep) {
#pragma unroll
      for (int r = 0; r < 16; ++r) { q0[r] = 0.f; q1[r] = 0.f; }
#endif
#pragma unroll 8
      for (int kk = 0; kk < 64; ++kk) {
          const bf16x8 af = *(const bf16x8*)(wq + 512 * kk);
          const bf16x8 b0 = *(const LAS bf16x8*)(hb0 + 32 * kk), b1 = *(const LAS bf16x8*)(hb0 + 32 * XF_HBS + 32 * kk);
          q0 = MFMA32(af, b0, q0); q1 = MFMA32(af, b1, q1); }
#ifdef XF_REPB
      }
#endif
      __syncthreads();
#pragma unroll
      for (int g = 0; g < 4; ++g) { v2u w0, w1;
          w0.x = pg8::cvt_pk_bf16(q0[4 * g] * rs0, q0[4 * g + 1] * rs0); w0.y = pg8::cvt_pk_bf16(q0[4 * g + 2] * rs0, q0[4 * g + 3] * rs0);
          w1.x = pg8::cvt_pk_bf16(q1[4 * g] * rs1, q1[4 * g + 1] * rs1); w1.y = pg8::cvt_pk_bf16(q1[4 * g + 2] * rs1, q1[4 * g + 3] * rs1);
          *(LAS v2u*)(lds + XF_Q + ql * XF_QS + (32 * w + 8 * g + 4 * hh) * 2) = w0; *(LAS v2u*)(lds + XF_Q + (32 + ql) * XF_QS + (32 * w + 8 * g + 4 * hh) * 2) = w1; }
    }
    __syncthreads();
    { const int h = w >> 1, th = w & 1;
      const bf16* kfb = (const bf16*)(a.ws + WS_KF) + (size_t)((l * 8 + b) * 4 + h) * 32 * 512 + lane * 8;
      const bf16* vfb = (const bf16*)(a.ws + WS_VF) + (size_t)((l * 8 + b) * 4 + h) * 32 * 512 + lane * 8;
      bf16x8 qa[4];
#pragma unroll
      for (int s = 0; s < 4; ++s) qa[s] = *(const LAS bf16x8*)(lds + XF_Q + (32 * th + ql) * XF_QS + (h * 64 + 16 * s + 8 * hh) * 2);
      f32x16 o0, o1;
#pragma unroll
      for (int r = 0; r < 16; ++r) { o0[r] = 0.f; o1[r] = 0.f; }
      float m = -1e30f, lsum = 0.f;
      bf16x8 kf[4], va00, va01, va10, va11;
#pragma unroll
      for (int s = 0; s < 4; ++s) kf[s] = *(const bf16x8*)(kfb + 512 * s);
      va00 = *(const bf16x8*)(vfb); va01 = *(const bf16x8*)(vfb + 512); va10 = *(const bf16x8*)(vfb + 1024); va11 = *(const bf16x8*)(vfb + 1536);
#ifdef XF_REPC
      XF_NREP(nrc);
#pragma unroll 1
      for (int rep = 0; rep < nrc; ++rep) { m = -1e30f; lsum = 0.f;
#pragma unroll
      for (int s = 0; s < 4; ++s) kf[s] = *(const bf16x8*)(kfb + 512 * s);
      va00 = *(const bf16x8*)(vfb); va01 = *(const bf16x8*)(vfb + 512); va10 = *(const bf16x8*)(vfb + 1024); va11 = *(const bf16x8*)(vfb + 1536);
#pragma unroll
      for (int r = 0; r < 16; ++r) { o0[r] = 0.f; o1[r] = 0.f; }
#endif
#pragma unroll 1
      for (int kt = 0; kt < 8; ++kt) {
          const int kn = kt < 7 ? kt + 1 : 7;
          bf16x8 nk[4];
#pragma unroll
          for (int s = 0; s < 4; ++s) nk[s] = *(const bf16x8*)(kfb + (size_t)(kn * 4 + s) * 512);
          const bf16x8 n00 = *(const bf16x8*)(vfb + (size_t)kn * 2048), n01 = *(const bf16x8*)(vfb + (size_t)kn * 2048 + 512), n10 = *(const bf16x8*)(vfb + (size_t)kn * 2048 + 1024), n11 = *(const bf16x8*)(vfb + (size_t)kn * 2048 + 1536);
          f32x16 sacc;
#pragma unroll
          for (int r = 0; r < 16; ++r) sacc[r] = 0.f;
#pragma unroll
          for (int s = 0; s < 4; ++s) sacc = MFMA32(kf[s], qa[s], sacc);
          float sv[16]; float tmax = -1e30f;
#pragma unroll
          for (int r = 0; r < 16; ++r) { sv[r] = sacc[r] * 1.4426950408889634f; tmax = fmaxf(tmax, sv[r]); }
          tmax = fmaxf(tmax, shfl_xor_c<32>(tmax));
          const float mnew = fmaxf(m, tmax), alpha = __builtin_amdgcn_exp2f(m - mnew);
          float p[16]; float ps = 0.f;
#pragma unroll
          for (int r = 0; r < 16; ++r) { p[r] = __builtin_amdgcn_exp2f(sv[r] - mnew); ps += p[r]; }
          ps += shfl_xor_c<32>(ps);
          lsum = lsum * alpha + ps; m = mnew;
#pragma unroll
          for (int r = 0; r < 16; ++r) { o0[r] *= alpha; o1[r] *= alpha; }
          bf16x8 pb[2];
#pragma unroll
          for (int s = 0; s < 2; ++s) { v4u t4; t4.x = pg8::cvt_pk_bf16(p[8 * s + 0], p[8 * s + 1]); t4.y = pg8::cvt_pk_bf16(p[8 * s + 2], p[8 * s + 3]); t4.z = pg8::cvt_pk_bf16(p[8 * s + 4], p[8 * s + 5]); t4.w = pg8::cvt_pk_bf16(p[8 * s + 6], p[8 * s + 7]);
              pb[s] = __builtin_bit_cast(bf16x8, t4); }
          o0 = MFMA32(va00, pb[0], o0); o0 = MFMA32(va01, pb[1], o0);
          o1 = MFMA32(va10, pb[0], o1); o1 = MFMA32(va11, pb[1], o1);
#pragma unroll
          for (int s = 0; s < 4; ++s) kf[s] = nk[s];
          va00 = n00; va01 = n01; va10 = n10; va11 = n11;
      }
#ifdef XF_REPC
      }
#endif
      const float inv = 1.0f / lsum;
      LAS unsigned char* orow = lds + XF_O + (32 * th + ql) * XF_QS + (h * 64 + 4 * hh) * 2;
#pragma unroll
      for (int g = 0; g < 4; ++g) { v2u w0, w1; w0.x = pg8::cvt_pk_bf16(o0[4 * g] * inv, o0[4 * g + 1] * inv); w0.y = pg8::cvt_pk_bf16(o0[4 * g + 2] * inv, o0[4 * g + 3] * inv);
          w1.x = pg8::cvt_pk_bf16(o1[4 * g] * inv, o1[4 * g + 1] * inv); w1.y = pg8::cvt_pk_bf16(o1[4 * g + 2] * inv, o1[4 * g + 3] * inv);
          *(LAS v2u*)(orow + 16 * g) = w0; *(LAS v2u*)(orow + 64 + 16 * g) = w1; }
    }
    __syncthreads();
    { f32x16 acc[4][2];
#pragma unroll
      for (int c = 0; c < 4; ++c)
#pragma unroll
          for (int t = 0; t < 2; ++t)
#pragma unroll
              for (int r = 0; r < 16; ++r) acc[c][t][r] = 0.f;
      const bf16* wo = (const bf16*)(a.ws + WS_WOF) + (size_t)(l * 32 + 4 * w) * 16 * 512 + lane * 8;
      const LAS unsigned char* ob = lds + XF_O + ql * XF_QS + 16 * hh;
#ifdef XF_REPD
      XF_NREP(nrd);
#pragma unroll 1
      for (int rep = 0; rep < nrd; ++rep) {
#pragma unroll
      for (int c = 0; c < 4; ++c)
#pragma unroll
          for (int t = 0; t < 2; ++t)
#pragma unroll
              for (int r = 0; r < 16; ++r) acc[c][t][r] = 0.f;
#endif
#pragma unroll 4
      for (int kk = 0; kk < 16; ++kk) {
          const bf16x8 b0 = *(const LAS bf16x8*)(ob + 32 * kk), b1 = *(const LAS bf16x8*)(ob + 32 * XF_QS + 32 * kk);
#pragma unroll
          for (int c = 0; c < 4; ++c) { const bf16x8 af = *(const bf16x8*)(wo + (size_t)(c * 16 + kk) * 512);
              acc[c][0] = MFMA32(af, b0, acc[c][0]); acc[c][1] = MFMA32(af, b1, acc[c][1]); } }
#ifdef XF_REPD
      }
#endif
      bf16* HB = (bf16*)(a.ws + WS_H16); float* SSw = (float*)(a.ws + WS_SS);
#pragma unroll
      for (int t = 0; t < 2; ++t) { const size_t row = (size_t)tok0 + 32 * t + ql; float q = 0.f;
          const size_t off0 = row * D + 128 * w + 4 * hh;
          v2u rv[4][4];
#pragma unroll
          for (int c = 0; c < 4; ++c)
#pragma unroll
              for (int g = 0; g < 4; ++g) rv[c][g] = *(const v2u*)(HB + off0 + 32 * c + 8 * g);
#pragma unroll
          for (int c = 0; c < 4; ++c)
#pragma unroll
              for (int g = 0; g < 4; ++g) { const f32x4 r0 = bf4(rv[c][g]);
                  f32x4 v; v.x = acc[c][t][4 * g] + r0.x; v.y = acc[c][t][4 * g + 1] + r0.y; v.z = acc[c][t][4 * g + 2] + r0.z; v.w = acc[c][t][4 * g + 3] + r0.w;
                  q += (v.x * v.x + v.y * v.y) + (v.z * v.z + v.w * v.w);
                  v2u pk; pk.x = pg8::cvt_pk_bf16(v.x, v.y); pk.y = pg8::cvt_pk_bf16(v.z, v.w); rv[c][g] = pk; }
          asm volatile("" ::: "memory");
#pragma unroll
          for (int c = 0; c < 4; ++c)
#pragma unroll
              for (int g = 0; g < 4; ++g) *(v2u*)(HB + off0 + 32 * c + 8 * g) = rv[c][g];
          q += shfl_xor_c<32>(q);
          SSw[row * 16 + 2 * w + hh] = hh ? 0.f : q; }
    }
    __syncthreads();
}
__device__ __forceinline__ bf16x8 tr_frag(unsigned addr) {
    bf16x4 lo, hi;
    asm volatile("ds_read_b64_tr_b16 %0, %2 offset:0\n\tds_read_b64_tr_b16 %1, %2 offset:256\n\ts_waitcnt lgkmcnt(0)" : "=&v"(lo), "=&v"(hi) : "v"(addr) : "memory");
    return __builtin_shufflevector(lo, hi, 0, 1, 2, 3, 4, 5, 6, 7);
}
__device__ __forceinline__ void sgu2_item(const Args& a, int l, int item, LAS unsigned char* lds, int tid) {
    const int lane = tid & 63, w = __builtin_amdgcn_readfirstlane(tid >> 6), ql = lane & 31, hh = lane >> 5;
    const int nc = item & 15, b = item >> 4, tok0 = b * T + nc * 128;
    const bf16* z = (const bf16*)(a.ws + WS_Z); bf16* mix = (bf16*)(a.ws + WS_MIX);
    for (int j = 0; j < 16; ++j) { const int s = 16 * w + j;
        const v2u raw = *(const v2u*)(z + (size_t)(tok0 + s) * ZW + Z_DUV + 256 + 4 * lane);
        float x[4] = {gelu_fast(bflo(raw.x)), gelu_fast(bfhi(raw.x)), gelu_fast(bflo(raw.y)), gelu_fast(bfhi(raw.y))};
        const float mu = wave_sum((x[0] + x[1]) + (x[2] + x[3])) * (1.0f / 256.0f);
        float q = 0.f;
#pragma unroll
        for (int i = 0; i < 4; ++i) { x[i] -= mu; q += x[i] * x[i]; }
        const float rstd = rsqrtf(wave_sum(q) * (1.0f / 256.0f) + EPS);
        const f32x4 gg = *(const f32x4*)(a.in[IN_LNG] + l * 256 + 4 * lane), bb = *(const f32x4*)(a.in[IN_LNB] + l * 256 + 4 * lane);
        v2u o; o.x = pk2(x[0] * rstd * gg.x + bb.x, x[1] * rstd * gg.y + bb.y); o.y = pk2(x[2] * rstd * gg.z + bb.z, x[3] * rstd * gg.w + bb.w);
        const int ch = 4 * lane;
        *(LAS v2u*)(lds + ((s >> 5) * 8 + (ch >> 5)) * 2048 + (s & 31) * 64 + (ch & 31) * 2) = o; }
    __syncthreads();
    const int g = w >> 1, cb = w & 1, cblk = g * 2 + cb;
    bf16x8 af[4][2];
    { const unsigned abase = (unsigned)(size_t)lds + (unsigned)(cblk * 2048 + (8 * hh + ((lane >> 2) & 3)) * 64 + 32 * ((lane >> 4) & 1) + 8 * (lane & 3));
#pragma unroll
      for (int sb = 0; sb < 4; ++sb) { af[sb][0] = tr_frag(abase + sb * 8 * 2048); af[sb][1] = tr_frag(abase + sb * 8 * 2048 + 16 * 64); } }
    const bf16* swt = (const bf16*)(a.ws + WS_SWT) + (size_t)(l * 4 + g) * 128 * 128;
#pragma unroll
    for (int tb = 0; tb < 4; ++tb) {
        f32x16 acc;
#pragma unroll
        for (int r = 0; r < 16; ++r) acc[r] = 0.f;
        const bf16* wrow = swt + (size_t)(32 * tb + ql) * 128 + 8 * hh;
#pragma unroll
        for (int sb = 0; sb <= tb; ++sb) { const bf16x8 b0 = *(const bf16x8*)(wrow + 32 * sb), b1 = *(const bf16x8*)(wrow + 32 * sb + 16);
            acc = MFMA32(af[sb][0], b0, acc); acc = MFMA32(af[sb][1], b1, acc); }
        const int t = 32 * tb + ql; const float bs = a.in[IN_SB][(l * 4 + g) * 128 + t];
        const bf16* up = z + (size_t)(tok0 + t) * ZW + Z_DUV + g * 64 + cb * 32 + 4 * hh; bf16* op = mix + (size_t)(tok0 + t) * D + 768 + g * 64 + cb * 32 + 4 * hh;
#pragma unroll
        for (int q4 = 0; q4 < 4; ++q4) { const v2u raw = *(const v2u*)(up + 8 * q4);
            v2u o; o.x = pk2(gelu_fast(bflo(raw.x)) * (acc[4 * q4] + bs), gelu_fast(bfhi(raw.x)) * (acc[4 * q4 + 1] + bs)); o.y = pk2(gelu_fast(bflo(raw.y)) * (acc[4 * q4 + 2] + bs), gelu_fast(bfhi(raw.y)) * (acc[4 * q4 + 3] + bs));
            *(v2u*)(op + 8 * q4) = o; }
    }
    __syncthreads();
}
__device__ __forceinline__ void pool2_item(const Args& a, int l, int item, LAS unsigned char* lds, int tid) {
    const int lane = tid & 63, w = __builtin_amdgcn_readfirstlane(tid >> 6), ql = lane & 31, hh = lane >> 5;
    const int tt = item & 31, b = item >> 5, t0 = tt * 64;
    const bf16* z = (const bf16*)(a.ws + WS_Z); bf16* mix = (bf16*)(a.ws + WS_MIX);
    for (int i = tid; i < 79 * 32; i += NTHR) { const int r = i >> 5, ch = i & 31, t = t0 - 15 + r;
        v4u v = (v4u){0u, 0u, 0u, 0u}; if (t >= 0) v = *(const v4u*)(z + (size_t)(b * T + t) * ZW + Z_BU + ch * 8);
        *(LAS v4u*)(lds + r * 528 + ch * 16) = v; }
    __syncthreads();
    const int tb = w & 1, g = w >> 1, win = 2 << g, tl = 32 * tb + ql, tabs = t0 + tl;
    const float icnt = 1.0f / (float)((tabs + 1 < win) ? tabs + 1 : win);
    bf16x8 bfr[4];
#pragma unroll
    for (int s = 0; s < 4; ++s) { const LAS unsigned char* p0 = lds + (tl + 15) * 528 + (g * 64 + 16 * s + 8 * hh) * 2; float acc[8] = {0.f, 0.f, 0.f, 0.f, 0.f, 0.f, 0.f, 0.f};
        for (int j = 0; j < win; ++j) { const v4u r = *(const LAS v4u*)(p0 - j * 528);
            acc[0] += bflo(r.x); acc[1] += bfhi(r.x); acc[2] += bflo(r.y); acc[3] += bfhi(r.y); acc[4] += bflo(r.z); acc[5] += bfhi(r.z); acc[6] += bflo(r.w); acc[7] += bfhi(r.w); }
        const v4u r0 = *(const LAS v4u*)p0;
        v4u o; o.x = pg8::cvt_pk_bf16(acc[0] * icnt - bflo(r0.x), acc[1] * icnt - bfhi(r0.x)); o.y = pg8::cvt_pk_bf16(acc[2] * icnt - bflo(r0.y), acc[3] * icnt - bfhi(r0.y));
        o.z = pg8::cvt_pk_bf16(acc[4] * icnt - bflo(r0.z), acc[5] * icnt - bfhi(r0.z)); o.w = pg8::cvt_pk_bf16(acc[6] * icnt - bflo(r0.w), acc[7] * icnt - bfhi(r0.w));
        bfr[s] = __builtin_bit_cast(bf16x8, o); }
    const bf16* pwt = (const bf16*)(a.ws + WS_PWT) + (size_t)(l * 4 + g) * 4096;
    bf16* op = mix + (size_t)(b * T + tabs) * D + 256 + g * 64 + 4 * hh;
#pragma unroll
    for (int db = 0; db < 2; ++db) { f32x16 acc;
#pragma unroll
        for (int r = 0; r < 16; ++r) acc[r] = 0.f;
#pragma unroll
        for (int s = 0; s < 4; ++s) { const bf16x8 af = *(const bf16x8*)(pwt + (size_t)(32 * db + ql) * 64 + 16 * s + 8 * hh); acc = MFMA32(af, bfr[s], acc); }
#pragma unroll
        for (int q4 = 0; q4 < 4; ++q4) { const int d0 = 32 * db + 8 * q4 + 4 * hh;
            const f32x4 pb = *(const f32x4*)(a.in[IN_PB] + (l * 4 + g) * 64 + d0), ps = *(const f32x4*)(a.in[IN_PS] + l * 256 + g * 64 + d0);
            v2u o; o.x = pk2((acc[4 * q4] + pb.x) * ps.x, (acc[4 * q4 + 1] + pb.y) * ps.y); o.y = pk2((acc[4 * q4 + 2] + pb.z) * ps.z, (acc[4 * q4 + 3] + pb.w) * ps.w);
            *(v2u*)(op + 32 * db + 8 * q4) = o; } }
    __syncthreads();
}

constexpr int GL_V = 0;
constexpr int GL_KD = 32768;

__device__ __forceinline__ void gla_decay(const Args& a, int l, int h, const bf16* zc  , int lane, float (&b0)[16], float (&b1)[16]) {
    const int ql = lane & 31, hh = lane >> 5;
    bf16x8 wfrag; { float wv[8];
#pragma unroll
        for (int j = 0; j < 8; ++j) wv[j] = a.in[IN_WA2][(size_t)l * 2048 + (8 * hh + j) * 128 + h * 32 + ql];
        v4u t4; t4.x = pk2(wv[0], wv[1]); t4.y = pk2(wv[2], wv[3]); t4.z = pk2(wv[4], wv[5]); t4.w = pk2(wv[6], wv[7]); wfrag = __builtin_bit_cast(bf16x8, t4); }
    f32x16 binit;
#pragma unroll
    for (int q4 = 0; q4 < 4; ++q4) { const f32x4 t = *(const f32x4*)(a.in[IN_BA] + l * 128 + h * 32 + 8 * q4 + 4 * hh); binit[4 * q4] = t.x; binit[4 * q4 + 1] = t.y; binit[4 * q4 + 2] = t.z; binit[4 * q4 + 3] = t.w; }
#pragma unroll
    for (int rb = 0; rb < 2; ++rb) {
        const bf16x8 afrag = *(const bf16x8*)(zc + (size_t)(32 * rb + ql) * ZW + Z_ALR + 8 * hh);
        f32x16 lg = MFMA32(wfrag, afrag, binit);
#pragma unroll
        for (int r = 0; r < 16; ++r) { const float x = lg[r]; float v = (fminf(x, 0.f) - __logf(1.0f + __expf(-fabsf(x)))) * 0.0625f;
#pragma unroll
            for (int d = 1; d < 32; d <<= 1) { const float t = shfl_idx(v, (lane - d) & 63); if (ql >= d) v += t; }
            if (rb == 0) b0[r] = v; else b1[r] = v + shfl_idx(b0[r], lane | 31); }
    }
}
__device__ __forceinline__ void ld16acc(const bf16* p  , float (&x)[16]) {
#pragma unroll
    for (int q4 = 0; q4 < 4; ++q4) { const v2u t = *(const v2u*)(p + 8 * q4); x[4 * q4] = bflo(t.x); x[4 * q4 + 1] = bfhi(t.x); x[4 * q4 + 2] = bflo(t.y); x[4 * q4 + 3] = bfhi(t.y); }
}
__device__ __forceinline__ bf16x8 pack_frag(const float (&x)[16], int s) { v4u t4; t4.x = pg8::cvt_pk_bf16(x[8 * s], x[8 * s + 1]); t4.y = pg8::cvt_pk_bf16(x[8 * s + 2], x[8 * s + 3]); t4.z = pg8::cvt_pk_bf16(x[8 * s + 4], x[8 * s + 5]); t4.w = pg8::cvt_pk_bf16(x[8 * s + 6], x[8 * s + 7]); return __builtin_bit_cast(bf16x8, t4); }
__device__ __forceinline__ void gla2_a_item(const Args& a, int l, int item, LAS unsigned char* lds, int tid) {
    const int lane = tid & 63, w = __builtin_amdgcn_readfirstlane(tid >> 6), ql = lane & 31, hh = lane >> 5;
    const int n = item & 31, b = item >> 5, h = w >> 1, ib = w & 1, tok0 = b * T + n * 64, it4 = (b * 4 + h) * 32 + n;
    const bf16* z = (const bf16*)(a.ws + WS_Z); const bf16* zc = z + (size_t)tok0 * ZW;
    float* OI = (float*)(a.ws + WS_GOI); v4u* QTF = (v4u*)(a.ws + WS_GQT); float* KVT = (float*)(a.ws + WS_GKV); float* DEC = (float*)(a.ws + WS_GDEC);
#pragma unroll
    for (int i = 0; i < 4; ++i) { const int tk = (lane >> 3) + 8 * i, ch = lane & 7;
        const v4u v = *(const v4u*)(zc + (size_t)(32 * ib + tk) * ZW + Z_AV + h * 64 + ch * 8);
        *(LAS v4u*)(lds + GL_V + h * 8192 + (ib * 2 + (ch >> 2)) * 2048 + tk * 64 + (ch & 3) * 16) = v; }
    float b0[16], b1[16]; gla_decay(a, l, h, zc, lane, b0, b1);
    float blast[16];
#pragma unroll
    for (int r = 0; r < 16; ++r) blast[r] = shfl_idx(b1[r], lane | 31);
    float x[16], qt[16], kt[16], kd[16];
    ld16acc(zc + (size_t)(32 * ib + ql) * ZW + Z_AQ + h * 32 + 4 * hh, x);
#pragma unroll
    for (int r = 0; r < 16; ++r) qt[r] = x[r] * 0.17677669529663687f * __expf(ib ? b1[r] : b0[r]);
    ld16acc(zc + (size_t)(32 * ib + ql) * ZW + Z_AK + h * 32 + 4 * hh, x);
#pragma unroll
    for (int r = 0; r < 16; ++r) { const float bv = ib ? b1[r] : b0[r]; kt[r] = x[r] * __expf(-bv); kd[r] = x[r] * __expf(blast[r] - bv); }
    const bf16x8 qf0 = pack_frag(qt, 0), qf1 = pack_frag(qt, 1);
    QTF[((size_t)it4 * 2 + ib) * 128 + lane] = __builtin_bit_cast(v4u, qf0); QTF[((size_t)it4 * 2 + ib) * 128 + 64 + lane] = __builtin_bit_cast(v4u, qf1);
#pragma unroll
    for (int q4 = 0; q4 < 4; ++q4) { v2u o; o.x = pg8::cvt_pk_bf16(kd[4 * q4], kd[4 * q4 + 1]); o.y = pg8::cvt_pk_bf16(kd[4 * q4 + 2], kd[4 * q4 + 3]);
        *(LAS v2u*)(lds + GL_KD + h * 4096 + (32 * ib + ql) * 64 + (8 * q4 + 4 * hh) * 2) = o; }
    if (ib == 1 && ql == 31) {
#pragma unroll
        for (int q4 = 0; q4 < 4; ++q4) { f32x4 d; d.x = __expf(b1[4 * q4]); d.y = __expf(b1[4 * q4 + 1]); d.z = __expf(b1[4 * q4 + 2]); d.w = __expf(b1[4 * q4 + 3]); *(f32x4*)(DEC + (size_t)it4 * 32 + 8 * q4 + 4 * hh) = d; } }
    __syncthreads();
    f32x16 o0, o1;
#pragma unroll
    for (int r = 0; r < 16; ++r) { o0[r] = 0.f; o1[r] = 0.f; }
    const unsigned vaddr = (unsigned)(size_t)(lds + GL_V + h * 8192) + (unsigned)((4 * hh + ((lane >> 2) & 3)) * 64 + 32 * ((lane >> 4) & 1) + 8 * (lane & 3));
#pragma unroll
    for (int jb = 0; jb < 2; ++jb) {
        if (jb <= ib) {
            bf16x8 kf0, kf1;
            if (jb == ib) { kf0 = pack_frag(kt, 0); kf1 = pack_frag(kt, 1); }
            else { float kx[16]; ld16acc(zc + (size_t)ql * ZW + Z_AK + h * 32 + 4 * hh, kx);
#pragma unroll
                for (int r = 0; r < 16; ++r) kx[r] *= __expf(-b0[r]);
                kf0 = pack_frag(kx, 0); kf1 = pack_frag(kx, 1); }
            f32x16 at;
#pragma unroll
            for (int r = 0; r < 16; ++r) at[r] = 0.f;
            at = MFMA32(kf0, qf0, at); at = MFMA32(kf1, qf1, at);
            float pa[16];
#pragma unroll
            for (int r = 0; r < 16; ++r) { const int jl = (r & 3) + 8 * (r >> 2) + 4 * hh; pa[r] = (jb < ib || jl <= ql) ? at[r] : 0.f; }
            const bf16x8 pb0 = pack_frag(pa, 0), pb1 = pack_frag(pa, 1);
            bf16x4 t00, t01, t10, t11, u00, u01, u10, u11;
            tr_read_tile(vaddr + jb * 4096, t00, t01, t10, t11, u00, u01, u10, u11);
            o0 = MFMA32(__builtin_shufflevector(t00, t01, 0, 1, 2, 3, 4, 5, 6, 7), pb0, o0); o0 = MFMA32(__builtin_shufflevector(t10, t11, 0, 1, 2, 3, 4, 5, 6, 7), pb1, o0);
            o1 = MFMA32(__builtin_shufflevector(u00, u01, 0, 1, 2, 3, 4, 5, 6, 7), pb0, o1); o1 = MFMA32(__builtin_shufflevector(u10, u11, 0, 1, 2, 3, 4, 5, 6, 7), pb1, o1);
        }
    }
    { float* op = OI + (size_t)(tok0 + 32 * ib + ql) * 256 + h * 64 + 4 * hh;
#pragma unroll
      for (int q4 = 0; q4 < 4; ++q4) { *(f32x4*)(op + 8 * q4) = (f32x4){o0[4 * q4], o0[4 * q4 + 1], o0[4 * q4 + 2], o0[4 * q4 + 3]}; *(f32x4*)(op + 32 + 8 * q4) = (f32x4){o1[4 * q4], o1[4 * q4 + 1], o1[4 * q4 + 2], o1[4 * q4 + 3]}; } }
    { f32x16 sa;
#pragma unroll
      for (int r = 0; r < 16; ++r) sa[r] = 0.f;
      const unsigned lp = (unsigned)((8 * hh + ((lane >> 2) & 3)) * 64 + 32 * ((lane >> 4) & 1) + 8 * (lane & 3));
      const unsigned va = (unsigned)(size_t)(lds + GL_V + h * 8192) + lp, ka = (unsigned)(size_t)(lds + GL_KD + h * 4096) + lp;
#pragma unroll
      for (int tt = 0; tt < 2; ++tt)
#pragma unroll
        for (int ks = 0; ks < 2; ++ks) { const bf16x8 af = tr_frag(va + (tt * 2 + ib) * 2048 + ks * 1024), bfv = tr_frag(ka + (32 * tt + 16 * ks) * 64); sa = MFMA32(af, bfv, sa); }
      float* kp = KVT + (size_t)it4 * 2048 + (size_t)(32 * ib + 4 * hh) * 32 + ql;
#pragma unroll
      for (int r = 0; r < 16; ++r) kp[((r & 3) + 8 * (r >> 2)) * 32] = sa[r]; }
    __syncthreads();
}
__device__ __forceinline__ void gla2_c_item(const Args& a, int l, int item, LAS unsigned char* lds, int tid) {
    const int lane = tid & 63, w = __builtin_amdgcn_readfirstlane(tid >> 6), ql = lane & 31, hh = lane >> 5;
    const int n = item & 31, b = item >> 5, h = w >> 1, ib = w & 1, tok0 = b * T + n * 64, it4 = (b * 4 + h) * 32 + n;
    const bf16* z = (const bf16*)(a.ws + WS_Z); bf16* mix = (bf16*)(a.ws + WS_MIX);
    const float* OI = (const float*)(a.ws + WS_GOI); const v4u* QTF = (const v4u*)(a.ws + WS_GQT); const float* KVT = (const float*)(a.ws + WS_GKV); const float* DEC = (const float*)(a.ws + WS_GDEC);
    float S0[16], S1[16];
    { const float* sp = KVT + (size_t)it4 * 2048 + ql * 32 + 4 * hh;
#pragma unroll
      for (int q4 = 0; q4 < 4; ++q4) { const f32x4 t0 = *(const f32x4*)(sp + 8 * q4), t1 = *(const f32x4*)(sp + 1024 + 8 * q4);
          S0[4 * q4] = t0.x; S0[4 * q4 + 1] = t0.y; S0[4 * q4 + 2] = t0.z; S0[4 * q4 + 3] = t0.w; S1[4 * q4] = t1.x; S1[4 * q4 + 1] = t1.y; S1[4 * q4 + 2] = t1.z; S1[4 * q4 + 3] = t1.w; } }
    const bf16x8 qf0 = __builtin_bit_cast(bf16x8, QTF[((size_t)it4 * 2 + ib) * 128 + lane]), qf1 = __builtin_bit_cast(bf16x8, QTF[((size_t)it4 * 2 + ib) * 128 + 64 + lane]);
    f32x16 o0, o1;
    { const float* op = OI + (size_t)(tok0 + 32 * ib + ql) * 256 + h * 64 + 4 * hh;
#pragma unroll
      for (int q4 = 0; q4 < 4; ++q4) { const f32x4 t0 = *(const f32x4*)(op + 8 * q4), t1 = *(const f32x4*)(op + 32 + 8 * q4);
          o0[4 * q4] = t0.x; o0[4 * q4 + 1] = t0.y; o0[4 * q4 + 2] = t0.z; o0[4 * q4 + 3] = t0.w; o1[4 * q4] = t1.x; o1[4 * q4 + 1] = t1.y; o1[4 * q4 + 2] = t1.z; o1[4 * q4 + 3] = t1.w; } }
    o0 = MFMA32(pack_frag(S0, 0), qf0, o0); o0 = MFMA32(pack_frag(S0, 1), qf1, o0);
    o1 = MFMA32(pack_frag(S1, 0), qf0, o1); o1 = MFMA32(pack_frag(S1, 1), qf1, o1);
    float ss = 0.f;
#pragma unroll
    for (int r = 0; r < 16; ++r) ss += o0[r] * o0[r] + o1[r] * o1[r];
    ss += shfl_xor_c<32>(ss);
    const float rstd = rsqrtf(ss * (1.0f / 64.0f) + EPS);
    const size_t row = (size_t)(tok0 + 32 * ib + ql);
#pragma unroll
    for (int vb = 0; vb < 2; ++vb)
#pragma unroll
        for (int q4 = 0; q4 < 4; ++q4) { const int v0 = 32 * vb + 8 * q4 + 4 * hh;
            const f32x4 gn = *(const f32x4*)(a.in[IN_GNORM] + l * 256 + h * 64 + v0); const v2u gr = *(const v2u*)(z + row * ZW + Z_AG + h * 64 + v0);
            const float g0 = bflo(gr.x), g1 = bfhi(gr.x), g2 = bflo(gr.y), g3 = bfhi(gr.y);
            const float y0 = (vb ? o1[4 * q4] : o0[4 * q4]) * rstd * gn.x * silu_f(g0), y1 = (vb ? o1[4 * q4 + 1] : o0[4 * q4 + 1]) * rstd * gn.y * silu_f(g1);
            const float y2 = (vb ? o1[4 * q4 + 2] : o0[4 * q4 + 2]) * rstd * gn.z * silu_f(g2), y3 = (vb ? o1[4 * q4 + 3] : o0[4 * q4 + 3]) * rstd * gn.w * silu_f(g3);
            v2u o; o.x = pk2(y0, y1); o.y = pk2(y2, y3); *(v2u*)(mix + row * D + h * 64 + v0) = o; }
}
__device__ __forceinline__ void gla_scan_phase(const Args& a, int tid, int G, int bid) {
    float* KVT = (float*)(a.ws + WS_GKV); const float* DEC = (const float*)(a.ws + WS_GDEC);
    typedef float f32x2v __attribute__((ext_vector_type(2)));
    for (int u = bid * NTHR + tid; u < 32 * 1024; u += G * NTHR) { const int bh = u >> 10, e0 = (u & 1023) * 2;
        float* kp = KVT + (size_t)bh * 32 * 2048 + e0; const float* dp = DEC + (size_t)bh * 32 * 32 + (e0 & 31);
        f32x2v kv[32], dc[32];
#pragma unroll
        for (int m = 0; m < 32; ++m) { kv[m] = *(const f32x2v*)(kp + (size_t)m * 2048); dc[m] = *(const f32x2v*)(dp + m * 32); }
        f32x2v S = (f32x2v){0.f, 0.f};
#pragma unroll
        for (int m = 0; m < 32; ++m) { *(f32x2v*)(kp + (size_t)m * 2048) = S; S = S * dc[m] + kv[m]; } }
}
constexpr int CW_QUEUE = 8192;
__device__ __forceinline__ void mixers_phase(const Args& a, int l, LAS unsigned char* lds, int tid) {
    dsa2_setup(a, lds, tid);
    float prof[6] = {0.f, 0.f, 0.f, 0.f, 0.f, 0.f};
#ifdef PROF_DSA
    const unsigned long long tph0 = wall_clock64();
#endif
    unsigned* qctr = (unsigned*)(a.ws + WS_CTL) + CW_QUEUE + 64 * l;
    volatile LAS int* qslot = (volatile LAS int*)(lds + MISC_OFF + 64);
    for (;;) {
        if (tid == 0) *qslot = (int)__hip_atomic_fetch_add(qctr, 1u, __ATOMIC_RELAXED, __HIP_MEMORY_SCOPE_AGENT);
        __syncthreads();
        int it = *qslot;
        __syncthreads();
#ifdef REP_MIX
        if (it >= 2304) break;
        if (it >= 1152) it -= 1152;
        if (it < 512) dsa2_setup(a, lds, tid);
#elif defined(REP_DSA)
        if (it >= 1152 + 512) break;
        if (it >= 1152) it -= 1152;
        if (it < 512) dsa2_setup(a, lds, tid);
#else
        if (it >= 1152) break;
#endif
        const int t2 = (tid & ~63) + (int)lane_id_now();
        if (it < 512) dsa2_item(a, it, lds, t2, prof);
        else if (it < 640) sgu2_item(a, l, it - 512, lds, t2);
        else if (it < 896) gla2_a_item(a, l, it - 640, lds, t2);
        else pool2_item(a, l, it - 896, lds, t2);
    }
#ifdef PROF_DSA
    if (tid == 0) { prof[5] = (float)(wall_clock64() - tph0); float* pr = (float*)(a.ws + WS_CTL) + 12288;
#pragma unroll
        for (int k2 = 0; k2 < 6; ++k2) atomicAdd(pr + 2 + k2, prof[k2]); }
#endif
#if defined(PROBE_DSA) && !defined(PROBE_GLA) && !defined(PROBE_SGU) && !defined(PROBE_POOL)
    __syncthreads(); dsa_setup(a, lds, tid);
    for (int it = M - 1 - (int)blockIdx.x; it >= 0; it -= gridDim.x) dsa_item(a, it, lds, tid, (bf16*)(a.ws + WS_QX), 256);
#endif
}
#ifdef PROBE_DSA
__device__ __forceinline__ void probe_dsa_compare(const Args& a, LAS unsigned char* lds, int tid, int col0 = 512) {
    const bf16* mix = (const bf16*)(a.ws + WS_MIX); const bf16* alt = (const bf16*)(a.ws + WS_QX); float d2 = 0.f, r2 = 0.f;
    for (size_t i = (size_t)blockIdx.x * NTHR + tid; i < (size_t)M * 256; i += (size_t)gridDim.x * NTHR) { const size_t row = i >> 8, c = i & 255; const float x = bf1(mix[row * D + col0 + c]), y = bf1(alt[i]); d2 += (x - y) * (x - y); r2 += y * y; }
    d2 = wave_sum(d2); r2 = wave_sum(r2);
    if ((tid & 63) == 0) { atomicAdd((float*)(a.ws + WS_CTL) + 12288, d2); atomicAdd((float*)(a.ws + WS_CTL) + 12289, r2); }
}
#endif

__device__ __forceinline__ unsigned long long uniform_u64(unsigned long long v) { const unsigned lo = __builtin_amdgcn_readfirstlane((unsigned)v), hi = __builtin_amdgcn_readfirstlane((unsigned)(v >> 32)); return ((unsigned long long)hi << 32) | lo; }
__device__ __forceinline__ void load_args(Args& la, LAS unsigned char* lds) {
    const LAS unsigned long long* p = (const LAS unsigned long long*)(lds + ARGS_OFF);
#pragma unroll
    for (int i = 0; i < N_IN; ++i) la.in[i] = (const float*)(const GAS float*)uniform_u64(p[i]);
    la.out = (float*)(GAS float*)uniform_u64(p[N_IN]); la.ws = (unsigned char*)(GAS unsigned char*)uniform_u64(p[N_IN + 1]);
}
constexpr int NPHASE = 28;
#define REPEAT_BEGIN(flag) { int nrep_ = (flag) ? 2 : 1; asm volatile("" : "+s"(nrep_)); _Pragma("unroll 1") for (int rep_ = 0; rep_ < nrep_; ++rep_) {
#define REPEAT_END() } }
#ifndef REP_Z
#define REP_Z 0
#endif
#ifndef REP_Q
#define REP_Q 0
#endif
#ifndef REP_FUP
#define REP_FUP 0
#endif
#ifndef REP_MUP
#define REP_MUP 0
#endif
#ifndef REP_MDN
#define REP_MDN 0
#endif
#define OTID() const int tid = wave_id * 64 + (int)lane_id_now(); Args la; load_args(la, lds)
__global__ void __launch_bounds__(NTHR, 2) fwd_kernel(Args a) {
    extern __shared__ __attribute__((aligned(16))) unsigned char lds_raw[];
    LAS unsigned char* lds = (LAS unsigned char*)lds_raw;
    const int G0 = gridDim.x, bid0 = blockIdx.x, wave_id = __builtin_amdgcn_readfirstlane(threadIdx.x >> 6); const int G = G0, bid = bid0;
    volatile LAS unsigned* MISC = (volatile LAS unsigned*)(lds + MISC_OFF);
    if (threadIdx.x < 32) MISC[threadIdx.x] = 0u;
    if (threadIdx.x < N_IN + 2) {
        const __attribute__((address_space(4))) unsigned long long* ka = (const __attribute__((address_space(4))) unsigned long long*)__builtin_amdgcn_kernarg_segment_ptr();
        ((LAS unsigned long long*)(lds + ARGS_OFF))[threadIdx.x] = ka[threadIdx.x]; }
    __syncthreads();
    unsigned char* ws0 = a.ws; unsigned char* ws = ws0;
#define PH() GAS unsigned char* wsg_ = (GAS unsigned char*)ws0; asm volatile("" : "+s"(wsg_)); unsigned char* ws = (unsigned char*)wsg_; int G = G0, bid = bid0; asm volatile("" : "+s"(G), "+s"(bid))
    XcdBarrier bar; bar.bar = (unsigned*)(ws + WS_CTL) + CW_BAR; bar.x = 0; bar.st = nullptr; bar.wid = (unsigned)wave_id;
    if (N_LAUNCH_MODE == 1) bar = xcd_barrier_post((unsigned*)(ws + WS_CTL) + CW_BAR, MISC + 8);
    const int lo = a.ph_lo, hi = a.ph_hi;
#if defined(PROBE_GLA) || defined(PROBE_SGU) || defined(PROBE_POOL)
#define RUN(k) ((k) <= 3 && lo <= (k) && (k) < hi)
#else
#define RUN(k) (lo <= (k) && (k) < hi)
#endif
#define SEAM() do { if (N_LAUNCH_MODE == 1) xcd_barrier(bar); } while (0)
#define WB(off) ((bf16*)(ws + (off)))
#define WF(off) ((float*)(ws + (off)))
#ifdef REP_PRO
    if (RUN(0)) { PH(); int nrep = 2; asm volatile("" : "+s"(nrep));
#pragma unroll 1
        for (int rep = 0; rep < nrep; ++rep) { OTID(); p0_prologue(la, lds, tid, G); } SEAM(); }
#else
    if (RUN(0)) { PH(); OTID(); p0_prologue(la, lds, tid, G); SEAM(); }
#ifdef REP_BAR
    { int nb_ = 20; asm volatile("" : "+s"(nb_));
#pragma unroll 1
      for (int i_ = 0; i_ < nb_; ++i_) SEAM(); }
#endif
#endif

    { constexpr int l = 0;
        const int pb = l ? 10 : 1;
        if (RUN(pb + 0)) { PH();
            REPEAT_BEGIN(REP_Z)
            { pg8::Gemm g{WB(WS_H16), WB(WS_WIN + l * SZ_WIN), M, ZW, D}; pg8::StaticOrder S; S.init(M, ZW, G, bid);
              EpiScale E{WB(WS_Z), ZW, WF(WS_SS), 1.0f, WB(WS_DKF), Z_CK / 256}; pg8::gemm_phase<EpiScale, pg8::StaticOrder, true, true>(lds, g, S, E, wave_id); }
            REPEAT_END()
            if (l == 0) {
                for (int l2 = 0; l2 < 2; ++l2) {
                    pg8::Gemm g{WB(WS_MEMB), WB(WS_WKV + l2 * SZ_WKV), MM, 512, D}; pg8::StaticOrder S; S.init(MM, 512, G, (G - 1 - bid - 16 * l2 + 2 * G) % G);
                    EpiScale E{WB(WS_KVM + l2 * SZ_KVM), 512, WF(WS_SSM), 1.0f, nullptr, 0}; pg8::gemm_phase<EpiScale, pg8::StaticOrder, true, true>(lds, g, S, E, wave_id); }
            }
            SEAM();
        }
        if (RUN(pb + 1)) { PH();
            { OTID(); mixers_phase(la, l, lds, tid); }
#if defined(PROBE_SGU) || defined(PROBE_POOL)
            SEAM();
            { constexpr int PCOL =
#ifdef PROBE_SGU
                768;
#else
                256;
#endif
              bf16* mixp = WB(WS_MIX); bf16* alt = WB(WS_QX);
              for (size_t i = (size_t)bid * NTHR + threadIdx.x; i < (size_t)M * 256; i += (size_t)G * NTHR) alt[i] = mixp[(i >> 8) * D + PCOL + (i & 255)];
              SEAM();
#ifdef PROBE_SGU
              { OTID(); for (int it = bid; it < 512; it += G) sgu_item(la, l, it, lds, tid); }
#else
              { OTID(); for (int it = bid; it < 1024; it += G) pool_item(la, l, it, lds, tid); }
#endif
              SEAM();
              { OTID(); probe_dsa_compare(la, lds, tid, PCOL); }
              SEAM();
              { const float* pr = (const float*)(ws + WS_CTL) + 12288; const float padd = PROBE_C * sqrtf(pr[0] / fmaxf(pr[1], 1e-30f));
                for (size_t i = (size_t)bid * NTHR + threadIdx.x; i < (size_t)M * D; i += (size_t)G * NTHR) la.out[i] = padd; return; } }
#endif
            SEAM();
        }
#ifdef REP_GLAC
        if (RUN(pb + 2)) { PH(); OTID(); int nit = 512; asm volatile("" : "+s"(nit)); for (int it = bid; it < nit; it += G) gla2_c_item(la, l, it & 255, lds, tid);
#else
        if (RUN(pb + 2)) { PH(); OTID(); if (l == 0) frag_phase(la, tid, G, bid); gla_scan_phase(la, tid, G, bid); SEAM(); for (int it = bid; it < 256; it += G) gla2_c_item(la, l, it, lds, tid);
#endif
#if defined(PROBE_DSA) && !defined(PROBE_GLA) && !defined(PROBE_SGU) && !defined(PROBE_POOL)
            probe_dsa_compare(la, lds, tid);
#endif
            SEAM();
#ifdef PROBE_GLA
            { bf16* mixp = WB(WS_MIX); bf16* alt = WB(WS_QX);
              for (size_t i = (size_t)bid * NTHR + threadIdx.x; i < (size_t)M * 256; i += (size_t)G * NTHR) alt[i] = mixp[(i >> 8) * D + (i & 255)];
              SEAM();
              { OTID(); for (int it = bid; it < 1024; it += G) gla_a_item(la, l, it, lds, tid); }
              SEAM();
              { OTID(); for (int it = bid; it < 1024; it += G) gla_c_item(la, l, it, lds, tid); }
              SEAM();
              { OTID(); probe_dsa_compare(la, lds, tid, 0); }
              SEAM();
              { const float* pr = (const float*)(ws + WS_CTL) + 12288; const float padd = PROBE_C * sqrtf(pr[0] / fmaxf(pr[1], 1e-30f));
                for (size_t i = (size_t)bid * NTHR + threadIdx.x; i < (size_t)M * D; i += (size_t)G * NTHR) la.out[i] = padd; return; } }
#endif
            }
        if (RUN(pb + 3)) { PH();
            pg8::Gemm g{WB(WS_MIX), WB(WS_WOUT + l * SZ_WOUT), M, D, D}; pg8::StaticOrder S; S.init(M, D, G, bid);
            EpiResid E{WB(WS_H16), WF(WS_SS)}; pg8::gemm_phase<EpiResid, pg8::StaticOrder, true, true>(lds, g, S, E, wave_id); SEAM();
        }
        if (RUN(pb + 4)) { PH(); OTID(); for (int it = bid; it < 256; it += G) { const int t2 = (tid & ~63) + (int)lane_id_now(); xfuse_item(la, l, it, lds, t2); }
            if (l == 1) { __syncthreads(); const int t3 = (tid & ~63) + (int)lane_id_now(); moe_route(la, lds, t3, G, bid); }
            SEAM(); }
        if (l == 0) {
            if (RUN(8)) { PH();
                REPEAT_BEGIN(REP_FUP)
                pg8::Gemm g{WB(WS_H16), WB(WS_W13), M, 2 * DFF, D}; pg8::StaticOrder S; S.init(M, 2 * DFF, G, bid);
                EpiSwiglu<false> E{WB(WS_FACT), DFF, WF(WS_SS), nullptr, nullptr}; pg8::gemm_phase<EpiSwiglu<false>, pg8::StaticOrder, true, true>(lds, g, S, E, wave_id);
                REPEAT_END()
                    SEAM();
            }
            if (RUN(9)) { PH();
                pg8::Gemm g{WB(WS_FACT), WB(WS_W2), M, D, DFF}; pg8::StaticOrder S; S.init(M, D, G, bid);
                EpiResid E{WB(WS_H16), WF(WS_SS)}; pg8::gemm_phase<EpiResid, pg8::StaticOrder, true, true>(lds, g, S, E, wave_id); SEAM();
            }
        } else {
#ifdef REP_R1
            if (RUN(17)) { PH(); OTID(); moe_route(la, lds, tid, G, bid); __syncthreads(); moe_route(la, lds, tid, G, bid); SEAM(); }
#else
#endif
#ifdef REP_ROUTE
            if (RUN(18)) { PH(); int nrep = 2; asm volatile("" : "+s"(nrep));
#pragma unroll 1
                for (int rep = 0; rep < nrep; ++rep) { OTID(); moe_assign(la, lds, tid, G, bid); __syncthreads(); } SEAM(); }
#else
            if (RUN(18)) { PH(); OTID(); moe_assign(la, lds, tid, G, bid); SEAM(); }
#endif
            for (int ph = 0; ph <= MOE_NPASS; ++ph) {
                const int* TILEE = (const int*)(ws + WS_TILEE);
                if (RUN(19 + ph)) { PH();
                    const int NT = TILEE[159]; int ndown = 0, ndsh = 3;
                    if (ph > 0) { const int p = ph - 1; const int nt = moe_pass_nt(NT, p); ndown = nt * (D / 256); if (ndown > G) { ndown -= G; ndsh = 3; if (ndown > G) ndown = G; }
                        REPEAT_BEGIN(REP_MDN)
                        pg8::Gemm g{WB(WS_MACT + (p & 1) * SZ_MACT), WB(WS_MW2), MOE_TP * 256, NEXP * D, DFE, (const int*)(ws + WS_IDMAP)}; pg8::MoeOrder S{p * MOE_TS, nt, D / 256, G, bid, 1, TILEE, 0, 0};
                        EpiPlain E{WB(WS_YS), D};
                        pg8::gemm_phase<EpiPlain, pg8::MoeOrder, true, true, true, 1>(lds, g, S, E, wave_id);
                        REPEAT_END() }
                    if (ph < MOE_NPASS) { const int p = ph; const int nt = moe_pass_nt(NT, p);
                        REPEAT_BEGIN(REP_MUP)
                        pg8::Gemm g{WB(WS_HB8), WB(WS_MW13), M, NEXP * 2 * DFE, D, (const int*)(ws + WS_SLOTT)}; pg8::MoeOrder S{p * MOE_TS, nt, 2 * DFE / 256, G, bid, 0, TILEE, ndown, ndsh};
                        EpiSwiglu<true> E{WB(WS_MACT + (p & 1) * SZ_MACT), DFE, nullptr, WF(WS_SLOTR), WF(WS_SLOTG)};
                        pg8::gemm_phase<EpiSwiglu<true>, pg8::MoeOrder, true, true, true, 1>(lds, g, S, E, wave_id);
                        REPEAT_END() }
                    SEAM();
                }
            }
#ifdef REP_FINAL
            if (RUN(27)) { PH(); OTID(); final_phase(la, tid, G, bid); }
#else
            if (RUN(27)) { PH(); OTID(); final_phase(la, tid, G, bid); }
#endif
        }
        }
    { constexpr int l = 1;
        const int pb = l ? 10 : 1;
        if (RUN(pb + 0)) { PH();
            REPEAT_BEGIN(REP_Z)
            { pg8::Gemm g{WB(WS_H16), WB(WS_WIN + l * SZ_WIN), M, ZW, D}; pg8::StaticOrder S; S.init(M, ZW, G, bid);
              EpiScale E{WB(WS_Z), ZW, WF(WS_SS), 1.0f, WB(WS_DKF), Z_CK / 256}; pg8::gemm_phase<EpiScale, pg8::StaticOrder, true, true>(lds, g, S, E, wave_id); }
            REPEAT_END()
            if (l == 0) {
                for (int l2 = 0; l2 < 2; ++l2) {
                    pg8::Gemm g{WB(WS_MEMB), WB(WS_WKV + l2 * SZ_WKV), MM, 512, D}; pg8::StaticOrder S; S.init(MM, 512, G, (G - 1 - bid - 16 * l2 + 2 * G) % G);
                    EpiScale E{WB(WS_KVM + l2 * SZ_KVM), 512, WF(WS_SSM), 1.0f, nullptr, 0}; pg8::gemm_phase<EpiScale, pg8::StaticOrder, true, true>(lds, g, S, E, wave_id); }
            }
            SEAM();
        }
        if (RUN(pb + 1)) { PH();
            { OTID(); mixers_phase(la, l, lds, tid); }
#if defined(PROBE_SGU) || defined(PROBE_POOL)
            SEAM();
            { constexpr int PCOL =
#ifdef PROBE_SGU
                768;
#else
                256;
#endif
              bf16* mixp = WB(WS_MIX); bf16* alt = WB(WS_QX);
              for (size_t i = (size_t)bid * NTHR + threadIdx.x; i < (size_t)M * 256; i += (size_t)G * NTHR) alt[i] = mixp[(i >> 8) * D + PCOL + (i & 255)];
              SEAM();
#ifdef PROBE_SGU
              { OTID(); for (int it = bid; it < 512; it += G) sgu_item(la, l, it, lds, tid); }
#else
              { OTID(); for (int it = bid; it < 1024; it += G) pool_item(la, l, it, lds, tid); }
#endif
              SEAM();
              { OTID(); probe_dsa_compare(la, lds, tid, PCOL); }
              SEAM();
              { const float* pr = (const float*)(ws + WS_CTL) + 12288; const float padd = PROBE_C * sqrtf(pr[0] / fmaxf(pr[1], 1e-30f));
                for (size_t i = (size_t)bid * NTHR + threadIdx.x; i < (size_t)M * D; i += (size_t)G * NTHR) la.out[i] = padd; return; } }
#endif
            SEAM();
        }
#ifdef REP_GLAC
        if (RUN(pb + 2)) { PH(); OTID(); int nit = 512; asm volatile("" : "+s"(nit)); for (int it = bid; it < nit; it += G) gla2_c_item(la, l, it & 255, lds, tid);
#else
        if (RUN(pb + 2)) { PH(); OTID(); if (l == 0) frag_phase(la, tid, G, bid); gla_scan_phase(la, tid, G, bid); SEAM(); for (int it = bid; it < 256; it += G) gla2_c_item(la, l, it, lds, tid);
#endif
#if defined(PROBE_DSA) && !defined(PROBE_GLA) && !defined(PROBE_SGU) && !defined(PROBE_POOL)
            probe_dsa_compare(la, lds, tid);
#endif
            SEAM();
#ifdef PROBE_GLA
            { bf16* mixp = WB(WS_MIX); bf16* alt = WB(WS_QX);
              for (size_t i = (size_t)bid * NTHR + threadIdx.x; i < (size_t)M * 256; i += (size_t)G * NTHR) alt[i] = mixp[(i >> 8) * D + (i & 255)];
              SEAM();
              { OTID(); for (int it = bid; it < 1024; it += G) gla_a_item(la, l, it, lds, tid); }
              SEAM();
              { OTID(); for (int it = bid; it < 1024; it += G) gla_c_item(la, l, it, lds, tid); }
              SEAM();
              { OTID(); probe_dsa_compare(la, lds, tid, 0); }
              SEAM();
              { const float* pr = (const float*)(ws + WS_CTL) + 12288; const float padd = PROBE_C * sqrtf(pr[0] / fmaxf(pr[1], 1e-30f));
                for (size_t i = (size_t)bid * NTHR + threadIdx.x; i < (size_t)M * D; i += (size_t)G * NTHR) la.out[i] = padd; return; } }
#endif
            }
        if (RUN(pb + 3)) { PH();
            pg8::Gemm g{WB(WS_MIX), WB(WS_WOUT + l * SZ_WOUT), M, D, D}; pg8::StaticOrder S; S.init(M, D, G, bid);
            EpiResid E{WB(WS_H16), WF(WS_SS)}; pg8::gemm_phase<EpiResid, pg8::StaticOrder, true, true>(lds, g, S, E, wave_id); SEAM();
        }
        if (RUN(pb + 4)) { PH(); OTID(); for (int it = bid; it < 256; it += G) { const int t2 = (tid & ~63) + (int)lane_id_now(); xfuse_item(la, l, it, lds, t2); }
            if (l == 1) { __syncthreads(); const int t3 = (tid & ~63) + (int)lane_id_now(); moe_route(la, lds, t3, G, bid); }
            SEAM(); }
        if (l == 0) {
            if (RUN(8)) { PH();
                REPEAT_BEGIN(REP_FUP)
                pg8::Gemm g{WB(WS_H16), WB(WS_W13), M, 2 * DFF, D}; pg8::StaticOrder S; S.init(M, 2 * DFF, G, bid);
                EpiSwiglu<false> E{WB(WS_FACT), DFF, WF(WS_SS), nullptr, nullptr}; pg8::gemm_phase<EpiSwiglu<false>, pg8::StaticOrder, true, true>(lds, g, S, E, wave_id);
                REPEAT_END()
                    SEAM();
            }
            if (RUN(9)) { PH();
                pg8::Gemm g{WB(WS_FACT), WB(WS_W2), M, D, DFF}; pg8::StaticOrder S; S.init(M, D, G, bid);
                EpiResid E{WB(WS_H16), WF(WS_SS)}; pg8::gemm_phase<EpiResid, pg8::StaticOrder, true, true>(lds, g, S, E, wave_id); SEAM();
            }
        } else {
#ifdef REP_R1
            if (RUN(17)) { PH(); OTID(); moe_route(la, lds, tid, G, bid); __syncthreads(); moe_route(la, lds, tid, G, bid); SEAM(); }
#else
#endif
#ifdef REP_ROUTE
            if (RUN(18)) { PH(); int nrep = 2; asm volatile("" : "+s"(nrep));
#pragma unroll 1
                for (int rep = 0; rep < nrep; ++rep) { OTID(); moe_assign(la, lds, tid, G, bid); __syncthreads(); } SEAM(); }
#else
            if (RUN(18)) { PH(); OTID(); moe_assign(la, lds, tid, G, bid); SEAM(); }
#endif
            for (int ph = 0; ph <= MOE_NPASS; ++ph) {
                const int* TILEE = (const int*)(ws + WS_TILEE);
                if (RUN(19 + ph)) { PH();
                    const int NT = TILEE[159]; int ndown = 0, ndsh = 3;
                    if (ph > 0) { const int p = ph - 1; const int nt = moe_pass_nt(NT, p); ndown = nt * (D / 256); if (ndown > G) { ndown -= G; ndsh = 3; if (ndown > G) ndown = G; }
                        REPEAT_BEGIN(REP_MDN)
                        pg8::Gemm g{WB(WS_MACT + (p & 1) * SZ_MACT), WB(WS_MW2), MOE_TP * 256, NEXP * D, DFE, (const int*)(ws + WS_IDMAP)}; pg8::MoeOrder S{p * MOE_TS, nt, D / 256, G, bid, 1, TILEE, 0, 0};
                        EpiPlain E{WB(WS_YS), D};
                        pg8::gemm_phase<EpiPlain, pg8::MoeOrder, true, true, true, 1>(lds, g, S, E, wave_id);
                        REPEAT_END() }
                    if (ph < MOE_NPASS) { const int p = ph; const int nt = moe_pass_nt(NT, p);
                        REPEAT_BEGIN(REP_MUP)
                        pg8::Gemm g{WB(WS_HB8), WB(WS_MW13), M, NEXP * 2 * DFE, D, (const int*)(ws + WS_SLOTT)}; pg8::MoeOrder S{p * MOE_TS, nt, 2 * DFE / 256, G, bid, 0, TILEE, ndown, ndsh};
                        EpiSwiglu<true> E{WB(WS_MACT + (p & 1) * SZ_MACT), DFE, nullptr, WF(WS_SLOTR), WF(WS_SLOTG)};
                        pg8::gemm_phase<EpiSwiglu<true>, pg8::MoeOrder, true, true, true, 1>(lds, g, S, E, wave_id);
                        REPEAT_END() }
                    SEAM();
                }
            }
#ifdef REP_FINAL
            if (RUN(27)) { PH(); OTID(); final_phase(la, tid, G, bid); }
#else
            if (RUN(27)) { PH(); OTID(); final_phase(la, tid, G, bid); }
#endif
        }
        }
#undef RUN
#undef SEAM
}

extern "C" void kernel_launch(void* const* d_in, const int* in_sizes, int n_in, void* d_out, int out_size, void* d_ws, size_t ws_size, hipStream_t stream) {
    static int grid = 0;
    if (grid == 0) {
        if (n_in != N_IN || out_size != M * D || ws_size < WS_END) { fprintf(stderr, "kernel_launch: unexpected problem (n_in %d, out %d, ws %zu < %zu)\n", n_in, out_size, ws_size, (size_t)WS_END); grid = -1; return; }
        int dev = 0, cus = 0, per_cu = 0;
        if (hipGetDevice(&dev) != hipSuccess || hipDeviceGetAttribute(&cus, hipDeviceAttributeMultiprocessorCount, dev) != hipSuccess) { grid = -1; return; }
        if (hipFuncSetAttribute((const void*)fwd_kernel, hipFuncAttributeMaxDynamicSharedMemorySize, LDS_BYTES) != hipSuccess) { fprintf(stderr, "kernel_launch: hipFuncSetAttribute failed\n"); grid = -1; return; }
        if (hipOccupancyMaxActiveBlocksPerMultiprocessor(&per_cu, (const void*)fwd_kernel, NTHR, LDS_BYTES) != hipSuccess || per_cu < 1) { fprintf(stderr, "kernel_launch: occupancy query says %d\n", per_cu); }
        (void)hipGetLastError();
        grid = (cus > 0 && cus < 256) ? cus : 256;
    }
    if (grid < 0) return;
    (void)hipMemsetAsync((char*)d_ws + WS_CTL, 0, CTL_ZERO_BYTES, stream);
    Args a{};
    for (int i = 0; i < N_IN; ++i) a.in[i] = (const float*)d_in[i];
    a.out = (float*)d_out; a.ws = (unsigned char*)d_ws;
#if N_LAUNCH_MODE == 1
    a.ph_lo = 0; a.ph_hi = NPHASE;
    hipLaunchKernelGGL(fwd_kernel, dim3(grid), dim3(NTHR), LDS_BYTES, stream, a);
#else
    for (int p = 0; p < NPHASE; ++p) { a.ph_lo = p; a.ph_hi = p + 1; hipLaunchKernelGGL(fwd_kernel, dim3(grid), dim3(NTHR), LDS_BYTES, stream, a); }
#endif
}
```
